# Optimizing an MI355X kernel written in HIP

```python
import jax, jax.numpy as jnp
from jax import lax
import numpy as np

D_MODEL = 1024
BATCH = 4
SEQ = 4096
DEPTH = 2

HEAD_DIM = 64
ATT_HEADS = D_MODEL // 128
ATT_WIDTH = ATT_HEADS * HEAD_DIM
DILATED_CONFIGS = ((128, 1), (512, 4), (2048, 16))
BLOCK = 128
ROPE_THETA = 10000.0
RWKV_HEAD = 64
RWKV_HEADS = D_MODEL // 128
RWKV_WIDTH = RWKV_HEADS * RWKV_HEAD
DECAY_LORA = 64
AAA_LORA = 64
GATE_LORA = 128
RWKV_COLS = 3 * RWKV_WIDTH + DECAY_LORA + AAA_LORA + GATE_LORA
GMLP_CHUNK = 128
GMLP_GROUPS = 8
GMLP_WIDTH = D_MODEL // 2
GMLP_GROUP_DIM = GMLP_WIDTH // GMLP_GROUPS
N_BRANCH = 3
IN_COLS = 3 * ATT_WIDTH + RWKV_COLS + 2 * GMLP_WIDTH + N_BRANCH * D_MODEL
D_FF = 2816
CONV_WIDTH = 3
RMS_EPS = 1e-6
LN_EPS = 1e-5
GN_EPS = 64e-5

kernel_name = 'hybrid_gated_parallel_mixer_block'


def rms_norm(x, g):
    xf = x.astype(jnp.float32)
    y = xf * lax.rsqrt(jnp.mean(xf * xf, axis=-1, keepdims=True) + RMS_EPS)
    return (y * g).astype(x.dtype)


def layer_norm(x, g, b, eps):
    xf = x.astype(jnp.float32)
    mu = jnp.mean(xf, axis=-1, keepdims=True)
    var = jnp.mean(jnp.square(xf - mu), axis=-1, keepdims=True)
    return (xf - mu) * lax.rsqrt(var + eps) * g + b


def modulate(h, shift, scale):
    return h * (1.0 + scale[:, None, :]) + shift[:, None, :]


def rope_tables(seq_len):
    inv = 1.0 / (ROPE_THETA ** (jnp.arange(0, HEAD_DIM, 2, dtype=jnp.float32) / HEAD_DIM))
    ang = jnp.arange(seq_len, dtype=jnp.float32)[:, None] * inv[None, :]
    return jnp.cos(ang), jnp.sin(ang)


def apply_rope(t, cos, sin):
    t1, t2 = jnp.split(t.astype(jnp.float32), 2, axis=-1)
    c = cos[None, :, None, :]
    s = sin[None, :, None, :]
    return jnp.concatenate([t1 * c - t2 * s, t2 * c + t1 * s], axis=-1)


def dilated_window_attention(q, k, v, window, dilation):
    B, S, H, Dh = q.shape
    span = window // dilation
    L = -(-S // (dilation * BLOCK)) * BLOCK
    pad = L * dilation - S
    nb = L // BLOCK

    def to_blocks(t):
        t = jnp.pad(t, ((0, 0), (0, pad), (0, 0), (0, 0)))
        t = t.reshape(B, L, dilation, H, Dh).transpose(0, 2, 3, 1, 4)
        return t.reshape(B, dilation, H, nb, BLOCK, Dh)

    def with_prev(t):
        prev = jnp.pad(t, ((0, 0), (0, 0), (0, 0), (1, 0), (0, 0), (0, 0)))[:, :, :, :-1]
        return jnp.concatenate([prev, t], axis=4)

    qb = to_blocks(q)
    kc = with_prev(to_blocks(k))
    vc = with_prev(to_blocks(v))
    s = jnp.einsum('brhnqe,brhnke->brhnqk', qb, kc).astype(jnp.float32) * (Dh ** -0.5)
    qi = jnp.arange(BLOCK)[:, None] + BLOCK
    ki = jnp.arange(2 * BLOCK)[None, :]
    dist = qi - ki
    band = (dist >= 0) & (dist <= span)
    has_prev = (jnp.arange(nb) > 0)[:, None, None] | (ki >= BLOCK)[None]
    mask = band[None] & has_prev
    s = jnp.where(mask, s, -jnp.inf)
    m = jnp.max(s, axis=-1, keepdims=True)
    p = jnp.exp(s - m)
    l = jnp.sum(p, axis=-1, keepdims=True)
    o = jnp.einsum('brhnqk,brhnke->brhnqe', p, vc.astype(jnp.float32)) / l
    lse = (m + jnp.log(l))[..., 0]

    def from_blocks(t):
        tail = t.shape[5:]
        t = t.reshape((B, dilation, H, L) + tail)
        t = jnp.moveaxis(t, 3, 1)
        return t.reshape((B, L * dilation, H) + tail)[:, :S]

    return from_blocks(o), from_blocks(lse)


def dilated_mixture_attention(q, k, v):
    outs, lses = [], []
    for window, dilation in DILATED_CONFIGS:
        o, lse = dilated_window_attention(q, k, v, window, dilation)
        outs.append(o)
        lses.append(lse)
    wts = jax.nn.softmax(jnp.stack(lses, axis=0), axis=0)
    return jnp.sum(wts[..., None] * jnp.stack(outs, axis=0), axis=0)


def token_shift(t):
    return jnp.pad(t, ((0, 0), (1, 0), (0, 0)))[:, :-1]


def wkv7_scan(r, decay, k, v, a, b):
    B, S, H, N = r.shape
    seq = tuple(jnp.moveaxis(t, 1, 0) for t in (r, decay, k, v, a, b))

    def step(state, inp):
        r_t, w_t, k_t, v_t, a_t, b_t = inp
        sa = jnp.einsum('bhij,bhj->bhi', state, a_t)
        state = (state * w_t[:, :, None, :] + sa[..., None] * b_t[:, :, None, :]
                 + v_t[..., None] * k_t[:, :, None, :])
        return state, jnp.einsum('bhij,bhj->bhi', state, r_t)

    _, y = lax.scan(step, jnp.zeros((B, H, N, N), jnp.float32), seq)
    return jnp.moveaxis(y, 0, 1)


def rwkv7_time_mix(p_rwkv, mu, w0, w_up, a0, a_up, g_up, k_k, k_a, r_k, gn_w, gn_b):
    B, S, _ = p_rwkv.shape
    z = p_rwkv.astype(jnp.float32)
    z = z + (token_shift(z) - z) * mu
    o1 = RWKV_WIDTH
    o2 = 2 * RWKV_WIDTH
    o3 = 3 * RWKV_WIDTH
    o4 = o3 + DECAY_LORA
    o5 = o4 + AAA_LORA
    r, k, v = z[..., :o1], z[..., o1:o2], z[..., o2:o3]
    xw, xa, xg = z[..., o3:o4], z[..., o4:o5], z[..., o5:]
    w = -jax.nn.softplus(-(w0 + jnp.tanh(xw) @ w_up)) - 0.5
    a = jax.nn.sigmoid(a0 + xa @ a_up)
    g = jax.nn.sigmoid(xg) @ g_up
    hs = lambda t: t.reshape(B, S, RWKV_HEADS, RWKV_HEAD)
    kk = hs(k * k_k)
    kk = kk / jnp.maximum(jnp.sqrt(jnp.sum(kk * kk, axis=-1, keepdims=True)), 1e-12)
    k = k * (1.0 + (a - 1.0) * k_a)
    r4, k4, v4, a4 = hs(r), hs(k), hs(v), hs(a)
    decay = jnp.exp(-jnp.exp(hs(w)))
    y = wkv7_scan(r4, decay, k4, v4, -kk, kk * a4)
    mu_y = jnp.mean(y, axis=-1, keepdims=True)
    var_y = jnp.mean(jnp.square(y - mu_y), axis=-1, keepdims=True)
    y = (y - mu_y) * lax.rsqrt(var_y + GN_EPS) * gn_w.reshape(RWKV_HEADS, RWKV_HEAD) \
        + gn_b.reshape(RWKV_HEADS, RWKV_HEAD)
    y = y + jnp.sum(r4 * k4 * r_k, axis=-1, keepdims=True) * v4
    return y.reshape(B, S, RWKV_WIDTH) * g


def chunked_spatial_gating(p_uv, ln_g, ln_b, w_s, b_s):
    B, S, _ = p_uv.shape
    z = jax.nn.gelu(p_uv.astype(jnp.float32))
    u, v = z[..., :GMLP_WIDTH], z[..., GMLP_WIDTH:]
    v = layer_norm(v, ln_g, ln_b, LN_EPS)
    nc = S // GMLP_CHUNK
    vg = v.reshape(B, nc, GMLP_CHUNK, GMLP_GROUPS, GMLP_GROUP_DIM)
    causal = jnp.tril(jnp.ones((GMLP_CHUNK, GMLP_CHUNK), dtype=bool))
    ws = jnp.where(causal[None], w_s, 0.0)
    s = jnp.einsum('gij,bcjgd->bcigd', ws, vg) + b_s.T[None, None, :, :, None]
    return u * s.reshape(B, S, GMLP_WIDTH)


def conv_gated_ffn(h, w_up, conv_w, conv_b, w_down):
    S = h.shape[1]
    up = h @ w_up
    a, g = up[..., :D_FF], up[..., D_FF:]
    ap = jnp.pad(a, ((0, 0), (CONV_WIDTH - 1, 0), (0, 0)))
    a = conv_b + sum(conv_w[j] * ap[:, j:j + S] for j in range(CONV_WIDTH))
    return (jax.nn.gelu(a) * g) @ w_down


def setup_inputs(seed: int = 0) -> dict:
    key = jax.random.key(seed)
    ks = jax.random.split(key, 32)
    nrm = lambda k, shape, scale: jax.random.normal(k, shape, jnp.float32) * scale
    L = DEPTH
    return {
        'x': nrm(ks[0], (BATCH, SEQ, D_MODEL), 1.0),
        'c': nrm(ks[1], (BATCH, D_MODEL), 1.0),
        'w_ada': nrm(ks[2], (L, D_MODEL, 6 * D_MODEL), 0.5 * D_MODEL ** -0.5),
        'b_ada': nrm(ks[3], (L, 6 * D_MODEL), 0.02),
        'norm_mix': 1.0 + nrm(ks[4], (L, D_MODEL), 0.05),
        'w_in': nrm(ks[5], (L, D_MODEL, IN_COLS), D_MODEL ** -0.5),
        'rwkv_mu': jax.random.uniform(ks[6], (L, RWKV_COLS), jnp.float32),
        'rwkv_w0': jax.random.uniform(ks[7], (L, RWKV_WIDTH), jnp.float32, minval=-5.0, maxval=-1.0),
        'rwkv_w_up': nrm(ks[8], (L, DECAY_LORA, RWKV_WIDTH), 0.5 * DECAY_LORA ** -0.5),
        'rwkv_a0': nrm(ks[9], (L, RWKV_WIDTH), 0.1),
        'rwkv_a_up': nrm(ks[10], (L, AAA_LORA, RWKV_WIDTH), AAA_LORA ** -0.5),
        'rwkv_g_up': nrm(ks[11], (L, GATE_LORA, RWKV_WIDTH), GATE_LORA ** -0.5),
        'rwkv_k_k': 0.85 + nrm(ks[12], (L, RWKV_WIDTH), 0.05),
        'rwkv_k_a': 1.0 + nrm(ks[13], (L, RWKV_WIDTH), 0.05),
        'rwkv_r_k': nrm(ks[14], (L, RWKV_HEADS, RWKV_HEAD), 0.1),
        'rwkv_gn_w': 1.0 + nrm(ks[15], (L, RWKV_WIDTH), 0.05),
        'rwkv_gn_b': nrm(ks[16], (L, RWKV_WIDTH), 0.02),
        'gmlp_ln_g': 1.0 + nrm(ks[17], (L, GMLP_WIDTH), 0.05),
        'gmlp_ln_b': nrm(ks[18], (L, GMLP_WIDTH), 0.02),
        'gmlp_w_s': nrm(ks[19], (L, GMLP_GROUPS, GMLP_CHUNK, GMLP_CHUNK), 0.5 * GMLP_CHUNK ** -0.5),
        'gmlp_b_s': 1.0 + nrm(ks[20], (L, GMLP_GROUPS, GMLP_CHUNK), 0.05),
        'w_branch': nrm(ks[21], (L, N_BRANCH, ATT_WIDTH, D_MODEL), ATT_WIDTH ** -0.5),
        'w_out': nrm(ks[22], (L, D_MODEL, D_MODEL), D_MODEL ** -0.5),
        'norm_ffn': 1.0 + nrm(ks[23], (L, D_MODEL), 0.05),
        'ffn_w_up': nrm(ks[24], (L, D_MODEL, 2 * D_FF), D_MODEL ** -0.5),
        'ffn_conv_w': nrm(ks[25], (L, CONV_WIDTH, D_FF), CONV_WIDTH ** -0.5),
        'ffn_conv_b': nrm(ks[26], (L, D_FF), 0.02),
        'ffn_w_down': nrm(ks[27], (L, D_FF, D_MODEL), D_FF ** -0.5),
        'norm_final': 1.0 + nrm(ks[28], (D_MODEL,), 0.05),
    }


def reference(x, c, w_ada, b_ada, norm_mix, w_in, rwkv_mu, rwkv_w0, rwkv_w_up, rwkv_a0,
              rwkv_a_up, rwkv_g_up, rwkv_k_k, rwkv_k_a, rwkv_r_k, rwkv_gn_w, rwkv_gn_b,
              gmlp_ln_g, gmlp_ln_b, gmlp_w_s, gmlp_b_s, w_branch, w_out, norm_ffn,
              ffn_w_up, ffn_conv_w, ffn_conv_b, ffn_w_down, norm_final):
    B, S, D = x.shape
    cos, sin = rope_tables(S)
    c_act = jax.nn.silu(c)
    i0 = 3 * ATT_WIDTH
    i1 = i0 + RWKV_COLS
    i2 = i1 + 2 * GMLP_WIDTH
    for l in range(DEPTH):
        mod = c_act @ w_ada[l] + b_ada[l]
        sh1, sc1, gt1, sh2, sc2, gt2 = jnp.split(mod, 6, axis=-1)

        h = modulate(rms_norm(x, norm_mix[l]), sh1, sc1)
        p = h @ w_in[l]
        qkv = p[..., :i0].reshape(B, S, 3, ATT_HEADS, HEAD_DIM)
        q = apply_rope(qkv[:, :, 0], cos, sin)
        k = apply_rope(qkv[:, :, 1], cos, sin)
        y_att = dilated_mixture_attention(q, k, qkv[:, :, 2]).reshape(B, S, ATT_WIDTH)
        y_rwkv = rwkv7_time_mix(p[..., i0:i1], rwkv_mu[l], rwkv_w0[l], rwkv_w_up[l], rwkv_a0[l],
                                rwkv_a_up[l], rwkv_g_up[l], rwkv_k_k[l], rwkv_k_a[l], rwkv_r_k[l],
                                rwkv_gn_w[l], rwkv_gn_b[l])
        y_gmlp = chunked_spatial_gating(p[..., i1:i2], gmlp_ln_g[l], gmlp_ln_b[l], gmlp_w_s[l], gmlp_b_s[l])
        ys = jnp.stack([y_att, y_rwkv, y_gmlp], axis=2).astype(x.dtype)
        gates = jax.nn.sigmoid(p[..., i2:].reshape(B, S, N_BRANCH, D))
        branch = jnp.einsum('bsnw,nwd->bsnd', ys, w_branch[l])
        merged = jnp.sum(gates * branch, axis=2)
        x = x + gt1[:, None, :] * (merged @ w_out[l])

        h = modulate(rms_norm(x, norm_ffn[l]), sh2, sc2)
        x = x + gt2[:, None, :] * conv_gated_ffn(h, ffn_w_up[l], ffn_conv_w[l], ffn_conv_b[l], ffn_w_down[l])
    return rms_norm(x, norm_final)
```

```cpp
#include <hip/hip_runtime.h>
#include <hip/hip_cooperative_groups.h>
#include <cstdio>
#include <cstdint>
namespace cg = cooperative_groups;

#define LAS __attribute__((address_space(3)))
#define DI __device__ __forceinline__
typedef unsigned short bf16_t;
typedef short bf16x8 __attribute__((ext_vector_type(8)));
typedef float f32x4 __attribute__((ext_vector_type(4)));
typedef float f32x16 __attribute__((ext_vector_type(16)));
typedef unsigned u32x4 __attribute__((ext_vector_type(4)));
typedef unsigned u32x2 __attribute__((ext_vector_type(2)));

constexpr int DM = 1024, SEQ = 4096, MTOK = 16384, INC = 7424, DFF = 2816, UPC = 5632, RAWC = 1792;
constexpr int LDS_BYTES = 147456;
constexpr size_t MiB = 1048576;
constexpr size_t WS_WIN = 0, WS_WBR = WS_WIN + (size_t)INC * 1024 * 2, WS_WOUT = WS_WBR + 3u * 1024 * 512 * 2, WS_WUP = WS_WOUT + 1024u * 1024 * 2,
                 WS_WDN = WS_WUP + (size_t)UPC * 1024 * 2, WS_LWU = WS_WDN + (size_t)DFF * 1024 * 2, WS_LAU = WS_LWU + 65536, WS_LGU = WS_LAU + 65536;
constexpr size_t WS_H = 37 * MiB;
constexpr size_t WS_SMALL = 69 * MiB, WS_MOD = WS_SMALL, WS_ROPEC = WS_MOD + 262144, WS_ROPES = WS_ROPEC + 524288, WS_BONUS = WS_ROPES + 524288, WS_LSE = WS_BONUS + 524288;
constexpr size_t WS_BAR = WS_LSE + 524288;
constexpr size_t DB = 72 * MiB;
constexpr size_t WS_RAW = DB, WS_RZ = DB + 56 * MiB, WS_KP = DB + 72 * MiB, WS_KKN = DB + 88 * MiB, WS_B = DB + 104 * MiB, WS_W = DB + 120 * MiB, WS_VZ = DB + 152 * MiB, WS_G = DB + 168 * MiB;
constexpr size_t WS_YRAW = DB, WS_YSR = DB + 32 * MiB;
constexpr size_t WS_Q = DB + 56 * MiB, WS_K = DB + 72 * MiB, WS_V = DB + 88 * MiB, WS_UV = DB + 104 * MiB;
constexpr size_t WS_YSA = DB + 152 * MiB, WS_YSG = DB + 168 * MiB;
constexpr size_t WS_GATE = DB, WS_M32 = DB + 48 * MiB, WS_MB = DB + 112 * MiB;
constexpr size_t WS_UP = DB;
static_assert(WS_LGU + 131072 <= WS_H, "weights region overflow");
static_assert(WS_BAR + 256 <= DB, "small region overflow");

struct Params {
    const float* in[29];
    float* out;
    unsigned char* ws;
};

typedef const __attribute__((address_space(4))) Params* KP;
DI KP okp() { unsigned long long k = (unsigned long long)__builtin_amdgcn_kernarg_segment_ptr(); asm volatile("" : "+s"(k)); return (KP)k; }
typedef float f32x2_t __attribute__((ext_vector_type(2)));
typedef __bf16 bf16x2_t __attribute__((ext_vector_type(2)));
DI unsigned cvt_pk_bf16(float lo, float hi) { const f32x2_t v = {lo, hi}; const bf16x2_t r = __builtin_convertvector(v, bf16x2_t); return __builtin_bit_cast(unsigned, r); }
DI float bf_lo(unsigned w) { return __uint_as_float(w << 16); }
DI float bf_hi(unsigned w) { return __uint_as_float(w & 0xffff0000u); }
DI int otid(int wv) { int ln; asm volatile("v_mbcnt_lo_u32_b32 %0, -1, 0\n\tv_mbcnt_hi_u32_b32 %0, -1, %0" : "=v"(ln)); return wv * 64 + ln; }
DI unsigned char* ows(unsigned char* w) { asm volatile("" : "+s"(w)); return w; }
DI float wave_sum(float v) {
#pragma unroll
    for (int o = 1; o < 64; o <<= 1) v += __shfl_xor(v, o);
    return v;
}
DI void gbar(unsigned* ctr, unsigned& epoch, unsigned nblocks, int wv) {
    asm volatile("s_waitcnt vmcnt(0) lgkmcnt(0)" ::: "memory");
    __syncthreads();
    epoch += nblocks;
    if (otid(wv) == 0) {
        __builtin_amdgcn_fence(__ATOMIC_RELEASE, "agent");
        asm volatile("s_waitcnt vmcnt(0)" ::: "memory");
        __hip_atomic_fetch_add(ctr, 1u, __ATOMIC_RELAXED, __HIP_MEMORY_SCOPE_AGENT);
        while (__hip_atomic_load(ctr, __ATOMIC_RELAXED, __HIP_MEMORY_SCOPE_AGENT) < epoch) __builtin_amdgcn_s_sleep(2);
        __builtin_amdgcn_fence(__ATOMIC_ACQUIRE, "agent");
        asm volatile("s_waitcnt vmcnt(0)" ::: "memory");
    }
    asm volatile("" ::: "memory");
    __syncthreads();
}
DI float sigmoidf_(float x) { return 1.0f / (1.0f + __expf(-x)); }
DI float gelu_tanh(float x) { const float u = 1.5957691216f * (x + 0.044715f * x * x * x); return x / (1.0f + __expf(-u)); }
#define LDS_WAIT() asm volatile("s_waitcnt lgkmcnt(0)" ::: "memory")
#define MFMA32(a, b, c) __builtin_amdgcn_mfma_f32_32x32x16_bf16((a), (b), (c), 0, 0, 0)
DI int crow(int reg, int h) { return (reg & 3) + 8 * (reg >> 2) + 4 * h; }
DI bf16x8 pack8(float a0, float a1, float a2, float a3, float a4, float a5, float a6, float a7) {
    u32x4 p; p.x = cvt_pk_bf16(a0, a1); p.y = cvt_pk_bf16(a2, a3); p.z = cvt_pk_bf16(a4, a5); p.w = cvt_pk_bf16(a6, a7);
    return __builtin_bit_cast(bf16x8, p);
}

namespace pg8 {
constexpr int BM = 256, BK = 64, HALF = 128, HTB = HALF * BK * 2, STAGE_BYTES = 8 * HTB, NXCD = 8, WGM = 8;
DI int lds_byte(int r, int c) { const int st = (r >> 4) * 2 + (c >> 5), rr = r & 15, cc = c & 31, ob = rr * 64 + cc * 2; return st * 1024 + (ob ^ (((ob >> 9) & 1) << 5)); }
DI void stage_rc(int b, int& R, int& C) { const int st = b / 1024, sb = b % 1024, swz = sb ^ (((sb >> 9) & 1) << 5); R = (st >> 1) * 16 + swz / 64; C = (st & 1) * 32 + (swz % 64) / 2; }
DI int perm32(int rho) { const int n = rho >> 4, i = rho & 15; return 8 * (i >> 2) + 4 * n + (i & 3); }
struct Unit { int pm, pn; };
struct Gemm { const bf16_t* A; const bf16_t* Bt; int lda, K; };
struct TileOrder {
    int nM, nN, nwg, G, c, split, off0, off1;
    DI void init(int nM_, int nN_, int G_, int c_, int split_, int off0_, int off1_) { nM = nM_; nN = nN_; nwg = nM * nN; G = G_; c = c_; split = split_; off0 = off0_; off1 = off1_; }
    DI bool next(int i, Unit& u) const {
        const long L = (long)i * G + c; if (L >= nwg) return false;
        int wgid = (int)L; { const int q = nwg / NXCD, r = nwg % NXCD, xcd = wgid % NXCD, off = wgid / NXCD; wgid = (xcd < r ? xcd * (q + 1) : r * (q + 1) + (xcd - r) * q) + off; }
        const int nig = WGM * nN, gid = wgid / nig, fm = gid * WGM, gsz = (nM - fm) < WGM ? (nM - fm) : WGM;
        u.pm = fm + ((wgid % nig) % gsz); const int pnv = (wgid % nig) / gsz; u.pn = pnv < split ? pnv + off0 : pnv - split + off1; return true;
    }
};

enum { EM_INPROJ = 0, EM_GATE = 1, EM_BR_FIRST = 2, EM_BR_MID = 3, EM_BR_LAST = 4, EM_RESID = 5, EM_UP = 6 };
struct Epi {
    int mode;
    bf16_t *o0, *o1, *o2, *o3, *o4;
    float* f0; const float* f1; const float* f2;
    const float *ropec, *ropes;
    DI void operator()(const f32x4 (&acc)[2][2][4][2], const Unit& u, int wr, int wc, int fr, int fq) const {
        const int row0 = u.pm * BM + wr * 64 + fr, colb = u.pn * BM + wc * 32 + 8 * fq;
#pragma unroll
        for (int ai = 0; ai < 2; ++ai)
#pragma unroll
            for (int m = 0; m < 4; ++m) {
                const int row = row0 + ai * HALF + m * 16;
#pragma unroll
                for (int bj = 0; bj < 2; ++bj) {
                    const int col0 = colb + bj * HALF;
                    f32x4 v0 = acc[ai][bj][m][0], v1 = acc[ai][bj][m][1];
                    if (mode == EM_INPROJ) {
                        bf16_t* dst;
                        if (u.pn < 4) {
                            const int pos = row & (SEQ - 1), e0 = (col0 & 63) >> 1;
                            const f32x4 cs = *(const f32x4*)(ropec + pos * 32 + e0), sn = *(const f32x4*)(ropes + pos * 32 + e0);
                            f32x4 a, b;
                            a[0] = v0[0] * cs[0] - v0[1] * sn[0]; a[1] = v0[1] * cs[0] + v0[0] * sn[0];
                            a[2] = v0[2] * cs[1] - v0[3] * sn[1]; a[3] = v0[3] * cs[1] + v0[2] * sn[1];
                            b[0] = v1[0] * cs[2] - v1[1] * sn[2]; b[1] = v1[1] * cs[2] + v1[0] * sn[2];
                            b[2] = v1[2] * cs[3] - v1[3] * sn[3]; b[3] = v1[3] * cs[3] + v1[2] * sn[3];
                            v0 = a; v1 = b;
                            dst = (u.pn < 2) ? o0 + (size_t)row * 512 + col0 : o1 + (size_t)row * 512 + (col0 - 512);
                        } else if (u.pn < 6) { dst = o2 + (size_t)row * 512 + (col0 - 1024); }
                        else if (u.pn < 13) { dst = o3 + (size_t)row * RAWC + (col0 - 1536); }
                        else {
#pragma unroll
                            for (int j = 0; j < 4; ++j) { v0[j] = gelu_tanh(v0[j]); v1[j] = gelu_tanh(v1[j]); }
                            dst = o4 + (size_t)row * 1024 + (col0 - 3328);
                        }
                        u32x4 w; w.x = cvt_pk_bf16(v0[0], v0[1]); w.y = cvt_pk_bf16(v0[2], v0[3]); w.z = cvt_pk_bf16(v1[0], v1[1]); w.w = cvt_pk_bf16(v1[2], v1[3]);
                        *(u32x4*)dst = w;
                    } else if (mode == EM_GATE) {
#pragma unroll
                        for (int j = 0; j < 4; ++j) { v0[j] = sigmoidf_(v0[j]); v1[j] = sigmoidf_(v1[j]); }
                        u32x4 w; w.x = cvt_pk_bf16(v0[0], v0[1]); w.y = cvt_pk_bf16(v0[2], v0[3]); w.z = cvt_pk_bf16(v1[0], v1[1]); w.w = cvt_pk_bf16(v1[2], v1[3]);
                        *(u32x4*)(o0 + (size_t)row * 1024 + col0) = w;
                    } else if (mode == EM_UP) {
                        u32x4 w; w.x = cvt_pk_bf16(v0[0], v0[1]); w.y = cvt_pk_bf16(v0[2], v0[3]); w.z = cvt_pk_bf16(v1[0], v1[1]); w.w = cvt_pk_bf16(v1[2], v1[3]);
                        *(u32x4*)(o0 + (size_t)row * UPC + col0) = w;
                    } else if (mode == EM_RESID) {
                        const size_t off = (size_t)row * 1024 + col0;
                        const float* gv = f2 + (size_t)(row >> 12) * 6144 + col0;
                        const f32x4 g0 = *(const f32x4*)gv, g1 = *(const f32x4*)(gv + 4);
                        const f32x4 b0 = *(const f32x4*)(f1 + off), b1 = *(const f32x4*)(f1 + off + 4);
                        *(f32x4*)(f0 + off) = b0 + g0 * v0; *(f32x4*)(f0 + off + 4) = b1 + g1 * v1;
                    } else {
                        const size_t off = (size_t)row * 1024 + col0;
                        const u32x4 gw = *(const u32x4*)(o0 + off);
                        f32x4 r0, r1;
                        r0[0] = bf_lo(gw.x) * v0[0]; r0[1] = bf_hi(gw.x) * v0[1]; r0[2] = bf_lo(gw.y) * v0[2]; r0[3] = bf_hi(gw.y) * v0[3];
                        r1[0] = bf_lo(gw.z) * v1[0]; r1[1] = bf_hi(gw.z) * v1[1]; r1[2] = bf_lo(gw.w) * v1[2]; r1[3] = bf_hi(gw.w) * v1[3];
                        if (mode != EM_BR_FIRST) { r0 += *(const f32x4*)(f0 + off); r1 += *(const f32x4*)(f0 + off + 4); }
                        if (mode == EM_BR_LAST) {
                            u32x4 w; w.x = cvt_pk_bf16(r0[0], r0[1]); w.y = cvt_pk_bf16(r0[2], r0[3]); w.z = cvt_pk_bf16(r1[0], r1[1]); w.w = cvt_pk_bf16(r1[2], r1[3]);
                            *(u32x4*)(o1 + off) = w;
                        } else { *(f32x4*)(f0 + off) = r0; *(f32x4*)(f0 + off + 4) = r1; }
                    }
                }
            }
    }
};

DI void gemm_phase(LAS unsigned char* lds, const Gemm g, const TileOrder S, const Epi E, int wv) {
    const int tid = otid(wv), wid = __builtin_amdgcn_readfirstlane(tid >> 6), lane = tid & 63, wr = wid >> 2, wc = wid & 3, fr = lane & 15, fq = lane >> 4;
    const int K = g.K, nt = K / BK, lda = g.lda;
    unsigned voffA[2], voffB[2];
#pragma unroll
    for (int i = 0; i < 2; ++i) { int R, C; stage_rc(tid * 16 + i * 8192, R, C); const int Rb = (R & ~31) + perm32(R & 31);
        voffA[i] = (unsigned)(R * lda + C) * 2u; voffB[i] = (unsigned)(Rb * K + C) * 2u; }
    const size_t kstep = (size_t)(BK * 2);
    const size_t hstepA = (size_t)HALF * lda * 2, hstepB = (size_t)HALF * K * 2;
    const size_t tstepA = 2 * hstepA, tstepB = 2 * hstepB;
    const unsigned ldsw = (unsigned)wid * 1024u;
    const int aoff = lds_byte(wr * 64 + fr, fq * 8), boff = lds_byte(wc * 32 + fr, fq * 8);
#define PG8_SA(b, h) (((b) * 2 + (h)) * HTB)
#define PG8_SB(b, h) ((4 + (b) * 2 + (h)) * HTB)
#define PG8_STAGE(bufoff, gbase, voff) do { _Pragma("unroll") for (int _i = 0; _i < 2; ++_i) \
        __builtin_amdgcn_global_load_lds((const unsigned*)((const char*)(gbase) + (voff)[_i]), (LAS unsigned*)(lds + (bufoff) + ldsw + _i * 8192), 16, 0, 0); } while (0)
#define PG8_LDA(dst, b, h) do { _Pragma("unroll") for (int m = 0; m < 4; ++m) _Pragma("unroll") for (int k = 0; k < 2; ++k) dst[m][k] = *(const LAS bf16x8*)(lds + PG8_SA(b, h) + aoff + m * 2048 + k * 1024); } while (0)
#define PG8_LDB(dst, b, h) do { _Pragma("unroll") for (int n = 0; n < 2; ++n) _Pragma("unroll") for (int k = 0; k < 2; ++k) dst[n][k] = *(const LAS bf16x8*)(lds + PG8_SB(b, h) + boff + n * 2048 + k * 1024); } while (0)
#define PG8_MMA(ai, bj, At, Bt) do { __builtin_amdgcn_s_setprio(1); _Pragma("unroll") for (int m = 0; m < 4; ++m) _Pragma("unroll") for (int n = 0; n < 2; ++n) _Pragma("unroll") for (int k = 0; k < 2; ++k) \
        acc[ai][bj][m][n] = __builtin_amdgcn_mfma_f32_16x16x32_bf16(Bt[n][k], At[m][k], acc[ai][bj][m][n], 0, 0, 0); __builtin_amdgcn_s_setprio(0); } while (0)
#define PG8_WAIT_V(n) asm volatile("s_waitcnt vmcnt(" #n ")" ::: "memory")
#define PG8_WAIT_L(n) asm volatile("s_waitcnt lgkmcnt(" #n ")" ::: "memory")
#define PG8_BAR __builtin_amdgcn_s_barrier()
#define PG8_SCHED __builtin_amdgcn_sched_barrier(0)
    Unit cur, nxt; int ui = 0;
    if (!S.next(0, cur)) return;
    f32x4 acc[2][2][4][2];
#pragma unroll
    for (int a = 0; a < 2; ++a)
#pragma unroll
        for (int b = 0; b < 2; ++b)
#pragma unroll
            for (int m = 0; m < 4; ++m)
#pragma unroll
                for (int n = 0; n < 2; ++n) acc[a][b][m][n] = (f32x4){0.f, 0.f, 0.f, 0.f};
    bf16x8 At[4][2], B0[2][2], B1[2][2];
    const char* cA = (const char*)g.A + (size_t)cur.pm * tstepA; const char* cB = (const char*)g.Bt + (size_t)cur.pn * tstepB;
    PG8_STAGE(PG8_SB(0, 0), cB, voffB); PG8_STAGE(PG8_SA(0, 0), cA, voffA); PG8_STAGE(PG8_SB(0, 1), cB + hstepB, voffB); PG8_STAGE(PG8_SA(0, 1), cA + hstepA, voffA);
    if (wr == 1) PG8_BAR;
    PG8_WAIT_V(4); PG8_BAR;
    PG8_STAGE(PG8_SB(1, 0), cB + kstep, voffB); PG8_STAGE(PG8_SA(1, 0), cA + kstep, voffA); PG8_STAGE(PG8_SB(1, 1), cB + hstepB + kstep, voffB);
    PG8_WAIT_V(6); PG8_BAR;
    for (;;) {
        const bool has_next = S.next(ui + 1, nxt);
        const char* nA = has_next ? (const char*)g.A + (size_t)nxt.pm * tstepA : cA; const char* nB = has_next ? (const char*)g.Bt + (size_t)nxt.pn * tstepB : cB;
        for (int t = 0; t < nt; t += 2) {
            const bool last = (t == nt - 2);
            const char* a1 = cA + (size_t)(t + 1) * kstep;
            const char* a2 = last ? nA : cA + (size_t)(t + 2) * kstep; const char* b2 = last ? nB : cB + (size_t)(t + 2) * kstep;
            const char* a3 = a2 + kstep; const char* b3 = b2 + kstep;
            PG8_LDB(B0, 0, 0); PG8_SCHED; PG8_LDA(At, 0, 0); PG8_STAGE(PG8_SA(1, 1), a1 + hstepA, voffA);
            PG8_WAIT_L(8); PG8_BAR; PG8_WAIT_L(0); PG8_MMA(0, 0, At, B0); PG8_BAR; PG8_SCHED;
            PG8_LDB(B1, 0, 1); PG8_STAGE(PG8_SB(0, 0), b2, voffB);
            PG8_BAR; PG8_WAIT_L(0); PG8_MMA(0, 1, At, B1); PG8_BAR;
            PG8_LDA(At, 0, 1); PG8_STAGE(PG8_SA(0, 0), a2, voffA);
            PG8_BAR; PG8_WAIT_L(0); PG8_MMA(1, 0, At, B0); PG8_BAR; PG8_SCHED;
            PG8_STAGE(PG8_SB(0, 1), b2 + hstepB, voffB);
            PG8_WAIT_V(6); PG8_BAR; PG8_MMA(1, 1, At, B1); PG8_BAR;
            PG8_LDB(B0, 1, 0); PG8_SCHED; PG8_LDA(At, 1, 0); PG8_STAGE(PG8_SA(0, 1), a2 + hstepA, voffA);
            PG8_WAIT_L(8); PG8_BAR; PG8_WAIT_L(0); PG8_MMA(0, 0, At, B0); PG8_BAR; PG8_SCHED;
            PG8_LDB(B1, 1, 1); PG8_STAGE(PG8_SB(1, 0), b3, voffB);
            PG8_BAR; PG8_WAIT_L(0); PG8_MMA(0, 1, At, B1); PG8_BAR;
            PG8_LDA(At, 1, 1); PG8_STAGE(PG8_SA(1, 0), a3, voffA);
            PG8_BAR; PG8_WAIT_L(0); PG8_MMA(1, 0, At, B0); PG8_BAR; PG8_SCHED;
            PG8_STAGE(PG8_SB(1, 1), b3 + hstepB, voffB);
            PG8_WAIT_V(6); PG8_BAR; PG8_MMA(1, 1, At, B1); PG8_BAR;
        }
        E(acc, cur, wr, wc, fr, fq);
        if (!has_next) break;
#pragma unroll
        for (int a = 0; a < 2; ++a)
#pragma unroll
            for (int b = 0; b < 2; ++b)
#pragma unroll
                for (int m = 0; m < 4; ++m)
#pragma unroll
                    for (int n = 0; n < 2; ++n) acc[a][b][m][n] = (f32x4){0.f, 0.f, 0.f, 0.f};
        cur = nxt; cA = nA; cB = nB; ++ui;
    }
    PG8_WAIT_V(0);
    if (wr == 0) PG8_BAR;
    PG8_BAR;
#undef PG8_SA
#undef PG8_SB
#undef PG8_STAGE
#undef PG8_LDA
#undef PG8_LDB
#undef PG8_MMA
#undef PG8_WAIT_V
#undef PG8_WAIT_L
#undef PG8_BAR
#undef PG8_SCHED
}
}

template <bool QKPERM>
DI void transpose_item(const float* W, int K, int N, bf16_t* WT, LAS float* scr, int item, int lane) {
    const int nblk = N / 32, kb = item / nblk, nb = item % nblk, k0 = 64 * kb, n0 = 32 * nb;
    int sc = n0 + (lane & 31);
    if (QKPERM && sc < 1024) { const int hd = sc >> 6, cp = sc & 63; sc = hd * 64 + 32 * (cp & 1) + (cp >> 1); }
#pragma unroll 8
    for (int i = 0; i < 32; ++i) { const int kk = 2 * i + (lane >> 5); scr[kk * 33 + (lane & 31)] = W[(size_t)(k0 + kk) * N + sc]; }
    LDS_WAIT();
    const int c = lane & 7;
#pragma unroll
    for (int j = 0; j < 4; ++j) { const int n = (lane >> 3) + 8 * j; const LAS float* s = scr + (8 * c) * 33 + n;
        u32x4 o; o.x = cvt_pk_bf16(s[0 * 33], s[1 * 33]); o.y = cvt_pk_bf16(s[2 * 33], s[3 * 33]); o.z = cvt_pk_bf16(s[4 * 33], s[5 * 33]); o.w = cvt_pk_bf16(s[6 * 33], s[7 * 33]);
        *(u32x4*)(WT + (size_t)(n0 + n) * K + k0 + 8 * c) = o; }
    LDS_WAIT();
}

DI void convert_weights(KP p, int l, LAS unsigned char* lds, int wv) {
    const int tid_ = otid(wv); const int wave = tid_ >> 6, lane = tid_ & 63;
    LAS float* scr = (LAS float*)(lds + wave * 8448);
    const int gw = blockIdx.x * 8 + wave, NGW = gridDim.x * 8;
    constexpr int I_IN = 16 * (INC / 32), I_BR = 8 * 32, I_OUT = 16 * 32, I_UP = 16 * (UPC / 32), I_DN = (DFF / 64) * 32, I_L64 = 16, I_L128 = 32;
    constexpr int NIT = I_IN + 3 * I_BR + I_OUT + I_UP + I_DN + 2 * I_L64 + I_L128;
    unsigned char* ws = ows(p->ws);
    for (int it = gw; it < NIT; it += NGW) {
        int r = it;
        if (r < I_IN) { transpose_item<true>(p->in[5] + (size_t)l * 1024 * INC, 1024, INC, (bf16_t*)(ws + WS_WIN), scr, r, lane); continue; } r -= I_IN;
        if (r < 3 * I_BR) { const int b = r / I_BR; transpose_item<false>(p->in[21] + ((size_t)l * 3 + b) * 512 * 1024, 512, 1024, (bf16_t*)(ws + WS_WBR) + (size_t)b * 1024 * 512, scr, r % I_BR, lane); continue; } r -= 3 * I_BR;
        if (r < I_OUT) { transpose_item<false>(p->in[22] + (size_t)l * 1024 * 1024, 1024, 1024, (bf16_t*)(ws + WS_WOUT), scr, r, lane); continue; } r -= I_OUT;
        if (r < I_UP) { transpose_item<false>(p->in[24] + (size_t)l * 1024 * UPC, 1024, UPC, (bf16_t*)(ws + WS_WUP), scr, r, lane); continue; } r -= I_UP;
        if (r < I_DN) { transpose_item<false>(p->in[27] + (size_t)l * DFF * 1024, DFF, 1024, (bf16_t*)(ws + WS_WDN), scr, r, lane); continue; } r -= I_DN;
        if (r < I_L64) { transpose_item<false>(p->in[8] + (size_t)l * 64 * 512, 64, 512, (bf16_t*)(ws + WS_LWU), scr, r, lane); continue; } r -= I_L64;
        if (r < I_L64) { transpose_item<false>(p->in[10] + (size_t)l * 64 * 512, 64, 512, (bf16_t*)(ws + WS_LAU), scr, r, lane); continue; } r -= I_L64;
        transpose_item<false>(p->in[11] + (size_t)l * 128 * 512, 128, 512, (bf16_t*)(ws + WS_LGU), scr, r, lane);
    }
}

DI void phase0(KP p, LAS unsigned char* lds, int wv) {
    const int tid = otid(wv);
    float* ropec = (float*)(p->ws + WS_ROPEC); float* ropes = (float*)(p->ws + WS_ROPES);
    for (int idx = blockIdx.x * 512 + tid; idx < SEQ * 32; idx += gridDim.x * 512) {
        const int pos = idx >> 5, e = idx & 31;
        const float inv = 1.0f / exp2f((float)e * (13.287712379549449f / 32.0f));
        const float ang = (float)pos * inv;
        double rev = (double)ang * 0.15915494309189535; rev -= rint(rev);
        const float rv = (float)rev;
        ropec[idx] = __builtin_amdgcn_cosf(rv); ropes[idx] = __builtin_amdgcn_sinf(rv);
    }
    {
        LAS float* ca = (LAS float*)lds;
        LAS float* red = (LAS float*)(lds + 16384);
        float* mod = (float*)(p->ws + WS_MOD);
        bool loaded = false;
        for (int item = blockIdx.x; item < 192; item += gridDim.x) {
            if (!loaded) { for (int i = tid; i < 4096; i += 512) { const float v = p->in[1][i]; ca[i] = v / (1.0f + __expf(-v)); } loaded = true; __syncthreads(); }
            const int l = item / 96, c0 = (item % 96) * 64, cc = tid & 63, kg = tid >> 6;
            const float* w = p->in[2] + (size_t)l * 1024 * 6144 + c0 + cc;
            float a0 = 0.f, a1 = 0.f, a2 = 0.f, a3 = 0.f;
#pragma unroll 8
            for (int k = kg * 128; k < kg * 128 + 128; ++k) { const float wv = w[(size_t)k * 6144]; a0 += ca[k] * wv; a1 += ca[1024 + k] * wv; a2 += ca[2048 + k] * wv; a3 += ca[3072 + k] * wv; }
            red[(kg * 4 + 0) * 64 + cc] = a0; red[(kg * 4 + 1) * 64 + cc] = a1; red[(kg * 4 + 2) * 64 + cc] = a2; red[(kg * 4 + 3) * 64 + cc] = a3;
            __syncthreads();
            if (tid < 256) { const int b = tid >> 6; float s = 0.f;
#pragma unroll
                for (int g = 0; g < 8; ++g) s += red[(g * 4 + b) * 64 + cc];
                mod[((size_t)l * 4 + b) * 6144 + c0 + cc] = s + p->in[3][(size_t)l * 6144 + c0 + cc]; }
            __syncthreads();
        }
        __syncthreads();
    }
    convert_weights(p, 0, lds, wv);
}

DI void norm_mod_phase(const float* x, const float* g, const float* sh, const float* sc, bf16_t* H, int wv) {
    const int tid_ = otid(wv); const int wave = tid_ >> 6, lane = tid_ & 63;
    for (int row = blockIdx.x * 8 + wave; row < MTOK; row += gridDim.x * 8) {
        const f32x4* xr = (const f32x4*)(x + (size_t)row * DM) + lane;
        f32x4 v[4]; float s = 0.f;
#pragma unroll
        for (int j = 0; j < 4; ++j) { v[j] = xr[64 * j]; s += (v[j][0] * v[j][0] + v[j][1] * v[j][1]) + (v[j][2] * v[j][2] + v[j][3] * v[j][3]); }
        const float rs = rsqrtf(wave_sum(s) * (1.0f / DM) + 1e-6f);
        const int b = row >> 12;
        u32x2* o8 = (u32x2*)(H + (size_t)row * DM) + lane;
#pragma unroll
        for (int j = 0; j < 4; ++j) {
            const int c = 4 * lane + 256 * j;
            const f32x4 gg = *(const f32x4*)(g + c), s1 = *(const f32x4*)(sc + (size_t)b * 6144 + c), s0 = *(const f32x4*)(sh + (size_t)b * 6144 + c);
            const f32x4 h = (v[j] * rs * gg) * (s1 + 1.0f) + s0;
            u32x2 w; w.x = cvt_pk_bf16(h[0], h[1]); w.y = cvt_pk_bf16(h[2], h[3]); o8[64 * j] = w;
        }
    }
}
DI void final_norm_phase(float* x, const float* g, int wv) {
    const int tid_ = otid(wv); const int wave = tid_ >> 6, lane = tid_ & 63;
    for (int row = blockIdx.x * 8 + wave; row < MTOK; row += gridDim.x * 8) {
        f32x4* xr = (f32x4*)(x + (size_t)row * DM) + lane;
        f32x4 v[4]; float s = 0.f;
#pragma unroll
        for (int j = 0; j < 4; ++j) { v[j] = xr[64 * j]; s += (v[j][0] * v[j][0] + v[j][1] * v[j][1]) + (v[j][2] * v[j][2] + v[j][3] * v[j][3]); }
        const float rs = rsqrtf(wave_sum(s) * (1.0f / DM) + 1e-6f);
#pragma unroll
        for (int j = 0; j < 4; ++j) { const f32x4 gg = *(const f32x4*)(g + 4 * lane + 256 * j); xr[64 * j] = v[j] * rs * gg; }
    }
}

DI bf16x8 lerp_frag(const bf16_t* cur, const bf16_t* prv, bool hasprev, const float* mu, int act) {
    const u32x4 c = *(const u32x4*)cur; u32x4 q = {0u, 0u, 0u, 0u}; if (hasprev) q = *(const u32x4*)prv;
    const f32x4 m0 = *(const f32x4*)mu, m1 = *(const f32x4*)(mu + 4);
    float z[8];
    const unsigned cw[4] = {c.x, c.y, c.z, c.w}, qw[4] = {q.x, q.y, q.z, q.w};
#pragma unroll
    for (int j = 0; j < 4; ++j) {
        const float c0 = bf_lo(cw[j]), c1 = bf_hi(cw[j]), p0 = bf_lo(qw[j]), p1 = bf_hi(qw[j]);
        const float mA = (j < 2) ? m0[2 * j] : m1[2 * j - 4], mB = (j < 2) ? m0[2 * j + 1] : m1[2 * j - 3];
        z[2 * j] = c0 + (p0 - c0) * mA; z[2 * j + 1] = c1 + (p1 - c1) * mB;
    }
#pragma unroll
    for (int j = 0; j < 8; ++j) {
        if (act == 1) { const float e = __expf(2.0f * z[j]); z[j] = 1.0f - 2.0f / (1.0f + e); }
        else if (act == 2) z[j] = sigmoidf_(z[j]);
    }
    return pack8(z[0], z[1], z[2], z[3], z[4], z[5], z[6], z[7]);
}

DI void rwkv_derived_phase(KP p, int l, int wv) {
    unsigned char* ws = ows(p->ws);
    const bf16_t* RAW = (const bf16_t*)(ws + WS_RAW);
    bf16_t *RZ = (bf16_t*)(ws + WS_RZ), *KP = (bf16_t*)(ws + WS_KP), *VZ = (bf16_t*)(ws + WS_VZ), *KKN = (bf16_t*)(ws + WS_KKN), *Bv = (bf16_t*)(ws + WS_B), *G = (bf16_t*)(ws + WS_G);
    float* W = (float*)(ws + WS_W); float* BONUS = (float*)(ws + WS_BONUS);
    const bf16_t *LWU = (const bf16_t*)(ws + WS_LWU), *LAU = (const bf16_t*)(ws + WS_LAU), *LGU = (const bf16_t*)(ws + WS_LGU);
    const float* mu = p->in[6] + (size_t)l * RAWC; const float* w0 = p->in[7] + l * 512; const float* a0 = p->in[9] + l * 512;
    const float* k_k = p->in[12] + l * 512; const float* k_a = p->in[13] + l * 512; const float* r_k = p->in[14] + l * 512;
    const int tid_ = otid(wv); const int wave = tid_ >> 6, lane = tid_ & 63, r = lane & 31, hh = lane >> 5;
    for (int job = blockIdx.x * 8 + wave; job < 512 * 8; job += gridDim.x * 8) {
        const int hd = job & 7, tg = job >> 3, t = tg * 32 + r;
        const bool hp = (t & (SEQ - 1)) != 0;
        const bf16_t* cur = RAW + (size_t)t * RAWC; const bf16_t* prv = cur - RAWC;
        float ss = 0.f;
#pragma unroll
        for (int q = 0; q < 8; ++q) {
            const int c = hd * 64 + 8 * q + 4 * hh;
            const u32x2 kc = *(const u32x2*)(cur + 512 + c); u32x2 kq = {0u, 0u}; if (hp) kq = *(const u32x2*)(prv + 512 + c);
            const f32x4 mk = *(const f32x4*)(mu + 512 + c), kkw = *(const f32x4*)(k_k + c);
            const float kcur[4] = {bf_lo(kc.x), bf_hi(kc.x), bf_lo(kc.y), bf_hi(kc.y)}, kprv[4] = {bf_lo(kq.x), bf_hi(kq.x), bf_lo(kq.y), bf_hi(kq.y)};
#pragma unroll
            for (int j = 0; j < 4; ++j) { const float kk = (kcur[j] + (kprv[j] - kcur[j]) * mk[j]) * kkw[j]; ss += kk * kk; }
        }
        ss += __shfl_xor(ss, 32);
        const float inv = 1.0f / fmaxf(sqrtf(ss), 1e-12f);
        float bonus = 0.f;
        {
            bf16x8 bw[4], ba[4];
#pragma unroll
            for (int s = 0; s < 4; ++s) { const int o = 16 * s + 8 * hh; bw[s] = lerp_frag(cur + 1536 + o, prv + 1536 + o, hp, mu + 1536 + o, 1); ba[s] = lerp_frag(cur + 1600 + o, prv + 1600 + o, hp, mu + 1600 + o, 0); }
#pragma unroll 1
            for (int mt = 0; mt < 2; ++mt) {
                const int chr = hd * 64 + 32 * mt + r;
                f32x16 aw, aa;
#pragma unroll
                for (int i = 0; i < 16; ++i) { aw[i] = 0.f; aa[i] = 0.f; }
#pragma unroll
                for (int s = 0; s < 4; ++s) {
                    const bf16x8 fw = *(const bf16x8*)(LWU + (size_t)chr * 64 + 16 * s + 8 * hh), fa = *(const bf16x8*)(LAU + (size_t)chr * 64 + 16 * s + 8 * hh);
                    aw = MFMA32(fw, bw[s], aw); aa = MFMA32(fa, ba[s], aa);
                }
#pragma unroll
                for (int i4 = 0; i4 < 4; ++i4) {
                    const int c = hd * 64 + 32 * mt + 8 * i4 + 4 * hh;
                    const u32x2 rc = *(const u32x2*)(cur + c), kc = *(const u32x2*)(cur + 512 + c), vc = *(const u32x2*)(cur + 1024 + c);
                    u32x2 rp = {0u, 0u}, kq = {0u, 0u}, vp = {0u, 0u};
                    if (hp) { rp = *(const u32x2*)(prv + c); kq = *(const u32x2*)(prv + 512 + c); vp = *(const u32x2*)(prv + 1024 + c); }
                    const f32x4 mr = *(const f32x4*)(mu + c), mk = *(const f32x4*)(mu + 512 + c), mv = *(const f32x4*)(mu + 1024 + c);
                    const f32x4 w0v = *(const f32x4*)(w0 + c), a0v = *(const f32x4*)(a0 + c), kkw = *(const f32x4*)(k_k + c), kaw = *(const f32x4*)(k_a + c), rkw = *(const f32x4*)(r_k + c);
                    const float rcur[4] = {bf_lo(rc.x), bf_hi(rc.x), bf_lo(rc.y), bf_hi(rc.y)}, rprv[4] = {bf_lo(rp.x), bf_hi(rp.x), bf_lo(rp.y), bf_hi(rp.y)};
                    const float kcur[4] = {bf_lo(kc.x), bf_hi(kc.x), bf_lo(kc.y), bf_hi(kc.y)}, kprv[4] = {bf_lo(kq.x), bf_hi(kq.x), bf_lo(kq.y), bf_hi(kq.y)};
                    const float vcur[4] = {bf_lo(vc.x), bf_hi(vc.x), bf_lo(vc.y), bf_hi(vc.y)}, vprv[4] = {bf_lo(vp.x), bf_hi(vp.x), bf_lo(vp.y), bf_hi(vp.y)};
                    f32x4 dec; float rz[4], kp[4], vz[4], kn[4], bb[4];
#pragma unroll
                    for (int j = 0; j < 4; ++j) {
                        const int i = 4 * i4 + j;
                        const float zz = -(w0v[j] + aw[i]);
                        const float sp = (zz > 20.f) ? zz : __logf(1.0f + __expf(zz));
                        const float wv = -sp - 0.5f;
                        dec[j] = __expf(-__expf(wv));
                        const float av = sigmoidf_(a0v[j] + aa[i]);
                        rz[j] = rcur[j] + (rprv[j] - rcur[j]) * mr[j];
                        const float kz = kcur[j] + (kprv[j] - kcur[j]) * mk[j];
                        vz[j] = vcur[j] + (vprv[j] - vcur[j]) * mv[j];
                        kn[j] = kz * kkw[j] * inv; bb[j] = kn[j] * av;
                        kp[j] = kz * (1.0f + (av - 1.0f) * kaw[j]);
                        bonus += rz[j] * kp[j] * rkw[j];
                    }
                    const size_t o = (size_t)t * 512 + c;
                    *(f32x4*)(W + o) = dec;
                    u32x2 w2; w2.x = cvt_pk_bf16(rz[0], rz[1]); w2.y = cvt_pk_bf16(rz[2], rz[3]); *(u32x2*)(RZ + o) = w2;
                    w2.x = cvt_pk_bf16(kp[0], kp[1]); w2.y = cvt_pk_bf16(kp[2], kp[3]); *(u32x2*)(KP + o) = w2;
                    w2.x = cvt_pk_bf16(vz[0], vz[1]); w2.y = cvt_pk_bf16(vz[2], vz[3]); *(u32x2*)(VZ + o) = w2;
                    w2.x = cvt_pk_bf16(kn[0], kn[1]); w2.y = cvt_pk_bf16(kn[2], kn[3]); *(u32x2*)(KKN + o) = w2;
                    w2.x = cvt_pk_bf16(bb[0], bb[1]); w2.y = cvt_pk_bf16(bb[2], bb[3]); *(u32x2*)(Bv + o) = w2;
                }
            }
        }
        bonus += __shfl_xor(bonus, 32);
        if (hh == 0) BONUS[(size_t)t * 8 + hd] = bonus;
        {
            bf16x8 bg[8];
#pragma unroll
            for (int s = 0; s < 8; ++s) { const int o = 16 * s + 8 * hh; bg[s] = lerp_frag(cur + 1664 + o, prv + 1664 + o, hp, mu + 1664 + o, 2); }
#pragma unroll 1
            for (int mt = 0; mt < 2; ++mt) {
                const int chr = hd * 64 + 32 * mt + r;
                f32x16 ag;
#pragma unroll
                for (int i = 0; i < 16; ++i) ag[i] = 0.f;
#pragma unroll
                for (int s = 0; s < 8; ++s) { const bf16x8 fg = *(const bf16x8*)(LGU + (size_t)chr * 128 + 16 * s + 8 * hh); ag = MFMA32(fg, bg[s], ag); }
#pragma unroll
                for (int i4 = 0; i4 < 4; ++i4) {
                    const size_t o = (size_t)t * 512 + hd * 64 + 32 * mt + 8 * i4 + 4 * hh;
                    u32x2 w2; w2.x = cvt_pk_bf16(ag[4 * i4], ag[4 * i4 + 1]); w2.y = cvt_pk_bf16(ag[4 * i4 + 2], ag[4 * i4 + 3]); *(u32x2*)(G + o) = w2;
                }
            }
        }
    }
}

constexpr int SC_T = 32, SC_STEP = 1344, SC_BUF = SC_T * SC_STEP;
DI float row16_sum(float v) {
    v += __builtin_bit_cast(float, __builtin_amdgcn_update_dpp(0, __builtin_bit_cast(int, v), 0xB1, 0xF, 0xF, false));
    v += __builtin_bit_cast(float, __builtin_amdgcn_update_dpp(0, __builtin_bit_cast(int, v), 0x4E, 0xF, 0xF, false));
    v += __builtin_bit_cast(float, __builtin_amdgcn_update_dpp(0, __builtin_bit_cast(int, v), 0x141, 0xF, 0xF, false));
    v += __builtin_bit_cast(float, __builtin_amdgcn_update_dpp(0, __builtin_bit_cast(int, v), 0x140, 0xF, 0xF, false));
    return v;
}
DI void scan_stage(KP p, LAS unsigned char* buf, int b, int h, int rg, int ck, int pt) {
    const unsigned char* ws = ows(p->ws);
    const size_t tok0 = (size_t)b * SEQ + (size_t)ck * SC_T;
    {
#pragma unroll
        for (int q = 0; q < 2; ++q) { const int pp = pt + 256 * q, st = pp >> 4, sub = pp & 15;
            const f32x4 v = *(const f32x4*)((const float*)(ws + WS_W) + (tok0 + st) * 512 + h * 64 + 4 * sub);
            *(LAS f32x4*)(buf + st * SC_STEP + sub * 16) = v; }
    }
    const int st = pt >> 3, sub = pt & 7; const size_t go = (tok0 + st) * 512 + h * 64 + 8 * sub;
    const u32x4 kn = *(const u32x4*)((const bf16_t*)(ws + WS_KKN) + go), bb = *(const u32x4*)((const bf16_t*)(ws + WS_B) + go),
                kp = *(const u32x4*)((const bf16_t*)(ws + WS_KP) + go), rz = *(const u32x4*)((const bf16_t*)(ws + WS_RZ) + go);
    LAS unsigned char* d = buf + st * SC_STEP + sub * 32;
    *(LAS f32x4*)(d + 256) = (f32x4){-bf_lo(kn.x), -bf_hi(kn.x), -bf_lo(kn.y), -bf_hi(kn.y)}; *(LAS f32x4*)(d + 256 + 16) = (f32x4){-bf_lo(kn.z), -bf_hi(kn.z), -bf_lo(kn.w), -bf_hi(kn.w)};
    *(LAS f32x4*)(d + 512) = (f32x4){bf_lo(bb.x), bf_hi(bb.x), bf_lo(bb.y), bf_hi(bb.y)}; *(LAS f32x4*)(d + 512 + 16) = (f32x4){bf_lo(bb.z), bf_hi(bb.z), bf_lo(bb.w), bf_hi(bb.w)};
    *(LAS f32x4*)(d + 768) = (f32x4){bf_lo(kp.x), bf_hi(kp.x), bf_lo(kp.y), bf_hi(kp.y)}; *(LAS f32x4*)(d + 768 + 16) = (f32x4){bf_lo(kp.z), bf_hi(kp.z), bf_lo(kp.w), bf_hi(kp.w)};
    *(LAS f32x4*)(d + 1024) = (f32x4){bf_lo(rz.x), bf_hi(rz.x), bf_lo(rz.y), bf_hi(rz.y)}; *(LAS f32x4*)(d + 1024 + 16) = (f32x4){bf_lo(rz.z), bf_hi(rz.z), bf_lo(rz.w), bf_hi(rz.w)};
    if (pt < 64) { const int s2 = pt >> 1, hf = pt & 1;
        const u32x4 vv = *(const u32x4*)((const bf16_t*)(ws + WS_VZ) + (tok0 + s2) * 512 + h * 64 + rg * 16 + 8 * hf);
        LAS unsigned char* dv = buf + s2 * SC_STEP + 1280 + hf * 32;
        *(LAS f32x4*)dv = (f32x4){bf_lo(vv.x), bf_hi(vv.x), bf_lo(vv.y), bf_hi(vv.y)}; *(LAS f32x4*)(dv + 16) = (f32x4){bf_lo(vv.z), bf_hi(vv.z), bf_lo(vv.w), bf_hi(vv.w)}; }
}
DI void rwkv_scan_phase(KP p, LAS unsigned char* lds, int wv) {
    const int tid = otid(wv), wave = tid >> 6, lane = tid & 63;
    float* YRAW = (float*)(p->ws + WS_YRAW);
    for (int job = blockIdx.x; job < 128; job += gridDim.x) {
        const int chain = job >> 2, rg = job & 3, b = chain >> 3, h = chain & 7;
        __syncthreads();
        if (wave >= 4) scan_stage(p, lds, b, h, rg, 0, tid - 256);
        __syncthreads();
        f32x4 S = {0.f, 0.f, 0.f, 0.f};
        const int jl = lane & 15, rl = 4 * (wave & 3) + (lane >> 4);
        for (int ck = 0; ck < SEQ / SC_T; ++ck) {
            LAS unsigned char* cb = lds + (ck & 1) * SC_BUF;
            if (wave >= 4) { if (ck + 1 < SEQ / SC_T) scan_stage(p, lds + ((ck + 1) & 1) * SC_BUF, b, h, rg, ck + 1, tid - 256); }
            else {
                float* yo = YRAW + ((size_t)b * SEQ + (size_t)ck * SC_T) * 512 + h * 64 + rg * 16 + rl;
#pragma unroll 4
                for (int s = 0; s < SC_T; ++s) {
                    const LAS unsigned char* sb = cb + s * SC_STEP + jl * 16;
                    const f32x4 w4 = *(const LAS f32x4*)sb, an = *(const LAS f32x4*)(sb + 256), b4 = *(const LAS f32x4*)(sb + 512), k4 = *(const LAS f32x4*)(sb + 768), r4 = *(const LAS f32x4*)(sb + 1024);
                    const float vi = *(const LAS float*)(cb + s * SC_STEP + 1280 + rl * 4);
                    float sa = (S[0] * an[0] + S[1] * an[1]) + (S[2] * an[2] + S[3] * an[3]);
                    sa = row16_sum(sa);
                    S = S * w4 + (b4 * sa + k4 * vi);
                    float y = (S[0] * r4[0] + S[1] * r4[1]) + (S[2] * r4[2] + S[3] * r4[3]);
                    y = row16_sum(y);
                    if (jl == 0) yo[(size_t)s * 512] = y;
                }
            }
            __syncthreads();
        }
    }
}

DI void rwkv_post_phase(KP p, int l, int wv) {
    const unsigned char* ws = ows(p->ws);
    const float* YRAW = (const float*)(ws + WS_YRAW); const bf16_t* VZ = (const bf16_t*)(ws + WS_VZ); const bf16_t* G = (const bf16_t*)(ws + WS_G);
    const float* BONUS = (const float*)(ws + WS_BONUS); bf16_t* YS = (bf16_t*)(p->ws + WS_YSR);
    const float* gnw = p->in[15] + l * 512; const float* gnb = p->in[16] + l * 512;
    const int tid_ = otid(wv); const int wave = tid_ >> 6, lane = tid_ & 63, c = 8 * lane;
    const f32x4 gw0 = *(const f32x4*)(gnw + c), gw1 = *(const f32x4*)(gnw + c + 4), gb0 = *(const f32x4*)(gnb + c), gb1 = *(const f32x4*)(gnb + c + 4);
    for (int t = blockIdx.x * 8 + wave; t < MTOK; t += gridDim.x * 8) {
        const size_t o = (size_t)t * 512 + c;
        const f32x4 y0 = *(const f32x4*)(YRAW + o), y1 = *(const f32x4*)(YRAW + o + 4);
        float s = (y0[0] + y0[1]) + (y0[2] + y0[3]) + (y1[0] + y1[1]) + (y1[2] + y1[3]);
        s += __shfl_xor(s, 1); s += __shfl_xor(s, 2); s += __shfl_xor(s, 4);
        const float mean = s * (1.0f / 64.0f);
        const f32x4 d0 = y0 - mean, d1 = y1 - mean;
        float q = (d0[0] * d0[0] + d0[1] * d0[1]) + (d0[2] * d0[2] + d0[3] * d0[3]) + (d1[0] * d1[0] + d1[1] * d1[1]) + (d1[2] * d1[2] + d1[3] * d1[3]);
        q += __shfl_xor(q, 1); q += __shfl_xor(q, 2); q += __shfl_xor(q, 4);
        const float rstd = rsqrtf(q * (1.0f / 64.0f) + 64e-5f);
        const float bon = BONUS[(size_t)t * 8 + (lane >> 3)];
        const u32x4 vv = *(const u32x4*)(VZ + o), gg = *(const u32x4*)(G + o);
        const f32x4 v0 = {bf_lo(vv.x), bf_hi(vv.x), bf_lo(vv.y), bf_hi(vv.y)}, v1 = {bf_lo(vv.z), bf_hi(vv.z), bf_lo(vv.w), bf_hi(vv.w)};
        const f32x4 g0 = {bf_lo(gg.x), bf_hi(gg.x), bf_lo(gg.y), bf_hi(gg.y)}, g1 = {bf_lo(gg.z), bf_hi(gg.z), bf_lo(gg.w), bf_hi(gg.w)};
        const f32x4 r0 = (d0 * rstd * gw0 + gb0 + v0 * bon) * g0, r1 = (d1 * rstd * gw1 + gb1 + v1 * bon) * g1;
        u32x4 w; w.x = cvt_pk_bf16(r0[0], r0[1]); w.y = cvt_pk_bf16(r0[2], r0[3]); w.z = cvt_pk_bf16(r1[0], r1[1]); w.w = cvt_pk_bf16(r1[2], r1[3]);
        *(u32x4*)(YS + o) = w;
    }
}

DI void attn_job(const bf16_t* Q, const bf16_t* K, const bf16_t* V, bf16_t* YS, float* LSE, LAS unsigned char* vl, int b, int h, int d, int rho, int J0, bool first, int lane) {
    asm volatile("" : "+v"(lane));
    const int r = lane & 31, hh = lane >> 5;
    const size_t tokq = (size_t)b * SEQ + (size_t)(J0 + r) * d + rho;
    bf16x8 bq[4];
#pragma unroll
    for (int s = 0; s < 4; ++s) bq[s] = *(const bf16x8*)(Q + tokq * 512 + h * 64 + 16 * s + 8 * hh);
    f32x16 sc[5];
#pragma unroll
    for (int kt = 0; kt < 5; ++kt) {
        const int Jk = J0 - 128 + 32 * kt + r; const bool valid = Jk >= 0;
        const size_t tokk = (size_t)b * SEQ + (size_t)(valid ? Jk : 0) * d + rho;
        f32x16 a;
#pragma unroll
        for (int i = 0; i < 16; ++i) a[i] = 0.f;
#pragma unroll
        for (int s = 0; s < 4; ++s) {
            bf16x8 ak = *(const bf16x8*)(K + tokk * 512 + h * 64 + 16 * s + 8 * hh);
            if (!valid) ak = (bf16x8){0, 0, 0, 0, 0, 0, 0, 0};
            a = MFMA32(ak, bq[s], a);
        }
        sc[kt] = a;
    }
    float m = -1e30f;
#pragma unroll
    for (int kt = 0; kt < 5; ++kt)
#pragma unroll
        for (int i = 0; i < 16; ++i) {
            const int kidx = 32 * kt + crow(i, hh); const int dist = 128 + r - kidx;
            const bool ok = (dist >= 0) && (dist <= 128) && (J0 - 128 + kidx >= 0);
            const float v = ok ? sc[kt][i] * 0.125f : -1e30f;
            sc[kt][i] = v; m = fmaxf(m, v);
        }
    m = fmaxf(m, __shfl_xor(m, 32));
    float lsum = 0.f;
#pragma unroll
    for (int kt = 0; kt < 5; ++kt)
#pragma unroll
        for (int i = 0; i < 16; ++i) { const float pv = __expf(sc[kt][i] - m); sc[kt][i] = pv; lsum += pv; }
    lsum += __shfl_xor(lsum, 32);
    const float lse = m + __logf(lsum);
    f32x16 o[2];
#pragma unroll
    for (int i = 0; i < 16; ++i) { o[0][i] = 0.f; o[1][i] = 0.f; }
#pragma unroll
    for (int kt = 0; kt < 5; ++kt) {
        {
            const int key = lane >> 1, hf = lane & 1; const int Jk = J0 - 128 + 32 * kt + key;
            const size_t tokv = (size_t)b * SEQ + (size_t)(Jk >= 0 ? Jk : 0) * d + rho;
            const u32x4* src = (const u32x4*)(V + tokv * 512 + h * 64 + 32 * hf);
            LAS u32x4* dst = (LAS u32x4*)(vl + key * 128 + hf * 64);
            const u32x4 x0 = src[0], x1 = src[1], x2 = src[2], x3 = src[3];
            dst[0] = x0; dst[1] = x1; dst[2] = x2; dst[3] = x3;
        }
        LDS_WAIT();
#pragma unroll
        for (int s = 0; s < 2; ++s) {
            const bf16x8 xs = pack8(sc[kt][8 * s], sc[kt][8 * s + 1], sc[kt][8 * s + 2], sc[kt][8 * s + 3], sc[kt][8 * s + 4], sc[kt][8 * s + 5], sc[kt][8 * s + 6], sc[kt][8 * s + 7]);
#pragma unroll
            for (int mt = 0; mt < 2; ++mt) {
                bf16x8 pa;
#pragma unroll
                for (int j = 0; j < 8; ++j) { const int key = 16 * s + 8 * (j >> 2) + 4 * hh + (j & 3); pa[j] = (short)*(const LAS bf16_t*)(vl + key * 128 + (r + 32 * mt) * 2); }
                o[mt] = MFMA32(pa, xs, o[mt]);
            }
        }
        LDS_WAIT();
    }
    const float il = 1.0f / lsum;
    float wp = 0.f, wc = 1.0f, nl = lse;
    if (!first) { const float lp = LSE[tokq * 8 + h]; const float mx = fmaxf(lp, lse); const float ep = __expf(lp - mx), ec = __expf(lse - mx); nl = mx + __logf(ep + ec); wp = ep / (ep + ec); wc = ec / (ep + ec); }
#pragma unroll
    for (int mt = 0; mt < 2; ++mt)
#pragma unroll
        for (int g4 = 0; g4 < 4; ++g4) {
            bf16_t* dst = YS + tokq * 512 + h * 64 + 32 * mt + 8 * g4 + 4 * hh;
            float v[4];
#pragma unroll
            for (int j = 0; j < 4; ++j) v[j] = o[mt][4 * g4 + j] * il * wc;
            if (!first) { const u32x2 pw = *(const u32x2*)dst; v[0] += bf_lo(pw.x) * wp; v[1] += bf_hi(pw.x) * wp; v[2] += bf_lo(pw.y) * wp; v[3] += bf_hi(pw.y) * wp; }
            u32x2 w2; w2.x = cvt_pk_bf16(v[0], v[1]); w2.y = cvt_pk_bf16(v[2], v[3]); *(u32x2*)dst = w2;
        }
    if (hh == 0) LSE[tokq * 8 + h] = nl;
}

DI void attention_phase(KP p, LAS unsigned char* lds, int wv) {
    unsigned char* ws = ows(p->ws);
    const bf16_t *Q = (const bf16_t*)(ws + WS_Q), *K = (const bf16_t*)(ws + WS_K), *V = (const bf16_t*)(ws + WS_V);
    bf16_t* YS = (bf16_t*)(ws + WS_YSA); float* LSE = (float*)(ws + WS_LSE);
    const int tid_ = otid(wv); const int wave = tid_ >> 6, lane = tid_ & 63;
    LAS unsigned char* vl = lds + wave * 4096;
    for (int item = blockIdx.x; item < 256; item += gridDim.x) {
        const int b = item >> 6, h = (item >> 3) & 7, qb = item & 7, P0 = qb * 512;
#pragma unroll 1
        for (int cfg = 0; cfg < 3; ++cfg) {
#pragma unroll 1
            for (int jj = wave; jj < 16; jj += 8) {
                int d, rho, J0;
                if (cfg == 0) { d = 1; rho = 0; J0 = P0 + 32 * jj; }
                else if (cfg == 1) { d = 4; rho = jj & 3; J0 = (P0 >> 2) + 32 * (jj >> 2); }
                else { d = 16; rho = jj; J0 = P0 >> 4; }
                attn_job(Q, K, V, YS, LSE, vl, b, h, d, rho, J0, cfg == 0, lane);
            }
            asm volatile("s_waitcnt vmcnt(0)" ::: "memory");
            __syncthreads();
        }
    }
}

DI void gmlp_phase(KP p, int l, LAS unsigned char* lds, int wv) {
    unsigned char* ws = ows(p->ws);
    const bf16_t* UV = (const bf16_t*)(ws + WS_UV); bf16_t* YS = (bf16_t*)(ws + WS_YSG);
    const float* lng = p->in[17] + l * 512; const float* lnb = p->in[18] + l * 512;
    const float* wsp = p->in[19] + (size_t)l * 8 * 128 * 128; const float* bsp = p->in[20] + (size_t)l * 8 * 128;
    const int tid_ = otid(wv); const int wave = tid_ >> 6, lane = tid_ & 63, r = lane & 31, hh = lane >> 5;
    LAS float* stats = (LAS float*)(lds + 8 * 17408);
    LAS bf16_t* VT = (LAS bf16_t*)(lds + wave * 17408);
    for (int item = blockIdx.x; item < 128; item += gridDim.x) {
        const size_t tok0 = (size_t)item * 128;
        __syncthreads();
        for (int tt = 0; tt < 16; ++tt) {
            const int tl = wave * 16 + tt;
            const u32x4 x = *(const u32x4*)(UV + (tok0 + tl) * 1024 + 512 + 8 * lane);
            const float f[8] = {bf_lo(x.x), bf_hi(x.x), bf_lo(x.y), bf_hi(x.y), bf_lo(x.z), bf_hi(x.z), bf_lo(x.w), bf_hi(x.w)};
            float s = 0.f;
#pragma unroll
            for (int j = 0; j < 8; ++j) s += f[j];
            const float mean = wave_sum(s) * (1.0f / 512.0f); float q = 0.f;
#pragma unroll
            for (int j = 0; j < 8; ++j) { const float dd = f[j] - mean; q += dd * dd; }
            const float rstd = rsqrtf(wave_sum(q) * (1.0f / 512.0f) + 1e-5f);
            if (lane == 0) { stats[2 * tl] = mean; stats[2 * tl + 1] = rstd; }
        }
        __syncthreads();
        const int g = wave;
        {
            const int d0 = 8 * (lane & 7);
            const f32x4 lg0 = *(const f32x4*)(lng + g * 64 + d0), lg1 = *(const f32x4*)(lng + g * 64 + d0 + 4), lb0 = *(const f32x4*)(lnb + g * 64 + d0), lb1 = *(const f32x4*)(lnb + g * 64 + d0 + 4);
            for (int it = 0; it < 16; ++it) {
                const int tl = it * 8 + (lane >> 3);
                const u32x4 x = *(const u32x4*)(UV + (tok0 + tl) * 1024 + 512 + g * 64 + d0);
                const float mean = stats[2 * tl], rstd = stats[2 * tl + 1];
                const float f[8] = {bf_lo(x.x), bf_hi(x.x), bf_lo(x.y), bf_hi(x.y), bf_lo(x.z), bf_hi(x.z), bf_lo(x.w), bf_hi(x.w)};
#pragma unroll
                for (int e = 0; e < 8; ++e) {
                    const float gg = e < 4 ? lg0[e & 3] : lg1[e & 3], bb = e < 4 ? lb0[e & 3] : lb1[e & 3];
                    const float y = (f[e] - mean) * rstd * gg + bb;
                    VT[(d0 + e) * 136 + tl] = (bf16_t)(cvt_pk_bf16(y, 0.f) & 0xffffu);
                }
            }
        }
        LDS_WAIT();
#pragma unroll 1
        for (int nt = 0; nt < 4; ++nt) {
            f32x16 acc[2];
#pragma unroll
            for (int i = 0; i < 16; ++i) { acc[0][i] = 0.f; acc[1][i] = 0.f; }
            const int irow = 32 * nt + r;
            for (int s = 0; s < 2 * (nt + 1); ++s) {
                const int j0 = 16 * s + 8 * hh;
                const float* wr_ = wsp + ((size_t)g * 128 + irow) * 128 + j0;
                const f32x4 wa = *(const f32x4*)wr_, wb = *(const f32x4*)(wr_ + 4);
                float wv[8] = {wa[0], wa[1], wa[2], wa[3], wb[0], wb[1], wb[2], wb[3]};
#pragma unroll
                for (int j = 0; j < 8; ++j) if (j0 + j > irow) wv[j] = 0.f;
                const bf16x8 bfr = pack8(wv[0], wv[1], wv[2], wv[3], wv[4], wv[5], wv[6], wv[7]);
#pragma unroll
                for (int mt = 0; mt < 2; ++mt) {
                    const bf16x8 afr = *(const LAS bf16x8*)(VT + (32 * mt + r) * 136 + j0);
                    acc[mt] = MFMA32(afr, bfr, acc[mt]);
                }
            }
            const size_t tok = tok0 + irow; const float bs = bsp[g * 128 + irow];
#pragma unroll
            for (int mt = 0; mt < 2; ++mt)
#pragma unroll
                for (int g4 = 0; g4 < 4; ++g4) {
                    const int c = g * 64 + 32 * mt + 8 * g4 + 4 * hh;
                    const u32x2 uu = *(const u32x2*)(UV + tok * 1024 + c);
                    const float o0 = bf_lo(uu.x) * (acc[mt][4 * g4] + bs), o1 = bf_hi(uu.x) * (acc[mt][4 * g4 + 1] + bs), o2 = bf_lo(uu.y) * (acc[mt][4 * g4 + 2] + bs), o3 = bf_hi(uu.y) * (acc[mt][4 * g4 + 3] + bs);
                    u32x2 w2; w2.x = cvt_pk_bf16(o0, o1); w2.y = cvt_pk_bf16(o2, o3); *(u32x2*)(YS + tok * 512 + c) = w2;
                }
        }
    }
}

DI void ffn_conv_phase(KP p, int l, int wv) {
    bf16_t* UP = (bf16_t*)(ows(p->ws) + WS_UP);
    const float* cw = p->in[25] + (size_t)l * 3 * DFF; const float* cb = p->in[26] + (size_t)l * DFF;
    constexpr int NCG = DFF / 8, RUN = 32, NRUN = MTOK / RUN;
    const int tid_ = otid(wv);
    for (int item = blockIdx.x * 512 + tid_; item < NCG * NRUN; item += gridDim.x * 512) {
        const int cgi = item % NCG, run = item / NCG, f0 = 8 * cgi, t0 = run * RUN;
        float w0[8], w1[8], w2[8], bb[8];
#pragma unroll
        for (int q = 0; q < 2; ++q) { const f32x4 a = *(const f32x4*)(cw + f0 + 4 * q), b = *(const f32x4*)(cw + DFF + f0 + 4 * q), c = *(const f32x4*)(cw + 2 * DFF + f0 + 4 * q), d = *(const f32x4*)(cb + f0 + 4 * q);
#pragma unroll
            for (int j = 0; j < 4; ++j) { w0[4 * q + j] = a[j]; w1[4 * q + j] = b[j]; w2[4 * q + j] = c[j]; bb[4 * q + j] = d[j]; } }
        u32x4 am2 = {0u, 0u, 0u, 0u}, am1 = {0u, 0u, 0u, 0u};
        if ((t0 & (SEQ - 1)) != 0) { am2 = *(const u32x4*)(UP + (size_t)(t0 - 2) * UPC + f0); am1 = *(const u32x4*)(UP + (size_t)(t0 - 1) * UPC + f0); }
        for (int t = t0; t < t0 + RUN; ++t) {
            const u32x4 a0 = *(const u32x4*)(UP + (size_t)t * UPC + f0); const u32x4 gg = *(const u32x4*)(UP + (size_t)t * UPC + DFF + f0);
            const unsigned x2[4] = {am2.x, am2.y, am2.z, am2.w}, x1[4] = {am1.x, am1.y, am1.z, am1.w}, x0[4] = {a0.x, a0.y, a0.z, a0.w}, xg[4] = {gg.x, gg.y, gg.z, gg.w};
            unsigned ow[4];
#pragma unroll
            for (int j = 0; j < 4; ++j) {
                const float c0 = bb[2 * j] + w0[2 * j] * bf_lo(x2[j]) + w1[2 * j] * bf_lo(x1[j]) + w2[2 * j] * bf_lo(x0[j]);
                const float c1 = bb[2 * j + 1] + w0[2 * j + 1] * bf_hi(x2[j]) + w1[2 * j + 1] * bf_hi(x1[j]) + w2[2 * j + 1] * bf_hi(x0[j]);
                ow[j] = cvt_pk_bf16(gelu_tanh(c0) * bf_lo(xg[j]), gelu_tanh(c1) * bf_hi(xg[j]));
            }
            *(u32x4*)(UP + (size_t)t * UPC + DFF + f0) = (u32x4){ow[0], ow[1], ow[2], ow[3]};
            am2 = am1; am1 = a0;
        }
    }
}

__global__ void __launch_bounds__(512) fwd_megakernel(Params p_unused) {
    extern __shared__ __attribute__((aligned(16))) unsigned char lds_raw[];
    LAS unsigned char* lds = (LAS unsigned char*)lds_raw;
    cg::grid_group grid = cg::this_grid();
    KP p = okp();
    unsigned char* ws = p->ws;
    const int G = gridDim.x, c = blockIdx.x;
    const int wv = __builtin_amdgcn_readfirstlane((int)(threadIdx.x >> 6));
    pg8::Epi E; pg8::TileOrder S; pg8::Gemm g;

    grid.sync();
    unsigned epoch = 0; unsigned* bar = (unsigned*)(ws + WS_BAR);
    phase0(p, lds, wv);
    gbar(bar, epoch, (unsigned)G, wv);
#pragma unroll 1
    for (int st = 0; st < 2 * 17; ++st) {
        const int l = st / 17, step = st % 17;
        p = okp(); ws = ows(p->ws);
        const float* mod = (const float*)(ws + WS_MOD); const bf16_t* H = (const bf16_t*)(ws + WS_H);
        const float* ml = mod + (size_t)l * 4 * 6144;
        const float* xin = (l == 0) ? p->in[0] : p->out;
        bool do_gemm = false, do_sync = true;
        E = pg8::Epi{};
        if (step == 0) {
            if (l > 0) convert_weights(p, l, lds, wv);
            norm_mod_phase(xin, p->in[4] + l * DM, ml + 0, ml + 1024, (bf16_t*)(ws + WS_H), wv);
        } else if (step == 1 || step == 4) {
            if (step == 4) rwkv_post_phase(p, l, wv);
            E.mode = pg8::EM_INPROJ; E.o0 = (bf16_t*)(ws + WS_Q); E.o1 = (bf16_t*)(ws + WS_K); E.o2 = (bf16_t*)(ws + WS_V); E.o3 = (bf16_t*)(ws + WS_RAW); E.o4 = (bf16_t*)(ws + WS_UV);
            E.ropec = (const float*)(ws + WS_ROPEC); E.ropes = (const float*)(ws + WS_ROPES);
            g.A = H; g.Bt = (const bf16_t*)(ws + WS_WIN); g.lda = 1024; g.K = 1024;
            if (step == 1) S.init(64, 7, G, c, 7, 6, 0); else S.init(64, 10, G, c, 6, 0, 13);
            do_gemm = true;
        } else if (step == 2) { rwkv_derived_phase(p, l, wv); }
        else if (step == 3) { rwkv_scan_phase(p, lds, wv); }
        else if (step == 5) { attention_phase(p, lds, wv); gmlp_phase(p, l, lds, wv); }
        else if (step >= 6 && step <= 11) {
            const int br = (step - 6) >> 1;
            if (((step - 6) & 1) == 0) {
                E.mode = pg8::EM_GATE; E.o0 = (bf16_t*)(ws + WS_GATE);
                g.A = H; g.Bt = (const bf16_t*)(ws + WS_WIN) + (size_t)(4352 + 1024 * br) * 1024; g.lda = 1024; g.K = 1024;
            } else {
                E.mode = (br == 0) ? pg8::EM_BR_FIRST : (br == 1 ? pg8::EM_BR_MID : pg8::EM_BR_LAST); E.o0 = (bf16_t*)(ws + WS_GATE); E.o1 = (bf16_t*)(ws + WS_MB); E.f0 = (float*)(ws + WS_M32);
                g.A = (const bf16_t*)(ws + (br == 0 ? WS_YSA : (br == 1 ? WS_YSR : WS_YSG))); g.Bt = (const bf16_t*)(ws + WS_WBR) + (size_t)br * 1024 * 512; g.lda = 512; g.K = 512;
            }
            S.init(64, 4, G, c, 4, 0, 0);
            do_gemm = true; do_sync = (step == 11);
        } else if (step == 12) {
            E.mode = pg8::EM_RESID; E.f0 = p->out; E.f1 = xin; E.f2 = ml + 2048;
            g.A = (const bf16_t*)(ws + WS_MB); g.Bt = (const bf16_t*)(ws + WS_WOUT); g.lda = 1024; g.K = 1024;
            S.init(64, 4, G, c, 4, 0, 0); do_gemm = true;
        } else if (step == 13) { norm_mod_phase(p->out, p->in[23] + l * DM, ml + 3072, ml + 4096, (bf16_t*)(ws + WS_H), wv); }
        else if (step == 14) {
            E.mode = pg8::EM_UP; E.o0 = (bf16_t*)(ws + WS_UP);
            g.A = H; g.Bt = (const bf16_t*)(ws + WS_WUP); g.lda = 1024; g.K = 1024;
            S.init(64, 22, G, c, 22, 0, 0); do_gemm = true;
        } else if (step == 15) { ffn_conv_phase(p, l, wv); }
        else {
            E.mode = pg8::EM_RESID; E.f0 = p->out; E.f1 = p->out; E.f2 = ml + 5120;
            g.A = (const bf16_t*)(ws + WS_UP) + DFF; g.Bt = (const bf16_t*)(ws + WS_WDN); g.lda = UPC; g.K = DFF;
            S.init(64, 4, G, c, 4, 0, 0); do_gemm = true;
        }
        if (do_gemm) pg8::gemm_phase(lds, g, S, E, wv);
        if (do_sync) gbar((unsigned*)(ws + WS_BAR), epoch, (unsigned)G, wv);
#ifdef DBG_ST
        if (st == DBG_ST) {
            gbar((unsigned*)(ws + WS_BAR), epoch, (unsigned)G, wv);
#if DBG_KIND == 1
            { const bf16_t* sb = (const bf16_t*)(ws + DBG_BUF); for (size_t i = (size_t)blockIdx.x * 512 + otid(wv); i < (size_t)MTOK * DM; i += (size_t)gridDim.x * 512) p->out[i] = __uint_as_float(((unsigned)sb[i]) << 16); }
#elif DBG_KIND == 3
            { const bf16_t* sb = (const bf16_t*)(ws + DBG_BUF); for (size_t i = (size_t)blockIdx.x * 512 + otid(wv); i < (size_t)MTOK * DM; i += (size_t)gridDim.x * 512) p->out[i] = __uint_as_float(((unsigned)sb[i % DBG_N]) << 16); }
#elif DBG_KIND == 2
            { const float* sb = (const float*)(ws + DBG_BUF); for (size_t i = (size_t)blockIdx.x * 512 + otid(wv); i < (size_t)MTOK * DM; i += (size_t)gridDim.x * 512) p->out[i] = sb[i % DBG_N]; }
#endif
            return;
        }
#endif
    }
    p = okp();
    final_norm_phase(p->out, p->in[28], wv);
}

extern "C" void kernel_launch(void* const* d_in, const int* in_sizes, int n_in, void* d_out, int out_size, void* d_ws, size_t ws_size, hipStream_t stream) {
    static int grid_blocks = 0;
    if (grid_blocks == 0) {
        int dev = 0, cus = 0, per_cu = 0;
        hipGetDevice(&dev);
        hipDeviceGetAttribute(&cus, hipDeviceAttributeMultiprocessorCount, dev);
        if (hipFuncSetAttribute((const void*)fwd_megakernel, hipFuncAttributeMaxDynamicSharedMemorySize, LDS_BYTES) != hipSuccess) { fprintf(stderr, "hipFuncSetAttribute failed\n"); }
        hipOccupancyMaxActiveBlocksPerMultiprocessor(&per_cu, (const void*)fwd_megakernel, 512, LDS_BYTES);
        if (per_cu < 1) { fprintf(stderr, "occupancy query returned %d\n", per_cu); per_cu = 1; }
        if (per_cu > 1) per_cu = 1;
        grid_blocks = cus * per_cu;
        (void)hipGetLastError();
    }
    if (n_in != 29 || ws_size < 256 * MiB) { fprintf(stderr, "unexpected inputs/workspace\n"); return; }
    (void)hipMemsetAsync((unsigned char*)d_ws + WS_BAR, 0, 256, stream);
    Params p{};
    for (int i = 0; i < 29; ++i) p.in[i] = (const float*)d_in[i];
    p.out = (float*)d_out; p.ws = (unsigned char*)d_ws;
    void* args[] = {&p};
    hipError_t e = hipLaunchCooperativeKernel((const void*)fwd_megakernel, dim3(grid_blocks), dim3(512), args, LDS_BYTES, stream);
    if (e != hipSuccess) fprintf(stderr, "cooperative launch failed: %s (grid %d)\n", hipGetErrorString(e), grid_blocks);
}
```

```cpp
#include <hip/hip_runtime.h>
#include <hip/hip_cooperative_groups.h>
#include <cstdio>
#include <cstdint>
namespace cg = cooperative_groups;

#define LAS __attribute__((address_space(3)))
#define DI __device__ __forceinline__
typedef unsigned short bf16_t;
typedef short bf16x8 __attribute__((ext_vector_type(8)));
typedef float f32x4 __attribute__((ext_vector_type(4)));
typedef float f32x16 __attribute__((ext_vector_type(16)));
typedef unsigned u32x4 __attribute__((ext_vector_type(4)));
typedef unsigned u32x2 __attribute__((ext_vector_type(2)));

constexpr int DM = 1024, SEQ = 4096, MTOK = 16384, INC = 7424, DFF = 2816, UPC = 5632, RAWC = 1792;
constexpr int LDS_BYTES = 147456;
constexpr size_t MiB = 1048576;
constexpr size_t WS_WIN = 0, WS_WBR = WS_WIN + (size_t)INC * 1024 * 2, WS_WOUT = WS_WBR + 3u * 1024 * 512 * 2, WS_WUP = WS_WOUT + 1024u * 1024 * 2,
                 WS_WDN = WS_WUP + (size_t)UPC * 1024 * 2, WS_LWU = WS_WDN + (size_t)DFF * 1024 * 2, WS_LAU = WS_LWU + 65536, WS_LGU = WS_LAU + 65536;
constexpr size_t WS_H = 37 * MiB;
constexpr size_t WS_SMALL = 69 * MiB, WS_MOD = WS_SMALL, WS_ROPEC = WS_MOD + 262144, WS_ROPES = WS_ROPEC + 524288, WS_BONUS = WS_ROPES + 524288, WS_LSE = WS_BONUS + 524288;
constexpr size_t WS_BAR = WS_LSE + 524288;
constexpr size_t DB = 72 * MiB;
constexpr size_t WS_RAW = DB, WS_RZ = DB + 56 * MiB, WS_KP = DB + 72 * MiB, WS_KKN = DB + 88 * MiB, WS_B = DB + 104 * MiB, WS_W = DB + 120 * MiB, WS_VZ = DB + 152 * MiB, WS_G = DB + 168 * MiB;
constexpr size_t WS_YRAW = DB, WS_YSR = DB + 32 * MiB;
constexpr size_t WS_Q = DB + 56 * MiB, WS_K = DB + 72 * MiB, WS_V = DB + 88 * MiB, WS_UV = DB + 104 * MiB;
constexpr size_t WS_YSA = DB + 152 * MiB, WS_YSG = DB + 168 * MiB;
constexpr size_t WS_GATE = DB, WS_M32 = DB + 48 * MiB, WS_MB = DB + 112 * MiB;
constexpr size_t WS_UP = DB;
static_assert(WS_LGU + 131072 <= WS_H, "weights region overflow");
static_assert(WS_BAR + 256 <= DB, "small region overflow");

struct Params {
    const float* in[29];
    float* out;
    unsigned char* ws;
};

typedef const __attribute__((address_space(4))) Params* KP;
DI KP okp() { unsigned long long k = (unsigned long long)__builtin_amdgcn_kernarg_segment_ptr(); asm volatile("" : "+s"(k)); return (KP)k; }
typedef float f32x2_t __attribute__((ext_vector_type(2)));
typedef __bf16 bf16x2_t __attribute__((ext_vector_type(2)));
DI unsigned cvt_pk_bf16(float lo, float hi) { const f32x2_t v = {lo, hi}; const bf16x2_t r = __builtin_convertvector(v, bf16x2_t); return __builtin_bit_cast(unsigned, r); }
DI float bf_lo(unsigned w) { return __uint_as_float(w << 16); }
DI float bf_hi(unsigned w) { return __uint_as_float(w & 0xffff0000u); }
DI int otid(int wv) { int ln; asm volatile("v_mbcnt_lo_u32_b32 %0, -1, 0\n\tv_mbcnt_hi_u32_b32 %0, -1, %0" : "=v"(ln)); return wv * 64 + ln; }
DI unsigned char* ows(unsigned char* w) { asm volatile("" : "+s"(w)); return w; }
DI float row16_sum(float v) {
    v += __builtin_bit_cast(float, __builtin_amdgcn_update_dpp(0, __builtin_bit_cast(int, v), 0xB1, 0xF, 0xF, false));
    v += __builtin_bit_cast(float, __builtin_amdgcn_update_dpp(0, __builtin_bit_cast(int, v), 0x4E, 0xF, 0xF, false));
    v += __builtin_bit_cast(float, __builtin_amdgcn_update_dpp(0, __builtin_bit_cast(int, v), 0x141, 0xF, 0xF, false));
    v += __builtin_bit_cast(float, __builtin_amdgcn_update_dpp(0, __builtin_bit_cast(int, v), 0x140, 0xF, 0xF, false));
    return v;
}
DI float wave_sum(float v) { v = row16_sum(v); v += __shfl_xor(v, 16); v += __shfl_xor(v, 32); return v; }
DI void gbar(unsigned* ctr, unsigned& epoch, unsigned nblocks, int wv) {
    asm volatile("s_waitcnt vmcnt(0) lgkmcnt(0)" ::: "memory");
    __syncthreads();
    epoch += nblocks;
    if (otid(wv) == 0) {
        __builtin_amdgcn_fence(__ATOMIC_RELEASE, "agent");
        asm volatile("s_waitcnt vmcnt(0)" ::: "memory");
        __hip_atomic_fetch_add(ctr, 1u, __ATOMIC_RELAXED, __HIP_MEMORY_SCOPE_AGENT);
        while (__hip_atomic_load(ctr, __ATOMIC_RELAXED, __HIP_MEMORY_SCOPE_AGENT) < epoch) __builtin_amdgcn_s_sleep(2);
        __builtin_amdgcn_fence(__ATOMIC_ACQUIRE, "agent");
        asm volatile("s_waitcnt vmcnt(0)" ::: "memory");
    }
    asm volatile("" ::: "memory");
    __syncthreads();
}
DI float sigmoidf_(float x) { return 1.0f / (1.0f + __expf(-x)); }
DI float gelu_tanh(float x) { const float u = 1.5957691216f * (x + 0.044715f * x * x * x); return x / (1.0f + __expf(-u)); }
#define LDS_WAIT() asm volatile("s_waitcnt lgkmcnt(0)" ::: "memory")
#define MFMA32(a, b, c) __builtin_amdgcn_mfma_f32_32x32x16_bf16((a), (b), (c), 0, 0, 0)
DI int crow(int reg, int h) { return (reg & 3) + 8 * (reg >> 2) + 4 * h; }
DI bf16x8 pack8(float a0, float a1, float a2, float a3, float a4, float a5, float a6, float a7) {
    u32x4 p; p.x = cvt_pk_bf16(a0, a1); p.y = cvt_pk_bf16(a2, a3); p.z = cvt_pk_bf16(a4, a5); p.w = cvt_pk_bf16(a6, a7);
    return __builtin_bit_cast(bf16x8, p);
}

namespace pg8 {
constexpr int BM = 256, BK = 64, HALF = 128, HTB = HALF * BK * 2, STAGE_BYTES = 8 * HTB, NXCD = 8, WGM = 8;
DI int lds_byte(int r, int c) { const int st = (r >> 4) * 2 + (c >> 5), rr = r & 15, cc = c & 31, ob = rr * 64 + cc * 2; return st * 1024 + (ob ^ (((ob >> 9) & 1) << 5)); }
DI void stage_rc(int b, int& R, int& C) { const int st = b / 1024, sb = b % 1024, swz = sb ^ (((sb >> 9) & 1) << 5); R = (st >> 1) * 16 + swz / 64; C = (st & 1) * 32 + (swz % 64) / 2; }
DI int perm32(int rho) { const int n = rho >> 4, i = rho & 15; return 8 * (i >> 2) + 4 * n + (i & 3); }
struct Unit { int pm, pn; };
struct Gemm { const bf16_t* A; const bf16_t* Bt; int lda, K; };
struct TileOrder {
    int nM, nN, nwg, G, c, split, off0, off1;
    DI void init(int nM_, int nN_, int G_, int c_, int split_, int off0_, int off1_) { nM = nM_; nN = nN_; nwg = nM * nN; G = G_; c = c_; split = split_; off0 = off0_; off1 = off1_; }
    DI bool next(int i, Unit& u) const {
        const long L = (long)i * G + c; if (L >= nwg) return false;
        int wgid = (int)L; { const int q = nwg / NXCD, r = nwg % NXCD, xcd = wgid % NXCD, off = wgid / NXCD; wgid = (xcd < r ? xcd * (q + 1) : r * (q + 1) + (xcd - r) * q) + off; }
        const int nig = WGM * nN, gid = wgid / nig, fm = gid * WGM, gsz = (nM - fm) < WGM ? (nM - fm) : WGM;
        u.pm = fm + ((wgid % nig) % gsz); const int pnv = (wgid % nig) / gsz; u.pn = pnv < split ? pnv + off0 : pnv - split + off1; return true;
    }
};

enum { EM_INPROJ = 0, EM_GATE = 1, EM_BR_FIRST = 2, EM_BR_MID = 3, EM_BR_LAST = 4, EM_RESID = 5, EM_UP = 6 };
struct Epi {
    int mode;
    bf16_t *o0, *o1, *o2, *o3, *o4;
    float* f0; const float* f1; const float* f2;
    const float *ropec, *ropes;
    DI void operator()(const f32x4 (&acc)[2][2][4][2], const Unit& u, int wr, int wc, int fr, int fq) const {
        const int row0 = u.pm * BM + wr * 64 + fr, colb = u.pn * BM + wc * 32 + 8 * fq;
#pragma unroll
        for (int ai = 0; ai < 2; ++ai)
#pragma unroll
            for (int m = 0; m < 4; ++m) {
                const int row = row0 + ai * HALF + m * 16;
#pragma unroll
                for (int bj = 0; bj < 2; ++bj) {
                    const int col0 = colb + bj * HALF;
                    f32x4 v0 = acc[ai][bj][m][0], v1 = acc[ai][bj][m][1];
                    if (mode == EM_INPROJ) {
                        bf16_t* dst;
                        if (u.pn < 4) {
                            const int pos = row & (SEQ - 1), e0 = (col0 & 63) >> 1;
                            const f32x4 cs = *(const f32x4*)(ropec + pos * 32 + e0), sn = *(const f32x4*)(ropes + pos * 32 + e0);
                            f32x4 a, b;
                            a[0] = v0[0] * cs[0] - v0[1] * sn[0]; a[1] = v0[1] * cs[0] + v0[0] * sn[0];
                            a[2] = v0[2] * cs[1] - v0[3] * sn[1]; a[3] = v0[3] * cs[1] + v0[2] * sn[1];
                            b[0] = v1[0] * cs[2] - v1[1] * sn[2]; b[1] = v1[1] * cs[2] + v1[0] * sn[2];
                            b[2] = v1[2] * cs[3] - v1[3] * sn[3]; b[3] = v1[3] * cs[3] + v1[2] * sn[3];
                            v0 = a; v1 = b;
                            dst = (u.pn < 2) ? o0 + (size_t)row * 512 + col0 : o1 + (size_t)row * 512 + (col0 - 512);
                        } else if (u.pn < 6) { dst = o2 + (size_t)row * 512 + (col0 - 1024); }
                        else if (u.pn < 13) { dst = o3 + (size_t)row * RAWC + (col0 - 1536); }
                        else {
#pragma unroll
                            for (int j = 0; j < 4; ++j) { v0[j] = gelu_tanh(v0[j]); v1[j] = gelu_tanh(v1[j]); }
                            dst = o4 + (size_t)row * 1024 + (col0 - 3328);
                        }
                        u32x4 w; w.x = cvt_pk_bf16(v0[0], v0[1]); w.y = cvt_pk_bf16(v0[2], v0[3]); w.z = cvt_pk_bf16(v1[0], v1[1]); w.w = cvt_pk_bf16(v1[2], v1[3]);
                        *(u32x4*)dst = w;
                    } else if (mode == EM_GATE) {
#pragma unroll
                        for (int j = 0; j < 4; ++j) { v0[j] = sigmoidf_(v0[j]); v1[j] = sigmoidf_(v1[j]); }
                        u32x4 w; w.x = cvt_pk_bf16(v0[0], v0[1]); w.y = cvt_pk_bf16(v0[2], v0[3]); w.z = cvt_pk_bf16(v1[0], v1[1]); w.w = cvt_pk_bf16(v1[2], v1[3]);
                        *(u32x4*)(o0 + (size_t)row * 1024 + col0) = w;
                    } else if (mode == EM_UP) {
                        u32x4 w; w.x = cvt_pk_bf16(v0[0], v0[1]); w.y = cvt_pk_bf16(v0[2], v0[3]); w.z = cvt_pk_bf16(v1[0], v1[1]); w.w = cvt_pk_bf16(v1[2], v1[3]);
                        *(u32x4*)(o0 + (size_t)row * UPC + col0) = w;
                    } else if (mode == EM_RESID) {
                        const size_t off = (size_t)row * 1024 + col0;
                        const float* gv = f2 + (size_t)(row >> 12) * 6144 + col0;
                        const f32x4 g0 = *(const f32x4*)gv, g1 = *(const f32x4*)(gv + 4);
                        const f32x4 b0 = *(const f32x4*)(f1 + off), b1 = *(const f32x4*)(f1 + off + 4);
                        *(f32x4*)(f0 + off) = b0 + g0 * v0; *(f32x4*)(f0 + off + 4) = b1 + g1 * v1;
                    } else {
                        const size_t off = (size_t)row * 1024 + col0;
                        const u32x4 gw = *(const u32x4*)(o0 + off);
                        f32x4 r0, r1;
                        r0[0] = bf_lo(gw.x) * v0[0]; r0[1] = bf_hi(gw.x) * v0[1]; r0[2] = bf_lo(gw.y) * v0[2]; r0[3] = bf_hi(gw.y) * v0[3];
                        r1[0] = bf_lo(gw.z) * v1[0]; r1[1] = bf_hi(gw.z) * v1[1]; r1[2] = bf_lo(gw.w) * v1[2]; r1[3] = bf_hi(gw.w) * v1[3];
                        if (mode != EM_BR_FIRST) { r0 += *(const f32x4*)(f0 + off); r1 += *(const f32x4*)(f0 + off + 4); }
                        if (mode == EM_BR_LAST) {
                            u32x4 w; w.x = cvt_pk_bf16(r0[0], r0[1]); w.y = cvt_pk_bf16(r0[2], r0[3]); w.z = cvt_pk_bf16(r1[0], r1[1]); w.w = cvt_pk_bf16(r1[2], r1[3]);
                            *(u32x4*)(o1 + off) = w;
                        } else { *(f32x4*)(f0 + off) = r0; *(f32x4*)(f0 + off + 4) = r1; }
                    }
                }
            }
    }
};

DI void gemm_phase(LAS unsigned char* lds, const Gemm g, const TileOrder S, const Epi E, int wv) {
    const int tid = otid(wv), wid = __builtin_amdgcn_readfirstlane(tid >> 6), lane = tid & 63, wr = wid >> 2, wc = wid & 3, fr = lane & 15, fq = lane >> 4;
    const int K = g.K, nt = K / BK, lda = g.lda;
    unsigned voffA[2], voffB[2];
#pragma unroll
    for (int i = 0; i < 2; ++i) { int R, C; stage_rc(tid * 16 + i * 8192, R, C); const int Rb = (R & ~31) + perm32(R & 31);
        voffA[i] = (unsigned)(R * lda + C) * 2u; voffB[i] = (unsigned)(Rb * K + C) * 2u; }
    const size_t kstep = (size_t)(BK * 2);
    const size_t hstepA = (size_t)HALF * lda * 2, hstepB = (size_t)HALF * K * 2;
    const size_t tstepA = 2 * hstepA, tstepB = 2 * hstepB;
    const unsigned ldsw = (unsigned)wid * 1024u;
    const int aoff = lds_byte(wr * 64 + fr, fq * 8), boff = lds_byte(wc * 32 + fr, fq * 8);
#define PG8_SA(b, h) (((b) * 2 + (h)) * HTB)
#define PG8_SB(b, h) ((4 + (b) * 2 + (h)) * HTB)
#define PG8_STAGE(bufoff, gbase, voff) do { _Pragma("unroll") for (int _i = 0; _i < 2; ++_i) \
        __builtin_amdgcn_global_load_lds((const unsigned*)((const char*)(gbase) + (voff)[_i]), (LAS unsigned*)(lds + (bufoff) + ldsw + _i * 8192), 16, 0, 0); } while (0)
#define PG8_LDA(dst, b, h) do { _Pragma("unroll") for (int m = 0; m < 4; ++m) _Pragma("unroll") for (int k = 0; k < 2; ++k) dst[m][k] = *(const LAS bf16x8*)(lds + PG8_SA(b, h) + aoff + m * 2048 + k * 1024); } while (0)
#define PG8_LDB(dst, b, h) do { _Pragma("unroll") for (int n = 0; n < 2; ++n) _Pragma("unroll") for (int k = 0; k < 2; ++k) dst[n][k] = *(const LAS bf16x8*)(lds + PG8_SB(b, h) + boff + n * 2048 + k * 1024); } while (0)
#define PG8_MMA(ai, bj, At, Bt) do { __builtin_amdgcn_s_setprio(1); _Pragma("unroll") for (int m = 0; m < 4; ++m) _Pragma("unroll") for (int n = 0; n < 2; ++n) _Pragma("unroll") for (int k = 0; k < 2; ++k) \
        acc[ai][bj][m][n] = __builtin_amdgcn_mfma_f32_16x16x32_bf16(Bt[n][k], At[m][k], acc[ai][bj][m][n], 0, 0, 0); __builtin_amdgcn_s_setprio(0); } while (0)
#define PG8_WAIT_V(n) asm volatile("s_waitcnt vmcnt(" #n ")" ::: "memory")
#define PG8_WAIT_L(n) asm volatile("s_waitcnt lgkmcnt(" #n ")" ::: "memory")
#define PG8_BAR __builtin_amdgcn_s_barrier()
#define PG8_SCHED __builtin_amdgcn_sched_barrier(0)
    Unit cur, nxt; int ui = 0;
    if (!S.next(0, cur)) return;
    f32x4 acc[2][2][4][2];
#pragma unroll
    for (int a = 0; a < 2; ++a)
#pragma unroll
        for (int b = 0; b < 2; ++b)
#pragma unroll
            for (int m = 0; m < 4; ++m)
#pragma unroll
                for (int n = 0; n < 2; ++n) acc[a][b][m][n] = (f32x4){0.f, 0.f, 0.f, 0.f};
    bf16x8 At[4][2], B0[2][2], B1[2][2];
    const char* cA = (const char*)g.A + (size_t)cur.pm * tstepA; const char* cB = (const char*)g.Bt + (size_t)cur.pn * tstepB;
    PG8_STAGE(PG8_SB(0, 0), cB, voffB); PG8_STAGE(PG8_SA(0, 0), cA, voffA); PG8_STAGE(PG8_SB(0, 1), cB + hstepB, voffB); PG8_STAGE(PG8_SA(0, 1), cA + hstepA, voffA);
    if (wr == 1) PG8_BAR;
    PG8_WAIT_V(4); PG8_BAR;
    PG8_STAGE(PG8_SB(1, 0), cB + kstep, voffB); PG8_STAGE(PG8_SA(1, 0), cA + kstep, voffA); PG8_STAGE(PG8_SB(1, 1), cB + hstepB + kstep, voffB);
    PG8_WAIT_V(6); PG8_BAR;
    for (;;) {
        const bool has_next = S.next(ui + 1, nxt);
        const char* nA = has_next ? (const char*)g.A + (size_t)nxt.pm * tstepA : cA; const char* nB = has_next ? (const char*)g.Bt + (size_t)nxt.pn * tstepB : cB;
        for (int t = 0; t < nt; t += 2) {
            const bool last = (t == nt - 2);
            const char* a1 = cA + (size_t)(t + 1) * kstep;
            const char* a2 = last ? nA : cA + (size_t)(t + 2) * kstep; const char* b2 = last ? nB : cB + (size_t)(t + 2) * kstep;
            const char* a3 = a2 + kstep; const char* b3 = b2 + kstep;
            PG8_LDB(B0, 0, 0); PG8_SCHED; PG8_LDA(At, 0, 0); PG8_STAGE(PG8_SA(1, 1), a1 + hstepA, voffA);
            PG8_WAIT_L(8); PG8_BAR; PG8_WAIT_L(0); PG8_MMA(0, 0, At, B0); PG8_BAR; PG8_SCHED;
            PG8_LDB(B1, 0, 1); PG8_STAGE(PG8_SB(0, 0), b2, voffB);
            PG8_BAR; PG8_WAIT_L(0); PG8_MMA(0, 1, At, B1); PG8_BAR;
            PG8_LDA(At, 0, 1); PG8_STAGE(PG8_SA(0, 0), a2, voffA);
            PG8_BAR; PG8_WAIT_L(0); PG8_MMA(1, 0, At, B0); PG8_BAR; PG8_SCHED;
            PG8_STAGE(PG8_SB(0, 1), b2 + hstepB, voffB);
            PG8_WAIT_V(6); PG8_BAR; PG8_MMA(1, 1, At, B1); PG8_BAR;
            PG8_LDB(B0, 1, 0); PG8_SCHED; PG8_LDA(At, 1, 0); PG8_STAGE(PG8_SA(0, 1), a2 + hstepA, voffA);
            PG8_WAIT_L(8); PG8_BAR; PG8_WAIT_L(0); PG8_MMA(0, 0, At, B0); PG8_BAR; PG8_SCHED;
            PG8_LDB(B1, 1, 1); PG8_STAGE(PG8_SB(1, 0), b3, voffB);
            PG8_BAR; PG8_WAIT_L(0); PG8_MMA(0, 1, At, B1); PG8_BAR;
            PG8_LDA(At, 1, 1); PG8_STAGE(PG8_SA(1, 0), a3, voffA);
            PG8_BAR; PG8_WAIT_L(0); PG8_MMA(1, 0, At, B0); PG8_BAR; PG8_SCHED;
            PG8_STAGE(PG8_SB(1, 1), b3 + hstepB, voffB);
            PG8_WAIT_V(6); PG8_BAR; PG8_MMA(1, 1, At, B1); PG8_BAR;
        }
        E(acc, cur, wr, wc, fr, fq);
        if (!has_next) break;
#pragma unroll
        for (int a = 0; a < 2; ++a)
#pragma unroll
            for (int b = 0; b < 2; ++b)
#pragma unroll
                for (int m = 0; m < 4; ++m)
#pragma unroll
                    for (int n = 0; n < 2; ++n) acc[a][b][m][n] = (f32x4){0.f, 0.f, 0.f, 0.f};
        cur = nxt; cA = nA; cB = nB; ++ui;
    }
    PG8_WAIT_V(0);
    if (wr == 0) PG8_BAR;
    PG8_BAR;
#undef PG8_SA
#undef PG8_SB
#undef PG8_STAGE
#undef PG8_LDA
#undef PG8_LDB
#undef PG8_MMA
#undef PG8_WAIT_V
#undef PG8_WAIT_L
#undef PG8_BAR
#undef PG8_SCHED
}
}

template <bool QKPERM>
DI void transpose_item(const float* W, int K, int N, bf16_t* WT, LAS float* scr, int item, int lane) {
    const int nblk = N / 32, kb = item / nblk, nb = item % nblk, k0 = 64 * kb, n0 = 32 * nb;
    int sc = n0 + (lane & 31);
    if (QKPERM && sc < 1024) { const int hd = sc >> 6, cp = sc & 63; sc = hd * 64 + 32 * (cp & 1) + (cp >> 1); }
#pragma unroll 8
    for (int i = 0; i < 32; ++i) { const int kk = 2 * i + (lane >> 5); scr[kk * 33 + (lane & 31)] = W[(size_t)(k0 + kk) * N + sc]; }
    LDS_WAIT();
    const int c = lane & 7;
#pragma unroll
    for (int j = 0; j < 4; ++j) { const int n = (lane >> 3) + 8 * j; const LAS float* s = scr + (8 * c) * 33 + n;
        u32x4 o; o.x = cvt_pk_bf16(s[0 * 33], s[1 * 33]); o.y = cvt_pk_bf16(s[2 * 33], s[3 * 33]); o.z = cvt_pk_bf16(s[4 * 33], s[5 * 33]); o.w = cvt_pk_bf16(s[6 * 33], s[7 * 33]);
        *(u32x4*)(WT + (size_t)(n0 + n) * K + k0 + 8 * c) = o; }
    LDS_WAIT();
}

DI void convert_weights(KP p, int l, LAS unsigned char* lds, int wv) {
    const int tid_ = otid(wv); const int wave = tid_ >> 6, lane = tid_ & 63;
    LAS float* scr = (LAS float*)(lds + wave * 8448);
    const int gw = blockIdx.x * 8 + wave, NGW = gridDim.x * 8;
    constexpr int I_IN = 16 * (INC / 32), I_BR = 8 * 32, I_OUT = 16 * 32, I_UP = 16 * (UPC / 32), I_DN = (DFF / 64) * 32, I_L64 = 16, I_L128 = 32;
    constexpr int NIT = I_IN + 3 * I_BR + I_OUT + I_UP + I_DN + 2 * I_L64 + I_L128;
    unsigned char* ws = ows(p->ws);
    for (int it = gw; it < NIT; it += NGW) {
        int r = it;
        if (r < I_IN) { transpose_item<true>(p->in[5] + (size_t)l * 1024 * INC, 1024, INC, (bf16_t*)(ws + WS_WIN), scr, r, lane); continue; } r -= I_IN;
        if (r < 3 * I_BR) { const int b = r / I_BR; transpose_item<false>(p->in[21] + ((size_t)l * 3 + b) * 512 * 1024, 512, 1024, (bf16_t*)(ws + WS_WBR) + (size_t)b * 1024 * 512, scr, r % I_BR, lane); continue; } r -= 3 * I_BR;
        if (r < I_OUT) { transpose_item<false>(p->in[22] + (size_t)l * 1024 * 1024, 1024, 1024, (bf16_t*)(ws + WS_WOUT), scr, r, lane); continue; } r -= I_OUT;
        if (r < I_UP) { transpose_item<false>(p->in[24] + (size_t)l * 1024 * UPC, 1024, UPC, (bf16_t*)(ws + WS_WUP), scr, r, lane); continue; } r -= I_UP;
        if (r < I_DN) { transpose_item<false>(p->in[27] + (size_t)l * DFF * 1024, DFF, 1024, (bf16_t*)(ws + WS_WDN), scr, r, lane); continue; } r -= I_DN;
        if (r < I_L64) { transpose_item<false>(p->in[8] + (size_t)l * 64 * 512, 64, 512, (bf16_t*)(ws + WS_LWU), scr, r, lane); continue; } r -= I_L64;
        if (r < I_L64) { transpose_item<false>(p->in[10] + (size_t)l * 64 * 512, 64, 512, (bf16_t*)(ws + WS_LAU), scr, r, lane); continue; } r -= I_L64;
        transpose_item<false>(p->in[11] + (size_t)l * 128 * 512, 128, 512, (bf16_t*)(ws + WS_LGU), scr, r, lane);
    }
}

DI void phase0(KP p, LAS unsigned char* lds, int wv) {
    const int tid = otid(wv);
    float* ropec = (float*)(p->ws + WS_ROPEC); float* ropes = (float*)(p->ws + WS_ROPES);
    for (int idx = blockIdx.x * 512 + tid; idx < SEQ * 32; idx += gridDim.x * 512) {
        const int pos = idx >> 5, e = idx & 31;
        const float inv = 1.0f / exp2f((float)e * (13.287712379549449f / 32.0f));
        const float ang = (float)pos * inv;
        double rev = (double)ang * 0.15915494309189535; rev -= rint(rev);
        const float rv = (float)rev;
        ropec[idx] = __builtin_amdgcn_cosf(rv); ropes[idx] = __builtin_amdgcn_sinf(rv);
    }
    {
        LAS float* ca = (LAS float*)lds;
        LAS float* red = (LAS float*)(lds + 16384);
        float* mod = (float*)(p->ws + WS_MOD);
        bool loaded = false;
        for (int item = blockIdx.x; item < 192; item += gridDim.x) {
            if (!loaded) { for (int i = tid; i < 4096; i += 512) { const float v = p->in[1][i]; ca[i] = v / (1.0f + __expf(-v)); } loaded = true; __syncthreads(); }
            const int l = item / 96, c0 = (item % 96) * 64, cc = tid & 63, kg = tid >> 6;
            const float* w = p->in[2] + (size_t)l * 1024 * 6144 + c0 + cc;
            float a0 = 0.f, a1 = 0.f, a2 = 0.f, a3 = 0.f;
#pragma unroll 8
            for (int k = kg * 128; k < kg * 128 + 128; ++k) { const float wv = w[(size_t)k * 6144]; a0 += ca[k] * wv; a1 += ca[1024 + k] * wv; a2 += ca[2048 + k] * wv; a3 += ca[3072 + k] * wv; }
            red[(kg * 4 + 0) * 64 + cc] = a0; red[(kg * 4 + 1) * 64 + cc] = a1; red[(kg * 4 + 2) * 64 + cc] = a2; red[(kg * 4 + 3) * 64 + cc] = a3;
            __syncthreads();
            if (tid < 256) { const int b = tid >> 6; float s = 0.f;
#pragma unroll
                for (int g = 0; g < 8; ++g) s += red[(g * 4 + b) * 64 + cc];
                mod[((size_t)l * 4 + b) * 6144 + c0 + cc] = s + p->in[3][(size_t)l * 6144 + c0 + cc]; }
            __syncthreads();
        }
        __syncthreads();
    }
    convert_weights(p, 0, lds, wv);
}

DI void norm_mod_phase(const float* x, const float* g, const float* sh, const float* sc, bf16_t* H, int wv) {
    const int tid_ = otid(wv); const int wave = tid_ >> 6, lane = tid_ & 63;
    for (int row0 = (blockIdx.x * 8 + wave) * 2; row0 < MTOK; row0 += gridDim.x * 16) {
        f32x4 v[2][4]; float s[2] = {0.f, 0.f};
#pragma unroll
        for (int q = 0; q < 2; ++q) { const f32x4* xr = (const f32x4*)(x + (size_t)(row0 + q) * DM) + lane;
#pragma unroll
            for (int j = 0; j < 4; ++j) v[q][j] = xr[64 * j]; }
#pragma unroll
        for (int q = 0; q < 2; ++q)
#pragma unroll
            for (int j = 0; j < 4; ++j) s[q] += (v[q][j][0] * v[q][j][0] + v[q][j][1] * v[q][j][1]) + (v[q][j][2] * v[q][j][2] + v[q][j][3] * v[q][j][3]);
        const float rs0 = rsqrtf(wave_sum(s[0]) * (1.0f / DM) + 1e-6f), rs1 = rsqrtf(wave_sum(s[1]) * (1.0f / DM) + 1e-6f);
        const int b = row0 >> 12;
#pragma unroll
        for (int j = 0; j < 4; ++j) {
            const int c = 4 * lane + 256 * j;
            const f32x4 gg = *(const f32x4*)(g + c), s1 = *(const f32x4*)(sc + (size_t)b * 6144 + c), s0 = *(const f32x4*)(sh + (size_t)b * 6144 + c);
#pragma unroll
            for (int q = 0; q < 2; ++q) {
                const f32x4 h = (v[q][j] * (q ? rs1 : rs0) * gg) * (s1 + 1.0f) + s0;
                u32x2 w; w.x = cvt_pk_bf16(h[0], h[1]); w.y = cvt_pk_bf16(h[2], h[3]);
                *((u32x2*)(H + (size_t)(row0 + q) * DM) + lane + 64 * j) = w;
            }
        }
    }
}
DI void final_norm_phase(float* x, const float* g, int wv) {
    const int tid_ = otid(wv); const int wave = tid_ >> 6, lane = tid_ & 63;
    for (int row = blockIdx.x * 8 + wave; row < MTOK; row += gridDim.x * 8) {
        f32x4* xr = (f32x4*)(x + (size_t)row * DM) + lane;
        f32x4 v[4]; float s = 0.f;
#pragma unroll
        for (int j = 0; j < 4; ++j) { v[j] = xr[64 * j]; s += (v[j][0] * v[j][0] + v[j][1] * v[j][1]) + (v[j][2] * v[j][2] + v[j][3] * v[j][3]); }
        const float rs = rsqrtf(wave_sum(s) * (1.0f / DM) + 1e-6f);
#pragma unroll
        for (int j = 0; j < 4; ++j) { const f32x4 gg = *(const f32x4*)(g + 4 * lane + 256 * j); xr[64 * j] = v[j] * rs * gg; }
    }
}

DI bf16x8 lerp_frag(const bf16_t* cur, const bf16_t* prv, bool hasprev, const float* mu, int act) {
    const u32x4 c = *(const u32x4*)cur; u32x4 q = {0u, 0u, 0u, 0u}; if (hasprev) q = *(const u32x4*)prv;
    const f32x4 m0 = *(const f32x4*)mu, m1 = *(const f32x4*)(mu + 4);
    float z[8];
    const unsigned cw[4] = {c.x, c.y, c.z, c.w}, qw[4] = {q.x, q.y, q.z, q.w};
#pragma unroll
    for (int j = 0; j < 4; ++j) {
        const float c0 = bf_lo(cw[j]), c1 = bf_hi(cw[j]), p0 = bf_lo(qw[j]), p1 = bf_hi(qw[j]);
        const float mA = (j < 2) ? m0[2 * j] : m1[2 * j - 4], mB = (j < 2) ? m0[2 * j + 1] : m1[2 * j - 3];
        z[2 * j] = c0 + (p0 - c0) * mA; z[2 * j + 1] = c1 + (p1 - c1) * mB;
    }
#pragma unroll
    for (int j = 0; j < 8; ++j) {
        if (act == 1) { const float e = __expf(2.0f * z[j]); z[j] = 1.0f - 2.0f / (1.0f + e); }
        else if (act == 2) z[j] = sigmoidf_(z[j]);
    }
    return pack8(z[0], z[1], z[2], z[3], z[4], z[5], z[6], z[7]);
}

DI void rwkv_derived_phase(KP p, int l, int wv) {
    unsigned char* ws = ows(p->ws);
    const bf16_t* RAW = (const bf16_t*)(ws + WS_RAW);
    bf16_t *RZ = (bf16_t*)(ws + WS_RZ), *KP = (bf16_t*)(ws + WS_KP), *VZ = (bf16_t*)(ws + WS_VZ), *KKN = (bf16_t*)(ws + WS_KKN), *Bv = (bf16_t*)(ws + WS_B), *G = (bf16_t*)(ws + WS_G);
    float* W = (float*)(ws + WS_W); float* BONUS = (float*)(ws + WS_BONUS);
    const bf16_t *LWU = (const bf16_t*)(ws + WS_LWU), *LAU = (const bf16_t*)(ws + WS_LAU), *LGU = (const bf16_t*)(ws + WS_LGU);
    const float* mu = p->in[6] + (size_t)l * RAWC; const float* w0 = p->in[7] + l * 512; const float* a0 = p->in[9] + l * 512;
    const float* k_k = p->in[12] + l * 512; const float* k_a = p->in[13] + l * 512; const float* r_k = p->in[14] + l * 512;
    const int tid_ = otid(wv); const int wave = tid_ >> 6, lane = tid_ & 63, r = lane & 31, hh = lane >> 5;
    for (int job = blockIdx.x * 8 + wave; job < 512 * 8; job += gridDim.x * 8) {
        const int hd = job & 7, tg = job >> 3, t = tg * 32 + r;
        const bool hp = (t & (SEQ - 1)) != 0;
        const bf16_t* cur = RAW + (size_t)t * RAWC; const bf16_t* prv = cur - RAWC;
        float ss = 0.f;
#pragma unroll
        for (int q = 0; q < 8; ++q) {
            const int c = hd * 64 + 8 * q + 4 * hh;
            const u32x2 kc = *(const u32x2*)(cur + 512 + c); u32x2 kq = {0u, 0u}; if (hp) kq = *(const u32x2*)(prv + 512 + c);
            const f32x4 mk = *(const f32x4*)(mu + 512 + c), kkw = *(const f32x4*)(k_k + c);
            const float kcur[4] = {bf_lo(kc.x), bf_hi(kc.x), bf_lo(kc.y), bf_hi(kc.y)}, kprv[4] = {bf_lo(kq.x), bf_hi(kq.x), bf_lo(kq.y), bf_hi(kq.y)};
#pragma unroll
            for (int j = 0; j < 4; ++j) { const float kk = (kcur[j] + (kprv[j] - kcur[j]) * mk[j]) * kkw[j]; ss += kk * kk; }
        }
        ss += __shfl_xor(ss, 32);
        const float inv = 1.0f / fmaxf(sqrtf(ss), 1e-12f);
        float bonus = 0.f;
        {
            bf16x8 bw[4], ba[4];
#pragma unroll
            for (int s = 0; s < 4; ++s) { const int o = 16 * s + 8 * hh; bw[s] = lerp_frag(cur + 1536 + o, prv + 1536 + o, hp, mu + 1536 + o, 1); ba[s] = lerp_frag(cur + 1600 + o, prv + 1600 + o, hp, mu + 1600 + o, 0); }
#pragma unroll 1
            for (int mt = 0; mt < 2; ++mt) {
                const int chr = hd * 64 + 32 * mt + r;
                f32x16 aw, aa;
#pragma unroll
                for (int i = 0; i < 16; ++i) { aw[i] = 0.f; aa[i] = 0.f; }
#pragma unroll
                for (int s = 0; s < 4; ++s) {
                    const bf16x8 fw = *(const bf16x8*)(LWU + (size_t)chr * 64 + 16 * s + 8 * hh), fa = *(const bf16x8*)(LAU + (size_t)chr * 64 + 16 * s + 8 * hh);
                    aw = MFMA32(fw, bw[s], aw); aa = MFMA32(fa, ba[s], aa);
                }
#pragma unroll
                for (int i4 = 0; i4 < 4; ++i4) {
                    const int c = hd * 64 + 32 * mt + 8 * i4 + 4 * hh;
                    const u32x2 rc = *(const u32x2*)(cur + c), kc = *(const u32x2*)(cur + 512 + c), vc = *(const u32x2*)(cur + 1024 + c);
                    u32x2 rp = {0u, 0u}, kq = {0u, 0u}, vp = {0u, 0u};
                    if (hp) { rp = *(const u32x2*)(prv + c); kq = *(const u32x2*)(prv + 512 + c); vp = *(const u32x2*)(prv + 1024 + c); }
                    const f32x4 mr = *(const f32x4*)(mu + c), mk = *(const f32x4*)(mu + 512 + c), mv = *(const f32x4*)(mu + 1024 + c);
                    const f32x4 w0v = *(const f32x4*)(w0 + c), a0v = *(const f32x4*)(a0 + c), kkw = *(const f32x4*)(k_k + c), kaw = *(const f32x4*)(k_a + c), rkw = *(const f32x4*)(r_k + c);
                    const float rcur[4] = {bf_lo(rc.x), bf_hi(rc.x), bf_lo(rc.y), bf_hi(rc.y)}, rprv[4] = {bf_lo(rp.x), bf_hi(rp.x), bf_lo(rp.y), bf_hi(rp.y)};
                    const float kcur[4] = {bf_lo(kc.x), bf_hi(kc.x), bf_lo(kc.y), bf_hi(kc.y)}, kprv[4] = {bf_lo(kq.x), bf_hi(kq.x), bf_lo(kq.y), bf_hi(kq.y)};
                    const float vcur[4] = {bf_lo(vc.x), bf_hi(vc.x), bf_lo(vc.y), bf_hi(vc.y)}, vprv[4] = {bf_lo(vp.x), bf_hi(vp.x), bf_lo(vp.y), bf_hi(vp.y)};
                    f32x4 dec; float rz[4], kp[4], vz[4], kn[4], bb[4];
#pragma unroll
                    for (int j = 0; j < 4; ++j) {
                        const int i = 4 * i4 + j;
                        const float zz = -(w0v[j] + aw[i]);
                        const float sp = (zz > 20.f) ? zz : __logf(1.0f + __expf(zz));
                        const float wv = -sp - 0.5f;
                        dec[j] = __expf(-__expf(wv));
                        const float av = sigmoidf_(a0v[j] + aa[i]);
                        rz[j] = rcur[j] + (rprv[j] - rcur[j]) * mr[j];
                        const float kz = kcur[j] + (kprv[j] - kcur[j]) * mk[j];
                        vz[j] = vcur[j] + (vprv[j] - vcur[j]) * mv[j];
                        kn[j] = kz * kkw[j] * inv; bb[j] = kn[j] * av;
                        kp[j] = kz * (1.0f + (av - 1.0f) * kaw[j]);
                        bonus += rz[j] * kp[j] * rkw[j];
                    }
                    const size_t o = (size_t)t * 512 + c;
                    *(f32x4*)(W + o) = dec;
                    u32x2 w2; w2.x = cvt_pk_bf16(rz[0], rz[1]); w2.y = cvt_pk_bf16(rz[2], rz[3]); *(u32x2*)(RZ + o) = w2;
                    w2.x = cvt_pk_bf16(kp[0], kp[1]); w2.y = cvt_pk_bf16(kp[2], kp[3]); *(u32x2*)(KP + o) = w2;
                    w2.x = cvt_pk_bf16(vz[0], vz[1]); w2.y = cvt_pk_bf16(vz[2], vz[3]); *(u32x2*)(VZ + o) = w2;
                    w2.x = cvt_pk_bf16(kn[0], kn[1]); w2.y = cvt_pk_bf16(kn[2], kn[3]); *(u32x2*)(KKN + o) = w2;
                    w2.x = cvt_pk_bf16(bb[0], bb[1]); w2.y = cvt_pk_bf16(bb[2], bb[3]); *(u32x2*)(Bv + o) = w2;
                }
            }
        }
        bonus += __shfl_xor(bonus, 32);
        if (hh == 0) BONUS[(size_t)t * 8 + hd] = bonus;
        {
            bf16x8 bg[8];
#pragma unroll
            for (int s = 0; s < 8; ++s) { const int o = 16 * s + 8 * hh; bg[s] = lerp_frag(cur + 1664 + o, prv + 1664 + o, hp, mu + 1664 + o, 2); }
#pragma unroll 1
            for (int mt = 0; mt < 2; ++mt) {
                const int chr = hd * 64 + 32 * mt + r;
                f32x16 ag;
#pragma unroll
                for (int i = 0; i < 16; ++i) ag[i] = 0.f;
#pragma unroll
                for (int s = 0; s < 8; ++s) { const bf16x8 fg = *(const bf16x8*)(LGU + (size_t)chr * 128 + 16 * s + 8 * hh); ag = MFMA32(fg, bg[s], ag); }
#pragma unroll
                for (int i4 = 0; i4 < 4; ++i4) {
                    const size_t o = (size_t)t * 512 + hd * 64 + 32 * mt + 8 * i4 + 4 * hh;
                    u32x2 w2; w2.x = cvt_pk_bf16(ag[4 * i4], ag[4 * i4 + 1]); w2.y = cvt_pk_bf16(ag[4 * i4 + 2], ag[4 * i4 + 3]); *(u32x2*)(G + o) = w2;
                }
            }
        }
    }
}

constexpr int SC_T = 32, SC_STEP = 1344, SC_BUF = SC_T * SC_STEP;
DI void scan_stage(KP p, LAS unsigned char* buf, int b, int h, int rg, int ck, int pt) {
    const unsigned char* ws = ows(p->ws);
    const size_t tok0 = (size_t)b * SEQ + (size_t)ck * SC_T;
    {
#pragma unroll
        for (int q = 0; q < 2; ++q) { const int pp = pt + 256 * q, st = pp >> 4, sub = pp & 15;
            const f32x4 v = *(const f32x4*)((const float*)(ws + WS_W) + (tok0 + st) * 512 + h * 64 + 4 * sub);
            *(LAS f32x4*)(buf + st * SC_STEP + sub * 16) = v; }
    }
    const int st = pt >> 3, sub = pt & 7; const size_t go = (tok0 + st) * 512 + h * 64 + 8 * sub;
    const u32x4 kn = *(const u32x4*)((const bf16_t*)(ws + WS_KKN) + go), bb = *(const u32x4*)((const bf16_t*)(ws + WS_B) + go),
                kp = *(const u32x4*)((const bf16_t*)(ws + WS_KP) + go), rz = *(const u32x4*)((const bf16_t*)(ws + WS_RZ) + go);
    LAS unsigned char* d = buf + st * SC_STEP + sub * 32;
    *(LAS f32x4*)(d + 256) = (f32x4){-bf_lo(kn.x), -bf_hi(kn.x), -bf_lo(kn.y), -bf_hi(kn.y)}; *(LAS f32x4*)(d + 256 + 16) = (f32x4){-bf_lo(kn.z), -bf_hi(kn.z), -bf_lo(kn.w), -bf_hi(kn.w)};
    *(LAS f32x4*)(d + 512) = (f32x4){bf_lo(bb.x), bf_hi(bb.x), bf_lo(bb.y), bf_hi(bb.y)}; *(LAS f32x4*)(d + 512 + 16) = (f32x4){bf_lo(bb.z), bf_hi(bb.z), bf_lo(bb.w), bf_hi(bb.w)};
    *(LAS f32x4*)(d + 768) = (f32x4){bf_lo(kp.x), bf_hi(kp.x), bf_lo(kp.y), bf_hi(kp.y)}; *(LAS f32x4*)(d + 768 + 16) = (f32x4){bf_lo(kp.z), bf_hi(kp.z), bf_lo(kp.w), bf_hi(kp.w)};
    *(LAS f32x4*)(d + 1024) = (f32x4){bf_lo(rz.x), bf_hi(rz.x), bf_lo(rz.y), bf_hi(rz.y)}; *(LAS f32x4*)(d + 1024 + 16) = (f32x4){bf_lo(rz.z), bf_hi(rz.z), bf_lo(rz.w), bf_hi(rz.w)};
    if (pt < 64) { const int s2 = pt >> 1, hf = pt & 1;
        const u32x4 vv = *(const u32x4*)((const bf16_t*)(ws + WS_VZ) + (tok0 + s2) * 512 + h * 64 + rg * 16 + 8 * hf);
        LAS unsigned char* dv = buf + s2 * SC_STEP + 1280 + hf * 32;
        *(LAS f32x4*)dv = (f32x4){bf_lo(vv.x), bf_hi(vv.x), bf_lo(vv.y), bf_hi(vv.y)}; *(LAS f32x4*)(dv + 16) = (f32x4){bf_lo(vv.z), bf_hi(vv.z), bf_lo(vv.w), bf_hi(vv.w)}; }
}
DI void rwkv_scan_phase(KP p, LAS unsigned char* lds, int wv) {
    const int tid = otid(wv), wave = tid >> 6, lane = tid & 63;
    float* YRAW = (float*)(p->ws + WS_YRAW);
    for (int job = blockIdx.x; job < 128; job += gridDim.x) {
        const int chain = job >> 2, rg = job & 3, b = chain >> 3, h = chain & 7;
        __syncthreads();
        if (wave >= 4) scan_stage(p, lds, b, h, rg, 0, tid - 256);
        __syncthreads();
        f32x4 S = {0.f, 0.f, 0.f, 0.f};
        const int jl = lane & 15, rl = 4 * (wave & 3) + (lane >> 4);
        for (int ck = 0; ck < SEQ / SC_T; ++ck) {
            LAS unsigned char* cb = lds + (ck & 1) * SC_BUF;
            if (wave >= 4) { if (ck + 1 < SEQ / SC_T) scan_stage(p, lds + ((ck + 1) & 1) * SC_BUF, b, h, rg, ck + 1, tid - 256); }
            else {
                float* yo = YRAW + ((size_t)b * SEQ + (size_t)ck * SC_T + jl) * 512 + h * 64 + rg * 16 + rl;
                const LAS unsigned char* sb = cb + jl * 16; const LAS unsigned char* vb = cb + 1280 + rl * 4;
                f32x4 w4 = *(const LAS f32x4*)sb, an = *(const LAS f32x4*)(sb + 256), b4 = *(const LAS f32x4*)(sb + 512), k4 = *(const LAS f32x4*)(sb + 768), r4 = *(const LAS f32x4*)(sb + 1024);
                float vi = *(const LAS float*)vb;
                float ysel = 0.f;
#pragma unroll
                for (int s = 0; s < SC_T; ++s) {
                    f32x4 w4n = w4, ann = an, b4n = b4, k4n = k4, r4n = r4; float vin = vi;
                    if (s + 1 < SC_T) {
                        const LAS unsigned char* sn = sb + (s + 1) * SC_STEP;
                        w4n = *(const LAS f32x4*)sn; ann = *(const LAS f32x4*)(sn + 256); b4n = *(const LAS f32x4*)(sn + 512); k4n = *(const LAS f32x4*)(sn + 768); r4n = *(const LAS f32x4*)(sn + 1024);
                        vin = *(const LAS float*)(vb + (s + 1) * SC_STEP);
                    }
                    float sa = (S[0] * an[0] + S[1] * an[1]) + (S[2] * an[2] + S[3] * an[3]);
                    sa = row16_sum(sa);
                    S = S * w4 + (b4 * sa + k4 * vi);
                    float y = (S[0] * r4[0] + S[1] * r4[1]) + (S[2] * r4[2] + S[3] * r4[3]);
                    y = row16_sum(y);
                    ysel = (jl == (s & 15)) ? y : ysel;
                    if ((s & 15) == 15) yo[(size_t)(s - 15) * 512] = ysel;
                    w4 = w4n; an = ann; b4 = b4n; k4 = k4n; r4 = r4n; vi = vin;
                }
            }
            __syncthreads();
        }
    }
}

DI void rwkv_post_phase(KP p, int l, int wv) {
    const unsigned char* ws = ows(p->ws);
    const float* YRAW = (const float*)(ws + WS_YRAW); const bf16_t* VZ = (const bf16_t*)(ws + WS_VZ); const bf16_t* G = (const bf16_t*)(ws + WS_G);
    const float* BONUS = (const float*)(ws + WS_BONUS); bf16_t* YS = (bf16_t*)(p->ws + WS_YSR);
    const float* gnw = p->in[15] + l * 512; const float* gnb = p->in[16] + l * 512;
    const int tid_ = otid(wv); const int wave = tid_ >> 6, lane = tid_ & 63, c = 8 * lane;
    const f32x4 gw0 = *(const f32x4*)(gnw + c), gw1 = *(const f32x4*)(gnw + c + 4), gb0 = *(const f32x4*)(gnb + c), gb1 = *(const f32x4*)(gnb + c + 4);
    for (int t = blockIdx.x * 8 + wave; t < MTOK; t += gridDim.x * 8) {
        const size_t o = (size_t)t * 512 + c;
        const f32x4 y0 = *(const f32x4*)(YRAW + o), y1 = *(const f32x4*)(YRAW + o + 4);
        float s = (y0[0] + y0[1]) + (y0[2] + y0[3]) + (y1[0] + y1[1]) + (y1[2] + y1[3]);
        s += __shfl_xor(s, 1); s += __shfl_xor(s, 2); s += __shfl_xor(s, 4);
        const float mean = s * (1.0f / 64.0f);
        const f32x4 d0 = y0 - mean, d1 = y1 - mean;
        float q = (d0[0] * d0[0] + d0[1] * d0[1]) + (d0[2] * d0[2] + d0[3] * d0[3]) + (d1[0] * d1[0] + d1[1] * d1[1]) + (d1[2] * d1[2] + d1[3] * d1[3]);
        q += __shfl_xor(q, 1); q += __shfl_xor(q, 2); q += __shfl_xor(q, 4);
        const float rstd = rsqrtf(q * (1.0f / 64.0f) + 64e-5f);
        const float bon = BONUS[(size_t)t * 8 + (lane >> 3)];
        const u32x4 vv = *(const u32x4*)(VZ + o), gg = *(const u32x4*)(G + o);
        const f32x4 v0 = {bf_lo(vv.x), bf_hi(vv.x), bf_lo(vv.y), bf_hi(vv.y)}, v1 = {bf_lo(vv.z), bf_hi(vv.z), bf_lo(vv.w), bf_hi(vv.w)};
        const f32x4 g0 = {bf_lo(gg.x), bf_hi(gg.x), bf_lo(gg.y), bf_hi(gg.y)}, g1 = {bf_lo(gg.z), bf_hi(gg.z), bf_lo(gg.w), bf_hi(gg.w)};
        const f32x4 r0 = (d0 * rstd * gw0 + gb0 + v0 * bon) * g0, r1 = (d1 * rstd * gw1 + gb1 + v1 * bon) * g1;
        u32x4 w; w.x = cvt_pk_bf16(r0[0], r0[1]); w.y = cvt_pk_bf16(r0[2], r0[3]); w.z = cvt_pk_bf16(r1[0], r1[1]); w.w = cvt_pk_bf16(r1[2], r1[3]);
        *(u32x4*)(YS + o) = w;
    }
}

DI void attn_job(const bf16_t* Q, const bf16_t* K, const bf16_t* V, bf16_t* YS, float* LSE, LAS unsigned char* vl, int b, int h, int d, int rho, int J0, bool first, int lane) {
    asm volatile("" : "+v"(lane));
    const int r = lane & 31, hh = lane >> 5;
    const size_t tokq = (size_t)b * SEQ + (size_t)(J0 + r) * d + rho;
    bf16x8 bq[4];
#pragma unroll
    for (int s = 0; s < 4; ++s) bq[s] = *(const bf16x8*)(Q + tokq * 512 + h * 64 + 16 * s + 8 * hh);
    f32x16 sc[5];
#pragma unroll
    for (int kt = 0; kt < 5; ++kt) {
        const int Jk = J0 - 128 + 32 * kt + r; const bool valid = Jk >= 0;
        const size_t tokk = (size_t)b * SEQ + (size_t)(valid ? Jk : 0) * d + rho;
        f32x16 a;
#pragma unroll
        for (int i = 0; i < 16; ++i) a[i] = 0.f;
#pragma unroll
        for (int s = 0; s < 4; ++s) {
            bf16x8 ak = *(const bf16x8*)(K + tokk * 512 + h * 64 + 16 * s + 8 * hh);
            if (!valid) ak = (bf16x8){0, 0, 0, 0, 0, 0, 0, 0};
            a = MFMA32(ak, bq[s], a);
        }
        sc[kt] = a;
    }
    float m = -1e30f;
#pragma unroll
    for (int kt = 0; kt < 5; ++kt)
#pragma unroll
        for (int i = 0; i < 16; ++i) {
            const int kidx = 32 * kt + crow(i, hh); const int dist = 128 + r - kidx;
            const bool ok = (dist >= 0) && (dist <= 128) && (J0 - 128 + kidx >= 0);
            const float v = ok ? sc[kt][i] * 0.125f : -1e30f;
            sc[kt][i] = v; m = fmaxf(m, v);
        }
    m = fmaxf(m, __shfl_xor(m, 32));
    float lsum = 0.f;
#pragma unroll
    for (int kt = 0; kt < 5; ++kt)
#pragma unroll
        for (int i = 0; i < 16; ++i) { const float pv = __expf(sc[kt][i] - m); sc[kt][i] = pv; lsum += pv; }
    lsum += __shfl_xor(lsum, 32);
    const float lse = m + __logf(lsum);
    f32x16 o[2];
#pragma unroll
    for (int i = 0; i < 16; ++i) { o[0][i] = 0.f; o[1][i] = 0.f; }
#pragma unroll
    for (int kt = 0; kt < 5; ++kt) {
        {
            const int key = lane >> 1, hf = lane & 1; const int Jk = J0 - 128 + 32 * kt + key;
            const size_t tokv = (size_t)b * SEQ + (size_t)(Jk >= 0 ? Jk : 0) * d + rho;
            const u32x4* src = (const u32x4*)(V + tokv * 512 + h * 64 + 32 * hf);
            LAS u32x4* dst = (LAS u32x4*)(vl + key * 128 + hf * 64);
            const u32x4 x0 = src[0], x1 = src[1], x2 = src[2], x3 = src[3];
            dst[0] = x0; dst[1] = x1; dst[2] = x2; dst[3] = x3;
        }
        LDS_WAIT();
#pragma unroll
        for (int s = 0; s < 2; ++s) {
            const bf16x8 xs = pack8(sc[kt][8 * s], sc[kt][8 * s + 1], sc[kt][8 * s + 2], sc[kt][8 * s + 3], sc[kt][8 * s + 4], sc[kt][8 * s + 5], sc[kt][8 * s + 6], sc[kt][8 * s + 7]);
#pragma unroll
            for (int mt = 0; mt < 2; ++mt) {
                bf16x8 pa;
#pragma unroll
                for (int j = 0; j < 8; ++j) { const int key = 16 * s + 8 * (j >> 2) + 4 * hh + (j & 3); pa[j] = (short)*(const LAS bf16_t*)(vl + key * 128 + (r + 32 * mt) * 2); }
                o[mt] = MFMA32(pa, xs, o[mt]);
            }
        }
        LDS_WAIT();
    }
    const float il = 1.0f / lsum;
    float wp = 0.f, wc = 1.0f, nl = lse;
    if (!first) { const float lp = LSE[tokq * 8 + h]; const float mx = fmaxf(lp, lse); const float ep = __expf(lp - mx), ec = __expf(lse - mx); nl = mx + __logf(ep + ec); wp = ep / (ep + ec); wc = ec / (ep + ec); }
#pragma unroll
    for (int mt = 0; mt < 2; ++mt)
#pragma unroll
        for (int g4 = 0; g4 < 4; ++g4) {
            bf16_t* dst = YS + tokq * 512 + h * 64 + 32 * mt + 8 * g4 + 4 * hh;
            float v[4];
#pragma unroll
            for (int j = 0; j < 4; ++j) v[j] = o[mt][4 * g4 + j] * il * wc;
            if (!first) { const u32x2 pw = *(const u32x2*)dst; v[0] += bf_lo(pw.x) * wp; v[1] += bf_hi(pw.x) * wp; v[2] += bf_lo(pw.y) * wp; v[3] += bf_hi(pw.y) * wp; }
            u32x2 w2; w2.x = cvt_pk_bf16(v[0], v[1]); w2.y = cvt_pk_bf16(v[2], v[3]); *(u32x2*)dst = w2;
        }
    if (hh == 0) LSE[tokq * 8 + h] = nl;
}

DI void attention_phase(KP p, LAS unsigned char* lds, int wv) {
    unsigned char* ws = ows(p->ws);
    const bf16_t *Q = (const bf16_t*)(ws + WS_Q), *K = (const bf16_t*)(ws + WS_K), *V = (const bf16_t*)(ws + WS_V);
    bf16_t* YS = (bf16_t*)(ws + WS_YSA); float* LSE = (float*)(ws + WS_LSE);
    const int tid_ = otid(wv); const int wave = tid_ >> 6, lane = tid_ & 63;
    LAS unsigned char* vl = lds + wave * 4096;
    for (int item = blockIdx.x; item < 256; item += gridDim.x) {
        const int b = item >> 6, h = (item >> 3) & 7, qb = item & 7, P0 = qb * 512;
#pragma unroll 1
        for (int cfg = 0; cfg < 3; ++cfg) {
#pragma unroll 1
            for (int jj = wave; jj < 16; jj += 8) {
                int d, rho, J0;
                if (cfg == 0) { d = 1; rho = 0; J0 = P0 + 32 * jj; }
                else if (cfg == 1) { d = 4; rho = jj & 3; J0 = (P0 >> 2) + 32 * (jj >> 2); }
                else { d = 16; rho = jj; J0 = P0 >> 4; }
                attn_job(Q, K, V, YS, LSE, vl, b, h, d, rho, J0, cfg == 0, lane);
            }
            asm volatile("s_waitcnt vmcnt(0)" ::: "memory");
            __syncthreads();
        }
    }
}

DI void gmlp_phase(KP p, int l, LAS unsigned char* lds, int wv) {
    unsigned char* ws = ows(p->ws);
    const bf16_t* UV = (const bf16_t*)(ws + WS_UV); bf16_t* YS = (bf16_t*)(ws + WS_YSG);
    const float* lng = p->in[17] + l * 512; const float* lnb = p->in[18] + l * 512;
    const float* wsp = p->in[19] + (size_t)l * 8 * 128 * 128; const float* bsp = p->in[20] + (size_t)l * 8 * 128;
    const int tid_ = otid(wv); const int wave = tid_ >> 6, lane = tid_ & 63, r = lane & 31, hh = lane >> 5;
    LAS float* stats = (LAS float*)(lds + 8 * 17408);
    LAS bf16_t* VT = (LAS bf16_t*)(lds + wave * 17408);
    for (int item = blockIdx.x; item < 128; item += gridDim.x) {
        const size_t tok0 = (size_t)item * 128;
        __syncthreads();
        for (int tt = 0; tt < 16; ++tt) {
            const int tl = wave * 16 + tt;
            const u32x4 x = *(const u32x4*)(UV + (tok0 + tl) * 1024 + 512 + 8 * lane);
            const float f[8] = {bf_lo(x.x), bf_hi(x.x), bf_lo(x.y), bf_hi(x.y), bf_lo(x.z), bf_hi(x.z), bf_lo(x.w), bf_hi(x.w)};
            float s = 0.f;
#pragma unroll
            for (int j = 0; j < 8; ++j) s += f[j];
            const float mean = wave_sum(s) * (1.0f / 512.0f); float q = 0.f;
#pragma unroll
            for (int j = 0; j < 8; ++j) { const float dd = f[j] - mean; q += dd * dd; }
            const float rstd = rsqrtf(wave_sum(q) * (1.0f / 512.0f) + 1e-5f);
            if (lane == 0) { stats[2 * tl] = mean; stats[2 * tl + 1] = rstd; }
        }
        __syncthreads();
        const int g = wave;
        {
            const int d0 = 8 * (lane & 7);
            const f32x4 lg0 = *(const f32x4*)(lng + g * 64 + d0), lg1 = *(const f32x4*)(lng + g * 64 + d0 + 4), lb0 = *(const f32x4*)(lnb + g * 64 + d0), lb1 = *(const f32x4*)(lnb + g * 64 + d0 + 4);
            for (int it = 0; it < 16; ++it) {
                const int tl = it * 8 + (lane >> 3);
                const u32x4 x = *(const u32x4*)(UV + (tok0 + tl) * 1024 + 512 + g * 64 + d0);
                const float mean = stats[2 * tl], rstd = stats[2 * tl + 1];
                const float f[8] = {bf_lo(x.x), bf_hi(x.x), bf_lo(x.y), bf_hi(x.y), bf_lo(x.z), bf_hi(x.z), bf_lo(x.w), bf_hi(x.w)};
#pragma unroll
                for (int e = 0; e < 8; ++e) {
                    const float gg = e < 4 ? lg0[e & 3] : lg1[e & 3], bb = e < 4 ? lb0[e & 3] : lb1[e & 3];
                    const float y = (f[e] - mean) * rstd * gg + bb;
                    VT[(d0 + e) * 136 + tl] = (bf16_t)(cvt_pk_bf16(y, 0.f) & 0xffffu);
                }
            }
        }
        LDS_WAIT();
#pragma unroll 1
        for (int nt = 0; nt < 4; ++nt) {
            f32x16 acc[2];
#pragma unroll
            for (int i = 0; i < 16; ++i) { acc[0][i] = 0.f; acc[1][i] = 0.f; }
            const int irow = 32 * nt + r;
            for (int s = 0; s < 2 * (nt + 1); ++s) {
                const int j0 = 16 * s + 8 * hh;
                const float* wr_ = wsp + ((size_t)g * 128 + irow) * 128 + j0;
                const f32x4 wa = *(const f32x4*)wr_, wb = *(const f32x4*)(wr_ + 4);
                float wv[8] = {wa[0], wa[1], wa[2], wa[3], wb[0], wb[1], wb[2], wb[3]};
#pragma unroll
                for (int j = 0; j < 8; ++j) if (j0 + j > irow) wv[j] = 0.f;
                const bf16x8 bfr = pack8(wv[0], wv[1], wv[2], wv[3], wv[4], wv[5], wv[6], wv[7]);
#pragma unroll
                for (int mt = 0; mt < 2; ++mt) {
                    const bf16x8 afr = *(const LAS bf16x8*)(VT + (32 * mt + r) * 136 + j0);
                    acc[mt] = MFMA32(afr, bfr, acc[mt]);
                }
            }
            const size_t tok = tok0 + irow; const float bs = bsp[g * 128 + irow];
#pragma unroll
            for (int mt = 0; mt < 2; ++mt)
#pragma unroll
                for (int g4 = 0; g4 < 4; ++g4) {
                    const int c = g * 64 + 32 * mt + 8 * g4 + 4 * hh;
                    const u32x2 uu = *(const u32x2*)(UV + tok * 1024 + c);
                    const float o0 = bf_lo(uu.x) * (acc[mt][4 * g4] + bs), o1 = bf_hi(uu.x) * (acc[mt][4 * g4 + 1] + bs), o2 = bf_lo(uu.y) * (acc[mt][4 * g4 + 2] + bs), o3 = bf_hi(uu.y) * (acc[mt][4 * g4 + 3] + bs);
                    u32x2 w2; w2.x = cvt_pk_bf16(o0, o1); w2.y = cvt_pk_bf16(o2, o3); *(u32x2*)(YS + tok * 512 + c) = w2;
                }
        }
    }
}

DI void ffn_conv_phase(KP p, int l, int wv) {
    bf16_t* UP = (bf16_t*)(ows(p->ws) + WS_UP);
    const float* cw = p->in[25] + (size_t)l * 3 * DFF; const float* cb = p->in[26] + (size_t)l * DFF;
    constexpr int NCG = DFF / 8, RUN = 32, NRUN = MTOK / RUN;
    const int tid_ = otid(wv);
    for (int item = blockIdx.x * 512 + tid_; item < NCG * NRUN; item += gridDim.x * 512) {
        const int cgi = item % NCG, run = item / NCG, f0 = 8 * cgi, t0 = run * RUN;
        float w0[8], w1[8], w2[8], bb[8];
#pragma unroll
        for (int q = 0; q < 2; ++q) { const f32x4 a = *(const f32x4*)(cw + f0 + 4 * q), b = *(const f32x4*)(cw + DFF + f0 + 4 * q), c = *(const f32x4*)(cw + 2 * DFF + f0 + 4 * q), d = *(const f32x4*)(cb + f0 + 4 * q);
#pragma unroll
            for (int j = 0; j < 4; ++j) { w0[4 * q + j] = a[j]; w1[4 * q + j] = b[j]; w2[4 * q + j] = c[j]; bb[4 * q + j] = d[j]; } }
        u32x4 am2 = {0u, 0u, 0u, 0u}, am1 = {0u, 0u, 0u, 0u};
        if ((t0 & (SEQ - 1)) != 0) { am2 = *(const u32x4*)(UP + (size_t)(t0 - 2) * UPC + f0); am1 = *(const u32x4*)(UP + (size_t)(t0 - 1) * UPC + f0); }
        for (int t = t0; t < t0 + RUN; t += 4) {
            u32x4 av[4], gv[4];
#pragma unroll
            for (int q = 0; q < 4; ++q) { av[q] = *(const u32x4*)(UP + (size_t)(t + q) * UPC + f0); gv[q] = *(const u32x4*)(UP + (size_t)(t + q) * UPC + DFF + f0); }
#pragma unroll
            for (int q = 0; q < 4; ++q) {
                const u32x4 a0 = av[q], gg = gv[q];
                const unsigned x2[4] = {am2.x, am2.y, am2.z, am2.w}, x1[4] = {am1.x, am1.y, am1.z, am1.w}, x0[4] = {a0.x, a0.y, a0.z, a0.w}, xg[4] = {gg.x, gg.y, gg.z, gg.w};
                unsigned ow[4];
#pragma unroll
                for (int j = 0; j < 4; ++j) {
                    const float c0 = bb[2 * j] + w0[2 * j] * bf_lo(x2[j]) + w1[2 * j] * bf_lo(x1[j]) + w2[2 * j] * bf_lo(x0[j]);
                    const float c1 = bb[2 * j + 1] + w0[2 * j + 1] * bf_hi(x2[j]) + w1[2 * j + 1] * bf_hi(x1[j]) + w2[2 * j + 1] * bf_hi(x0[j]);
                    ow[j] = cvt_pk_bf16(gelu_tanh(c0) * bf_lo(xg[j]), gelu_tanh(c1) * bf_hi(xg[j]));
                }
                *(u32x4*)(UP + (size_t)(t + q) * UPC + DFF + f0) = (u32x4){ow[0], ow[1], ow[2], ow[3]};
                am2 = am1; am1 = a0;
            }
        }
    }
}

__global__ void __launch_bounds__(512) fwd_megakernel(Params p_unused) {
    extern __shared__ __attribute__((aligned(16))) unsigned char lds_raw[];
    LAS unsigned char* lds = (LAS unsigned char*)lds_raw;
    cg::grid_group grid = cg::this_grid();
    KP p = okp();
    unsigned char* ws = p->ws;
    const int G = gridDim.x, c = blockIdx.x;
    const int wv = __builtin_amdgcn_readfirstlane((int)(threadIdx.x >> 6));
    pg8::Epi E; pg8::TileOrder S; pg8::Gemm g;

    grid.sync();
    unsigned epoch = 0; unsigned* bar = (unsigned*)(ws + WS_BAR);
    phase0(p, lds, wv);
    gbar(bar, epoch, (unsigned)G, wv);
#pragma unroll 1
    for (int st = 0; st < 2 * 17; ++st) {
        const int l = st / 17, step = st % 17;
        p = okp(); ws = ows(p->ws);
        const float* mod = (const float*)(ws + WS_MOD); const bf16_t* H = (const bf16_t*)(ws + WS_H);
        const float* ml = mod + (size_t)l * 4 * 6144;
        const float* xin = (l == 0) ? p->in[0] : p->out;
        bool do_gemm = false, do_sync = true;
        E = pg8::Epi{};
        if (step == 0) {
            if (l > 0) convert_weights(p, l, lds, wv);
            norm_mod_phase(xin, p->in[4] + l * DM, ml + 0, ml + 1024, (bf16_t*)(ws + WS_H), wv);
        } else if (step == 1 || step == 4) {
            if (step == 4) rwkv_post_phase(p, l, wv);
            E.mode = pg8::EM_INPROJ; E.o0 = (bf16_t*)(ws + WS_Q); E.o1 = (bf16_t*)(ws + WS_K); E.o2 = (bf16_t*)(ws + WS_V); E.o3 = (bf16_t*)(ws + WS_RAW); E.o4 = (bf16_t*)(ws + WS_UV);
            E.ropec = (const float*)(ws + WS_ROPEC); E.ropes = (const float*)(ws + WS_ROPES);
            g.A = H; g.Bt = (const bf16_t*)(ws + WS_WIN); g.lda = 1024; g.K = 1024;
            if (step == 1) S.init(64, 7, G, c, 7, 6, 0); else S.init(64, 10, G, c, 6, 0, 13);
            do_gemm = true;
        } else if (step == 2) { rwkv_derived_phase(p, l, wv); }
        else if (step == 3) { rwkv_scan_phase(p, lds, wv);
#ifdef REP_SCAN
            gbar((unsigned*)(ws + WS_BAR), epoch, (unsigned)G, wv); rwkv_scan_phase(p, lds, wv);
#endif
        }
        else if (step == 5) { attention_phase(p, lds, wv);
#ifdef REP_ATT
            gbar((unsigned*)(ws + WS_BAR), epoch, (unsigned)G, wv); attention_phase(p, lds, wv);
#endif
            gmlp_phase(p, l, lds, wv);
#ifdef REP_GMLP
            gbar((unsigned*)(ws + WS_BAR), epoch, (unsigned)G, wv); gmlp_phase(p, l, lds, wv);
#endif
        }
        else if (step >= 6 && step <= 11) {
            const int br = (step - 6) >> 1;
            if (((step - 6) & 1) == 0) {
                E.mode = pg8::EM_GATE; E.o0 = (bf16_t*)(ws + WS_GATE);
                g.A = H; g.Bt = (const bf16_t*)(ws + WS_WIN) + (size_t)(4352 + 1024 * br) * 1024; g.lda = 1024; g.K = 1024;
            } else {
                E.mode = (br == 0) ? pg8::EM_BR_FIRST : (br == 1 ? pg8::EM_BR_MID : pg8::EM_BR_LAST); E.o0 = (bf16_t*)(ws + WS_GATE); E.o1 = (bf16_t*)(ws + WS_MB); E.f0 = (float*)(ws + WS_M32);
                g.A = (const bf16_t*)(ws + (br == 0 ? WS_YSA : (br == 1 ? WS_YSR : WS_YSG))); g.Bt = (const bf16_t*)(ws + WS_WBR) + (size_t)br * 1024 * 512; g.lda = 512; g.K = 512;
            }
            S.init(64, 4, G, c, 4, 0, 0);
            do_gemm = true; do_sync = (step == 11);
        } else if (step == 12) {
            E.mode = pg8::EM_RESID; E.f0 = p->out; E.f1 = xin; E.f2 = ml + 2048;
            g.A = (const bf16_t*)(ws + WS_MB); g.Bt = (const bf16_t*)(ws + WS_WOUT); g.lda = 1024; g.K = 1024;
            S.init(64, 4, G, c, 4, 0, 0); do_gemm = true;
        } else if (step == 13) { norm_mod_phase(p->out, p->in[23] + l * DM, ml + 3072, ml + 4096, (bf16_t*)(ws + WS_H), wv); }
        else if (step == 14) {
            E.mode = pg8::EM_UP; E.o0 = (bf16_t*)(ws + WS_UP);
            g.A = H; g.Bt = (const bf16_t*)(ws + WS_WUP); g.lda = 1024; g.K = 1024;
            S.init(64, 22, G, c, 22, 0, 0); do_gemm = true;
        } else if (step == 15) { ffn_conv_phase(p, l, wv); }
        else {
            E.mode = pg8::EM_RESID; E.f0 = p->out; E.f1 = p->out; E.f2 = ml + 5120;
            g.A = (const bf16_t*)(ws + WS_UP) + DFF; g.Bt = (const bf16_t*)(ws + WS_WDN); g.lda = UPC; g.K = DFF;
            S.init(64, 4, G, c, 4, 0, 0); do_gemm = true;
        }
        if (do_gemm) pg8::gemm_phase(lds, g, S, E, wv);
        if (do_sync) gbar((unsigned*)(ws + WS_BAR), epoch, (unsigned)G, wv);
#ifdef DBG_ST
        if (st == DBG_ST) {
            gbar((unsigned*)(ws + WS_BAR), epoch, (unsigned)G, wv);
#if DBG_KIND == 1
            { const bf16_t* sb = (const bf16_t*)(ws + DBG_BUF); for (size_t i = (size_t)blockIdx.x * 512 + otid(wv); i < (size_t)MTOK * DM; i += (size_t)gridDim.x * 512) p->out[i] = __uint_as_float(((unsigned)sb[i]) << 16); }
#elif DBG_KIND == 3
            { const bf16_t* sb = (const bf16_t*)(ws + DBG_BUF); for (size_t i = (size_t)blockIdx.x * 512 + otid(wv); i < (size_t)MTOK * DM; i += (size_t)gridDim.x * 512) p->out[i] = __uint_as_float(((unsigned)sb[i % DBG_N]) << 16); }
#elif DBG_KIND == 2
            { const float* sb = (const float*)(ws + DBG_BUF); for (size_t i = (size_t)blockIdx.x * 512 + otid(wv); i < (size_t)MTOK * DM; i += (size_t)gridDim.x * 512) p->out[i] = sb[i % DBG_N]; }
#endif
            return;
        }
#endif
    }
    p = okp();
    final_norm_phase(p->out, p->in[28], wv);
}

extern "C" void kernel_launch(void* const* d_in, const int* in_sizes, int n_in, void* d_out, int out_size, void* d_ws, size_t ws_size, hipStream_t stream) {
    static int grid_blocks = 0;
    if (grid_blocks == 0) {
        int dev = 0, cus = 0, per_cu = 0;
        hipGetDevice(&dev);
        hipDeviceGetAttribute(&cus, hipDeviceAttributeMultiprocessorCount, dev);
        if (hipFuncSetAttribute((const void*)fwd_megakernel, hipFuncAttributeMaxDynamicSharedMemorySize, LDS_BYTES) != hipSuccess) { fprintf(stderr, "hipFuncSetAttribute failed\n"); }
        hipOccupancyMaxActiveBlocksPerMultiprocessor(&per_cu, (const void*)fwd_megakernel, 512, LDS_BYTES);
        if (per_cu < 1) { fprintf(stderr, "occupancy query returned %d\n", per_cu); per_cu = 1; }
        if (per_cu > 1) per_cu = 1;
        grid_blocks = cus * per_cu;
        (void)hipGetLastError();
    }
    if (n_in != 29 || ws_size < 256 * MiB) { fprintf(stderr, "unexpected inputs/workspace\n"); return; }
    (void)hipMemsetAsync((unsigned char*)d_ws + WS_BAR, 0, 256, stream);
    Params p{};
    for (int i = 0; i < 29; ++i) p.in[i] = (const float*)d_in[i];
    p.out = (float*)d_out; p.ws = (unsigned char*)d_ws;
    void* args[] = {&p};
    hipError_t e = hipLaunchCooperativeKernel((const void*)fwd_megakernel, dim3(grid_blocks), dim3(512), args, LDS_BYTES, stream);
    if (e != hipSuccess) fprintf(stderr, "cooperative launch failed: %s (grid %d)\n", hipGetErrorString(e), grid_blocks);
}
```

```cpp
#include <hip/hip_runtime.h>
#include <hip/hip_cooperative_groups.h>
#include <cstdio>
#include <cstdint>
namespace cg = cooperative_groups;

#define LAS __attribute__((address_space(3)))
#define DI __device__ __forceinline__
typedef unsigned short bf16_t;
typedef short bf16x8 __attribute__((ext_vector_type(8)));
typedef float f32x4 __attribute__((ext_vector_type(4)));
typedef float f32x16 __attribute__((ext_vector_type(16)));
typedef unsigned u32x4 __attribute__((ext_vector_type(4)));
typedef unsigned u32x2 __attribute__((ext_vector_type(2)));

constexpr int DM = 1024, SEQ = 4096, MTOK = 16384, INC = 7424, DFF = 2816, UPC = 5632, RAWC = 1792;
constexpr int LDS_BYTES = 147456;
constexpr size_t MiB = 1048576;
constexpr size_t WS_WIN = 0, WS_WBR = WS_WIN + (size_t)INC * 1024 * 2, WS_WOUT = WS_WBR + 3u * 1024 * 512 * 2, WS_WUP = WS_WOUT + 1024u * 1024 * 2,
                 WS_WDN = WS_WUP + (size_t)UPC * 1024 * 2, WS_LWU = WS_WDN + (size_t)DFF * 1024 * 2, WS_LAU = WS_LWU + 65536, WS_LGU = WS_LAU + 65536;
constexpr size_t WS_H = 37 * MiB;
constexpr size_t WS_SMALL = 69 * MiB, WS_MOD = WS_SMALL, WS_ROPEC = WS_MOD + 262144, WS_ROPES = WS_ROPEC + 524288, WS_BONUS = WS_ROPES + 524288, WS_LSE = WS_BONUS + 524288;
constexpr size_t WS_BAR = WS_LSE + 524288;
constexpr size_t DB = 72 * MiB;
constexpr size_t WS_RAW = DB, WS_RZ = DB + 56 * MiB, WS_KP = DB + 72 * MiB, WS_KKN = DB + 88 * MiB, WS_B = DB + 104 * MiB, WS_W = DB + 120 * MiB, WS_VZ = DB + 152 * MiB, WS_G = DB + 168 * MiB;
constexpr size_t WS_YRAW = DB, WS_YSR = DB + 32 * MiB;
constexpr size_t WS_Q = DB + 56 * MiB, WS_K = DB + 72 * MiB, WS_V = DB + 88 * MiB, WS_UV = DB + 104 * MiB;
constexpr size_t WS_YSA = DB + 152 * MiB, WS_YSG = DB + 168 * MiB;
constexpr size_t WS_GATE = DB, WS_M32 = DB + 48 * MiB, WS_MB = DB + 112 * MiB;
constexpr size_t WS_UP = DB;
static_assert(WS_LGU + 131072 <= WS_H, "weights region overflow");
static_assert(WS_BAR + 256 <= DB, "small region overflow");

struct Params {
    const float* in[29];
    float* out;
    unsigned char* ws;
};

typedef const __attribute__((address_space(4))) Params* KP;
DI KP okp() { unsigned long long k = (unsigned long long)__builtin_amdgcn_kernarg_segment_ptr(); asm volatile("" : "+s"(k)); return (KP)k; }
typedef float f32x2_t __attribute__((ext_vector_type(2)));
typedef __bf16 bf16x2_t __attribute__((ext_vector_type(2)));
DI unsigned cvt_pk_bf16(float lo, float hi) { const f32x2_t v = {lo, hi}; const bf16x2_t r = __builtin_convertvector(v, bf16x2_t); return __builtin_bit_cast(unsigned, r); }
DI float bf_lo(unsigned w) { return __uint_as_float(w << 16); }
DI float bf_hi(unsigned w) { return __uint_as_float(w & 0xffff0000u); }
DI int otid(int wv) { int ln; asm volatile("v_mbcnt_lo_u32_b32 %0, -1, 0\n\tv_mbcnt_hi_u32_b32 %0, -1, %0" : "=v"(ln)); return wv * 64 + ln; }
DI unsigned char* ows(unsigned char* w) { asm volatile("" : "+s"(w)); return w; }
DI float row16_sum(float v) {
    v += __builtin_bit_cast(float, __builtin_amdgcn_update_dpp(0, __builtin_bit_cast(int, v), 0xB1, 0xF, 0xF, false));
    v += __builtin_bit_cast(float, __builtin_amdgcn_update_dpp(0, __builtin_bit_cast(int, v), 0x4E, 0xF, 0xF, false));
    v += __builtin_bit_cast(float, __builtin_amdgcn_update_dpp(0, __builtin_bit_cast(int, v), 0x141, 0xF, 0xF, false));
    v += __builtin_bit_cast(float, __builtin_amdgcn_update_dpp(0, __builtin_bit_cast(int, v), 0x140, 0xF, 0xF, false));
    return v;
}
DI float wave_sum(float v) { v = row16_sum(v); v += __shfl_xor(v, 16); v += __shfl_xor(v, 32); return v; }
DI void gbar(unsigned* ctr, unsigned& epoch, unsigned nblocks, int wv) {
    asm volatile("s_waitcnt vmcnt(0) lgkmcnt(0)" ::: "memory");
    __syncthreads();
    epoch += nblocks;
    if (otid(wv) == 0) {
        __builtin_amdgcn_fence(__ATOMIC_RELEASE, "agent");
        asm volatile("s_waitcnt vmcnt(0)" ::: "memory");
        __hip_atomic_fetch_add(ctr, 1u, __ATOMIC_RELAXED, __HIP_MEMORY_SCOPE_AGENT);
        while (__hip_atomic_load(ctr, __ATOMIC_RELAXED, __HIP_MEMORY_SCOPE_AGENT) < epoch) __builtin_amdgcn_s_sleep(2);
        __builtin_amdgcn_fence(__ATOMIC_ACQUIRE, "agent");
        asm volatile("s_waitcnt vmcnt(0)" ::: "memory");
    }
    asm volatile("" ::: "memory");
    __syncthreads();
}
DI float sigmoidf_(float x) { return __builtin_amdgcn_rcpf(1.0f + __expf(-x)); }
DI float gelu_tanh(float x) { const float u = 1.5957691216f * (x + 0.044715f * x * x * x); return x * __builtin_amdgcn_rcpf(1.0f + __expf(-u)); }
#define LDS_WAIT() asm volatile("s_waitcnt lgkmcnt(0)" ::: "memory")
#define MFMA32(a, b, c) __builtin_amdgcn_mfma_f32_32x32x16_bf16((a), (b), (c), 0, 0, 0)
DI int crow(int reg, int h) { return (reg & 3) + 8 * (reg >> 2) + 4 * h; }
DI bf16x8 pack8(float a0, float a1, float a2, float a3, float a4, float a5, float a6, float a7) {
    u32x4 p; p.x = cvt_pk_bf16(a0, a1); p.y = cvt_pk_bf16(a2, a3); p.z = cvt_pk_bf16(a4, a5); p.w = cvt_pk_bf16(a6, a7);
    return __builtin_bit_cast(bf16x8, p);
}

namespace pg8 {
constexpr int BM = 256, BK = 64, HALF = 128, HTB = HALF * BK * 2, STAGE_BYTES = 8 * HTB, NXCD = 8, WGM = 8;
DI int lds_byte(int r, int c) { const int st = (r >> 4) * 2 + (c >> 5), rr = r & 15, cc = c & 31, ob = rr * 64 + cc * 2; return st * 1024 + (ob ^ (((ob >> 9) & 1) << 5)); }
DI void stage_rc(int b, int& R, int& C) { const int st = b / 1024, sb = b % 1024, swz = sb ^ (((sb >> 9) & 1) << 5); R = (st >> 1) * 16 + swz / 64; C = (st & 1) * 32 + (swz % 64) / 2; }
DI int perm32(int rho) { const int n = rho >> 4, i = rho & 15; return 8 * (i >> 2) + 4 * n + (i & 3); }
struct Unit { int pm, pn; };
struct Gemm { const bf16_t* A; const bf16_t* Bt; int lda, K; };
struct TileOrder {
    int nM, nN, nwg, G, c, split, off0, off1;
    DI void init(int nM_, int nN_, int G_, int c_, int split_, int off0_, int off1_) { nM = nM_; nN = nN_; nwg = nM * nN; G = G_; c = c_; split = split_; off0 = off0_; off1 = off1_; }
    DI bool next(int i, Unit& u) const {
        const long L = (long)i * G + c; if (L >= nwg) return false;
        int wgid = (int)L; { const int q = nwg / NXCD, r = nwg % NXCD, xcd = wgid % NXCD, off = wgid / NXCD; wgid = (xcd < r ? xcd * (q + 1) : r * (q + 1) + (xcd - r) * q) + off; }
        const int nig = WGM * nN, gid = wgid / nig, fm = gid * WGM, gsz = (nM - fm) < WGM ? (nM - fm) : WGM;
        u.pm = fm + ((wgid % nig) % gsz); const int pnv = (wgid % nig) / gsz; u.pn = pnv < split ? pnv + off0 : pnv - split + off1; return true;
    }
};

enum { EM_INPROJ = 0, EM_GATE = 1, EM_BR_FIRST = 2, EM_BR_MID = 3, EM_BR_LAST = 4, EM_RESID = 5, EM_UP = 6 };
struct Epi {
    int mode;
    bf16_t *o0, *o1, *o2, *o3, *o4;
    float* f0; const float* f1; const float* f2;
    const float *ropec, *ropes;
    DI void operator()(const f32x4 (&acc)[2][2][4][2], const Unit& u, int wr, int wc, int fr, int fq) const {
        const int row0 = u.pm * BM + wr * 64 + fr, colb = u.pn * BM + wc * 32 + 8 * fq;
#pragma unroll
        for (int ai = 0; ai < 2; ++ai)
#pragma unroll
            for (int m = 0; m < 4; ++m) {
                const int row = row0 + ai * HALF + m * 16;
#pragma unroll
                for (int bj = 0; bj < 2; ++bj) {
                    const int col0 = colb + bj * HALF;
                    f32x4 v0 = acc[ai][bj][m][0], v1 = acc[ai][bj][m][1];
                    if (mode == EM_INPROJ) {
                        bf16_t* dst;
                        if (u.pn < 4) {
                            const int pos = row & (SEQ - 1), e0 = (col0 & 63) >> 1;
                            const f32x4 cs = *(const f32x4*)(ropec + pos * 32 + e0), sn = *(const f32x4*)(ropes + pos * 32 + e0);
                            f32x4 a, b;
                            a[0] = v0[0] * cs[0] - v0[1] * sn[0]; a[1] = v0[1] * cs[0] + v0[0] * sn[0];
                            a[2] = v0[2] * cs[1] - v0[3] * sn[1]; a[3] = v0[3] * cs[1] + v0[2] * sn[1];
                            b[0] = v1[0] * cs[2] - v1[1] * sn[2]; b[1] = v1[1] * cs[2] + v1[0] * sn[2];
                            b[2] = v1[2] * cs[3] - v1[3] * sn[3]; b[3] = v1[3] * cs[3] + v1[2] * sn[3];
                            v0 = a; v1 = b;
                            dst = (u.pn < 2) ? o0 + (size_t)row * 512 + col0 : o1 + (size_t)row * 512 + (col0 - 512);
                        } else if (u.pn < 6) { dst = o2 + (size_t)row * 512 + (col0 - 1024); }
                        else if (u.pn < 13) { dst = o3 + (size_t)row * RAWC + (col0 - 1536); }
                        else {
#pragma unroll
                            for (int j = 0; j < 4; ++j) { v0[j] = gelu_tanh(v0[j]); v1[j] = gelu_tanh(v1[j]); }
                            dst = o4 + (size_t)row * 1024 + (col0 - 3328);
                        }
                        u32x4 w; w.x = cvt_pk_bf16(v0[0], v0[1]); w.y = cvt_pk_bf16(v0[2], v0[3]); w.z = cvt_pk_bf16(v1[0], v1[1]); w.w = cvt_pk_bf16(v1[2], v1[3]);
                        *(u32x4*)dst = w;
                    } else if (mode == EM_GATE) {
#pragma unroll
                        for (int j = 0; j < 4; ++j) { v0[j] = sigmoidf_(v0[j]); v1[j] = sigmoidf_(v1[j]); }
                        u32x4 w; w.x = cvt_pk_bf16(v0[0], v0[1]); w.y = cvt_pk_bf16(v0[2], v0[3]); w.z = cvt_pk_bf16(v1[0], v1[1]); w.w = cvt_pk_bf16(v1[2], v1[3]);
                        *(u32x4*)(o0 + (size_t)row * 1024 + col0) = w;
                    } else if (mode == EM_UP) {
                        u32x4 w; w.x = cvt_pk_bf16(v0[0], v0[1]); w.y = cvt_pk_bf16(v0[2], v0[3]); w.z = cvt_pk_bf16(v1[0], v1[1]); w.w = cvt_pk_bf16(v1[2], v1[3]);
                        *(u32x4*)(o0 + (size_t)row * UPC + col0) = w;
                    } else if (mode == EM_RESID) {
                        const size_t off = (size_t)row * 1024 + col0;
                        const float* gv = f2 + (size_t)(row >> 12) * 6144 + col0;
                        const f32x4 g0 = *(const f32x4*)gv, g1 = *(const f32x4*)(gv + 4);
                        const f32x4 b0 = *(const f32x4*)(f1 + off), b1 = *(const f32x4*)(f1 + off + 4);
                        *(f32x4*)(f0 + off) = b0 + g0 * v0; *(f32x4*)(f0 + off + 4) = b1 + g1 * v1;
                    } else {
                        const size_t off = (size_t)row * 1024 + col0;
                        const u32x4 gw = *(const u32x4*)(o0 + off);
                        f32x4 r0, r1;
                        r0[0] = bf_lo(gw.x) * v0[0]; r0[1] = bf_hi(gw.x) * v0[1]; r0[2] = bf_lo(gw.y) * v0[2]; r0[3] = bf_hi(gw.y) * v0[3];
                        r1[0] = bf_lo(gw.z) * v1[0]; r1[1] = bf_hi(gw.z) * v1[1]; r1[2] = bf_lo(gw.w) * v1[2]; r1[3] = bf_hi(gw.w) * v1[3];
                        if (mode != EM_BR_FIRST) { r0 += *(const f32x4*)(f0 + off); r1 += *(const f32x4*)(f0 + off + 4); }
                        if (mode == EM_BR_LAST) {
                            u32x4 w; w.x = cvt_pk_bf16(r0[0], r0[1]); w.y = cvt_pk_bf16(r0[2], r0[3]); w.z = cvt_pk_bf16(r1[0], r1[1]); w.w = cvt_pk_bf16(r1[2], r1[3]);
                            *(u32x4*)(o1 + off) = w;
                        } else { *(f32x4*)(f0 + off) = r0; *(f32x4*)(f0 + off + 4) = r1; }
                    }
                }
            }
    }
};

DI void gemm_phase(LAS unsigned char* lds, const Gemm g, const TileOrder S, const Epi E, int wv) {
    const int tid = otid(wv), wid = __builtin_amdgcn_readfirstlane(tid >> 6), lane = tid & 63, wr = wid >> 2, wc = wid & 3, fr = lane & 15, fq = lane >> 4;
    const int K = g.K, nt = K / BK, lda = g.lda;
    unsigned voffA[2], voffB[2];
#pragma unroll
    for (int i = 0; i < 2; ++i) { int R, C; stage_rc(tid * 16 + i * 8192, R, C); const int Rb = (R & ~31) + perm32(R & 31);
        voffA[i] = (unsigned)(R * lda + C) * 2u; voffB[i] = (unsigned)(Rb * K + C) * 2u; }
    const size_t kstep = (size_t)(BK * 2);
    const size_t hstepA = (size_t)HALF * lda * 2, hstepB = (size_t)HALF * K * 2;
    const size_t tstepA = 2 * hstepA, tstepB = 2 * hstepB;
    const unsigned ldsw = (unsigned)wid * 1024u;
    const int aoff = lds_byte(wr * 64 + fr, fq * 8), boff = lds_byte(wc * 32 + fr, fq * 8);
#define PG8_SA(b, h) (((b) * 2 + (h)) * HTB)
#define PG8_SB(b, h) ((4 + (b) * 2 + (h)) * HTB)
#define PG8_STAGE(bufoff, gbase, voff) do { _Pragma("unroll") for (int _i = 0; _i < 2; ++_i) \
        __builtin_amdgcn_global_load_lds((const unsigned*)((const char*)(gbase) + (voff)[_i]), (LAS unsigned*)(lds + (bufoff) + ldsw + _i * 8192), 16, 0, 0); } while (0)
#define PG8_LDA(dst, b, h) do { _Pragma("unroll") for (int m = 0; m < 4; ++m) _Pragma("unroll") for (int k = 0; k < 2; ++k) dst[m][k] = *(const LAS bf16x8*)(lds + PG8_SA(b, h) + aoff + m * 2048 + k * 1024); } while (0)
#define PG8_LDB(dst, b, h) do { _Pragma("unroll") for (int n = 0; n < 2; ++n) _Pragma("unroll") for (int k = 0; k < 2; ++k) dst[n][k] = *(const LAS bf16x8*)(lds + PG8_SB(b, h) + boff + n * 2048 + k * 1024); } while (0)
#define PG8_MMA(ai, bj, At, Bt) do { __builtin_amdgcn_s_setprio(1); _Pragma("unroll") for (int m = 0; m < 4; ++m) _Pragma("unroll") for (int n = 0; n < 2; ++n) _Pragma("unroll") for (int k = 0; k < 2; ++k) \
        acc[ai][bj][m][n] = __builtin_amdgcn_mfma_f32_16x16x32_bf16(Bt[n][k], At[m][k], acc[ai][bj][m][n], 0, 0, 0); __builtin_amdgcn_s_setprio(0); } while (0)
#define PG8_WAIT_V(n) asm volatile("s_waitcnt vmcnt(" #n ")" ::: "memory")
#define PG8_WAIT_L(n) asm volatile("s_waitcnt lgkmcnt(" #n ")" ::: "memory")
#define PG8_BAR __builtin_amdgcn_s_barrier()
#define PG8_SCHED __builtin_amdgcn_sched_barrier(0)
    Unit cur, nxt; int ui = 0;
    if (!S.next(0, cur)) return;
    f32x4 acc[2][2][4][2];
#pragma unroll
    for (int a = 0; a < 2; ++a)
#pragma unroll
        for (int b = 0; b < 2; ++b)
#pragma unroll
            for (int m = 0; m < 4; ++m)
#pragma unroll
                for (int n = 0; n < 2; ++n) acc[a][b][m][n] = (f32x4){0.f, 0.f, 0.f, 0.f};
    bf16x8 At[4][2], B0[2][2], B1[2][2];
    const char* cA = (const char*)g.A + (size_t)cur.pm * tstepA; const char* cB = (const char*)g.Bt + (size_t)cur.pn * tstepB;
    PG8_STAGE(PG8_SB(0, 0), cB, voffB); PG8_STAGE(PG8_SA(0, 0), cA, voffA); PG8_STAGE(PG8_SB(0, 1), cB + hstepB, voffB); PG8_STAGE(PG8_SA(0, 1), cA + hstepA, voffA);
    if (wr == 1) PG8_BAR;
    PG8_WAIT_V(4); PG8_BAR;
    PG8_STAGE(PG8_SB(1, 0), cB + kstep, voffB); PG8_STAGE(PG8_SA(1, 0), cA + kstep, voffA); PG8_STAGE(PG8_SB(1, 1), cB + hstepB + kstep, voffB);
    PG8_WAIT_V(6); PG8_BAR;
    for (;;) {
        const bool has_next = S.next(ui + 1, nxt);
        const char* nA = has_next ? (const char*)g.A + (size_t)nxt.pm * tstepA : cA; const char* nB = has_next ? (const char*)g.Bt + (size_t)nxt.pn * tstepB : cB;
        for (int t = 0; t < nt; t += 2) {
            const bool last = (t == nt - 2);
            const char* a1 = cA + (size_t)(t + 1) * kstep;
            const char* a2 = last ? nA : cA + (size_t)(t + 2) * kstep; const char* b2 = last ? nB : cB + (size_t)(t + 2) * kstep;
            const char* a3 = a2 + kstep; const char* b3 = b2 + kstep;
            PG8_LDB(B0, 0, 0); PG8_SCHED; PG8_LDA(At, 0, 0); PG8_STAGE(PG8_SA(1, 1), a1 + hstepA, voffA);
            PG8_WAIT_L(8); PG8_BAR; PG8_WAIT_L(0); PG8_MMA(0, 0, At, B0); PG8_BAR; PG8_SCHED;
            PG8_LDB(B1, 0, 1); PG8_STAGE(PG8_SB(0, 0), b2, voffB);
            PG8_BAR; PG8_WAIT_L(0); PG8_MMA(0, 1, At, B1); PG8_BAR;
            PG8_LDA(At, 0, 1); PG8_STAGE(PG8_SA(0, 0), a2, voffA);
            PG8_BAR; PG8_WAIT_L(0); PG8_MMA(1, 0, At, B0); PG8_BAR; PG8_SCHED;
            PG8_STAGE(PG8_SB(0, 1), b2 + hstepB, voffB);
            PG8_WAIT_V(6); PG8_BAR; PG8_MMA(1, 1, At, B1); PG8_BAR;
            PG8_LDB(B0, 1, 0); PG8_SCHED; PG8_LDA(At, 1, 0); PG8_STAGE(PG8_SA(0, 1), a2 + hstepA, voffA);
            PG8_WAIT_L(8); PG8_BAR; PG8_WAIT_L(0); PG8_MMA(0, 0, At, B0); PG8_BAR; PG8_SCHED;
            PG8_LDB(B1, 1, 1); PG8_STAGE(PG8_SB(1, 0), b3, voffB);
            PG8_BAR; PG8_WAIT_L(0); PG8_MMA(0, 1, At, B1); PG8_BAR;
            PG8_LDA(At, 1, 1); PG8_STAGE(PG8_SA(1, 0), a3, voffA);
            PG8_BAR; PG8_WAIT_L(0); PG8_MMA(1, 0, At, B0); PG8_BAR; PG8_SCHED;
            PG8_STAGE(PG8_SB(1, 1), b3 + hstepB, voffB);
            PG8_WAIT_V(6); PG8_BAR; PG8_MMA(1, 1, At, B1); PG8_BAR;
        }
        E(acc, cur, wr, wc, fr, fq);
        if (!has_next) break;
#pragma unroll
        for (int a = 0; a < 2; ++a)
#pragma unroll
            for (int b = 0; b < 2; ++b)
#pragma unroll
                for (int m = 0; m < 4; ++m)
#pragma unroll
                    for (int n = 0; n < 2; ++n) acc[a][b][m][n] = (f32x4){0.f, 0.f, 0.f, 0.f};
        cur = nxt; cA = nA; cB = nB; ++ui;
    }
    PG8_WAIT_V(0);
    if (wr == 0) PG8_BAR;
    PG8_BAR;
#undef PG8_SA
#undef PG8_SB
#undef PG8_STAGE
#undef PG8_LDA
#undef PG8_LDB
#undef PG8_MMA
#undef PG8_WAIT_V
#undef PG8_WAIT_L
#undef PG8_BAR
#undef PG8_SCHED
}
}

template <bool QKPERM>
DI void transpose_item(const float* W, int K, int N, bf16_t* WT, LAS float* scr, int item, int lane) {
    const int nblk = N / 32, kb = item / nblk, nb = item % nblk, k0 = 64 * kb, n0 = 32 * nb;
    int sc = n0 + (lane & 31);
    if (QKPERM && sc < 1024) { const int hd = sc >> 6, cp = sc & 63; sc = hd * 64 + 32 * (cp & 1) + (cp >> 1); }
#pragma unroll 8
    for (int i = 0; i < 32; ++i) { const int kk = 2 * i + (lane >> 5); scr[kk * 33 + (lane & 31)] = W[(size_t)(k0 + kk) * N + sc]; }
    LDS_WAIT();
    const int c = lane & 7;
#pragma unroll
    for (int j = 0; j < 4; ++j) { const int n = (lane >> 3) + 8 * j; const LAS float* s = scr + (8 * c) * 33 + n;
        u32x4 o; o.x = cvt_pk_bf16(s[0 * 33], s[1 * 33]); o.y = cvt_pk_bf16(s[2 * 33], s[3 * 33]); o.z = cvt_pk_bf16(s[4 * 33], s[5 * 33]); o.w = cvt_pk_bf16(s[6 * 33], s[7 * 33]);
        *(u32x4*)(WT + (size_t)(n0 + n) * K + k0 + 8 * c) = o; }
    LDS_WAIT();
}

DI void convert_weights(KP p, int l, LAS unsigned char* lds, int wv) {
    const int tid_ = otid(wv); const int wave = tid_ >> 6, lane = tid_ & 63;
    LAS float* scr = (LAS float*)(lds + wave * 8448);
    const int gw = blockIdx.x * 8 + wave, NGW = gridDim.x * 8;
    constexpr int I_IN = 16 * (INC / 32), I_BR = 8 * 32, I_OUT = 16 * 32, I_UP = 16 * (UPC / 32), I_DN = (DFF / 64) * 32, I_L64 = 16, I_L128 = 32;
    constexpr int NIT = I_IN + 3 * I_BR + I_OUT + I_UP + I_DN + 2 * I_L64 + I_L128;
    unsigned char* ws = ows(p->ws);
    for (int it = gw; it < NIT; it += NGW) {
        int r = it;
        if (r < I_IN) { transpose_item<true>(p->in[5] + (size_t)l * 1024 * INC, 1024, INC, (bf16_t*)(ws + WS_WIN), scr, r, lane); continue; } r -= I_IN;
        if (r < 3 * I_BR) { const int b = r / I_BR; transpose_item<false>(p->in[21] + ((size_t)l * 3 + b) * 512 * 1024, 512, 1024, (bf16_t*)(ws + WS_WBR) + (size_t)b * 1024 * 512, scr, r % I_BR, lane); continue; } r -= 3 * I_BR;
        if (r < I_OUT) { transpose_item<false>(p->in[22] + (size_t)l * 1024 * 1024, 1024, 1024, (bf16_t*)(ws + WS_WOUT), scr, r, lane); continue; } r -= I_OUT;
        if (r < I_UP) { transpose_item<false>(p->in[24] + (size_t)l * 1024 * UPC, 1024, UPC, (bf16_t*)(ws + WS_WUP), scr, r, lane); continue; } r -= I_UP;
        if (r < I_DN) { transpose_item<false>(p->in[27] + (size_t)l * DFF * 1024, DFF, 1024, (bf16_t*)(ws + WS_WDN), scr, r, lane); continue; } r -= I_DN;
        if (r < I_L64) { transpose_item<false>(p->in[8] + (size_t)l * 64 * 512, 64, 512, (bf16_t*)(ws + WS_LWU), scr, r, lane); continue; } r -= I_L64;
        if (r < I_L64) { transpose_item<false>(p->in[10] + (size_t)l * 64 * 512, 64, 512, (bf16_t*)(ws + WS_LAU), scr, r, lane); continue; } r -= I_L64;
        transpose_item<false>(p->in[11] + (size_t)l * 128 * 512, 128, 512, (bf16_t*)(ws + WS_LGU), scr, r, lane);
    }
}

DI void phase0(KP p, LAS unsigned char* lds, int wv) {
    const int tid = otid(wv);
    float* ropec = (float*)(p->ws + WS_ROPEC); float* ropes = (float*)(p->ws + WS_ROPES);
    for (int idx = blockIdx.x * 512 + tid; idx < SEQ * 32; idx += gridDim.x * 512) {
        const int pos = idx >> 5, e = idx & 31;
        const float inv = 1.0f / exp2f((float)e * (13.287712379549449f / 32.0f));
        const float ang = (float)pos * inv;
        double rev = (double)ang * 0.15915494309189535; rev -= rint(rev);
        const float rv = (float)rev;
        ropec[idx] = __builtin_amdgcn_cosf(rv); ropes[idx] = __builtin_amdgcn_sinf(rv);
    }
    {
        LAS float* ca = (LAS float*)lds;
        LAS float* red = (LAS float*)(lds + 16384);
        float* mod = (float*)(p->ws + WS_MOD);
        bool loaded = false;
        for (int item = blockIdx.x; item < 192; item += gridDim.x) {
            if (!loaded) { for (int i = tid; i < 4096; i += 512) { const float v = p->in[1][i]; ca[i] = v / (1.0f + __expf(-v)); } loaded = true; __syncthreads(); }
            const int l = item / 96, c0 = (item % 96) * 64, cc = tid & 63, kg = tid >> 6;
            const float* w = p->in[2] + (size_t)l * 1024 * 6144 + c0 + cc;
            float a0 = 0.f, a1 = 0.f, a2 = 0.f, a3 = 0.f;
#pragma unroll 8
            for (int k = kg * 128; k < kg * 128 + 128; ++k) { const float wv = w[(size_t)k * 6144]; a0 += ca[k] * wv; a1 += ca[1024 + k] * wv; a2 += ca[2048 + k] * wv; a3 += ca[3072 + k] * wv; }
            red[(kg * 4 + 0) * 64 + cc] = a0; red[(kg * 4 + 1) * 64 + cc] = a1; red[(kg * 4 + 2) * 64 + cc] = a2; red[(kg * 4 + 3) * 64 + cc] = a3;
            __syncthreads();
            if (tid < 256) { const int b = tid >> 6; float s = 0.f;
#pragma unroll
                for (int g = 0; g < 8; ++g) s += red[(g * 4 + b) * 64 + cc];
                mod[((size_t)l * 4 + b) * 6144 + c0 + cc] = s + p->in[3][(size_t)l * 6144 + c0 + cc]; }
            __syncthreads();
        }
        __syncthreads();
    }
    convert_weights(p, 0, lds, wv);
}

DI void norm_mod_phase(const float* x, const float* g, const float* sh, const float* sc, bf16_t* H, int wv) {
    const int tid_ = otid(wv); const int wave = tid_ >> 6, lane = tid_ & 63;
    for (int row0 = (blockIdx.x * 8 + wave) * 2; row0 < MTOK; row0 += gridDim.x * 16) {
        f32x4 v[2][4]; float s[2] = {0.f, 0.f};
#pragma unroll
        for (int q = 0; q < 2; ++q) { const f32x4* xr = (const f32x4*)(x + (size_t)(row0 + q) * DM) + lane;
#pragma unroll
            for (int j = 0; j < 4; ++j) v[q][j] = xr[64 * j]; }
#pragma unroll
        for (int q = 0; q < 2; ++q)
#pragma unroll
            for (int j = 0; j < 4; ++j) s[q] += (v[q][j][0] * v[q][j][0] + v[q][j][1] * v[q][j][1]) + (v[q][j][2] * v[q][j][2] + v[q][j][3] * v[q][j][3]);
        const float rs0 = rsqrtf(wave_sum(s[0]) * (1.0f / DM) + 1e-6f), rs1 = rsqrtf(wave_sum(s[1]) * (1.0f / DM) + 1e-6f);
        const int b = row0 >> 12;
#pragma unroll
        for (int j = 0; j < 4; ++j) {
            const int c = 4 * lane + 256 * j;
            const f32x4 gg = *(const f32x4*)(g + c), s1 = *(const f32x4*)(sc + (size_t)b * 6144 + c), s0 = *(const f32x4*)(sh + (size_t)b * 6144 + c);
#pragma unroll
            for (int q = 0; q < 2; ++q) {
                const f32x4 h = (v[q][j] * (q ? rs1 : rs0) * gg) * (s1 + 1.0f) + s0;
                u32x2 w; w.x = cvt_pk_bf16(h[0], h[1]); w.y = cvt_pk_bf16(h[2], h[3]);
                *((u32x2*)(H + (size_t)(row0 + q) * DM) + lane + 64 * j) = w;
            }
        }
    }
}
DI void final_norm_phase(float* x, const float* g, int wv) {
    const int tid_ = otid(wv); const int wave = tid_ >> 6, lane = tid_ & 63;
    for (int row = blockIdx.x * 8 + wave; row < MTOK; row += gridDim.x * 8) {
        f32x4* xr = (f32x4*)(x + (size_t)row * DM) + lane;
        f32x4 v[4]; float s = 0.f;
#pragma unroll
        for (int j = 0; j < 4; ++j) { v[j] = xr[64 * j]; s += (v[j][0] * v[j][0] + v[j][1] * v[j][1]) + (v[j][2] * v[j][2] + v[j][3] * v[j][3]); }
        const float rs = rsqrtf(wave_sum(s) * (1.0f / DM) + 1e-6f);
#pragma unroll
        for (int j = 0; j < 4; ++j) { const f32x4 gg = *(const f32x4*)(g + 4 * lane + 256 * j); xr[64 * j] = v[j] * rs * gg; }
    }
}

DI bf16x8 lerp_frag(const bf16_t* cur, const bf16_t* prv, bool hasprev, const float* mu, int act) {
    const u32x4 c = *(const u32x4*)cur; u32x4 q = {0u, 0u, 0u, 0u}; if (hasprev) q = *(const u32x4*)prv;
    const f32x4 m0 = *(const f32x4*)mu, m1 = *(const f32x4*)(mu + 4);
    float z[8];
    const unsigned cw[4] = {c.x, c.y, c.z, c.w}, qw[4] = {q.x, q.y, q.z, q.w};
#pragma unroll
    for (int j = 0; j < 4; ++j) {
        const float c0 = bf_lo(cw[j]), c1 = bf_hi(cw[j]), p0 = bf_lo(qw[j]), p1 = bf_hi(qw[j]);
        const float mA = (j < 2) ? m0[2 * j] : m1[2 * j - 4], mB = (j < 2) ? m0[2 * j + 1] : m1[2 * j - 3];
        z[2 * j] = c0 + (p0 - c0) * mA; z[2 * j + 1] = c1 + (p1 - c1) * mB;
    }
#pragma unroll
    for (int j = 0; j < 8; ++j) {
        if (act == 1) { const float e = __expf(2.0f * z[j]); z[j] = 1.0f - 2.0f / (1.0f + e); }
        else if (act == 2) z[j] = sigmoidf_(z[j]);
    }
    return pack8(z[0], z[1], z[2], z[3], z[4], z[5], z[6], z[7]);
}

DI void rwkv_derived_phase(KP p0, int l, int wv) {
    const int tid_ = otid(wv); const int wave = tid_ >> 6, lane = tid_ & 63, r = lane & 31, hh = lane >> 5;
    for (int job = blockIdx.x * 8 + wave; job < 512 * 8; job += gridDim.x * 8) {
        KP p = okp(); unsigned char* ws = ows(p->ws);
        const bf16_t* RAW = (const bf16_t*)(ws + WS_RAW);
        bf16_t *RZ = (bf16_t*)(ws + WS_RZ), *KP = (bf16_t*)(ws + WS_KP), *VZ = (bf16_t*)(ws + WS_VZ), *KKN = (bf16_t*)(ws + WS_KKN), *Bv = (bf16_t*)(ws + WS_B), *G = (bf16_t*)(ws + WS_G);
        float* W = (float*)(ws + WS_W);
        const bf16_t *LWU = (const bf16_t*)(ws + WS_LWU), *LAU = (const bf16_t*)(ws + WS_LAU), *LGU = (const bf16_t*)(ws + WS_LGU);
        const float* mu = p->in[6] + (size_t)l * RAWC; const float* w0 = p->in[7] + l * 512; const float* a0 = p->in[9] + l * 512;
        const float* k_k = p->in[12] + l * 512; const float* k_a = p->in[13] + l * 512; const float* r_k = p->in[14] + l * 512;
        const int hd = job & 7, tg = job >> 3, t = tg * 32 + r;
        const bool hp = (t & (SEQ - 1)) != 0;
        const bf16_t* cur = RAW + (size_t)t * RAWC; const bf16_t* prv = cur - RAWC;
        float ss = 0.f;
#pragma unroll
        for (int q = 0; q < 8; ++q) {
            const int c = hd * 64 + 8 * q + 4 * hh;
            const u32x2 kc = *(const u32x2*)(cur + 512 + c); u32x2 kq = {0u, 0u}; if (hp) kq = *(const u32x2*)(prv + 512 + c);
            const f32x4 mk = *(const f32x4*)(mu + 512 + c), kkw = *(const f32x4*)(k_k + c);
            const float kcur[4] = {bf_lo(kc.x), bf_hi(kc.x), bf_lo(kc.y), bf_hi(kc.y)}, kprv[4] = {bf_lo(kq.x), bf_hi(kq.x), bf_lo(kq.y), bf_hi(kq.y)};
#pragma unroll
            for (int j = 0; j < 4; ++j) { const float kk = (kcur[j] + (kprv[j] - kcur[j]) * mk[j]) * kkw[j]; ss += kk * kk; }
        }
        ss += __shfl_xor(ss, 32);
        const float inv = 1.0f / fmaxf(sqrtf(ss), 1e-12f);
        float bonus = 0.f;
        {
            bf16x8 bw[4], ba[4];
#pragma unroll
            for (int s = 0; s < 4; ++s) { const int o = 16 * s + 8 * hh; bw[s] = lerp_frag(cur + 1536 + o, prv + 1536 + o, hp, mu + 1536 + o, 1); ba[s] = lerp_frag(cur + 1600 + o, prv + 1600 + o, hp, mu + 1600 + o, 0); }
#pragma unroll 1
            for (int mt = 0; mt < 2; ++mt) {
                const int chr = hd * 64 + 32 * mt + r;
                f32x16 aw, aa;
#pragma unroll
                for (int i = 0; i < 16; ++i) { aw[i] = 0.f; aa[i] = 0.f; }
#pragma unroll
                for (int s = 0; s < 4; ++s) {
                    const bf16x8 fw = *(const bf16x8*)(LWU + (size_t)chr * 64 + 16 * s + 8 * hh), fa = *(const bf16x8*)(LAU + (size_t)chr * 64 + 16 * s + 8 * hh);
                    aw = MFMA32(fw, bw[s], aw); aa = MFMA32(fa, ba[s], aa);
                }
#pragma unroll
                for (int i4 = 0; i4 < 4; ++i4) {
                    const int c = hd * 64 + 32 * mt + 8 * i4 + 4 * hh;
                    const u32x2 rc = *(const u32x2*)(cur + c), kc = *(const u32x2*)(cur + 512 + c), vc = *(const u32x2*)(cur + 1024 + c);
                    u32x2 rp = {0u, 0u}, kq = {0u, 0u}, vp = {0u, 0u};
                    if (hp) { rp = *(const u32x2*)(prv + c); kq = *(const u32x2*)(prv + 512 + c); vp = *(const u32x2*)(prv + 1024 + c); }
                    const f32x4 mr = *(const f32x4*)(mu + c), mk = *(const f32x4*)(mu + 512 + c), mv = *(const f32x4*)(mu + 1024 + c);
                    const f32x4 w0v = *(const f32x4*)(w0 + c), a0v = *(const f32x4*)(a0 + c), kkw = *(const f32x4*)(k_k + c), kaw = *(const f32x4*)(k_a + c), rkw = *(const f32x4*)(r_k + c);
                    const float rcur[4] = {bf_lo(rc.x), bf_hi(rc.x), bf_lo(rc.y), bf_hi(rc.y)}, rprv[4] = {bf_lo(rp.x), bf_hi(rp.x), bf_lo(rp.y), bf_hi(rp.y)};
                    const float kcur[4] = {bf_lo(kc.x), bf_hi(kc.x), bf_lo(kc.y), bf_hi(kc.y)}, kprv[4] = {bf_lo(kq.x), bf_hi(kq.x), bf_lo(kq.y), bf_hi(kq.y)};
                    const float vcur[4] = {bf_lo(vc.x), bf_hi(vc.x), bf_lo(vc.y), bf_hi(vc.y)}, vprv[4] = {bf_lo(vp.x), bf_hi(vp.x), bf_lo(vp.y), bf_hi(vp.y)};
                    f32x4 dec; float rz[4], kp[4], vz[4], kn[4], bb[4];
#pragma unroll
                    for (int j = 0; j < 4; ++j) {
                        const int i = 4 * i4 + j;
                        const float zz = -(w0v[j] + aw[i]);
                        const float sp = (zz > 20.f) ? zz : __logf(1.0f + __expf(zz));
                        const float wv = -sp - 0.5f;
                        dec[j] = __expf(-__expf(wv));
                        const float av = sigmoidf_(a0v[j] + aa[i]);
                        rz[j] = rcur[j] + (rprv[j] - rcur[j]) * mr[j];
                        const float kz = kcur[j] + (kprv[j] - kcur[j]) * mk[j];
                        vz[j] = vcur[j] + (vprv[j] - vcur[j]) * mv[j];
                        kn[j] = kz * kkw[j] * inv; bb[j] = kn[j] * av;
                        kp[j] = kz * (1.0f + (av - 1.0f) * kaw[j]);
                        bonus += rz[j] * kp[j] * rkw[j];
                    }
                    const size_t o = (size_t)t * 512 + c;
                    *(f32x4*)(W + o) = dec;
                    u32x2 w2; w2.x = cvt_pk_bf16(rz[0], rz[1]); w2.y = cvt_pk_bf16(rz[2], rz[3]); *(u32x2*)(RZ + o) = w2;
                    w2.x = cvt_pk_bf16(kp[0], kp[1]); w2.y = cvt_pk_bf16(kp[2], kp[3]); *(u32x2*)(KP + o) = w2;
                    w2.x = cvt_pk_bf16(vz[0], vz[1]); w2.y = cvt_pk_bf16(vz[2], vz[3]); *(u32x2*)(VZ + o) = w2;
                    w2.x = cvt_pk_bf16(kn[0], kn[1]); w2.y = cvt_pk_bf16(kn[2], kn[3]); *(u32x2*)(KKN + o) = w2;
                    w2.x = cvt_pk_bf16(bb[0], bb[1]); w2.y = cvt_pk_bf16(bb[2], bb[3]); *(u32x2*)(Bv + o) = w2;
                }
            }
        }
        bonus += __shfl_xor(bonus, 32);
        int t2 = t; asm volatile("" : "+v"(t2));
        if (hh == 0) ((float*)(ows(ws) + WS_BONUS))[(size_t)t2 * 8 + hd] = bonus;
        {
            bf16x8 bg[8];
#pragma unroll
            for (int s = 0; s < 8; ++s) { const int o = 16 * s + 8 * hh; bg[s] = lerp_frag(cur + 1664 + o, prv + 1664 + o, hp, mu + 1664 + o, 2); }
#pragma unroll 1
            for (int mt = 0; mt < 2; ++mt) {
                const int chr = hd * 64 + 32 * mt + r;
                f32x16 ag;
#pragma unroll
                for (int i = 0; i < 16; ++i) ag[i] = 0.f;
#pragma unroll
                for (int s = 0; s < 8; ++s) { const bf16x8 fg = *(const bf16x8*)(LGU + (size_t)chr * 128 + 16 * s + 8 * hh); ag = MFMA32(fg, bg[s], ag); }
#pragma unroll
                for (int i4 = 0; i4 < 4; ++i4) {
                    const size_t o = (size_t)t2 * 512 + hd * 64 + 32 * mt + 8 * i4 + 4 * hh;
                    u32x2 w2; w2.x = cvt_pk_bf16(ag[4 * i4], ag[4 * i4 + 1]); w2.y = cvt_pk_bf16(ag[4 * i4 + 2], ag[4 * i4 + 3]); *(u32x2*)(G + o) = w2;
                }
            }
        }
    }
}

constexpr int SC_T = 32, SC_STEP = 1344, SC_BUF = SC_T * SC_STEP;
struct ScanRegs { f32x4 w0, w1; u32x4 kn, bb, kp, rz, vv; };
DI void scan_gload(KP p, ScanRegs& R, int b, int h, int rg, int ck, int pt) {
    const unsigned char* ws = ows(p->ws);
    const size_t tok0 = (size_t)b * SEQ + (size_t)ck * SC_T;
    { const int st = pt >> 4, sub = pt & 15; R.w0 = *(const f32x4*)((const float*)(ws + WS_W) + (tok0 + st) * 512 + h * 64 + 4 * sub); }
    { const int pp = pt + 256, st = pp >> 4, sub = pp & 15; R.w1 = *(const f32x4*)((const float*)(ws + WS_W) + (tok0 + st) * 512 + h * 64 + 4 * sub); }
    const int st = pt >> 3, sub = pt & 7; const size_t go = (tok0 + st) * 512 + h * 64 + 8 * sub;
    R.kn = *(const u32x4*)((const bf16_t*)(ws + WS_KKN) + go); R.bb = *(const u32x4*)((const bf16_t*)(ws + WS_B) + go);
    R.kp = *(const u32x4*)((const bf16_t*)(ws + WS_KP) + go); R.rz = *(const u32x4*)((const bf16_t*)(ws + WS_RZ) + go);
    R.vv = (u32x4){0u, 0u, 0u, 0u};
    if (pt < 64) { const int s2 = pt >> 1, hf = pt & 1; R.vv = *(const u32x4*)((const bf16_t*)(ws + WS_VZ) + (tok0 + s2) * 512 + h * 64 + rg * 16 + 8 * hf); }
}
DI void scan_write(const ScanRegs& R, LAS unsigned char* buf, int pt) {
    { const int st = pt >> 4, sub = pt & 15; *(LAS f32x4*)(buf + st * SC_STEP + sub * 16) = R.w0; }
    { const int pp = pt + 256, st = pp >> 4, sub = pp & 15; *(LAS f32x4*)(buf + st * SC_STEP + sub * 16) = R.w1; }
    const int st = pt >> 3, sub = pt & 7;
    const u32x4 kn = R.kn, bb = R.bb, kp = R.kp, rz = R.rz;
    LAS unsigned char* d = buf + st * SC_STEP + sub * 32;
    *(LAS f32x4*)(d + 256) = (f32x4){-bf_lo(kn.x), -bf_hi(kn.x), -bf_lo(kn.y), -bf_hi(kn.y)}; *(LAS f32x4*)(d + 256 + 16) = (f32x4){-bf_lo(kn.z), -bf_hi(kn.z), -bf_lo(kn.w), -bf_hi(kn.w)};
    *(LAS f32x4*)(d + 512) = (f32x4){bf_lo(bb.x), bf_hi(bb.x), bf_lo(bb.y), bf_hi(bb.y)}; *(LAS f32x4*)(d + 512 + 16) = (f32x4){bf_lo(bb.z), bf_hi(bb.z), bf_lo(bb.w), bf_hi(bb.w)};
    *(LAS f32x4*)(d + 768) = (f32x4){bf_lo(kp.x), bf_hi(kp.x), bf_lo(kp.y), bf_hi(kp.y)}; *(LAS f32x4*)(d + 768 + 16) = (f32x4){bf_lo(kp.z), bf_hi(kp.z), bf_lo(kp.w), bf_hi(kp.w)};
    *(LAS f32x4*)(d + 1024) = (f32x4){bf_lo(rz.x), bf_hi(rz.x), bf_lo(rz.y), bf_hi(rz.y)}; *(LAS f32x4*)(d + 1024 + 16) = (f32x4){bf_lo(rz.z), bf_hi(rz.z), bf_lo(rz.w), bf_hi(rz.w)};
    if (pt < 64) { const int s2 = pt >> 1, hf = pt & 1; const u32x4 vv = R.vv;
        LAS unsigned char* dv = buf + s2 * SC_STEP + 1280 + hf * 32;
        *(LAS f32x4*)dv = (f32x4){bf_lo(vv.x), bf_hi(vv.x), bf_lo(vv.y), bf_hi(vv.y)}; *(LAS f32x4*)(dv + 16) = (f32x4){bf_lo(vv.z), bf_hi(vv.z), bf_lo(vv.w), bf_hi(vv.w)}; }
}
DI void rwkv_scan_phase(KP p, LAS unsigned char* lds, int wv) {
    const int tid = otid(wv), wave = tid >> 6, lane = tid & 63;
    float* YRAW = (float*)(p->ws + WS_YRAW);
    for (int job = blockIdx.x; job < 128; job += gridDim.x) {
        const int chain = job >> 2, rg = job & 3, b = chain >> 3, h = chain & 7;
        __syncthreads();
        ScanRegs R;
        if (wave >= 4) { scan_gload(p, R, b, h, rg, 0, tid - 256); scan_write(R, lds, tid - 256); scan_gload(p, R, b, h, rg, 1, tid - 256); }
        __syncthreads();
        f32x4 S = {0.f, 0.f, 0.f, 0.f};
        const int jl = lane & 15, rl = 4 * (wave & 3) + (lane >> 4);
        for (int ck = 0; ck < SEQ / SC_T; ++ck) {
            LAS unsigned char* cb = lds + (ck & 1) * SC_BUF;
            if (wave >= 4) { if (ck + 1 < SEQ / SC_T) { scan_write(R, lds + ((ck + 1) & 1) * SC_BUF, tid - 256); if (ck + 2 < SEQ / SC_T) scan_gload(p, R, b, h, rg, ck + 2, tid - 256); } }
            else {
                float* yo = YRAW + ((size_t)b * SEQ + (size_t)ck * SC_T + jl) * 512 + h * 64 + rg * 16 + rl;
                const LAS unsigned char* sb = cb + jl * 16; const LAS unsigned char* vb = cb + 1280 + rl * 4;
                f32x4 w4 = *(const LAS f32x4*)sb, an = *(const LAS f32x4*)(sb + 256), b4 = *(const LAS f32x4*)(sb + 512), k4 = *(const LAS f32x4*)(sb + 768), r4 = *(const LAS f32x4*)(sb + 1024);
                float vi = *(const LAS float*)vb;
                float ysel = 0.f;
#pragma unroll
                for (int s = 0; s < SC_T; ++s) {
                    f32x4 w4n = w4, ann = an, b4n = b4, k4n = k4, r4n = r4; float vin = vi;
                    if (s + 1 < SC_T) {
                        const LAS unsigned char* sn = sb + (s + 1) * SC_STEP;
                        w4n = *(const LAS f32x4*)sn; ann = *(const LAS f32x4*)(sn + 256); b4n = *(const LAS f32x4*)(sn + 512); k4n = *(const LAS f32x4*)(sn + 768); r4n = *(const LAS f32x4*)(sn + 1024);
                        vin = *(const LAS float*)(vb + (s + 1) * SC_STEP);
                    }
                    float sa = (S[0] * an[0] + S[1] * an[1]) + (S[2] * an[2] + S[3] * an[3]);
                    sa = row16_sum(sa);
                    S = S * w4 + (b4 * sa + k4 * vi);
                    float y = (S[0] * r4[0] + S[1] * r4[1]) + (S[2] * r4[2] + S[3] * r4[3]);
                    y = row16_sum(y);
                    ysel = (jl == (s & 15)) ? y : ysel;
                    if ((s & 15) == 15) yo[(size_t)(s - 15) * 512] = ysel;
                    w4 = w4n; an = ann; b4 = b4n; k4 = k4n; r4 = r4n; vi = vin;
                }
            }
            __syncthreads();
        }
    }
}

DI void rwkv_post_phase(KP p, int l, int wv) {
    const unsigned char* ws = ows(p->ws);
    const float* YRAW = (const float*)(ws + WS_YRAW); const bf16_t* VZ = (const bf16_t*)(ws + WS_VZ); const bf16_t* G = (const bf16_t*)(ws + WS_G);
    const float* BONUS = (const float*)(ws + WS_BONUS); bf16_t* YS = (bf16_t*)(p->ws + WS_YSR);
    const float* gnw = p->in[15] + l * 512; const float* gnb = p->in[16] + l * 512;
    const int tid_ = otid(wv); const int wave = tid_ >> 6, lane = tid_ & 63, c = 8 * lane;
    const f32x4 gw0 = *(const f32x4*)(gnw + c), gw1 = *(const f32x4*)(gnw + c + 4), gb0 = *(const f32x4*)(gnb + c), gb1 = *(const f32x4*)(gnb + c + 4);
    for (int t = blockIdx.x * 8 + wave; t < MTOK; t += gridDim.x * 8) {
        const size_t o = (size_t)t * 512 + c;
        const f32x4 y0 = *(const f32x4*)(YRAW + o), y1 = *(const f32x4*)(YRAW + o + 4);
        float s = (y0[0] + y0[1]) + (y0[2] + y0[3]) + (y1[0] + y1[1]) + (y1[2] + y1[3]);
        s += __shfl_xor(s, 1); s += __shfl_xor(s, 2); s += __shfl_xor(s, 4);
        const float mean = s * (1.0f / 64.0f);
        const f32x4 d0 = y0 - mean, d1 = y1 - mean;
        float q = (d0[0] * d0[0] + d0[1] * d0[1]) + (d0[2] * d0[2] + d0[3] * d0[3]) + (d1[0] * d1[0] + d1[1] * d1[1]) + (d1[2] * d1[2] + d1[3] * d1[3]);
        q += __shfl_xor(q, 1); q += __shfl_xor(q, 2); q += __shfl_xor(q, 4);
        const float rstd = rsqrtf(q * (1.0f / 64.0f) + 64e-5f);
        const float bon = BONUS[(size_t)t * 8 + (lane >> 3)];
        const u32x4 vv = *(const u32x4*)(VZ + o), gg = *(const u32x4*)(G + o);
        const f32x4 v0 = {bf_lo(vv.x), bf_hi(vv.x), bf_lo(vv.y), bf_hi(vv.y)}, v1 = {bf_lo(vv.z), bf_hi(vv.z), bf_lo(vv.w), bf_hi(vv.w)};
        const f32x4 g0 = {bf_lo(gg.x), bf_hi(gg.x), bf_lo(gg.y), bf_hi(gg.y)}, g1 = {bf_lo(gg.z), bf_hi(gg.z), bf_lo(gg.w), bf_hi(gg.w)};
        const f32x4 r0 = (d0 * rstd * gw0 + gb0 + v0 * bon) * g0, r1 = (d1 * rstd * gw1 + gb1 + v1 * bon) * g1;
        u32x4 w; w.x = cvt_pk_bf16(r0[0], r0[1]); w.y = cvt_pk_bf16(r0[2], r0[3]); w.z = cvt_pk_bf16(r1[0], r1[1]); w.w = cvt_pk_bf16(r1[2], r1[3]);
        *(u32x4*)(YS + o) = w;
    }
}

DI void attn_job(const bf16_t* Q, const bf16_t* K, const bf16_t* V, bf16_t* YS, float* LSE, LAS unsigned char* vl, int b, int h, int d, int rho, int J0, bool first, int lane) {
    asm volatile("" : "+v"(lane));
    const int r = lane & 31, hh = lane >> 5;
    const size_t tokq = (size_t)b * SEQ + (size_t)(J0 + r) * d + rho;
    bf16x8 bq[4];
#pragma unroll
    for (int s = 0; s < 4; ++s) bq[s] = *(const bf16x8*)(Q + tokq * 512 + h * 64 + 16 * s + 8 * hh);
    f32x16 sc[5];
#pragma unroll
    for (int kt = 0; kt < 5; ++kt) {
        const int Jk = J0 - 128 + 32 * kt + r; const bool valid = Jk >= 0;
        const size_t tokk = (size_t)b * SEQ + (size_t)(valid ? Jk : 0) * d + rho;
        f32x16 a;
#pragma unroll
        for (int i = 0; i < 16; ++i) a[i] = 0.f;
#pragma unroll
        for (int s = 0; s < 4; ++s) {
            bf16x8 ak = *(const bf16x8*)(K + tokk * 512 + h * 64 + 16 * s + 8 * hh);
            if (!valid) ak = (bf16x8){0, 0, 0, 0, 0, 0, 0, 0};
            a = MFMA32(ak, bq[s], a);
        }
        sc[kt] = a;
    }
    float m = -1e30f;
#pragma unroll
    for (int kt = 0; kt < 5; ++kt)
#pragma unroll
        for (int i = 0; i < 16; ++i) {
            const int kidx = 32 * kt + crow(i, hh); const int dist = 128 + r - kidx;
            const bool ok = (dist >= 0) && (dist <= 128) && (J0 - 128 + kidx >= 0);
            const float v = ok ? sc[kt][i] * 0.125f : -1e30f;
            sc[kt][i] = v; m = fmaxf(m, v);
        }
    m = fmaxf(m, __shfl_xor(m, 32));
    float lsum = 0.f;
#pragma unroll
    for (int kt = 0; kt < 5; ++kt)
#pragma unroll
        for (int i = 0; i < 16; ++i) { const float pv = __expf(sc[kt][i] - m); sc[kt][i] = pv; lsum += pv; }
    lsum += __shfl_xor(lsum, 32);
    const float lse = m + __logf(lsum);
    f32x16 o[2];
#pragma unroll
    for (int i = 0; i < 16; ++i) { o[0][i] = 0.f; o[1][i] = 0.f; }
#pragma unroll
    for (int kt = 0; kt < 5; ++kt) {
        {
            const int key = lane >> 1, hf = lane & 1; const int Jk = J0 - 128 + 32 * kt + key;
            const size_t tokv = (size_t)b * SEQ + (size_t)(Jk >= 0 ? Jk : 0) * d + rho;
            const u32x4* src = (const u32x4*)(V + tokv * 512 + h * 64 + 32 * hf);
            LAS u32x4* dst = (LAS u32x4*)(vl + key * 128 + hf * 64);
            const u32x4 x0 = src[0], x1 = src[1], x2 = src[2], x3 = src[3];
            dst[0] = x0; dst[1] = x1; dst[2] = x2; dst[3] = x3;
        }
        LDS_WAIT();
#pragma unroll
        for (int s = 0; s < 2; ++s) {
            const bf16x8 xs = pack8(sc[kt][8 * s], sc[kt][8 * s + 1], sc[kt][8 * s + 2], sc[kt][8 * s + 3], sc[kt][8 * s + 4], sc[kt][8 * s + 5], sc[kt][8 * s + 6], sc[kt][8 * s + 7]);
#pragma unroll
            for (int mt = 0; mt < 2; ++mt) {
                bf16x8 pa;
#pragma unroll
                for (int j = 0; j < 8; ++j) { const int key = 16 * s + 8 * (j >> 2) + 4 * hh + (j & 3); pa[j] = (short)*(const LAS bf16_t*)(vl + key * 128 + (r + 32 * mt) * 2); }
                o[mt] = MFMA32(pa, xs, o[mt]);
            }
        }
        LDS_WAIT();
    }
    const float il = 1.0f / lsum;
    float wp = 0.f, wc = 1.0f, nl = lse;
    if (!first) { const float lp = LSE[tokq * 8 + h]; const float mx = fmaxf(lp, lse); const float ep = __expf(lp - mx), ec = __expf(lse - mx); nl = mx + __logf(ep + ec); wp = ep / (ep + ec); wc = ec / (ep + ec); }
#pragma unroll
    for (int mt = 0; mt < 2; ++mt)
#pragma unroll
        for (int g4 = 0; g4 < 4; ++g4) {
            bf16_t* dst = YS + tokq * 512 + h * 64 + 32 * mt + 8 * g4 + 4 * hh;
            float v[4];
#pragma unroll
            for (int j = 0; j < 4; ++j) v[j] = o[mt][4 * g4 + j] * il * wc;
            if (!first) { const u32x2 pw = *(const u32x2*)dst; v[0] += bf_lo(pw.x) * wp; v[1] += bf_hi(pw.x) * wp; v[2] += bf_lo(pw.y) * wp; v[3] += bf_hi(pw.y) * wp; }
            u32x2 w2; w2.x = cvt_pk_bf16(v[0], v[1]); w2.y = cvt_pk_bf16(v[2], v[3]); *(u32x2*)dst = w2;
        }
    if (hh == 0) LSE[tokq * 8 + h] = nl;
}

DI void attention_phase(KP p, LAS unsigned char* lds, int wv) {
    unsigned char* ws = ows(p->ws);
    const bf16_t *Q = (const bf16_t*)(ws + WS_Q), *K = (const bf16_t*)(ws + WS_K), *V = (const bf16_t*)(ws + WS_V);
    bf16_t* YS = (bf16_t*)(ws + WS_YSA); float* LSE = (float*)(ws + WS_LSE);
    const int tid_ = otid(wv); const int wave = tid_ >> 6, lane = tid_ & 63;
    LAS unsigned char* vl = lds + wave * 4096;
    for (int item = blockIdx.x; item < 256; item += gridDim.x) {
        const int b = item >> 6, h = (item >> 3) & 7, qb = item & 7, P0 = qb * 512;
#pragma unroll 1
        for (int cfg = 0; cfg < 3; ++cfg) {
#pragma unroll 1
            for (int jj = wave; jj < 16; jj += 8) {
                int d, rho, J0;
                if (cfg == 0) { d = 1; rho = 0; J0 = P0 + 32 * jj; }
                else if (cfg == 1) { d = 4; rho = jj & 3; J0 = (P0 >> 2) + 32 * (jj >> 2); }
                else { d = 16; rho = jj; J0 = P0 >> 4; }
                attn_job(Q, K, V, YS, LSE, vl, b, h, d, rho, J0, cfg == 0, lane);
            }
            asm volatile("s_waitcnt vmcnt(0)" ::: "memory");
            __syncthreads();
        }
    }
}

DI void gmlp_phase(KP p, int l, LAS unsigned char* lds, int wv) {
    unsigned char* ws = ows(p->ws);
    const bf16_t* UV = (const bf16_t*)(ws + WS_UV); bf16_t* YS = (bf16_t*)(ws + WS_YSG);
    const float* lng = p->in[17] + l * 512; const float* lnb = p->in[18] + l * 512;
    const float* wsp = p->in[19] + (size_t)l * 8 * 128 * 128; const float* bsp = p->in[20] + (size_t)l * 8 * 128;
    const int tid_ = otid(wv); const int wave = tid_ >> 6, lane = tid_ & 63, r = lane & 31, hh = lane >> 5;
    LAS float* stats = (LAS float*)(lds + 8 * 17408);
    LAS bf16_t* VT = (LAS bf16_t*)(lds + wave * 17408);
    for (int item = blockIdx.x; item < 128; item += gridDim.x) {
        const size_t tok0 = (size_t)item * 128;
        __syncthreads();
        for (int tt = 0; tt < 16; ++tt) {
            const int tl = wave * 16 + tt;
            const u32x4 x = *(const u32x4*)(UV + (tok0 + tl) * 1024 + 512 + 8 * lane);
            const float f[8] = {bf_lo(x.x), bf_hi(x.x), bf_lo(x.y), bf_hi(x.y), bf_lo(x.z), bf_hi(x.z), bf_lo(x.w), bf_hi(x.w)};
            float s = 0.f;
#pragma unroll
            for (int j = 0; j < 8; ++j) s += f[j];
            const float mean = wave_sum(s) * (1.0f / 512.0f); float q = 0.f;
#pragma unroll
            for (int j = 0; j < 8; ++j) { const float dd = f[j] - mean; q += dd * dd; }
            const float rstd = rsqrtf(wave_sum(q) * (1.0f / 512.0f) + 1e-5f);
            if (lane == 0) { stats[2 * tl] = mean; stats[2 * tl + 1] = rstd; }
        }
        __syncthreads();
        const int g = wave;
        {
            const int d0 = 8 * (lane & 7);
            const f32x4 lg0 = *(const f32x4*)(lng + g * 64 + d0), lg1 = *(const f32x4*)(lng + g * 64 + d0 + 4), lb0 = *(const f32x4*)(lnb + g * 64 + d0), lb1 = *(const f32x4*)(lnb + g * 64 + d0 + 4);
            for (int it = 0; it < 16; ++it) {
                const int tl = it * 8 + (lane >> 3);
                const u32x4 x = *(const u32x4*)(UV + (tok0 + tl) * 1024 + 512 + g * 64 + d0);
                const float mean = stats[2 * tl], rstd = stats[2 * tl + 1];
                const float f[8] = {bf_lo(x.x), bf_hi(x.x), bf_lo(x.y), bf_hi(x.y), bf_lo(x.z), bf_hi(x.z), bf_lo(x.w), bf_hi(x.w)};
#pragma unroll
                for (int e = 0; e < 8; ++e) {
                    const float gg = e < 4 ? lg0[e & 3] : lg1[e & 3], bb = e < 4 ? lb0[e & 3] : lb1[e & 3];
                    const float y = (f[e] - mean) * rstd * gg + bb;
                    VT[(d0 + e) * 136 + tl] = (bf16_t)(cvt_pk_bf16(y, 0.f) & 0xffffu);
                }
            }
        }
        LDS_WAIT();
#pragma unroll 1
        for (int nt = 0; nt < 4; ++nt) {
            f32x16 acc[2];
#pragma unroll
            for (int i = 0; i < 16; ++i) { acc[0][i] = 0.f; acc[1][i] = 0.f; }
            const int irow = 32 * nt + r;
            for (int s = 0; s < 2 * (nt + 1); ++s) {
                const int j0 = 16 * s + 8 * hh;
                const float* wr_ = wsp + ((size_t)g * 128 + irow) * 128 + j0;
                const f32x4 wa = *(const f32x4*)wr_, wb = *(const f32x4*)(wr_ + 4);
                float wv[8] = {wa[0], wa[1], wa[2], wa[3], wb[0], wb[1], wb[2], wb[3]};
#pragma unroll
                for (int j = 0; j < 8; ++j) if (j0 + j > irow) wv[j] = 0.f;
                const bf16x8 bfr = pack8(wv[0], wv[1], wv[2], wv[3], wv[4], wv[5], wv[6], wv[7]);
#pragma unroll
                for (int mt = 0; mt < 2; ++mt) {
                    const bf16x8 afr = *(const LAS bf16x8*)(VT + (32 * mt + r) * 136 + j0);
                    acc[mt] = MFMA32(afr, bfr, acc[mt]);
                }
            }
            const size_t tok = tok0 + irow; const float bs = bsp[g * 128 + irow];
#pragma unroll
            for (int mt = 0; mt < 2; ++mt)
#pragma unroll
                for (int g4 = 0; g4 < 4; ++g4) {
                    const int c = g * 64 + 32 * mt + 8 * g4 + 4 * hh;
                    const u32x2 uu = *(const u32x2*)(UV + tok * 1024 + c);
                    const float o0 = bf_lo(uu.x) * (acc[mt][4 * g4] + bs), o1 = bf_hi(uu.x) * (acc[mt][4 * g4 + 1] + bs), o2 = bf_lo(uu.y) * (acc[mt][4 * g4 + 2] + bs), o3 = bf_hi(uu.y) * (acc[mt][4 * g4 + 3] + bs);
                    u32x2 w2; w2.x = cvt_pk_bf16(o0, o1); w2.y = cvt_pk_bf16(o2, o3); *(u32x2*)(YS + tok * 512 + c) = w2;
                }
        }
    }
}

DI void ffn_conv_phase(KP p, int l, int wv) {
    bf16_t* UP = (bf16_t*)(ows(p->ws) + WS_UP);
    const float* cw = p->in[25] + (size_t)l * 3 * DFF; const float* cb = p->in[26] + (size_t)l * DFF;
    constexpr int NCG = DFF / 8, RUN = 32, NRUN = MTOK / RUN;
    const int tid_ = otid(wv);
    for (int item = blockIdx.x * 512 + tid_; item < NCG * NRUN; item += gridDim.x * 512) {
        const int cgi = item % NCG, run = item / NCG, f0 = 8 * cgi, t0 = run * RUN;
        float w0[8], w1[8], w2[8], bb[8];
#pragma unroll
        for (int q = 0; q < 2; ++q) { const f32x4 a = *(const f32x4*)(cw + f0 + 4 * q), b = *(const f32x4*)(cw + DFF + f0 + 4 * q), c = *(const f32x4*)(cw + 2 * DFF + f0 + 4 * q), d = *(const f32x4*)(cb + f0 + 4 * q);
#pragma unroll
            for (int j = 0; j < 4; ++j) { w0[4 * q + j] = a[j]; w1[4 * q + j] = b[j]; w2[4 * q + j] = c[j]; bb[4 * q + j] = d[j]; } }
        u32x4 am2 = {0u, 0u, 0u, 0u}, am1 = {0u, 0u, 0u, 0u};
        if ((t0 & (SEQ - 1)) != 0) { am2 = *(const u32x4*)(UP + (size_t)(t0 - 2) * UPC + f0); am1 = *(const u32x4*)(UP + (size_t)(t0 - 1) * UPC + f0); }
        for (int t = t0; t < t0 + RUN; t += 4) {
            u32x4 av[4], gv[4];
#pragma unroll
            for (int q = 0; q < 4; ++q) { av[q] = *(const u32x4*)(UP + (size_t)(t + q) * UPC + f0); gv[q] = *(const u32x4*)(UP + (size_t)(t + q) * UPC + DFF + f0); }
#pragma unroll
            for (int q = 0; q < 4; ++q) {
                const u32x4 a0 = av[q], gg = gv[q];
                const unsigned x2[4] = {am2.x, am2.y, am2.z, am2.w}, x1[4] = {am1.x, am1.y, am1.z, am1.w}, x0[4] = {a0.x, a0.y, a0.z, a0.w}, xg[4] = {gg.x, gg.y, gg.z, gg.w};
                unsigned ow[4];
#pragma unroll
                for (int j = 0; j < 4; ++j) {
                    const float c0 = bb[2 * j] + w0[2 * j] * bf_lo(x2[j]) + w1[2 * j] * bf_lo(x1[j]) + w2[2 * j] * bf_lo(x0[j]);
                    const float c1 = bb[2 * j + 1] + w0[2 * j + 1] * bf_hi(x2[j]) + w1[2 * j + 1] * bf_hi(x1[j]) + w2[2 * j + 1] * bf_hi(x0[j]);
                    ow[j] = cvt_pk_bf16(gelu_tanh(c0) * bf_lo(xg[j]), gelu_tanh(c1) * bf_hi(xg[j]));
                }
                *(u32x4*)(UP + (size_t)(t + q) * UPC + DFF + f0) = (u32x4){ow[0], ow[1], ow[2], ow[3]};
                am2 = am1; am1 = a0;
            }
        }
    }
}

__global__ void __launch_bounds__(512) fwd_megakernel(Params p_unused) {
    extern __shared__ __attribute__((aligned(16))) unsigned char lds_raw[];
    LAS unsigned char* lds = (LAS unsigned char*)lds_raw;
    cg::grid_group grid = cg::this_grid();
    KP p = okp();
    unsigned char* ws = p->ws;
    const int G = gridDim.x, c = blockIdx.x;
    const int wv = __builtin_amdgcn_readfirstlane((int)(threadIdx.x >> 6));
    pg8::Epi E; pg8::TileOrder S; pg8::Gemm g;

    grid.sync();
    unsigned epoch = 0; unsigned* bar = (unsigned*)(ws + WS_BAR);
    phase0(p, lds, wv);
    gbar(bar, epoch, (unsigned)G, wv);
#pragma unroll 1
    for (int st = 0; st < 2 * 17; ++st) {
        const int l = st / 17, step = st % 17;
        p = okp(); ws = ows(p->ws);
        const float* mod = (const float*)(ws + WS_MOD); const bf16_t* H = (const bf16_t*)(ws + WS_H);
        const float* ml = mod + (size_t)l * 4 * 6144;
        const float* xin = (l == 0) ? p->in[0] : p->out;
        bool do_gemm = false, do_sync = true;
        E = pg8::Epi{};
        if (step == 0) {
            if (l > 0) convert_weights(p, l, lds, wv);
#ifdef REP_CONVW
            if (l > 0) convert_weights(p, l, lds, wv);
#endif
            norm_mod_phase(xin, p->in[4] + l * DM, ml + 0, ml + 1024, (bf16_t*)(ws + WS_H), wv);
#ifdef REP_NORM
            norm_mod_phase(xin, p->in[4] + l * DM, ml + 0, ml + 1024, (bf16_t*)(ws + WS_H), wv);
#endif
        } else if (step == 1 || step == 4) {
            if (step == 4) rwkv_post_phase(p, l, wv);
#ifdef REP_POST
            if (step == 4) rwkv_post_phase(p, l, wv);
#endif
            E.mode = pg8::EM_INPROJ; E.o0 = (bf16_t*)(ws + WS_Q); E.o1 = (bf16_t*)(ws + WS_K); E.o2 = (bf16_t*)(ws + WS_V); E.o3 = (bf16_t*)(ws + WS_RAW); E.o4 = (bf16_t*)(ws + WS_UV);
            E.ropec = (const float*)(ws + WS_ROPEC); E.ropes = (const float*)(ws + WS_ROPES);
            g.A = H; g.Bt = (const bf16_t*)(ws + WS_WIN); g.lda = 1024; g.K = 1024;
            if (step == 1) S.init(64, 7, G, c, 7, 6, 0); else S.init(64, 10, G, c, 6, 0, 13);
            do_gemm = true;
        } else if (step == 2) { rwkv_derived_phase(p, l, wv); }
        else if (step == 3) { rwkv_scan_phase(p, lds, wv);
#ifdef REP_SCAN
            gbar((unsigned*)(ws + WS_BAR), epoch, (unsigned)G, wv); rwkv_scan_phase(p, lds, wv);
#endif
        }
        else if (step == 5) { attention_phase(p, lds, wv);
#ifdef REP_ATT
            gbar((unsigned*)(ws + WS_BAR), epoch, (unsigned)G, wv); attention_phase(p, lds, wv);
#endif
            gmlp_phase(p, l, lds, wv);
#ifdef REP_GMLP
            gbar((unsigned*)(ws + WS_BAR), epoch, (unsigned)G, wv); gmlp_phase(p, l, lds, wv);
#endif
        }
        else if (step >= 6 && step <= 11) {
            const int br = (step - 6) >> 1;
            if (((step - 6) & 1) == 0) {
                E.mode = pg8::EM_GATE; E.o0 = (bf16_t*)(ws + WS_GATE);
                g.A = H; g.Bt = (const bf16_t*)(ws + WS_WIN) + (size_t)(4352 + 1024 * br) * 1024; g.lda = 1024; g.K = 1024;
            } else {
                E.mode = (br == 0) ? pg8::EM_BR_FIRST : (br == 1 ? pg8::EM_BR_MID : pg8::EM_BR_LAST); E.o0 = (bf16_t*)(ws + WS_GATE); E.o1 = (bf16_t*)(ws + WS_MB); E.f0 = (float*)(ws + WS_M32);
                g.A = (const bf16_t*)(ws + (br == 0 ? WS_YSA : (br == 1 ? WS_YSR : WS_YSG))); g.Bt = (const bf16_t*)(ws + WS_WBR) + (size_t)br * 1024 * 512; g.lda = 512; g.K = 512;
            }
            S.init(64, 4, G, c, 4, 0, 0);
            do_gemm = true; do_sync = (step == 11);
        } else if (step == 12) {
            E.mode = pg8::EM_RESID; E.f0 = p->out; E.f1 = xin; E.f2 = ml + 2048;
            g.A = (const bf16_t*)(ws + WS_MB); g.Bt = (const bf16_t*)(ws + WS_WOUT); g.lda = 1024; g.K = 1024;
            S.init(64, 4, G, c, 4, 0, 0); do_gemm = true;
        } else if (step == 13) { norm_mod_phase(p->out, p->in[23] + l * DM, ml + 3072, ml + 4096, (bf16_t*)(ws + WS_H), wv); }
        else if (step == 14) {
            E.mode = pg8::EM_UP; E.o0 = (bf16_t*)(ws + WS_UP);
            g.A = H; g.Bt = (const bf16_t*)(ws + WS_WUP); g.lda = 1024; g.K = 1024;
            S.init(64, 22, G, c, 22, 0, 0); do_gemm = true;
        } else if (step == 15) { ffn_conv_phase(p, l, wv); }
        else {
            E.mode = pg8::EM_RESID; E.f0 = p->out; E.f1 = p->out; E.f2 = ml + 5120;
            g.A = (const bf16_t*)(ws + WS_UP) + DFF; g.Bt = (const bf16_t*)(ws + WS_WDN); g.lda = UPC; g.K = DFF;
            S.init(64, 4, G, c, 4, 0, 0); do_gemm = true;
        }
        if (do_gemm) pg8::gemm_phase(lds, g, S, E, wv);
#ifdef REP_UP
        if (step == 14) pg8::gemm_phase(lds, g, S, E, wv);
#endif
#ifdef REP_BAR
        if (step == 14) { for (int q = 0; q < 10; ++q) gbar((unsigned*)(ws + WS_BAR), epoch, (unsigned)G, wv); }
#endif
        if (do_sync) gbar((unsigned*)(ws + WS_BAR), epoch, (unsigned)G, wv);
#ifdef DBG_ST
        if (st == DBG_ST) {
            gbar((unsigned*)(ws + WS_BAR), epoch, (unsigned)G, wv);
#if DBG_KIND == 1
            { const bf16_t* sb = (const bf16_t*)(ws + DBG_BUF); for (size_t i = (size_t)blockIdx.x * 512 + otid(wv); i < (size_t)MTOK * DM; i += (size_t)gridDim.x * 512) p->out[i] = __uint_as_float(((unsigned)sb[i]) << 16); }
#elif DBG_KIND == 3
            { const bf16_t* sb = (const bf16_t*)(ws + DBG_BUF); for (size_t i = (size_t)blockIdx.x * 512 + otid(wv); i < (size_t)MTOK * DM; i += (size_t)gridDim.x * 512) p->out[i] = __uint_as_float(((unsigned)sb[i % DBG_N]) << 16); }
#elif DBG_KIND == 2
            { const float* sb = (const float*)(ws + DBG_BUF); for (size_t i = (size_t)blockIdx.x * 512 + otid(wv); i < (size_t)MTOK * DM; i += (size_t)gridDim.x * 512) p->out[i] = sb[i % DBG_N]; }
#endif
            return;
        }
#endif
    }
    p = okp();
    final_norm_phase(p->out, p->in[28], wv);
}

extern "C" void kernel_launch(void* const* d_in, const int* in_sizes, int n_in, void* d_out, int out_size, void* d_ws, size_t ws_size, hipStream_t stream) {
    static int grid_blocks = 0;
    if (grid_blocks == 0) {
        int dev = 0, cus = 0, per_cu = 0;
        hipGetDevice(&dev);
        hipDeviceGetAttribute(&cus, hipDeviceAttributeMultiprocessorCount, dev);
        if (hipFuncSetAttribute((const void*)fwd_megakernel, hipFuncAttributeMaxDynamicSharedMemorySize, LDS_BYTES) != hipSuccess) { fprintf(stderr, "hipFuncSetAttribute failed\n"); }
        hipOccupancyMaxActiveBlocksPerMultiprocessor(&per_cu, (const void*)fwd_megakernel, 512, LDS_BYTES);
        if (per_cu < 1) { fprintf(stderr, "occupancy query returned %d\n", per_cu); per_cu = 1; }
        if (per_cu > 1) per_cu = 1;
        grid_blocks = cus * per_cu;
        (void)hipGetLastError();
    }
    if (n_in != 29 || ws_size < 256 * MiB) { fprintf(stderr, "unexpected inputs/workspace\n"); return; }
    (void)hipMemsetAsync((unsigned char*)d_ws + WS_BAR, 0, 256, stream);
    Params p{};
    for (int i = 0; i < 29; ++i) p.in[i] = (const float*)d_in[i];
    p.out = (float*)d_out; p.ws = (unsigned char*)d_ws;
    void* args[] = {&p};
    hipError_t e = hipLaunchCooperativeKernel((const void*)fwd_megakernel, dim3(grid_blocks), dim3(512), args, LDS_BYTES, stream);
    if (e != hipSuccess) fprintf(stderr, "cooperative launch failed: %s (grid %d)\n", hipGetErrorString(e), grid_blocks);
}
```

```cpp
#include <hip/hip_runtime.h>
#include <hip/hip_cooperative_groups.h>
#include <cstdio>
#include <cstdint>
namespace cg = cooperative_groups;

#define LAS __attribute__((address_space(3)))
#define DI __device__ __forceinline__
typedef unsigned short bf16_t;
typedef short bf16x8 __attribute__((ext_vector_type(8)));
typedef float f32x4 __attribute__((ext_vector_type(4)));
typedef float f32x16 __attribute__((ext_vector_type(16)));
typedef unsigned u32x4 __attribute__((ext_vector_type(4)));
typedef unsigned u32x2 __attribute__((ext_vector_type(2)));

constexpr int DM = 1024, SEQ = 4096, MTOK = 16384, INC = 7424, DFF = 2816, UPC = 5632, RAWC = 1792;
constexpr int LDS_BYTES = 147456;
constexpr size_t MiB = 1048576;
constexpr size_t WS_WIN = 0, WS_WBR = WS_WIN + (size_t)INC * 1024 * 2, WS_WOUT = WS_WBR + 3u * 1024 * 512 * 2, WS_WUP = WS_WOUT + 1024u * 1024 * 2,
                 WS_WDN = WS_WUP + (size_t)UPC * 1024 * 2, WS_LWU = WS_WDN + (size_t)DFF * 1024 * 2, WS_LAU = WS_LWU + 65536, WS_LGU = WS_LAU + 65536;
constexpr size_t WS_H = 37 * MiB;
constexpr size_t WS_SMALL = 69 * MiB, WS_MOD = WS_SMALL, WS_ROPEC = WS_MOD + 262144, WS_ROPES = WS_ROPEC + 524288, WS_BONUS = WS_ROPES + 524288, WS_LSE = WS_BONUS + 524288;
constexpr size_t WS_BAR = WS_LSE + 524288;
constexpr size_t DB = 72 * MiB;
constexpr size_t WS_RAW = DB, WS_RZ = DB + 56 * MiB, WS_KP = DB + 72 * MiB, WS_KKN = DB + 88 * MiB, WS_B = DB + 104 * MiB, WS_W = DB + 120 * MiB, WS_VZ = DB + 152 * MiB, WS_G = DB + 168 * MiB;
constexpr size_t WS_YRAW = DB, WS_YSR = DB + 32 * MiB;
constexpr size_t WS_Q = DB + 56 * MiB, WS_K = DB + 72 * MiB, WS_V = DB + 88 * MiB, WS_UV = DB + 104 * MiB;
constexpr size_t WS_YSA = DB + 152 * MiB, WS_YSG = DB + 168 * MiB;
constexpr size_t WS_GATE = DB, WS_M32 = DB + 48 * MiB, WS_MB = DB + 112 * MiB;
constexpr size_t WS_UP = DB;
static_assert(WS_LGU + 131072 <= WS_H, "weights region overflow");
static_assert(WS_BAR + 256 <= DB, "small region overflow");

struct Params {
    const float* in[29];
    float* out;
    unsigned char* ws;
};

typedef const __attribute__((address_space(4))) Params* KP;
DI KP okp() { unsigned long long k = (unsigned long long)__builtin_amdgcn_kernarg_segment_ptr(); asm volatile("" : "+s"(k)); return (KP)k; }
typedef float f32x2_t __attribute__((ext_vector_type(2)));
typedef __bf16 bf16x2_t __attribute__((ext_vector_type(2)));
DI unsigned cvt_pk_bf16(float lo, float hi) { const f32x2_t v = {lo, hi}; const bf16x2_t r = __builtin_convertvector(v, bf16x2_t); return __builtin_bit_cast(unsigned, r); }
DI float bf_lo(unsigned w) { return __uint_as_float(w << 16); }
DI float bf_hi(unsigned w) { return __uint_as_float(w & 0xffff0000u); }
DI int otid(int wv) { int ln; asm volatile("v_mbcnt_lo_u32_b32 %0, -1, 0\n\tv_mbcnt_hi_u32_b32 %0, -1, %0" : "=v"(ln)); return wv * 64 + ln; }
DI unsigned char* ows(unsigned char* w) { asm volatile("" : "+s"(w)); return w; }
DI float row16_sum(float v) {
    v += __builtin_bit_cast(float, __builtin_amdgcn_update_dpp(0, __builtin_bit_cast(int, v), 0xB1, 0xF, 0xF, false));
    v += __builtin_bit_cast(float, __builtin_amdgcn_update_dpp(0, __builtin_bit_cast(int, v), 0x4E, 0xF, 0xF, false));
    v += __builtin_bit_cast(float, __builtin_amdgcn_update_dpp(0, __builtin_bit_cast(int, v), 0x141, 0xF, 0xF, false));
    v += __builtin_bit_cast(float, __builtin_amdgcn_update_dpp(0, __builtin_bit_cast(int, v), 0x140, 0xF, 0xF, false));
    return v;
}
DI float wave_sum(float v) { v = row16_sum(v); v += __shfl_xor(v, 16); v += __shfl_xor(v, 32); return v; }
DI void gbar(unsigned* ctr, unsigned& epoch, unsigned nblocks, int wv) {
    asm volatile("s_waitcnt vmcnt(0) lgkmcnt(0)" ::: "memory");
    __syncthreads();
    epoch += nblocks;
    if (otid(wv) == 0) {
        __builtin_amdgcn_fence(__ATOMIC_RELEASE, "agent");
        asm volatile("s_waitcnt vmcnt(0)" ::: "memory");
        __hip_atomic_fetch_add(ctr, 1u, __ATOMIC_RELAXED, __HIP_MEMORY_SCOPE_AGENT);
        while (__hip_atomic_load(ctr, __ATOMIC_RELAXED, __HIP_MEMORY_SCOPE_AGENT) < epoch) __builtin_amdgcn_s_sleep(2);
        __builtin_amdgcn_fence(__ATOMIC_ACQUIRE, "agent");
        asm volatile("s_waitcnt vmcnt(0)" ::: "memory");
    }
    asm volatile("" ::: "memory");
    __syncthreads();
}
DI float sigmoidf_(float x) { return __builtin_amdgcn_rcpf(1.0f + __expf(-x)); }
DI float gelu_tanh(float x) { const float u = 1.5957691216f * (x + 0.044715f * x * x * x); return x * __builtin_amdgcn_rcpf(1.0f + __expf(-u)); }
#define LDS_WAIT() asm volatile("s_waitcnt lgkmcnt(0)" ::: "memory")
#define MFMA32(a, b, c) __builtin_amdgcn_mfma_f32_32x32x16_bf16((a), (b), (c), 0, 0, 0)
DI int crow(int reg, int h) { return (reg & 3) + 8 * (reg >> 2) + 4 * h; }
DI bf16x8 pack8(float a0, float a1, float a2, float a3, float a4, float a5, float a6, float a7) {
    u32x4 p; p.x = cvt_pk_bf16(a0, a1); p.y = cvt_pk_bf16(a2, a3); p.z = cvt_pk_bf16(a4, a5); p.w = cvt_pk_bf16(a6, a7);
    return __builtin_bit_cast(bf16x8, p);
}

namespace pg8 {
constexpr int BM = 256, BK = 64, HALF = 128, HTB = HALF * BK * 2, STAGE_BYTES = 8 * HTB, NXCD = 8, WGM = 8;
DI int lds_byte(int r, int c) { const int st = (r >> 4) * 2 + (c >> 5), rr = r & 15, cc = c & 31, ob = rr * 64 + cc * 2; return st * 1024 + (ob ^ (((ob >> 9) & 1) << 5)); }
DI void stage_rc(int b, int& R, int& C) { const int st = b / 1024, sb = b % 1024, swz = sb ^ (((sb >> 9) & 1) << 5); R = (st >> 1) * 16 + swz / 64; C = (st & 1) * 32 + (swz % 64) / 2; }
DI int perm32(int rho) { const int n = rho >> 4, i = rho & 15; return 8 * (i >> 2) + 4 * n + (i & 3); }
struct Unit { int pm, pn; };
struct Gemm { const bf16_t* A; const bf16_t* Bt; int lda, K; };
struct TileOrder {
    int nM, nN, nwg, G, c, split, off0, off1;
    DI void init(int nM_, int nN_, int G_, int c_, int split_, int off0_, int off1_) { nM = nM_; nN = nN_; nwg = nM * nN; G = G_; c = c_; split = split_; off0 = off0_; off1 = off1_; }
    DI bool next(int i, Unit& u) const {
        const long L = (long)i * G + c; if (L >= nwg) return false;
        int wgid = (int)L; { const int q = nwg / NXCD, r = nwg % NXCD, xcd = wgid % NXCD, off = wgid / NXCD; wgid = (xcd < r ? xcd * (q + 1) : r * (q + 1) + (xcd - r) * q) + off; }
        const int nig = WGM * nN, gid = wgid / nig, fm = gid * WGM, gsz = (nM - fm) < WGM ? (nM - fm) : WGM;
        u.pm = fm + ((wgid % nig) % gsz); const int pnv = (wgid % nig) / gsz; u.pn = pnv < split ? pnv + off0 : pnv - split + off1; return true;
    }
};

enum { EM_INPROJ = 0, EM_GATE = 1, EM_BR_FIRST = 2, EM_BR_MID = 3, EM_BR_LAST = 4, EM_RESID = 5, EM_UP = 6 };
struct Epi {
    int mode;
    bf16_t *o0, *o1, *o2, *o3, *o4;
    float* f0; const float* f1; const float* f2;
    const float *ropec, *ropes;
    DI void operator()(const f32x4 (&acc)[2][2][4][2], const Unit& u, int wr, int wc, int fr, int fq) const {
        const int row0 = u.pm * BM + wr * 64 + fr, colb = u.pn * BM + wc * 32 + 8 * fq;
#pragma unroll
        for (int ai = 0; ai < 2; ++ai)
#pragma unroll
            for (int m = 0; m < 4; ++m) {
                const int row = row0 + ai * HALF + m * 16;
#pragma unroll
                for (int bj = 0; bj < 2; ++bj) {
                    const int col0 = colb + bj * HALF;
                    f32x4 v0 = acc[ai][bj][m][0], v1 = acc[ai][bj][m][1];
                    if (mode == EM_INPROJ) {
                        bf16_t* dst;
                        if (u.pn < 4) {
                            const int pos = row & (SEQ - 1), e0 = (col0 & 63) >> 1;
                            const f32x4 cs = *(const f32x4*)(ropec + pos * 32 + e0), sn = *(const f32x4*)(ropes + pos * 32 + e0);
                            f32x4 a, b;
                            a[0] = v0[0] * cs[0] - v0[1] * sn[0]; a[1] = v0[1] * cs[0] + v0[0] * sn[0];
                            a[2] = v0[2] * cs[1] - v0[3] * sn[1]; a[3] = v0[3] * cs[1] + v0[2] * sn[1];
                            b[0] = v1[0] * cs[2] - v1[1] * sn[2]; b[1] = v1[1] * cs[2] + v1[0] * sn[2];
                            b[2] = v1[2] * cs[3] - v1[3] * sn[3]; b[3] = v1[3] * cs[3] + v1[2] * sn[3];
                            v0 = a; v1 = b;
                            dst = (u.pn < 2) ? o0 + (size_t)row * 512 + col0 : o1 + (size_t)row * 512 + (col0 - 512);
                        } else if (u.pn < 6) { dst = o2 + (size_t)row * 512 + (col0 - 1024); }
                        else if (u.pn < 13) { dst = o3 + (size_t)row * RAWC + (col0 - 1536); }
                        else {
#pragma unroll
                            for (int j = 0; j < 4; ++j) { v0[j] = gelu_tanh(v0[j]); v1[j] = gelu_tanh(v1[j]); }
                            dst = o4 + (size_t)row * 1024 + (col0 - 3328);
                        }
                        u32x4 w; w.x = cvt_pk_bf16(v0[0], v0[1]); w.y = cvt_pk_bf16(v0[2], v0[3]); w.z = cvt_pk_bf16(v1[0], v1[1]); w.w = cvt_pk_bf16(v1[2], v1[3]);
                        *(u32x4*)dst = w;
                    } else if (mode == EM_GATE) {
#pragma unroll
                        for (int j = 0; j < 4; ++j) { v0[j] = sigmoidf_(v0[j]); v1[j] = sigmoidf_(v1[j]); }
                        u32x4 w; w.x = cvt_pk_bf16(v0[0], v0[1]); w.y = cvt_pk_bf16(v0[2], v0[3]); w.z = cvt_pk_bf16(v1[0], v1[1]); w.w = cvt_pk_bf16(v1[2], v1[3]);
                        *(u32x4*)(o0 + (size_t)row * 1024 + col0) = w;
                    } else if (mode == EM_UP) {
                        u32x4 w; w.x = cvt_pk_bf16(v0[0], v0[1]); w.y = cvt_pk_bf16(v0[2], v0[3]); w.z = cvt_pk_bf16(v1[0], v1[1]); w.w = cvt_pk_bf16(v1[2], v1[3]);
                        *(u32x4*)(o0 + (size_t)row * UPC + col0) = w;
                    } else if (mode == EM_RESID) {
                        const size_t off = (size_t)row * 1024 + col0;
                        const float* gv = f2 + (size_t)(row >> 12) * 6144 + col0;
                        const f32x4 g0 = *(const f32x4*)gv, g1 = *(const f32x4*)(gv + 4);
                        const f32x4 b0 = *(const f32x4*)(f1 + off), b1 = *(const f32x4*)(f1 + off + 4);
                        *(f32x4*)(f0 + off) = b0 + g0 * v0; *(f32x4*)(f0 + off + 4) = b1 + g1 * v1;
                    } else {
                        const size_t off = (size_t)row * 1024 + col0;
                        const u32x4 gw = *(const u32x4*)(o0 + off);
                        f32x4 r0, r1;
                        r0[0] = bf_lo(gw.x) * v0[0]; r0[1] = bf_hi(gw.x) * v0[1]; r0[2] = bf_lo(gw.y) * v0[2]; r0[3] = bf_hi(gw.y) * v0[3];
                        r1[0] = bf_lo(gw.z) * v1[0]; r1[1] = bf_hi(gw.z) * v1[1]; r1[2] = bf_lo(gw.w) * v1[2]; r1[3] = bf_hi(gw.w) * v1[3];
                        if (mode != EM_BR_FIRST) { r0 += *(const f32x4*)(f0 + off); r1 += *(const f32x4*)(f0 + off + 4); }
                        if (mode == EM_BR_LAST) {
                            u32x4 w; w.x = cvt_pk_bf16(r0[0], r0[1]); w.y = cvt_pk_bf16(r0[2], r0[3]); w.z = cvt_pk_bf16(r1[0], r1[1]); w.w = cvt_pk_bf16(r1[2], r1[3]);
                            *(u32x4*)(o1 + off) = w;
                        } else { *(f32x4*)(f0 + off) = r0; *(f32x4*)(f0 + off + 4) = r1; }
                    }
                }
            }
    }
};

DI void gemm_phase(LAS unsigned char* lds, const Gemm g, const TileOrder S, const Epi E, int wv) {
    const int tid = otid(wv), wid = __builtin_amdgcn_readfirstlane(tid >> 6), lane = tid & 63, wr = wid >> 2, wc = wid & 3, fr = lane & 15, fq = lane >> 4;
    const int K = g.K, nt = K / BK, lda = g.lda;
    unsigned voffA[2], voffB[2];
#pragma unroll
    for (int i = 0; i < 2; ++i) { int R, C; stage_rc(tid * 16 + i * 8192, R, C); const int Rb = (R & ~31) + perm32(R & 31);
        voffA[i] = (unsigned)(R * lda + C) * 2u; voffB[i] = (unsigned)(Rb * K + C) * 2u; }
    const size_t kstep = (size_t)(BK * 2);
    const size_t hstepA = (size_t)HALF * lda * 2, hstepB = (size_t)HALF * K * 2;
    const size_t tstepA = 2 * hstepA, tstepB = 2 * hstepB;
    const unsigned ldsw = (unsigned)wid * 1024u;
    const int aoff = lds_byte(wr * 64 + fr, fq * 8), boff = lds_byte(wc * 32 + fr, fq * 8);
#define PG8_SA(b, h) (((b) * 2 + (h)) * HTB)
#define PG8_SB(b, h) ((4 + (b) * 2 + (h)) * HTB)
#define PG8_STAGE(bufoff, gbase, voff) do { _Pragma("unroll") for (int _i = 0; _i < 2; ++_i) \
        __builtin_amdgcn_global_load_lds((const unsigned*)((const char*)(gbase) + (voff)[_i]), (LAS unsigned*)(lds + (bufoff) + ldsw + _i * 8192), 16, 0, 0); } while (0)
#define PG8_LDA(dst, b, h) do { _Pragma("unroll") for (int m = 0; m < 4; ++m) _Pragma("unroll") for (int k = 0; k < 2; ++k) dst[m][k] = *(const LAS bf16x8*)(lds + PG8_SA(b, h) + aoff + m * 2048 + k * 1024); } while (0)
#define PG8_LDB(dst, b, h) do { _Pragma("unroll") for (int n = 0; n < 2; ++n) _Pragma("unroll") for (int k = 0; k < 2; ++k) dst[n][k] = *(const LAS bf16x8*)(lds + PG8_SB(b, h) + boff + n * 2048 + k * 1024); } while (0)
#define PG8_MMA(ai, bj, At, Bt) do { __builtin_amdgcn_s_setprio(1); _Pragma("unroll") for (int m = 0; m < 4; ++m) _Pragma("unroll") for (int n = 0; n < 2; ++n) _Pragma("unroll") for (int k = 0; k < 2; ++k) \
        acc[ai][bj][m][n] = __builtin_amdgcn_mfma_f32_16x16x32_bf16(Bt[n][k], At[m][k], acc[ai][bj][m][n], 0, 0, 0); __builtin_amdgcn_s_setprio(0); } while (0)
#define PG8_WAIT_V(n) asm volatile("s_waitcnt vmcnt(" #n ")" ::: "memory")
#define PG8_WAIT_L(n) asm volatile("s_waitcnt lgkmcnt(" #n ")" ::: "memory")
#define PG8_BAR __builtin_amdgcn_s_barrier()
#define PG8_SCHED __builtin_amdgcn_sched_barrier(0)
    Unit cur, nxt; int ui = 0;
    if (!S.next(0, cur)) return;
    f32x4 acc[2][2][4][2];
#pragma unroll
    for (int a = 0; a < 2; ++a)
#pragma unroll
        for (int b = 0; b < 2; ++b)
#pragma unroll
            for (int m = 0; m < 4; ++m)
#pragma unroll
                for (int n = 0; n < 2; ++n) acc[a][b][m][n] = (f32x4){0.f, 0.f, 0.f, 0.f};
    bf16x8 At[4][2], B0[2][2], B1[2][2];
    const char* cA = (const char*)g.A + (size_t)cur.pm * tstepA; const char* cB = (const char*)g.Bt + (size_t)cur.pn * tstepB;
    PG8_STAGE(PG8_SB(0, 0), cB, voffB); PG8_STAGE(PG8_SA(0, 0), cA, voffA); PG8_STAGE(PG8_SB(0, 1), cB + hstepB, voffB); PG8_STAGE(PG8_SA(0, 1), cA + hstepA, voffA);
    if (wr == 1) PG8_BAR;
    PG8_WAIT_V(4); PG8_BAR;
    PG8_STAGE(PG8_SB(1, 0), cB + kstep, voffB); PG8_STAGE(PG8_SA(1, 0), cA + kstep, voffA); PG8_STAGE(PG8_SB(1, 1), cB + hstepB + kstep, voffB);
    PG8_WAIT_V(6); PG8_BAR;
    for (;;) {
        const bool has_next = S.next(ui + 1, nxt);
        const char* nA = has_next ? (const char*)g.A + (size_t)nxt.pm * tstepA : cA; const char* nB = has_next ? (const char*)g.Bt + (size_t)nxt.pn * tstepB : cB;
        for (int t = 0; t < nt; t += 2) {
            const bool last = (t == nt - 2);
            const char* a1 = cA + (size_t)(t + 1) * kstep;
            const char* a2 = last ? nA : cA + (size_t)(t + 2) * kstep; const char* b2 = last ? nB : cB + (size_t)(t + 2) * kstep;
            const char* a3 = a2 + kstep; const char* b3 = b2 + kstep;
            PG8_LDB(B0, 0, 0); PG8_SCHED; PG8_LDA(At, 0, 0); PG8_STAGE(PG8_SA(1, 1), a1 + hstepA, voffA);
            PG8_WAIT_L(8); PG8_BAR; PG8_WAIT_L(0); PG8_MMA(0, 0, At, B0); PG8_BAR; PG8_SCHED;
            PG8_LDB(B1, 0, 1); PG8_STAGE(PG8_SB(0, 0), b2, voffB);
            PG8_BAR; PG8_WAIT_L(0); PG8_MMA(0, 1, At, B1); PG8_BAR;
            PG8_LDA(At, 0, 1); PG8_STAGE(PG8_SA(0, 0), a2, voffA);
            PG8_BAR; PG8_WAIT_L(0); PG8_MMA(1, 0, At, B0); PG8_BAR; PG8_SCHED;
            PG8_STAGE(PG8_SB(0, 1), b2 + hstepB, voffB);
            PG8_WAIT_V(6); PG8_BAR; PG8_MMA(1, 1, At, B1); PG8_BAR;
            PG8_LDB(B0, 1, 0); PG8_SCHED; PG8_LDA(At, 1, 0); PG8_STAGE(PG8_SA(0, 1), a2 + hstepA, voffA);
            PG8_WAIT_L(8); PG8_BAR; PG8_WAIT_L(0); PG8_MMA(0, 0, At, B0); PG8_BAR; PG8_SCHED;
            PG8_LDB(B1, 1, 1); PG8_STAGE(PG8_SB(1, 0), b3, voffB);
            PG8_BAR; PG8_WAIT_L(0); PG8_MMA(0, 1, At, B1); PG8_BAR;
            PG8_LDA(At, 1, 1); PG8_STAGE(PG8_SA(1, 0), a3, voffA);
            PG8_BAR; PG8_WAIT_L(0); PG8_MMA(1, 0, At, B0); PG8_BAR; PG8_SCHED;
            PG8_STAGE(PG8_SB(1, 1), b3 + hstepB, voffB);
            PG8_WAIT_V(6); PG8_BAR; PG8_MMA(1, 1, At, B1); PG8_BAR;
        }
        E(acc, cur, wr, wc, fr, fq);
        if (!has_next) break;
#pragma unroll
        for (int a = 0; a < 2; ++a)
#pragma unroll
            for (int b = 0; b < 2; ++b)
#pragma unroll
                for (int m = 0; m < 4; ++m)
#pragma unroll
                    for (int n = 0; n < 2; ++n) acc[a][b][m][n] = (f32x4){0.f, 0.f, 0.f, 0.f};
        cur = nxt; cA = nA; cB = nB; ++ui;
    }
    PG8_WAIT_V(0);
    if (wr == 0) PG8_BAR;
    PG8_BAR;
#undef PG8_SA
#undef PG8_SB
#undef PG8_STAGE
#undef PG8_LDA
#undef PG8_LDB
#undef PG8_MMA
#undef PG8_WAIT_V
#undef PG8_WAIT_L
#undef PG8_BAR
#undef PG8_SCHED
}
}

template <bool QKPERM>
DI void transpose_item(const float* W, int K, int N, bf16_t* WT, LAS float* scr, int item, int lane) {
    const int nblk = N / 32, kb = item / nblk, nb = item % nblk, k0 = 64 * kb, n0 = 32 * nb;
    int sc = n0 + (lane & 31);
    if (QKPERM && sc < 1024) { const int hd = sc >> 6, cp = sc & 63; sc = hd * 64 + 32 * (cp & 1) + (cp >> 1); }
#pragma unroll 8
    for (int i = 0; i < 32; ++i) { const int kk = 2 * i + (lane >> 5); scr[kk * 33 + (lane & 31)] = W[(size_t)(k0 + kk) * N + sc]; }
    LDS_WAIT();
    const int c = lane & 7;
#pragma unroll
    for (int j = 0; j < 4; ++j) { const int n = (lane >> 3) + 8 * j; const LAS float* s = scr + (8 * c) * 33 + n;
        u32x4 o; o.x = cvt_pk_bf16(s[0 * 33], s[1 * 33]); o.y = cvt_pk_bf16(s[2 * 33], s[3 * 33]); o.z = cvt_pk_bf16(s[4 * 33], s[5 * 33]); o.w = cvt_pk_bf16(s[6 * 33], s[7 * 33]);
        *(u32x4*)(WT + (size_t)(n0 + n) * K + k0 + 8 * c) = o; }
    LDS_WAIT();
}

DI void convert_weights(KP p, int l, LAS unsigned char* lds, int wv) {
    const int tid_ = otid(wv); const int wave = tid_ >> 6, lane = tid_ & 63;
    LAS float* scr = (LAS float*)(lds + wave * 8448);
    const int gw = blockIdx.x * 8 + wave, NGW = gridDim.x * 8;
    constexpr int I_IN = 16 * (INC / 32), I_BR = 8 * 32, I_OUT = 16 * 32, I_UP = 16 * (UPC / 32), I_DN = (DFF / 64) * 32, I_L64 = 16, I_L128 = 32;
    constexpr int NIT = I_IN + 3 * I_BR + I_OUT + I_UP + I_DN + 2 * I_L64 + I_L128;
    unsigned char* ws = ows(p->ws);
    for (int it = gw; it < NIT; it += NGW) {
        int r = it;
        if (r < I_IN) { transpose_item<true>(p->in[5] + (size_t)l * 1024 * INC, 1024, INC, (bf16_t*)(ws + WS_WIN), scr, r, lane); continue; } r -= I_IN;
        if (r < 3 * I_BR) { const int b = r / I_BR; transpose_item<false>(p->in[21] + ((size_t)l * 3 + b) * 512 * 1024, 512, 1024, (bf16_t*)(ws + WS_WBR) + (size_t)b * 1024 * 512, scr, r % I_BR, lane); continue; } r -= 3 * I_BR;
        if (r < I_OUT) { transpose_item<false>(p->in[22] + (size_t)l * 1024 * 1024, 1024, 1024, (bf16_t*)(ws + WS_WOUT), scr, r, lane); continue; } r -= I_OUT;
        if (r < I_UP) { transpose_item<false>(p->in[24] + (size_t)l * 1024 * UPC, 1024, UPC, (bf16_t*)(ws + WS_WUP), scr, r, lane); continue; } r -= I_UP;
        if (r < I_DN) { transpose_item<false>(p->in[27] + (size_t)l * DFF * 1024, DFF, 1024, (bf16_t*)(ws + WS_WDN), scr, r, lane); continue; } r -= I_DN;
        if (r < I_L64) { transpose_item<false>(p->in[8] + (size_t)l * 64 * 512, 64, 512, (bf16_t*)(ws + WS_LWU), scr, r, lane); continue; } r -= I_L64;
        if (r < I_L64) { transpose_item<false>(p->in[10] + (size_t)l * 64 * 512, 64, 512, (bf16_t*)(ws + WS_LAU), scr, r, lane); continue; } r -= I_L64;
        transpose_item<false>(p->in[11] + (size_t)l * 128 * 512, 128, 512, (bf16_t*)(ws + WS_LGU), scr, r, lane);
    }
}

DI void phase0(KP p, LAS unsigned char* lds, int wv) {
    const int tid = otid(wv);
    float* ropec = (float*)(p->ws + WS_ROPEC); float* ropes = (float*)(p->ws + WS_ROPES);
    for (int idx = blockIdx.x * 512 + tid; idx < SEQ * 32; idx += gridDim.x * 512) {
        const int pos = idx >> 5, e = idx & 31;
        const float inv = 1.0f / exp2f((float)e * (13.287712379549449f / 32.0f));
        const float ang = (float)pos * inv;
        double rev = (double)ang * 0.15915494309189535; rev -= rint(rev);
        const float rv = (float)rev;
        ropec[idx] = __builtin_amdgcn_cosf(rv); ropes[idx] = __builtin_amdgcn_sinf(rv);
    }
    {
        LAS float* ca = (LAS float*)lds;
        LAS float* red = (LAS float*)(lds + 16384);
        float* mod = (float*)(p->ws + WS_MOD);
        bool loaded = false;
        for (int item = blockIdx.x; item < 192; item += gridDim.x) {
            if (!loaded) { for (int i = tid; i < 4096; i += 512) { const float v = p->in[1][i]; ca[i] = v / (1.0f + __expf(-v)); } loaded = true; __syncthreads(); }
            const int l = item / 96, c0 = (item % 96) * 64, cc = tid & 63, kg = tid >> 6;
            const float* w = p->in[2] + (size_t)l * 1024 * 6144 + c0 + cc;
            float a0 = 0.f, a1 = 0.f, a2 = 0.f, a3 = 0.f;
#pragma unroll 8
            for (int k = kg * 128; k < kg * 128 + 128; ++k) { const float wv = w[(size_t)k * 6144]; a0 += ca[k] * wv; a1 += ca[1024 + k] * wv; a2 += ca[2048 + k] * wv; a3 += ca[3072 + k] * wv; }
            red[(kg * 4 + 0) * 64 + cc] = a0; red[(kg * 4 + 1) * 64 + cc] = a1; red[(kg * 4 + 2) * 64 + cc] = a2; red[(kg * 4 + 3) * 64 + cc] = a3;
            __syncthreads();
            if (tid < 256) { const int b = tid >> 6; float s = 0.f;
#pragma unroll
                for (int g = 0; g < 8; ++g) s += red[(g * 4 + b) * 64 + cc];
                mod[((size_t)l * 4 + b) * 6144 + c0 + cc] = s + p->in[3][(size_t)l * 6144 + c0 + cc]; }
            __syncthreads();
        }
        __syncthreads();
    }
    convert_weights(p, 0, lds, wv);
}

DI void norm_mod_phase(const float* x, const float* g, const float* sh, const float* sc, bf16_t* H, int wv) {
    const int tid_ = otid(wv); const int wave = tid_ >> 6, lane = tid_ & 63;
    for (int row0 = (blockIdx.x * 8 + wave) * 2; row0 < MTOK; row0 += gridDim.x * 16) {
        f32x4 v[2][4]; float s[2] = {0.f, 0.f};
#pragma unroll
        for (int q = 0; q < 2; ++q) { const f32x4* xr = (const f32x4*)(x + (size_t)(row0 + q) * DM) + lane;
#pragma unroll
            for (int j = 0; j < 4; ++j) v[q][j] = xr[64 * j]; }
#pragma unroll
        for (int q = 0; q < 2; ++q)
#pragma unroll
            for (int j = 0; j < 4; ++j) s[q] += (v[q][j][0] * v[q][j][0] + v[q][j][1] * v[q][j][1]) + (v[q][j][2] * v[q][j][2] + v[q][j][3] * v[q][j][3]);
        const float rs0 = rsqrtf(wave_sum(s[0]) * (1.0f / DM) + 1e-6f), rs1 = rsqrtf(wave_sum(s[1]) * (1.0f / DM) + 1e-6f);
        const int b = row0 >> 12;
#pragma unroll
        for (int j = 0; j < 4; ++j) {
            const int c = 4 * lane + 256 * j;
            const f32x4 gg = *(const f32x4*)(g + c), s1 = *(const f32x4*)(sc + (size_t)b * 6144 + c), s0 = *(const f32x4*)(sh + (size_t)b * 6144 + c);
#pragma unroll
            for (int q = 0; q < 2; ++q) {
                const f32x4 h = (v[q][j] * (q ? rs1 : rs0) * gg) * (s1 + 1.0f) + s0;
                u32x2 w; w.x = cvt_pk_bf16(h[0], h[1]); w.y = cvt_pk_bf16(h[2], h[3]);
                *((u32x2*)(H + (size_t)(row0 + q) * DM) + lane + 64 * j) = w;
            }
        }
    }
}
DI void final_norm_phase(float* x, const float* g, int wv) {
    const int tid_ = otid(wv); const int wave = tid_ >> 6, lane = tid_ & 63;
    for (int row = blockIdx.x * 8 + wave; row < MTOK; row += gridDim.x * 8) {
        f32x4* xr = (f32x4*)(x + (size_t)row * DM) + lane;
        f32x4 v[4]; float s = 0.f;
#pragma unroll
        for (int j = 0; j < 4; ++j) { v[j] = xr[64 * j]; s += (v[j][0] * v[j][0] + v[j][1] * v[j][1]) + (v[j][2] * v[j][2] + v[j][3] * v[j][3]); }
        const float rs = rsqrtf(wave_sum(s) * (1.0f / DM) + 1e-6f);
#pragma unroll
        for (int j = 0; j < 4; ++j) { const f32x4 gg = *(const f32x4*)(g + 4 * lane + 256 * j); xr[64 * j] = v[j] * rs * gg; }
    }
}

DI bf16x8 lerp_frag(const bf16_t* cur, const bf16_t* prv, bool hasprev, const float* mu, int act) {
    const u32x4 c = *(const u32x4*)cur; u32x4 q = {0u, 0u, 0u, 0u}; if (hasprev) q = *(const u32x4*)prv;
    const f32x4 m0 = *(const f32x4*)mu, m1 = *(const f32x4*)(mu + 4);
    float z[8];
    const unsigned cw[4] = {c.x, c.y, c.z, c.w}, qw[4] = {q.x, q.y, q.z, q.w};
#pragma unroll
    for (int j = 0; j < 4; ++j) {
        const float c0 = bf_lo(cw[j]), c1 = bf_hi(cw[j]), p0 = bf_lo(qw[j]), p1 = bf_hi(qw[j]);
        const float mA = (j < 2) ? m0[2 * j] : m1[2 * j - 4], mB = (j < 2) ? m0[2 * j + 1] : m1[2 * j - 3];
        z[2 * j] = c0 + (p0 - c0) * mA; z[2 * j + 1] = c1 + (p1 - c1) * mB;
    }
#pragma unroll
    for (int j = 0; j < 8; ++j) {
        if (act == 1) { const float e = __expf(2.0f * z[j]); z[j] = 1.0f - 2.0f / (1.0f + e); }
        else if (act == 2) z[j] = sigmoidf_(z[j]);
    }
    return pack8(z[0], z[1], z[2], z[3], z[4], z[5], z[6], z[7]);
}

DI void rwkv_derived_phase(KP p0, int l, int wv) {
    const int tid_ = otid(wv); const int wave = tid_ >> 6, lane = tid_ & 63, r = lane & 31, hh = lane >> 5;
    for (int job = blockIdx.x * 8 + wave; job < 512 * 8; job += gridDim.x * 8) {
        KP p = okp(); unsigned char* ws = ows(p->ws);
        const bf16_t* RAW = (const bf16_t*)(ws + WS_RAW);
        bf16_t *RZ = (bf16_t*)(ws + WS_RZ), *KP = (bf16_t*)(ws + WS_KP), *VZ = (bf16_t*)(ws + WS_VZ), *KKN = (bf16_t*)(ws + WS_KKN), *Bv = (bf16_t*)(ws + WS_B), *G = (bf16_t*)(ws + WS_G);
        float* W = (float*)(ws + WS_W);
        const bf16_t *LWU = (const bf16_t*)(ws + WS_LWU), *LAU = (const bf16_t*)(ws + WS_LAU), *LGU = (const bf16_t*)(ws + WS_LGU);
        const float* mu = p->in[6] + (size_t)l * RAWC; const float* w0 = p->in[7] + l * 512; const float* a0 = p->in[9] + l * 512;
        const float* k_k = p->in[12] + l * 512; const float* k_a = p->in[13] + l * 512; const float* r_k = p->in[14] + l * 512;
        const int hd = job & 7, tg = job >> 3, t = tg * 32 + r;
        const bool hp = (t & (SEQ - 1)) != 0;
        const bf16_t* cur = RAW + (size_t)t * RAWC; const bf16_t* prv = cur - RAWC;
        float ss = 0.f;
#pragma unroll
        for (int q = 0; q < 8; ++q) {
            const int c = hd * 64 + 8 * q + 4 * hh;
            const u32x2 kc = *(const u32x2*)(cur + 512 + c); u32x2 kq = {0u, 0u}; if (hp) kq = *(const u32x2*)(prv + 512 + c);
            const f32x4 mk = *(const f32x4*)(mu + 512 + c), kkw = *(const f32x4*)(k_k + c);
            const float kcur[4] = {bf_lo(kc.x), bf_hi(kc.x), bf_lo(kc.y), bf_hi(kc.y)}, kprv[4] = {bf_lo(kq.x), bf_hi(kq.x), bf_lo(kq.y), bf_hi(kq.y)};
#pragma unroll
            for (int j = 0; j < 4; ++j) { const float kk = (kcur[j] + (kprv[j] - kcur[j]) * mk[j]) * kkw[j]; ss += kk * kk; }
        }
        ss += __shfl_xor(ss, 32);
        const float inv = 1.0f / fmaxf(sqrtf(ss), 1e-12f);
        float bonus = 0.f;
        {
            bf16x8 bw[4], ba[4];
#pragma unroll
            for (int s = 0; s < 4; ++s) { const int o = 16 * s + 8 * hh; bw[s] = lerp_frag(cur + 1536 + o, prv + 1536 + o, hp, mu + 1536 + o, 1); ba[s] = lerp_frag(cur + 1600 + o, prv + 1600 + o, hp, mu + 1600 + o, 0); }
#pragma unroll 1
            for (int mt = 0; mt < 2; ++mt) {
                const int chr = hd * 64 + 32 * mt + r;
                f32x16 aw, aa;
#pragma unroll
                for (int i = 0; i < 16; ++i) { aw[i] = 0.f; aa[i] = 0.f; }
                {
                    typedef const __attribute__((address_space(1))) bf16x8* GP8;
                    const GP8 pw = (GP8)(LWU + (size_t)chr * 64 + 8 * hh), pa = (GP8)(LAU + (size_t)chr * 64 + 8 * hh);
                    bf16x8 fw[4], fa[4];
#pragma unroll
                    for (int s = 0; s < 4; ++s) { fw[s] = pw[2 * s]; fa[s] = pa[2 * s]; }
                    asm volatile("" ::: "memory");
#pragma unroll
                    for (int s = 0; s < 4; ++s) { aw = MFMA32(fw[s], bw[s], aw); aa = MFMA32(fa[s], ba[s], aa); }
                }
#pragma unroll
                for (int i4 = 0; i4 < 4; ++i4) {
                    const int c = hd * 64 + 32 * mt + 8 * i4 + 4 * hh;
                    const u32x2 rc = *(const u32x2*)(cur + c), kc = *(const u32x2*)(cur + 512 + c), vc = *(const u32x2*)(cur + 1024 + c);
                    u32x2 rp = {0u, 0u}, kq = {0u, 0u}, vp = {0u, 0u};
                    if (hp) { rp = *(const u32x2*)(prv + c); kq = *(const u32x2*)(prv + 512 + c); vp = *(const u32x2*)(prv + 1024 + c); }
                    const f32x4 mr = *(const f32x4*)(mu + c), mk = *(const f32x4*)(mu + 512 + c), mv = *(const f32x4*)(mu + 1024 + c);
                    const f32x4 w0v = *(const f32x4*)(w0 + c), a0v = *(const f32x4*)(a0 + c), kkw = *(const f32x4*)(k_k + c), kaw = *(const f32x4*)(k_a + c), rkw = *(const f32x4*)(r_k + c);
                    const float rcur[4] = {bf_lo(rc.x), bf_hi(rc.x), bf_lo(rc.y), bf_hi(rc.y)}, rprv[4] = {bf_lo(rp.x), bf_hi(rp.x), bf_lo(rp.y), bf_hi(rp.y)};
                    const float kcur[4] = {bf_lo(kc.x), bf_hi(kc.x), bf_lo(kc.y), bf_hi(kc.y)}, kprv[4] = {bf_lo(kq.x), bf_hi(kq.x), bf_lo(kq.y), bf_hi(kq.y)};
                    const float vcur[4] = {bf_lo(vc.x), bf_hi(vc.x), bf_lo(vc.y), bf_hi(vc.y)}, vprv[4] = {bf_lo(vp.x), bf_hi(vp.x), bf_lo(vp.y), bf_hi(vp.y)};
                    f32x4 dec; float rz[4], kp[4], vz[4], kn[4], bb[4];
#pragma unroll
                    for (int j = 0; j < 4; ++j) {
                        const int i = 4 * i4 + j;
                        const float zz = -(w0v[j] + aw[i]);
                        const float sp = (zz > 20.f) ? zz : __logf(1.0f + __expf(zz));
                        const float wv = -sp - 0.5f;
                        dec[j] = __expf(-__expf(wv));
                        const float av = sigmoidf_(a0v[j] + aa[i]);
                        rz[j] = rcur[j] + (rprv[j] - rcur[j]) * mr[j];
                        const float kz = kcur[j] + (kprv[j] - kcur[j]) * mk[j];
                        vz[j] = vcur[j] + (vprv[j] - vcur[j]) * mv[j];
                        kn[j] = kz * kkw[j] * inv; bb[j] = kn[j] * av;
                        kp[j] = kz * (1.0f + (av - 1.0f) * kaw[j]);
                        bonus += rz[j] * kp[j] * rkw[j];
                    }
                    const size_t o = (size_t)t * 512 + c;
                    *(f32x4*)(W + o) = dec;
                    u32x2 w2; w2.x = cvt_pk_bf16(rz[0], rz[1]); w2.y = cvt_pk_bf16(rz[2], rz[3]); *(u32x2*)(RZ + o) = w2;
                    w2.x = cvt_pk_bf16(kp[0], kp[1]); w2.y = cvt_pk_bf16(kp[2], kp[3]); *(u32x2*)(KP + o) = w2;
                    w2.x = cvt_pk_bf16(vz[0], vz[1]); w2.y = cvt_pk_bf16(vz[2], vz[3]); *(u32x2*)(VZ + o) = w2;
                    w2.x = cvt_pk_bf16(kn[0], kn[1]); w2.y = cvt_pk_bf16(kn[2], kn[3]); *(u32x2*)(KKN + o) = w2;
                    w2.x = cvt_pk_bf16(bb[0], bb[1]); w2.y = cvt_pk_bf16(bb[2], bb[3]); *(u32x2*)(Bv + o) = w2;
                }
            }
        }
        bonus += __shfl_xor(bonus, 32);
        int t2 = t; asm volatile("" : "+v"(t2));
        if (hh == 0) ((float*)(ows(ws) + WS_BONUS))[(size_t)t2 * 8 + hd] = bonus;
        {
            bf16x8 bg[8];
#pragma unroll
            for (int s = 0; s < 8; ++s) { const int o = 16 * s + 8 * hh; bg[s] = lerp_frag(cur + 1664 + o, prv + 1664 + o, hp, mu + 1664 + o, 2); }
#pragma unroll 1
            for (int mt = 0; mt < 2; ++mt) {
                const int chr = hd * 64 + 32 * mt + r;
                f32x16 ag;
#pragma unroll
                for (int i = 0; i < 16; ++i) ag[i] = 0.f;
                {
                    typedef const __attribute__((address_space(1))) bf16x8* GP8;
                    const GP8 pg = (GP8)(LGU + (size_t)chr * 128 + 8 * hh);
                    bf16x8 fg[8];
#pragma unroll
                    for (int s = 0; s < 8; ++s) fg[s] = pg[2 * s];
                    asm volatile("" ::: "memory");
#pragma unroll
                    for (int s = 0; s < 8; ++s) ag = MFMA32(fg[s], bg[s], ag);
                }
#pragma unroll
                for (int i4 = 0; i4 < 4; ++i4) {
                    const size_t o = (size_t)t2 * 512 + hd * 64 + 32 * mt + 8 * i4 + 4 * hh;
                    u32x2 w2; w2.x = cvt_pk_bf16(ag[4 * i4], ag[4 * i4 + 1]); w2.y = cvt_pk_bf16(ag[4 * i4 + 2], ag[4 * i4 + 3]); *(u32x2*)(G + o) = w2;
                }
            }
        }
    }
}

constexpr int SC_T = 32, SC_STEP = 1344, SC_BUF = SC_T * SC_STEP;
struct ScanRegs { f32x4 w0, w1; u32x4 kn, bb, kp, rz, vv; };
DI void scan_gload(KP p, ScanRegs& R, int b, int h, int rg, int ck, int pt) {
    const unsigned char* ws = ows(p->ws);
    const size_t tok0 = (size_t)b * SEQ + (size_t)ck * SC_T;
    { const int st = pt >> 4, sub = pt & 15; R.w0 = *(const f32x4*)((const float*)(ws + WS_W) + (tok0 + st) * 512 + h * 64 + 4 * sub); }
    { const int pp = pt + 256, st = pp >> 4, sub = pp & 15; R.w1 = *(const f32x4*)((const float*)(ws + WS_W) + (tok0 + st) * 512 + h * 64 + 4 * sub); }
    const int st = pt >> 3, sub = pt & 7; const size_t go = (tok0 + st) * 512 + h * 64 + 8 * sub;
    R.kn = *(const u32x4*)((const bf16_t*)(ws + WS_KKN) + go); R.bb = *(const u32x4*)((const bf16_t*)(ws + WS_B) + go);
    R.kp = *(const u32x4*)((const bf16_t*)(ws + WS_KP) + go); R.rz = *(const u32x4*)((const bf16_t*)(ws + WS_RZ) + go);
    R.vv = (u32x4){0u, 0u, 0u, 0u};
    if (pt < 64) { const int s2 = pt >> 1, hf = pt & 1; R.vv = *(const u32x4*)((const bf16_t*)(ws + WS_VZ) + (tok0 + s2) * 512 + h * 64 + rg * 16 + 8 * hf); }
}
DI void scan_write(const ScanRegs& R, LAS unsigned char* buf, int pt) {
    { const int st = pt >> 4, sub = pt & 15; *(LAS f32x4*)(buf + st * SC_STEP + sub * 16) = R.w0; }
    { const int pp = pt + 256, st = pp >> 4, sub = pp & 15; *(LAS f32x4*)(buf + st * SC_STEP + sub * 16) = R.w1; }
    const int st = pt >> 3, sub = pt & 7;
    const u32x4 kn = R.kn, bb = R.bb, kp = R.kp, rz = R.rz;
    LAS unsigned char* d = buf + st * SC_STEP + sub * 32;
    *(LAS f32x4*)(d + 256) = (f32x4){-bf_lo(kn.x), -bf_hi(kn.x), -bf_lo(kn.y), -bf_hi(kn.y)}; *(LAS f32x4*)(d + 256 + 16) = (f32x4){-bf_lo(kn.z), -bf_hi(kn.z), -bf_lo(kn.w), -bf_hi(kn.w)};
    *(LAS f32x4*)(d + 512) = (f32x4){bf_lo(bb.x), bf_hi(bb.x), bf_lo(bb.y), bf_hi(bb.y)}; *(LAS f32x4*)(d + 512 + 16) = (f32x4){bf_lo(bb.z), bf_hi(bb.z), bf_lo(bb.w), bf_hi(bb.w)};
    *(LAS f32x4*)(d + 768) = (f32x4){bf_lo(kp.x), bf_hi(kp.x), bf_lo(kp.y), bf_hi(kp.y)}; *(LAS f32x4*)(d + 768 + 16) = (f32x4){bf_lo(kp.z), bf_hi(kp.z), bf_lo(kp.w), bf_hi(kp.w)};
    *(LAS f32x4*)(d + 1024) = (f32x4){bf_lo(rz.x), bf_hi(rz.x), bf_lo(rz.y), bf_hi(rz.y)}; *(LAS f32x4*)(d + 1024 + 16) = (f32x4){bf_lo(rz.z), bf_hi(rz.z), bf_lo(rz.w), bf_hi(rz.w)};
    if (pt < 64) { const int s2 = pt >> 1, hf = pt & 1; const u32x4 vv = R.vv;
        LAS unsigned char* dv = buf + s2 * SC_STEP + 1280 + hf * 32;
        *(LAS f32x4*)dv = (f32x4){bf_lo(vv.x), bf_hi(vv.x), bf_lo(vv.y), bf_hi(vv.y)}; *(LAS f32x4*)(dv + 16) = (f32x4){bf_lo(vv.z), bf_hi(vv.z), bf_lo(vv.w), bf_hi(vv.w)}; }
}
DI void rwkv_scan_phase(KP p, LAS unsigned char* lds, int wv) {
    const int tid = otid(wv), wave = tid >> 6, lane = tid & 63;
    float* YRAW = (float*)(p->ws + WS_YRAW);
    for (int job = blockIdx.x; job < 128; job += gridDim.x) {
        const int chain = job >> 2, rg = job & 3, b = chain >> 3, h = chain & 7;
        __syncthreads();
        ScanRegs R;
        if (wave >= 4) { scan_gload(p, R, b, h, rg, 0, tid - 256); scan_write(R, lds, tid - 256); scan_gload(p, R, b, h, rg, 1, tid - 256); }
        __syncthreads();
        f32x4 S = {0.f, 0.f, 0.f, 0.f};
        const int jl = lane & 15, rl = 4 * (wave & 3) + (lane >> 4);
        for (int ck = 0; ck < SEQ / SC_T; ++ck) {
            LAS unsigned char* cb = lds + (ck & 1) * SC_BUF;
            if (wave >= 4) { if (ck + 1 < SEQ / SC_T) { scan_write(R, lds + ((ck + 1) & 1) * SC_BUF, tid - 256); if (ck + 2 < SEQ / SC_T) scan_gload(p, R, b, h, rg, ck + 2, tid - 256); } }
            else {
                float* yo = YRAW + ((size_t)b * SEQ + (size_t)ck * SC_T + jl) * 512 + h * 64 + rg * 16 + rl;
                const LAS unsigned char* sb = cb + jl * 16; const LAS unsigned char* vb = cb + 1280 + rl * 4;
                f32x4 w4 = *(const LAS f32x4*)sb, an = *(const LAS f32x4*)(sb + 256), b4 = *(const LAS f32x4*)(sb + 512), k4 = *(const LAS f32x4*)(sb + 768), r4 = *(const LAS f32x4*)(sb + 1024);
                float vi = *(const LAS float*)vb;
                float ysel = 0.f;
#pragma unroll
                for (int s = 0; s < SC_T; ++s) {
                    f32x4 w4n = w4, ann = an, b4n = b4, k4n = k4, r4n = r4; float vin = vi;
                    if (s + 1 < SC_T) {
                        const LAS unsigned char* sn = sb + (s + 1) * SC_STEP;
                        w4n = *(const LAS f32x4*)sn; ann = *(const LAS f32x4*)(sn + 256); b4n = *(const LAS f32x4*)(sn + 512); k4n = *(const LAS f32x4*)(sn + 768); r4n = *(const LAS f32x4*)(sn + 1024);
                        vin = *(const LAS float*)(vb + (s + 1) * SC_STEP);
                    }
                    float sa = (S[0] * an[0] + S[1] * an[1]) + (S[2] * an[2] + S[3] * an[3]);
                    sa = row16_sum(sa);
                    S = S * w4 + (b4 * sa + k4 * vi);
                    float y = (S[0] * r4[0] + S[1] * r4[1]) + (S[2] * r4[2] + S[3] * r4[3]);
                    y = row16_sum(y);
                    ysel = (jl == (s & 15)) ? y : ysel;
                    if ((s & 15) == 15) yo[(size_t)(s - 15) * 512] = ysel;
                    w4 = w4n; an = ann; b4 = b4n; k4 = k4n; r4 = r4n; vi = vin;
                }
            }
            __syncthreads();
        }
    }
}

DI void rwkv_post_phase(KP p, int l, int wv) {
    const unsigned char* ws = ows(p->ws);
    const float* YRAW = (const float*)(ws + WS_YRAW); const bf16_t* VZ = (const bf16_t*)(ws + WS_VZ); const bf16_t* G = (const bf16_t*)(ws + WS_G);
    const float* BONUS = (const float*)(ws + WS_BONUS); bf16_t* YS = (bf16_t*)(p->ws + WS_YSR);
    const float* gnw = p->in[15] + l * 512; const float* gnb = p->in[16] + l * 512;
    const int tid_ = otid(wv); const int wave = tid_ >> 6, lane = tid_ & 63, c = 8 * lane;
    const f32x4 gw0 = *(const f32x4*)(gnw + c), gw1 = *(const f32x4*)(gnw + c + 4), gb0 = *(const f32x4*)(gnb + c), gb1 = *(const f32x4*)(gnb + c + 4);
    for (int t = blockIdx.x * 8 + wave; t < MTOK; t += gridDim.x * 8) {
        const size_t o = (size_t)t * 512 + c;
        const f32x4 y0 = *(const f32x4*)(YRAW + o), y1 = *(const f32x4*)(YRAW + o + 4);
        float s = (y0[0] + y0[1]) + (y0[2] + y0[3]) + (y1[0] + y1[1]) + (y1[2] + y1[3]);
        s += __shfl_xor(s, 1); s += __shfl_xor(s, 2); s += __shfl_xor(s, 4);
        const float mean = s * (1.0f / 64.0f);
        const f32x4 d0 = y0 - mean, d1 = y1 - mean;
        float q = (d0[0] * d0[0] + d0[1] * d0[1]) + (d0[2] * d0[2] + d0[3] * d0[3]) + (d1[0] * d1[0] + d1[1] * d1[1]) + (d1[2] * d1[2] + d1[3] * d1[3]);
        q += __shfl_xor(q, 1); q += __shfl_xor(q, 2); q += __shfl_xor(q, 4);
        const float rstd = rsqrtf(q * (1.0f / 64.0f) + 64e-5f);
        const float bon = BONUS[(size_t)t * 8 + (lane >> 3)];
        const u32x4 vv = *(const u32x4*)(VZ + o), gg = *(const u32x4*)(G + o);
        const f32x4 v0 = {bf_lo(vv.x), bf_hi(vv.x), bf_lo(vv.y), bf_hi(vv.y)}, v1 = {bf_lo(vv.z), bf_hi(vv.z), bf_lo(vv.w), bf_hi(vv.w)};
        const f32x4 g0 = {bf_lo(gg.x), bf_hi(gg.x), bf_lo(gg.y), bf_hi(gg.y)}, g1 = {bf_lo(gg.z), bf_hi(gg.z), bf_lo(gg.w), bf_hi(gg.w)};
        const f32x4 r0 = (d0 * rstd * gw0 + gb0 + v0 * bon) * g0, r1 = (d1 * rstd * gw1 + gb1 + v1 * bon) * g1;
        u32x4 w; w.x = cvt_pk_bf16(r0[0], r0[1]); w.y = cvt_pk_bf16(r0[2], r0[3]); w.z = cvt_pk_bf16(r1[0], r1[1]); w.w = cvt_pk_bf16(r1[2], r1[3]);
        *(u32x4*)(YS + o) = w;
    }
}

DI void attn_job(const bf16_t* Q, const bf16_t* K, const bf16_t* V, bf16_t* YS, float* LSE, LAS unsigned char* vl, int b, int h, int d, int rho, int J0, bool first, int lane) {
    asm volatile("" : "+v"(lane));
    const int r = lane & 31, hh = lane >> 5;
    const size_t tokq = (size_t)b * SEQ + (size_t)(J0 + r) * d + rho;
    typedef const __attribute__((address_space(1))) bf16x8* GP8;
    typedef const __attribute__((address_space(1))) u32x4* GP4;
    bf16x8 bq[4];
    { const GP8 qp = (GP8)(Q + tokq * 512 + h * 64 + 8 * hh);
#pragma unroll
      for (int s = 0; s < 4; ++s) bq[s] = qp[2 * s]; }
    bf16x8 ak[5][4];
#pragma unroll
    for (int kt = 0; kt < 5; ++kt) {
        const int Jk = J0 - 128 + 32 * kt + r;
        const size_t tokk = (size_t)b * SEQ + (size_t)(Jk >= 0 ? Jk : 0) * d + rho;
        const GP8 kp = (GP8)(K + tokk * 512 + h * 64 + 8 * hh);
#pragma unroll
        for (int s = 0; s < 4; ++s) ak[kt][s] = kp[2 * s];
    }
    asm volatile("" ::: "memory");
    f32x16 sc[5];
#pragma unroll
    for (int kt = 0; kt < 5; ++kt) {
        const bool valid = (J0 - 128 + 32 * kt + r) >= 0;
        f32x16 a;
#pragma unroll
        for (int i = 0; i < 16; ++i) a[i] = 0.f;
#pragma unroll
        for (int s = 0; s < 4; ++s) {
            bf16x8 kf = ak[kt][s];
            if (!valid) kf = (bf16x8){0, 0, 0, 0, 0, 0, 0, 0};
            a = MFMA32(kf, bq[s], a);
        }
        sc[kt] = a;
    }
    float m = -1e30f;
#pragma unroll
    for (int kt = 0; kt < 5; ++kt)
#pragma unroll
        for (int i = 0; i < 16; ++i) {
            const int kidx = 32 * kt + crow(i, hh); const int dist = 128 + r - kidx;
            const bool ok = (dist >= 0) && (dist <= 128) && (J0 - 128 + kidx >= 0);
            const float v = ok ? sc[kt][i] * 0.125f : -1e30f;
            sc[kt][i] = v; m = fmaxf(m, v);
        }
    m = fmaxf(m, __shfl_xor(m, 32));
    float lsum = 0.f;
#pragma unroll
    for (int kt = 0; kt < 5; ++kt)
#pragma unroll
        for (int i = 0; i < 16; ++i) { const float pv = __expf(sc[kt][i] - m); sc[kt][i] = pv; lsum += pv; }
    lsum += __shfl_xor(lsum, 32);
    const float lse = m + __logf(lsum);
    f32x16 o[2];
#pragma unroll
    for (int i = 0; i < 16; ++i) { o[0][i] = 0.f; o[1][i] = 0.f; }
    u32x4 vr[4];
    {
        const int key = lane >> 1, hf = lane & 1; const int Jk = J0 - 128 + key;
        const size_t tokv = (size_t)b * SEQ + (size_t)(Jk >= 0 ? Jk : 0) * d + rho;
        const GP4 src = (GP4)(V + tokv * 512 + h * 64 + 32 * hf);
        vr[0] = src[0]; vr[1] = src[1]; vr[2] = src[2]; vr[3] = src[3];
    }
#pragma unroll
    for (int kt = 0; kt < 5; ++kt) {
        {
            const int key = lane >> 1, hf = lane & 1;
            LAS u32x4* dst = (LAS u32x4*)(vl + key * 128 + hf * 64);
            dst[0] = vr[0]; dst[1] = vr[1]; dst[2] = vr[2]; dst[3] = vr[3];
            if (kt + 1 < 5) {
                const int Jk = J0 - 128 + 32 * (kt + 1) + key;
                const size_t tokv = (size_t)b * SEQ + (size_t)(Jk >= 0 ? Jk : 0) * d + rho;
                const GP4 src = (GP4)(V + tokv * 512 + h * 64 + 32 * hf);
                vr[0] = src[0]; vr[1] = src[1]; vr[2] = src[2]; vr[3] = src[3];
            }
        }
        LDS_WAIT();
#pragma unroll
        for (int s = 0; s < 2; ++s) {
            const bf16x8 xs = pack8(sc[kt][8 * s], sc[kt][8 * s + 1], sc[kt][8 * s + 2], sc[kt][8 * s + 3], sc[kt][8 * s + 4], sc[kt][8 * s + 5], sc[kt][8 * s + 6], sc[kt][8 * s + 7]);
#pragma unroll
            for (int mt = 0; mt < 2; ++mt) {
                bf16x8 pa;
#pragma unroll
                for (int j = 0; j < 8; ++j) { const int key = 16 * s + 8 * (j >> 2) + 4 * hh + (j & 3); pa[j] = (short)*(const LAS bf16_t*)(vl + key * 128 + (r + 32 * mt) * 2); }
                o[mt] = MFMA32(pa, xs, o[mt]);
            }
        }
        LDS_WAIT();
    }
    const float il = 1.0f / lsum;
    float wp = 0.f, wc = 1.0f, nl = lse;
    if (!first) { const float lp = LSE[tokq * 8 + h]; const float mx = fmaxf(lp, lse); const float ep = __expf(lp - mx), ec = __expf(lse - mx); nl = mx + __logf(ep + ec); wp = ep / (ep + ec); wc = ec / (ep + ec); }
#pragma unroll
    for (int mt = 0; mt < 2; ++mt)
#pragma unroll
        for (int g4 = 0; g4 < 4; ++g4) {
            bf16_t* dst = YS + tokq * 512 + h * 64 + 32 * mt + 8 * g4 + 4 * hh;
            float v[4];
#pragma unroll
            for (int j = 0; j < 4; ++j) v[j] = o[mt][4 * g4 + j] * il * wc;
            if (!first) { const u32x2 pw = *(const u32x2*)dst; v[0] += bf_lo(pw.x) * wp; v[1] += bf_hi(pw.x) * wp; v[2] += bf_lo(pw.y) * wp; v[3] += bf_hi(pw.y) * wp; }
            u32x2 w2; w2.x = cvt_pk_bf16(v[0], v[1]); w2.y = cvt_pk_bf16(v[2], v[3]); *(u32x2*)dst = w2;
        }
    if (hh == 0) LSE[tokq * 8 + h] = nl;
}

DI void attention_phase(KP p, LAS unsigned char* lds, int wv) {
    unsigned char* ws = ows(p->ws);
    const bf16_t *Q = (const bf16_t*)(ws + WS_Q), *K = (const bf16_t*)(ws + WS_K), *V = (const bf16_t*)(ws + WS_V);
    bf16_t* YS = (bf16_t*)(ws + WS_YSA); float* LSE = (float*)(ws + WS_LSE);
    const int tid_ = otid(wv); const int wave = tid_ >> 6, lane = tid_ & 63;
    LAS unsigned char* vl = lds + wave * 4096;
    for (int item = blockIdx.x; item < 256; item += gridDim.x) {
        const int b = item >> 6, h = (item >> 3) & 7, qb = item & 7, P0 = qb * 512;
#pragma unroll 1
        for (int cfg = 0; cfg < 3; ++cfg) {
#pragma unroll 1
            for (int jj = wave; jj < 16; jj += 8) {
                int d, rho, J0;
                if (cfg == 0) { d = 1; rho = 0; J0 = P0 + 32 * jj; }
                else if (cfg == 1) { d = 4; rho = jj & 3; J0 = (P0 >> 2) + 32 * (jj >> 2); }
                else { d = 16; rho = jj; J0 = P0 >> 4; }
                attn_job(Q, K, V, YS, LSE, vl, b, h, d, rho, J0, cfg == 0, lane);
            }
            asm volatile("s_waitcnt vmcnt(0)" ::: "memory");
            __syncthreads();
        }
    }
}

DI void gmlp_phase(KP p, int l, LAS unsigned char* lds, int wv) {
    unsigned char* ws = ows(p->ws);
    const bf16_t* UV = (const bf16_t*)(ws + WS_UV); bf16_t* YS = (bf16_t*)(ws + WS_YSG);
    const float* lng = p->in[17] + l * 512; const float* lnb = p->in[18] + l * 512;
    const float* wsp = p->in[19] + (size_t)l * 8 * 128 * 128; const float* bsp = p->in[20] + (size_t)l * 8 * 128;
    const int tid_ = otid(wv); const int wave = tid_ >> 6, lane = tid_ & 63, r = lane & 31, hh = lane >> 5;
    LAS float* stats = (LAS float*)(lds + 8 * 17408);
    LAS bf16_t* VT = (LAS bf16_t*)(lds + wave * 17408);
    for (int item = blockIdx.x; item < 256; item += gridDim.x) {
        const size_t tok0 = (size_t)(item >> 1) * 128;
        __syncthreads();
        for (int tt = 0; tt < 16; ++tt) {
            const int tl = wave * 16 + tt;
            const u32x4 x = *(const u32x4*)(UV + (tok0 + tl) * 1024 + 512 + 8 * lane);
            const float f[8] = {bf_lo(x.x), bf_hi(x.x), bf_lo(x.y), bf_hi(x.y), bf_lo(x.z), bf_hi(x.z), bf_lo(x.w), bf_hi(x.w)};
            float s = 0.f;
#pragma unroll
            for (int j = 0; j < 8; ++j) s += f[j];
            const float mean = wave_sum(s) * (1.0f / 512.0f); float q = 0.f;
#pragma unroll
            for (int j = 0; j < 8; ++j) { const float dd = f[j] - mean; q += dd * dd; }
            const float rstd = rsqrtf(wave_sum(q) * (1.0f / 512.0f) + 1e-5f);
            if (lane == 0) { stats[2 * tl] = mean; stats[2 * tl + 1] = rstd; }
        }
        __syncthreads();
        const int g = (item & 1) * 4 + (wave & 3);
        if (wave < 4) {
        {
            const int d0 = 8 * (lane & 7);
            const f32x4 lg0 = *(const f32x4*)(lng + g * 64 + d0), lg1 = *(const f32x4*)(lng + g * 64 + d0 + 4), lb0 = *(const f32x4*)(lnb + g * 64 + d0), lb1 = *(const f32x4*)(lnb + g * 64 + d0 + 4);
            for (int it = 0; it < 16; ++it) {
                const int tl = it * 8 + (lane >> 3);
                const u32x4 x = *(const u32x4*)(UV + (tok0 + tl) * 1024 + 512 + g * 64 + d0);
                const float mean = stats[2 * tl], rstd = stats[2 * tl + 1];
                const float f[8] = {bf_lo(x.x), bf_hi(x.x), bf_lo(x.y), bf_hi(x.y), bf_lo(x.z), bf_hi(x.z), bf_lo(x.w), bf_hi(x.w)};
#pragma unroll
                for (int e = 0; e < 8; ++e) {
                    const float gg = e < 4 ? lg0[e & 3] : lg1[e & 3], bb = e < 4 ? lb0[e & 3] : lb1[e & 3];
                    const float y = (f[e] - mean) * rstd * gg + bb;
                    VT[(d0 + e) * 136 + tl] = (bf16_t)(cvt_pk_bf16(y, 0.f) & 0xffffu);
                }
            }
        }
        LDS_WAIT();
#pragma unroll 1
        for (int nt = 0; nt < 4; ++nt) {
            f32x16 acc[2];
#pragma unroll
            for (int i = 0; i < 16; ++i) { acc[0][i] = 0.f; acc[1][i] = 0.f; }
            const int irow = 32 * nt + r;
            for (int s = 0; s < 2 * (nt + 1); ++s) {
                const int j0 = 16 * s + 8 * hh;
                const float* wr_ = wsp + ((size_t)g * 128 + irow) * 128 + j0;
                const f32x4 wa = *(const f32x4*)wr_, wb = *(const f32x4*)(wr_ + 4);
                float wv[8] = {wa[0], wa[1], wa[2], wa[3], wb[0], wb[1], wb[2], wb[3]};
#pragma unroll
                for (int j = 0; j < 8; ++j) if (j0 + j > irow) wv[j] = 0.f;
                const bf16x8 bfr = pack8(wv[0], wv[1], wv[2], wv[3], wv[4], wv[5], wv[6], wv[7]);
#pragma unroll
                for (int mt = 0; mt < 2; ++mt) {
                    const bf16x8 afr = *(const LAS bf16x8*)(VT + (32 * mt + r) * 136 + j0);
                    acc[mt] = MFMA32(afr, bfr, acc[mt]);
                }
            }
            const size_t tok = tok0 + irow; const float bs = bsp[g * 128 + irow];
#pragma unroll
            for (int mt = 0; mt < 2; ++mt)
#pragma unroll
                for (int g4 = 0; g4 < 4; ++g4) {
                    const int c = g * 64 + 32 * mt + 8 * g4 + 4 * hh;
                    const u32x2 uu = *(const u32x2*)(UV + tok * 1024 + c);
                    const float o0 = bf_lo(uu.x) * (acc[mt][4 * g4] + bs), o1 = bf_hi(uu.x) * (acc[mt][4 * g4 + 1] + bs), o2 = bf_lo(uu.y) * (acc[mt][4 * g4 + 2] + bs), o3 = bf_hi(uu.y) * (acc[mt][4 * g4 + 3] + bs);
                    u32x2 w2; w2.x = cvt_pk_bf16(o0, o1); w2.y = cvt_pk_bf16(o2, o3); *(u32x2*)(YS + tok * 512 + c) = w2;
                }
        }
        }
    }
}

DI void ffn_conv_phase(KP p, int l, int wv) {
    bf16_t* UP = (bf16_t*)(ows(p->ws) + WS_UP);
    const float* cw = p->in[25] + (size_t)l * 3 * DFF; const float* cb = p->in[26] + (size_t)l * DFF;
    constexpr int NCG = DFF / 8, RUN = 32, NRUN = MTOK / RUN;
    const int tid_ = otid(wv);
    for (int item = blockIdx.x * 512 + tid_; item < NCG * NRUN; item += gridDim.x * 512) {
        const int cgi = item % NCG, run = item / NCG, f0 = 8 * cgi, t0 = run * RUN;
        float w0[8], w1[8], w2[8], bb[8];
#pragma unroll
        for (int q = 0; q < 2; ++q) { const f32x4 a = *(const f32x4*)(cw + f0 + 4 * q), b = *(const f32x4*)(cw + DFF + f0 + 4 * q), c = *(const f32x4*)(cw + 2 * DFF + f0 + 4 * q), d = *(const f32x4*)(cb + f0 + 4 * q);
#pragma unroll
            for (int j = 0; j < 4; ++j) { w0[4 * q + j] = a[j]; w1[4 * q + j] = b[j]; w2[4 * q + j] = c[j]; bb[4 * q + j] = d[j]; } }
        u32x4 am2 = {0u, 0u, 0u, 0u}, am1 = {0u, 0u, 0u, 0u};
        if ((t0 & (SEQ - 1)) != 0) { am2 = *(const u32x4*)(UP + (size_t)(t0 - 2) * UPC + f0); am1 = *(const u32x4*)(UP + (size_t)(t0 - 1) * UPC + f0); }
        for (int t = t0; t < t0 + RUN; t += 4) {
            u32x4 av[4], gv[4];
#pragma unroll
            for (int q = 0; q < 4; ++q) { av[q] = *(const u32x4*)(UP + (size_t)(t + q) * UPC + f0); gv[q] = *(const u32x4*)(UP + (size_t)(t + q) * UPC + DFF + f0); }
#pragma unroll
            for (int q = 0; q < 4; ++q) {
                const u32x4 a0 = av[q], gg = gv[q];
                const unsigned x2[4] = {am2.x, am2.y, am2.z, am2.w}, x1[4] = {am1.x, am1.y, am1.z, am1.w}, x0[4] = {a0.x, a0.y, a0.z, a0.w}, xg[4] = {gg.x, gg.y, gg.z, gg.w};
                unsigned ow[4];
#pragma unroll
                for (int j = 0; j < 4; ++j) {
                    const float c0 = bb[2 * j] + w0[2 * j] * bf_lo(x2[j]) + w1[2 * j] * bf_lo(x1[j]) + w2[2 * j] * bf_lo(x0[j]);
                    const float c1 = bb[2 * j + 1] + w0[2 * j + 1] * bf_hi(x2[j]) + w1[2 * j + 1] * bf_hi(x1[j]) + w2[2 * j + 1] * bf_hi(x0[j]);
                    ow[j] = cvt_pk_bf16(gelu_tanh(c0) * bf_lo(xg[j]), gelu_tanh(c1) * bf_hi(xg[j]));
                }
                *(u32x4*)(UP + (size_t)(t + q) * UPC + DFF + f0) = (u32x4){ow[0], ow[1], ow[2], ow[3]};
                am2 = am1; am1 = a0;
            }
        }
    }
}

__global__ void __launch_bounds__(512) fwd_megakernel(Params p_unused) {
    extern __shared__ __attribute__((aligned(16))) unsigned char lds_raw[];
    LAS unsigned char* lds = (LAS unsigned char*)lds_raw;
    cg::grid_group grid = cg::this_grid();
    KP p = okp();
    unsigned char* ws = p->ws;
    const int G = gridDim.x, c = blockIdx.x;
    const int wv = __builtin_amdgcn_readfirstlane((int)(threadIdx.x >> 6));
    pg8::Epi E; pg8::TileOrder S; pg8::Gemm g;

    grid.sync();
    unsigned epoch = 0; unsigned* bar = (unsigned*)(ws + WS_BAR);
    phase0(p, lds, wv);
    gbar(bar, epoch, (unsigned)G, wv);
#pragma unroll 1
    for (int st = 0; st < 2 * 17; ++st) {
        const int l = st / 17, step = st % 17;
        p = okp(); ws = ows(p->ws);
        const float* mod = (const float*)(ws + WS_MOD); const bf16_t* H = (const bf16_t*)(ws + WS_H);
        const float* ml = mod + (size_t)l * 4 * 6144;
        const float* xin = (l == 0) ? p->in[0] : p->out;
        bool do_gemm = false, do_sync = true;
        E = pg8::Epi{};
        if (step == 0) {
            if (l > 0) convert_weights(p, l, lds, wv);
#ifdef REP_CONVW
            if (l > 0) convert_weights(p, l, lds, wv);
#endif
            norm_mod_phase(xin, p->in[4] + l * DM, ml + 0, ml + 1024, (bf16_t*)(ws + WS_H), wv);
#ifdef REP_NORM
            norm_mod_phase(xin, p->in[4] + l * DM, ml + 0, ml + 1024, (bf16_t*)(ws + WS_H), wv);
#endif
        } else if (step == 1 || step == 4) {
            if (step == 4) rwkv_post_phase(p, l, wv);
#ifdef REP_POST
            if (step == 4) rwkv_post_phase(p, l, wv);
#endif
            E.mode = pg8::EM_INPROJ; E.o0 = (bf16_t*)(ws + WS_Q); E.o1 = (bf16_t*)(ws + WS_K); E.o2 = (bf16_t*)(ws + WS_V); E.o3 = (bf16_t*)(ws + WS_RAW); E.o4 = (bf16_t*)(ws + WS_UV);
            E.ropec = (const float*)(ws + WS_ROPEC); E.ropes = (const float*)(ws + WS_ROPES);
            g.A = H; g.Bt = (const bf16_t*)(ws + WS_WIN); g.lda = 1024; g.K = 1024;
            if (step == 1) S.init(64, 7, G, c, 7, 6, 0); else S.init(64, 10, G, c, 6, 0, 13);
            do_gemm = true;
        } else if (step == 2) { rwkv_derived_phase(p, l, wv); }
        else if (step == 3) { rwkv_scan_phase(p, lds, wv);
#ifdef REP_SCAN
            gbar((unsigned*)(ws + WS_BAR), epoch, (unsigned)G, wv); rwkv_scan_phase(p, lds, wv);
#endif
        }
        else if (step == 5) { attention_phase(p, lds, wv);
#ifdef REP_ATT
            gbar((unsigned*)(ws + WS_BAR), epoch, (unsigned)G, wv); attention_phase(p, lds, wv);
#endif
            gmlp_phase(p, l, lds, wv);
#ifdef REP_GMLP
            gbar((unsigned*)(ws + WS_BAR), epoch, (unsigned)G, wv); gmlp_phase(p, l, lds, wv);
#endif
        }
        else if (step >= 6 && step <= 11) {
            const int br = (step - 6) >> 1;
            if (((step - 6) & 1) == 0) {
                E.mode = pg8::EM_GATE; E.o0 = (bf16_t*)(ws + WS_GATE);
                g.A = H; g.Bt = (const bf16_t*)(ws + WS_WIN) + (size_t)(4352 + 1024 * br) * 1024; g.lda = 1024; g.K = 1024;
            } else {
                E.mode = (br == 0) ? pg8::EM_BR_FIRST : (br == 1 ? pg8::EM_BR_MID : pg8::EM_BR_LAST); E.o0 = (bf16_t*)(ws + WS_GATE); E.o1 = (bf16_t*)(ws + WS_MB); E.f0 = (float*)(ws + WS_M32);
                g.A = (const bf16_t*)(ws + (br == 0 ? WS_YSA : (br == 1 ? WS_YSR : WS_YSG))); g.Bt = (const bf16_t*)(ws + WS_WBR) + (size_t)br * 1024 * 512; g.lda = 512; g.K = 512;
            }
            S.init(64, 4, G, c, 4, 0, 0);
            do_gemm = true; do_sync = (step == 11);
        } else if (step == 12) {
            E.mode = pg8::EM_RESID; E.f0 = p->out; E.f1 = xin; E.f2 = ml + 2048;
            g.A = (const bf16_t*)(ws + WS_MB); g.Bt = (const bf16_t*)(ws + WS_WOUT); g.lda = 1024; g.K = 1024;
            S.init(64, 4, G, c, 4, 0, 0); do_gemm = true;
        } else if (step == 13) { norm_mod_phase(p->out, p->in[23] + l * DM, ml + 3072, ml + 4096, (bf16_t*)(ws + WS_H), wv); }
        else if (step == 14) {
            E.mode = pg8::EM_UP; E.o0 = (bf16_t*)(ws + WS_UP);
            g.A = H; g.Bt = (const bf16_t*)(ws + WS_WUP); g.lda = 1024; g.K = 1024;
            S.init(64, 22, G, c, 22, 0, 0); do_gemm = true;
        } else if (step == 15) { ffn_conv_phase(p, l, wv); }
        else {
            E.mode = pg8::EM_RESID; E.f0 = p->out; E.f1 = p->out; E.f2 = ml + 5120;
            g.A = (const bf16_t*)(ws + WS_UP) + DFF; g.Bt = (const bf16_t*)(ws + WS_WDN); g.lda = UPC; g.K = DFF;
            S.init(64, 4, G, c, 4, 0, 0); do_gemm = true;
        }
        if (do_gemm) pg8::gemm_phase(lds, g, S, E, wv);
#ifdef REP_UP
        if (step == 14) pg8::gemm_phase(lds, g, S, E, wv);
#endif
#ifdef REP_BAR
        if (step == 14) { for (int q = 0; q < 10; ++q) gbar((unsigned*)(ws + WS_BAR), epoch, (unsigned)G, wv); }
#endif
        if (do_sync) gbar((unsigned*)(ws + WS_BAR), epoch, (unsigned)G, wv);
#ifdef DBG_ST
        if (st == DBG_ST) {
            gbar((unsigned*)(ws + WS_BAR), epoch, (unsigned)G, wv);
#if DBG_KIND == 1
            { const bf16_t* sb = (const bf16_t*)(ws + DBG_BUF); for (size_t i = (size_t)blockIdx.x * 512 + otid(wv); i < (size_t)MTOK * DM; i += (size_t)gridDim.x * 512) p->out[i] = __uint_as_float(((unsigned)sb[i]) << 16); }
#elif DBG_KIND == 3
            { const bf16_t* sb = (const bf16_t*)(ws + DBG_BUF); for (size_t i = (size_t)blockIdx.x * 512 + otid(wv); i < (size_t)MTOK * DM; i += (size_t)gridDim.x * 512) p->out[i] = __uint_as_float(((unsigned)sb[i % DBG_N]) << 16); }
#elif DBG_KIND == 2
            { const float* sb = (const float*)(ws + DBG_BUF); for (size_t i = (size_t)blockIdx.x * 512 + otid(wv); i < (size_t)MTOK * DM; i += (size_t)gridDim.x * 512) p->out[i] = sb[i % DBG_N]; }
#endif
            return;
        }
#endif
    }
    p = okp();
    final_norm_phase(p->out, p->in[28], wv);
}

extern "C" void kernel_launch(void* const* d_in, const int* in_sizes, int n_in, void* d_out, int out_size, void* d_ws, size_t ws_size, hipStream_t stream) {
    static int grid_blocks = 0;
    if (grid_blocks == 0) {
        int dev = 0, cus = 0, per_cu = 0;
        hipGetDevice(&dev);
        hipDeviceGetAttribute(&cus, hipDeviceAttributeMultiprocessorCount, dev);
        if (hipFuncSetAttribute((const void*)fwd_megakernel, hipFuncAttributeMaxDynamicSharedMemorySize, LDS_BYTES) != hipSuccess) { fprintf(stderr, "hipFuncSetAttribute failed\n"); }
        hipOccupancyMaxActiveBlocksPerMultiprocessor(&per_cu, (const void*)fwd_megakernel, 512, LDS_BYTES);
        if (per_cu < 1) { fprintf(stderr, "occupancy query returned %d\n", per_cu); per_cu = 1; }
        if (per_cu > 1) per_cu = 1;
        grid_blocks = cus * per_cu;
        (void)hipGetLastError();
    }
    if (n_in != 29 || ws_size < 256 * MiB) { fprintf(stderr, "unexpected inputs/workspace\n"); return; }
    (void)hipMemsetAsync((unsigned char*)d_ws + WS_BAR, 0, 256, stream);
    Params p{};
    for (int i = 0; i < 29; ++i) p.in[i] = (const float*)d_in[i];
    p.out = (float*)d_out; p.ws = (unsigned char*)d_ws;
    void* args[] = {&p};
    hipError_t e = hipLaunchCooperativeKernel((const void*)fwd_megakernel, dim3(grid_blocks), dim3(512), args, LDS_BYTES, stream);
    if (e != hipSuccess) fprintf(stderr, "cooperative launch failed: %s (grid %d)\n", hipGetErrorString(e), grid_blocks);
}
```

```cpp
#include <hip/hip_runtime.h>
#include <hip/hip_cooperative_groups.h>
#include <cstdio>
#include <cstdint>
namespace cg = cooperative_groups;

#define LAS __attribute__((address_space(3)))
#define DI __device__ __forceinline__
typedef unsigned short bf16_t;
typedef short bf16x8 __attribute__((ext_vector_type(8)));
typedef float f32x4 __attribute__((ext_vector_type(4)));
typedef float f32x16 __attribute__((ext_vector_type(16)));
typedef unsigned u32x4 __attribute__((ext_vector_type(4)));
typedef unsigned u32x2 __attribute__((ext_vector_type(2)));

constexpr int DM = 1024, SEQ = 4096, MTOK = 16384, INC = 7424, DFF = 2816, UPC = 5632, RAWC = 1792;
constexpr int LDS_BYTES = 147456;
constexpr size_t MiB = 1048576;
constexpr size_t WS_WIN = 0, WS_WBR = WS_WIN + (size_t)INC * 1024 * 2, WS_WOUT = WS_WBR + 3u * 1024 * 512 * 2, WS_WUP = WS_WOUT + 1024u * 1024 * 2,
                 WS_WDN = WS_WUP + (size_t)UPC * 1024 * 2, WS_LWU = WS_WDN + (size_t)DFF * 1024 * 2, WS_LAU = WS_LWU + 65536, WS_LGU = WS_LAU + 65536;
constexpr size_t WS_H = 37 * MiB;
constexpr size_t WS_SMALL = 69 * MiB, WS_MOD = WS_SMALL, WS_ROPEC = WS_MOD + 262144, WS_ROPES = WS_ROPEC + 524288, WS_BONUS = WS_ROPES + 524288, WS_LSE = WS_BONUS + 524288;
constexpr size_t WS_BAR = WS_LSE + 524288;
constexpr size_t DB = 72 * MiB;
constexpr size_t WS_RAW = DB, WS_RZ = DB + 56 * MiB, WS_KP = DB + 72 * MiB, WS_KKN = DB + 88 * MiB, WS_B = DB + 104 * MiB, WS_W = DB + 120 * MiB, WS_VZ = DB + 152 * MiB, WS_G = DB + 168 * MiB;
constexpr size_t WS_YRAW = DB, WS_YSR = DB + 32 * MiB;
constexpr size_t WS_Q = DB + 56 * MiB, WS_K = DB + 72 * MiB, WS_V = DB + 88 * MiB, WS_UV = DB + 104 * MiB;
constexpr size_t WS_YSA = DB + 152 * MiB, WS_YSG = DB + 168 * MiB;
constexpr size_t WS_GATE = DB, WS_M32 = DB + 48 * MiB, WS_MB = DB + 112 * MiB;
constexpr size_t WS_UP = DB;
static_assert(WS_LGU + 131072 <= WS_H, "weights region overflow");
static_assert(WS_BAR + 64 * 26 * 4 <= DB, "small region overflow");

struct Params {
    const float* in[29];
    float* out;
    unsigned char* ws;
};

typedef const __attribute__((address_space(4))) Params* KP;
DI KP okp() { unsigned long long k = (unsigned long long)__builtin_amdgcn_kernarg_segment_ptr(); asm volatile("" : "+s"(k)); return (KP)k; }
typedef float f32x2_t __attribute__((ext_vector_type(2)));
typedef __bf16 bf16x2_t __attribute__((ext_vector_type(2)));
DI unsigned cvt_pk_bf16(float lo, float hi) { const f32x2_t v = {lo, hi}; const bf16x2_t r = __builtin_convertvector(v, bf16x2_t); return __builtin_bit_cast(unsigned, r); }
DI float bf_lo(unsigned w) { return __uint_as_float(w << 16); }
DI float bf_hi(unsigned w) { return __uint_as_float(w & 0xffff0000u); }
DI int otid(int wv) { int ln; asm volatile("v_mbcnt_lo_u32_b32 %0, -1, 0\n\tv_mbcnt_hi_u32_b32 %0, -1, %0" : "=v"(ln)); return wv * 64 + ln; }
DI unsigned char* ows(unsigned char* w) { asm volatile("" : "+s"(w)); return w; }
DI float row16_sum(float v) {
    v += __builtin_bit_cast(float, __builtin_amdgcn_update_dpp(0, __builtin_bit_cast(int, v), 0xB1, 0xF, 0xF, false));
    v += __builtin_bit_cast(float, __builtin_amdgcn_update_dpp(0, __builtin_bit_cast(int, v), 0x4E, 0xF, 0xF, false));
    v += __builtin_bit_cast(float, __builtin_amdgcn_update_dpp(0, __builtin_bit_cast(int, v), 0x141, 0xF, 0xF, false));
    v += __builtin_bit_cast(float, __builtin_amdgcn_update_dpp(0, __builtin_bit_cast(int, v), 0x140, 0xF, 0xF, false));
    return v;
}
DI float wave_sum(float v) { v = row16_sum(v); v += __shfl_xor(v, 16); v += __shfl_xor(v, 32); return v; }
#define XB_CNT(j)  (64 * (j))
#define XB_SUB(j)  (64 * (8 + (j)))
#define XB_GEN(j)  (64 * (16 + (j)))
#define XB_TOP     (64 * 24)
#define XB_TOPGEN  (64 * 25)
#define XB_WORDS   (64 * 26)
DI unsigned xb_ld(unsigned* p) { return __hip_atomic_load(p, __ATOMIC_RELAXED, __HIP_MEMORY_SCOPE_AGENT); }
DI unsigned xb_add(unsigned* p, unsigned v) { return __hip_atomic_fetch_add(p, v, __ATOMIC_RELAXED, __HIP_MEMORY_SCOPE_AGENT); }
DI unsigned xb_xcc_id() { return (unsigned)__builtin_amdgcn_s_getreg((3 << 11) | 20) & 0x7u; }
DI void gbar(unsigned* bar, volatile LAS unsigned* st, int wv) {
    asm volatile("s_waitcnt vmcnt(0) lgkmcnt(0)" ::: "memory");
    __syncthreads();
    if (otid(wv) == 0) {
        const unsigned nloc = st[0], nx = st[1], x = st[2];
        const unsigned old = xb_add(&bar[XB_SUB(x)], 1u);
        const unsigned gen = old / nloc;
        if (old + 1u == (gen + 1u) * nloc) {
            __builtin_amdgcn_fence(__ATOMIC_RELEASE, "agent");
            asm volatile("s_waitcnt vmcnt(0)" ::: "memory");
            const unsigned og = xb_add(&bar[XB_TOP], 1u);
            const unsigned tg = og / nx;
            if (og + 1u == (tg + 1u) * nx) xb_add(&bar[XB_TOPGEN], 1u);
            else { while (xb_ld(&bar[XB_TOPGEN]) == tg) __builtin_amdgcn_s_sleep(1); }
            __builtin_amdgcn_fence(__ATOMIC_ACQUIRE, "agent");
            xb_add(&bar[XB_GEN(x)], 1u);
            asm volatile("s_waitcnt vmcnt(0)" ::: "memory");
        } else {
            while (xb_ld(&bar[XB_GEN(x)]) == gen) __builtin_amdgcn_s_sleep(1);
            __builtin_amdgcn_fence(__ATOMIC_ACQUIRE, "agent");
            asm volatile("s_waitcnt vmcnt(0)" ::: "memory");
        }
    }
    asm volatile("" ::: "memory");
    __syncthreads();
}
DI float sigmoidf_(float x) { return __builtin_amdgcn_rcpf(1.0f + __expf(-x)); }
DI float gelu_tanh(float x) { const float u = 1.5957691216f * (x + 0.044715f * x * x * x); return x * __builtin_amdgcn_rcpf(1.0f + __expf(-u)); }
#define LDS_WAIT() asm volatile("s_waitcnt lgkmcnt(0)" ::: "memory")
#define MFMA32(a, b, c) __builtin_amdgcn_mfma_f32_32x32x16_bf16((a), (b), (c), 0, 0, 0)
DI int crow(int reg, int h) { return (reg & 3) + 8 * (reg >> 2) + 4 * h; }
DI bf16x8 pack8(float a0, float a1, float a2, float a3, float a4, float a5, float a6, float a7) {
    u32x4 p; p.x = cvt_pk_bf16(a0, a1); p.y = cvt_pk_bf16(a2, a3); p.z = cvt_pk_bf16(a4, a5); p.w = cvt_pk_bf16(a6, a7);
    return __builtin_bit_cast(bf16x8, p);
}

namespace pg8 {
constexpr int BM = 256, BK = 64, HALF = 128, HTB = HALF * BK * 2, STAGE_BYTES = 8 * HTB, NXCD = 8, WGM = 8;
DI int lds_byte(int r, int c) { const int st = (r >> 4) * 2 + (c >> 5), rr = r & 15, cc = c & 31, ob = rr * 64 + cc * 2; return st * 1024 + (ob ^ (((ob >> 9) & 1) << 5)); }
DI void stage_rc(int b, int& R, int& C) { const int st = b / 1024, sb = b % 1024, swz = sb ^ (((sb >> 9) & 1) << 5); R = (st >> 1) * 16 + swz / 64; C = (st & 1) * 32 + (swz % 64) / 2; }
DI int perm32(int rho) { const int n = rho >> 4, i = rho & 15; return 8 * (i >> 2) + 4 * n + (i & 3); }
struct Unit { int pm, pn; };
struct Gemm { const bf16_t* A; const bf16_t* Bt; int lda, K; };
struct TileOrder {
    int nM, nN, nwg, G, c, split, off0, off1;
    DI void init(int nM_, int nN_, int G_, int c_, int split_, int off0_, int off1_) { nM = nM_; nN = nN_; nwg = nM * nN; G = G_; c = c_; split = split_; off0 = off0_; off1 = off1_; }
    DI bool next(int i, Unit& u) const {
        const long L = (long)i * G + c; if (L >= nwg) return false;
        int wgid = (int)L; { const int q = nwg / NXCD, r = nwg % NXCD, xcd = wgid % NXCD, off = wgid / NXCD; wgid = (xcd < r ? xcd * (q + 1) : r * (q + 1) + (xcd - r) * q) + off; }
        const int nig = WGM * nN, gid = wgid / nig, fm = gid * WGM, gsz = (nM - fm) < WGM ? (nM - fm) : WGM;
        u.pm = fm + ((wgid % nig) % gsz); const int pnv = (wgid % nig) / gsz; u.pn = pnv < split ? pnv + off0 : pnv - split + off1; return true;
    }
};

enum { EM_INPROJ = 0, EM_GATE = 1, EM_BR_FIRST = 2, EM_BR_MID = 3, EM_BR_LAST = 4, EM_RESID = 5, EM_UP = 6 };
struct Epi {
    int mode;
    bf16_t *o0, *o1, *o2, *o3, *o4;
    float* f0; const float* f1; const float* f2;
    const float *ropec, *ropes;
    DI void operator()(const f32x4 (&acc)[2][2][4][2], const Unit& u, int wr, int wc, int fr, int fq) const {
        const int row0 = u.pm * BM + wr * 64 + fr, colb = u.pn * BM + wc * 32 + 8 * fq;
#pragma unroll
        for (int ai = 0; ai < 2; ++ai)
#pragma unroll
            for (int m = 0; m < 4; ++m) {
                const int row = row0 + ai * HALF + m * 16;
#pragma unroll
                for (int bj = 0; bj < 2; ++bj) {
                    const int col0 = colb + bj * HALF;
                    f32x4 v0 = acc[ai][bj][m][0], v1 = acc[ai][bj][m][1];
                    if (mode == EM_INPROJ) {
                        bf16_t* dst;
                        if (u.pn < 4) {
                            const int pos = row & (SEQ - 1), e0 = (col0 & 63) >> 1;
                            const f32x4 cs = *(const f32x4*)(ropec + pos * 32 + e0), sn = *(const f32x4*)(ropes + pos * 32 + e0);
                            f32x4 a, b;
                            a[0] = v0[0] * cs[0] - v0[1] * sn[0]; a[1] = v0[1] * cs[0] + v0[0] * sn[0];
                            a[2] = v0[2] * cs[1] - v0[3] * sn[1]; a[3] = v0[3] * cs[1] + v0[2] * sn[1];
                            b[0] = v1[0] * cs[2] - v1[1] * sn[2]; b[1] = v1[1] * cs[2] + v1[0] * sn[2];
                            b[2] = v1[2] * cs[3] - v1[3] * sn[3]; b[3] = v1[3] * cs[3] + v1[2] * sn[3];
                            v0 = a; v1 = b;
                            dst = (u.pn < 2) ? o0 + (size_t)row * 512 + col0 : o1 + (size_t)row * 512 + (col0 - 512);
                        } else if (u.pn < 6) { dst = o2 + (size_t)row * 512 + (col0 - 1024); }
                        else if (u.pn < 13) { dst = o3 + (size_t)row * RAWC + (col0 - 1536); }
                        else {
#pragma unroll
                            for (int j = 0; j < 4; ++j) { v0[j] = gelu_tanh(v0[j]); v1[j] = gelu_tanh(v1[j]); }
                            dst = o4 + (size_t)row * 1024 + (col0 - 3328);
                        }
                        u32x4 w; w.x = cvt_pk_bf16(v0[0], v0[1]); w.y = cvt_pk_bf16(v0[2], v0[3]); w.z = cvt_pk_bf16(v1[0], v1[1]); w.w = cvt_pk_bf16(v1[2], v1[3]);
                        *(u32x4*)dst = w;
                    } else if (mode == EM_GATE) {
#pragma unroll
                        for (int j = 0; j < 4; ++j) { v0[j] = sigmoidf_(v0[j]); v1[j] = sigmoidf_(v1[j]); }
                        u32x4 w; w.x = cvt_pk_bf16(v0[0], v0[1]); w.y = cvt_pk_bf16(v0[2], v0[3]); w.z = cvt_pk_bf16(v1[0], v1[1]); w.w = cvt_pk_bf16(v1[2], v1[3]);
                        *(u32x4*)(o0 + (size_t)row * 1024 + col0) = w;
                    } else if (mode == EM_UP) {
                        u32x4 w; w.x = cvt_pk_bf16(v0[0], v0[1]); w.y = cvt_pk_bf16(v0[2], v0[3]); w.z = cvt_pk_bf16(v1[0], v1[1]); w.w = cvt_pk_bf16(v1[2], v1[3]);
                        *(u32x4*)(o0 + (size_t)row * UPC + col0) = w;
                    } else if (mode == EM_RESID) {
                        const size_t off = (size_t)row * 1024 + col0;
                        const float* gv = f2 + (size_t)(row >> 12) * 6144 + col0;
                        const f32x4 g0 = *(const f32x4*)gv, g1 = *(const f32x4*)(gv + 4);
                        const f32x4 b0 = *(const f32x4*)(f1 + off), b1 = *(const f32x4*)(f1 + off + 4);
                        *(f32x4*)(f0 + off) = b0 + g0 * v0; *(f32x4*)(f0 + off + 4) = b1 + g1 * v1;
                    } else {
                        const size_t off = (size_t)row * 1024 + col0;
                        const u32x4 gw = *(const u32x4*)(o0 + off);
                        f32x4 r0, r1;
                        r0[0] = bf_lo(gw.x) * v0[0]; r0[1] = bf_hi(gw.x) * v0[1]; r0[2] = bf_lo(gw.y) * v0[2]; r0[3] = bf_hi(gw.y) * v0[3];
                        r1[0] = bf_lo(gw.z) * v1[0]; r1[1] = bf_hi(gw.z) * v1[1]; r1[2] = bf_lo(gw.w) * v1[2]; r1[3] = bf_hi(gw.w) * v1[3];
                        if (mode != EM_BR_FIRST) { r0 += *(const f32x4*)(f0 + off); r1 += *(const f32x4*)(f0 + off + 4); }
                        if (mode == EM_BR_LAST) {
                            u32x4 w; w.x = cvt_pk_bf16(r0[0], r0[1]); w.y = cvt_pk_bf16(r0[2], r0[3]); w.z = cvt_pk_bf16(r1[0], r1[1]); w.w = cvt_pk_bf16(r1[2], r1[3]);
                            *(u32x4*)(o1 + off) = w;
                        } else { *(f32x4*)(f0 + off) = r0; *(f32x4*)(f0 + off + 4) = r1; }
                    }
                }
            }
    }
};

DI void gemm_phase(LAS unsigned char* lds, const Gemm g, const TileOrder S, const Epi E, int wv) {
    const int tid = otid(wv), wid = __builtin_amdgcn_readfirstlane(tid >> 6), lane = tid & 63, wr = wid >> 2, wc = wid & 3, fr = lane & 15, fq = lane >> 4;
    const int K = g.K, nt = K / BK, lda = g.lda;
    unsigned voffA[2], voffB[2];
#pragma unroll
    for (int i = 0; i < 2; ++i) { int R, C; stage_rc(tid * 16 + i * 8192, R, C); const int Rb = (R & ~31) + perm32(R & 31);
        voffA[i] = (unsigned)(R * lda + C) * 2u; voffB[i] = (unsigned)(Rb * K + C) * 2u; }
    const size_t kstep = (size_t)(BK * 2);
    const size_t hstepA = (size_t)HALF * lda * 2, hstepB = (size_t)HALF * K * 2;
    const size_t tstepA = 2 * hstepA, tstepB = 2 * hstepB;
    const unsigned ldsw = (unsigned)wid * 1024u;
    const int aoff = lds_byte(wr * 64 + fr, fq * 8), boff = lds_byte(wc * 32 + fr, fq * 8);
#define PG8_SA(b, h) (((b) * 2 + (h)) * HTB)
#define PG8_SB(b, h) ((4 + (b) * 2 + (h)) * HTB)
#define PG8_STAGE(bufoff, gbase, voff) do { _Pragma("unroll") for (int _i = 0; _i < 2; ++_i) \
        __builtin_amdgcn_global_load_lds((const unsigned*)((const char*)(gbase) + (voff)[_i]), (LAS unsigned*)(lds + (bufoff) + ldsw + _i * 8192), 16, 0, 0); } while (0)
#define PG8_LDA(dst, b, h) do { _Pragma("unroll") for (int m = 0; m < 4; ++m) _Pragma("unroll") for (int k = 0; k < 2; ++k) dst[m][k] = *(const LAS bf16x8*)(lds + PG8_SA(b, h) + aoff + m * 2048 + k * 1024); } while (0)
#define PG8_LDB(dst, b, h) do { _Pragma("unroll") for (int n = 0; n < 2; ++n) _Pragma("unroll") for (int k = 0; k < 2; ++k) dst[n][k] = *(const LAS bf16x8*)(lds + PG8_SB(b, h) + boff + n * 2048 + k * 1024); } while (0)
#define PG8_MMA(ai, bj, At, Bt) do { __builtin_amdgcn_s_setprio(1); _Pragma("unroll") for (int m = 0; m < 4; ++m) _Pragma("unroll") for (int n = 0; n < 2; ++n) _Pragma("unroll") for (int k = 0; k < 2; ++k) \
        acc[ai][bj][m][n] = __builtin_amdgcn_mfma_f32_16x16x32_bf16(Bt[n][k], At[m][k], acc[ai][bj][m][n], 0, 0, 0); __builtin_amdgcn_s_setprio(0); } while (0)
#define PG8_WAIT_V(n) asm volatile("s_waitcnt vmcnt(" #n ")" ::: "memory")
#define PG8_WAIT_L(n) asm volatile("s_waitcnt lgkmcnt(" #n ")" ::: "memory")
#define PG8_BAR __builtin_amdgcn_s_barrier()
#define PG8_SCHED __builtin_amdgcn_sched_barrier(0)
    Unit cur, nxt; int ui = 0;
    if (!S.next(0, cur)) return;
    f32x4 acc[2][2][4][2];
#pragma unroll
    for (int a = 0; a < 2; ++a)
#pragma unroll
        for (int b = 0; b < 2; ++b)
#pragma unroll
            for (int m = 0; m < 4; ++m)
#pragma unroll
                for (int n = 0; n < 2; ++n) acc[a][b][m][n] = (f32x4){0.f, 0.f, 0.f, 0.f};
    bf16x8 At[4][2], B0[2][2], B1[2][2];
    const char* cA = (const char*)g.A + (size_t)cur.pm * tstepA; const char* cB = (const char*)g.Bt + (size_t)cur.pn * tstepB;
    PG8_STAGE(PG8_SB(0, 0), cB, voffB); PG8_STAGE(PG8_SA(0, 0), cA, voffA); PG8_STAGE(PG8_SB(0, 1), cB + hstepB, voffB); PG8_STAGE(PG8_SA(0, 1), cA + hstepA, voffA);
    if (wr == 1) PG8_BAR;
    PG8_WAIT_V(4); PG8_BAR;
    PG8_STAGE(PG8_SB(1, 0), cB + kstep, voffB); PG8_STAGE(PG8_SA(1, 0), cA + kstep, voffA); PG8_STAGE(PG8_SB(1, 1), cB + hstepB + kstep, voffB);
    PG8_WAIT_V(6); PG8_BAR;
    for (;;) {
        const bool has_next = S.next(ui + 1, nxt);
        const char* nA = has_next ? (const char*)g.A + (size_t)nxt.pm * tstepA : cA; const char* nB = has_next ? (const char*)g.Bt + (size_t)nxt.pn * tstepB : cB;
        for (int t = 0; t < nt; t += 2) {
            const bool last = (t == nt - 2);
            const char* a1 = cA + (size_t)(t + 1) * kstep;
            const char* a2 = last ? nA : cA + (size_t)(t + 2) * kstep; const char* b2 = last ? nB : cB + (size_t)(t + 2) * kstep;
            const char* a3 = a2 + kstep; const char* b3 = b2 + kstep;
            PG8_LDB(B0, 0, 0); PG8_SCHED; PG8_LDA(At, 0, 0); PG8_STAGE(PG8_SA(1, 1), a1 + hstepA, voffA);
            PG8_WAIT_L(8); PG8_BAR; PG8_WAIT_L(0); PG8_MMA(0, 0, At, B0); PG8_BAR; PG8_SCHED;
            PG8_LDB(B1, 0, 1); PG8_STAGE(PG8_SB(0, 0), b2, voffB);
            PG8_BAR; PG8_WAIT_L(0); PG8_MMA(0, 1, At, B1); PG8_BAR;
            PG8_LDA(At, 0, 1); PG8_STAGE(PG8_SA(0, 0), a2, voffA);
            PG8_BAR; PG8_WAIT_L(0); PG8_MMA(1, 0, At, B0); PG8_BAR; PG8_SCHED;
            PG8_STAGE(PG8_SB(0, 1), b2 + hstepB, voffB);
            PG8_WAIT_V(6); PG8_BAR; PG8_MMA(1, 1, At, B1); PG8_BAR;
            PG8_LDB(B0, 1, 0); PG8_SCHED; PG8_LDA(At, 1, 0); PG8_STAGE(PG8_SA(0, 1), a2 + hstepA, voffA);
            PG8_WAIT_L(8); PG8_BAR; PG8_WAIT_L(0); PG8_MMA(0, 0, At, B0); PG8_BAR; PG8_SCHED;
            PG8_LDB(B1, 1, 1); PG8_STAGE(PG8_SB(1, 0), b3, voffB);
            PG8_BAR; PG8_WAIT_L(0); PG8_MMA(0, 1, At, B1); PG8_BAR;
            PG8_LDA(At, 1, 1); PG8_STAGE(PG8_SA(1, 0), a3, voffA);
            PG8_BAR; PG8_WAIT_L(0); PG8_MMA(1, 0, At, B0); PG8_BAR; PG8_SCHED;
            PG8_STAGE(PG8_SB(1, 1), b3 + hstepB, voffB);
            PG8_WAIT_V(6); PG8_BAR; PG8_MMA(1, 1, At, B1); PG8_BAR;
        }
        E(acc, cur, wr, wc, fr, fq);
        if (!has_next) break;
#pragma unroll
        for (int a = 0; a < 2; ++a)
#pragma unroll
            for (int b = 0; b < 2; ++b)
#pragma unroll
                for (int m = 0; m < 4; ++m)
#pragma unroll
                    for (int n = 0; n < 2; ++n) acc[a][b][m][n] = (f32x4){0.f, 0.f, 0.f, 0.f};
        cur = nxt; cA = nA; cB = nB; ++ui;
    }
    PG8_WAIT_V(0);
    if (wr == 0) PG8_BAR;
    PG8_BAR;
#undef PG8_SA
#undef PG8_SB
#undef PG8_STAGE
#undef PG8_LDA
#undef PG8_LDB
#undef PG8_MMA
#undef PG8_WAIT_V
#undef PG8_WAIT_L
#undef PG8_BAR
#undef PG8_SCHED
}
}

template <bool QKPERM>
DI void transpose_item(const float* W, int K, int N, bf16_t* WT, LAS float* scr, int item, int lane) {
    const int nblk = N / 32, kb = item / nblk, nb = item % nblk, k0 = 64 * kb, n0 = 32 * nb;
    int sc = n0 + (lane & 31);
    if (QKPERM && sc < 1024) { const int hd = sc >> 6, cp = sc & 63; sc = hd * 64 + 32 * (cp & 1) + (cp >> 1); }
#pragma unroll 8
    for (int i = 0; i < 32; ++i) { const int kk = 2 * i + (lane >> 5); scr[kk * 33 + (lane & 31)] = W[(size_t)(k0 + kk) * N + sc]; }
    LDS_WAIT();
    const int c = lane & 7;
#pragma unroll
    for (int j = 0; j < 4; ++j) { const int n = (lane >> 3) + 8 * j; const LAS float* s = scr + (8 * c) * 33 + n;
        u32x4 o; o.x = cvt_pk_bf16(s[0 * 33], s[1 * 33]); o.y = cvt_pk_bf16(s[2 * 33], s[3 * 33]); o.z = cvt_pk_bf16(s[4 * 33], s[5 * 33]); o.w = cvt_pk_bf16(s[6 * 33], s[7 * 33]);
        *(u32x4*)(WT + (size_t)(n0 + n) * K + k0 + 8 * c) = o; }
    LDS_WAIT();
}

DI void convert_weights(KP p, int l, LAS unsigned char* lds, int wv) {
    const int tid_ = otid(wv); const int wave = tid_ >> 6, lane = tid_ & 63;
    LAS float* scr = (LAS float*)(lds + wave * 8448);
    const int gw = blockIdx.x * 8 + wave, NGW = gridDim.x * 8;
    constexpr int I_IN = 16 * (INC / 32), I_BR = 8 * 32, I_OUT = 16 * 32, I_UP = 16 * (UPC / 32), I_DN = (DFF / 64) * 32, I_L64 = 16, I_L128 = 32;
    constexpr int NIT = I_IN + 3 * I_BR + I_OUT + I_UP + I_DN + 2 * I_L64 + I_L128;
    unsigned char* ws = ows(p->ws);
    for (int it = gw; it < NIT; it += NGW) {
        int r = it;
        if (r < I_IN) { transpose_item<true>(p->in[5] + (size_t)l * 1024 * INC, 1024, INC, (bf16_t*)(ws + WS_WIN), scr, r, lane); continue; } r -= I_IN;
        if (r < 3 * I_BR) { const int b = r / I_BR; transpose_item<false>(p->in[21] + ((size_t)l * 3 + b) * 512 * 1024, 512, 1024, (bf16_t*)(ws + WS_WBR) + (size_t)b * 1024 * 512, scr, r % I_BR, lane); continue; } r -= 3 * I_BR;
        if (r < I_OUT) { transpose_item<false>(p->in[22] + (size_t)l * 1024 * 1024, 1024, 1024, (bf16_t*)(ws + WS_WOUT), scr, r, lane); continue; } r -= I_OUT;
        if (r < I_UP) { transpose_item<false>(p->in[24] + (size_t)l * 1024 * UPC, 1024, UPC, (bf16_t*)(ws + WS_WUP), scr, r, lane); continue; } r -= I_UP;
        if (r < I_DN) { transpose_item<false>(p->in[27] + (size_t)l * DFF * 1024, DFF, 1024, (bf16_t*)(ws + WS_WDN), scr, r, lane); continue; } r -= I_DN;
        if (r < I_L64) { transpose_item<false>(p->in[8] + (size_t)l * 64 * 512, 64, 512, (bf16_t*)(ws + WS_LWU), scr, r, lane); continue; } r -= I_L64;
        if (r < I_L64) { transpose_item<false>(p->in[10] + (size_t)l * 64 * 512, 64, 512, (bf16_t*)(ws + WS_LAU), scr, r, lane); continue; } r -= I_L64;
        transpose_item<false>(p->in[11] + (size_t)l * 128 * 512, 128, 512, (bf16_t*)(ws + WS_LGU), scr, r, lane);
    }
}

DI void phase0(KP p, LAS unsigned char* lds, int wv) {
    const int tid = otid(wv);
    float* ropec = (float*)(p->ws + WS_ROPEC); float* ropes = (float*)(p->ws + WS_ROPES);
    for (int idx = blockIdx.x * 512 + tid; idx < SEQ * 32; idx += gridDim.x * 512) {
        const int pos = idx >> 5, e = idx & 31;
        const float inv = 1.0f / exp2f((float)e * (13.287712379549449f / 32.0f));
        const float ang = (float)pos * inv;
        double rev = (double)ang * 0.15915494309189535; rev -= rint(rev);
        const float rv = (float)rev;
        ropec[idx] = __builtin_amdgcn_cosf(rv); ropes[idx] = __builtin_amdgcn_sinf(rv);
    }
    {
        LAS float* ca = (LAS float*)lds;
        LAS float* red = (LAS float*)(lds + 16384);
        float* mod = (float*)(p->ws + WS_MOD);
        bool loaded = false;
        for (int item = blockIdx.x; item < 192; item += gridDim.x) {
            if (!loaded) { for (int i = tid; i < 4096; i += 512) { const float v = p->in[1][i]; ca[i] = v / (1.0f + __expf(-v)); } loaded = true; __syncthreads(); }
            const int l = item / 96, c0 = (item % 96) * 64, cc = tid & 63, kg = tid >> 6;
            const float* w = p->in[2] + (size_t)l * 1024 * 6144 + c0 + cc;
            float a0 = 0.f, a1 = 0.f, a2 = 0.f, a3 = 0.f;
#pragma unroll 8
            for (int k = kg * 128; k < kg * 128 + 128; ++k) { const float wv = w[(size_t)k * 6144]; a0 += ca[k] * wv; a1 += ca[1024 + k] * wv; a2 += ca[2048 + k] * wv; a3 += ca[3072 + k] * wv; }
            red[(kg * 4 + 0) * 64 + cc] = a0; red[(kg * 4 + 1) * 64 + cc] = a1; red[(kg * 4 + 2) * 64 + cc] = a2; red[(kg * 4 + 3) * 64 + cc] = a3;
            __syncthreads();
            if (tid < 256) { const int b = tid >> 6; float s = 0.f;
#pragma unroll
                for (int g = 0; g < 8; ++g) s += red[(g * 4 + b) * 64 + cc];
                mod[((size_t)l * 4 + b) * 6144 + c0 + cc] = s + p->in[3][(size_t)l * 6144 + c0 + cc]; }
            __syncthreads();
        }
        __syncthreads();
    }
    convert_weights(p, 0, lds, wv);
}

DI void norm_mod_phase(const float* x, const float* g, const float* sh, const float* sc, bf16_t* H, int wv) {
    const int tid_ = otid(wv); const int wave = tid_ >> 6, lane = tid_ & 63;
    for (int row0 = (blockIdx.x * 8 + wave) * 2; row0 < MTOK; row0 += gridDim.x * 16) {
        f32x4 v[2][4]; float s[2] = {0.f, 0.f};
#pragma unroll
        for (int q = 0; q < 2; ++q) { const f32x4* xr = (const f32x4*)(x + (size_t)(row0 + q) * DM) + lane;
#pragma unroll
            for (int j = 0; j < 4; ++j) v[q][j] = xr[64 * j]; }
#pragma unroll
        for (int q = 0; q < 2; ++q)
#pragma unroll
            for (int j = 0; j < 4; ++j) s[q] += (v[q][j][0] * v[q][j][0] + v[q][j][1] * v[q][j][1]) + (v[q][j][2] * v[q][j][2] + v[q][j][3] * v[q][j][3]);
        const float rs0 = rsqrtf(wave_sum(s[0]) * (1.0f / DM) + 1e-6f), rs1 = rsqrtf(wave_sum(s[1]) * (1.0f / DM) + 1e-6f);
        const int b = row0 >> 12;
#pragma unroll
        for (int j = 0; j < 4; ++j) {
            const int c = 4 * lane + 256 * j;
            const f32x4 gg = *(const f32x4*)(g + c), s1 = *(const f32x4*)(sc + (size_t)b * 6144 + c), s0 = *(const f32x4*)(sh + (size_t)b * 6144 + c);
#pragma unroll
            for (int q = 0; q < 2; ++q) {
                const f32x4 h = (v[q][j] * (q ? rs1 : rs0) * gg) * (s1 + 1.0f) + s0;
                u32x2 w; w.x = cvt_pk_bf16(h[0], h[1]); w.y = cvt_pk_bf16(h[2], h[3]);
                *((u32x2*)(H + (size_t)(row0 + q) * DM) + lane + 64 * j) = w;
            }
        }
    }
}
DI void final_norm_phase(float* x, const float* g, int wv) {
    const int tid_ = otid(wv); const int wave = tid_ >> 6, lane = tid_ & 63;
    for (int row = blockIdx.x * 8 + wave; row < MTOK; row += gridDim.x * 8) {
        f32x4* xr = (f32x4*)(x + (size_t)row * DM) + lane;
        f32x4 v[4]; float s = 0.f;
#pragma unroll
        for (int j = 0; j < 4; ++j) { v[j] = xr[64 * j]; s += (v[j][0] * v[j][0] + v[j][1] * v[j][1]) + (v[j][2] * v[j][2] + v[j][3] * v[j][3]); }
        const float rs = rsqrtf(wave_sum(s) * (1.0f / DM) + 1e-6f);
#pragma unroll
        for (int j = 0; j < 4; ++j) { const f32x4 gg = *(const f32x4*)(g + 4 * lane + 256 * j); xr[64 * j] = v[j] * rs * gg; }
    }
}

DI bf16x8 lerp_frag(const bf16_t* cur, const bf16_t* prv, bool hasprev, const float* mu, int act) {
    const u32x4 c = *(const u32x4*)cur; u32x4 q = {0u, 0u, 0u, 0u}; if (hasprev) q = *(const u32x4*)prv;
    const f32x4 m0 = *(const f32x4*)mu, m1 = *(const f32x4*)(mu + 4);
    float z[8];
    const unsigned cw[4] = {c.x, c.y, c.z, c.w}, qw[4] = {q.x, q.y, q.z, q.w};
#pragma unroll
    for (int j = 0; j < 4; ++j) {
        const float c0 = bf_lo(cw[j]), c1 = bf_hi(cw[j]), p0 = bf_lo(qw[j]), p1 = bf_hi(qw[j]);
        const float mA = (j < 2) ? m0[2 * j] : m1[2 * j - 4], mB = (j < 2) ? m0[2 * j + 1] : m1[2 * j - 3];
        z[2 * j] = c0 + (p0 - c0) * mA; z[2 * j + 1] = c1 + (p1 - c1) * mB;
    }
#pragma unroll
    for (int j = 0; j < 8; ++j) {
        if (act == 1) { const float e = __expf(2.0f * z[j]); z[j] = 1.0f - 2.0f / (1.0f + e); }
        else if (act == 2) z[j] = sigmoidf_(z[j]);
    }
    return pack8(z[0], z[1], z[2], z[3], z[4], z[5], z[6], z[7]);
}

DI void rwkv_derived_phase(KP p0, int l, int wv) {
    const int tid_ = otid(wv); const int wave = tid_ >> 6, lane = tid_ & 63, r = lane & 31, hh = lane >> 5;
    for (int job = blockIdx.x * 8 + wave; job < 512 * 8; job += gridDim.x * 8) {
        KP p = okp(); unsigned char* ws = ows(p->ws);
        const bf16_t* RAW = (const bf16_t*)(ws + WS_RAW);
        bf16_t *RZ = (bf16_t*)(ws + WS_RZ), *KP = (bf16_t*)(ws + WS_KP), *VZ = (bf16_t*)(ws + WS_VZ), *KKN = (bf16_t*)(ws + WS_KKN), *Bv = (bf16_t*)(ws + WS_B), *G = (bf16_t*)(ws + WS_G);
        float* W = (float*)(ws + WS_W);
        const bf16_t *LWU = (const bf16_t*)(ws + WS_LWU), *LAU = (const bf16_t*)(ws + WS_LAU), *LGU = (const bf16_t*)(ws + WS_LGU);
        const float* mu = p->in[6] + (size_t)l * RAWC; const float* w0 = p->in[7] + l * 512; const float* a0 = p->in[9] + l * 512;
        const float* k_k = p->in[12] + l * 512; const float* k_a = p->in[13] + l * 512; const float* r_k = p->in[14] + l * 512;
        const int hd = job & 7, tg = job >> 3, t = tg * 32 + r;
        const bool hp = (t & (SEQ - 1)) != 0;
        const bf16_t* cur = RAW + (size_t)t * RAWC; const bf16_t* prv = cur - RAWC;
        float ss = 0.f;
#pragma unroll
        for (int q = 0; q < 8; ++q) {
            const int c = hd * 64 + 8 * q + 4 * hh;
            const u32x2 kc = *(const u32x2*)(cur + 512 + c); u32x2 kq = {0u, 0u}; if (hp) kq = *(const u32x2*)(prv + 512 + c);
            const f32x4 mk = *(const f32x4*)(mu + 512 + c), kkw = *(const f32x4*)(k_k + c);
            const float kcur[4] = {bf_lo(kc.x), bf_hi(kc.x), bf_lo(kc.y), bf_hi(kc.y)}, kprv[4] = {bf_lo(kq.x), bf_hi(kq.x), bf_lo(kq.y), bf_hi(kq.y)};
#pragma unroll
            for (int j = 0; j < 4; ++j) { const float kk = (kcur[j] + (kprv[j] - kcur[j]) * mk[j]) * kkw[j]; ss += kk * kk; }
        }
        ss += __shfl_xor(ss, 32);
        const float inv = 1.0f / fmaxf(sqrtf(ss), 1e-12f);
        float bonus = 0.f;
        {
            bf16x8 bw[4], ba[4];
#pragma unroll
            for (int s = 0; s < 4; ++s) { const int o = 16 * s + 8 * hh; bw[s] = lerp_frag(cur + 1536 + o, prv + 1536 + o, hp, mu + 1536 + o, 1); ba[s] = lerp_frag(cur + 1600 + o, prv + 1600 + o, hp, mu + 1600 + o, 0); }
#pragma unroll 1
            for (int mt = 0; mt < 2; ++mt) {
                const int chr = hd * 64 + 32 * mt + r;
                f32x16 aw, aa;
#pragma unroll
                for (int i = 0; i < 16; ++i) { aw[i] = 0.f; aa[i] = 0.f; }
                {
                    typedef const __attribute__((address_space(1))) bf16x8* GP8;
                    const GP8 pw = (GP8)(LWU + (size_t)chr * 64 + 8 * hh), pa = (GP8)(LAU + (size_t)chr * 64 + 8 * hh);
                    bf16x8 fw[4], fa[4];
#pragma unroll
                    for (int s = 0; s < 4; ++s) { fw[s] = pw[2 * s]; fa[s] = pa[2 * s]; }
                    asm volatile("" ::: "memory");
#pragma unroll
                    for (int s = 0; s < 4; ++s) { aw = MFMA32(fw[s], bw[s], aw); aa = MFMA32(fa[s], ba[s], aa); }
                }
#pragma unroll
                for (int i4 = 0; i4 < 4; ++i4) {
                    const int c = hd * 64 + 32 * mt + 8 * i4 + 4 * hh;
                    const u32x2 rc = *(const u32x2*)(cur + c), kc = *(const u32x2*)(cur + 512 + c), vc = *(const u32x2*)(cur + 1024 + c);
                    u32x2 rp = {0u, 0u}, kq = {0u, 0u}, vp = {0u, 0u};
                    if (hp) { rp = *(const u32x2*)(prv + c); kq = *(const u32x2*)(prv + 512 + c); vp = *(const u32x2*)(prv + 1024 + c); }
                    const f32x4 mr = *(const f32x4*)(mu + c), mk = *(const f32x4*)(mu + 512 + c), mv = *(const f32x4*)(mu + 1024 + c);
                    const f32x4 w0v = *(const f32x4*)(w0 + c), a0v = *(const f32x4*)(a0 + c), kkw = *(const f32x4*)(k_k + c), kaw = *(const f32x4*)(k_a + c), rkw = *(const f32x4*)(r_k + c);
                    const float rcur[4] = {bf_lo(rc.x), bf_hi(rc.x), bf_lo(rc.y), bf_hi(rc.y)}, rprv[4] = {bf_lo(rp.x), bf_hi(rp.x), bf_lo(rp.y), bf_hi(rp.y)};
                    const float kcur[4] = {bf_lo(kc.x), bf_hi(kc.x), bf_lo(kc.y), bf_hi(kc.y)}, kprv[4] = {bf_lo(kq.x), bf_hi(kq.x), bf_lo(kq.y), bf_hi(kq.y)};
                    const float vcur[4] = {bf_lo(vc.x), bf_hi(vc.x), bf_lo(vc.y), bf_hi(vc.y)}, vprv[4] = {bf_lo(vp.x), bf_hi(vp.x), bf_lo(vp.y), bf_hi(vp.y)};
                    f32x4 dec; float rz[4], kp[4], vz[4], kn[4], bb[4];
#pragma unroll
                    for (int j = 0; j < 4; ++j) {
                        const int i = 4 * i4 + j;
                        const float zz = -(w0v[j] + aw[i]);
                        const float sp = (zz > 20.f) ? zz : __logf(1.0f + __expf(zz));
                        const float wv = -sp - 0.5f;
                        dec[j] = __expf(-__expf(wv));
                        const float av = sigmoidf_(a0v[j] + aa[i]);
                        rz[j] = rcur[j] + (rprv[j] - rcur[j]) * mr[j];
                        const float kz = kcur[j] + (kprv[j] - kcur[j]) * mk[j];
                        vz[j] = vcur[j] + (vprv[j] - vcur[j]) * mv[j];
                        kn[j] = kz * kkw[j] * inv; bb[j] = kn[j] * av;
                        kp[j] = kz * (1.0f + (av - 1.0f) * kaw[j]);
                        bonus += rz[j] * kp[j] * rkw[j];
                    }
                    const size_t o = (size_t)t * 512 + c;
                    *(f32x4*)(W + o) = dec;
                    u32x2 w2; w2.x = cvt_pk_bf16(rz[0], rz[1]); w2.y = cvt_pk_bf16(rz[2], rz[3]); *(u32x2*)(RZ + o) = w2;
                    w2.x = cvt_pk_bf16(kp[0], kp[1]); w2.y = cvt_pk_bf16(kp[2], kp[3]); *(u32x2*)(KP + o) = w2;
                    w2.x = cvt_pk_bf16(vz[0], vz[1]); w2.y = cvt_pk_bf16(vz[2], vz[3]); *(u32x2*)(VZ + o) = w2;
                    w2.x = cvt_pk_bf16(kn[0], kn[1]); w2.y = cvt_pk_bf16(kn[2], kn[3]); *(u32x2*)(KKN + o) = w2;
                    w2.x = cvt_pk_bf16(bb[0], bb[1]); w2.y = cvt_pk_bf16(bb[2], bb[3]); *(u32x2*)(Bv + o) = w2;
                }
            }
        }
        bonus += __shfl_xor(bonus, 32);
        int t2 = t; asm volatile("" : "+v"(t2));
        if (hh == 0) ((float*)(ows(ws) + WS_BONUS))[(size_t)t2 * 8 + hd] = bonus;
        {
            bf16x8 bg[8];
#pragma unroll
            for (int s = 0; s < 8; ++s) { const int o = 16 * s + 8 * hh; bg[s] = lerp_frag(cur + 1664 + o, prv + 1664 + o, hp, mu + 1664 + o, 2); }
#pragma unroll 1
            for (int mt = 0; mt < 2; ++mt) {
                const int chr = hd * 64 + 32 * mt + r;
                f32x16 ag;
#pragma unroll
                for (int i = 0; i < 16; ++i) ag[i] = 0.f;
                {
                    typedef const __attribute__((address_space(1))) bf16x8* GP8;
                    const GP8 pg = (GP8)(LGU + (size_t)chr * 128 + 8 * hh);
                    bf16x8 fg[8];
#pragma unroll
                    for (int s = 0; s < 8; ++s) fg[s] = pg[2 * s];
                    asm volatile("" ::: "memory");
#pragma unroll
                    for (int s = 0; s < 8; ++s) ag = MFMA32(fg[s], bg[s], ag);
                }
#pragma unroll
                for (int i4 = 0; i4 < 4; ++i4) {
                    const size_t o = (size_t)t2 * 512 + hd * 64 + 32 * mt + 8 * i4 + 4 * hh;
                    u32x2 w2; w2.x = cvt_pk_bf16(ag[4 * i4], ag[4 * i4 + 1]); w2.y = cvt_pk_bf16(ag[4 * i4 + 2], ag[4 * i4 + 3]); *(u32x2*)(G + o) = w2;
                }
            }
        }
    }
}

constexpr int SC_T = 32, SC_STEP = 1344, SC_BUF = SC_T * SC_STEP;
struct ScanRegs { f32x4 w0, w1; u32x4 kn, bb, kp, rz, vv; };
DI void scan_gload(KP p, ScanRegs& R, int b, int h, int rg, int ck, int pt) {
    const unsigned char* ws = ows(p->ws);
    const size_t tok0 = (size_t)b * SEQ + (size_t)ck * SC_T;
    { const int st = pt >> 4, sub = pt & 15; R.w0 = *(const f32x4*)((const float*)(ws + WS_W) + (tok0 + st) * 512 + h * 64 + 4 * sub); }
    { const int pp = pt + 256, st = pp >> 4, sub = pp & 15; R.w1 = *(const f32x4*)((const float*)(ws + WS_W) + (tok0 + st) * 512 + h * 64 + 4 * sub); }
    const int st = pt >> 3, sub = pt & 7; const size_t go = (tok0 + st) * 512 + h * 64 + 8 * sub;
    R.kn = *(const u32x4*)((const bf16_t*)(ws + WS_KKN) + go); R.bb = *(const u32x4*)((const bf16_t*)(ws + WS_B) + go);
    R.kp = *(const u32x4*)((const bf16_t*)(ws + WS_KP) + go); R.rz = *(const u32x4*)((const bf16_t*)(ws + WS_RZ) + go);
    R.vv = (u32x4){0u, 0u, 0u, 0u};
    if (pt < 64) { const int s2 = pt >> 1, hf = pt & 1; R.vv = *(const u32x4*)((const bf16_t*)(ws + WS_VZ) + (tok0 + s2) * 512 + h * 64 + rg * 16 + 8 * hf); }
}
DI void scan_write(const ScanRegs& R, LAS unsigned char* buf, int pt) {
    { const int st = pt >> 4, sub = pt & 15; *(LAS f32x4*)(buf + st * SC_STEP + sub * 16) = R.w0; }
    { const int pp = pt + 256, st = pp >> 4, sub = pp & 15; *(LAS f32x4*)(buf + st * SC_STEP + sub * 16) = R.w1; }
    const int st = pt >> 3, sub = pt & 7;
    const u32x4 kn = R.kn, bb = R.bb, kp = R.kp, rz = R.rz;
    LAS unsigned char* d = buf + st * SC_STEP + sub * 32;
    *(LAS f32x4*)(d + 256) = (f32x4){-bf_lo(kn.x), -bf_hi(kn.x), -bf_lo(kn.y), -bf_hi(kn.y)}; *(LAS f32x4*)(d + 256 + 16) = (f32x4){-bf_lo(kn.z), -bf_hi(kn.z), -bf_lo(kn.w), -bf_hi(kn.w)};
    *(LAS f32x4*)(d + 512) = (f32x4){bf_lo(bb.x), bf_hi(bb.x), bf_lo(bb.y), bf_hi(bb.y)}; *(LAS f32x4*)(d + 512 + 16) = (f32x4){bf_lo(bb.z), bf_hi(bb.z), bf_lo(bb.w), bf_hi(bb.w)};
    *(LAS f32x4*)(d + 768) = (f32x4){bf_lo(kp.x), bf_hi(kp.x), bf_lo(kp.y), bf_hi(kp.y)}; *(LAS f32x4*)(d + 768 + 16) = (f32x4){bf_lo(kp.z), bf_hi(kp.z), bf_lo(kp.w), bf_hi(kp.w)};
    *(LAS f32x4*)(d + 1024) = (f32x4){bf_lo(rz.x), bf_hi(rz.x), bf_lo(rz.y), bf_hi(rz.y)}; *(LAS f32x4*)(d + 1024 + 16) = (f32x4){bf_lo(rz.z), bf_hi(rz.z), bf_lo(rz.w), bf_hi(rz.w)};
    if (pt < 64) { const int s2 = pt >> 1, hf = pt & 1; const u32x4 vv = R.vv;
        LAS unsigned char* dv = buf + s2 * SC_STEP + 1280 + hf * 32;
        *(LAS f32x4*)dv = (f32x4){bf_lo(vv.x), bf_hi(vv.x), bf_lo(vv.y), bf_hi(vv.y)}; *(LAS f32x4*)(dv + 16) = (f32x4){bf_lo(vv.z), bf_hi(vv.z), bf_lo(vv.w), bf_hi(vv.w)}; }
}
DI void rwkv_scan_phase(KP p, LAS unsigned char* lds, int wv) {
    const int tid = otid(wv), wave = tid >> 6, lane = tid & 63;
    float* YRAW = (float*)(p->ws + WS_YRAW);
    for (int job = blockIdx.x; job < 128; job += gridDim.x) {
        const int chain = job >> 2, rg = job & 3, b = chain >> 3, h = chain & 7;
        __syncthreads();
        ScanRegs R;
        if (wave >= 4) { scan_gload(p, R, b, h, rg, 0, tid - 256); scan_write(R, lds, tid - 256); scan_gload(p, R, b, h, rg, 1, tid - 256); }
        __syncthreads();
        f32x4 S = {0.f, 0.f, 0.f, 0.f};
        const int jl = lane & 15, rl = 4 * (wave & 3) + (lane >> 4);
        for (int ck = 0; ck < SEQ / SC_T; ++ck) {
            LAS unsigned char* cb = lds + (ck & 1) * SC_BUF;
            if (wave >= 4) { if (ck + 1 < SEQ / SC_T) { scan_write(R, lds + ((ck + 1) & 1) * SC_BUF, tid - 256); if (ck + 2 < SEQ / SC_T) scan_gload(p, R, b, h, rg, ck + 2, tid - 256); } }
            else {
                float* yo = YRAW + ((size_t)b * SEQ + (size_t)ck * SC_T + jl) * 512 + h * 64 + rg * 16 + rl;
                const LAS unsigned char* sb = cb + jl * 16; const LAS unsigned char* vb = cb + 1280 + rl * 4;
                f32x4 w4 = *(const LAS f32x4*)sb, an = *(const LAS f32x4*)(sb + 256), b4 = *(const LAS f32x4*)(sb + 512), k4 = *(const LAS f32x4*)(sb + 768), r4 = *(const LAS f32x4*)(sb + 1024);
                float vi = *(const LAS float*)vb;
                float ysel = 0.f;
#pragma unroll
                for (int s = 0; s < SC_T; ++s) {
                    f32x4 w4n = w4, ann = an, b4n = b4, k4n = k4, r4n = r4; float vin = vi;
                    if (s + 1 < SC_T) {
                        const LAS unsigned char* sn = sb + (s + 1) * SC_STEP;
                        w4n = *(const LAS f32x4*)sn; ann = *(const LAS f32x4*)(sn + 256); b4n = *(const LAS f32x4*)(sn + 512); k4n = *(const LAS f32x4*)(sn + 768); r4n = *(const LAS f32x4*)(sn + 1024);
                        vin = *(const LAS float*)(vb + (s + 1) * SC_STEP);
                    }
                    float sa = (S[0] * an[0] + S[1] * an[1]) + (S[2] * an[2] + S[3] * an[3]);
                    sa = row16_sum(sa);
                    S = S * w4 + (b4 * sa + k4 * vi);
                    float y = (S[0] * r4[0] + S[1] * r4[1]) + (S[2] * r4[2] + S[3] * r4[3]);
                    y = row16_sum(y);
                    ysel = (jl == (s & 15)) ? y : ysel;
                    if ((s & 15) == 15) yo[(size_t)(s - 15) * 512] = ysel;
                    w4 = w4n; an = ann; b4 = b4n; k4 = k4n; r4 = r4n; vi = vin;
                }
            }
            __syncthreads();
        }
    }
}

DI void rwkv_post_phase(KP p, int l, int wv) {
    const unsigned char* ws = ows(p->ws);
    const float* YRAW = (const float*)(ws + WS_YRAW); const bf16_t* VZ = (const bf16_t*)(ws + WS_VZ); const bf16_t* G = (const bf16_t*)(ws + WS_G);
    const float* BONUS = (const float*)(ws + WS_BONUS); bf16_t* YS = (bf16_t*)(p->ws + WS_YSR);
    const float* gnw = p->in[15] + l * 512; const float* gnb = p->in[16] + l * 512;
    const int tid_ = otid(wv); const int wave = tid_ >> 6, lane = tid_ & 63, c = 8 * lane;
    const f32x4 gw0 = *(const f32x4*)(gnw + c), gw1 = *(const f32x4*)(gnw + c + 4), gb0 = *(const f32x4*)(gnb + c), gb1 = *(const f32x4*)(gnb + c + 4);
    for (int t = blockIdx.x * 8 + wave; t < MTOK; t += gridDim.x * 8) {
        const size_t o = (size_t)t * 512 + c;
        const f32x4 y0 = *(const f32x4*)(YRAW + o), y1 = *(const f32x4*)(YRAW + o + 4);
        float s = (y0[0] + y0[1]) + (y0[2] + y0[3]) + (y1[0] + y1[1]) + (y1[2] + y1[3]);
        s += __shfl_xor(s, 1); s += __shfl_xor(s, 2); s += __shfl_xor(s, 4);
        const float mean = s * (1.0f / 64.0f);
        const f32x4 d0 = y0 - mean, d1 = y1 - mean;
        float q = (d0[0] * d0[0] + d0[1] * d0[1]) + (d0[2] * d0[2] + d0[3] * d0[3]) + (d1[0] * d1[0] + d1[1] * d1[1]) + (d1[2] * d1[2] + d1[3] * d1[3]);
        q += __shfl_xor(q, 1); q += __shfl_xor(q, 2); q += __shfl_xor(q, 4);
        const float rstd = rsqrtf(q * (1.0f / 64.0f) + 64e-5f);
        const float bon = BONUS[(size_t)t * 8 + (lane >> 3)];
        const u32x4 vv = *(const u32x4*)(VZ + o), gg = *(const u32x4*)(G + o);
        const f32x4 v0 = {bf_lo(vv.x), bf_hi(vv.x), bf_lo(vv.y), bf_hi(vv.y)}, v1 = {bf_lo(vv.z), bf_hi(vv.z), bf_lo(vv.w), bf_hi(vv.w)};
        const f32x4 g0 = {bf_lo(gg.x), bf_hi(gg.x), bf_lo(gg.y), bf_hi(gg.y)}, g1 = {bf_lo(gg.z), bf_hi(gg.z), bf_lo(gg.w), bf_hi(gg.w)};
        const f32x4 r0 = (d0 * rstd * gw0 + gb0 + v0 * bon) * g0, r1 = (d1 * rstd * gw1 + gb1 + v1 * bon) * g1;
        u32x4 w; w.x = cvt_pk_bf16(r0[0], r0[1]); w.y = cvt_pk_bf16(r0[2], r0[3]); w.z = cvt_pk_bf16(r1[0], r1[1]); w.w = cvt_pk_bf16(r1[2], r1[3]);
        *(u32x4*)(YS + o) = w;
    }
}

DI void attn_job(const bf16_t* Q, const bf16_t* K, const bf16_t* V, bf16_t* YS, float* LSE, LAS unsigned char* vl, int b, int h, int d, int rho, int J0, bool first, int lane) {
    asm volatile("" : "+v"(lane));
    const int r = lane & 31, hh = lane >> 5;
    const size_t tokq = (size_t)b * SEQ + (size_t)(J0 + r) * d + rho;
    typedef const __attribute__((address_space(1))) bf16x8* GP8;
    typedef const __attribute__((address_space(1))) u32x4* GP4;
    bf16x8 bq[4];
    { const GP8 qp = (GP8)(Q + tokq * 512 + h * 64 + 8 * hh);
#pragma unroll
      for (int s = 0; s < 4; ++s) bq[s] = qp[2 * s]; }
    bf16x8 ak[5][4];
#pragma unroll
    for (int kt = 0; kt < 5; ++kt) {
        const int Jk = J0 - 128 + 32 * kt + r;
        const size_t tokk = (size_t)b * SEQ + (size_t)(Jk >= 0 ? Jk : 0) * d + rho;
        const GP8 kp = (GP8)(K + tokk * 512 + h * 64 + 8 * hh);
#pragma unroll
        for (int s = 0; s < 4; ++s) ak[kt][s] = kp[2 * s];
    }
    asm volatile("" ::: "memory");
    f32x16 sc[5];
#pragma unroll
    for (int kt = 0; kt < 5; ++kt) {
        const bool valid = (J0 - 128 + 32 * kt + r) >= 0;
        f32x16 a;
#pragma unroll
        for (int i = 0; i < 16; ++i) a[i] = 0.f;
#pragma unroll
        for (int s = 0; s < 4; ++s) {
            bf16x8 kf = ak[kt][s];
            if (!valid) kf = (bf16x8){0, 0, 0, 0, 0, 0, 0, 0};
            a = MFMA32(kf, bq[s], a);
        }
        sc[kt] = a;
    }
    float m = -1e30f;
#pragma unroll
    for (int kt = 0; kt < 5; ++kt)
#pragma unroll
        for (int i = 0; i < 16; ++i) {
            const int kidx = 32 * kt + crow(i, hh); const int dist = 128 + r - kidx;
            const bool ok = (dist >= 0) && (dist <= 128) && (J0 - 128 + kidx >= 0);
            const float v = ok ? sc[kt][i] * 0.125f : -1e30f;
            sc[kt][i] = v; m = fmaxf(m, v);
        }
    m = fmaxf(m, __shfl_xor(m, 32));
    float lsum = 0.f;
#pragma unroll
    for (int kt = 0; kt < 5; ++kt)
#pragma unroll
        for (int i = 0; i < 16; ++i) { const float pv = __expf(sc[kt][i] - m); sc[kt][i] = pv; lsum += pv; }
    lsum += __shfl_xor(lsum, 32);
    const float lse = m + __logf(lsum);
    f32x16 o[2];
#pragma unroll
    for (int i = 0; i < 16; ++i) { o[0][i] = 0.f; o[1][i] = 0.f; }
    u32x4 vr[4];
    {
        const int key = lane >> 1, hf = lane & 1; const int Jk = J0 - 128 + key;
        const size_t tokv = (size_t)b * SEQ + (size_t)(Jk >= 0 ? Jk : 0) * d + rho;
        const GP4 src = (GP4)(V + tokv * 512 + h * 64 + 32 * hf);
        vr[0] = src[0]; vr[1] = src[1]; vr[2] = src[2]; vr[3] = src[3];
    }
#pragma unroll
    for (int kt = 0; kt < 5; ++kt) {
        {
            const int key = lane >> 1, hf = lane & 1;
            LAS u32x4* dst = (LAS u32x4*)(vl + key * 128 + hf * 64);
            dst[0] = vr[0]; dst[1] = vr[1]; dst[2] = vr[2]; dst[3] = vr[3];
            if (kt + 1 < 5) {
                const int Jk = J0 - 128 + 32 * (kt + 1) + key;
                const size_t tokv = (size_t)b * SEQ + (size_t)(Jk >= 0 ? Jk : 0) * d + rho;
                const GP4 src = (GP4)(V + tokv * 512 + h * 64 + 32 * hf);
                vr[0] = src[0]; vr[1] = src[1]; vr[2] = src[2]; vr[3] = src[3];
            }
        }
        LDS_WAIT();
#pragma unroll
        for (int s = 0; s < 2; ++s) {
            const bf16x8 xs = pack8(sc[kt][8 * s], sc[kt][8 * s + 1], sc[kt][8 * s + 2], sc[kt][8 * s + 3], sc[kt][8 * s + 4], sc[kt][8 * s + 5], sc[kt][8 * s + 6], sc[kt][8 * s + 7]);
#pragma unroll
            for (int mt = 0; mt < 2; ++mt) {
                bf16x8 pa;
#pragma unroll
                for (int j = 0; j < 8; ++j) { const int key = 16 * s + 8 * (j >> 2) + 4 * hh + (j & 3); pa[j] = (short)*(const LAS bf16_t*)(vl + key * 128 + (r + 32 * mt) * 2); }
                o[mt] = MFMA32(pa, xs, o[mt]);
            }
        }
        LDS_WAIT();
    }
    const float il = 1.0f / lsum;
    float wp = 0.f, wc = 1.0f, nl = lse;
    if (!first) { const float lp = LSE[tokq * 8 + h]; const float mx = fmaxf(lp, lse); const float ep = __expf(lp - mx), ec = __expf(lse - mx); nl = mx + __logf(ep + ec); wp = ep / (ep + ec); wc = ec / (ep + ec); }
#pragma unroll
    for (int mt = 0; mt < 2; ++mt)
#pragma unroll
        for (int g4 = 0; g4 < 4; ++g4) {
            bf16_t* dst = YS + tokq * 512 + h * 64 + 32 * mt + 8 * g4 + 4 * hh;
            float v[4];
#pragma unroll
            for (int j = 0; j < 4; ++j) v[j] = o[mt][4 * g4 + j] * il * wc;
            if (!first) { const u32x2 pw = *(const u32x2*)dst; v[0] += bf_lo(pw.x) * wp; v[1] += bf_hi(pw.x) * wp; v[2] += bf_lo(pw.y) * wp; v[3] += bf_hi(pw.y) * wp; }
            u32x2 w2; w2.x = cvt_pk_bf16(v[0], v[1]); w2.y = cvt_pk_bf16(v[2], v[3]); *(u32x2*)dst = w2;
        }
    if (hh == 0) LSE[tokq * 8 + h] = nl;
}

DI void attention_phase(KP p, LAS unsigned char* lds, int wv) {
    unsigned char* ws = ows(p->ws);
    const bf16_t *Q = (const bf16_t*)(ws + WS_Q), *K = (const bf16_t*)(ws + WS_K), *V = (const bf16_t*)(ws + WS_V);
    bf16_t* YS = (bf16_t*)(ws + WS_YSA); float* LSE = (float*)(ws + WS_LSE);
    const int tid_ = otid(wv); const int wave = tid_ >> 6, lane = tid_ & 63;
    LAS unsigned char* vl = lds + wave * 4096;
    for (int item = blockIdx.x; item < 256; item += gridDim.x) {
        const int b = item >> 6, h = (item >> 3) & 7, qb = item & 7, P0 = qb * 512;
#pragma unroll 1
        for (int cfg = 0; cfg < 3; ++cfg) {
#pragma unroll 1
            for (int jj = wave; jj < 16; jj += 8) {
                int d, rho, J0;
                if (cfg == 0) { d = 1; rho = 0; J0 = P0 + 32 * jj; }
                else if (cfg == 1) { d = 4; rho = jj & 3; J0 = (P0 >> 2) + 32 * (jj >> 2); }
                else { d = 16; rho = jj; J0 = P0 >> 4; }
                attn_job(Q, K, V, YS, LSE, vl, b, h, d, rho, J0, cfg == 0, lane);
            }
            asm volatile("s_waitcnt vmcnt(0)" ::: "memory");
            __syncthreads();
        }
    }
}

DI void gmlp_phase(KP p, int l, LAS unsigned char* lds, int wv) {
    unsigned char* ws = ows(p->ws);
    const bf16_t* UV = (const bf16_t*)(ws + WS_UV); bf16_t* YS = (bf16_t*)(ws + WS_YSG);
    const float* lng = p->in[17] + l * 512; const float* lnb = p->in[18] + l * 512;
    const float* wsp = p->in[19] + (size_t)l * 8 * 128 * 128; const float* bsp = p->in[20] + (size_t)l * 8 * 128;
    const int tid_ = otid(wv); const int wave = tid_ >> 6, lane = tid_ & 63, r = lane & 31, hh = lane >> 5;
    LAS float* stats = (LAS float*)(lds + 8 * 17408);
    LAS bf16_t* VT = (LAS bf16_t*)(lds + wave * 17408);
    for (int item = blockIdx.x; item < 256; item += gridDim.x) {
        const size_t tok0 = (size_t)(item >> 1) * 128;
        __syncthreads();
        for (int tt = 0; tt < 16; ++tt) {
            const int tl = wave * 16 + tt;
            const u32x4 x = *(const u32x4*)(UV + (tok0 + tl) * 1024 + 512 + 8 * lane);
            const float f[8] = {bf_lo(x.x), bf_hi(x.x), bf_lo(x.y), bf_hi(x.y), bf_lo(x.z), bf_hi(x.z), bf_lo(x.w), bf_hi(x.w)};
            float s = 0.f;
#pragma unroll
            for (int j = 0; j < 8; ++j) s += f[j];
            const float mean = wave_sum(s) * (1.0f / 512.0f); float q = 0.f;
#pragma unroll
            for (int j = 0; j < 8; ++j) { const float dd = f[j] - mean; q += dd * dd; }
            const float rstd = rsqrtf(wave_sum(q) * (1.0f / 512.0f) + 1e-5f);
            if (lane == 0) { stats[2 * tl] = mean; stats[2 * tl + 1] = rstd; }
        }
        __syncthreads();
        const int g = (item & 1) * 4 + (wave & 3);
        if (wave < 4) {
        {
            const int d0 = 8 * (lane & 7);
            const f32x4 lg0 = *(const f32x4*)(lng + g * 64 + d0), lg1 = *(const f32x4*)(lng + g * 64 + d0 + 4), lb0 = *(const f32x4*)(lnb + g * 64 + d0), lb1 = *(const f32x4*)(lnb + g * 64 + d0 + 4);
            for (int it = 0; it < 16; ++it) {
                const int tl = it * 8 + (lane >> 3);
                const u32x4 x = *(const u32x4*)(UV + (tok0 + tl) * 1024 + 512 + g * 64 + d0);
                const float mean = stats[2 * tl], rstd = stats[2 * tl + 1];
                const float f[8] = {bf_lo(x.x), bf_hi(x.x), bf_lo(x.y), bf_hi(x.y), bf_lo(x.z), bf_hi(x.z), bf_lo(x.w), bf_hi(x.w)};
#pragma unroll
                for (int e = 0; e < 8; ++e) {
                    const float gg = e < 4 ? lg0[e & 3] : lg1[e & 3], bb = e < 4 ? lb0[e & 3] : lb1[e & 3];
                    const float y = (f[e] - mean) * rstd * gg + bb;
                    VT[(d0 + e) * 136 + tl] = (bf16_t)(cvt_pk_bf16(y, 0.f) & 0xffffu);
                }
            }
        }
        LDS_WAIT();
#pragma unroll 1
        for (int nt = 0; nt < 4; ++nt) {
            f32x16 acc[2];
#pragma unroll
            for (int i = 0; i < 16; ++i) { acc[0][i] = 0.f; acc[1][i] = 0.f; }
            const int irow = 32 * nt + r;
            for (int s = 0; s < 2 * (nt + 1); ++s) {
                const int j0 = 16 * s + 8 * hh;
                const float* wr_ = wsp + ((size_t)g * 128 + irow) * 128 + j0;
                const f32x4 wa = *(const f32x4*)wr_, wb = *(const f32x4*)(wr_ + 4);
                float wv[8] = {wa[0], wa[1], wa[2], wa[3], wb[0], wb[1], wb[2], wb[3]};
#pragma unroll
                for (int j = 0; j < 8; ++j) if (j0 + j > irow) wv[j] = 0.f;
                const bf16x8 bfr = pack8(wv[0], wv[1], wv[2], wv[3], wv[4], wv[5], wv[6], wv[7]);
#pragma unroll
                for (int mt = 0; mt < 2; ++mt) {
                    const bf16x8 afr = *(const LAS bf16x8*)(VT + (32 * mt + r) * 136 + j0);
                    acc[mt] = MFMA32(afr, bfr, acc[mt]);
                }
            }
            const size_t tok = tok0 + irow; const float bs = bsp[g * 128 + irow];
#pragma unroll
            for (int mt = 0; mt < 2; ++mt)
#pragma unroll
                for (int g4 = 0; g4 < 4; ++g4) {
                    const int c = g * 64 + 32 * mt + 8 * g4 + 4 * hh;
                    const u32x2 uu = *(const u32x2*)(UV + tok * 1024 + c);
                    const float o0 = bf_lo(uu.x) * (acc[mt][4 * g4] + bs), o1 = bf_hi(uu.x) * (acc[mt][4 * g4 + 1] + bs), o2 = bf_lo(uu.y) * (acc[mt][4 * g4 + 2] + bs), o3 = bf_hi(uu.y) * (acc[mt][4 * g4 + 3] + bs);
                    u32x2 w2; w2.x = cvt_pk_bf16(o0, o1); w2.y = cvt_pk_bf16(o2, o3); *(u32x2*)(YS + tok * 512 + c) = w2;
                }
        }
        }
    }
}

DI void ffn_conv_phase(KP p, int l, int wv) {
    bf16_t* UP = (bf16_t*)(ows(p->ws) + WS_UP);
    const float* cw = p->in[25] + (size_t)l * 3 * DFF; const float* cb = p->in[26] + (size_t)l * DFF;
    constexpr int NCG = DFF / 8, RUN = 32, NRUN = MTOK / RUN;
    const int tid_ = otid(wv);
    for (int item = blockIdx.x * 512 + tid_; item < NCG * NRUN; item += gridDim.x * 512) {
        const int cgi = item % NCG, run = item / NCG, f0 = 8 * cgi, t0 = run * RUN;
        float w0[8], w1[8], w2[8], bb[8];
#pragma unroll
        for (int q = 0; q < 2; ++q) { const f32x4 a = *(const f32x4*)(cw + f0 + 4 * q), b = *(const f32x4*)(cw + DFF + f0 + 4 * q), c = *(const f32x4*)(cw + 2 * DFF + f0 + 4 * q), d = *(const f32x4*)(cb + f0 + 4 * q);
#pragma unroll
            for (int j = 0; j < 4; ++j) { w0[4 * q + j] = a[j]; w1[4 * q + j] = b[j]; w2[4 * q + j] = c[j]; bb[4 * q + j] = d[j]; } }
        u32x4 am2 = {0u, 0u, 0u, 0u}, am1 = {0u, 0u, 0u, 0u};
        if ((t0 & (SEQ - 1)) != 0) { am2 = *(const u32x4*)(UP + (size_t)(t0 - 2) * UPC + f0); am1 = *(const u32x4*)(UP + (size_t)(t0 - 1) * UPC + f0); }
        for (int t = t0; t < t0 + RUN; t += 4) {
            u32x4 av[4], gv[4];
#pragma unroll
            for (int q = 0; q < 4; ++q) { av[q] = *(const u32x4*)(UP + (size_t)(t + q) * UPC + f0); gv[q] = *(const u32x4*)(UP + (size_t)(t + q) * UPC + DFF + f0); }
#pragma unroll
            for (int q = 0; q < 4; ++q) {
                const u32x4 a0 = av[q], gg = gv[q];
                const unsigned x2[4] = {am2.x, am2.y, am2.z, am2.w}, x1[4] = {am1.x, am1.y, am1.z, am1.w}, x0[4] = {a0.x, a0.y, a0.z, a0.w}, xg[4] = {gg.x, gg.y, gg.z, gg.w};
                unsigned ow[4];
#pragma unroll
                for (int j = 0; j < 4; ++j) {
                    const float c0 = bb[2 * j] + w0[2 * j] * bf_lo(x2[j]) + w1[2 * j] * bf_lo(x1[j]) + w2[2 * j] * bf_lo(x0[j]);
                    const float c1 = bb[2 * j + 1] + w0[2 * j + 1] * bf_hi(x2[j]) + w1[2 * j + 1] * bf_hi(x1[j]) + w2[2 * j + 1] * bf_hi(x0[j]);
                    ow[j] = cvt_pk_bf16(gelu_tanh(c0) * bf_lo(xg[j]), gelu_tanh(c1) * bf_hi(xg[j]));
                }
                *(u32x4*)(UP + (size_t)(t + q) * UPC + DFF + f0) = (u32x4){ow[0], ow[1], ow[2], ow[3]};
                am2 = am1; am1 = a0;
            }
        }
    }
}

__global__ void __launch_bounds__(512) fwd_megakernel(Params p_unused) {
    extern __shared__ __attribute__((aligned(16))) unsigned char lds_raw[];
    LAS unsigned char* lds = (LAS unsigned char*)lds_raw;
    cg::grid_group grid = cg::this_grid();
    KP p = okp();
    unsigned char* ws = p->ws;
    const int G = gridDim.x, c = blockIdx.x;
    const int wv = __builtin_amdgcn_readfirstlane((int)(threadIdx.x >> 6));
    pg8::Epi E; pg8::TileOrder S; pg8::Gemm g;

    unsigned* bar = (unsigned*)(ws + WS_BAR);
    volatile LAS unsigned* xst = (volatile LAS unsigned*)(lds + LDS_BYTES - 16);
    const unsigned myx = xb_xcc_id();
    if (otid(wv) == 0) { xb_add(&bar[XB_CNT(myx)], 1u); __builtin_amdgcn_fence(__ATOMIC_RELEASE, "agent"); }
    grid.sync();
    if (otid(wv) == 0) {
        unsigned mine = 0u, cnt = 0u;
#pragma unroll
        for (unsigned j = 0; j < 8; ++j) { const unsigned c = xb_ld(&bar[XB_CNT(j)]); cnt += (c > 0u) ? 1u : 0u; mine = (j == myx) ? c : mine; }
        xst[0] = mine > 0u ? mine : 1u; xst[1] = cnt > 0u ? cnt : 1u; xst[2] = myx;
    }
    __syncthreads();
    phase0(p, lds, wv);
    gbar(bar, xst, wv);
#pragma unroll 1
    for (int st = 0; st < 2 * 17; ++st) {
        const int l = st / 17, step = st % 17;
        p = okp(); ws = ows(p->ws);
        const float* mod = (const float*)(ws + WS_MOD); const bf16_t* H = (const bf16_t*)(ws + WS_H);
        const float* ml = mod + (size_t)l * 4 * 6144;
        const float* xin = (l == 0) ? p->in[0] : p->out;
        bool do_gemm = false, do_sync = true;
        E = pg8::Epi{};
        if (step == 0) {
            if (l > 0) convert_weights(p, l, lds, wv);
#ifdef REP_CONVW
            if (l > 0) convert_weights(p, l, lds, wv);
#endif
            norm_mod_phase(xin, p->in[4] + l * DM, ml + 0, ml + 1024, (bf16_t*)(ws + WS_H), wv);
#ifdef REP_NORM
            norm_mod_phase(xin, p->in[4] + l * DM, ml + 0, ml + 1024, (bf16_t*)(ws + WS_H), wv);
#endif
        } else if (step == 1 || step == 4) {
            if (step == 4) rwkv_post_phase(p, l, wv);
#ifdef REP_POST
            if (step == 4) rwkv_post_phase(p, l, wv);
#endif
            E.mode = pg8::EM_INPROJ; E.o0 = (bf16_t*)(ws + WS_Q); E.o1 = (bf16_t*)(ws + WS_K); E.o2 = (bf16_t*)(ws + WS_V); E.o3 = (bf16_t*)(ws + WS_RAW); E.o4 = (bf16_t*)(ws + WS_UV);
            E.ropec = (const float*)(ws + WS_ROPEC); E.ropes = (const float*)(ws + WS_ROPES);
            g.A = H; g.Bt = (const bf16_t*)(ws + WS_WIN); g.lda = 1024; g.K = 1024;
            if (step == 1) S.init(64, 7, G, c, 7, 6, 0); else S.init(64, 10, G, c, 6, 0, 13);
            do_gemm = true;
        } else if (step == 2) { rwkv_derived_phase(p, l, wv); }
        else if (step == 3) { rwkv_scan_phase(p, lds, wv);
#ifdef REP_SCAN
            gbar((unsigned*)(ws + WS_BAR), xst, wv); rwkv_scan_phase(p, lds, wv);
#endif
        }
        else if (step == 5) { attention_phase(p, lds, wv);
#ifdef REP_ATT
            gbar((unsigned*)(ws + WS_BAR), xst, wv); attention_phase(p, lds, wv);
#endif
            gmlp_phase(p, l, lds, wv);
#ifdef REP_GMLP
            gbar((unsigned*)(ws + WS_BAR), xst, wv); gmlp_phase(p, l, lds, wv);
#endif
        }
        else if (step >= 6 && step <= 11) {
            const int br = (step - 6) >> 1;
            if (((step - 6) & 1) == 0) {
                E.mode = pg8::EM_GATE; E.o0 = (bf16_t*)(ws + WS_GATE);
                g.A = H; g.Bt = (const bf16_t*)(ws + WS_WIN) + (size_t)(4352 + 1024 * br) * 1024; g.lda = 1024; g.K = 1024;
            } else {
                E.mode = (br == 0) ? pg8::EM_BR_FIRST : (br == 1 ? pg8::EM_BR_MID : pg8::EM_BR_LAST); E.o0 = (bf16_t*)(ws + WS_GATE); E.o1 = (bf16_t*)(ws + WS_MB); E.f0 = (float*)(ws + WS_M32);
                g.A = (const bf16_t*)(ws + (br == 0 ? WS_YSA : (br == 1 ? WS_YSR : WS_YSG))); g.Bt = (const bf16_t*)(ws + WS_WBR) + (size_t)br * 1024 * 512; g.lda = 512; g.K = 512;
            }
            S.init(64, 4, G, c, 4, 0, 0);
            do_gemm = true; do_sync = (step == 11);
        } else if (step == 12) {
            E.mode = pg8::EM_RESID; E.f0 = p->out; E.f1 = xin; E.f2 = ml + 2048;
            g.A = (const bf16_t*)(ws + WS_MB); g.Bt = (const bf16_t*)(ws + WS_WOUT); g.lda = 1024; g.K = 1024;
            S.init(64, 4, G, c, 4, 0, 0); do_gemm = true;
        } else if (step == 13) { norm_mod_phase(p->out, p->in[23] + l * DM, ml + 3072, ml + 4096, (bf16_t*)(ws + WS_H), wv); }
        else if (step == 14) {
            E.mode = pg8::EM_UP; E.o0 = (bf16_t*)(ws + WS_UP);
            g.A = H; g.Bt = (const bf16_t*)(ws + WS_WUP); g.lda = 1024; g.K = 1024;
            S.init(64, 22, G, c, 22, 0, 0); do_gemm = true;
        } else if (step == 15) { ffn_conv_phase(p, l, wv); }
        else {
            E.mode = pg8::EM_RESID; E.f0 = p->out; E.f1 = p->out; E.f2 = ml + 5120;
            g.A = (const bf16_t*)(ws + WS_UP) + DFF; g.Bt = (const bf16_t*)(ws + WS_WDN); g.lda = UPC; g.K = DFF;
            S.init(64, 4, G, c, 4, 0, 0); do_gemm = true;
        }
        if (do_gemm) pg8::gemm_phase(lds, g, S, E, wv);
#ifdef REP_UP
        if (step == 14) pg8::gemm_phase(lds, g, S, E, wv);
#endif
#ifdef REP_BAR
        if (step == 14) { for (int q = 0; q < 10; ++q) gbar((unsigned*)(ws + WS_BAR), xst, wv); }
#endif
        if (do_sync) gbar((unsigned*)(ws + WS_BAR), xst, wv);
#ifdef DBG_ST
        if (st == DBG_ST) {
            gbar((unsigned*)(ws + WS_BAR), xst, wv);
#if DBG_KIND == 1
            { const bf16_t* sb = (const bf16_t*)(ws + DBG_BUF); for (size_t i = (size_t)blockIdx.x * 512 + otid(wv); i < (size_t)MTOK * DM; i += (size_t)gridDim.x * 512) p->out[i] = __uint_as_float(((unsigned)sb[i]) << 16); }
#elif DBG_KIND == 3
            { const bf16_t* sb = (const bf16_t*)(ws + DBG_BUF); for (size_t i = (size_t)blockIdx.x * 512 + otid(wv); i < (size_t)MTOK * DM; i += (size_t)gridDim.x * 512) p->out[i] = __uint_as_float(((unsigned)sb[i % DBG_N]) << 16); }
#elif DBG_KIND == 2
            { const float* sb = (const float*)(ws + DBG_BUF); for (size_t i = (size_t)blockIdx.x * 512 + otid(wv); i < (size_t)MTOK * DM; i += (size_t)gridDim.x * 512) p->out[i] = sb[i % DBG_N]; }
#endif
            return;
        }
#endif
    }
    p = okp();
    final_norm_phase(p->out, p->in[28], wv);
}

extern "C" void kernel_launch(void* const* d_in, const int* in_sizes, int n_in, void* d_out, int out_size, void* d_ws, size_t ws_size, hipStream_t stream) {
    static int grid_blocks = 0;
    if (grid_blocks == 0) {
        int dev = 0, cus = 0, per_cu = 0;
        hipGetDevice(&dev);
        hipDeviceGetAttribute(&cus, hipDeviceAttributeMultiprocessorCount, dev);
        if (hipFuncSetAttribute((const void*)fwd_megakernel, hipFuncAttributeMaxDynamicSharedMemorySize, LDS_BYTES) != hipSuccess) { fprintf(stderr, "hipFuncSetAttribute failed\n"); }
        hipOccupancyMaxActiveBlocksPerMultiprocessor(&per_cu, (const void*)fwd_megakernel, 512, LDS_BYTES);
        if (per_cu < 1) { fprintf(stderr, "occupancy query returned %d\n", per_cu); per_cu = 1; }
        if (per_cu > 1) per_cu = 1;
        grid_blocks = cus * per_cu;
        (void)hipGetLastError();
    }
    if (n_in != 29 || ws_size < 256 * MiB) { fprintf(stderr, "unexpected inputs/workspace\n"); return; }
    (void)hipMemsetAsync((unsigned char*)d_ws + WS_BAR, 0, XB_WORDS * 4, stream);
    Params p{};
    for (int i = 0; i < 29; ++i) p.in[i] = (const float*)d_in[i];
    p.out = (float*)d_out; p.ws = (unsigned char*)d_ws;
    void* args[] = {&p};
    hipError_t e = hipLaunchCooperativeKernel((const void*)fwd_megakernel, dim3(grid_blocks), dim3(512), args, LDS_BYTES, stream);
    if (e != hipSuccess) fprintf(stderr, "cooperative launch failed: %s (grid %d)\n", hipGetErrorString(e), grid_blocks);
}
```

```cpp
#include <hip/hip_runtime.h>
#include <hip/hip_cooperative_groups.h>
#include <cstdio>
#include <cstdint>
namespace cg = cooperative_groups;

#define LAS __attribute__((address_space(3)))
#define DI __device__ __forceinline__
typedef unsigned short bf16_t;
typedef short bf16x8 __attribute__((ext_vector_type(8)));
typedef float f32x4 __attribute__((ext_vector_type(4)));
typedef float f32x16 __attribute__((ext_vector_type(16)));
typedef unsigned u32x4 __attribute__((ext_vector_type(4)));
typedef unsigned u32x2 __attribute__((ext_vector_type(2)));

constexpr int DM = 1024, SEQ = 4096, MTOK = 16384, INC = 7424, DFF = 2816, UPC = 5632, RAWC = 1792;
constexpr int LDS_BYTES = 147456;
constexpr size_t MiB = 1048576;
constexpr size_t WS_WIN = 0, WS_WBR = WS_WIN + (size_t)INC * 1024 * 2, WS_WOUT = WS_WBR + 3u * 1024 * 512 * 2, WS_WUP = WS_WOUT + 1024u * 1024 * 2,
                 WS_WDN = WS_WUP + (size_t)UPC * 1024 * 2, WS_LWU = WS_WDN + (size_t)DFF * 1024 * 2, WS_LAU = WS_LWU + 65536, WS_LGU = WS_LAU + 65536;
constexpr size_t WS_H = 37 * MiB;
constexpr size_t WS_SMALL = 69 * MiB, WS_MOD = WS_SMALL, WS_ROPEC = WS_MOD + 262144, WS_ROPES = WS_ROPEC + 524288, WS_BONUS = WS_ROPES + 524288, WS_LSE = WS_BONUS + 524288;
constexpr size_t WS_BAR = WS_LSE + 524288;
constexpr size_t DB = 72 * MiB;
constexpr size_t WS_RAW = DB, WS_RZ = DB + 56 * MiB, WS_KP = DB + 72 * MiB, WS_KKN = DB + 88 * MiB, WS_B = DB + 104 * MiB, WS_W = DB + 120 * MiB, WS_VZ = DB + 152 * MiB, WS_G = DB + 168 * MiB;
constexpr size_t WS_YRAW = DB, WS_YSR = DB + 32 * MiB;
constexpr size_t WS_Q = DB + 56 * MiB, WS_K = DB + 72 * MiB, WS_V = DB + 88 * MiB, WS_UV = DB + 104 * MiB;
constexpr size_t WS_YSA = DB + 152 * MiB, WS_YSG = DB + 168 * MiB;
constexpr size_t WS_GATE = DB, WS_M32 = DB + 48 * MiB, WS_MB = DB + 112 * MiB;
constexpr size_t WS_UP = DB;
constexpr size_t WS_SIDEA = DB + 88 * MiB, WS_SIDEG = DB + 100 * MiB;
static_assert(WS_LGU + 131072 <= WS_H, "weights region overflow");
static_assert(WS_BAR + 64 * 26 * 4 <= DB, "small region overflow");

struct Params {
    const float* in[29];
    float* out;
    unsigned char* ws;
};

typedef const __attribute__((address_space(4))) Params* KP;
DI KP okp() { unsigned long long k = (unsigned long long)__builtin_amdgcn_kernarg_segment_ptr(); asm volatile("" : "+s"(k)); return (KP)k; }
typedef float f32x2_t __attribute__((ext_vector_type(2)));
typedef __bf16 bf16x2_t __attribute__((ext_vector_type(2)));
DI unsigned cvt_pk_bf16(float lo, float hi) { const f32x2_t v = {lo, hi}; const bf16x2_t r = __builtin_convertvector(v, bf16x2_t); return __builtin_bit_cast(unsigned, r); }
DI float bf_lo(unsigned w) { return __uint_as_float(w << 16); }
DI float bf_hi(unsigned w) { return __uint_as_float(w & 0xffff0000u); }
DI int otid(int wv) { int ln; asm volatile("v_mbcnt_lo_u32_b32 %0, -1, 0\n\tv_mbcnt_hi_u32_b32 %0, -1, %0" : "=v"(ln)); return wv * 64 + ln; }
DI unsigned char* ows(unsigned char* w) { asm volatile("" : "+s"(w)); return w; }
DI float row16_sum(float v) {
    v += __builtin_bit_cast(float, __builtin_amdgcn_update_dpp(0, __builtin_bit_cast(int, v), 0xB1, 0xF, 0xF, false));
    v += __builtin_bit_cast(float, __builtin_amdgcn_update_dpp(0, __builtin_bit_cast(int, v), 0x4E, 0xF, 0xF, false));
    v += __builtin_bit_cast(float, __builtin_amdgcn_update_dpp(0, __builtin_bit_cast(int, v), 0x141, 0xF, 0xF, false));
    v += __builtin_bit_cast(float, __builtin_amdgcn_update_dpp(0, __builtin_bit_cast(int, v), 0x140, 0xF, 0xF, false));
    return v;
}
DI float wave_sum(float v) { v = row16_sum(v); v += __shfl_xor(v, 16); v += __shfl_xor(v, 32); return v; }
#define XB_CNT(j)  (64 * (j))
#define XB_SUB(j)  (64 * (8 + (j)))
#define XB_GEN(j)  (64 * (16 + (j)))
#define XB_TOP     (64 * 24)
#define XB_TOPGEN  (64 * 25)
#define XB_WORDS   (64 * 26)
DI unsigned xb_ld(unsigned* p) { return __hip_atomic_load(p, __ATOMIC_RELAXED, __HIP_MEMORY_SCOPE_AGENT); }
DI unsigned xb_add(unsigned* p, unsigned v) { return __hip_atomic_fetch_add(p, v, __ATOMIC_RELAXED, __HIP_MEMORY_SCOPE_AGENT); }
DI unsigned xb_xcc_id() { return (unsigned)__builtin_amdgcn_s_getreg((3 << 11) | 20) & 0x7u; }
DI void gbar(unsigned* bar, volatile LAS unsigned* st, int wv) {
    asm volatile("s_waitcnt vmcnt(0) lgkmcnt(0)" ::: "memory");
    __syncthreads();
    if (otid(wv) == 0) {
        const unsigned nloc = st[0], nx = st[1], x = st[2];
        const unsigned old = xb_add(&bar[XB_SUB(x)], 1u);
        const unsigned gen = old / nloc;
        if (old + 1u == (gen + 1u) * nloc) {
            __builtin_amdgcn_fence(__ATOMIC_RELEASE, "agent");
            asm volatile("s_waitcnt vmcnt(0)" ::: "memory");
            const unsigned og = xb_add(&bar[XB_TOP], 1u);
            const unsigned tg = og / nx;
            if (og + 1u == (tg + 1u) * nx) xb_add(&bar[XB_TOPGEN], 1u);
            else { while (xb_ld(&bar[XB_TOPGEN]) == tg) __builtin_amdgcn_s_sleep(1); }
            __builtin_amdgcn_fence(__ATOMIC_ACQUIRE, "agent");
            xb_add(&bar[XB_GEN(x)], 1u);
            asm volatile("s_waitcnt vmcnt(0)" ::: "memory");
        } else {
            while (xb_ld(&bar[XB_GEN(x)]) == gen) __builtin_amdgcn_s_sleep(1);
            __builtin_amdgcn_fence(__ATOMIC_ACQUIRE, "agent");
            asm volatile("s_waitcnt vmcnt(0)" ::: "memory");
        }
    }
    asm volatile("" ::: "memory");
    __syncthreads();
}
DI float sigmoidf_(float x) { return __builtin_amdgcn_rcpf(1.0f + __expf(-x)); }
DI float gelu_tanh(float x) { const float u = 1.5957691216f * (x + 0.044715f * x * x * x); return x * __builtin_amdgcn_rcpf(1.0f + __expf(-u)); }
#define LDS_WAIT() asm volatile("s_waitcnt lgkmcnt(0)" ::: "memory")
#define MFMA32(a, b, c) __builtin_amdgcn_mfma_f32_32x32x16_bf16((a), (b), (c), 0, 0, 0)
DI int crow(int reg, int h) { return (reg & 3) + 8 * (reg >> 2) + 4 * h; }
DI bf16x8 pack8(float a0, float a1, float a2, float a3, float a4, float a5, float a6, float a7) {
    u32x4 p; p.x = cvt_pk_bf16(a0, a1); p.y = cvt_pk_bf16(a2, a3); p.z = cvt_pk_bf16(a4, a5); p.w = cvt_pk_bf16(a6, a7);
    return __builtin_bit_cast(bf16x8, p);
}

namespace pg8 {
constexpr int BM = 256, BK = 64, HALF = 128, HTB = HALF * BK * 2, STAGE_BYTES = 8 * HTB, NXCD = 8, WGM = 8;
DI int lds_byte(int r, int c) { const int st = (r >> 4) * 2 + (c >> 5), rr = r & 15, cc = c & 31, ob = rr * 64 + cc * 2; return st * 1024 + (ob ^ (((ob >> 9) & 1) << 5)); }
DI void stage_rc(int b, int& R, int& C) { const int st = b / 1024, sb = b % 1024, swz = sb ^ (((sb >> 9) & 1) << 5); R = (st >> 1) * 16 + swz / 64; C = (st & 1) * 32 + (swz % 64) / 2; }
DI int perm32(int rho) { const int n = rho >> 4, i = rho & 15; return 8 * (i >> 2) + 4 * n + (i & 3); }
struct Unit { int pm, pn; };
struct Gemm { const bf16_t* A; const bf16_t* Bt; int lda, K; };
struct TileOrder {
    int nM, nN, nwg, G, c, split, off0, off1;
    DI void init(int nM_, int nN_, int G_, int c_, int split_, int off0_, int off1_) { nM = nM_; nN = nN_; nwg = nM * nN; G = G_; c = c_; split = split_; off0 = off0_; off1 = off1_; }
    DI bool next(int i, Unit& u) const {
        const long L = (long)i * G + c; if (L >= nwg) return false;
        int wgid = (int)L; { const int q = nwg / NXCD, r = nwg % NXCD, xcd = wgid % NXCD, off = wgid / NXCD; wgid = (xcd < r ? xcd * (q + 1) : r * (q + 1) + (xcd - r) * q) + off; }
        const int nig = WGM * nN, gid = wgid / nig, fm = gid * WGM, gsz = (nM - fm) < WGM ? (nM - fm) : WGM;
        u.pm = fm + ((wgid % nig) % gsz); const int pnv = (wgid % nig) / gsz; u.pn = pnv < split ? pnv + off0 : pnv - split + off1; return true;
    }
};

enum { EM_INPROJ = 0, EM_GATE = 1, EM_BR_FIRST = 2, EM_BR_MID = 3, EM_BR_LAST = 4, EM_RESID = 5, EM_UP = 6 };
struct Epi {
    int mode;
    bf16_t *o0, *o1, *o2, *o3, *o4;
    float* f3;
    float* f0; const float* f1; const float* f2;
    const float *ropec, *ropes;
    DI void up_conv(const f32x4 (&acc)[2][2][4][2], const Unit& u, int wr, int wc, int fr, int fq) const {
        const int f = u.pn * 128 + wc * 32 + 8 * fq;
        const int src1 = (fq << 4) | ((fr + 15) & 15), src2 = (fq << 4) | ((fr + 14) & 15);
        const f32x4 w0a = *(const f32x4*)(f1 + f), w0b = *(const f32x4*)(f1 + f + 4), w1a = *(const f32x4*)(f1 + DFF + f), w1b = *(const f32x4*)(f1 + DFF + f + 4);
        const f32x4 w2a = *(const f32x4*)(f1 + 2 * DFF + f), w2b = *(const f32x4*)(f1 + 2 * DFF + f + 4), cba = *(const f32x4*)(f2 + f), cbb = *(const f32x4*)(f2 + f + 4);
#pragma unroll
        for (int ai = 0; ai < 2; ++ai) {
            const int q = u.pm * 4 + ai * 2 + wr;
            f32x4 p1a_prev = {0.f, 0.f, 0.f, 0.f}, p1b_prev = p1a_prev, p2a_prev = p1a_prev, p2b_prev = p1a_prev;
#pragma unroll
            for (int m = 0; m < 4; ++m) {
                const f32x4 aa = acc[ai][0][m][0], ab = acc[ai][0][m][1], ga = acc[ai][1][m][0], gb = acc[ai][1][m][1];
                f32x4 p1a, p1b, p2a, p2b;
#pragma unroll
                for (int j = 0; j < 4; ++j) {
                    p1a[j] = __shfl(aa[j], src1); p1b[j] = __shfl(ab[j], src1); p2a[j] = __shfl(aa[j], src2); p2b[j] = __shfl(ab[j], src2);
                }
                const f32x4 t1a = fr >= 1 ? p1a : p1a_prev, t1b = fr >= 1 ? p1b : p1b_prev, t2a = fr >= 2 ? p2a : p2a_prev, t2b = fr >= 2 ? p2b : p2b_prev;
                const f32x4 ca = cba + w0a * t2a + w1a * t1a + w2a * aa, cb_ = cbb + w0b * t2b + w1b * t1b + w2b * ab;
                const int row = u.pm * BM + ai * HALF + wr * 64 + m * 16 + fr;
                u32x4 w;
                w.x = cvt_pk_bf16(gelu_tanh(ca[0]) * ga[0], gelu_tanh(ca[1]) * ga[1]); w.y = cvt_pk_bf16(gelu_tanh(ca[2]) * ga[2], gelu_tanh(ca[3]) * ga[3]);
                w.z = cvt_pk_bf16(gelu_tanh(cb_[0]) * gb[0], gelu_tanh(cb_[1]) * gb[1]); w.w = cvt_pk_bf16(gelu_tanh(cb_[2]) * gb[2], gelu_tanh(cb_[3]) * gb[3]);
                *(u32x4*)(o0 + (size_t)row * DFF + f) = w;
                if (m == 0 && fr < 2) {
                    float* sa = f0 + ((size_t)q * 4 + fr) * DFF + f; *(f32x4*)sa = aa; *(f32x4*)(sa + 4) = ab;
                    float* sg = f3 + ((size_t)q * 2 + fr) * DFF + f; *(f32x4*)sg = ga; *(f32x4*)(sg + 4) = gb;
                }
                if (m == 3 && fr >= 14) { float* sa = f0 + ((size_t)q * 4 + 2 + (fr - 14)) * DFF + f; *(f32x4*)sa = aa; *(f32x4*)(sa + 4) = ab; }
                p1a_prev = p1a; p1b_prev = p1b; p2a_prev = p2a; p2b_prev = p2b;
            }
        }
    }
    DI void operator()(const f32x4 (&acc)[2][2][4][2], const Unit& u, int wr, int wc, int fr, int fq) const {
        if (mode == EM_UP) { up_conv(acc, u, wr, wc, fr, fq); return; }
        const int row0 = u.pm * BM + wr * 64 + fr, colb = u.pn * BM + wc * 32 + 8 * fq;
#pragma unroll
        for (int ai = 0; ai < 2; ++ai)
#pragma unroll
            for (int m = 0; m < 4; ++m) {
                const int row = row0 + ai * HALF + m * 16;
#pragma unroll
                for (int bj = 0; bj < 2; ++bj) {
                    const int col0 = colb + bj * HALF;
                    f32x4 v0 = acc[ai][bj][m][0], v1 = acc[ai][bj][m][1];
                    if (mode == EM_INPROJ) {
                        bf16_t* dst;
                        if (u.pn < 4) {
                            const int pos = row & (SEQ - 1), e0 = (col0 & 63) >> 1;
                            const f32x4 cs = *(const f32x4*)(ropec + pos * 32 + e0), sn = *(const f32x4*)(ropes + pos * 32 + e0);
                            f32x4 a, b;
                            a[0] = v0[0] * cs[0] - v0[1] * sn[0]; a[1] = v0[1] * cs[0] + v0[0] * sn[0];
                            a[2] = v0[2] * cs[1] - v0[3] * sn[1]; a[3] = v0[3] * cs[1] + v0[2] * sn[1];
                            b[0] = v1[0] * cs[2] - v1[1] * sn[2]; b[1] = v1[1] * cs[2] + v1[0] * sn[2];
                            b[2] = v1[2] * cs[3] - v1[3] * sn[3]; b[3] = v1[3] * cs[3] + v1[2] * sn[3];
                            v0 = a; v1 = b;
                            dst = (u.pn < 2) ? o0 + (size_t)row * 512 + col0 : o1 + (size_t)row * 512 + (col0 - 512);
                        } else if (u.pn < 6) { dst = o2 + (size_t)row * 512 + (col0 - 1024); }
                        else if (u.pn < 13) { dst = o3 + (size_t)row * RAWC + (col0 - 1536); }
                        else {
#pragma unroll
                            for (int j = 0; j < 4; ++j) { v0[j] = gelu_tanh(v0[j]); v1[j] = gelu_tanh(v1[j]); }
                            dst = o4 + (size_t)row * 1024 + (col0 - 3328);
                        }
                        u32x4 w; w.x = cvt_pk_bf16(v0[0], v0[1]); w.y = cvt_pk_bf16(v0[2], v0[3]); w.z = cvt_pk_bf16(v1[0], v1[1]); w.w = cvt_pk_bf16(v1[2], v1[3]);
                        *(u32x4*)dst = w;
                    } else if (mode == EM_GATE) {
#pragma unroll
                        for (int j = 0; j < 4; ++j) { v0[j] = sigmoidf_(v0[j]); v1[j] = sigmoidf_(v1[j]); }
                        u32x4 w; w.x = cvt_pk_bf16(v0[0], v0[1]); w.y = cvt_pk_bf16(v0[2], v0[3]); w.z = cvt_pk_bf16(v1[0], v1[1]); w.w = cvt_pk_bf16(v1[2], v1[3]);
                        *(u32x4*)(o0 + (size_t)row * 1024 + col0) = w;
                    } else if (mode == EM_RESID) {
                        const size_t off = (size_t)row * 1024 + col0;
                        const float* gv = f2 + (size_t)(row >> 12) * 6144 + col0;
                        const f32x4 g0 = *(const f32x4*)gv, g1 = *(const f32x4*)(gv + 4);
                        const f32x4 b0 = *(const f32x4*)(f1 + off), b1 = *(const f32x4*)(f1 + off + 4);
                        *(f32x4*)(f0 + off) = b0 + g0 * v0; *(f32x4*)(f0 + off + 4) = b1 + g1 * v1;
                    } else {
                        const size_t off = (size_t)row * 1024 + col0;
                        const u32x4 gw = *(const u32x4*)(o0 + off);
                        f32x4 r0, r1;
                        r0[0] = bf_lo(gw.x) * v0[0]; r0[1] = bf_hi(gw.x) * v0[1]; r0[2] = bf_lo(gw.y) * v0[2]; r0[3] = bf_hi(gw.y) * v0[3];
                        r1[0] = bf_lo(gw.z) * v1[0]; r1[1] = bf_hi(gw.z) * v1[1]; r1[2] = bf_lo(gw.w) * v1[2]; r1[3] = bf_hi(gw.w) * v1[3];
                        if (mode != EM_BR_FIRST) { const u32x4 pm = *(const u32x4*)(o1 + off);
                            r0[0] += bf_lo(pm.x); r0[1] += bf_hi(pm.x); r0[2] += bf_lo(pm.y); r0[3] += bf_hi(pm.y); r1[0] += bf_lo(pm.z); r1[1] += bf_hi(pm.z); r1[2] += bf_lo(pm.w); r1[3] += bf_hi(pm.w); }
                        u32x4 w; w.x = cvt_pk_bf16(r0[0], r0[1]); w.y = cvt_pk_bf16(r0[2], r0[3]); w.z = cvt_pk_bf16(r1[0], r1[1]); w.w = cvt_pk_bf16(r1[2], r1[3]);
                        *(u32x4*)(o1 + off) = w;
                    }
                }
            }
    }
};

DI void gemm_phase(LAS unsigned char* lds, const Gemm g, const TileOrder S, const Epi E, int wv) {
    const int tid = otid(wv), wid = __builtin_amdgcn_readfirstlane(tid >> 6), lane = tid & 63, wr = wid >> 2, wc = wid & 3, fr = lane & 15, fq = lane >> 4;
    const int K = g.K, nt = K / BK, lda = g.lda;
    unsigned voffA[2], voffB[2];
#pragma unroll
    for (int i = 0; i < 2; ++i) { int R, C; stage_rc(tid * 16 + i * 8192, R, C); const int Rb = (R & ~31) + perm32(R & 31);
        voffA[i] = (unsigned)(R * lda + C) * 2u; voffB[i] = (unsigned)(Rb * K + C) * 2u; }
    const size_t kstep = (size_t)(BK * 2);
    const size_t hstepA = (size_t)HALF * lda * 2, hstepB = (size_t)HALF * K * 2;
    const size_t tstepA = 2 * hstepA, tstepB = 2 * hstepB;
    const unsigned ldsw = (unsigned)wid * 1024u;
    const int aoff = lds_byte(wr * 64 + fr, fq * 8), boff = lds_byte(wc * 32 + fr, fq * 8);
#define PG8_SA(b, h) (((b) * 2 + (h)) * HTB)
#define PG8_SB(b, h) ((4 + (b) * 2 + (h)) * HTB)
#define PG8_STAGE(bufoff, gbase, voff) do { _Pragma("unroll") for (int _i = 0; _i < 2; ++_i) \
        __builtin_amdgcn_global_load_lds((const unsigned*)((const char*)(gbase) + (voff)[_i]), (LAS unsigned*)(lds + (bufoff) + ldsw + _i * 8192), 16, 0, 0); } while (0)
#define PG8_LDA(dst, b, h) do { _Pragma("unroll") for (int m = 0; m < 4; ++m) _Pragma("unroll") for (int k = 0; k < 2; ++k) dst[m][k] = *(const LAS bf16x8*)(lds + PG8_SA(b, h) + aoff + m * 2048 + k * 1024); } while (0)
#define PG8_LDB(dst, b, h) do { _Pragma("unroll") for (int n = 0; n < 2; ++n) _Pragma("unroll") for (int k = 0; k < 2; ++k) dst[n][k] = *(const LAS bf16x8*)(lds + PG8_SB(b, h) + boff + n * 2048 + k * 1024); } while (0)
#define PG8_MMA(ai, bj, At, Bt) do { __builtin_amdgcn_s_setprio(1); _Pragma("unroll") for (int m = 0; m < 4; ++m) _Pragma("unroll") for (int n = 0; n < 2; ++n) _Pragma("unroll") for (int k = 0; k < 2; ++k) \
        acc[ai][bj][m][n] = __builtin_amdgcn_mfma_f32_16x16x32_bf16(Bt[n][k], At[m][k], acc[ai][bj][m][n], 0, 0, 0); __builtin_amdgcn_s_setprio(0); } while (0)
#define PG8_WAIT_V(n) asm volatile("s_waitcnt vmcnt(" #n ")" ::: "memory")
#define PG8_WAIT_L(n) asm volatile("s_waitcnt lgkmcnt(" #n ")" ::: "memory")
#define PG8_BAR __builtin_amdgcn_s_barrier()
#define PG8_SCHED __builtin_amdgcn_sched_barrier(0)
    Unit cur, nxt; int ui = 0;
    if (!S.next(0, cur)) return;
    f32x4 acc[2][2][4][2];
#pragma unroll
    for (int a = 0; a < 2; ++a)
#pragma unroll
        for (int b = 0; b < 2; ++b)
#pragma unroll
            for (int m = 0; m < 4; ++m)
#pragma unroll
                for (int n = 0; n < 2; ++n) acc[a][b][m][n] = (f32x4){0.f, 0.f, 0.f, 0.f};
    bf16x8 At[4][2], B0[2][2], B1[2][2];
    const char* cA = (const char*)g.A + (size_t)cur.pm * tstepA; const char* cB = (const char*)g.Bt + (size_t)cur.pn * tstepB;
    PG8_STAGE(PG8_SB(0, 0), cB, voffB); PG8_STAGE(PG8_SA(0, 0), cA, voffA); PG8_STAGE(PG8_SB(0, 1), cB + hstepB, voffB); PG8_STAGE(PG8_SA(0, 1), cA + hstepA, voffA);
    if (wr == 1) PG8_BAR;
    PG8_WAIT_V(4); PG8_BAR;
    PG8_STAGE(PG8_SB(1, 0), cB + kstep, voffB); PG8_STAGE(PG8_SA(1, 0), cA + kstep, voffA); PG8_STAGE(PG8_SB(1, 1), cB + hstepB + kstep, voffB);
    PG8_WAIT_V(6); PG8_BAR;
    for (;;) {
        const bool has_next = S.next(ui + 1, nxt);
        const char* nA = has_next ? (const char*)g.A + (size_t)nxt.pm * tstepA : cA; const char* nB = has_next ? (const char*)g.Bt + (size_t)nxt.pn * tstepB : cB;
        for (int t = 0; t < nt; t += 2) {
            const bool last = (t == nt - 2);
            const char* a1 = cA + (size_t)(t + 1) * kstep;
            const char* a2 = last ? nA : cA + (size_t)(t + 2) * kstep; const char* b2 = last ? nB : cB + (size_t)(t + 2) * kstep;
            const char* a3 = a2 + kstep; const char* b3 = b2 + kstep;
            PG8_LDB(B0, 0, 0); PG8_SCHED; PG8_LDA(At, 0, 0); PG8_STAGE(PG8_SA(1, 1), a1 + hstepA, voffA);
            PG8_WAIT_L(8); PG8_BAR; PG8_WAIT_L(0); PG8_MMA(0, 0, At, B0); PG8_BAR; PG8_SCHED;
            PG8_LDB(B1, 0, 1); PG8_STAGE(PG8_SB(0, 0), b2, voffB);
            PG8_BAR; PG8_WAIT_L(0); PG8_MMA(0, 1, At, B1); PG8_BAR;
            PG8_LDA(At, 0, 1); PG8_STAGE(PG8_SA(0, 0), a2, voffA);
            PG8_BAR; PG8_WAIT_L(0); PG8_MMA(1, 0, At, B0); PG8_BAR; PG8_SCHED;
            PG8_STAGE(PG8_SB(0, 1), b2 + hstepB, voffB);
            PG8_WAIT_V(6); PG8_BAR; PG8_MMA(1, 1, At, B1); PG8_BAR;
            PG8_LDB(B0, 1, 0); PG8_SCHED; PG8_LDA(At, 1, 0); PG8_STAGE(PG8_SA(0, 1), a2 + hstepA, voffA);
            PG8_WAIT_L(8); PG8_BAR; PG8_WAIT_L(0); PG8_MMA(0, 0, At, B0); PG8_BAR; PG8_SCHED;
            PG8_LDB(B1, 1, 1); PG8_STAGE(PG8_SB(1, 0), b3, voffB);
            PG8_BAR; PG8_WAIT_L(0); PG8_MMA(0, 1, At, B1); PG8_BAR;
            PG8_LDA(At, 1, 1); PG8_STAGE(PG8_SA(1, 0), a3, voffA);
            PG8_BAR; PG8_WAIT_L(0); PG8_MMA(1, 0, At, B0); PG8_BAR; PG8_SCHED;
            PG8_STAGE(PG8_SB(1, 1), b3 + hstepB, voffB);
            PG8_WAIT_V(6); PG8_BAR; PG8_MMA(1, 1, At, B1); PG8_BAR;
        }
        E(acc, cur, wr, wc, fr, fq);
        if (!has_next) break;
#pragma unroll
        for (int a = 0; a < 2; ++a)
#pragma unroll
            for (int b = 0; b < 2; ++b)
#pragma unroll
                for (int m = 0; m < 4; ++m)
#pragma unroll
                    for (int n = 0; n < 2; ++n) acc[a][b][m][n] = (f32x4){0.f, 0.f, 0.f, 0.f};
        cur = nxt; cA = nA; cB = nB; ++ui;
    }
    PG8_WAIT_V(0);
    if (wr == 0) PG8_BAR;
    PG8_BAR;
#undef PG8_SA
#undef PG8_SB
#undef PG8_STAGE
#undef PG8_LDA
#undef PG8_LDB
#undef PG8_MMA
#undef PG8_WAIT_V
#undef PG8_WAIT_L
#undef PG8_BAR
#undef PG8_SCHED
}
}

template <int PERMK>
DI void transpose_item(const float* W, int K, int N, bf16_t* WT, LAS float* scr, int item, int lane) {
    const int nblk = N / 32, kb = item / nblk, nb = item % nblk, k0 = 64 * kb, n0 = 32 * nb;
    int sc = n0 + (lane & 31);
    if (PERMK == 1 && sc < 1024) { const int hd = sc >> 6, cp = sc & 63; sc = hd * 64 + 32 * (cp & 1) + (cp >> 1); }
    if (PERMK == 2) { const int tl = sc >> 8, w = sc & 255; sc = (w < 128) ? (128 * tl + w) : (DFF + 128 * tl + (w - 128)); }
#pragma unroll 8
    for (int i = 0; i < 32; ++i) { const int kk = 2 * i + (lane >> 5); scr[kk * 33 + (lane & 31)] = W[(size_t)(k0 + kk) * N + sc]; }
    LDS_WAIT();
    const int c = lane & 7;
#pragma unroll
    for (int j = 0; j < 4; ++j) { const int n = (lane >> 3) + 8 * j; const LAS float* s = scr + (8 * c) * 33 + n;
        u32x4 o; o.x = cvt_pk_bf16(s[0 * 33], s[1 * 33]); o.y = cvt_pk_bf16(s[2 * 33], s[3 * 33]); o.z = cvt_pk_bf16(s[4 * 33], s[5 * 33]); o.w = cvt_pk_bf16(s[6 * 33], s[7 * 33]);
        *(u32x4*)(WT + (size_t)(n0 + n) * K + k0 + 8 * c) = o; }
    LDS_WAIT();
}

DI void convert_weights(KP p, int l, LAS unsigned char* lds, int wv) {
    const int tid_ = otid(wv); const int wave = tid_ >> 6, lane = tid_ & 63;
    LAS float* scr = (LAS float*)(lds + wave * 8448);
    const int gw = blockIdx.x * 8 + wave, NGW = gridDim.x * 8;
    constexpr int I_IN = 16 * (INC / 32), I_BR = 8 * 32, I_OUT = 16 * 32, I_UP = 16 * (UPC / 32), I_DN = (DFF / 64) * 32, I_L64 = 16, I_L128 = 32;
    constexpr int NIT = I_IN + 3 * I_BR + I_OUT + I_UP + I_DN + 2 * I_L64 + I_L128;
    unsigned char* ws = ows(p->ws);
    for (int it = gw; it < NIT; it += NGW) {
        int r = it;
        if (r < I_IN) { transpose_item<1>(p->in[5] + (size_t)l * 1024 * INC, 1024, INC, (bf16_t*)(ws + WS_WIN), scr, r, lane); continue; } r -= I_IN;
        if (r < 3 * I_BR) { const int b = r / I_BR; transpose_item<0>(p->in[21] + ((size_t)l * 3 + b) * 512 * 1024, 512, 1024, (bf16_t*)(ws + WS_WBR) + (size_t)b * 1024 * 512, scr, r % I_BR, lane); continue; } r -= 3 * I_BR;
        if (r < I_OUT) { transpose_item<0>(p->in[22] + (size_t)l * 1024 * 1024, 1024, 1024, (bf16_t*)(ws + WS_WOUT), scr, r, lane); continue; } r -= I_OUT;
        if (r < I_UP) { transpose_item<2>(p->in[24] + (size_t)l * 1024 * UPC, 1024, UPC, (bf16_t*)(ws + WS_WUP), scr, r, lane); continue; } r -= I_UP;
        if (r < I_DN) { transpose_item<0>(p->in[27] + (size_t)l * DFF * 1024, DFF, 1024, (bf16_t*)(ws + WS_WDN), scr, r, lane); continue; } r -= I_DN;
        if (r < I_L64) { transpose_item<0>(p->in[8] + (size_t)l * 64 * 512, 64, 512, (bf16_t*)(ws + WS_LWU), scr, r, lane); continue; } r -= I_L64;
        if (r < I_L64) { transpose_item<0>(p->in[10] + (size_t)l * 64 * 512, 64, 512, (bf16_t*)(ws + WS_LAU), scr, r, lane); continue; } r -= I_L64;
        transpose_item<0>(p->in[11] + (size_t)l * 128 * 512, 128, 512, (bf16_t*)(ws + WS_LGU), scr, r, lane);
    }
}

DI void phase0(KP p, LAS unsigned char* lds, int wv) {
    const int tid = otid(wv);
    float* ropec = (float*)(p->ws + WS_ROPEC); float* ropes = (float*)(p->ws + WS_ROPES);
    for (int idx = blockIdx.x * 512 + tid; idx < SEQ * 32; idx += gridDim.x * 512) {
        const int pos = idx >> 5, e = idx & 31;
        const float inv = 1.0f / exp2f((float)e * (13.287712379549449f / 32.0f));
        const float ang = (float)pos * inv;
        double rev = (double)ang * 0.15915494309189535; rev -= rint(rev);
        const float rv = (float)rev;
        ropec[idx] = __builtin_amdgcn_cosf(rv); ropes[idx] = __builtin_amdgcn_sinf(rv);
    }
    {
        LAS float* ca = (LAS float*)lds;
        LAS float* red = (LAS float*)(lds + 16384);
        float* mod = (float*)(p->ws + WS_MOD);
        bool loaded = false;
        for (int item = blockIdx.x; item < 192; item += gridDim.x) {
            if (!loaded) { for (int i = tid; i < 4096; i += 512) { const float v = p->in[1][i]; ca[i] = v / (1.0f + __expf(-v)); } loaded = true; __syncthreads(); }
            const int l = item / 96, c0 = (item % 96) * 64, cc = tid & 63, kg = tid >> 6;
            const float* w = p->in[2] + (size_t)l * 1024 * 6144 + c0 + cc;
            float a0 = 0.f, a1 = 0.f, a2 = 0.f, a3 = 0.f;
#pragma unroll 8
            for (int k = kg * 128; k < kg * 128 + 128; ++k) { const float wv = w[(size_t)k * 6144]; a0 += ca[k] * wv; a1 += ca[1024 + k] * wv; a2 += ca[2048 + k] * wv; a3 += ca[3072 + k] * wv; }
            red[(kg * 4 + 0) * 64 + cc] = a0; red[(kg * 4 + 1) * 64 + cc] = a1; red[(kg * 4 + 2) * 64 + cc] = a2; red[(kg * 4 + 3) * 64 + cc] = a3;
            __syncthreads();
            if (tid < 256) { const int b = tid >> 6; float s = 0.f;
#pragma unroll
                for (int g = 0; g < 8; ++g) s += red[(g * 4 + b) * 64 + cc];
                mod[((size_t)l * 4 + b) * 6144 + c0 + cc] = s + p->in[3][(size_t)l * 6144 + c0 + cc]; }
            __syncthreads();
        }
        __syncthreads();
    }
    convert_weights(p, 0, lds, wv);
}

DI void norm_mod_phase(const float* x, const float* g, const float* sh, const float* sc, bf16_t* H, int wv) {
    const int tid_ = otid(wv); const int wave = tid_ >> 6, lane = tid_ & 63;
    for (int row0 = (blockIdx.x * 8 + wave) * 2; row0 < MTOK; row0 += gridDim.x * 16) {
        f32x4 v[2][4]; float s[2] = {0.f, 0.f};
#pragma unroll
        for (int q = 0; q < 2; ++q) { const f32x4* xr = (const f32x4*)(x + (size_t)(row0 + q) * DM) + lane;
#pragma unroll
            for (int j = 0; j < 4; ++j) v[q][j] = xr[64 * j]; }
#pragma unroll
        for (int q = 0; q < 2; ++q)
#pragma unroll
            for (int j = 0; j < 4; ++j) s[q] += (v[q][j][0] * v[q][j][0] + v[q][j][1] * v[q][j][1]) + (v[q][j][2] * v[q][j][2] + v[q][j][3] * v[q][j][3]);
        const float rs0 = rsqrtf(wave_sum(s[0]) * (1.0f / DM) + 1e-6f), rs1 = rsqrtf(wave_sum(s[1]) * (1.0f / DM) + 1e-6f);
        const int b = row0 >> 12;
#pragma unroll
        for (int j = 0; j < 4; ++j) {
            const int c = 4 * lane + 256 * j;
            const f32x4 gg = *(const f32x4*)(g + c), s1 = *(const f32x4*)(sc + (size_t)b * 6144 + c), s0 = *(const f32x4*)(sh + (size_t)b * 6144 + c);
#pragma unroll
            for (int q = 0; q < 2; ++q) {
                const f32x4 h = (v[q][j] * (q ? rs1 : rs0) * gg) * (s1 + 1.0f) + s0;
                u32x2 w; w.x = cvt_pk_bf16(h[0], h[1]); w.y = cvt_pk_bf16(h[2], h[3]);
                *((u32x2*)(H + (size_t)(row0 + q) * DM) + lane + 64 * j) = w;
            }
        }
    }
}
DI void final_norm_phase(float* x, const float* g, int wv) {
    const int tid_ = otid(wv); const int wave = tid_ >> 6, lane = tid_ & 63;
    for (int row = blockIdx.x * 8 + wave; row < MTOK; row += gridDim.x * 8) {
        f32x4* xr = (f32x4*)(x + (size_t)row * DM) + lane;
        f32x4 v[4]; float s = 0.f;
#pragma unroll
        for (int j = 0; j < 4; ++j) { v[j] = xr[64 * j]; s += (v[j][0] * v[j][0] + v[j][1] * v[j][1]) + (v[j][2] * v[j][2] + v[j][3] * v[j][3]); }
        const float rs = rsqrtf(wave_sum(s) * (1.0f / DM) + 1e-6f);
#pragma unroll
        for (int j = 0; j < 4; ++j) { const f32x4 gg = *(const f32x4*)(g + 4 * lane + 256 * j); xr[64 * j] = v[j] * rs * gg; }
    }
}

DI bf16x8 lerp_frag(const bf16_t* cur, const bf16_t* prv, bool hasprev, const float* mu, int act) {
    const u32x4 c = *(const u32x4*)cur; u32x4 q = {0u, 0u, 0u, 0u}; if (hasprev) q = *(const u32x4*)prv;
    const f32x4 m0 = *(const f32x4*)mu, m1 = *(const f32x4*)(mu + 4);
    float z[8];
    const unsigned cw[4] = {c.x, c.y, c.z, c.w}, qw[4] = {q.x, q.y, q.z, q.w};
#pragma unroll
    for (int j = 0; j < 4; ++j) {
        const float c0 = bf_lo(cw[j]), c1 = bf_hi(cw[j]), p0 = bf_lo(qw[j]), p1 = bf_hi(qw[j]);
        const float mA = (j < 2) ? m0[2 * j] : m1[2 * j - 4], mB = (j < 2) ? m0[2 * j + 1] : m1[2 * j - 3];
        z[2 * j] = c0 + (p0 - c0) * mA; z[2 * j + 1] = c1 + (p1 - c1) * mB;
    }
#pragma unroll
    for (int j = 0; j < 8; ++j) {
        if (act == 1) { const float e = __expf(2.0f * z[j]); z[j] = 1.0f - 2.0f / (1.0f + e); }
        else if (act == 2) z[j] = sigmoidf_(z[j]);
    }
    return pack8(z[0], z[1], z[2], z[3], z[4], z[5], z[6], z[7]);
}

DI void rwkv_derived_phase(KP p0, int l, int wv) {
    const int tid_ = otid(wv); const int wave = tid_ >> 6, lane = tid_ & 63, r = lane & 31, hh = lane >> 5;
    for (int job = blockIdx.x * 8 + wave; job < 512 * 8; job += gridDim.x * 8) {
        KP p = okp(); unsigned char* ws = ows(p->ws);
        const bf16_t* RAW = (const bf16_t*)(ws + WS_RAW);
        bf16_t *RZ = (bf16_t*)(ws + WS_RZ), *KP = (bf16_t*)(ws + WS_KP), *VZ = (bf16_t*)(ws + WS_VZ), *KKN = (bf16_t*)(ws + WS_KKN), *Bv = (bf16_t*)(ws + WS_B), *G = (bf16_t*)(ws + WS_G);
        float* W = (float*)(ws + WS_W);
        const bf16_t *LWU = (const bf16_t*)(ws + WS_LWU), *LAU = (const bf16_t*)(ws + WS_LAU), *LGU = (const bf16_t*)(ws + WS_LGU);
        const float* mu = p->in[6] + (size_t)l * RAWC; const float* w0 = p->in[7] + l * 512; const float* a0 = p->in[9] + l * 512;
        const float* k_k = p->in[12] + l * 512; const float* k_a = p->in[13] + l * 512; const float* r_k = p->in[14] + l * 512;
        const int hd = job & 7, tg = job >> 3, t = tg * 32 + r;
        const bool hp = (t & (SEQ - 1)) != 0;
        const bf16_t* cur = RAW + (size_t)t * RAWC; const bf16_t* prv = cur - RAWC;
        float ss = 0.f;
#pragma unroll
        for (int q = 0; q < 8; ++q) {
            const int c = hd * 64 + 8 * q + 4 * hh;
            const u32x2 kc = *(const u32x2*)(cur + 512 + c); u32x2 kq = {0u, 0u}; if (hp) kq = *(const u32x2*)(prv + 512 + c);
            const f32x4 mk = *(const f32x4*)(mu + 512 + c), kkw = *(const f32x4*)(k_k + c);
            const float kcur[4] = {bf_lo(kc.x), bf_hi(kc.x), bf_lo(kc.y), bf_hi(kc.y)}, kprv[4] = {bf_lo(kq.x), bf_hi(kq.x), bf_lo(kq.y), bf_hi(kq.y)};
#pragma unroll
            for (int j = 0; j < 4; ++j) { const float kk = (kcur[j] + (kprv[j] - kcur[j]) * mk[j]) * kkw[j]; ss += kk * kk; }
        }
        ss += __shfl_xor(ss, 32);
        const float inv = 1.0f / fmaxf(sqrtf(ss), 1e-12f);
        float bonus = 0.f;
        {
            bf16x8 bw[4], ba[4];
#pragma unroll
            for (int s = 0; s < 4; ++s) { const int o = 16 * s + 8 * hh; bw[s] = lerp_frag(cur + 1536 + o, prv + 1536 + o, hp, mu + 1536 + o, 1); ba[s] = lerp_frag(cur + 1600 + o, prv + 1600 + o, hp, mu + 1600 + o, 0); }
#pragma unroll 1
            for (int mt = 0; mt < 2; ++mt) {
                const int chr = hd * 64 + 32 * mt + r;
                f32x16 aw, aa;
#pragma unroll
                for (int i = 0; i < 16; ++i) { aw[i] = 0.f; aa[i] = 0.f; }
                {
                    typedef const __attribute__((address_space(1))) bf16x8* GP8;
                    const GP8 pw = (GP8)(LWU + (size_t)chr * 64 + 8 * hh), pa = (GP8)(LAU + (size_t)chr * 64 + 8 * hh);
                    bf16x8 fw[4], fa[4];
#pragma unroll
                    for (int s = 0; s < 4; ++s) { fw[s] = pw[2 * s]; fa[s] = pa[2 * s]; }
                    asm volatile("" ::: "memory");
#pragma unroll
                    for (int s = 0; s < 4; ++s) { aw = MFMA32(fw[s], bw[s], aw); aa = MFMA32(fa[s], ba[s], aa); }
                }
#pragma unroll
                for (int i4 = 0; i4 < 4; ++i4) {
                    const int c = hd * 64 + 32 * mt + 8 * i4 + 4 * hh;
                    const u32x2 rc = *(const u32x2*)(cur + c), kc = *(const u32x2*)(cur + 512 + c), vc = *(const u32x2*)(cur + 1024 + c);
                    u32x2 rp = {0u, 0u}, kq = {0u, 0u}, vp = {0u, 0u};
                    if (hp) { rp = *(const u32x2*)(prv + c); kq = *(const u32x2*)(prv + 512 + c); vp = *(const u32x2*)(prv + 1024 + c); }
                    const f32x4 mr = *(const f32x4*)(mu + c), mk = *(const f32x4*)(mu + 512 + c), mv = *(const f32x4*)(mu + 1024 + c);
                    const f32x4 w0v = *(const f32x4*)(w0 + c), a0v = *(const f32x4*)(a0 + c), kkw = *(const f32x4*)(k_k + c), kaw = *(const f32x4*)(k_a + c), rkw = *(const f32x4*)(r_k + c);
                    const float rcur[4] = {bf_lo(rc.x), bf_hi(rc.x), bf_lo(rc.y), bf_hi(rc.y)}, rprv[4] = {bf_lo(rp.x), bf_hi(rp.x), bf_lo(rp.y), bf_hi(rp.y)};
                    const float kcur[4] = {bf_lo(kc.x), bf_hi(kc.x), bf_lo(kc.y), bf_hi(kc.y)}, kprv[4] = {bf_lo(kq.x), bf_hi(kq.x), bf_lo(kq.y), bf_hi(kq.y)};
                    const float vcur[4] = {bf_lo(vc.x), bf_hi(vc.x), bf_lo(vc.y), bf_hi(vc.y)}, vprv[4] = {bf_lo(vp.x), bf_hi(vp.x), bf_lo(vp.y), bf_hi(vp.y)};
                    f32x4 dec; float rz[4], kp[4], vz[4], kn[4], bb[4];
#pragma unroll
                    for (int j = 0; j < 4; ++j) {
                        const int i = 4 * i4 + j;
                        const float zz = -(w0v[j] + aw[i]);
                        const float sp = (zz > 20.f) ? zz : __logf(1.0f + __expf(zz));
                        const float wv = -sp - 0.5f;
                        dec[j] = __expf(-__expf(wv));
                        const float av = sigmoidf_(a0v[j] + aa[i]);
                        rz[j] = rcur[j] + (rprv[j] - rcur[j]) * mr[j];
                        const float kz = kcur[j] + (kprv[j] - kcur[j]) * mk[j];
                        vz[j] = vcur[j] + (vprv[j] - vcur[j]) * mv[j];
                        kn[j] = kz * kkw[j] * inv; bb[j] = kn[j] * av;
                        kp[j] = kz * (1.0f + (av - 1.0f) * kaw[j]);
                        bonus += rz[j] * kp[j] * rkw[j];
                    }
                    const size_t o = (size_t)t * 512 + c;
                    *(f32x4*)(W + o) = dec;
                    u32x2 w2; w2.x = cvt_pk_bf16(rz[0], rz[1]); w2.y = cvt_pk_bf16(rz[2], rz[3]); *(u32x2*)(RZ + o) = w2;
                    w2.x = cvt_pk_bf16(kp[0], kp[1]); w2.y = cvt_pk_bf16(kp[2], kp[3]); *(u32x2*)(KP + o) = w2;
                    w2.x = cvt_pk_bf16(vz[0], vz[1]); w2.y = cvt_pk_bf16(vz[2], vz[3]); *(u32x2*)(VZ + o) = w2;
                    w2.x = cvt_pk_bf16(kn[0], kn[1]); w2.y = cvt_pk_bf16(kn[2], kn[3]); *(u32x2*)(KKN + o) = w2;
                    w2.x = cvt_pk_bf16(bb[0], bb[1]); w2.y = cvt_pk_bf16(bb[2], bb[3]); *(u32x2*)(Bv + o) = w2;
                }
            }
        }
        bonus += __shfl_xor(bonus, 32);
        int t2 = t; asm volatile("" : "+v"(t2));
        if (hh == 0) ((float*)(ows(ws) + WS_BONUS))[(size_t)t2 * 8 + hd] = bonus;
        {
            bf16x8 bg[8];
#pragma unroll
            for (int s = 0; s < 8; ++s) { const int o = 16 * s + 8 * hh; bg[s] = lerp_frag(cur + 1664 + o, prv + 1664 + o, hp, mu + 1664 + o, 2); }
#pragma unroll 1
            for (int mt = 0; mt < 2; ++mt) {
                const int chr = hd * 64 + 32 * mt + r;
                f32x16 ag;
#pragma unroll
                for (int i = 0; i < 16; ++i) ag[i] = 0.f;
                {
                    typedef const __attribute__((address_space(1))) bf16x8* GP8;
                    const GP8 pg = (GP8)(LGU + (size_t)chr * 128 + 8 * hh);
                    bf16x8 fg[8];
#pragma unroll
                    for (int s = 0; s < 8; ++s) fg[s] = pg[2 * s];
                    asm volatile("" ::: "memory");
#pragma unroll
                    for (int s = 0; s < 8; ++s) ag = MFMA32(fg[s], bg[s], ag);
                }
#pragma unroll
                for (int i4 = 0; i4 < 4; ++i4) {
                    const size_t o = (size_t)t2 * 512 + hd * 64 + 32 * mt + 8 * i4 + 4 * hh;
                    u32x2 w2; w2.x = cvt_pk_bf16(ag[4 * i4], ag[4 * i4 + 1]); w2.y = cvt_pk_bf16(ag[4 * i4 + 2], ag[4 * i4 + 3]); *(u32x2*)(G + o) = w2;
                }
            }
        }
    }
}

constexpr int SC_T = 32, SC_STEP = 1344, SC_BUF = SC_T * SC_STEP;
struct ScanRegs { f32x4 w0, w1; u32x4 kn, bb, kp, rz, vv; };
DI void scan_gload(KP p, ScanRegs& R, int b, int h, int rg, int ck, int pt) {
    const unsigned char* ws = ows(p->ws);
    const size_t tok0 = (size_t)b * SEQ + (size_t)ck * SC_T;
    { const int st = pt >> 4, sub = pt & 15; R.w0 = *(const f32x4*)((const float*)(ws + WS_W) + (tok0 + st) * 512 + h * 64 + 4 * sub); }
    { const int pp = pt + 256, st = pp >> 4, sub = pp & 15; R.w1 = *(const f32x4*)((const float*)(ws + WS_W) + (tok0 + st) * 512 + h * 64 + 4 * sub); }
    const int st = pt >> 3, sub = pt & 7; const size_t go = (tok0 + st) * 512 + h * 64 + 8 * sub;
    R.kn = *(const u32x4*)((const bf16_t*)(ws + WS_KKN) + go); R.bb = *(const u32x4*)((const bf16_t*)(ws + WS_B) + go);
    R.kp = *(const u32x4*)((const bf16_t*)(ws + WS_KP) + go); R.rz = *(const u32x4*)((const bf16_t*)(ws + WS_RZ) + go);
    R.vv = (u32x4){0u, 0u, 0u, 0u};
    if (pt < 64) { const int s2 = pt >> 1, hf = pt & 1; R.vv = *(const u32x4*)((const bf16_t*)(ws + WS_VZ) + (tok0 + s2) * 512 + h * 64 + rg * 16 + 8 * hf); }
}
DI void scan_write(const ScanRegs& R, LAS unsigned char* buf, int pt) {
    { const int st = pt >> 4, sub = pt & 15; *(LAS f32x4*)(buf + st * SC_STEP + sub * 16) = R.w0; }
    { const int pp = pt + 256, st = pp >> 4, sub = pp & 15; *(LAS f32x4*)(buf + st * SC_STEP + sub * 16) = R.w1; }
    const int st = pt >> 3, sub = pt & 7;
    const u32x4 kn = R.kn, bb = R.bb, kp = R.kp, rz = R.rz;
    LAS unsigned char* d = buf + st * SC_STEP + sub * 32;
    *(LAS f32x4*)(d + 256) = (f32x4){-bf_lo(kn.x), -bf_hi(kn.x), -bf_lo(kn.y), -bf_hi(kn.y)}; *(LAS f32x4*)(d + 256 + 16) = (f32x4){-bf_lo(kn.z), -bf_hi(kn.z), -bf_lo(kn.w), -bf_hi(kn.w)};
    *(LAS f32x4*)(d + 512) = (f32x4){bf_lo(bb.x), bf_hi(bb.x), bf_lo(bb.y), bf_hi(bb.y)}; *(LAS f32x4*)(d + 512 + 16) = (f32x4){bf_lo(bb.z), bf_hi(bb.z), bf_lo(bb.w), bf_hi(bb.w)};
    *(LAS f32x4*)(d + 768) = (f32x4){bf_lo(kp.x), bf_hi(kp.x), bf_lo(kp.y), bf_hi(kp.y)}; *(LAS f32x4*)(d + 768 + 16) = (f32x4){bf_lo(kp.z), bf_hi(kp.z), bf_lo(kp.w), bf_hi(kp.w)};
    *(LAS f32x4*)(d + 1024) = (f32x4){bf_lo(rz.x), bf_hi(rz.x), bf_lo(rz.y), bf_hi(rz.y)}; *(LAS f32x4*)(d + 1024 + 16) = (f32x4){bf_lo(rz.z), bf_hi(rz.z), bf_lo(rz.w), bf_hi(rz.w)};
    if (pt < 64) { const int s2 = pt >> 1, hf = pt & 1; const u32x4 vv = R.vv;
        LAS unsigned char* dv = buf + s2 * SC_STEP + 1280 + hf * 32;
        *(LAS f32x4*)dv = (f32x4){bf_lo(vv.x), bf_hi(vv.x), bf_lo(vv.y), bf_hi(vv.y)}; *(LAS f32x4*)(dv + 16) = (f32x4){bf_lo(vv.z), bf_hi(vv.z), bf_lo(vv.w), bf_hi(vv.w)}; }
}
DI void rwkv_scan_phase(KP p, LAS unsigned char* lds, int wv) {
    const int tid = otid(wv), wave = tid >> 6, lane = tid & 63;
    float* YRAW = (float*)(p->ws + WS_YRAW);
    for (int job = blockIdx.x; job < 128; job += gridDim.x) {
        const int chain = job >> 2, rg = job & 3, b = chain >> 3, h = chain & 7;
        __syncthreads();
        ScanRegs R0, R1;
        if (wave >= 4) { scan_gload(p, R0, b, h, rg, 0, tid - 256); scan_write(R0, lds, tid - 256); scan_gload(p, R0, b, h, rg, 1, tid - 256); scan_gload(p, R1, b, h, rg, 2, tid - 256); }
        __syncthreads();
        f32x4 S = {0.f, 0.f, 0.f, 0.f};
        const int jl = lane & 15, rl = 4 * (wave & 3) + (lane >> 4);
        for (int ck2 = 0; ck2 < SEQ / SC_T; ck2 += 2) {
#pragma unroll
            for (int half = 0; half < 2; ++half) {
                const int ck = ck2 + half;
                LAS unsigned char* cb = lds + (ck & 1) * SC_BUF;
                if (wave >= 4) {
                    if (ck + 1 < SEQ / SC_T) {
                        if (half == 0) { scan_write(R0, lds + ((ck + 1) & 1) * SC_BUF, tid - 256); if (ck + 3 < SEQ / SC_T) scan_gload(p, R0, b, h, rg, ck + 3, tid - 256); }
                        else           { scan_write(R1, lds + ((ck + 1) & 1) * SC_BUF, tid - 256); if (ck + 3 < SEQ / SC_T) scan_gload(p, R1, b, h, rg, ck + 3, tid - 256); }
                    }
                } else {
                    float* yo = YRAW + ((size_t)b * SEQ + (size_t)ck * SC_T + jl) * 512 + h * 64 + rg * 16 + rl;
                    const LAS unsigned char* sb = cb + jl * 16; const LAS unsigned char* vb = cb + 1280 + rl * 4;
                    f32x4 w4 = *(const LAS f32x4*)sb, an = *(const LAS f32x4*)(sb + 256), b4 = *(const LAS f32x4*)(sb + 512), k4 = *(const LAS f32x4*)(sb + 768), r4 = *(const LAS f32x4*)(sb + 1024);
                    float vi = *(const LAS float*)vb;
                    float ysel = 0.f;
#pragma unroll
                    for (int s = 0; s < SC_T; ++s) {
                        f32x4 w4n = w4, ann = an, b4n = b4, k4n = k4, r4n = r4; float vin = vi;
                        if (s + 1 < SC_T) {
                            const LAS unsigned char* sn = sb + (s + 1) * SC_STEP;
                            w4n = *(const LAS f32x4*)sn; ann = *(const LAS f32x4*)(sn + 256); b4n = *(const LAS f32x4*)(sn + 512); k4n = *(const LAS f32x4*)(sn + 768); r4n = *(const LAS f32x4*)(sn + 1024);
                            vin = *(const LAS float*)(vb + (s + 1) * SC_STEP);
                        }
                        float sa = (S[0] * an[0] + S[1] * an[1]) + (S[2] * an[2] + S[3] * an[3]);
                        sa = row16_sum(sa);
                        S = S * w4 + (b4 * sa + k4 * vi);
                        float y = (S[0] * r4[0] + S[1] * r4[1]) + (S[2] * r4[2] + S[3] * r4[3]);
                        y = row16_sum(y);
                        ysel = (jl == (s & 15)) ? y : ysel;
                        if ((s & 15) == 15) yo[(size_t)(s - 15) * 512] = ysel;
                        w4 = w4n; an = ann; b4 = b4n; k4 = k4n; r4 = r4n; vi = vin;
                    }
                }
                __syncthreads();
            }
        }
    }
}

DI void rwkv_post_phase(KP p, int l, int wv) {
    const unsigned char* ws = ows(p->ws);
    const float* YRAW = (const float*)(ws + WS_YRAW); const bf16_t* VZ = (const bf16_t*)(ws + WS_VZ); const bf16_t* G = (const bf16_t*)(ws + WS_G);
    const float* BONUS = (const float*)(ws + WS_BONUS); bf16_t* YS = (bf16_t*)(p->ws + WS_YSR);
    const float* gnw = p->in[15] + l * 512; const float* gnb = p->in[16] + l * 512;
    const int tid_ = otid(wv); const int wave = tid_ >> 6, lane = tid_ & 63, c = 8 * lane;
    const f32x4 gw0 = *(const f32x4*)(gnw + c), gw1 = *(const f32x4*)(gnw + c + 4), gb0 = *(const f32x4*)(gnb + c), gb1 = *(const f32x4*)(gnb + c + 4);
    for (int t = blockIdx.x * 8 + wave; t < MTOK; t += gridDim.x * 8) {
        const size_t o = (size_t)t * 512 + c;
        const f32x4 y0 = *(const f32x4*)(YRAW + o), y1 = *(const f32x4*)(YRAW + o + 4);
        float s = (y0[0] + y0[1]) + (y0[2] + y0[3]) + (y1[0] + y1[1]) + (y1[2] + y1[3]);
        s += __shfl_xor(s, 1); s += __shfl_xor(s, 2); s += __shfl_xor(s, 4);
        const float mean = s * (1.0f / 64.0f);
        const f32x4 d0 = y0 - mean, d1 = y1 - mean;
        float q = (d0[0] * d0[0] + d0[1] * d0[1]) + (d0[2] * d0[2] + d0[3] * d0[3]) + (d1[0] * d1[0] + d1[1] * d1[1]) + (d1[2] * d1[2] + d1[3] * d1[3]);
        q += __shfl_xor(q, 1); q += __shfl_xor(q, 2); q += __shfl_xor(q, 4);
        const float rstd = rsqrtf(q * (1.0f / 64.0f) + 64e-5f);
        const float bon = BONUS[(size_t)t * 8 + (lane >> 3)];
        const u32x4 vv = *(const u32x4*)(VZ + o), gg = *(const u32x4*)(G + o);
        const f32x4 v0 = {bf_lo(vv.x), bf_hi(vv.x), bf_lo(vv.y), bf_hi(vv.y)}, v1 = {bf_lo(vv.z), bf_hi(vv.z), bf_lo(vv.w), bf_hi(vv.w)};
        const f32x4 g0 = {bf_lo(gg.x), bf_hi(gg.x), bf_lo(gg.y), bf_hi(gg.y)}, g1 = {bf_lo(gg.z), bf_hi(gg.z), bf_lo(gg.w), bf_hi(gg.w)};
        const f32x4 r0 = (d0 * rstd * gw0 + gb0 + v0 * bon) * g0, r1 = (d1 * rstd * gw1 + gb1 + v1 * bon) * g1;
        u32x4 w; w.x = cvt_pk_bf16(r0[0], r0[1]); w.y = cvt_pk_bf16(r0[2], r0[3]); w.z = cvt_pk_bf16(r1[0], r1[1]); w.w = cvt_pk_bf16(r1[2], r1[3]);
        *(u32x4*)(YS + o) = w;
    }
}

DI void attn_job(const bf16_t* Q, const bf16_t* K, const bf16_t* V, bf16_t* YS, float* LSE, LAS unsigned char* vl, int b, int h, int d, int rho, int J0, bool first, int lane) {
    asm volatile("" : "+v"(lane));
    const int r = lane & 31, hh = lane >> 5;
    const size_t tokq = (size_t)b * SEQ + (size_t)(J0 + r) * d + rho;
    typedef const __attribute__((address_space(1))) bf16x8* GP8;
    typedef const __attribute__((address_space(1))) u32x4* GP4;
    bf16x8 bq[4];
    { const GP8 qp = (GP8)(Q + tokq * 512 + h * 64 + 8 * hh);
#pragma unroll
      for (int s = 0; s < 4; ++s) bq[s] = qp[2 * s]; }
    bf16x8 ak[5][4];
#pragma unroll
    for (int kt = 0; kt < 5; ++kt) {
        const int Jk = J0 - 128 + 32 * kt + r;
        const size_t tokk = (size_t)b * SEQ + (size_t)(Jk >= 0 ? Jk : 0) * d + rho;
        const GP8 kp = (GP8)(K + tokk * 512 + h * 64 + 8 * hh);
#pragma unroll
        for (int s = 0; s < 4; ++s) ak[kt][s] = kp[2 * s];
    }
    asm volatile("" ::: "memory");
    f32x16 sc[5];
#pragma unroll
    for (int kt = 0; kt < 5; ++kt) {
        const bool valid = (J0 - 128 + 32 * kt + r) >= 0;
        f32x16 a;
#pragma unroll
        for (int i = 0; i < 16; ++i) a[i] = 0.f;
#pragma unroll
        for (int s = 0; s < 4; ++s) {
            bf16x8 kf = ak[kt][s];
            if (!valid) kf = (bf16x8){0, 0, 0, 0, 0, 0, 0, 0};
            a = MFMA32(kf, bq[s], a);
        }
        sc[kt] = a;
    }
    float m = -1e30f;
#pragma unroll
    for (int kt = 0; kt < 5; ++kt)
#pragma unroll
        for (int i = 0; i < 16; ++i) {
            const int kidx = 32 * kt + crow(i, hh); const int dist = 128 + r - kidx;
            const bool ok = (dist >= 0) && (dist <= 128) && (J0 - 128 + kidx >= 0);
            const float v = ok ? sc[kt][i] * 0.125f : -1e30f;
            sc[kt][i] = v; m = fmaxf(m, v);
        }
    m = fmaxf(m, __shfl_xor(m, 32));
    float lsum = 0.f;
#pragma unroll
    for (int kt = 0; kt < 5; ++kt)
#pragma unroll
        for (int i = 0; i < 16; ++i) { const float pv = __expf(sc[kt][i] - m); sc[kt][i] = pv; lsum += pv; }
    lsum += __shfl_xor(lsum, 32);
    const float lse = m + __logf(lsum);
    f32x16 o[2];
#pragma unroll
    for (int i = 0; i < 16; ++i) { o[0][i] = 0.f; o[1][i] = 0.f; }
    u32x4 vr[4];
    {
        const int key = lane >> 1, hf = lane & 1; const int Jk = J0 - 128 + key;
        const size_t tokv = (size_t)b * SEQ + (size_t)(Jk >= 0 ? Jk : 0) * d + rho;
        const GP4 src = (GP4)(V + tokv * 512 + h * 64 + 32 * hf);
        vr[0] = src[0]; vr[1] = src[1]; vr[2] = src[2]; vr[3] = src[3];
    }
#pragma unroll
    for (int kt = 0; kt < 5; ++kt) {
        {
            const int key = lane >> 1, hf = lane & 1;
            LAS u32x4* dst = (LAS u32x4*)(vl + key * 128 + hf * 64);
            dst[0] = vr[0]; dst[1] = vr[1]; dst[2] = vr[2]; dst[3] = vr[3];
            if (kt + 1 < 5) {
                const int Jk = J0 - 128 + 32 * (kt + 1) + key;
                const size_t tokv = (size_t)b * SEQ + (size_t)(Jk >= 0 ? Jk : 0) * d + rho;
                const GP4 src = (GP4)(V + tokv * 512 + h * 64 + 32 * hf);
                vr[0] = src[0]; vr[1] = src[1]; vr[2] = src[2]; vr[3] = src[3];
            }
        }
        LDS_WAIT();
#pragma unroll
        for (int s = 0; s < 2; ++s) {
            const bf16x8 xs = pack8(sc[kt][8 * s], sc[kt][8 * s + 1], sc[kt][8 * s + 2], sc[kt][8 * s + 3], sc[kt][8 * s + 4], sc[kt][8 * s + 5], sc[kt][8 * s + 6], sc[kt][8 * s + 7]);
#pragma unroll
            for (int mt = 0; mt < 2; ++mt) {
                bf16x8 pa;
#pragma unroll
                for (int j = 0; j < 8; ++j) { const int key = 16 * s + 8 * (j >> 2) + 4 * hh + (j & 3); pa[j] = (short)*(const LAS bf16_t*)(vl + key * 128 + (r + 32 * mt) * 2); }
                o[mt] = MFMA32(pa, xs, o[mt]);
            }
        }
        LDS_WAIT();
    }
    const float il = 1.0f / lsum;
    float wp = 0.f, wc = 1.0f, nl = lse;
    if (!first) { const float lp = LSE[tokq * 8 + h]; const float mx = fmaxf(lp, lse); const float ep = __expf(lp - mx), ec = __expf(lse - mx); nl = mx + __logf(ep + ec); wp = ep / (ep + ec); wc = ec / (ep + ec); }
#pragma unroll
    for (int mt = 0; mt < 2; ++mt)
#pragma unroll
        for (int g4 = 0; g4 < 4; ++g4) {
            bf16_t* dst = YS + tokq * 512 + h * 64 + 32 * mt + 8 * g4 + 4 * hh;
            float v[4];
#pragma unroll
            for (int j = 0; j < 4; ++j) v[j] = o[mt][4 * g4 + j] * il * wc;
            if (!first) { const u32x2 pw = *(const u32x2*)dst; v[0] += bf_lo(pw.x) * wp; v[1] += bf_hi(pw.x) * wp; v[2] += bf_lo(pw.y) * wp; v[3] += bf_hi(pw.y) * wp; }
            u32x2 w2; w2.x = cvt_pk_bf16(v[0], v[1]); w2.y = cvt_pk_bf16(v[2], v[3]); *(u32x2*)dst = w2;
        }
    if (hh == 0) LSE[tokq * 8 + h] = nl;
}

DI void attention_phase(KP p, LAS unsigned char* lds, int wv) {
    unsigned char* ws = ows(p->ws);
    const bf16_t *Q = (const bf16_t*)(ws + WS_Q), *K = (const bf16_t*)(ws + WS_K), *V = (const bf16_t*)(ws + WS_V);
    bf16_t* YS = (bf16_t*)(ws + WS_YSA); float* LSE = (float*)(ws + WS_LSE);
    const int tid_ = otid(wv); const int wave = tid_ >> 6, lane = tid_ & 63;
    LAS unsigned char* vl = lds + wave * 4096;
    for (int item = blockIdx.x; item < 256; item += gridDim.x) {
        const int b = item >> 6, h = (item >> 3) & 7, qb = item & 7, P0 = qb * 512;
#pragma unroll 1
        for (int cfg = 0; cfg < 3; ++cfg) {
#pragma unroll 1
            for (int jj = wave; jj < 16; jj += 8) {
                int d, rho, J0;
                if (cfg == 0) { d = 1; rho = 0; J0 = P0 + 32 * jj; }
                else if (cfg == 1) { d = 4; rho = jj & 3; J0 = (P0 >> 2) + 32 * (jj >> 2); }
                else { d = 16; rho = jj; J0 = P0 >> 4; }
                attn_job(Q, K, V, YS, LSE, vl, b, h, d, rho, J0, cfg == 0, lane);
            }
            asm volatile("s_waitcnt vmcnt(0)" ::: "memory");
            __syncthreads();
        }
    }
}

DI void gmlp_phase(KP p, int l, LAS unsigned char* lds, int wv) {
    unsigned char* ws = ows(p->ws);
    const bf16_t* UV = (const bf16_t*)(ws + WS_UV); bf16_t* YS = (bf16_t*)(ws + WS_YSG);
    const float* lng = p->in[17] + l * 512; const float* lnb = p->in[18] + l * 512;
    const float* wsp = p->in[19] + (size_t)l * 8 * 128 * 128; const float* bsp = p->in[20] + (size_t)l * 8 * 128;
    const int tid_ = otid(wv); const int wave = tid_ >> 6, lane = tid_ & 63, r = lane & 31, hh = lane >> 5;
    LAS float* stats = (LAS float*)(lds + 8 * 17408);
    LAS bf16_t* VT = (LAS bf16_t*)(lds + wave * 17408);
    for (int item = blockIdx.x; item < 256; item += gridDim.x) {
        const size_t tok0 = (size_t)(item >> 1) * 128;
        __syncthreads();
        for (int tt = 0; tt < 16; ++tt) {
            const int tl = wave * 16 + tt;
            const u32x4 x = *(const u32x4*)(UV + (tok0 + tl) * 1024 + 512 + 8 * lane);
            const float f[8] = {bf_lo(x.x), bf_hi(x.x), bf_lo(x.y), bf_hi(x.y), bf_lo(x.z), bf_hi(x.z), bf_lo(x.w), bf_hi(x.w)};
            float s = 0.f;
#pragma unroll
            for (int j = 0; j < 8; ++j) s += f[j];
            const float mean = wave_sum(s) * (1.0f / 512.0f); float q = 0.f;
#pragma unroll
            for (int j = 0; j < 8; ++j) { const float dd = f[j] - mean; q += dd * dd; }
            const float rstd = rsqrtf(wave_sum(q) * (1.0f / 512.0f) + 1e-5f);
            if (lane == 0) { stats[2 * tl] = mean; stats[2 * tl + 1] = rstd; }
        }
        __syncthreads();
        const int g = (item & 1) * 4 + (wave & 3);
        if (wave < 4) {
        {
            const int d0 = 8 * (lane & 7);
            const f32x4 lg0 = *(const f32x4*)(lng + g * 64 + d0), lg1 = *(const f32x4*)(lng + g * 64 + d0 + 4), lb0 = *(const f32x4*)(lnb + g * 64 + d0), lb1 = *(const f32x4*)(lnb + g * 64 + d0 + 4);
            for (int it = 0; it < 16; ++it) {
                const int tl = it * 8 + (lane >> 3);
                const u32x4 x = *(const u32x4*)(UV + (tok0 + tl) * 1024 + 512 + g * 64 + d0);
                const float mean = stats[2 * tl], rstd = stats[2 * tl + 1];
                const float f[8] = {bf_lo(x.x), bf_hi(x.x), bf_lo(x.y), bf_hi(x.y), bf_lo(x.z), bf_hi(x.z), bf_lo(x.w), bf_hi(x.w)};
#pragma unroll
                for (int e = 0; e < 8; ++e) {
                    const float gg = e < 4 ? lg0[e & 3] : lg1[e & 3], bb = e < 4 ? lb0[e & 3] : lb1[e & 3];
                    const float y = (f[e] - mean) * rstd * gg + bb;
                    VT[(d0 + e) * 136 + tl] = (bf16_t)(cvt_pk_bf16(y, 0.f) & 0xffffu);
                }
            }
        }
        LDS_WAIT();
#pragma unroll 1
        for (int nt = 0; nt < 4; ++nt) {
            f32x16 acc[2];
#pragma unroll
            for (int i = 0; i < 16; ++i) { acc[0][i] = 0.f; acc[1][i] = 0.f; }
            const int irow = 32 * nt + r;
            for (int s = 0; s < 2 * (nt + 1); ++s) {
                const int j0 = 16 * s + 8 * hh;
                const float* wr_ = wsp + ((size_t)g * 128 + irow) * 128 + j0;
                const f32x4 wa = *(const f32x4*)wr_, wb = *(const f32x4*)(wr_ + 4);
                float wv[8] = {wa[0], wa[1], wa[2], wa[3], wb[0], wb[1], wb[2], wb[3]};
#pragma unroll
                for (int j = 0; j < 8; ++j) if (j0 + j > irow) wv[j] = 0.f;
                const bf16x8 bfr = pack8(wv[0], wv[1], wv[2], wv[3], wv[4], wv[5], wv[6], wv[7]);
#pragma unroll
                for (int mt = 0; mt < 2; ++mt) {
                    const bf16x8 afr = *(const LAS bf16x8*)(VT + (32 * mt + r) * 136 + j0);
                    acc[mt] = MFMA32(afr, bfr, acc[mt]);
                }
            }
            const size_t tok = tok0 + irow; const float bs = bsp[g * 128 + irow];
#pragma unroll
            for (int mt = 0; mt < 2; ++mt)
#pragma unroll
                for (int g4 = 0; g4 < 4; ++g4) {
                    const int c = g * 64 + 32 * mt + 8 * g4 + 4 * hh;
                    const u32x2 uu = *(const u32x2*)(UV + tok * 1024 + c);
                    const float o0 = bf_lo(uu.x) * (acc[mt][4 * g4] + bs), o1 = bf_hi(uu.x) * (acc[mt][4 * g4 + 1] + bs), o2 = bf_lo(uu.y) * (acc[mt][4 * g4 + 2] + bs), o3 = bf_hi(uu.y) * (acc[mt][4 * g4 + 3] + bs);
                    u32x2 w2; w2.x = cvt_pk_bf16(o0, o1); w2.y = cvt_pk_bf16(o2, o3); *(u32x2*)(YS + tok * 512 + c) = w2;
                }
        }
        }
    }
}

DI void ffn_fix_phase(KP p, int l, int wv) {
    unsigned char* ws = ows(p->ws);
    bf16_t* ACT = (bf16_t*)(ws + WS_UP); const float* SA = (const float*)(ws + WS_SIDEA); const float* SG = (const float*)(ws + WS_SIDEG);
    const float* cw = p->in[25] + (size_t)l * 3 * DFF; const float* cb = p->in[26] + (size_t)l * DFF;
    constexpr int NCG = DFF / 8;
    const int tid_ = otid(wv);
    for (int item = blockIdx.x * 512 + tid_; item < 256 * 2 * NCG; item += gridDim.x * 512) {
        const int cgi = item % NCG, qe = item / NCG, q = qe >> 1, e = qe & 1, f = 8 * cgi;
        const bool first = (q & 63) == 0;
        float o[8];
#pragma unroll
        for (int hf = 0; hf < 2; ++hf) {
            const int ff = f + 4 * hf;
            const f32x4 at = *(const f32x4*)(SA + ((size_t)q * 4 + e) * DFF + ff);
            f32x4 t1 = {0.f, 0.f, 0.f, 0.f}, t2 = {0.f, 0.f, 0.f, 0.f};
            if (e == 1) t1 = *(const f32x4*)(SA + ((size_t)q * 4 + 0) * DFF + ff);
            else if (!first) t1 = *(const f32x4*)(SA + ((size_t)(q - 1) * 4 + 3) * DFF + ff);
            if (!first) t2 = *(const f32x4*)(SA + ((size_t)(q - 1) * 4 + (e == 1 ? 3 : 2)) * DFF + ff);
            const f32x4 g = *(const f32x4*)(SG + ((size_t)q * 2 + e) * DFF + ff);
            const f32x4 w0 = *(const f32x4*)(cw + ff), w1 = *(const f32x4*)(cw + DFF + ff), w2 = *(const f32x4*)(cw + 2 * DFF + ff), bb = *(const f32x4*)(cb + ff);
            const f32x4 c = bb + w0 * t2 + w1 * t1 + w2 * at;
#pragma unroll
            for (int j = 0; j < 4; ++j) o[4 * hf + j] = gelu_tanh(c[j]) * g[j];
        }
        u32x4 w; w.x = cvt_pk_bf16(o[0], o[1]); w.y = cvt_pk_bf16(o[2], o[3]); w.z = cvt_pk_bf16(o[4], o[5]); w.w = cvt_pk_bf16(o[6], o[7]);
        *(u32x4*)(ACT + (size_t)(64 * q + e) * DFF + f) = w;
    }
}

__global__ void __launch_bounds__(512) fwd_megakernel(Params p_unused) {
    extern __shared__ __attribute__((aligned(16))) unsigned char lds_raw[];
    LAS unsigned char* lds = (LAS unsigned char*)lds_raw;
    cg::grid_group grid = cg::this_grid();
    KP p = okp();
    unsigned char* ws = p->ws;
    const int G = gridDim.x, c = blockIdx.x;
    const int wv = __builtin_amdgcn_readfirstlane((int)(threadIdx.x >> 6));
    pg8::Epi E; pg8::TileOrder S; pg8::Gemm g;

    unsigned* bar = (unsigned*)(ws + WS_BAR);
    volatile LAS unsigned* xst = (volatile LAS unsigned*)(lds + LDS_BYTES - 16);
    const unsigned myx = xb_xcc_id();
    if (otid(wv) == 0) { xb_add(&bar[XB_CNT(myx)], 1u); __builtin_amdgcn_fence(__ATOMIC_RELEASE, "agent"); }
    grid.sync();
    if (otid(wv) == 0) {
        unsigned mine = 0u, cnt = 0u;
#pragma unroll
        for (unsigned j = 0; j < 8; ++j) { const unsigned c = xb_ld(&bar[XB_CNT(j)]); cnt += (c > 0u) ? 1u : 0u; mine = (j == myx) ? c : mine; }
        xst[0] = mine > 0u ? mine : 1u; xst[1] = cnt > 0u ? cnt : 1u; xst[2] = myx;
    }
    __syncthreads();
    phase0(p, lds, wv);
    gbar(bar, xst, wv);
#pragma unroll 1
    for (int st = 0; st < 2 * 17; ++st) {
        const int l = st / 17, step = st % 17;
        p = okp(); ws = ows(p->ws);
        const float* mod = (const float*)(ws + WS_MOD); const bf16_t* H = (const bf16_t*)(ws + WS_H);
        const float* ml = mod + (size_t)l * 4 * 6144;
        const float* xin = (l == 0) ? p->in[0] : p->out;
        bool do_gemm = false, do_sync = true;
        E = pg8::Epi{};
        if (step == 0) {
            if (l > 0) convert_weights(p, l, lds, wv);
#ifdef REP_CONVW
            if (l > 0) convert_weights(p, l, lds, wv);
#endif
            norm_mod_phase(xin, p->in[4] + l * DM, ml + 0, ml + 1024, (bf16_t*)(ws + WS_H), wv);
#ifdef REP_NORM
            norm_mod_phase(xin, p->in[4] + l * DM, ml + 0, ml + 1024, (bf16_t*)(ws + WS_H), wv);
#endif
        } else if (step == 1 || step == 4) {
            if (step == 4) rwkv_post_phase(p, l, wv);
#ifdef REP_POST
            if (step == 4) rwkv_post_phase(p, l, wv);
#endif
            E.mode = pg8::EM_INPROJ; E.o0 = (bf16_t*)(ws + WS_Q); E.o1 = (bf16_t*)(ws + WS_K); E.o2 = (bf16_t*)(ws + WS_V); E.o3 = (bf16_t*)(ws + WS_RAW); E.o4 = (bf16_t*)(ws + WS_UV);
            E.ropec = (const float*)(ws + WS_ROPEC); E.ropes = (const float*)(ws + WS_ROPES);
            g.A = H; g.Bt = (const bf16_t*)(ws + WS_WIN); g.lda = 1024; g.K = 1024;
            if (step == 1) S.init(64, 7, G, c, 7, 6, 0); else S.init(64, 10, G, c, 6, 0, 13);
            do_gemm = true;
        } else if (step == 2) { rwkv_derived_phase(p, l, wv); }
        else if (step == 3) { rwkv_scan_phase(p, lds, wv);
#ifdef REP_SCAN
            gbar((unsigned*)(ws + WS_BAR), xst, wv); rwkv_scan_phase(p, lds, wv);
#endif
        }
        else if (step == 5) { attention_phase(p, lds, wv);
#ifdef REP_ATT
            gbar((unsigned*)(ws + WS_BAR), xst, wv); attention_phase(p, lds, wv);
#endif
            gmlp_phase(p, l, lds, wv);
#ifdef REP_GMLP
            gbar((unsigned*)(ws + WS_BAR), xst, wv); gmlp_phase(p, l, lds, wv);
#endif
        }
        else if (step >= 6 && step <= 11) {
            const int br = (step - 6) >> 1;
            if (((step - 6) & 1) == 0) {
                E.mode = pg8::EM_GATE; E.o0 = (bf16_t*)(ws + WS_GATE);
                g.A = H; g.Bt = (const bf16_t*)(ws + WS_WIN) + (size_t)(4352 + 1024 * br) * 1024; g.lda = 1024; g.K = 1024;
            } else {
                E.mode = (br == 0) ? pg8::EM_BR_FIRST : (br == 1 ? pg8::EM_BR_MID : pg8::EM_BR_LAST); E.o0 = (bf16_t*)(ws + WS_GATE); E.o1 = (bf16_t*)(ws + WS_MB); E.f0 = (float*)(ws + WS_M32);
                g.A = (const bf16_t*)(ws + (br == 0 ? WS_YSA : (br == 1 ? WS_YSR : WS_YSG))); g.Bt = (const bf16_t*)(ws + WS_WBR) + (size_t)br * 1024 * 512; g.lda = 512; g.K = 512;
            }
            S.init(64, 4, G, c, 4, 0, 0);
            do_gemm = true; do_sync = (step == 11);
        } else if (step == 12) {
            E.mode = pg8::EM_RESID; E.f0 = p->out; E.f1 = xin; E.f2 = ml + 2048;
            g.A = (const bf16_t*)(ws + WS_MB); g.Bt = (const bf16_t*)(ws + WS_WOUT); g.lda = 1024; g.K = 1024;
            S.init(64, 4, G, c, 4, 0, 0); do_gemm = true;
        } else if (step == 13) { norm_mod_phase(p->out, p->in[23] + l * DM, ml + 3072, ml + 4096, (bf16_t*)(ws + WS_H), wv); }
        else if (step == 14) {
            E.mode = pg8::EM_UP; E.o0 = (bf16_t*)(ws + WS_UP); E.f0 = (float*)(ws + WS_SIDEA); E.f3 = (float*)(ws + WS_SIDEG); E.f1 = p->in[25] + (size_t)l * 3 * DFF; E.f2 = p->in[26] + (size_t)l * DFF;
            g.A = H; g.Bt = (const bf16_t*)(ws + WS_WUP); g.lda = 1024; g.K = 1024;
            S.init(64, 22, G, c, 22, 0, 0); do_gemm = true;
        } else if (step == 15) { ffn_fix_phase(p, l, wv); }
        else {
            E.mode = pg8::EM_RESID; E.f0 = p->out; E.f1 = p->out; E.f2 = ml + 5120;
            g.A = (const bf16_t*)(ws + WS_UP); g.Bt = (const bf16_t*)(ws + WS_WDN); g.lda = DFF; g.K = DFF;
            S.init(64, 4, G, c, 4, 0, 0); do_gemm = true;
        }
        if (do_gemm) pg8::gemm_phase(lds, g, S, E, wv);
#ifdef REP_UP
        if (step == 14) pg8::gemm_phase(lds, g, S, E, wv);
#endif
#ifdef REP_BAR
        if (step == 14) { for (int q = 0; q < 10; ++q) gbar((unsigned*)(ws + WS_BAR), xst, wv); }
#endif
        if (do_sync) gbar((unsigned*)(ws + WS_BAR), xst, wv);
#ifdef DBG_ST
        if (st == DBG_ST) {
            gbar((unsigned*)(ws + WS_BAR), xst, wv);
#if DBG_KIND == 1
            { const bf16_t* sb = (const bf16_t*)(ws + DBG_BUF); for (size_t i = (size_t)blockIdx.x * 512 + otid(wv); i < (size_t)MTOK * DM; i += (size_t)gridDim.x * 512) p->out[i] = __uint_as_float(((unsigned)sb[i]) << 16); }
#elif DBG_KIND == 3
            { const bf16_t* sb = (const bf16_t*)(ws + DBG_BUF); for (size_t i = (size_t)blockIdx.x * 512 + otid(wv); i < (size_t)MTOK * DM; i += (size_t)gridDim.x * 512) p->out[i] = __uint_as_float(((unsigned)sb[i % DBG_N]) << 16); }
#elif DBG_KIND == 2
            { const float* sb = (const float*)(ws + DBG_BUF); for (size_t i = (size_t)blockIdx.x * 512 + otid(wv); i < (size_t)MTOK * DM; i += (size_t)gridDim.x * 512) p->out[i] = sb[i % DBG_N]; }
#endif
            return;
        }
#endif
    }
    p = okp();
    final_norm_phase(p->out, p->in[28], wv);
}

extern "C" void kernel_launch(void* const* d_in, const int* in_sizes, int n_in, void* d_out, int out_size, void* d_ws, size_t ws_size, hipStream_t stream) {
    static int grid_blocks = 0;
    if (grid_blocks == 0) {
        int dev = 0, cus = 0, per_cu = 0;
        hipGetDevice(&dev);
        hipDeviceGetAttribute(&cus, hipDeviceAttributeMultiprocessorCount, dev);
        if (hipFuncSetAttribute((const void*)fwd_megakernel, hipFuncAttributeMaxDynamicSharedMemorySize, LDS_BYTES) != hipSuccess) { fprintf(stderr, "hipFuncSetAttribute failed\n"); }
        hipOccupancyMaxActiveBlocksPerMultiprocessor(&per_cu, (const void*)fwd_megakernel, 512, LDS_BYTES);
        if (per_cu < 1) { fprintf(stderr, "occupancy query returned %d\n", per_cu); per_cu = 1; }
        if (per_cu > 1) per_cu = 1;
        grid_blocks = cus * per_cu;
        (void)hipGetLastError();
    }
    if (n_in != 29 || ws_size < 256 * MiB) { fprintf(stderr, "unexpected inputs/workspace\n"); return; }
    (void)hipMemsetAsync((unsigned char*)d_ws + WS_BAR, 0, XB_WORDS * 4, stream);
    Params p{};
    for (int i = 0; i < 29; ++i) p.in[i] = (const float*)d_in[i];
    p.out = (float*)d_out; p.ws = (unsigned char*)d_ws;
    void* args[] = {&p};
    hipError_t e = hipLaunchCooperativeKernel((const void*)fwd_megakernel, dim3(grid_blocks), dim3(512), args, LDS_BYTES, stream);
    if (e != hipSuccess) fprintf(stderr, "cooperative launch failed: %s (grid %d)\n", hipGetErrorString(e), grid_blocks);
}
```

```cpp
#include <hip/hip_runtime.h>
#include <hip/hip_cooperative_groups.h>
#include <cstdio>
#include <cstdint>
namespace cg = cooperative_groups;

#define LAS __attribute__((address_space(3)))
#define DI __device__ __forceinline__
typedef unsigned short bf16_t;
typedef short bf16x8 __attribute__((ext_vector_type(8)));
typedef float f32x4 __attribute__((ext_vector_type(4)));
typedef float f32x16 __attribute__((ext_vector_type(16)));
typedef unsigned u32x4 __attribute__((ext_vector_type(4)));
typedef unsigned u32x2 __attribute__((ext_vector_type(2)));

constexpr int DM = 1024, SEQ = 4096, MTOK = 16384, INC = 7424, DFF = 2816, UPC = 5632, RAWC = 1792;
constexpr int LDS_BYTES = 147456;
constexpr size_t MiB = 1048576;
constexpr size_t WS_WIN = 0, WS_WBR = WS_WIN + (size_t)INC * 1024 * 2, WS_WOUT = WS_WBR + 3u * 1024 * 512 * 2, WS_WUP = WS_WOUT + 1024u * 1024 * 2,
                 WS_WDN = WS_WUP + (size_t)UPC * 1024 * 2, WS_LWU = WS_WDN + (size_t)DFF * 1024 * 2, WS_LAU = WS_LWU + 65536, WS_LGU = WS_LAU + 65536;
constexpr size_t WS_H = 37 * MiB;
constexpr size_t WS_SMALL = 69 * MiB, WS_MOD = WS_SMALL, WS_ROPEC = WS_MOD + 262144, WS_ROPES = WS_ROPEC + 524288, WS_BONUS = WS_ROPES + 524288, WS_LSE = WS_BONUS + 524288;
constexpr size_t WS_BAR = WS_LSE + 524288;
constexpr size_t DB = 72 * MiB;
constexpr size_t WS_RAW = DB, WS_RZ = DB + 56 * MiB, WS_KP = DB + 72 * MiB, WS_KKN = DB + 88 * MiB, WS_B = DB + 104 * MiB, WS_W = DB + 120 * MiB, WS_VZ = DB + 152 * MiB, WS_G = DB + 168 * MiB;
constexpr size_t WS_YRAW = DB, WS_YSR = DB + 32 * MiB;
constexpr size_t WS_Q = DB + 56 * MiB, WS_K = DB + 72 * MiB, WS_V = DB + 88 * MiB, WS_UV = DB + 104 * MiB;
constexpr size_t WS_YSA = DB + 152 * MiB, WS_YSG = DB + 168 * MiB;
constexpr size_t WS_GATE = DB, WS_M32 = DB + 48 * MiB, WS_MB = DB + 112 * MiB;
constexpr size_t WS_UP = DB;
constexpr size_t WS_SIDEA = DB + 88 * MiB, WS_SIDEG = DB + 100 * MiB;
static_assert(WS_LGU + 131072 <= WS_H, "weights region overflow");
static_assert(WS_BAR + 64 * 26 * 4 <= DB, "small region overflow");

struct Params {
    const float* in[29];
    float* out;
    unsigned char* ws;
};

typedef const __attribute__((address_space(4))) Params* KP;
DI KP okp() { unsigned long long k = (unsigned long long)__builtin_amdgcn_kernarg_segment_ptr(); asm volatile("" : "+s"(k)); return (KP)k; }
typedef float f32x2_t __attribute__((ext_vector_type(2)));
typedef __bf16 bf16x2_t __attribute__((ext_vector_type(2)));
DI unsigned cvt_pk_bf16(float lo, float hi) { const f32x2_t v = {lo, hi}; const bf16x2_t r = __builtin_convertvector(v, bf16x2_t); return __builtin_bit_cast(unsigned, r); }
DI float bf_lo(unsigned w) { return __uint_as_float(w << 16); }
DI float bf_hi(unsigned w) { return __uint_as_float(w & 0xffff0000u); }
DI int otid(int wv) { int ln; asm volatile("v_mbcnt_lo_u32_b32 %0, -1, 0\n\tv_mbcnt_hi_u32_b32 %0, -1, %0" : "=v"(ln)); return wv * 64 + ln; }
DI unsigned char* ows(unsigned char* w) { asm volatile("" : "+s"(w)); return w; }
DI float row16_sum(float v) {
    v += __builtin_bit_cast(float, __builtin_amdgcn_update_dpp(0, __builtin_bit_cast(int, v), 0xB1, 0xF, 0xF, false));
    v += __builtin_bit_cast(float, __builtin_amdgcn_update_dpp(0, __builtin_bit_cast(int, v), 0x4E, 0xF, 0xF, false));
    v += __builtin_bit_cast(float, __builtin_amdgcn_update_dpp(0, __builtin_bit_cast(int, v), 0x141, 0xF, 0xF, false));
    v += __builtin_bit_cast(float, __builtin_amdgcn_update_dpp(0, __builtin_bit_cast(int, v), 0x140, 0xF, 0xF, false));
    return v;
}
DI float wave_sum(float v) { v = row16_sum(v); v += __shfl_xor(v, 16); v += __shfl_xor(v, 32); return v; }
#define XB_CNT(j)  (64 * (j))
#define XB_SUB(j)  (64 * (8 + (j)))
#define XB_GEN(j)  (64 * (16 + (j)))
#define XB_TOP     (64 * 24)
#define XB_TOPGEN  (64 * 25)
#define XB_WORDS   (64 * 26)
DI unsigned xb_ld(unsigned* p) { return __hip_atomic_load(p, __ATOMIC_RELAXED, __HIP_MEMORY_SCOPE_AGENT); }
DI unsigned xb_add(unsigned* p, unsigned v) { return __hip_atomic_fetch_add(p, v, __ATOMIC_RELAXED, __HIP_MEMORY_SCOPE_AGENT); }
DI unsigned xb_xcc_id() { return (unsigned)__builtin_amdgcn_s_getreg((3 << 11) | 20) & 0x7u; }
DI void gbar(unsigned* bar, volatile LAS unsigned* st, int wv) {
    asm volatile("s_waitcnt vmcnt(0) lgkmcnt(0)" ::: "memory");
    __syncthreads();
    if (otid(wv) == 0) {
        const unsigned nloc = st[0], nx = st[1], x = st[2];
        const unsigned old = xb_add(&bar[XB_SUB(x)], 1u);
        const unsigned gen = old / nloc;
        if (old + 1u == (gen + 1u) * nloc) {
            __builtin_amdgcn_fence(__ATOMIC_RELEASE, "agent");
            asm volatile("s_waitcnt vmcnt(0)" ::: "memory");
            const unsigned og = xb_add(&bar[XB_TOP], 1u);
            const unsigned tg = og / nx;
            if (og + 1u == (tg + 1u) * nx) xb_add(&bar[XB_TOPGEN], 1u);
            else { while (xb_ld(&bar[XB_TOPGEN]) == tg) __builtin_amdgcn_s_sleep(1); }
            __builtin_amdgcn_fence(__ATOMIC_ACQUIRE, "agent");
            xb_add(&bar[XB_GEN(x)], 1u);
            asm volatile("s_waitcnt vmcnt(0)" ::: "memory");
        } else {
            while (xb_ld(&bar[XB_GEN(x)]) == gen) __builtin_amdgcn_s_sleep(1);
            __builtin_amdgcn_fence(__ATOMIC_ACQUIRE, "agent");
            asm volatile("s_waitcnt vmcnt(0)" ::: "memory");
        }
    }
    asm volatile("" ::: "memory");
    __syncthreads();
}
DI float sigmoidf_(float x) { return __builtin_amdgcn_rcpf(1.0f + __expf(-x)); }
DI float gelu_tanh(float x) { const float u = 1.5957691216f * (x + 0.044715f * x * x * x); return x * __builtin_amdgcn_rcpf(1.0f + __expf(-u)); }
#define LDS_WAIT() asm volatile("s_waitcnt lgkmcnt(0)" ::: "memory")
#define MFMA32(a, b, c) __builtin_amdgcn_mfma_f32_32x32x16_bf16((a), (b), (c), 0, 0, 0)
DI int crow(int reg, int h) { return (reg & 3) + 8 * (reg >> 2) + 4 * h; }
DI bf16x8 pack8(float a0, float a1, float a2, float a3, float a4, float a5, float a6, float a7) {
    u32x4 p; p.x = cvt_pk_bf16(a0, a1); p.y = cvt_pk_bf16(a2, a3); p.z = cvt_pk_bf16(a4, a5); p.w = cvt_pk_bf16(a6, a7);
    return __builtin_bit_cast(bf16x8, p);
}

namespace pg8 {
constexpr int BM = 256, BK = 64, HALF = 128, HTB = HALF * BK * 2, STAGE_BYTES = 8 * HTB, NXCD = 8, WGM = 8;
DI int lds_byte(int r, int c) { const int st = (r >> 4) * 2 + (c >> 5), rr = r & 15, cc = c & 31, ob = rr * 64 + cc * 2; return st * 1024 + (ob ^ (((ob >> 9) & 1) << 5)); }
DI void stage_rc(int b, int& R, int& C) { const int st = b / 1024, sb = b % 1024, swz = sb ^ (((sb >> 9) & 1) << 5); R = (st >> 1) * 16 + swz / 64; C = (st & 1) * 32 + (swz % 64) / 2; }
DI int perm32(int rho) { const int n = rho >> 4, i = rho & 15; return 8 * (i >> 2) + 4 * n + (i & 3); }
struct Unit { int pm, pn, sub; };
struct Gemm { const bf16_t* A; const bf16_t* Bt; int lda, K; int merge; const unsigned char* ws; };
struct TileOrder {
    int nM, nN, nwg, G, c, split, off0, off1, nsub;
    DI void init(int nM_, int nN_, int G_, int c_, int split_, int off0_, int off1_, int nsub_ = 1) { nM = nM_; nN = nN_; nwg = nM * nN; G = G_; c = c_; split = split_; off0 = off0_; off1 = off1_; nsub = nsub_; }
    DI bool next(int i0, Unit& u) const {
        const int i = i0 / nsub; u.sub = i0 - i * nsub;
        const long L = (long)i * G + c; if (L >= nwg) return false;
        int wgid = (int)L; { const int q = nwg / NXCD, r = nwg % NXCD, xcd = wgid % NXCD, off = wgid / NXCD; wgid = (xcd < r ? xcd * (q + 1) : r * (q + 1) + (xcd - r) * q) + off; }
        const int nig = WGM * nN, gid = wgid / nig, fm = gid * WGM, gsz = (nM - fm) < WGM ? (nM - fm) : WGM;
        u.pm = fm + ((wgid % nig) % gsz); const int pnv = (wgid % nig) / gsz; u.pn = pnv < split ? pnv + off0 : pnv - split + off1; return true;
    }
};

enum { EM_INPROJ = 0, EM_GATE = 1, EM_BR_FIRST = 2, EM_BR_MID = 3, EM_BR_LAST = 4, EM_RESID = 5, EM_UP = 6, EM_MERGE = 7 };
struct Epi {
    int mode;
    bf16_t *o0, *o1, *o2, *o3, *o4;
    float* f3;
    float* f0; const float* f1; const float* f2;
    const float *ropec, *ropes;
    DI void up_conv(const f32x4 (&acc)[2][2][4][2], const Unit& u, int wr, int wc, int fr, int fq) const {
        const int f = u.pn * 128 + wc * 32 + 8 * fq;
        const int src1 = (fq << 4) | ((fr + 15) & 15), src2 = (fq << 4) | ((fr + 14) & 15);
        const f32x4 w0a = *(const f32x4*)(f1 + f), w0b = *(const f32x4*)(f1 + f + 4), w1a = *(const f32x4*)(f1 + DFF + f), w1b = *(const f32x4*)(f1 + DFF + f + 4);
        const f32x4 w2a = *(const f32x4*)(f1 + 2 * DFF + f), w2b = *(const f32x4*)(f1 + 2 * DFF + f + 4), cba = *(const f32x4*)(f2 + f), cbb = *(const f32x4*)(f2 + f + 4);
#pragma unroll
        for (int ai = 0; ai < 2; ++ai) {
            const int q = u.pm * 4 + ai * 2 + wr;
            f32x4 p1a_prev = {0.f, 0.f, 0.f, 0.f}, p1b_prev = p1a_prev, p2a_prev = p1a_prev, p2b_prev = p1a_prev;
#pragma unroll
            for (int m = 0; m < 4; ++m) {
                const f32x4 aa = acc[ai][0][m][0], ab = acc[ai][0][m][1], ga = acc[ai][1][m][0], gb = acc[ai][1][m][1];
                f32x4 p1a, p1b, p2a, p2b;
#pragma unroll
                for (int j = 0; j < 4; ++j) {
                    p1a[j] = __shfl(aa[j], src1); p1b[j] = __shfl(ab[j], src1); p2a[j] = __shfl(aa[j], src2); p2b[j] = __shfl(ab[j], src2);
                }
                const f32x4 t1a = fr >= 1 ? p1a : p1a_prev, t1b = fr >= 1 ? p1b : p1b_prev, t2a = fr >= 2 ? p2a : p2a_prev, t2b = fr >= 2 ? p2b : p2b_prev;
                const f32x4 ca = cba + w0a * t2a + w1a * t1a + w2a * aa, cb_ = cbb + w0b * t2b + w1b * t1b + w2b * ab;
                const int row = u.pm * BM + ai * HALF + wr * 64 + m * 16 + fr;
                u32x4 w;
                w.x = cvt_pk_bf16(gelu_tanh(ca[0]) * ga[0], gelu_tanh(ca[1]) * ga[1]); w.y = cvt_pk_bf16(gelu_tanh(ca[2]) * ga[2], gelu_tanh(ca[3]) * ga[3]);
                w.z = cvt_pk_bf16(gelu_tanh(cb_[0]) * gb[0], gelu_tanh(cb_[1]) * gb[1]); w.w = cvt_pk_bf16(gelu_tanh(cb_[2]) * gb[2], gelu_tanh(cb_[3]) * gb[3]);
                *(u32x4*)(o0 + (size_t)row * DFF + f) = w;
                if (m == 0 && fr < 2) {
                    float* sa = f0 + ((size_t)q * 4 + fr) * DFF + f; *(f32x4*)sa = aa; *(f32x4*)(sa + 4) = ab;
                    float* sg = f3 + ((size_t)q * 2 + fr) * DFF + f; *(f32x4*)sg = ga; *(f32x4*)(sg + 4) = gb;
                }
                if (m == 3 && fr >= 14) { float* sa = f0 + ((size_t)q * 4 + 2 + (fr - 14)) * DFF + f; *(f32x4*)sa = aa; *(f32x4*)(sa + 4) = ab; }
                p1a_prev = p1a; p1b_prev = p1b; p2a_prev = p2a; p2b_prev = p2b;
            }
        }
    }
    DI void operator()(const f32x4 (&acc)[2][2][4][2], const Unit& u, int wr, int wc, int fr, int fq) const {
        if (mode == EM_UP) { up_conv(acc, u, wr, wc, fr, fq); return; }
        const int mode = (this->mode == EM_MERGE) ? (((u.sub & 1) == 0) ? (int)EM_GATE : ((u.sub >> 1) == 0 ? (int)EM_BR_FIRST : ((u.sub >> 1) == 1 ? (int)EM_BR_MID : (int)EM_BR_LAST))) : this->mode;
        const int row0 = u.pm * BM + wr * 64 + fr, colb = u.pn * BM + wc * 32 + 8 * fq;
        if (mode == EM_RESID) {
            const float* gv = f2 + (size_t)(row0 >> 12) * 6144 + colb;
            const f32x4 g00 = *(const f32x4*)gv, g01 = *(const f32x4*)(gv + 4), g10 = *(const f32x4*)(gv + HALF), g11 = *(const f32x4*)(gv + HALF + 4);
#pragma unroll
            for (int ai = 0; ai < 2; ++ai) {
                f32x4 b0[4][2], b1[4][2];
#pragma unroll
                for (int m = 0; m < 4; ++m)
#pragma unroll
                    for (int bj = 0; bj < 2; ++bj) { const size_t off = (size_t)(row0 + ai * HALF + m * 16) * 1024 + colb + bj * HALF; b0[m][bj] = *(const f32x4*)(f1 + off); b1[m][bj] = *(const f32x4*)(f1 + off + 4); }
                asm volatile("" ::: "memory");
#pragma unroll
                for (int m = 0; m < 4; ++m)
#pragma unroll
                    for (int bj = 0; bj < 2; ++bj) { const size_t off = (size_t)(row0 + ai * HALF + m * 16) * 1024 + colb + bj * HALF;
                        *(f32x4*)(f0 + off) = b0[m][bj] + (bj ? g10 : g00) * acc[ai][bj][m][0]; *(f32x4*)(f0 + off + 4) = b1[m][bj] + (bj ? g11 : g01) * acc[ai][bj][m][1]; }
            }
            return;
        }
        if (mode == EM_BR_FIRST || mode == EM_BR_MID || mode == EM_BR_LAST) {
#pragma unroll
            for (int ai = 0; ai < 2; ++ai) {
                u32x4 gw[4][2], pm[4][2];
#pragma unroll
                for (int m = 0; m < 4; ++m)
#pragma unroll
                    for (int bj = 0; bj < 2; ++bj) { const size_t off = (size_t)(row0 + ai * HALF + m * 16) * 1024 + colb + bj * HALF; gw[m][bj] = *(const u32x4*)(o0 + off);
                        pm[m][bj] = (u32x4){0u, 0u, 0u, 0u}; if (mode != EM_BR_FIRST) pm[m][bj] = *(const u32x4*)(o1 + off); }
                asm volatile("" ::: "memory");
#pragma unroll
                for (int m = 0; m < 4; ++m)
#pragma unroll
                    for (int bj = 0; bj < 2; ++bj) { const size_t off = (size_t)(row0 + ai * HALF + m * 16) * 1024 + colb + bj * HALF;
                        const f32x4 v0 = acc[ai][bj][m][0], v1 = acc[ai][bj][m][1]; const u32x4 g_ = gw[m][bj], q_ = pm[m][bj];
                        u32x4 w;
                        w.x = cvt_pk_bf16(bf_lo(g_.x) * v0[0] + bf_lo(q_.x), bf_hi(g_.x) * v0[1] + bf_hi(q_.x)); w.y = cvt_pk_bf16(bf_lo(g_.y) * v0[2] + bf_lo(q_.y), bf_hi(g_.y) * v0[3] + bf_hi(q_.y));
                        w.z = cvt_pk_bf16(bf_lo(g_.z) * v1[0] + bf_lo(q_.z), bf_hi(g_.z) * v1[1] + bf_hi(q_.z)); w.w = cvt_pk_bf16(bf_lo(g_.w) * v1[2] + bf_lo(q_.w), bf_hi(g_.w) * v1[3] + bf_hi(q_.w));
                        *(u32x4*)(o1 + off) = w; }
            }
            return;
        }
#pragma unroll
        for (int ai = 0; ai < 2; ++ai) {
            f32x4 csn[4][2], snn[4][2];
            if (mode == EM_INPROJ && u.pn < 4) {
#pragma unroll
                for (int m = 0; m < 4; ++m)
#pragma unroll
                    for (int bj = 0; bj < 2; ++bj) { const int pos = (row0 + ai * HALF + m * 16) & (SEQ - 1), e0 = ((colb + bj * HALF) & 63) >> 1;
                        csn[m][bj] = *(const f32x4*)(ropec + pos * 32 + e0); snn[m][bj] = *(const f32x4*)(ropes + pos * 32 + e0); }
                asm volatile("" ::: "memory");
            }
#pragma unroll
            for (int m = 0; m < 4; ++m) {
                const int row = row0 + ai * HALF + m * 16;
#pragma unroll
                for (int bj = 0; bj < 2; ++bj) {
                    const int col0 = colb + bj * HALF;
                    f32x4 v0 = acc[ai][bj][m][0], v1 = acc[ai][bj][m][1];
                    if (mode == EM_INPROJ) {
                        bf16_t* dst;
                        if (u.pn < 4) {
                            const f32x4 cs = csn[m][bj], sn = snn[m][bj];
                            f32x4 a, b;
                            a[0] = v0[0] * cs[0] - v0[1] * sn[0]; a[1] = v0[1] * cs[0] + v0[0] * sn[0];
                            a[2] = v0[2] * cs[1] - v0[3] * sn[1]; a[3] = v0[3] * cs[1] + v0[2] * sn[1];
                            b[0] = v1[0] * cs[2] - v1[1] * sn[2]; b[1] = v1[1] * cs[2] + v1[0] * sn[2];
                            b[2] = v1[2] * cs[3] - v1[3] * sn[3]; b[3] = v1[3] * cs[3] + v1[2] * sn[3];
                            v0 = a; v1 = b;
                            dst = (u.pn < 2) ? o0 + (size_t)row * 512 + col0 : o1 + (size_t)row * 512 + (col0 - 512);
                        } else if (u.pn < 6) { dst = o2 + (size_t)row * 512 + (col0 - 1024); }
                        else if (u.pn < 13) { dst = o3 + (size_t)row * RAWC + (col0 - 1536); }
                        else {
#pragma unroll
                            for (int j = 0; j < 4; ++j) { v0[j] = gelu_tanh(v0[j]); v1[j] = gelu_tanh(v1[j]); }
                            dst = o4 + (size_t)row * 1024 + (col0 - 3328);
                        }
                        u32x4 w; w.x = cvt_pk_bf16(v0[0], v0[1]); w.y = cvt_pk_bf16(v0[2], v0[3]); w.z = cvt_pk_bf16(v1[0], v1[1]); w.w = cvt_pk_bf16(v1[2], v1[3]);
                        *(u32x4*)dst = w;
                    } else {
#pragma unroll
                        for (int j = 0; j < 4; ++j) { v0[j] = sigmoidf_(v0[j]); v1[j] = sigmoidf_(v1[j]); }
                        u32x4 w; w.x = cvt_pk_bf16(v0[0], v0[1]); w.y = cvt_pk_bf16(v0[2], v0[3]); w.z = cvt_pk_bf16(v1[0], v1[1]); w.w = cvt_pk_bf16(v1[2], v1[3]);
                        *(u32x4*)(o0 + (size_t)row * 1024 + col0) = w;
                    }
                }
            }
        }
    }
};

DI void unit_operands(const Gemm& g, int sub, const char*& A, const char*& Bt, int& lda, int& K) {
    if (!g.merge) { A = (const char*)g.A; Bt = (const char*)g.Bt; lda = g.lda; K = g.K; return; }
    const int br = sub >> 1;
    if ((sub & 1) == 0) { A = (const char*)(g.ws + WS_H); Bt = (const char*)(g.ws + WS_WIN) + (size_t)(4352 + 1024 * br) * 1024 * 2; lda = 1024; K = 1024; }
    else { A = (const char*)(g.ws + (br == 0 ? WS_YSA : (br == 1 ? WS_YSR : WS_YSG))); Bt = (const char*)(g.ws + WS_WBR) + (size_t)br * 1024 * 512 * 2; lda = 512; K = 512; }
}
DI void gemm_phase(LAS unsigned char* lds, const Gemm g, const TileOrder S, const Epi E, int wv) {
    const int tid = otid(wv), wid = __builtin_amdgcn_readfirstlane(tid >> 6), lane = tid & 63, wr = wid >> 2, wc = wid & 3, fr = lane & 15, fq = lane >> 4;
    int stR[2], stC[2], stRb[2];
#pragma unroll
    for (int i = 0; i < 2; ++i) { int R, C; stage_rc(tid * 16 + i * 8192, R, C); stR[i] = R; stC[i] = C; stRb[i] = (R & ~31) + perm32(R & 31); }
    const size_t kstep = (size_t)(BK * 2);
    const unsigned ldsw = (unsigned)wid * 1024u;
    const int aoff = lds_byte(wr * 64 + fr, fq * 8), boff = lds_byte(wc * 32 + fr, fq * 8);
#define PG8_SA(b, h) (((b) * 2 + (h)) * HTB)
#define PG8_SB(b, h) ((4 + (b) * 2 + (h)) * HTB)
#define PG8_STAGE(bufoff, gbase, voff) do { _Pragma("unroll") for (int _i = 0; _i < 2; ++_i) \
        __builtin_amdgcn_global_load_lds((const unsigned*)((const char*)(gbase) + (voff)[_i]), (LAS unsigned*)(lds + (bufoff) + ldsw + _i * 8192), 16, 0, 0); } while (0)
#define PG8_LDA(dst, b, h) do { _Pragma("unroll") for (int m = 0; m < 4; ++m) _Pragma("unroll") for (int k = 0; k < 2; ++k) dst[m][k] = *(const LAS bf16x8*)(lds + PG8_SA(b, h) + aoff + m * 2048 + k * 1024); } while (0)
#define PG8_LDB(dst, b, h) do { _Pragma("unroll") for (int n = 0; n < 2; ++n) _Pragma("unroll") for (int k = 0; k < 2; ++k) dst[n][k] = *(const LAS bf16x8*)(lds + PG8_SB(b, h) + boff + n * 2048 + k * 1024); } while (0)
#define PG8_MMA(ai, bj, At, Bt) do { __builtin_amdgcn_s_setprio(1); _Pragma("unroll") for (int m = 0; m < 4; ++m) _Pragma("unroll") for (int n = 0; n < 2; ++n) _Pragma("unroll") for (int k = 0; k < 2; ++k) \
        acc[ai][bj][m][n] = __builtin_amdgcn_mfma_f32_16x16x32_bf16(Bt[n][k], At[m][k], acc[ai][bj][m][n], 0, 0, 0); __builtin_amdgcn_s_setprio(0); } while (0)
#define PG8_WAIT_V(n) asm volatile("s_waitcnt vmcnt(" #n ")" ::: "memory")
#define PG8_WAIT_L(n) asm volatile("s_waitcnt lgkmcnt(" #n ")" ::: "memory")
#define PG8_BAR __builtin_amdgcn_s_barrier()
#define PG8_SCHED __builtin_amdgcn_sched_barrier(0)
#define PG8_SETUP(u, pA, pB, vA, vB, hA, hB, ntv) do { const char* _A; const char* _B; int _lda, _K; unit_operands(g, (u).sub, _A, _B, _lda, _K); \
        pA = _A + (size_t)(u).pm * 256 * _lda * 2; pB = _B + (size_t)(u).pn * 256 * _K * 2; hA = (size_t)HALF * _lda * 2; hB = (size_t)HALF * _K * 2; ntv = _K / BK; \
        _Pragma("unroll") for (int _i = 0; _i < 2; ++_i) { vA[_i] = (unsigned)(stR[_i] * _lda + stC[_i]) * 2u; vB[_i] = (unsigned)(stRb[_i] * _K + stC[_i]) * 2u; } } while (0)
    Unit cur, nxt; int ui = 0;
    if (!S.next(0, cur)) return;
    f32x4 acc[2][2][4][2];
#pragma unroll
    for (int a = 0; a < 2; ++a)
#pragma unroll
        for (int b = 0; b < 2; ++b)
#pragma unroll
            for (int m = 0; m < 4; ++m)
#pragma unroll
                for (int n = 0; n < 2; ++n) acc[a][b][m][n] = (f32x4){0.f, 0.f, 0.f, 0.f};
    bf16x8 At[4][2], B0[2][2], B1[2][2];
    const char *cA, *cB, *nA, *nB; unsigned vAc[2], vBc[2], vAn[2], vBn[2]; size_t hAc, hBc, hAn, hBn; int nt, ntn;
    PG8_SETUP(cur, cA, cB, vAc, vBc, hAc, hBc, nt);
    PG8_STAGE(PG8_SB(0, 0), cB, vBc); PG8_STAGE(PG8_SA(0, 0), cA, vAc); PG8_STAGE(PG8_SB(0, 1), cB + hBc, vBc); PG8_STAGE(PG8_SA(0, 1), cA + hAc, vAc);
    if (wr == 1) PG8_BAR;
    PG8_WAIT_V(4); PG8_BAR;
    PG8_STAGE(PG8_SB(1, 0), cB + kstep, vBc); PG8_STAGE(PG8_SA(1, 0), cA + kstep, vAc); PG8_STAGE(PG8_SB(1, 1), cB + hBc + kstep, vBc);
    PG8_WAIT_V(6); PG8_BAR;
    for (;;) {
        const bool has_next = S.next(ui + 1, nxt);
        if (has_next) { PG8_SETUP(nxt, nA, nB, vAn, vBn, hAn, hBn, ntn); }
        else { nA = cA; nB = cB; vAn[0] = vAc[0]; vAn[1] = vAc[1]; vBn[0] = vBc[0]; vBn[1] = vBc[1]; hAn = hAc; hBn = hBc; ntn = nt; }
        for (int t = 0; t < nt; t += 2) {
            const bool last = (t == nt - 2);
            const char* a1 = cA + (size_t)(t + 1) * kstep;
            const char* a2 = last ? nA : cA + (size_t)(t + 2) * kstep; const char* b2 = last ? nB : cB + (size_t)(t + 2) * kstep;
            const char* a3 = a2 + kstep; const char* b3 = b2 + kstep;
            unsigned vA2[2], vB2[2]; vA2[0] = last ? vAn[0] : vAc[0]; vA2[1] = last ? vAn[1] : vAc[1]; vB2[0] = last ? vBn[0] : vBc[0]; vB2[1] = last ? vBn[1] : vBc[1];
            const size_t hA2 = last ? hAn : hAc, hB2 = last ? hBn : hBc;
            PG8_LDB(B0, 0, 0); PG8_SCHED; PG8_LDA(At, 0, 0); PG8_STAGE(PG8_SA(1, 1), a1 + hAc, vAc);
            PG8_WAIT_L(8); PG8_BAR; PG8_WAIT_L(0); PG8_MMA(0, 0, At, B0); PG8_BAR; PG8_SCHED;
            PG8_LDB(B1, 0, 1); PG8_STAGE(PG8_SB(0, 0), b2, vB2);
            PG8_BAR; PG8_WAIT_L(0); PG8_MMA(0, 1, At, B1); PG8_BAR;
            PG8_LDA(At, 0, 1); PG8_STAGE(PG8_SA(0, 0), a2, vA2);
            PG8_BAR; PG8_WAIT_L(0); PG8_MMA(1, 0, At, B0); PG8_BAR; PG8_SCHED;
            PG8_STAGE(PG8_SB(0, 1), b2 + hB2, vB2);
            PG8_WAIT_V(6); PG8_BAR; PG8_MMA(1, 1, At, B1); PG8_BAR;
            PG8_LDB(B0, 1, 0); PG8_SCHED; PG8_LDA(At, 1, 0); PG8_STAGE(PG8_SA(0, 1), a2 + hA2, vA2);
            PG8_WAIT_L(8); PG8_BAR; PG8_WAIT_L(0); PG8_MMA(0, 0, At, B0); PG8_BAR; PG8_SCHED;
            PG8_LDB(B1, 1, 1); PG8_STAGE(PG8_SB(1, 0), b3, vB2);
            PG8_BAR; PG8_WAIT_L(0); PG8_MMA(0, 1, At, B1); PG8_BAR;
            PG8_LDA(At, 1, 1); PG8_STAGE(PG8_SA(1, 0), a3, vA2);
            PG8_BAR; PG8_WAIT_L(0); PG8_MMA(1, 0, At, B0); PG8_BAR; PG8_SCHED;
            PG8_STAGE(PG8_SB(1, 1), b3 + hB2, vB2);
            PG8_WAIT_V(6); PG8_BAR; PG8_MMA(1, 1, At, B1); PG8_BAR;
        }
        E(acc, cur, wr, wc, fr, fq);
        if (!has_next) break;
#pragma unroll
        for (int a = 0; a < 2; ++a)
#pragma unroll
            for (int b = 0; b < 2; ++b)
#pragma unroll
                for (int m = 0; m < 4; ++m)
#pragma unroll
                    for (int n = 0; n < 2; ++n) acc[a][b][m][n] = (f32x4){0.f, 0.f, 0.f, 0.f};
        cur = nxt; cA = nA; cB = nB; vAc[0] = vAn[0]; vAc[1] = vAn[1]; vBc[0] = vBn[0]; vBc[1] = vBn[1]; hAc = hAn; hBc = hBn; nt = ntn; ++ui;
    }
    PG8_WAIT_V(0);
    if (wr == 0) PG8_BAR;
    PG8_BAR;
#undef PG8_SA
#undef PG8_SB
#undef PG8_STAGE
#undef PG8_LDA
#undef PG8_LDB
#undef PG8_MMA
#undef PG8_WAIT_V
#undef PG8_WAIT_L
#undef PG8_BAR
#undef PG8_SCHED
#undef PG8_SETUP
}
}

template <int PERMK>
DI void transpose_item(const float* W, int K, int N, bf16_t* WT, LAS float* scr, int item, int lane) {
    const int nblk = N / 32, kb = item / nblk, nb = item % nblk, k0 = 64 * kb, n0 = 32 * nb;
    int sc = n0 + (lane & 31);
    if (PERMK == 1 && sc < 1024) { const int hd = sc >> 6, cp = sc & 63; sc = hd * 64 + 32 * (cp & 1) + (cp >> 1); }
    if (PERMK == 2) { const int tl = sc >> 8, w = sc & 255; sc = (w < 128) ? (128 * tl + w) : (DFF + 128 * tl + (w - 128)); }
#pragma unroll 8
    for (int i = 0; i < 32; ++i) { const int kk = 2 * i + (lane >> 5); scr[kk * 33 + (lane & 31)] = W[(size_t)(k0 + kk) * N + sc]; }
    LDS_WAIT();
    const int c = lane & 7;
#pragma unroll
    for (int j = 0; j < 4; ++j) { const int n = (lane >> 3) + 8 * j; const LAS float* s = scr + (8 * c) * 33 + n;
        u32x4 o; o.x = cvt_pk_bf16(s[0 * 33], s[1 * 33]); o.y = cvt_pk_bf16(s[2 * 33], s[3 * 33]); o.z = cvt_pk_bf16(s[4 * 33], s[5 * 33]); o.w = cvt_pk_bf16(s[6 * 33], s[7 * 33]);
        *(u32x4*)(WT + (size_t)(n0 + n) * K + k0 + 8 * c) = o; }
    LDS_WAIT();
}

DI void convert_weights(KP p, int l, LAS unsigned char* lds, int wv) {
    const int tid_ = otid(wv); const int wave = tid_ >> 6, lane = tid_ & 63;
    LAS float* scr = (LAS float*)(lds + wave * 8448);
    const int gw = blockIdx.x * 8 + wave, NGW = gridDim.x * 8;
    constexpr int I_IN = 16 * (INC / 32), I_BR = 8 * 32, I_OUT = 16 * 32, I_UP = 16 * (UPC / 32), I_DN = (DFF / 64) * 32, I_L64 = 16, I_L128 = 32;
    constexpr int NIT = I_IN + 3 * I_BR + I_OUT + I_UP + I_DN + 2 * I_L64 + I_L128;
    unsigned char* ws = ows(p->ws);
    for (int it = gw; it < NIT; it += NGW) {
        int r = it;
        if (r < I_IN) { transpose_item<1>(p->in[5] + (size_t)l * 1024 * INC, 1024, INC, (bf16_t*)(ws + WS_WIN), scr, r, lane); continue; } r -= I_IN;
        if (r < 3 * I_BR) { const int b = r / I_BR; transpose_item<0>(p->in[21] + ((size_t)l * 3 + b) * 512 * 1024, 512, 1024, (bf16_t*)(ws + WS_WBR) + (size_t)b * 1024 * 512, scr, r % I_BR, lane); continue; } r -= 3 * I_BR;
        if (r < I_OUT) { transpose_item<0>(p->in[22] + (size_t)l * 1024 * 1024, 1024, 1024, (bf16_t*)(ws + WS_WOUT), scr, r, lane); continue; } r -= I_OUT;
        if (r < I_UP) { transpose_item<2>(p->in[24] + (size_t)l * 1024 * UPC, 1024, UPC, (bf16_t*)(ws + WS_WUP), scr, r, lane); continue; } r -= I_UP;
        if (r < I_DN) { transpose_item<0>(p->in[27] + (size_t)l * DFF * 1024, DFF, 1024, (bf16_t*)(ws + WS_WDN), scr, r, lane); continue; } r -= I_DN;
        if (r < I_L64) { transpose_item<0>(p->in[8] + (size_t)l * 64 * 512, 64, 512, (bf16_t*)(ws + WS_LWU), scr, r, lane); continue; } r -= I_L64;
        if (r < I_L64) { transpose_item<0>(p->in[10] + (size_t)l * 64 * 512, 64, 512, (bf16_t*)(ws + WS_LAU), scr, r, lane); continue; } r -= I_L64;
        transpose_item<0>(p->in[11] + (size_t)l * 128 * 512, 128, 512, (bf16_t*)(ws + WS_LGU), scr, r, lane);
    }
}

DI void phase0(KP p, LAS unsigned char* lds, int wv) {
    const int tid = otid(wv);
    float* ropec = (float*)(p->ws + WS_ROPEC); float* ropes = (float*)(p->ws + WS_ROPES);
    for (int idx = blockIdx.x * 512 + tid; idx < SEQ * 32; idx += gridDim.x * 512) {
        const int pos = idx >> 5, e = idx & 31;
        const float inv = 1.0f / exp2f((float)e * (13.287712379549449f / 32.0f));
        const float ang = (float)pos * inv;
        double rev = (double)ang * 0.15915494309189535; rev -= rint(rev);
        const float rv = (float)rev;
        ropec[idx] = __builtin_amdgcn_cosf(rv); ropes[idx] = __builtin_amdgcn_sinf(rv);
    }
    {
        LAS float* ca = (LAS float*)lds;
        LAS float* red = (LAS float*)(lds + 16384);
        float* mod = (float*)(p->ws + WS_MOD);
        bool loaded = false;
        for (int item = blockIdx.x; item < 192; item += gridDim.x) {
            if (!loaded) { for (int i = tid; i < 4096; i += 512) { const float v = p->in[1][i]; ca[i] = v / (1.0f + __expf(-v)); } loaded = true; __syncthreads(); }
            const int l = item / 96, c0 = (item % 96) * 64, cc = tid & 63, kg = tid >> 6;
            const float* w = p->in[2] + (size_t)l * 1024 * 6144 + c0 + cc;
            float a0 = 0.f, a1 = 0.f, a2 = 0.f, a3 = 0.f;
#pragma unroll 8
            for (int k = kg * 128; k < kg * 128 + 128; ++k) { const float wv = w[(size_t)k * 6144]; a0 += ca[k] * wv; a1 += ca[1024 + k] * wv; a2 += ca[2048 + k] * wv; a3 += ca[3072 + k] * wv; }
            red[(kg * 4 + 0) * 64 + cc] = a0; red[(kg * 4 + 1) * 64 + cc] = a1; red[(kg * 4 + 2) * 64 + cc] = a2; red[(kg * 4 + 3) * 64 + cc] = a3;
            __syncthreads();
            if (tid < 256) { const int b = tid >> 6; float s = 0.f;
#pragma unroll
                for (int g = 0; g < 8; ++g) s += red[(g * 4 + b) * 64 + cc];
                mod[((size_t)l * 4 + b) * 6144 + c0 + cc] = s + p->in[3][(size_t)l * 6144 + c0 + cc]; }
            __syncthreads();
        }
        __syncthreads();
    }
    convert_weights(p, 0, lds, wv);
}

DI void norm_mod_phase(const float* x, const float* g, const float* sh, const float* sc, bf16_t* H, int wv) {
    const int tid_ = otid(wv); const int wave = tid_ >> 6, lane = tid_ & 63;
    for (int row0 = (blockIdx.x * 8 + wave) * 2; row0 < MTOK; row0 += gridDim.x * 16) {
        f32x4 v[2][4]; float s[2] = {0.f, 0.f};
#pragma unroll
        for (int q = 0; q < 2; ++q) { const f32x4* xr = (const f32x4*)(x + (size_t)(row0 + q) * DM) + lane;
#pragma unroll
            for (int j = 0; j < 4; ++j) v[q][j] = xr[64 * j]; }
#pragma unroll
        for (int q = 0; q < 2; ++q)
#pragma unroll
            for (int j = 0; j < 4; ++j) s[q] += (v[q][j][0] * v[q][j][0] + v[q][j][1] * v[q][j][1]) + (v[q][j][2] * v[q][j][2] + v[q][j][3] * v[q][j][3]);
        const float rs0 = rsqrtf(wave_sum(s[0]) * (1.0f / DM) + 1e-6f), rs1 = rsqrtf(wave_sum(s[1]) * (1.0f / DM) + 1e-6f);
        const int b = row0 >> 12;
#pragma unroll
        for (int j = 0; j < 4; ++j) {
            const int c = 4 * lane + 256 * j;
            const f32x4 gg = *(const f32x4*)(g + c), s1 = *(const f32x4*)(sc + (size_t)b * 6144 + c), s0 = *(const f32x4*)(sh + (size_t)b * 6144 + c);
#pragma unroll
            for (int q = 0; q < 2; ++q) {
                const f32x4 h = (v[q][j] * (q ? rs1 : rs0) * gg) * (s1 + 1.0f) + s0;
                u32x2 w; w.x = cvt_pk_bf16(h[0], h[1]); w.y = cvt_pk_bf16(h[2], h[3]);
                *((u32x2*)(H + (size_t)(row0 + q) * DM) + lane + 64 * j) = w;
            }
        }
    }
}
DI void final_norm_phase(float* x, const float* g, int wv) {
    const int tid_ = otid(wv); const int wave = tid_ >> 6, lane = tid_ & 63;
    for (int row = blockIdx.x * 8 + wave; row < MTOK; row += gridDim.x * 8) {
        f32x4* xr = (f32x4*)(x + (size_t)row * DM) + lane;
        f32x4 v[4]; float s = 0.f;
#pragma unroll
        for (int j = 0; j < 4; ++j) { v[j] = xr[64 * j]; s += (v[j][0] * v[j][0] + v[j][1] * v[j][1]) + (v[j][2] * v[j][2] + v[j][3] * v[j][3]); }
        const float rs = rsqrtf(wave_sum(s) * (1.0f / DM) + 1e-6f);
#pragma unroll
        for (int j = 0; j < 4; ++j) { const f32x4 gg = *(const f32x4*)(g + 4 * lane + 256 * j); xr[64 * j] = v[j] * rs * gg; }
    }
}

DI bf16x8 lerp_frag(const bf16_t* cur, const bf16_t* prv, bool hasprev, const float* mu, int act) {
    const u32x4 c = *(const u32x4*)cur; u32x4 q = {0u, 0u, 0u, 0u}; if (hasprev) q = *(const u32x4*)prv;
    const f32x4 m0 = *(const f32x4*)mu, m1 = *(const f32x4*)(mu + 4);
    float z[8];
    const unsigned cw[4] = {c.x, c.y, c.z, c.w}, qw[4] = {q.x, q.y, q.z, q.w};
#pragma unroll
    for (int j = 0; j < 4; ++j) {
        const float c0 = bf_lo(cw[j]), c1 = bf_hi(cw[j]), p0 = bf_lo(qw[j]), p1 = bf_hi(qw[j]);
        const float mA = (j < 2) ? m0[2 * j] : m1[2 * j - 4], mB = (j < 2) ? m0[2 * j + 1] : m1[2 * j - 3];
        z[2 * j] = c0 + (p0 - c0) * mA; z[2 * j + 1] = c1 + (p1 - c1) * mB;
    }
#pragma unroll
    for (int j = 0; j < 8; ++j) {
        if (act == 1) { const float e = __expf(2.0f * z[j]); z[j] = 1.0f - 2.0f / (1.0f + e); }
        else if (act == 2) z[j] = sigmoidf_(z[j]);
    }
    return pack8(z[0], z[1], z[2], z[3], z[4], z[5], z[6], z[7]);
}

DI void rwkv_derived_phase(KP p0, int l, int wv) {
    const int tid_ = otid(wv); const int wave = tid_ >> 6, lane = tid_ & 63, r = lane & 31, hh = lane >> 5;
    for (int job = blockIdx.x * 8 + wave; job < 512 * 8; job += gridDim.x * 8) {
        KP p = okp(); unsigned char* ws = ows(p->ws);
        const bf16_t* RAW = (const bf16_t*)(ws + WS_RAW);
        bf16_t *RZ = (bf16_t*)(ws + WS_RZ), *KP = (bf16_t*)(ws + WS_KP), *VZ = (bf16_t*)(ws + WS_VZ), *KKN = (bf16_t*)(ws + WS_KKN), *Bv = (bf16_t*)(ws + WS_B), *G = (bf16_t*)(ws + WS_G);
        float* W = (float*)(ws + WS_W);
        const bf16_t *LWU = (const bf16_t*)(ws + WS_LWU), *LAU = (const bf16_t*)(ws + WS_LAU), *LGU = (const bf16_t*)(ws + WS_LGU);
        const float* mu = p->in[6] + (size_t)l * RAWC; const float* w0 = p->in[7] + l * 512; const float* a0 = p->in[9] + l * 512;
        const float* k_k = p->in[12] + l * 512; const float* k_a = p->in[13] + l * 512; const float* r_k = p->in[14] + l * 512;
        const int hd = job & 7, tg = job >> 3, t = tg * 32 + r;
        const bool hp = (t & (SEQ - 1)) != 0;
        const bf16_t* cur = RAW + (size_t)t * RAWC; const bf16_t* prv = cur - RAWC;
        float ss = 0.f;
#pragma unroll
        for (int q = 0; q < 8; ++q) {
            const int c = hd * 64 + 8 * q + 4 * hh;
            const u32x2 kc = *(const u32x2*)(cur + 512 + c); u32x2 kq = {0u, 0u}; if (hp) kq = *(const u32x2*)(prv + 512 + c);
            const f32x4 mk = *(const f32x4*)(mu + 512 + c), kkw = *(const f32x4*)(k_k + c);
            const float kcur[4] = {bf_lo(kc.x), bf_hi(kc.x), bf_lo(kc.y), bf_hi(kc.y)}, kprv[4] = {bf_lo(kq.x), bf_hi(kq.x), bf_lo(kq.y), bf_hi(kq.y)};
#pragma unroll
            for (int j = 0; j < 4; ++j) { const float kk = (kcur[j] + (kprv[j] - kcur[j]) * mk[j]) * kkw[j]; ss += kk * kk; }
        }
        ss += __shfl_xor(ss, 32);
        const float inv = 1.0f / fmaxf(sqrtf(ss), 1e-12f);
        float bonus = 0.f;
        {
            bf16x8 bw[4], ba[4];
#pragma unroll
            for (int s = 0; s < 4; ++s) { const int o = 16 * s + 8 * hh; bw[s] = lerp_frag(cur + 1536 + o, prv + 1536 + o, hp, mu + 1536 + o, 1); ba[s] = lerp_frag(cur + 1600 + o, prv + 1600 + o, hp, mu + 1600 + o, 0); }
#pragma unroll 1
            for (int mt = 0; mt < 2; ++mt) {
                const int chr = hd * 64 + 32 * mt + r;
                f32x16 aw, aa;
#pragma unroll
                for (int i = 0; i < 16; ++i) { aw[i] = 0.f; aa[i] = 0.f; }
                {
                    typedef const __attribute__((address_space(1))) bf16x8* GP8;
                    const GP8 pw = (GP8)(LWU + (size_t)chr * 64 + 8 * hh), pa = (GP8)(LAU + (size_t)chr * 64 + 8 * hh);
                    bf16x8 fw[4], fa[4];
#pragma unroll
                    for (int s = 0; s < 4; ++s) { fw[s] = pw[2 * s]; fa[s] = pa[2 * s]; }
                    asm volatile("" ::: "memory");
#pragma unroll
                    for (int s = 0; s < 4; ++s) { aw = MFMA32(fw[s], bw[s], aw); aa = MFMA32(fa[s], ba[s], aa); }
                }
#pragma unroll
                for (int i4 = 0; i4 < 4; ++i4) {
                    const int c = hd * 64 + 32 * mt + 8 * i4 + 4 * hh;
                    const u32x2 rc = *(const u32x2*)(cur + c), kc = *(const u32x2*)(cur + 512 + c), vc = *(const u32x2*)(cur + 1024 + c);
                    u32x2 rp = {0u, 0u}, kq = {0u, 0u}, vp = {0u, 0u};
                    if (hp) { rp = *(const u32x2*)(prv + c); kq = *(const u32x2*)(prv + 512 + c); vp = *(const u32x2*)(prv + 1024 + c); }
                    const f32x4 mr = *(const f32x4*)(mu + c), mk = *(const f32x4*)(mu + 512 + c), mv = *(const f32x4*)(mu + 1024 + c);
                    const f32x4 w0v = *(const f32x4*)(w0 + c), a0v = *(const f32x4*)(a0 + c), kkw = *(const f32x4*)(k_k + c), kaw = *(const f32x4*)(k_a + c), rkw = *(const f32x4*)(r_k + c);
                    const float rcur[4] = {bf_lo(rc.x), bf_hi(rc.x), bf_lo(rc.y), bf_hi(rc.y)}, rprv[4] = {bf_lo(rp.x), bf_hi(rp.x), bf_lo(rp.y), bf_hi(rp.y)};
                    const float kcur[4] = {bf_lo(kc.x), bf_hi(kc.x), bf_lo(kc.y), bf_hi(kc.y)}, kprv[4] = {bf_lo(kq.x), bf_hi(kq.x), bf_lo(kq.y), bf_hi(kq.y)};
                    const float vcur[4] = {bf_lo(vc.x), bf_hi(vc.x), bf_lo(vc.y), bf_hi(vc.y)}, vprv[4] = {bf_lo(vp.x), bf_hi(vp.x), bf_lo(vp.y), bf_hi(vp.y)};
                    f32x4 dec; float rz[4], kp[4], vz[4], kn[4], bb[4];
#pragma unroll
                    for (int j = 0; j < 4; ++j) {
                        const int i = 4 * i4 + j;
                        const float zz = -(w0v[j] + aw[i]);
                        const float sp = (zz > 20.f) ? zz : __logf(1.0f + __expf(zz));
                        const float wv = -sp - 0.5f;
                        dec[j] = __expf(-__expf(wv));
                        const float av = sigmoidf_(a0v[j] + aa[i]);
                        rz[j] = rcur[j] + (rprv[j] - rcur[j]) * mr[j];
                        const float kz = kcur[j] + (kprv[j] - kcur[j]) * mk[j];
                        vz[j] = vcur[j] + (vprv[j] - vcur[j]) * mv[j];
                        kn[j] = kz * kkw[j] * inv; bb[j] = kn[j] * av;
                        kp[j] = kz * (1.0f + (av - 1.0f) * kaw[j]);
                        bonus += rz[j] * kp[j] * rkw[j];
                    }
                    const size_t o = (size_t)t * 512 + c;
                    *(f32x4*)(W + o) = dec;
                    u32x2 w2; w2.x = cvt_pk_bf16(rz[0], rz[1]); w2.y = cvt_pk_bf16(rz[2], rz[3]); *(u32x2*)(RZ + o) = w2;
                    w2.x = cvt_pk_bf16(kp[0], kp[1]); w2.y = cvt_pk_bf16(kp[2], kp[3]); *(u32x2*)(KP + o) = w2;
                    w2.x = cvt_pk_bf16(vz[0], vz[1]); w2.y = cvt_pk_bf16(vz[2], vz[3]); *(u32x2*)(VZ + o) = w2;
                    w2.x = cvt_pk_bf16(kn[0], kn[1]); w2.y = cvt_pk_bf16(kn[2], kn[3]); *(u32x2*)(KKN + o) = w2;
                    w2.x = cvt_pk_bf16(bb[0], bb[1]); w2.y = cvt_pk_bf16(bb[2], bb[3]); *(u32x2*)(Bv + o) = w2;
                }
            }
        }
        bonus += __shfl_xor(bonus, 32);
        int t2 = t; asm volatile("" : "+v"(t2));
        if (hh == 0) ((float*)(ows(ws) + WS_BONUS))[(size_t)t2 * 8 + hd] = bonus;
        {
            bf16x8 bg[8];
#pragma unroll
            for (int s = 0; s < 8; ++s) { const int o = 16 * s + 8 * hh; bg[s] = lerp_frag(cur + 1664 + o, prv + 1664 + o, hp, mu + 1664 + o, 2); }
#pragma unroll 1
            for (int mt = 0; mt < 2; ++mt) {
                const int chr = hd * 64 + 32 * mt + r;
                f32x16 ag;
#pragma unroll
                for (int i = 0; i < 16; ++i) ag[i] = 0.f;
                {
                    typedef const __attribute__((address_space(1))) bf16x8* GP8;
                    const GP8 pg = (GP8)(LGU + (size_t)chr * 128 + 8 * hh);
                    bf16x8 fg[8];
#pragma unroll
                    for (int s = 0; s < 8; ++s) fg[s] = pg[2 * s];
                    asm volatile("" ::: "memory");
#pragma unroll
                    for (int s = 0; s < 8; ++s) ag = MFMA32(fg[s], bg[s], ag);
                }
#pragma unroll
                for (int i4 = 0; i4 < 4; ++i4) {
                    const size_t o = (size_t)t2 * 512 + hd * 64 + 32 * mt + 8 * i4 + 4 * hh;
                    u32x2 w2; w2.x = cvt_pk_bf16(ag[4 * i4], ag[4 * i4 + 1]); w2.y = cvt_pk_bf16(ag[4 * i4 + 2], ag[4 * i4 + 3]); *(u32x2*)(G + o) = w2;
                }
            }
        }
    }
}

constexpr int SC_T = 32, SC_STEP = 1344, SC_BUF = SC_T * SC_STEP;
struct ScanRegs { f32x4 w0, w1; u32x4 kn, bb, kp, rz, vv; };
DI void scan_gload(KP p, ScanRegs& R, int b, int h, int rg, int ck, int pt) {
    const unsigned char* ws = ows(p->ws);
    const size_t tok0 = (size_t)b * SEQ + (size_t)ck * SC_T;
    { const int st = pt >> 4, sub = pt & 15; R.w0 = *(const f32x4*)((const float*)(ws + WS_W) + (tok0 + st) * 512 + h * 64 + 4 * sub); }
    { const int pp = pt + 256, st = pp >> 4, sub = pp & 15; R.w1 = *(const f32x4*)((const float*)(ws + WS_W) + (tok0 + st) * 512 + h * 64 + 4 * sub); }
    const int st = pt >> 3, sub = pt & 7; const size_t go = (tok0 + st) * 512 + h * 64 + 8 * sub;
    R.kn = *(const u32x4*)((const bf16_t*)(ws + WS_KKN) + go); R.bb = *(const u32x4*)((const bf16_t*)(ws + WS_B) + go);
    R.kp = *(const u32x4*)((const bf16_t*)(ws + WS_KP) + go); R.rz = *(const u32x4*)((const bf16_t*)(ws + WS_RZ) + go);
    R.vv = (u32x4){0u, 0u, 0u, 0u};
    if (pt < 64) { const int s2 = pt >> 1, hf = pt & 1; R.vv = *(const u32x4*)((const bf16_t*)(ws + WS_VZ) + (tok0 + s2) * 512 + h * 64 + rg * 16 + 8 * hf); }
}
DI void scan_write(const ScanRegs& R, LAS unsigned char* buf, int pt) {
    { const int st = pt >> 4, sub = pt & 15; *(LAS f32x4*)(buf + st * SC_STEP + sub * 16) = R.w0; }
    { const int pp = pt + 256, st = pp >> 4, sub = pp & 15; *(LAS f32x4*)(buf + st * SC_STEP + sub * 16) = R.w1; }
    const int st = pt >> 3, sub = pt & 7;
    const u32x4 kn = R.kn, bb = R.bb, kp = R.kp, rz = R.rz;
    LAS unsigned char* d = buf + st * SC_STEP + sub * 32;
    *(LAS f32x4*)(d + 256) = (f32x4){-bf_lo(kn.x), -bf_hi(kn.x), -bf_lo(kn.y), -bf_hi(kn.y)}; *(LAS f32x4*)(d + 256 + 16) = (f32x4){-bf_lo(kn.z), -bf_hi(kn.z), -bf_lo(kn.w), -bf_hi(kn.w)};
    *(LAS f32x4*)(d + 512) = (f32x4){bf_lo(bb.x), bf_hi(bb.x), bf_lo(bb.y), bf_hi(bb.y)}; *(LAS f32x4*)(d + 512 + 16) = (f32x4){bf_lo(bb.z), bf_hi(bb.z), bf_lo(bb.w), bf_hi(bb.w)};
    *(LAS f32x4*)(d + 768) = (f32x4){bf_lo(kp.x), bf_hi(kp.x), bf_lo(kp.y), bf_hi(kp.y)}; *(LAS f32x4*)(d + 768 + 16) = (f32x4){bf_lo(kp.z), bf_hi(kp.z), bf_lo(kp.w), bf_hi(kp.w)};
    *(LAS f32x4*)(d + 1024) = (f32x4){bf_lo(rz.x), bf_hi(rz.x), bf_lo(rz.y), bf_hi(rz.y)}; *(LAS f32x4*)(d + 1024 + 16) = (f32x4){bf_lo(rz.z), bf_hi(rz.z), bf_lo(rz.w), bf_hi(rz.w)};
    if (pt < 64) { const int s2 = pt >> 1, hf = pt & 1; const u32x4 vv = R.vv;
        LAS unsigned char* dv = buf + s2 * SC_STEP + 1280 + hf * 32;
        *(LAS f32x4*)dv = (f32x4){bf_lo(vv.x), bf_hi(vv.x), bf_lo(vv.y), bf_hi(vv.y)}; *(LAS f32x4*)(dv + 16) = (f32x4){bf_lo(vv.z), bf_hi(vv.z), bf_lo(vv.w), bf_hi(vv.w)}; }
}
DI void rwkv_scan_phase(KP p, LAS unsigned char* lds, int wv) {
    const int tid = otid(wv), wave = tid >> 6, lane = tid & 63;
    float* YRAW = (float*)(p->ws + WS_YRAW);
    for (int job = blockIdx.x; job < 128; job += gridDim.x) {
        const int chain = job >> 2, rg = job & 3, b = chain >> 3, h = chain & 7;
        __syncthreads();
        ScanRegs R0, R1;
        if (wave >= 4) { scan_gload(p, R0, b, h, rg, 0, tid - 256); scan_write(R0, lds, tid - 256); scan_gload(p, R0, b, h, rg, 1, tid - 256); scan_gload(p, R1, b, h, rg, 2, tid - 256); }
        __syncthreads();
        f32x4 S = {0.f, 0.f, 0.f, 0.f};
        const int jl = lane & 15, rl = 4 * (wave & 3) + (lane >> 4);
        for (int ck2 = 0; ck2 < SEQ / SC_T; ck2 += 2) {
#pragma unroll
            for (int half = 0; half < 2; ++half) {
                const int ck = ck2 + half;
                LAS unsigned char* cb = lds + (ck & 1) * SC_BUF;
                if (wave >= 4) {
                    if (ck + 1 < SEQ / SC_T) {
                        if (half == 0) { scan_write(R0, lds + ((ck + 1) & 1) * SC_BUF, tid - 256); if (ck + 3 < SEQ / SC_T) scan_gload(p, R0, b, h, rg, ck + 3, tid - 256); }
                        else           { scan_write(R1, lds + ((ck + 1) & 1) * SC_BUF, tid - 256); if (ck + 3 < SEQ / SC_T) scan_gload(p, R1, b, h, rg, ck + 3, tid - 256); }
                    }
                } else {
                    float* yo = YRAW + ((size_t)b * SEQ + (size_t)ck * SC_T + jl) * 512 + h * 64 + rg * 16 + rl;
                    const LAS unsigned char* sb = cb + jl * 16; const LAS unsigned char* vb = cb + 1280 + rl * 4;
                    f32x4 w4 = *(const LAS f32x4*)sb, an = *(const LAS f32x4*)(sb + 256), b4 = *(const LAS f32x4*)(sb + 512), k4 = *(const LAS f32x4*)(sb + 768), r4 = *(const LAS f32x4*)(sb + 1024);
                    float vi = *(const LAS float*)vb;
                    float ysel = 0.f;
#pragma unroll
                    for (int s = 0; s < SC_T; ++s) {
                        f32x4 w4n = w4, ann = an, b4n = b4, k4n = k4, r4n = r4; float vin = vi;
                        if (s + 1 < SC_T) {
                            const LAS unsigned char* sn = sb + (s + 1) * SC_STEP;
                            w4n = *(const LAS f32x4*)sn; ann = *(const LAS f32x4*)(sn + 256); b4n = *(const LAS f32x4*)(sn + 512); k4n = *(const LAS f32x4*)(sn + 768); r4n = *(const LAS f32x4*)(sn + 1024);
                            vin = *(const LAS float*)(vb + (s + 1) * SC_STEP);
                        }
                        float sa = (S[0] * an[0] + S[1] * an[1]) + (S[2] * an[2] + S[3] * an[3]);
                        sa = row16_sum(sa);
                        S = S * w4 + (b4 * sa + k4 * vi);
                        float y = (S[0] * r4[0] + S[1] * r4[1]) + (S[2] * r4[2] + S[3] * r4[3]);
                        y = row16_sum(y);
                        ysel = (jl == (s & 15)) ? y : ysel;
                        if ((s & 15) == 15) yo[(size_t)(s - 15) * 512] = ysel;
                        w4 = w4n; an = ann; b4 = b4n; k4 = k4n; r4 = r4n; vi = vin;
                    }
                }
                __syncthreads();
            }
        }
    }
}

DI void rwkv_post_phase(KP p, int l, int wv) {
    const unsigned char* ws = ows(p->ws);
    const float* YRAW = (const float*)(ws + WS_YRAW); const bf16_t* VZ = (const bf16_t*)(ws + WS_VZ); const bf16_t* G = (const bf16_t*)(ws + WS_G);
    const float* BONUS = (const float*)(ws + WS_BONUS); bf16_t* YS = (bf16_t*)(p->ws + WS_YSR);
    const float* gnw = p->in[15] + l * 512; const float* gnb = p->in[16] + l * 512;
    const int tid_ = otid(wv); const int wave = tid_ >> 6, lane = tid_ & 63, c = 8 * lane;
    const f32x4 gw0 = *(const f32x4*)(gnw + c), gw1 = *(const f32x4*)(gnw + c + 4), gb0 = *(const f32x4*)(gnb + c), gb1 = *(const f32x4*)(gnb + c + 4);
    for (int t = blockIdx.x * 8 + wave; t < MTOK; t += gridDim.x * 8) {
        const size_t o = (size_t)t * 512 + c;
        const f32x4 y0 = *(const f32x4*)(YRAW + o), y1 = *(const f32x4*)(YRAW + o + 4);
        float s = (y0[0] + y0[1]) + (y0[2] + y0[3]) + (y1[0] + y1[1]) + (y1[2] + y1[3]);
        s += __shfl_xor(s, 1); s += __shfl_xor(s, 2); s += __shfl_xor(s, 4);
        const float mean = s * (1.0f / 64.0f);
        const f32x4 d0 = y0 - mean, d1 = y1 - mean;
        float q = (d0[0] * d0[0] + d0[1] * d0[1]) + (d0[2] * d0[2] + d0[3] * d0[3]) + (d1[0] * d1[0] + d1[1] * d1[1]) + (d1[2] * d1[2] + d1[3] * d1[3]);
        q += __shfl_xor(q, 1); q += __shfl_xor(q, 2); q += __shfl_xor(q, 4);
        const float rstd = rsqrtf(q * (1.0f / 64.0f) + 64e-5f);
        const float bon = BONUS[(size_t)t * 8 + (lane >> 3)];
        const u32x4 vv = *(const u32x4*)(VZ + o), gg = *(const u32x4*)(G + o);
        const f32x4 v0 = {bf_lo(vv.x), bf_hi(vv.x), bf_lo(vv.y), bf_hi(vv.y)}, v1 = {bf_lo(vv.z), bf_hi(vv.z), bf_lo(vv.w), bf_hi(vv.w)};
        const f32x4 g0 = {bf_lo(gg.x), bf_hi(gg.x), bf_lo(gg.y), bf_hi(gg.y)}, g1 = {bf_lo(gg.z), bf_hi(gg.z), bf_lo(gg.w), bf_hi(gg.w)};
        const f32x4 r0 = (d0 * rstd * gw0 + gb0 + v0 * bon) * g0, r1 = (d1 * rstd * gw1 + gb1 + v1 * bon) * g1;
        u32x4 w; w.x = cvt_pk_bf16(r0[0], r0[1]); w.y = cvt_pk_bf16(r0[2], r0[3]); w.z = cvt_pk_bf16(r1[0], r1[1]); w.w = cvt_pk_bf16(r1[2], r1[3]);
        *(u32x4*)(YS + o) = w;
    }
}

DI void attn_job(const bf16_t* Q, const bf16_t* K, const bf16_t* V, bf16_t* YS, float* LSE, LAS unsigned char* vl, int b, int h, int d, int rho, int J0, bool first, int lane) {
    asm volatile("" : "+v"(lane));
    const int r = lane & 31, hh = lane >> 5;
    const size_t tokq = (size_t)b * SEQ + (size_t)(J0 + r) * d + rho;
    typedef const __attribute__((address_space(1))) bf16x8* GP8;
    typedef const __attribute__((address_space(1))) u32x4* GP4;
    bf16x8 bq[4];
    { const GP8 qp = (GP8)(Q + tokq * 512 + h * 64 + 8 * hh);
#pragma unroll
      for (int s = 0; s < 4; ++s) bq[s] = qp[2 * s]; }
    bf16x8 ak[5][4];
#pragma unroll
    for (int kt = 0; kt < 5; ++kt) {
        const int Jk = J0 - 128 + 32 * kt + r;
        const size_t tokk = (size_t)b * SEQ + (size_t)(Jk >= 0 ? Jk : 0) * d + rho;
        const GP8 kp = (GP8)(K + tokk * 512 + h * 64 + 8 * hh);
#pragma unroll
        for (int s = 0; s < 4; ++s) ak[kt][s] = kp[2 * s];
    }
    asm volatile("" ::: "memory");
    f32x16 sc[5];
#pragma unroll
    for (int kt = 0; kt < 5; ++kt) {
        const bool valid = (J0 - 128 + 32 * kt + r) >= 0;
        f32x16 a;
#pragma unroll
        for (int i = 0; i < 16; ++i) a[i] = 0.f;
#pragma unroll
        for (int s = 0; s < 4; ++s) {
            bf16x8 kf = ak[kt][s];
            if (!valid) kf = (bf16x8){0, 0, 0, 0, 0, 0, 0, 0};
            a = MFMA32(kf, bq[s], a);
        }
        sc[kt] = a;
    }
    float m = -1e30f;
#pragma unroll
    for (int kt = 0; kt < 5; ++kt)
#pragma unroll
        for (int i = 0; i < 16; ++i) {
            const int kidx = 32 * kt + crow(i, hh); const int dist = 128 + r - kidx;
            const bool ok = (dist >= 0) && (dist <= 128) && (J0 - 128 + kidx >= 0);
            const float v = ok ? sc[kt][i] * 0.125f : -1e30f;
            sc[kt][i] = v; m = fmaxf(m, v);
        }
    m = fmaxf(m, __shfl_xor(m, 32));
    float lsum = 0.f;
#pragma unroll
    for (int kt = 0; kt < 5; ++kt)
#pragma unroll
        for (int i = 0; i < 16; ++i) { const float pv = __expf(sc[kt][i] - m); sc[kt][i] = pv; lsum += pv; }
    lsum += __shfl_xor(lsum, 32);
    const float lse = m + __logf(lsum);
    f32x16 o[2];
#pragma unroll
    for (int i = 0; i < 16; ++i) { o[0][i] = 0.f; o[1][i] = 0.f; }
    u32x4 vr[4];
    {
        const int key = lane >> 1, hf = lane & 1; const int Jk = J0 - 128 + key;
        const size_t tokv = (size_t)b * SEQ + (size_t)(Jk >= 0 ? Jk : 0) * d + rho;
        const GP4 src = (GP4)(V + tokv * 512 + h * 64 + 32 * hf);
        vr[0] = src[0]; vr[1] = src[1]; vr[2] = src[2]; vr[3] = src[3];
    }
#pragma unroll
    for (int kt = 0; kt < 5; ++kt) {
        {
            const int key = lane >> 1, hf = lane & 1;
            LAS u32x4* dst = (LAS u32x4*)(vl + key * 128 + hf * 64);
            dst[0] = vr[0]; dst[1] = vr[1]; dst[2] = vr[2]; dst[3] = vr[3];
            if (kt + 1 < 5) {
                const int Jk = J0 - 128 + 32 * (kt + 1) + key;
                const size_t tokv = (size_t)b * SEQ + (size_t)(Jk >= 0 ? Jk : 0) * d + rho;
                const GP4 src = (GP4)(V + tokv * 512 + h * 64 + 32 * hf);
                vr[0] = src[0]; vr[1] = src[1]; vr[2] = src[2]; vr[3] = src[3];
            }
        }
        LDS_WAIT();
#pragma unroll
        for (int s = 0; s < 2; ++s) {
            const bf16x8 xs = pack8(sc[kt][8 * s], sc[kt][8 * s + 1], sc[kt][8 * s + 2], sc[kt][8 * s + 3], sc[kt][8 * s + 4], sc[kt][8 * s + 5], sc[kt][8 * s + 6], sc[kt][8 * s + 7]);
#pragma unroll
            for (int mt = 0; mt < 2; ++mt) {
                bf16x8 pa;
#pragma unroll
                for (int j = 0; j < 8; ++j) { const int key = 16 * s + 8 * (j >> 2) + 4 * hh + (j & 3); pa[j] = (short)*(const LAS bf16_t*)(vl + key * 128 + (r + 32 * mt) * 2); }
                o[mt] = MFMA32(pa, xs, o[mt]);
            }
        }
        LDS_WAIT();
    }
    const float il = 1.0f / lsum;
    float wp = 0.f, wc = 1.0f, nl = lse;
    if (!first) { const float lp = LSE[tokq * 8 + h]; const float mx = fmaxf(lp, lse); const float ep = __expf(lp - mx), ec = __expf(lse - mx); nl = mx + __logf(ep + ec); wp = ep / (ep + ec); wc = ec / (ep + ec); }
#pragma unroll
    for (int mt = 0; mt < 2; ++mt)
#pragma unroll
        for (int g4 = 0; g4 < 4; ++g4) {
            bf16_t* dst = YS + tokq * 512 + h * 64 + 32 * mt + 8 * g4 + 4 * hh;
            float v[4];
#pragma unroll
            for (int j = 0; j < 4; ++j) v[j] = o[mt][4 * g4 + j] * il * wc;
            if (!first) { const u32x2 pw = *(const u32x2*)dst; v[0] += bf_lo(pw.x) * wp; v[1] += bf_hi(pw.x) * wp; v[2] += bf_lo(pw.y) * wp; v[3] += bf_hi(pw.y) * wp; }
            u32x2 w2; w2.x = cvt_pk_bf16(v[0], v[1]); w2.y = cvt_pk_bf16(v[2], v[3]); *(u32x2*)dst = w2;
        }
    if (hh == 0) LSE[tokq * 8 + h] = nl;
}

DI void attention_phase(KP p, LAS unsigned char* lds, int wv) {
    unsigned char* ws = ows(p->ws);
    const bf16_t *Q = (const bf16_t*)(ws + WS_Q), *K = (const bf16_t*)(ws + WS_K), *V = (const bf16_t*)(ws + WS_V);
    bf16_t* YS = (bf16_t*)(ws + WS_YSA); float* LSE = (float*)(ws + WS_LSE);
    const int tid_ = otid(wv); const int wave = tid_ >> 6, lane = tid_ & 63;
    LAS unsigned char* vl = lds + wave * 4096;
    for (int item = blockIdx.x; item < 256; item += gridDim.x) {
        const int b = item >> 6, h = (item >> 3) & 7, qb = item & 7, P0 = qb * 512;
#pragma unroll 1
        for (int cfg = 0; cfg < 3; ++cfg) {
#pragma unroll 1
            for (int jj = wave; jj < 16; jj += 8) {
                int d, rho, J0;
                if (cfg == 0) { d = 1; rho = 0; J0 = P0 + 32 * jj; }
                else if (cfg == 1) { d = 4; rho = jj & 3; J0 = (P0 >> 2) + 32 * (jj >> 2); }
                else { d = 16; rho = jj; J0 = P0 >> 4; }
                attn_job(Q, K, V, YS, LSE, vl, b, h, d, rho, J0, cfg == 0, lane);
            }
            asm volatile("s_waitcnt vmcnt(0)" ::: "memory");
            __syncthreads();
        }
    }
}

DI void gmlp_phase(KP p, int l, LAS unsigned char* lds, int wv) {
    unsigned char* ws = ows(p->ws);
    const bf16_t* UV = (const bf16_t*)(ws + WS_UV); bf16_t* YS = (bf16_t*)(ws + WS_YSG);
    const float* lng = p->in[17] + l * 512; const float* lnb = p->in[18] + l * 512;
    const float* wsp = p->in[19] + (size_t)l * 8 * 128 * 128; const float* bsp = p->in[20] + (size_t)l * 8 * 128;
    const int tid_ = otid(wv); const int wave = tid_ >> 6, lane = tid_ & 63, r = lane & 31, hh = lane >> 5;
    LAS float* stats = (LAS float*)(lds + 8 * 17408);
    LAS bf16_t* VT = (LAS bf16_t*)(lds + wave * 17408);
    for (int item = blockIdx.x; item < 256; item += gridDim.x) {
        const size_t tok0 = (size_t)(item >> 1) * 128;
        __syncthreads();
        for (int tt = 0; tt < 16; ++tt) {
            const int tl = wave * 16 + tt;
            const u32x4 x = *(const u32x4*)(UV + (tok0 + tl) * 1024 + 512 + 8 * lane);
            const float f[8] = {bf_lo(x.x), bf_hi(x.x), bf_lo(x.y), bf_hi(x.y), bf_lo(x.z), bf_hi(x.z), bf_lo(x.w), bf_hi(x.w)};
            float s = 0.f;
#pragma unroll
            for (int j = 0; j < 8; ++j) s += f[j];
            const float mean = wave_sum(s) * (1.0f / 512.0f); float q = 0.f;
#pragma unroll
            for (int j = 0; j < 8; ++j) { const float dd = f[j] - mean; q += dd * dd; }
            const float rstd = rsqrtf(wave_sum(q) * (1.0f / 512.0f) + 1e-5f);
            if (lane == 0) { stats[2 * tl] = mean; stats[2 * tl + 1] = rstd; }
        }
        __syncthreads();
        const int g = (item & 1) * 4 + (wave & 3);
        if (wave < 4) {
        {
            const int d0 = 8 * (lane & 7);
            const f32x4 lg0 = *(const f32x4*)(lng + g * 64 + d0), lg1 = *(const f32x4*)(lng + g * 64 + d0 + 4), lb0 = *(const f32x4*)(lnb + g * 64 + d0), lb1 = *(const f32x4*)(lnb + g * 64 + d0 + 4);
            for (int it = 0; it < 16; ++it) {
                const int tl = it * 8 + (lane >> 3);
                const u32x4 x = *(const u32x4*)(UV + (tok0 + tl) * 1024 + 512 + g * 64 + d0);
                const float mean = stats[2 * tl], rstd = stats[2 * tl + 1];
                const float f[8] = {bf_lo(x.x), bf_hi(x.x), bf_lo(x.y), bf_hi(x.y), bf_lo(x.z), bf_hi(x.z), bf_lo(x.w), bf_hi(x.w)};
#pragma unroll
                for (int e = 0; e < 8; ++e) {
                    const float gg = e < 4 ? lg0[e & 3] : lg1[e & 3], bb = e < 4 ? lb0[e & 3] : lb1[e & 3];
                    const float y = (f[e] - mean) * rstd * gg + bb;
                    VT[(d0 + e) * 136 + tl] = (bf16_t)(cvt_pk_bf16(y, 0.f) & 0xffffu);
                }
            }
        }
        LDS_WAIT();
#pragma unroll 1
        for (int nt = 0; nt < 4; ++nt) {
            f32x16 acc[2];
#pragma unroll
            for (int i = 0; i < 16; ++i) { acc[0][i] = 0.f; acc[1][i] = 0.f; }
            const int irow = 32 * nt + r;
            for (int s = 0; s < 2 * (nt + 1); ++s) {
                const int j0 = 16 * s + 8 * hh;
                const float* wr_ = wsp + ((size_t)g * 128 + irow) * 128 + j0;
                const f32x4 wa = *(const f32x4*)wr_, wb = *(const f32x4*)(wr_ + 4);
                float wv[8] = {wa[0], wa[1], wa[2], wa[3], wb[0], wb[1], wb[2], wb[3]};
#pragma unroll
                for (int j = 0; j < 8; ++j) if (j0 + j > irow) wv[j] = 0.f;
                const bf16x8 bfr = pack8(wv[0], wv[1], wv[2], wv[3], wv[4], wv[5], wv[6], wv[7]);
#pragma unroll
                for (int mt = 0; mt < 2; ++mt) {
                    const bf16x8 afr = *(const LAS bf16x8*)(VT + (32 * mt + r) * 136 + j0);
                    acc[mt] = MFMA32(afr, bfr, acc[mt]);
                }
            }
            const size_t tok = tok0 + irow; const float bs = bsp[g * 128 + irow];
#pragma unroll
            for (int mt = 0; mt < 2; ++mt)
#pragma unroll
                for (int g4 = 0; g4 < 4; ++g4) {
                    const int c = g * 64 + 32 * mt + 8 * g4 + 4 * hh;
                    const u32x2 uu = *(const u32x2*)(UV + tok * 1024 + c);
                    const float o0 = bf_lo(uu.x) * (acc[mt][4 * g4] + bs), o1 = bf_hi(uu.x) * (acc[mt][4 * g4 + 1] + bs), o2 = bf_lo(uu.y) * (acc[mt][4 * g4 + 2] + bs), o3 = bf_hi(uu.y) * (acc[mt][4 * g4 + 3] + bs);
                    u32x2 w2; w2.x = cvt_pk_bf16(o0, o1); w2.y = cvt_pk_bf16(o2, o3); *(u32x2*)(YS + tok * 512 + c) = w2;
                }
        }
        }
    }
}

DI void ffn_fix_phase(KP p, int l, int wv) {
    unsigned char* ws = ows(p->ws);
    bf16_t* ACT = (bf16_t*)(ws + WS_UP); const float* SA = (const float*)(ws + WS_SIDEA); const float* SG = (const float*)(ws + WS_SIDEG);
    const float* cw = p->in[25] + (size_t)l * 3 * DFF; const float* cb = p->in[26] + (size_t)l * DFF;
    constexpr int NCG = DFF / 8;
    const int tid_ = otid(wv);
    for (int item = blockIdx.x * 512 + tid_; item < 256 * 2 * NCG; item += gridDim.x * 512) {
        const int cgi = item % NCG, qe = item / NCG, q = qe >> 1, e = qe & 1, f = 8 * cgi;
        const bool first = (q & 63) == 0;
        float o[8];
#pragma unroll
        for (int hf = 0; hf < 2; ++hf) {
            const int ff = f + 4 * hf;
            const f32x4 at = *(const f32x4*)(SA + ((size_t)q * 4 + e) * DFF + ff);
            f32x4 t1 = {0.f, 0.f, 0.f, 0.f}, t2 = {0.f, 0.f, 0.f, 0.f};
            if (e == 1) t1 = *(const f32x4*)(SA + ((size_t)q * 4 + 0) * DFF + ff);
            else if (!first) t1 = *(const f32x4*)(SA + ((size_t)(q - 1) * 4 + 3) * DFF + ff);
            if (!first) t2 = *(const f32x4*)(SA + ((size_t)(q - 1) * 4 + (e == 1 ? 3 : 2)) * DFF + ff);
            const f32x4 g = *(const f32x4*)(SG + ((size_t)q * 2 + e) * DFF + ff);
            const f32x4 w0 = *(const f32x4*)(cw + ff), w1 = *(const f32x4*)(cw + DFF + ff), w2 = *(const f32x4*)(cw + 2 * DFF + ff), bb = *(const f32x4*)(cb + ff);
            const f32x4 c = bb + w0 * t2 + w1 * t1 + w2 * at;
#pragma unroll
            for (int j = 0; j < 4; ++j) o[4 * hf + j] = gelu_tanh(c[j]) * g[j];
        }
        u32x4 w; w.x = cvt_pk_bf16(o[0], o[1]); w.y = cvt_pk_bf16(o[2], o[3]); w.z = cvt_pk_bf16(o[4], o[5]); w.w = cvt_pk_bf16(o[6], o[7]);
        *(u32x4*)(ACT + (size_t)(64 * q + e) * DFF + f) = w;
    }
}

__global__ void __launch_bounds__(512) fwd_megakernel(Params p_unused) {
    extern __shared__ __attribute__((aligned(16))) unsigned char lds_raw[];
    LAS unsigned char* lds = (LAS unsigned char*)lds_raw;
    cg::grid_group grid = cg::this_grid();
    KP p = okp();
    unsigned char* ws = p->ws;
    const int G = gridDim.x, c = blockIdx.x;
    const int wv = __builtin_amdgcn_readfirstlane((int)(threadIdx.x >> 6));
    pg8::Epi E; pg8::TileOrder S; pg8::Gemm g;

    unsigned* bar = (unsigned*)(ws + WS_BAR);
    volatile LAS unsigned* xst = (volatile LAS unsigned*)(lds + LDS_BYTES - 16);
    const unsigned myx = xb_xcc_id();
    if (otid(wv) == 0) { xb_add(&bar[XB_CNT(myx)], 1u); __builtin_amdgcn_fence(__ATOMIC_RELEASE, "agent"); }
    grid.sync();
    if (otid(wv) == 0) {
        unsigned mine = 0u, cnt = 0u;
#pragma unroll
        for (unsigned j = 0; j < 8; ++j) { const unsigned c = xb_ld(&bar[XB_CNT(j)]); cnt += (c > 0u) ? 1u : 0u; mine = (j == myx) ? c : mine; }
        xst[0] = mine > 0u ? mine : 1u; xst[1] = cnt > 0u ? cnt : 1u; xst[2] = myx;
    }
    __syncthreads();
    phase0(p, lds, wv);
    gbar(bar, xst, wv);
#pragma unroll 1
    for (int st = 0; st < 2 * 12; ++st) {
        const int l = st / 12, step = st % 12;
        p = okp(); ws = ows(p->ws);
        const float* mod = (const float*)(ws + WS_MOD); const bf16_t* H = (const bf16_t*)(ws + WS_H);
        const float* ml = mod + (size_t)l * 4 * 6144;
        const float* xin = (l == 0) ? p->in[0] : p->out;
        bool do_gemm = false;
        E = pg8::Epi{}; g.merge = 0; g.ws = ws;
        if (step == 0) {
            if (l > 0) convert_weights(p, l, lds, wv);
            norm_mod_phase(xin, p->in[4] + l * DM, ml + 0, ml + 1024, (bf16_t*)(ws + WS_H), wv);
        } else if (step == 1 || step == 4) {
            if (step == 4) rwkv_post_phase(p, l, wv);
            E.mode = pg8::EM_INPROJ; E.o0 = (bf16_t*)(ws + WS_Q); E.o1 = (bf16_t*)(ws + WS_K); E.o2 = (bf16_t*)(ws + WS_V); E.o3 = (bf16_t*)(ws + WS_RAW); E.o4 = (bf16_t*)(ws + WS_UV);
            E.ropec = (const float*)(ws + WS_ROPEC); E.ropes = (const float*)(ws + WS_ROPES);
            g.A = H; g.Bt = (const bf16_t*)(ws + WS_WIN); g.lda = 1024; g.K = 1024;
            if (step == 1) S.init(64, 7, G, c, 7, 6, 0); else S.init(64, 10, G, c, 6, 0, 13);
            do_gemm = true;
        } else if (step == 2) { rwkv_derived_phase(p, l, wv); }
        else if (step == 3) { rwkv_scan_phase(p, lds, wv); }
        else if (step == 5) { attention_phase(p, lds, wv); gmlp_phase(p, l, lds, wv); }
        else if (step == 6) {
            E.mode = pg8::EM_MERGE; E.o0 = (bf16_t*)(ws + WS_GATE); E.o1 = (bf16_t*)(ws + WS_MB);
            g.merge = 1; g.A = H; g.Bt = (const bf16_t*)(ws + WS_WIN); g.lda = 1024; g.K = 1024;
            S.init(64, 4, G, c, 4, 0, 0, 6);
            do_gemm = true;
        } else if (step == 7) {
            E.mode = pg8::EM_RESID; E.f0 = p->out; E.f1 = xin; E.f2 = ml + 2048;
            g.A = (const bf16_t*)(ws + WS_MB); g.Bt = (const bf16_t*)(ws + WS_WOUT); g.lda = 1024; g.K = 1024;
            S.init(64, 4, G, c, 4, 0, 0); do_gemm = true;
        } else if (step == 8) { norm_mod_phase(p->out, p->in[23] + l * DM, ml + 3072, ml + 4096, (bf16_t*)(ws + WS_H), wv); }
        else if (step == 9) {
            E.mode = pg8::EM_UP; E.o0 = (bf16_t*)(ws + WS_UP); E.f0 = (float*)(ws + WS_SIDEA); E.f3 = (float*)(ws + WS_SIDEG); E.f1 = p->in[25] + (size_t)l * 3 * DFF; E.f2 = p->in[26] + (size_t)l * DFF;
            g.A = H; g.Bt = (const bf16_t*)(ws + WS_WUP); g.lda = 1024; g.K = 1024;
            S.init(64, 22, G, c, 22, 0, 0); do_gemm = true;
        } else if (step == 10) { ffn_fix_phase(p, l, wv); }
        else {
            E.mode = pg8::EM_RESID; E.f0 = p->out; E.f1 = p->out; E.f2 = ml + 5120;
            g.A = (const bf16_t*)(ws + WS_UP); g.Bt = (const bf16_t*)(ws + WS_WDN); g.lda = DFF; g.K = DFF;
            S.init(64, 4, G, c, 4, 0, 0); do_gemm = true;
        }
        if (do_gemm) pg8::gemm_phase(lds, g, S, E, wv);
        gbar((unsigned*)(ws + WS_BAR), xst, wv);
    }
    p = okp();
    final_norm_phase(p->out, p->in[28], wv);
}

extern "C" void kernel_launch(void* const* d_in, const int* in_sizes, int n_in, void* d_out, int out_size, void* d_ws, size_t ws_size, hipStream_t stream) {
    static int grid_blocks = 0;
    if (grid_blocks == 0) {
        int dev = 0, cus = 0, per_cu = 0;
        hipGetDevice(&dev);
        hipDeviceGetAttribute(&cus, hipDeviceAttributeMultiprocessorCount, dev);
        if (hipFuncSetAttribute((const void*)fwd_megakernel, hipFuncAttributeMaxDynamicSharedMemorySize, LDS_BYTES) != hipSuccess) { fprintf(stderr, "hipFuncSetAttribute failed\n"); }
        hipOccupancyMaxActiveBlocksPerMultiprocessor(&per_cu, (const void*)fwd_megakernel, 512, LDS_BYTES);
        if (per_cu < 1) { fprintf(stderr, "occupancy query returned %d\n", per_cu); per_cu = 1; }
        if (per_cu > 1) per_cu = 1;
        grid_blocks = cus * per_cu;
        (void)hipGetLastError();
    }
    if (n_in != 29 || ws_size < 256 * MiB) { fprintf(stderr, "unexpected inputs/workspace\n"); return; }
    (void)hipMemsetAsync((unsigned char*)d_ws + WS_BAR, 0, XB_WORDS * 4, stream);
    Params p{};
    for (int i = 0; i < 29; ++i) p.in[i] = (const float*)d_in[i];
    p.out = (float*)d_out; p.ws = (unsigned char*)d_ws;
    void* args[] = {&p};
    hipError_t e = hipLaunchCooperativeKernel((const void*)fwd_megakernel, dim3(grid_blocks), dim3(512), args, LDS_BYTES, stream);
    if (e != hipSuccess) fprintf(stderr, "cooperative launch failed: %s (grid %d)\n", hipGetErrorString(e), grid_blocks);
}
```

```cpp
#include <hip/hip_runtime.h>
#include <hip/hip_cooperative_groups.h>
#include <cstdio>
#include <cstdint>
namespace cg = cooperative_groups;

#define LAS __attribute__((address_space(3)))
#define DI __device__ __forceinline__
typedef unsigned short bf16_t;
typedef short bf16x8 __attribute__((ext_vector_type(8)));
typedef float f32x4 __attribute__((ext_vector_type(4)));
typedef float f32x16 __attribute__((ext_vector_type(16)));
typedef unsigned u32x4 __attribute__((ext_vector_type(4)));
typedef unsigned u32x2 __attribute__((ext_vector_type(2)));

constexpr int DM = 1024, SEQ = 4096, MTOK = 16384, INC = 7424, DFF = 2816, UPC = 5632, RAWC = 1792;
constexpr int LDS_BYTES = 147456;
constexpr size_t MiB = 1048576;
constexpr size_t WS_WIN = 0, WS_WBR = WS_WIN + (size_t)INC * 1024 * 2, WS_WOUT = WS_WBR + 3u * 1024 * 512 * 2, WS_WUP = WS_WOUT + 1024u * 1024 * 2,
                 WS_WDN = WS_WUP + (size_t)UPC * 1024 * 2, WS_LWU = WS_WDN + (size_t)DFF * 1024 * 2, WS_LAU = WS_LWU + 65536, WS_LGU = WS_LAU + 65536;
constexpr size_t WS_H = 37 * MiB;
constexpr size_t WS_SMALL = 69 * MiB, WS_MOD = WS_SMALL, WS_ROPEC = WS_MOD + 262144, WS_ROPES = WS_ROPEC + 524288, WS_BONUS = WS_ROPES + 524288, WS_LSE = WS_BONUS + 524288;
constexpr size_t WS_BAR = WS_LSE + 524288;
constexpr size_t DB = 72 * MiB;
constexpr size_t WS_RAW = DB, WS_RZ = DB + 56 * MiB, WS_KP = DB + 72 * MiB, WS_KKN = DB + 88 * MiB, WS_B = DB + 104 * MiB, WS_W = DB + 120 * MiB, WS_VZ = DB + 152 * MiB, WS_G = DB + 168 * MiB;
constexpr size_t WS_YRAW = DB, WS_YSR = DB + 32 * MiB;
constexpr size_t WS_Q = DB + 56 * MiB, WS_K = DB + 72 * MiB, WS_V = DB + 88 * MiB, WS_UV = DB + 104 * MiB;
constexpr size_t WS_YSA = DB + 152 * MiB, WS_YSG = DB + 168 * MiB;
constexpr size_t WS_GATE = DB, WS_M32 = DB + 48 * MiB, WS_MB = DB + 112 * MiB;
constexpr size_t WS_UP = DB;
constexpr size_t WS_SIDEA = DB + 88 * MiB, WS_SIDEG = DB + 100 * MiB;
static_assert(WS_LGU + 131072 <= WS_H, "weights region overflow");
static_assert(WS_BAR + 64 * 26 * 4 <= DB, "small region overflow");

struct Params {
    const float* in[29];
    float* out;
    unsigned char* ws;
};

typedef const __attribute__((address_space(4))) Params* KP;
DI KP okp() { unsigned long long k = (unsigned long long)__builtin_amdgcn_kernarg_segment_ptr(); asm volatile("" : "+s"(k)); return (KP)k; }
typedef float f32x2_t __attribute__((ext_vector_type(2)));
typedef __bf16 bf16x2_t __attribute__((ext_vector_type(2)));
DI unsigned cvt_pk_bf16(float lo, float hi) { const f32x2_t v = {lo, hi}; const bf16x2_t r = __builtin_convertvector(v, bf16x2_t); return __builtin_bit_cast(unsigned, r); }
DI float bf_lo(unsigned w) { return __uint_as_float(w << 16); }
DI float bf_hi(unsigned w) { return __uint_as_float(w & 0xffff0000u); }
DI int otid(int wv) { int ln; asm volatile("v_mbcnt_lo_u32_b32 %0, -1, 0\n\tv_mbcnt_hi_u32_b32 %0, -1, %0" : "=v"(ln)); return wv * 64 + ln; }
DI unsigned char* ows(unsigned char* w) { asm volatile("" : "+s"(w)); return w; }
DI float row16_sum(float v) {
    v += __builtin_bit_cast(float, __builtin_amdgcn_update_dpp(0, __builtin_bit_cast(int, v), 0xB1, 0xF, 0xF, false));
    v += __builtin_bit_cast(float, __builtin_amdgcn_update_dpp(0, __builtin_bit_cast(int, v), 0x4E, 0xF, 0xF, false));
    v += __builtin_bit_cast(float, __builtin_amdgcn_update_dpp(0, __builtin_bit_cast(int, v), 0x141, 0xF, 0xF, false));
    v += __builtin_bit_cast(float, __builtin_amdgcn_update_dpp(0, __builtin_bit_cast(int, v), 0x140, 0xF, 0xF, false));
    return v;
}
DI float wave_sum(float v) { v = row16_sum(v); v += __shfl_xor(v, 16); v += __shfl_xor(v, 32); return v; }
#define XB_CNT(j)  (64 * (j))
#define XB_SUB(j)  (64 * (8 + (j)))
#define XB_GEN(j)  (64 * (16 + (j)))
#define XB_TOP     (64 * 24)
#define XB_TOPGEN  (64 * 25)
#define XB_WORDS   (64 * 26)
DI unsigned xb_ld(unsigned* p) { return __hip_atomic_load(p, __ATOMIC_RELAXED, __HIP_MEMORY_SCOPE_AGENT); }
DI unsigned xb_add(unsigned* p, unsigned v) { return __hip_atomic_fetch_add(p, v, __ATOMIC_RELAXED, __HIP_MEMORY_SCOPE_AGENT); }
DI unsigned xb_xcc_id() { return (unsigned)__builtin_amdgcn_s_getreg((3 << 11) | 20) & 0x7u; }
DI void gbar(unsigned* bar, volatile LAS unsigned* st, int wv) {
    asm volatile("s_waitcnt vmcnt(0) lgkmcnt(0)" ::: "memory");
    __syncthreads();
    if (otid(wv) == 0) {
        const unsigned nloc = st[0], nx = st[1], x = st[2];
        const unsigned old = xb_add(&bar[XB_SUB(x)], 1u);
        const unsigned gen = old / nloc;
        if (old + 1u == (gen + 1u) * nloc) {
            __builtin_amdgcn_fence(__ATOMIC_RELEASE, "agent");
            asm volatile("s_waitcnt vmcnt(0)" ::: "memory");
            const unsigned og = xb_add(&bar[XB_TOP], 1u);
            const unsigned tg = og / nx;
            if (og + 1u == (tg + 1u) * nx) xb_add(&bar[XB_TOPGEN], 1u);
            else { while (xb_ld(&bar[XB_TOPGEN]) == tg) __builtin_amdgcn_s_sleep(1); }
            __builtin_amdgcn_fence(__ATOMIC_ACQUIRE, "agent");
            xb_add(&bar[XB_GEN(x)], 1u);
            asm volatile("s_waitcnt vmcnt(0)" ::: "memory");
        } else {
            while (xb_ld(&bar[XB_GEN(x)]) == gen) __builtin_amdgcn_s_sleep(1);
            __builtin_amdgcn_fence(__ATOMIC_ACQUIRE, "agent");
            asm volatile("s_waitcnt vmcnt(0)" ::: "memory");
        }
    }
    asm volatile("" ::: "memory");
    __syncthreads();
}
DI float sigmoidf_(float x) { return __builtin_amdgcn_rcpf(1.0f + __expf(-x)); }
DI float gelu_tanh(float x) { const float u = 1.5957691216f * (x + 0.044715f * x * x * x); return x * __builtin_amdgcn_rcpf(1.0f + __expf(-u)); }
#define LDS_WAIT() asm volatile("s_waitcnt lgkmcnt(0)" ::: "memory")
#define MFMA32(a, b, c) __builtin_amdgcn_mfma_f32_32x32x16_bf16((a), (b), (c), 0, 0, 0)
DI int crow(int reg, int h) { return (reg & 3) + 8 * (reg >> 2) + 4 * h; }
DI bf16x8 pack8(float a0, float a1, float a2, float a3, float a4, float a5, float a6, float a7) {
    u32x4 p; p.x = cvt_pk_bf16(a0, a1); p.y = cvt_pk_bf16(a2, a3); p.z = cvt_pk_bf16(a4, a5); p.w = cvt_pk_bf16(a6, a7);
    return __builtin_bit_cast(bf16x8, p);
}

namespace pg8 {
constexpr int BM = 256, BK = 64, HALF = 128, HTB = HALF * BK * 2, STAGE_BYTES = 8 * HTB, NXCD = 8, WGM = 8;
DI int lds_byte(int r, int c) { const int st = (r >> 4) * 2 + (c >> 5), rr = r & 15, cc = c & 31, ob = rr * 64 + cc * 2; return st * 1024 + (ob ^ (((ob >> 9) & 1) << 5)); }
DI void stage_rc(int b, int& R, int& C) { const int st = b / 1024, sb = b % 1024, swz = sb ^ (((sb >> 9) & 1) << 5); R = (st >> 1) * 16 + swz / 64; C = (st & 1) * 32 + (swz % 64) / 2; }
DI int perm32(int rho) { const int n = rho >> 4, i = rho & 15; return 8 * (i >> 2) + 4 * n + (i & 3); }
struct Unit { int pm, pn, sub; };
struct Gemm { const bf16_t* A; const bf16_t* Bt; int lda, K; int merge; const unsigned char* ws; };
struct TileOrder {
    int nM, nN, nwg, G, c, split, off0, off1, nsub;
    DI void init(int nM_, int nN_, int G_, int c_, int split_, int off0_, int off1_, int nsub_ = 1) { nM = nM_; nN = nN_; nwg = nM * nN; G = G_; c = c_; split = split_; off0 = off0_; off1 = off1_; nsub = nsub_; }
    DI bool next(int i0, Unit& u) const {
        const int i = i0 / nsub; u.sub = i0 - i * nsub;
        const long L = (long)i * G + c; if (L >= nwg) return false;
        int wgid = (int)L; { const int q = nwg / NXCD, r = nwg % NXCD, xcd = wgid % NXCD, off = wgid / NXCD; wgid = (xcd < r ? xcd * (q + 1) : r * (q + 1) + (xcd - r) * q) + off; }
        const int nig = WGM * nN, gid = wgid / nig, fm = gid * WGM, gsz = (nM - fm) < WGM ? (nM - fm) : WGM;
        u.pm = fm + ((wgid % nig) % gsz); const int pnv = (wgid % nig) / gsz; u.pn = pnv < split ? pnv + off0 : pnv - split + off1; return true;
    }
};

enum { EM_INPROJ = 0, EM_GATE = 1, EM_BR_FIRST = 2, EM_BR_MID = 3, EM_BR_LAST = 4, EM_RESID = 5, EM_UP = 6, EM_MERGE = 7 };
struct Epi {
    int mode;
    bf16_t *o0, *o1, *o2, *o3, *o4;
    float* f3;
    float* f0; const float* f1; const float* f2;
    const float *ropec, *ropes;
    DI void up_conv(const f32x4 (&acc)[2][2][4][2], const Unit& u, int wr, int wc, int fr, int fq) const {
        const int f = u.pn * 128 + wc * 32 + 8 * fq;
        const int src1 = (fq << 4) | ((fr + 15) & 15), src2 = (fq << 4) | ((fr + 14) & 15);
        const f32x4 w0a = *(const f32x4*)(f1 + f), w0b = *(const f32x4*)(f1 + f + 4), w1a = *(const f32x4*)(f1 + DFF + f), w1b = *(const f32x4*)(f1 + DFF + f + 4);
        const f32x4 w2a = *(const f32x4*)(f1 + 2 * DFF + f), w2b = *(const f32x4*)(f1 + 2 * DFF + f + 4), cba = *(const f32x4*)(f2 + f), cbb = *(const f32x4*)(f2 + f + 4);
#pragma unroll
        for (int ai = 0; ai < 2; ++ai) {
            const int q = u.pm * 4 + ai * 2 + wr;
            f32x4 p1a_prev = {0.f, 0.f, 0.f, 0.f}, p1b_prev = p1a_prev, p2a_prev = p1a_prev, p2b_prev = p1a_prev;
#pragma unroll
            for (int m = 0; m < 4; ++m) {
                const f32x4 aa = acc[ai][0][m][0], ab = acc[ai][0][m][1], ga = acc[ai][1][m][0], gb = acc[ai][1][m][1];
                f32x4 p1a, p1b, p2a, p2b;
#pragma unroll
                for (int j = 0; j < 4; ++j) {
                    p1a[j] = __shfl(aa[j], src1); p1b[j] = __shfl(ab[j], src1); p2a[j] = __shfl(aa[j], src2); p2b[j] = __shfl(ab[j], src2);
                }
                const f32x4 t1a = fr >= 1 ? p1a : p1a_prev, t1b = fr >= 1 ? p1b : p1b_prev, t2a = fr >= 2 ? p2a : p2a_prev, t2b = fr >= 2 ? p2b : p2b_prev;
                const f32x4 ca = cba + w0a * t2a + w1a * t1a + w2a * aa, cb_ = cbb + w0b * t2b + w1b * t1b + w2b * ab;
                const int row = u.pm * BM + ai * HALF + wr * 64 + m * 16 + fr;
                u32x4 w;
                w.x = cvt_pk_bf16(gelu_tanh(ca[0]) * ga[0], gelu_tanh(ca[1]) * ga[1]); w.y = cvt_pk_bf16(gelu_tanh(ca[2]) * ga[2], gelu_tanh(ca[3]) * ga[3]);
                w.z = cvt_pk_bf16(gelu_tanh(cb_[0]) * gb[0], gelu_tanh(cb_[1]) * gb[1]); w.w = cvt_pk_bf16(gelu_tanh(cb_[2]) * gb[2], gelu_tanh(cb_[3]) * gb[3]);
                *(u32x4*)(o0 + (size_t)row * DFF + f) = w;
                if (m == 0 && fr < 2) {
                    float* sa = f0 + ((size_t)q * 4 + fr) * DFF + f; *(f32x4*)sa = aa; *(f32x4*)(sa + 4) = ab;
                    float* sg = f3 + ((size_t)q * 2 + fr) * DFF + f; *(f32x4*)sg = ga; *(f32x4*)(sg + 4) = gb;
                }
                if (m == 3 && fr >= 14) { float* sa = f0 + ((size_t)q * 4 + 2 + (fr - 14)) * DFF + f; *(f32x4*)sa = aa; *(f32x4*)(sa + 4) = ab; }
                p1a_prev = p1a; p1b_prev = p1b; p2a_prev = p2a; p2b_prev = p2b;
            }
        }
    }
    DI void operator()(const f32x4 (&acc)[2][2][4][2], const Unit& u, int wr, int wc, int fr, int fq) const {
        if (mode == EM_UP) { up_conv(acc, u, wr, wc, fr, fq); return; }
        const int mode = (this->mode == EM_MERGE) ? (((u.sub & 1) == 0) ? (int)EM_GATE : ((u.sub >> 1) == 0 ? (int)EM_BR_FIRST : ((u.sub >> 1) == 1 ? (int)EM_BR_MID : (int)EM_BR_LAST))) : this->mode;
        const int row0 = u.pm * BM + wr * 64 + fr, colb = u.pn * BM + wc * 32 + 8 * fq;
        if (mode == EM_RESID) {
            const float* gv = f2 + (size_t)(row0 >> 12) * 6144 + colb;
            const f32x4 g00 = *(const f32x4*)gv, g01 = *(const f32x4*)(gv + 4), g10 = *(const f32x4*)(gv + HALF), g11 = *(const f32x4*)(gv + HALF + 4);
#pragma unroll
            for (int ai = 0; ai < 2; ++ai) {
                f32x4 b0[4][2], b1[4][2];
#pragma unroll
                for (int m = 0; m < 4; ++m)
#pragma unroll
                    for (int bj = 0; bj < 2; ++bj) { const size_t off = (size_t)(row0 + ai * HALF + m * 16) * 1024 + colb + bj * HALF; b0[m][bj] = *(const f32x4*)(f1 + off); b1[m][bj] = *(const f32x4*)(f1 + off + 4); }
                asm volatile("" ::: "memory");
#pragma unroll
                for (int m = 0; m < 4; ++m)
#pragma unroll
                    for (int bj = 0; bj < 2; ++bj) { const size_t off = (size_t)(row0 + ai * HALF + m * 16) * 1024 + colb + bj * HALF;
                        *(f32x4*)(f0 + off) = b0[m][bj] + (bj ? g10 : g00) * acc[ai][bj][m][0]; *(f32x4*)(f0 + off + 4) = b1[m][bj] + (bj ? g11 : g01) * acc[ai][bj][m][1]; }
            }
            return;
        }
        if (mode == EM_BR_FIRST || mode == EM_BR_MID || mode == EM_BR_LAST) {
#pragma unroll
            for (int ai = 0; ai < 2; ++ai) {
                u32x4 gw[4][2], pm[4][2];
#pragma unroll
                for (int m = 0; m < 4; ++m)
#pragma unroll
                    for (int bj = 0; bj < 2; ++bj) { const size_t off = (size_t)(row0 + ai * HALF + m * 16) * 1024 + colb + bj * HALF; gw[m][bj] = *(const u32x4*)(o0 + off);
                        pm[m][bj] = (u32x4){0u, 0u, 0u, 0u}; if (mode != EM_BR_FIRST) pm[m][bj] = *(const u32x4*)(o1 + off); }
                asm volatile("" ::: "memory");
#pragma unroll
                for (int m = 0; m < 4; ++m)
#pragma unroll
                    for (int bj = 0; bj < 2; ++bj) { const size_t off = (size_t)(row0 + ai * HALF + m * 16) * 1024 + colb + bj * HALF;
                        const f32x4 v0 = acc[ai][bj][m][0], v1 = acc[ai][bj][m][1]; const u32x4 g_ = gw[m][bj], q_ = pm[m][bj];
                        u32x4 w;
                        w.x = cvt_pk_bf16(bf_lo(g_.x) * v0[0] + bf_lo(q_.x), bf_hi(g_.x) * v0[1] + bf_hi(q_.x)); w.y = cvt_pk_bf16(bf_lo(g_.y) * v0[2] + bf_lo(q_.y), bf_hi(g_.y) * v0[3] + bf_hi(q_.y));
                        w.z = cvt_pk_bf16(bf_lo(g_.z) * v1[0] + bf_lo(q_.z), bf_hi(g_.z) * v1[1] + bf_hi(q_.z)); w.w = cvt_pk_bf16(bf_lo(g_.w) * v1[2] + bf_lo(q_.w), bf_hi(g_.w) * v1[3] + bf_hi(q_.w));
                        *(u32x4*)(o1 + off) = w; }
            }
            return;
        }
#pragma unroll
        for (int ai = 0; ai < 2; ++ai) {
            f32x4 csn[4][2], snn[4][2];
            if (mode == EM_INPROJ && u.pn < 4) {
#pragma unroll
                for (int m = 0; m < 4; ++m)
#pragma unroll
                    for (int bj = 0; bj < 2; ++bj) { const int pos = (row0 + ai * HALF + m * 16) & (SEQ - 1), e0 = ((colb + bj * HALF) & 63) >> 1;
                        csn[m][bj] = *(const f32x4*)(ropec + pos * 32 + e0); snn[m][bj] = *(const f32x4*)(ropes + pos * 32 + e0); }
                asm volatile("" ::: "memory");
            }
#pragma unroll
            for (int m = 0; m < 4; ++m) {
                const int row = row0 + ai * HALF + m * 16;
#pragma unroll
                for (int bj = 0; bj < 2; ++bj) {
                    const int col0 = colb + bj * HALF;
                    f32x4 v0 = acc[ai][bj][m][0], v1 = acc[ai][bj][m][1];
                    if (mode == EM_INPROJ) {
                        bf16_t* dst;
                        if (u.pn < 4) {
                            const f32x4 cs = csn[m][bj], sn = snn[m][bj];
                            f32x4 a, b;
                            a[0] = v0[0] * cs[0] - v0[1] * sn[0]; a[1] = v0[1] * cs[0] + v0[0] * sn[0];
                            a[2] = v0[2] * cs[1] - v0[3] * sn[1]; a[3] = v0[3] * cs[1] + v0[2] * sn[1];
                            b[0] = v1[0] * cs[2] - v1[1] * sn[2]; b[1] = v1[1] * cs[2] + v1[0] * sn[2];
                            b[2] = v1[2] * cs[3] - v1[3] * sn[3]; b[3] = v1[3] * cs[3] + v1[2] * sn[3];
                            v0 = a; v1 = b;
                            dst = (u.pn < 2) ? o0 + (size_t)row * 512 + col0 : o1 + (size_t)row * 512 + (col0 - 512);
                        } else if (u.pn < 6) { dst = o2 + (size_t)row * 512 + (col0 - 1024); }
                        else if (u.pn < 13) { dst = o3 + (size_t)row * RAWC + (col0 - 1536); }
                        else {
#pragma unroll
                            for (int j = 0; j < 4; ++j) { v0[j] = gelu_tanh(v0[j]); v1[j] = gelu_tanh(v1[j]); }
                            dst = o4 + (size_t)row * 1024 + (col0 - 3328);
                        }
                        u32x4 w; w.x = cvt_pk_bf16(v0[0], v0[1]); w.y = cvt_pk_bf16(v0[2], v0[3]); w.z = cvt_pk_bf16(v1[0], v1[1]); w.w = cvt_pk_bf16(v1[2], v1[3]);
                        *(u32x4*)dst = w;
                    } else {
#pragma unroll
                        for (int j = 0; j < 4; ++j) { v0[j] = sigmoidf_(v0[j]); v1[j] = sigmoidf_(v1[j]); }
                        u32x4 w; w.x = cvt_pk_bf16(v0[0], v0[1]); w.y = cvt_pk_bf16(v0[2], v0[3]); w.z = cvt_pk_bf16(v1[0], v1[1]); w.w = cvt_pk_bf16(v1[2], v1[3]);
                        *(u32x4*)(o0 + (size_t)row * 1024 + col0) = w;
                    }
                }
            }
        }
    }
};

DI void unit_operands(const Gemm& g, int sub, const char*& A, const char*& Bt, int& lda, int& K) {
    if (!g.merge) { A = (const char*)g.A; Bt = (const char*)g.Bt; lda = g.lda; K = g.K; return; }
    const int br = sub >> 1;
    if ((sub & 1) == 0) { A = (const char*)(g.ws + WS_H); Bt = (const char*)(g.ws + WS_WIN) + (size_t)(4352 + 1024 * br) * 1024 * 2; lda = 1024; K = 1024; }
    else { A = (const char*)(g.ws + (br == 0 ? WS_YSA : (br == 1 ? WS_YSR : WS_YSG))); Bt = (const char*)(g.ws + WS_WBR) + (size_t)br * 1024 * 512 * 2; lda = 512; K = 512; }
}
DI void gemm_phase(LAS unsigned char* lds, const Gemm g, const TileOrder S, const Epi E, int wv) {
    const int tid = otid(wv), wid = __builtin_amdgcn_readfirstlane(tid >> 6), lane = tid & 63, wr = wid >> 2, wc = wid & 3, fr = lane & 15, fq = lane >> 4;
    int stR[2], stC[2], stRb[2];
#pragma unroll
    for (int i = 0; i < 2; ++i) { int R, C; stage_rc(tid * 16 + i * 8192, R, C); stR[i] = R; stC[i] = C; stRb[i] = (R & ~31) + perm32(R & 31); }
    const size_t kstep = (size_t)(BK * 2);
    const unsigned ldsw = (unsigned)wid * 1024u;
    const int aoff = lds_byte(wr * 64 + fr, fq * 8), boff = lds_byte(wc * 32 + fr, fq * 8);
#define PG8_SA(b, h) (((b) * 2 + (h)) * HTB)
#define PG8_SB(b, h) ((4 + (b) * 2 + (h)) * HTB)
#define PG8_STAGE(bufoff, gbase, voff) do { _Pragma("unroll") for (int _i = 0; _i < 2; ++_i) \
        __builtin_amdgcn_global_load_lds((const unsigned*)((const char*)(gbase) + (voff)[_i]), (LAS unsigned*)(lds + (bufoff) + ldsw + _i * 8192), 16, 0, 0); } while (0)
#define PG8_LDA(dst, b, h) do { _Pragma("unroll") for (int m = 0; m < 4; ++m) _Pragma("unroll") for (int k = 0; k < 2; ++k) dst[m][k] = *(const LAS bf16x8*)(lds + PG8_SA(b, h) + aoff + m * 2048 + k * 1024); } while (0)
#define PG8_LDB(dst, b, h) do { _Pragma("unroll") for (int n = 0; n < 2; ++n) _Pragma("unroll") for (int k = 0; k < 2; ++k) dst[n][k] = *(const LAS bf16x8*)(lds + PG8_SB(b, h) + boff + n * 2048 + k * 1024); } while (0)
#define PG8_MMA(ai, bj, At, Bt) do { __builtin_amdgcn_s_setprio(1); _Pragma("unroll") for (int m = 0; m < 4; ++m) _Pragma("unroll") for (int n = 0; n < 2; ++n) _Pragma("unroll") for (int k = 0; k < 2; ++k) \
        acc[ai][bj][m][n] = __builtin_amdgcn_mfma_f32_16x16x32_bf16(Bt[n][k], At[m][k], acc[ai][bj][m][n], 0, 0, 0); __builtin_amdgcn_s_setprio(0); } while (0)
#define PG8_WAIT_V(n) asm volatile("s_waitcnt vmcnt(" #n ")" ::: "memory")
#define PG8_WAIT_L(n) asm volatile("s_waitcnt lgkmcnt(" #n ")" ::: "memory")
#define PG8_BAR __builtin_amdgcn_s_barrier()
#define PG8_SCHED __builtin_amdgcn_sched_barrier(0)
#define PG8_SETUP(u, pA, pB, vA, vB, hA, hB, ntv) do { const char* _A; const char* _B; int _lda, _K; unit_operands(g, (u).sub, _A, _B, _lda, _K); \
        pA = _A + (size_t)(u).pm * 256 * _lda * 2; pB = _B + (size_t)(u).pn * 256 * _K * 2; hA = (size_t)HALF * _lda * 2; hB = (size_t)HALF * _K * 2; ntv = _K / BK; \
        _Pragma("unroll") for (int _i = 0; _i < 2; ++_i) { vA[_i] = (unsigned)(stR[_i] * _lda + stC[_i]) * 2u; vB[_i] = (unsigned)(stRb[_i] * _K + stC[_i]) * 2u; } } while (0)
    Unit cur, nxt; int ui = 0;
    if (!S.next(0, cur)) return;
    f32x4 acc[2][2][4][2];
#pragma unroll
    for (int a = 0; a < 2; ++a)
#pragma unroll
        for (int b = 0; b < 2; ++b)
#pragma unroll
            for (int m = 0; m < 4; ++m)
#pragma unroll
                for (int n = 0; n < 2; ++n) acc[a][b][m][n] = (f32x4){0.f, 0.f, 0.f, 0.f};
    bf16x8 At[4][2], B0[2][2], B1[2][2];
    const char *cA, *cB, *nA, *nB; unsigned vAc[2], vBc[2], vAn[2], vBn[2]; size_t hAc, hBc, hAn, hBn; int nt, ntn;
    PG8_SETUP(cur, cA, cB, vAc, vBc, hAc, hBc, nt);
    PG8_STAGE(PG8_SB(0, 0), cB, vBc); PG8_STAGE(PG8_SA(0, 0), cA, vAc); PG8_STAGE(PG8_SB(0, 1), cB + hBc, vBc); PG8_STAGE(PG8_SA(0, 1), cA + hAc, vAc);
    if (wr == 1) PG8_BAR;
    PG8_WAIT_V(4); PG8_BAR;
    PG8_STAGE(PG8_SB(1, 0), cB + kstep, vBc); PG8_STAGE(PG8_SA(1, 0), cA + kstep, vAc); PG8_STAGE(PG8_SB(1, 1), cB + hBc + kstep, vBc);
    PG8_WAIT_V(6); PG8_BAR;
    for (;;) {
        const bool has_next = S.next(ui + 1, nxt);
        if (has_next) { PG8_SETUP(nxt, nA, nB, vAn, vBn, hAn, hBn, ntn); }
        else { nA = cA; nB = cB; vAn[0] = vAc[0]; vAn[1] = vAc[1]; vBn[0] = vBc[0]; vBn[1] = vBc[1]; hAn = hAc; hBn = hBc; ntn = nt; }
        for (int t = 0; t < nt; t += 2) {
            const bool last = (t == nt - 2);
            const char* a1 = cA + (size_t)(t + 1) * kstep;
            const char* a2 = last ? nA : cA + (size_t)(t + 2) * kstep; const char* b2 = last ? nB : cB + (size_t)(t + 2) * kstep;
            const char* a3 = a2 + kstep; const char* b3 = b2 + kstep;
            unsigned vA2[2], vB2[2]; vA2[0] = last ? vAn[0] : vAc[0]; vA2[1] = last ? vAn[1] : vAc[1]; vB2[0] = last ? vBn[0] : vBc[0]; vB2[1] = last ? vBn[1] : vBc[1];
            const size_t hA2 = last ? hAn : hAc, hB2 = last ? hBn : hBc;
            PG8_LDB(B0, 0, 0); PG8_SCHED; PG8_LDA(At, 0, 0); PG8_STAGE(PG8_SA(1, 1), a1 + hAc, vAc);
            PG8_WAIT_L(8); PG8_BAR; PG8_WAIT_L(0); PG8_MMA(0, 0, At, B0); PG8_BAR; PG8_SCHED;
            PG8_LDB(B1, 0, 1); PG8_STAGE(PG8_SB(0, 0), b2, vB2);
            PG8_BAR; PG8_WAIT_L(0); PG8_MMA(0, 1, At, B1); PG8_BAR;
            PG8_LDA(At, 0, 1); PG8_STAGE(PG8_SA(0, 0), a2, vA2);
            PG8_BAR; PG8_WAIT_L(0); PG8_MMA(1, 0, At, B0); PG8_BAR; PG8_SCHED;
            PG8_STAGE(PG8_SB(0, 1), b2 + hB2, vB2);
            PG8_WAIT_V(6); PG8_BAR; PG8_MMA(1, 1, At, B1); PG8_BAR;
            PG8_LDB(B0, 1, 0); PG8_SCHED; PG8_LDA(At, 1, 0); PG8_STAGE(PG8_SA(0, 1), a2 + hA2, vA2);
            PG8_WAIT_L(8); PG8_BAR; PG8_WAIT_L(0); PG8_MMA(0, 0, At, B0); PG8_BAR; PG8_SCHED;
            PG8_LDB(B1, 1, 1); PG8_STAGE(PG8_SB(1, 0), b3, vB2);
            PG8_BAR; PG8_WAIT_L(0); PG8_MMA(0, 1, At, B1); PG8_BAR;
            PG8_LDA(At, 1, 1); PG8_STAGE(PG8_SA(1, 0), a3, vA2);
            PG8_BAR; PG8_WAIT_L(0); PG8_MMA(1, 0, At, B0); PG8_BAR; PG8_SCHED;
            PG8_STAGE(PG8_SB(1, 1), b3 + hB2, vB2);
            PG8_WAIT_V(6); PG8_BAR; PG8_MMA(1, 1, At, B1); PG8_BAR;
        }
        E(acc, cur, wr, wc, fr, fq);
        if (!has_next) break;
#pragma unroll
        for (int a = 0; a < 2; ++a)
#pragma unroll
            for (int b = 0; b < 2; ++b)
#pragma unroll
                for (int m = 0; m < 4; ++m)
#pragma unroll
                    for (int n = 0; n < 2; ++n) acc[a][b][m][n] = (f32x4){0.f, 0.f, 0.f, 0.f};
        cur = nxt; cA = nA; cB = nB; vAc[0] = vAn[0]; vAc[1] = vAn[1]; vBc[0] = vBn[0]; vBc[1] = vBn[1]; hAc = hAn; hBc = hBn; nt = ntn; ++ui;
    }
    PG8_WAIT_V(0);
    if (wr == 0) PG8_BAR;
    PG8_BAR;
#undef PG8_SA
#undef PG8_SB
#undef PG8_STAGE
#undef PG8_LDA
#undef PG8_LDB
#undef PG8_MMA
#undef PG8_WAIT_V
#undef PG8_WAIT_L
#undef PG8_BAR
#undef PG8_SCHED
#undef PG8_SETUP
}
}

template <int PERMK>
DI void transpose_item(const float* W, int K, int N, bf16_t* WT, LAS float* scr, int item, int lane) {
    const int nblk = N / 32, kb = item / nblk, nb = item % nblk, k0 = 64 * kb, n0 = 32 * nb;
    int sc = n0 + (lane & 31);
    if (PERMK == 1 && sc < 1024) { const int hd = sc >> 6, cp = sc & 63; sc = hd * 64 + 32 * (cp & 1) + (cp >> 1); }
    if (PERMK == 2) { const int tl = sc >> 8, w = sc & 255; sc = (w < 128) ? (128 * tl + w) : (DFF + 128 * tl + (w - 128)); }
#pragma unroll 8
    for (int i = 0; i < 32; ++i) { const int kk = 2 * i + (lane >> 5); scr[kk * 33 + (lane & 31)] = W[(size_t)(k0 + kk) * N + sc]; }
    LDS_WAIT();
    const int c = lane & 7;
#pragma unroll
    for (int j = 0; j < 4; ++j) { const int n = (lane >> 3) + 8 * j; const LAS float* s = scr + (8 * c) * 33 + n;
        u32x4 o; o.x = cvt_pk_bf16(s[0 * 33], s[1 * 33]); o.y = cvt_pk_bf16(s[2 * 33], s[3 * 33]); o.z = cvt_pk_bf16(s[4 * 33], s[5 * 33]); o.w = cvt_pk_bf16(s[6 * 33], s[7 * 33]);
        *(u32x4*)(WT + (size_t)(n0 + n) * K + k0 + 8 * c) = o; }
    LDS_WAIT();
}

DI void convert_weights(KP p, int l, LAS unsigned char* lds, int wv) {
    const int tid_ = otid(wv); const int wave = tid_ >> 6, lane = tid_ & 63;
    LAS float* scr = (LAS float*)(lds + wave * 8448);
    const int gw = blockIdx.x * 8 + wave, NGW = gridDim.x * 8;
    constexpr int I_IN = 16 * (INC / 32), I_BR = 8 * 32, I_OUT = 16 * 32, I_UP = 16 * (UPC / 32), I_DN = (DFF / 64) * 32, I_L64 = 16, I_L128 = 32;
    constexpr int NIT = I_IN + 3 * I_BR + I_OUT + I_UP + I_DN + 2 * I_L64 + I_L128;
    unsigned char* ws = ows(p->ws);
    for (int it = gw; it < NIT; it += NGW) {
        int r = it;
        if (r < I_IN) { transpose_item<1>(p->in[5] + (size_t)l * 1024 * INC, 1024, INC, (bf16_t*)(ws + WS_WIN), scr, r, lane); continue; } r -= I_IN;
        if (r < 3 * I_BR) { const int b = r / I_BR; transpose_item<0>(p->in[21] + ((size_t)l * 3 + b) * 512 * 1024, 512, 1024, (bf16_t*)(ws + WS_WBR) + (size_t)b * 1024 * 512, scr, r % I_BR, lane); continue; } r -= 3 * I_BR;
        if (r < I_OUT) { transpose_item<0>(p->in[22] + (size_t)l * 1024 * 1024, 1024, 1024, (bf16_t*)(ws + WS_WOUT), scr, r, lane); continue; } r -= I_OUT;
        if (r < I_UP) { transpose_item<2>(p->in[24] + (size_t)l * 1024 * UPC, 1024, UPC, (bf16_t*)(ws + WS_WUP), scr, r, lane); continue; } r -= I_UP;
        if (r < I_DN) { transpose_item<0>(p->in[27] + (size_t)l * DFF * 1024, DFF, 1024, (bf16_t*)(ws + WS_WDN), scr, r, lane); continue; } r -= I_DN;
        if (r < I_L64) { transpose_item<0>(p->in[8] + (size_t)l * 64 * 512, 64, 512, (bf16_t*)(ws + WS_LWU), scr, r, lane); continue; } r -= I_L64;
        if (r < I_L64) { transpose_item<0>(p->in[10] + (size_t)l * 64 * 512, 64, 512, (bf16_t*)(ws + WS_LAU), scr, r, lane); continue; } r -= I_L64;
        transpose_item<0>(p->in[11] + (size_t)l * 128 * 512, 128, 512, (bf16_t*)(ws + WS_LGU), scr, r, lane);
    }
}

DI void phase0(KP p, LAS unsigned char* lds, int wv) {
    const int tid = otid(wv);
    float* ropec = (float*)(p->ws + WS_ROPEC); float* ropes = (float*)(p->ws + WS_ROPES);
    for (int idx = blockIdx.x * 512 + tid; idx < SEQ * 32; idx += gridDim.x * 512) {
        const int pos = idx >> 5, e = idx & 31;
        const float inv = 1.0f / exp2f((float)e * (13.287712379549449f / 32.0f));
        const float ang = (float)pos * inv;
        double rev = (double)ang * 0.15915494309189535; rev -= rint(rev);
        const float rv = (float)rev;
        ropec[idx] = __builtin_amdgcn_cosf(rv); ropes[idx] = __builtin_amdgcn_sinf(rv);
    }
    {
        LAS float* ca = (LAS float*)lds;
        LAS float* red = (LAS float*)(lds + 16384);
        float* mod = (float*)(p->ws + WS_MOD);
        bool loaded = false;
        for (int item = blockIdx.x; item < 192; item += gridDim.x) {
            if (!loaded) { for (int i = tid; i < 4096; i += 512) { const float v = p->in[1][i]; ca[i] = v / (1.0f + __expf(-v)); } loaded = true; __syncthreads(); }
            const int l = item / 96, c0 = (item % 96) * 64, cc = tid & 63, kg = tid >> 6;
            const float* w = p->in[2] + (size_t)l * 1024 * 6144 + c0 + cc;
            float a0 = 0.f, a1 = 0.f, a2 = 0.f, a3 = 0.f;
#pragma unroll 8
            for (int k = kg * 128; k < kg * 128 + 128; ++k) { const float wv = w[(size_t)k * 6144]; a0 += ca[k] * wv; a1 += ca[1024 + k] * wv; a2 += ca[2048 + k] * wv; a3 += ca[3072 + k] * wv; }
            red[(kg * 4 + 0) * 64 + cc] = a0; red[(kg * 4 + 1) * 64 + cc] = a1; red[(kg * 4 + 2) * 64 + cc] = a2; red[(kg * 4 + 3) * 64 + cc] = a3;
            __syncthreads();
            if (tid < 256) { const int b = tid >> 6; float s = 0.f;
#pragma unroll
                for (int g = 0; g < 8; ++g) s += red[(g * 4 + b) * 64 + cc];
                mod[((size_t)l * 4 + b) * 6144 + c0 + cc] = s + p->in[3][(size_t)l * 6144 + c0 + cc]; }
            __syncthreads();
        }
        __syncthreads();
    }
    convert_weights(p, 0, lds, wv);
}

DI void norm_mod_phase(const float* x, const float* g, const float* sh, const float* sc, bf16_t* H, int wv) {
    const int tid_ = otid(wv); const int wave = tid_ >> 6, lane = tid_ & 63;
    for (int row0 = (blockIdx.x * 8 + wave) * 2; row0 < MTOK; row0 += gridDim.x * 16) {
        f32x4 v[2][4]; float s[2] = {0.f, 0.f};
#pragma unroll
        for (int q = 0; q < 2; ++q) { const f32x4* xr = (const f32x4*)(x + (size_t)(row0 + q) * DM) + lane;
#pragma unroll
            for (int j = 0; j < 4; ++j) v[q][j] = xr[64 * j]; }
#pragma unroll
        for (int q = 0; q < 2; ++q)
#pragma unroll
            for (int j = 0; j < 4; ++j) s[q] += (v[q][j][0] * v[q][j][0] + v[q][j][1] * v[q][j][1]) + (v[q][j][2] * v[q][j][2] + v[q][j][3] * v[q][j][3]);
        const float rs0 = rsqrtf(wave_sum(s[0]) * (1.0f / DM) + 1e-6f), rs1 = rsqrtf(wave_sum(s[1]) * (1.0f / DM) + 1e-6f);
        const int b = row0 >> 12;
#pragma unroll
        for (int j = 0; j < 4; ++j) {
            const int c = 4 * lane + 256 * j;
            const f32x4 gg = *(const f32x4*)(g + c), s1 = *(const f32x4*)(sc + (size_t)b * 6144 + c), s0 = *(const f32x4*)(sh + (size_t)b * 6144 + c);
#pragma unroll
            for (int q = 0; q < 2; ++q) {
                const f32x4 h = (v[q][j] * (q ? rs1 : rs0) * gg) * (s1 + 1.0f) + s0;
                u32x2 w; w.x = cvt_pk_bf16(h[0], h[1]); w.y = cvt_pk_bf16(h[2], h[3]);
                *((u32x2*)(H + (size_t)(row0 + q) * DM) + lane + 64 * j) = w;
            }
        }
    }
}
DI void final_norm_phase(float* x, const float* g, int wv) {
    const int tid_ = otid(wv); const int wave = tid_ >> 6, lane = tid_ & 63;
    for (int row = blockIdx.x * 8 + wave; row < MTOK; row += gridDim.x * 8) {
        f32x4* xr = (f32x4*)(x + (size_t)row * DM) + lane;
        f32x4 v[4]; float s = 0.f;
#pragma unroll
        for (int j = 0; j < 4; ++j) { v[j] = xr[64 * j]; s += (v[j][0] * v[j][0] + v[j][1] * v[j][1]) + (v[j][2] * v[j][2] + v[j][3] * v[j][3]); }
        const float rs = rsqrtf(wave_sum(s) * (1.0f / DM) + 1e-6f);
#pragma unroll
        for (int j = 0; j < 4; ++j) { const f32x4 gg = *(const f32x4*)(g + 4 * lane + 256 * j); xr[64 * j] = v[j] * rs * gg; }
    }
}

DI bf16x8 lerp_frag(const bf16_t* cur, const bf16_t* prv, bool hasprev, const float* mu, int act) {
    const u32x4 c = *(const u32x4*)cur; u32x4 q = {0u, 0u, 0u, 0u}; if (hasprev) q = *(const u32x4*)prv;
    const f32x4 m0 = *(const f32x4*)mu, m1 = *(const f32x4*)(mu + 4);
    float z[8];
    const unsigned cw[4] = {c.x, c.y, c.z, c.w}, qw[4] = {q.x, q.y, q.z, q.w};
#pragma unroll
    for (int j = 0; j < 4; ++j) {
        const float c0 = bf_lo(cw[j]), c1 = bf_hi(cw[j]), p0 = bf_lo(qw[j]), p1 = bf_hi(qw[j]);
        const float mA = (j < 2) ? m0[2 * j] : m1[2 * j - 4], mB = (j < 2) ? m0[2 * j + 1] : m1[2 * j - 3];
        z[2 * j] = c0 + (p0 - c0) * mA; z[2 * j + 1] = c1 + (p1 - c1) * mB;
    }
#pragma unroll
    for (int j = 0; j < 8; ++j) {
        if (act == 1) { const float e = __expf(2.0f * z[j]); z[j] = 1.0f - 2.0f / (1.0f + e); }
        else if (act == 2) z[j] = sigmoidf_(z[j]);
    }
    return pack8(z[0], z[1], z[2], z[3], z[4], z[5], z[6], z[7]);
}

DI void rwkv_derived_phase(KP p0, int l, int wv) {
    const int tid_ = otid(wv); const int wave = tid_ >> 6, lane = tid_ & 63, r = lane & 31, hh = lane >> 5;
    for (int job = blockIdx.x * 8 + wave; job < 512 * 8; job += gridDim.x * 8) {
        KP p = okp(); unsigned char* ws = ows(p->ws);
        const bf16_t* RAW = (const bf16_t*)(ws + WS_RAW);
        bf16_t *RZ = (bf16_t*)(ws + WS_RZ), *KP = (bf16_t*)(ws + WS_KP), *VZ = (bf16_t*)(ws + WS_VZ), *KKN = (bf16_t*)(ws + WS_KKN), *Bv = (bf16_t*)(ws + WS_B), *G = (bf16_t*)(ws + WS_G);
        float* W = (float*)(ws + WS_W);
        const bf16_t *LWU = (const bf16_t*)(ws + WS_LWU), *LAU = (const bf16_t*)(ws + WS_LAU), *LGU = (const bf16_t*)(ws + WS_LGU);
        const float* mu = p->in[6] + (size_t)l * RAWC; const float* w0 = p->in[7] + l * 512; const float* a0 = p->in[9] + l * 512;
        const float* k_k = p->in[12] + l * 512; const float* k_a = p->in[13] + l * 512; const float* r_k = p->in[14] + l * 512;
        const int hd = job & 7, tg = job >> 3, t = tg * 32 + r;
        const bool hp = (t & (SEQ - 1)) != 0;
        const bf16_t* cur = RAW + (size_t)t * RAWC; const bf16_t* prv = cur - RAWC;
        float ss = 0.f;
#pragma unroll
        for (int q = 0; q < 8; ++q) {
            const int c = hd * 64 + 8 * q + 4 * hh;
            const u32x2 kc = *(const u32x2*)(cur + 512 + c); u32x2 kq = {0u, 0u}; if (hp) kq = *(const u32x2*)(prv + 512 + c);
            const f32x4 mk = *(const f32x4*)(mu + 512 + c), kkw = *(const f32x4*)(k_k + c);
            const float kcur[4] = {bf_lo(kc.x), bf_hi(kc.x), bf_lo(kc.y), bf_hi(kc.y)}, kprv[4] = {bf_lo(kq.x), bf_hi(kq.x), bf_lo(kq.y), bf_hi(kq.y)};
#pragma unroll
            for (int j = 0; j < 4; ++j) { const float kk = (kcur[j] + (kprv[j] - kcur[j]) * mk[j]) * kkw[j]; ss += kk * kk; }
        }
        ss += __shfl_xor(ss, 32);
        const float inv = 1.0f / fmaxf(sqrtf(ss), 1e-12f);
        float bonus = 0.f;
        {
            bf16x8 bw[4], ba[4];
#pragma unroll
            for (int s = 0; s < 4; ++s) { const int o = 16 * s + 8 * hh; bw[s] = lerp_frag(cur + 1536 + o, prv + 1536 + o, hp, mu + 1536 + o, 1); ba[s] = lerp_frag(cur + 1600 + o, prv + 1600 + o, hp, mu + 1600 + o, 0); }
#pragma unroll 1
            for (int mt = 0; mt < 2; ++mt) {
                const int chr = hd * 64 + 32 * mt + r;
                f32x16 aw, aa;
#pragma unroll
                for (int i = 0; i < 16; ++i) { aw[i] = 0.f; aa[i] = 0.f; }
                {
                    typedef const __attribute__((address_space(1))) bf16x8* GP8;
                    const GP8 pw = (GP8)(LWU + (size_t)chr * 64 + 8 * hh), pa = (GP8)(LAU + (size_t)chr * 64 + 8 * hh);
                    bf16x8 fw[4], fa[4];
#pragma unroll
                    for (int s = 0; s < 4; ++s) { fw[s] = pw[2 * s]; fa[s] = pa[2 * s]; }
                    asm volatile("" ::: "memory");
#pragma unroll
                    for (int s = 0; s < 4; ++s) { aw = MFMA32(fw[s], bw[s], aw); aa = MFMA32(fa[s], ba[s], aa); }
                }
#pragma unroll
                for (int i4 = 0; i4 < 4; ++i4) {
                    const int c = hd * 64 + 32 * mt + 8 * i4 + 4 * hh;
                    const u32x2 rc = *(const u32x2*)(cur + c), kc = *(const u32x2*)(cur + 512 + c), vc = *(const u32x2*)(cur + 1024 + c);
                    u32x2 rp = {0u, 0u}, kq = {0u, 0u}, vp = {0u, 0u};
                    if (hp) { rp = *(const u32x2*)(prv + c); kq = *(const u32x2*)(prv + 512 + c); vp = *(const u32x2*)(prv + 1024 + c); }
                    const f32x4 mr = *(const f32x4*)(mu + c), mk = *(const f32x4*)(mu + 512 + c), mv = *(const f32x4*)(mu + 1024 + c);
                    const f32x4 w0v = *(const f32x4*)(w0 + c), a0v = *(const f32x4*)(a0 + c), kkw = *(const f32x4*)(k_k + c), kaw = *(const f32x4*)(k_a + c), rkw = *(const f32x4*)(r_k + c);
                    const float rcur[4] = {bf_lo(rc.x), bf_hi(rc.x), bf_lo(rc.y), bf_hi(rc.y)}, rprv[4] = {bf_lo(rp.x), bf_hi(rp.x), bf_lo(rp.y), bf_hi(rp.y)};
                    const float kcur[4] = {bf_lo(kc.x), bf_hi(kc.x), bf_lo(kc.y), bf_hi(kc.y)}, kprv[4] = {bf_lo(kq.x), bf_hi(kq.x), bf_lo(kq.y), bf_hi(kq.y)};
                    const float vcur[4] = {bf_lo(vc.x), bf_hi(vc.x), bf_lo(vc.y), bf_hi(vc.y)}, vprv[4] = {bf_lo(vp.x), bf_hi(vp.x), bf_lo(vp.y), bf_hi(vp.y)};
                    f32x4 dec; float rz[4], kp[4], vz[4], kn[4], bb[4];
#pragma unroll
                    for (int j = 0; j < 4; ++j) {
                        const int i = 4 * i4 + j;
                        const float zz = -(w0v[j] + aw[i]);
                        const float sp = (zz > 20.f) ? zz : __logf(1.0f + __expf(zz));
                        const float wv = -sp - 0.5f;
                        dec[j] = __expf(-__expf(wv));
                        const float av = sigmoidf_(a0v[j] + aa[i]);
                        rz[j] = rcur[j] + (rprv[j] - rcur[j]) * mr[j];
                        const float kz = kcur[j] + (kprv[j] - kcur[j]) * mk[j];
                        vz[j] = vcur[j] + (vprv[j] - vcur[j]) * mv[j];
                        kn[j] = kz * kkw[j] * inv; bb[j] = kn[j] * av;
                        kp[j] = kz * (1.0f + (av - 1.0f) * kaw[j]);
                        bonus += rz[j] * kp[j] * rkw[j];
                    }
                    const size_t o = (size_t)t * 512 + c;
                    *(f32x4*)(W + o) = dec;
                    u32x2 w2; w2.x = cvt_pk_bf16(rz[0], rz[1]); w2.y = cvt_pk_bf16(rz[2], rz[3]); *(u32x2*)(RZ + o) = w2;
                    w2.x = cvt_pk_bf16(kp[0], kp[1]); w2.y = cvt_pk_bf16(kp[2], kp[3]); *(u32x2*)(KP + o) = w2;
                    w2.x = cvt_pk_bf16(vz[0], vz[1]); w2.y = cvt_pk_bf16(vz[2], vz[3]); *(u32x2*)(VZ + o) = w2;
                    w2.x = cvt_pk_bf16(kn[0], kn[1]); w2.y = cvt_pk_bf16(kn[2], kn[3]); *(u32x2*)(KKN + o) = w2;
                    w2.x = cvt_pk_bf16(bb[0], bb[1]); w2.y = cvt_pk_bf16(bb[2], bb[3]); *(u32x2*)(Bv + o) = w2;
                }
            }
        }
        bonus += __shfl_xor(bonus, 32);
        int t2 = t; asm volatile("" : "+v"(t2));
        if (hh == 0) ((float*)(ows(ws) + WS_BONUS))[(size_t)t2 * 8 + hd] = bonus;
        {
            bf16x8 bg[8];
#pragma unroll
            for (int s = 0; s < 8; ++s) { const int o = 16 * s + 8 * hh; bg[s] = lerp_frag(cur + 1664 + o, prv + 1664 + o, hp, mu + 1664 + o, 2); }
#pragma unroll 1
            for (int mt = 0; mt < 2; ++mt) {
                const int chr = hd * 64 + 32 * mt + r;
                f32x16 ag;
#pragma unroll
                for (int i = 0; i < 16; ++i) ag[i] = 0.f;
                {
                    typedef const __attribute__((address_space(1))) bf16x8* GP8;
                    const GP8 pg = (GP8)(LGU + (size_t)chr * 128 + 8 * hh);
                    bf16x8 fg[8];
#pragma unroll
                    for (int s = 0; s < 8; ++s) fg[s] = pg[2 * s];
                    asm volatile("" ::: "memory");
#pragma unroll
                    for (int s = 0; s < 8; ++s) ag = MFMA32(fg[s], bg[s], ag);
                }
#pragma unroll
                for (int i4 = 0; i4 < 4; ++i4) {
                    const size_t o = (size_t)t2 * 512 + hd * 64 + 32 * mt + 8 * i4 + 4 * hh;
                    u32x2 w2; w2.x = cvt_pk_bf16(ag[4 * i4], ag[4 * i4 + 1]); w2.y = cvt_pk_bf16(ag[4 * i4 + 2], ag[4 * i4 + 3]); *(u32x2*)(G + o) = w2;
                }
            }
        }
    }
}

constexpr int SC_T = 32, SC_STEP = 1344, SC_BUF = SC_T * SC_STEP;
struct ScanRegs { f32x4 w0, w1; u32x4 kn, bb, kp, rz, vv; };
DI void scan_gload(KP p, ScanRegs& R, int b, int h, int rg, int ck, int pt) {
    const unsigned char* ws = ows(p->ws);
    const size_t tok0 = (size_t)b * SEQ + (size_t)ck * SC_T;
    { const int st = pt >> 4, sub = pt & 15; R.w0 = *(const f32x4*)((const float*)(ws + WS_W) + (tok0 + st) * 512 + h * 64 + 4 * sub); }
    { const int pp = pt + 256, st = pp >> 4, sub = pp & 15; R.w1 = *(const f32x4*)((const float*)(ws + WS_W) + (tok0 + st) * 512 + h * 64 + 4 * sub); }
    const int st = pt >> 3, sub = pt & 7; const size_t go = (tok0 + st) * 512 + h * 64 + 8 * sub;
    R.kn = *(const u32x4*)((const bf16_t*)(ws + WS_KKN) + go); R.bb = *(const u32x4*)((const bf16_t*)(ws + WS_B) + go);
    R.kp = *(const u32x4*)((const bf16_t*)(ws + WS_KP) + go); R.rz = *(const u32x4*)((const bf16_t*)(ws + WS_RZ) + go);
    R.vv = (u32x4){0u, 0u, 0u, 0u};
    if (pt < 64) { const int s2 = pt >> 1, hf = pt & 1; R.vv = *(const u32x4*)((const bf16_t*)(ws + WS_VZ) + (tok0 + s2) * 512 + h * 64 + rg * 16 + 8 * hf); }
}
DI void scan_write(const ScanRegs& R, LAS unsigned char* buf, int pt) {
    { const int st = pt >> 4, sub = pt & 15; *(LAS f32x4*)(buf + st * SC_STEP + sub * 16) = R.w0; }
    { const int pp = pt + 256, st = pp >> 4, sub = pp & 15; *(LAS f32x4*)(buf + st * SC_STEP + sub * 16) = R.w1; }
    const int st = pt >> 3, sub = pt & 7;
    const u32x4 kn = R.kn, bb = R.bb, kp = R.kp, rz = R.rz;
    LAS unsigned char* d = buf + st * SC_STEP + sub * 32;
    *(LAS f32x4*)(d + 256) = (f32x4){-bf_lo(kn.x), -bf_hi(kn.x), -bf_lo(kn.y), -bf_hi(kn.y)}; *(LAS f32x4*)(d + 256 + 16) = (f32x4){-bf_lo(kn.z), -bf_hi(kn.z), -bf_lo(kn.w), -bf_hi(kn.w)};
    *(LAS f32x4*)(d + 512) = (f32x4){bf_lo(bb.x), bf_hi(bb.x), bf_lo(bb.y), bf_hi(bb.y)}; *(LAS f32x4*)(d + 512 + 16) = (f32x4){bf_lo(bb.z), bf_hi(bb.z), bf_lo(bb.w), bf_hi(bb.w)};
    *(LAS f32x4*)(d + 768) = (f32x4){bf_lo(kp.x), bf_hi(kp.x), bf_lo(kp.y), bf_hi(kp.y)}; *(LAS f32x4*)(d + 768 + 16) = (f32x4){bf_lo(kp.z), bf_hi(kp.z), bf_lo(kp.w), bf_hi(kp.w)};
    *(LAS f32x4*)(d + 1024) = (f32x4){bf_lo(rz.x), bf_hi(rz.x), bf_lo(rz.y), bf_hi(rz.y)}; *(LAS f32x4*)(d + 1024 + 16) = (f32x4){bf_lo(rz.z), bf_hi(rz.z), bf_lo(rz.w), bf_hi(rz.w)};
    if (pt < 64) { const int s2 = pt >> 1, hf = pt & 1; const u32x4 vv = R.vv;
        LAS unsigned char* dv = buf + s2 * SC_STEP + 1280 + hf * 32;
        *(LAS f32x4*)dv = (f32x4){bf_lo(vv.x), bf_hi(vv.x), bf_lo(vv.y), bf_hi(vv.y)}; *(LAS f32x4*)(dv + 16) = (f32x4){bf_lo(vv.z), bf_hi(vv.z), bf_lo(vv.w), bf_hi(vv.w)}; }
}
DI void rwkv_scan_phase(KP p, LAS unsigned char* lds, int wv) {
    const int tid = otid(wv), wave = tid >> 6, lane = tid & 63;
    float* YRAW = (float*)(p->ws + WS_YRAW);
    for (int job = blockIdx.x; job < 128; job += gridDim.x) {
        const int jx = job & 7, jk = job >> 3;
        const int chain = jx + 8 * (jk >> 2), rg = jk & 3, b = chain >> 3, h = chain & 7;
        __syncthreads();
        ScanRegs R0, R1;
        if (wave >= 4) { scan_gload(p, R0, b, h, rg, 0, tid - 256); scan_write(R0, lds, tid - 256); scan_gload(p, R0, b, h, rg, 1, tid - 256); scan_gload(p, R1, b, h, rg, 2, tid - 256); }
        __syncthreads();
        f32x4 S = {0.f, 0.f, 0.f, 0.f};
        const int jl = lane & 15, rl = 4 * (wave & 3) + (lane >> 4);
        for (int ck2 = 0; ck2 < SEQ / SC_T; ck2 += 2) {
#pragma unroll
            for (int half = 0; half < 2; ++half) {
                const int ck = ck2 + half;
                LAS unsigned char* cb = lds + (ck & 1) * SC_BUF;
                if (wave >= 4) {
                    if (ck + 1 < SEQ / SC_T) {
                        if (half == 0) { scan_write(R0, lds + ((ck + 1) & 1) * SC_BUF, tid - 256); if (ck + 3 < SEQ / SC_T) scan_gload(p, R0, b, h, rg, ck + 3, tid - 256); }
                        else           { scan_write(R1, lds + ((ck + 1) & 1) * SC_BUF, tid - 256); if (ck + 3 < SEQ / SC_T) scan_gload(p, R1, b, h, rg, ck + 3, tid - 256); }
                    }
                } else {
                    float* yo = YRAW + ((size_t)b * SEQ + (size_t)ck * SC_T + jl) * 512 + h * 64 + rg * 16 + rl;
                    const LAS unsigned char* sb = cb + jl * 16; const LAS unsigned char* vb = cb + 1280 + rl * 4;
                    f32x4 w4 = *(const LAS f32x4*)sb, an = *(const LAS f32x4*)(sb + 256), b4 = *(const LAS f32x4*)(sb + 512), k4 = *(const LAS f32x4*)(sb + 768), r4 = *(const LAS f32x4*)(sb + 1024);
                    float vi = *(const LAS float*)vb;
                    float ysel = 0.f;
#pragma unroll
                    for (int s = 0; s < SC_T; ++s) {
                        f32x4 w4n = w4, ann = an, b4n = b4, k4n = k4, r4n = r4; float vin = vi;
                        if (s + 1 < SC_T) {
                            const LAS unsigned char* sn = sb + (s + 1) * SC_STEP;
                            w4n = *(const LAS f32x4*)sn; ann = *(const LAS f32x4*)(sn + 256); b4n = *(const LAS f32x4*)(sn + 512); k4n = *(const LAS f32x4*)(sn + 768); r4n = *(const LAS f32x4*)(sn + 1024);
                            vin = *(const LAS float*)(vb + (s + 1) * SC_STEP);
                        }
                        float sa = (S[0] * an[0] + S[1] * an[1]) + (S[2] * an[2] + S[3] * an[3]);
                        sa = row16_sum(sa);
                        S = S * w4 + (b4 * sa + k4 * vi);
                        float y = (S[0] * r4[0] + S[1] * r4[1]) + (S[2] * r4[2] + S[3] * r4[3]);
                        y = row16_sum(y);
                        ysel = (jl == (s & 15)) ? y : ysel;
                        if ((s & 15) == 15) yo[(size_t)(s - 15) * 512] = ysel;
                        w4 = w4n; an = ann; b4 = b4n; k4 = k4n; r4 = r4n; vi = vin;
                    }
                }
                __syncthreads();
            }
        }
    }
}

DI void rwkv_post_phase(KP p, int l, int wv) {
    const unsigned char* ws = ows(p->ws);
    const float* YRAW = (const float*)(ws + WS_YRAW); const bf16_t* VZ = (const bf16_t*)(ws + WS_VZ); const bf16_t* G = (const bf16_t*)(ws + WS_G);
    const float* BONUS = (const float*)(ws + WS_BONUS); bf16_t* YS = (bf16_t*)(p->ws + WS_YSR);
    const float* gnw = p->in[15] + l * 512; const float* gnb = p->in[16] + l * 512;
    const int tid_ = otid(wv); const int wave = tid_ >> 6, lane = tid_ & 63, c = 8 * lane;
    const f32x4 gw0 = *(const f32x4*)(gnw + c), gw1 = *(const f32x4*)(gnw + c + 4), gb0 = *(const f32x4*)(gnb + c), gb1 = *(const f32x4*)(gnb + c + 4);
    for (int t = blockIdx.x * 8 + wave; t < MTOK; t += gridDim.x * 8) {
        const size_t o = (size_t)t * 512 + c;
        const f32x4 y0 = *(const f32x4*)(YRAW + o), y1 = *(const f32x4*)(YRAW + o + 4);
        float s = (y0[0] + y0[1]) + (y0[2] + y0[3]) + (y1[0] + y1[1]) + (y1[2] + y1[3]);
        s += __shfl_xor(s, 1); s += __shfl_xor(s, 2); s += __shfl_xor(s, 4);
        const float mean = s * (1.0f / 64.0f);
        const f32x4 d0 = y0 - mean, d1 = y1 - mean;
        float q = (d0[0] * d0[0] + d0[1] * d0[1]) + (d0[2] * d0[2] + d0[3] * d0[3]) + (d1[0] * d1[0] + d1[1] * d1[1]) + (d1[2] * d1[2] + d1[3] * d1[3]);
        q += __shfl_xor(q, 1); q += __shfl_xor(q, 2); q += __shfl_xor(q, 4);
        const float rstd = rsqrtf(q * (1.0f / 64.0f) + 64e-5f);
        const float bon = BONUS[(size_t)t * 8 + (lane >> 3)];
        const u32x4 vv = *(const u32x4*)(VZ + o), gg = *(const u32x4*)(G + o);
        const f32x4 v0 = {bf_lo(vv.x), bf_hi(vv.x), bf_lo(vv.y), bf_hi(vv.y)}, v1 = {bf_lo(vv.z), bf_hi(vv.z), bf_lo(vv.w), bf_hi(vv.w)};
        const f32x4 g0 = {bf_lo(gg.x), bf_hi(gg.x), bf_lo(gg.y), bf_hi(gg.y)}, g1 = {bf_lo(gg.z), bf_hi(gg.z), bf_lo(gg.w), bf_hi(gg.w)};
        const f32x4 r0 = (d0 * rstd * gw0 + gb0 + v0 * bon) * g0, r1 = (d1 * rstd * gw1 + gb1 + v1 * bon) * g1;
        u32x4 w; w.x = cvt_pk_bf16(r0[0], r0[1]); w.y = cvt_pk_bf16(r0[2], r0[3]); w.z = cvt_pk_bf16(r1[0], r1[1]); w.w = cvt_pk_bf16(r1[2], r1[3]);
        *(u32x4*)(YS + o) = w;
    }
}

DI void attn_job(const bf16_t* Q, const bf16_t* K, const bf16_t* V, bf16_t* YS, float* LSE, LAS unsigned char* vl, int b, int h, int d, int rho, int J0, bool first, int lane) {
    asm volatile("" : "+v"(lane));
    const int r = lane & 31, hh = lane >> 5;
    const size_t tokq = (size_t)b * SEQ + (size_t)(J0 + r) * d + rho;
    typedef const __attribute__((address_space(1))) bf16x8* GP8;
    typedef const __attribute__((address_space(1))) u32x4* GP4;
    bf16x8 bq[4];
    { const GP8 qp = (GP8)(Q + tokq * 512 + h * 64 + 8 * hh);
#pragma unroll
      for (int s = 0; s < 4; ++s) bq[s] = qp[2 * s]; }
    bf16x8 ak[5][4];
#pragma unroll
    for (int kt = 0; kt < 5; ++kt) {
        const int Jk = J0 - 128 + 32 * kt + r;
        const size_t tokk = (size_t)b * SEQ + (size_t)(Jk >= 0 ? Jk : 0) * d + rho;
        const GP8 kp = (GP8)(K + tokk * 512 + h * 64 + 8 * hh);
#pragma unroll
        for (int s = 0; s < 4; ++s) ak[kt][s] = kp[2 * s];
    }
    asm volatile("" ::: "memory");
    f32x16 sc[5];
#pragma unroll
    for (int kt = 0; kt < 5; ++kt) {
        const bool valid = (J0 - 128 + 32 * kt + r) >= 0;
        f32x16 a;
#pragma unroll
        for (int i = 0; i < 16; ++i) a[i] = 0.f;
#pragma unroll
        for (int s = 0; s < 4; ++s) {
            bf16x8 kf = ak[kt][s];
            if (!valid) kf = (bf16x8){0, 0, 0, 0, 0, 0, 0, 0};
            a = MFMA32(kf, bq[s], a);
        }
        sc[kt] = a;
    }
    float m = -1e30f;
#pragma unroll
    for (int kt = 0; kt < 5; ++kt)
#pragma unroll
        for (int i = 0; i < 16; ++i) {
            const int kidx = 32 * kt + crow(i, hh); const int dist = 128 + r - kidx;
            const bool ok = (dist >= 0) && (dist <= 128) && (J0 - 128 + kidx >= 0);
            const float v = ok ? sc[kt][i] * 0.125f : -1e30f;
            sc[kt][i] = v; m = fmaxf(m, v);
        }
    m = fmaxf(m, __shfl_xor(m, 32));
    float lsum = 0.f;
#pragma unroll
    for (int kt = 0; kt < 5; ++kt)
#pragma unroll
        for (int i = 0; i < 16; ++i) { const float pv = __expf(sc[kt][i] - m); sc[kt][i] = pv; lsum += pv; }
    lsum += __shfl_xor(lsum, 32);
    const float lse = m + __logf(lsum);
    f32x16 o[2];
#pragma unroll
    for (int i = 0; i < 16; ++i) { o[0][i] = 0.f; o[1][i] = 0.f; }
    u32x4 vr[4];
    {
        const int key = lane >> 1, hf = lane & 1; const int Jk = J0 - 128 + key;
        const size_t tokv = (size_t)b * SEQ + (size_t)(Jk >= 0 ? Jk : 0) * d + rho;
        const GP4 src = (GP4)(V + tokv * 512 + h * 64 + 32 * hf);
        vr[0] = src[0]; vr[1] = src[1]; vr[2] = src[2]; vr[3] = src[3];
    }
#pragma unroll
    for (int kt = 0; kt < 5; ++kt) {
        {
            const int key = lane >> 1, hf = lane & 1;
            LAS u32x4* dst = (LAS u32x4*)(vl + key * 128 + hf * 64);
            dst[0] = vr[0]; dst[1] = vr[1]; dst[2] = vr[2]; dst[3] = vr[3];
            if (kt + 1 < 5) {
                const int Jk = J0 - 128 + 32 * (kt + 1) + key;
                const size_t tokv = (size_t)b * SEQ + (size_t)(Jk >= 0 ? Jk : 0) * d + rho;
                const GP4 src = (GP4)(V + tokv * 512 + h * 64 + 32 * hf);
                vr[0] = src[0]; vr[1] = src[1]; vr[2] = src[2]; vr[3] = src[3];
            }
        }
        LDS_WAIT();
#pragma unroll
        for (int s = 0; s < 2; ++s) {
            const bf16x8 xs = pack8(sc[kt][8 * s], sc[kt][8 * s + 1], sc[kt][8 * s + 2], sc[kt][8 * s + 3], sc[kt][8 * s + 4], sc[kt][8 * s + 5], sc[kt][8 * s + 6], sc[kt][8 * s + 7]);
#pragma unroll
            for (int mt = 0; mt < 2; ++mt) {
                bf16x8 pa;
#pragma unroll
                for (int j = 0; j < 8; ++j) { const int key = 16 * s + 8 * (j >> 2) + 4 * hh + (j & 3); pa[j] = (short)*(const LAS bf16_t*)(vl + key * 128 + (r + 32 * mt) * 2); }
                o[mt] = MFMA32(pa, xs, o[mt]);
            }
        }
        LDS_WAIT();
    }
    const float il = 1.0f / lsum;
    float wp = 0.f, wc = 1.0f, nl = lse;
    if (!first) { const float lp = LSE[tokq * 8 + h]; const float mx = fmaxf(lp, lse); const float ep = __expf(lp - mx), ec = __expf(lse - mx); nl = mx + __logf(ep + ec); wp = ep / (ep + ec); wc = ec / (ep + ec); }
#pragma unroll
    for (int mt = 0; mt < 2; ++mt)
#pragma unroll
        for (int g4 = 0; g4 < 4; ++g4) {
            bf16_t* dst = YS + tokq * 512 + h * 64 + 32 * mt + 8 * g4 + 4 * hh;
            float v[4];
#pragma unroll
            for (int j = 0; j < 4; ++j) v[j] = o[mt][4 * g4 + j] * il * wc;
            if (!first) { const u32x2 pw = *(const u32x2*)dst; v[0] += bf_lo(pw.x) * wp; v[1] += bf_hi(pw.x) * wp; v[2] += bf_lo(pw.y) * wp; v[3] += bf_hi(pw.y) * wp; }
            u32x2 w2; w2.x = cvt_pk_bf16(v[0], v[1]); w2.y = cvt_pk_bf16(v[2], v[3]); *(u32x2*)dst = w2;
        }
    if (hh == 0) LSE[tokq * 8 + h] = nl;
}

DI void attention_phase(KP p, LAS unsigned char* lds, int wv) {
    unsigned char* ws = ows(p->ws);
    const bf16_t *Q = (const bf16_t*)(ws + WS_Q), *K = (const bf16_t*)(ws + WS_K), *V = (const bf16_t*)(ws + WS_V);
    bf16_t* YS = (bf16_t*)(ws + WS_YSA); float* LSE = (float*)(ws + WS_LSE);
    const int tid_ = otid(wv); const int wave = tid_ >> 6, lane = tid_ & 63;
    LAS unsigned char* vl = lds + wave * 4096;
    for (int item0 = blockIdx.x; item0 < 256; item0 += gridDim.x) {
        const int item = (((item0 & 7) * 4 + (item0 >> 6)) << 3) | ((item0 >> 3) & 7);
        const int b = item >> 6, h = (item >> 3) & 7, qb = item & 7, P0 = qb * 512;
#pragma unroll 1
        for (int cfg = 0; cfg < 3; ++cfg) {
#pragma unroll 1
            for (int jj = wave; jj < 16; jj += 8) {
                int d, rho, J0;
                if (cfg == 0) { d = 1; rho = 0; J0 = P0 + 32 * jj; }
                else if (cfg == 1) { d = 4; rho = jj & 3; J0 = (P0 >> 2) + 32 * (jj >> 2); }
                else { d = 16; rho = jj; J0 = P0 >> 4; }
                attn_job(Q, K, V, YS, LSE, vl, b, h, d, rho, J0, cfg == 0, lane);
            }
            asm volatile("s_waitcnt vmcnt(0)" ::: "memory");
            __syncthreads();
        }
    }
}

DI void gmlp_phase(KP p, int l, LAS unsigned char* lds, int wv) {
    unsigned char* ws = ows(p->ws);
    const bf16_t* UV = (const bf16_t*)(ws + WS_UV); bf16_t* YS = (bf16_t*)(ws + WS_YSG);
    const float* lng = p->in[17] + l * 512; const float* lnb = p->in[18] + l * 512;
    const float* wsp = p->in[19] + (size_t)l * 8 * 128 * 128; const float* bsp = p->in[20] + (size_t)l * 8 * 128;
    const int tid_ = otid(wv); const int wave = tid_ >> 6, lane = tid_ & 63, r = lane & 31, hh = lane >> 5;
    LAS float* stats = (LAS float*)(lds + 8 * 17408);
    LAS bf16_t* VT = (LAS bf16_t*)(lds + wave * 17408);
    for (int item0 = blockIdx.x; item0 < 256; item0 += gridDim.x) {
        const int item = ((((item0 & 7) << 4) | (item0 >> 4)) << 1) | ((item0 >> 3) & 1);
        const size_t tok0 = (size_t)(item >> 1) * 128;
        __syncthreads();
        for (int tt = 0; tt < 16; ++tt) {
            const int tl = wave * 16 + tt;
            const u32x4 x = *(const u32x4*)(UV + (tok0 + tl) * 1024 + 512 + 8 * lane);
            const float f[8] = {bf_lo(x.x), bf_hi(x.x), bf_lo(x.y), bf_hi(x.y), bf_lo(x.z), bf_hi(x.z), bf_lo(x.w), bf_hi(x.w)};
            float s = 0.f;
#pragma unroll
            for (int j = 0; j < 8; ++j) s += f[j];
            const float mean = wave_sum(s) * (1.0f / 512.0f); float q = 0.f;
#pragma unroll
            for (int j = 0; j < 8; ++j) { const float dd = f[j] - mean; q += dd * dd; }
            const float rstd = rsqrtf(wave_sum(q) * (1.0f / 512.0f) + 1e-5f);
            if (lane == 0) { stats[2 * tl] = mean; stats[2 * tl + 1] = rstd; }
        }
        __syncthreads();
        const int g = (item & 1) * 4 + (wave & 3);
        if (wave < 4) {
        {
            const int d0 = 8 * (lane & 7);
            const f32x4 lg0 = *(const f32x4*)(lng + g * 64 + d0), lg1 = *(const f32x4*)(lng + g * 64 + d0 + 4), lb0 = *(const f32x4*)(lnb + g * 64 + d0), lb1 = *(const f32x4*)(lnb + g * 64 + d0 + 4);
            for (int it = 0; it < 16; ++it) {
                const int tl = it * 8 + (lane >> 3);
                const u32x4 x = *(const u32x4*)(UV + (tok0 + tl) * 1024 + 512 + g * 64 + d0);
                const float mean = stats[2 * tl], rstd = stats[2 * tl + 1];
                const float f[8] = {bf_lo(x.x), bf_hi(x.x), bf_lo(x.y), bf_hi(x.y), bf_lo(x.z), bf_hi(x.z), bf_lo(x.w), bf_hi(x.w)};
#pragma unroll
                for (int e = 0; e < 8; ++e) {
                    const float gg = e < 4 ? lg0[e & 3] : lg1[e & 3], bb = e < 4 ? lb0[e & 3] : lb1[e & 3];
                    const float y = (f[e] - mean) * rstd * gg + bb;
                    VT[(d0 + e) * 136 + tl] = (bf16_t)(cvt_pk_bf16(y, 0.f) & 0xffffu);
                }
            }
        }
        LDS_WAIT();
#pragma unroll 1
        for (int nt = 0; nt < 4; ++nt) {
            f32x16 acc[2];
#pragma unroll
            for (int i = 0; i < 16; ++i) { acc[0][i] = 0.f; acc[1][i] = 0.f; }
            const int irow = 32 * nt + r;
            for (int s = 0; s < 2 * (nt + 1); ++s) {
                const int j0 = 16 * s + 8 * hh;
                const float* wr_ = wsp + ((size_t)g * 128 + irow) * 128 + j0;
                const f32x4 wa = *(const f32x4*)wr_, wb = *(const f32x4*)(wr_ + 4);
                float wv[8] = {wa[0], wa[1], wa[2], wa[3], wb[0], wb[1], wb[2], wb[3]};
#pragma unroll
                for (int j = 0; j < 8; ++j) if (j0 + j > irow) wv[j] = 0.f;
                const bf16x8 bfr = pack8(wv[0], wv[1], wv[2], wv[3], wv[4], wv[5], wv[6], wv[7]);
#pragma unroll
                for (int mt = 0; mt < 2; ++mt) {
                    const bf16x8 afr = *(const LAS bf16x8*)(VT + (32 * mt + r) * 136 + j0);
                    acc[mt] = MFMA32(afr, bfr, acc[mt]);
                }
            }
            const size_t tok = tok0 + irow; const float bs = bsp[g * 128 + irow];
#pragma unroll
            for (int mt = 0; mt < 2; ++mt)
#pragma unroll
                for (int g4 = 0; g4 < 4; ++g4) {
                    const int c = g * 64 + 32 * mt + 8 * g4 + 4 * hh;
                    const u32x2 uu = *(const u32x2*)(UV + tok * 1024 + c);
                    const float o0 = bf_lo(uu.x) * (acc[mt][4 * g4] + bs), o1 = bf_hi(uu.x) * (acc[mt][4 * g4 + 1] + bs), o2 = bf_lo(uu.y) * (acc[mt][4 * g4 + 2] + bs), o3 = bf_hi(uu.y) * (acc[mt][4 * g4 + 3] + bs);
                    u32x2 w2; w2.x = cvt_pk_bf16(o0, o1); w2.y = cvt_pk_bf16(o2, o3); *(u32x2*)(YS + tok * 512 + c) = w2;
                }
        }
        }
    }
}

DI void ffn_fix_phase(KP p, int l, int wv) {
    unsigned char* ws = ows(p->ws);
    bf16_t* ACT = (bf16_t*)(ws + WS_UP); const float* SA = (const float*)(ws + WS_SIDEA); const float* SG = (const float*)(ws + WS_SIDEG);
    const float* cw = p->in[25] + (size_t)l * 3 * DFF; const float* cb = p->in[26] + (size_t)l * DFF;
    constexpr int NCG = DFF / 8;
    const int tid_ = otid(wv);
    for (int item = blockIdx.x * 512 + tid_; item < 256 * 2 * NCG; item += gridDim.x * 512) {
        const int cgi = item % NCG, qe = item / NCG, q = qe >> 1, e = qe & 1, f = 8 * cgi;
        const bool first = (q & 63) == 0;
        float o[8];
#pragma unroll
        for (int hf = 0; hf < 2; ++hf) {
            const int ff = f + 4 * hf;
            const f32x4 at = *(const f32x4*)(SA + ((size_t)q * 4 + e) * DFF + ff);
            f32x4 t1 = {0.f, 0.f, 0.f, 0.f}, t2 = {0.f, 0.f, 0.f, 0.f};
            if (e == 1) t1 = *(const f32x4*)(SA + ((size_t)q * 4 + 0) * DFF + ff);
            else if (!first) t1 = *(const f32x4*)(SA + ((size_t)(q - 1) * 4 + 3) * DFF + ff);
            if (!first) t2 = *(const f32x4*)(SA + ((size_t)(q - 1) * 4 + (e == 1 ? 3 : 2)) * DFF + ff);
            const f32x4 g = *(const f32x4*)(SG + ((size_t)q * 2 + e) * DFF + ff);
            const f32x4 w0 = *(const f32x4*)(cw + ff), w1 = *(const f32x4*)(cw + DFF + ff), w2 = *(const f32x4*)(cw + 2 * DFF + ff), bb = *(const f32x4*)(cb + ff);
            const f32x4 c = bb + w0 * t2 + w1 * t1 + w2 * at;
#pragma unroll
            for (int j = 0; j < 4; ++j) o[4 * hf + j] = gelu_tanh(c[j]) * g[j];
        }
        u32x4 w; w.x = cvt_pk_bf16(o[0], o[1]); w.y = cvt_pk_bf16(o[2], o[3]); w.z = cvt_pk_bf16(o[4], o[5]); w.w = cvt_pk_bf16(o[6], o[7]);
        *(u32x4*)(ACT + (size_t)(64 * q + e) * DFF + f) = w;
    }
}

__global__ void __launch_bounds__(512) fwd_megakernel(Params p_unused) {
    extern __shared__ __attribute__((aligned(16))) unsigned char lds_raw[];
    LAS unsigned char* lds = (LAS unsigned char*)lds_raw;
    cg::grid_group grid = cg::this_grid();
    KP p = okp();
    unsigned char* ws = p->ws;
    const int G = gridDim.x, c = blockIdx.x;
    const int wv = __builtin_amdgcn_readfirstlane((int)(threadIdx.x >> 6));
    pg8::Epi E; pg8::TileOrder S; pg8::Gemm g;

    unsigned* bar = (unsigned*)(ws + WS_BAR);
    volatile LAS unsigned* xst = (volatile LAS unsigned*)(lds + LDS_BYTES - 16);
    const unsigned myx = xb_xcc_id();
    if (otid(wv) == 0) { xb_add(&bar[XB_CNT(myx)], 1u); __builtin_amdgcn_fence(__ATOMIC_RELEASE, "agent"); }
    grid.sync();
    if (otid(wv) == 0) {
        unsigned mine = 0u, cnt = 0u;
#pragma unroll
        for (unsigned j = 0; j < 8; ++j) { const unsigned c = xb_ld(&bar[XB_CNT(j)]); cnt += (c > 0u) ? 1u : 0u; mine = (j == myx) ? c : mine; }
        xst[0] = mine > 0u ? mine : 1u; xst[1] = cnt > 0u ? cnt : 1u; xst[2] = myx;
    }
    __syncthreads();
    phase0(p, lds, wv);
    gbar(bar, xst, wv);
#pragma unroll 1
    for (int st = 0; st < 2 * 12; ++st) {
        const int l = st / 12, step = st % 12;
        p = okp(); ws = ows(p->ws);
        const float* mod = (const float*)(ws + WS_MOD); const bf16_t* H = (const bf16_t*)(ws + WS_H);
        const float* ml = mod + (size_t)l * 4 * 6144;
        const float* xin = (l == 0) ? p->in[0] : p->out;
        bool do_gemm = false;
        E = pg8::Epi{}; g.merge = 0; g.ws = ws;
        if (step == 0) {
            if (l > 0) convert_weights(p, l, lds, wv);
            norm_mod_phase(xin, p->in[4] + l * DM, ml + 0, ml + 1024, (bf16_t*)(ws + WS_H), wv);
        } else if (step == 1 || step == 4) {
            if (step == 4) rwkv_post_phase(p, l, wv);
            E.mode = pg8::EM_INPROJ; E.o0 = (bf16_t*)(ws + WS_Q); E.o1 = (bf16_t*)(ws + WS_K); E.o2 = (bf16_t*)(ws + WS_V); E.o3 = (bf16_t*)(ws + WS_RAW); E.o4 = (bf16_t*)(ws + WS_UV);
            E.ropec = (const float*)(ws + WS_ROPEC); E.ropes = (const float*)(ws + WS_ROPES);
            g.A = H; g.Bt = (const bf16_t*)(ws + WS_WIN); g.lda = 1024; g.K = 1024;
            if (step == 1) S.init(64, 7, G, c, 7, 6, 0); else S.init(64, 10, G, c, 6, 0, 13);
            do_gemm = true;
        } else if (step == 2) { rwkv_derived_phase(p, l, wv); }
        else if (step == 3) { rwkv_scan_phase(p, lds, wv); }
        else if (step == 5) { attention_phase(p, lds, wv); gmlp_phase(p, l, lds, wv); }
        else if (step == 6) {
            E.mode = pg8::EM_MERGE; E.o0 = (bf16_t*)(ws + WS_GATE); E.o1 = (bf16_t*)(ws + WS_MB);
            g.merge = 1; g.A = H; g.Bt = (const bf16_t*)(ws + WS_WIN); g.lda = 1024; g.K = 1024;
            S.init(64, 4, G, c, 4, 0, 0, 6);
            do_gemm = true;
        } else if (step == 7) {
            E.mode = pg8::EM_RESID; E.f0 = p->out; E.f1 = xin; E.f2 = ml + 2048;
            g.A = (const bf16_t*)(ws + WS_MB); g.Bt = (const bf16_t*)(ws + WS_WOUT); g.lda = 1024; g.K = 1024;
            S.init(64, 4, G, c, 4, 0, 0); do_gemm = true;
        } else if (step == 8) { norm_mod_phase(p->out, p->in[23] + l * DM, ml + 3072, ml + 4096, (bf16_t*)(ws + WS_H), wv); }
        else if (step == 9) {
            E.mode = pg8::EM_UP; E.o0 = (bf16_t*)(ws + WS_UP); E.f0 = (float*)(ws + WS_SIDEA); E.f3 = (float*)(ws + WS_SIDEG); E.f1 = p->in[25] + (size_t)l * 3 * DFF; E.f2 = p->in[26] + (size_t)l * DFF;
            g.A = H; g.Bt = (const bf16_t*)(ws + WS_WUP); g.lda = 1024; g.K = 1024;
            S.init(64, 22, G, c, 22, 0, 0); do_gemm = true;
        } else if (step == 10) { ffn_fix_phase(p, l, wv); }
        else {
            E.mode = pg8::EM_RESID; E.f0 = p->out; E.f1 = p->out; E.f2 = ml + 5120;
            g.A = (const bf16_t*)(ws + WS_UP); g.Bt = (const bf16_t*)(ws + WS_WDN); g.lda = DFF; g.K = DFF;
            S.init(64, 4, G, c, 4, 0, 0); do_gemm = true;
        }
        if (do_gemm) pg8::gemm_phase(lds, g, S, E, wv);
        gbar((unsigned*)(ws + WS_BAR), xst, wv);
    }
    p = okp();
    final_norm_phase(p->out, p->in[28], wv);
}

extern "C" void kernel_launch(void* const* d_in, const int* in_sizes, int n_in, void* d_out, int out_size, void* d_ws, size_t ws_size, hipStream_t stream) {
    static int grid_blocks = 0;
    if (grid_blocks == 0) {
        int dev = 0, cus = 0, per_cu = 0;
        hipGetDevice(&dev);
        hipDeviceGetAttribute(&cus, hipDeviceAttributeMultiprocessorCount, dev);
        if (hipFuncSetAttribute((const void*)fwd_megakernel, hipFuncAttributeMaxDynamicSharedMemorySize, LDS_BYTES) != hipSuccess) { fprintf(stderr, "hipFuncSetAttribute failed\n"); }
        hipOccupancyMaxActiveBlocksPerMultiprocessor(&per_cu, (const void*)fwd_megakernel, 512, LDS_BYTES);
        if (per_cu < 1) { fprintf(stderr, "occupancy query returned %d\n", per_cu); per_cu = 1; }
        if (per_cu > 1) per_cu = 1;
        grid_blocks = cus * per_cu;
        (void)hipGetLastError();
    }
    if (n_in != 29 || ws_size < 256 * MiB) { fprintf(stderr, "unexpected inputs/workspace\n"); return; }
    (void)hipMemsetAsync((unsigned char*)d_ws + WS_BAR, 0, XB_WORDS * 4, stream);
    Params p{};
    for (int i = 0; i < 29; ++i) p.in[i] = (const float*)d_in[i];
    p.out = (float*)d_out; p.ws = (unsigned char*)d_ws;
    void* args[] = {&p};
    hipError_t e = hipLaunchCooperativeKernel((const void*)fwd_megakernel, dim3(grid_blocks), dim3(512), args, LDS_BYTES, stream);
    if (e != hipSuccess) fprintf(stderr, "cooperative launch failed: %s (grid %d)\n", hipGetErrorString(e), grid_blocks);
}
```

```cpp
#include <hip/hip_runtime.h>
#include <hip/hip_cooperative_groups.h>
#include <cstdio>
#include <cstdint>
namespace cg = cooperative_groups;

#define LAS __attribute__((address_space(3)))
#define DI __device__ __forceinline__
typedef unsigned short bf16_t;
typedef short bf16x8 __attribute__((ext_vector_type(8)));
typedef float f32x4 __attribute__((ext_vector_type(4)));
typedef float f32x16 __attribute__((ext_vector_type(16)));
typedef unsigned u32x4 __attribute__((ext_vector_type(4)));
typedef unsigned u32x2 __attribute__((ext_vector_type(2)));

constexpr int DM = 1024, SEQ = 4096, MTOK = 16384, INC = 7424, DFF = 2816, UPC = 5632, RAWC = 1792;
constexpr int LDS_BYTES = 147456;
constexpr size_t MiB = 1048576;
constexpr size_t WS_WIN = 0, WS_WBR = WS_WIN + (size_t)INC * 1024 * 2, WS_WOUT = WS_WBR + 3u * 1024 * 512 * 2, WS_WUP = WS_WOUT + 1024u * 1024 * 2,
                 WS_WDN = WS_WUP + (size_t)UPC * 1024 * 2, WS_LWU = WS_WDN + (size_t)DFF * 1024 * 2, WS_LAU = WS_LWU + 65536, WS_LGU = WS_LAU + 65536;
constexpr size_t WS_H = 37 * MiB;
constexpr size_t WS_SMALL = 69 * MiB, WS_MOD = WS_SMALL, WS_ROPEC = WS_MOD + 262144, WS_ROPES = WS_ROPEC + 524288, WS_BONUS = WS_ROPES + 524288, WS_LSE = WS_BONUS + 524288;
constexpr size_t WS_BAR = WS_LSE + 524288;
constexpr size_t DB = 72 * MiB;
constexpr size_t WS_RAW = DB, WS_RZ = DB + 56 * MiB, WS_KP = DB + 72 * MiB, WS_KKN = DB + 88 * MiB, WS_B = DB + 104 * MiB, WS_W = DB + 120 * MiB, WS_VZ = DB + 152 * MiB, WS_G = DB + 168 * MiB;
constexpr size_t WS_YRAW = DB, WS_YSR = DB + 32 * MiB;
constexpr size_t WS_Q = DB + 56 * MiB, WS_K = DB + 72 * MiB, WS_V = DB + 88 * MiB, WS_UV = DB + 104 * MiB;
constexpr size_t WS_YSA = DB + 152 * MiB, WS_YSG = DB + 168 * MiB;
constexpr size_t WS_GATE = DB, WS_M32 = DB + 48 * MiB, WS_MB = DB + 112 * MiB;
constexpr size_t WS_UP = DB;
constexpr size_t WS_SIDEA = DB + 88 * MiB, WS_SIDEG = DB + 100 * MiB;
static_assert(WS_LGU + 131072 <= WS_H, "weights region overflow");
static_assert(WS_BAR + 64 * 26 * 4 <= DB, "small region overflow");

struct Params {
    const float* in[29];
    float* out;
    unsigned char* ws;
};

typedef const __attribute__((address_space(4))) Params* KP;
DI KP okp() { unsigned long long k = (unsigned long long)__builtin_amdgcn_kernarg_segment_ptr(); asm volatile("" : "+s"(k)); return (KP)k; }
typedef float f32x2_t __attribute__((ext_vector_type(2)));
typedef __bf16 bf16x2_t __attribute__((ext_vector_type(2)));
DI unsigned cvt_pk_bf16(float lo, float hi) { const f32x2_t v = {lo, hi}; const bf16x2_t r = __builtin_convertvector(v, bf16x2_t); return __builtin_bit_cast(unsigned, r); }
DI float bf_lo(unsigned w) { return __uint_as_float(w << 16); }
DI float bf_hi(unsigned w) { return __uint_as_float(w & 0xffff0000u); }
DI int otid(int wv) { int ln; asm volatile("v_mbcnt_lo_u32_b32 %0, -1, 0\n\tv_mbcnt_hi_u32_b32 %0, -1, %0" : "=v"(ln)); return wv * 64 + ln; }
DI unsigned char* ows(unsigned char* w) { asm volatile("" : "+s"(w)); return w; }
DI float row16_sum(float v) {
    v += __builtin_bit_cast(float, __builtin_amdgcn_update_dpp(0, __builtin_bit_cast(int, v), 0xB1, 0xF, 0xF, false));
    v += __builtin_bit_cast(float, __builtin_amdgcn_update_dpp(0, __builtin_bit_cast(int, v), 0x4E, 0xF, 0xF, false));
    v += __builtin_bit_cast(float, __builtin_amdgcn_update_dpp(0, __builtin_bit_cast(int, v), 0x141, 0xF, 0xF, false));
    v += __builtin_bit_cast(float, __builtin_amdgcn_update_dpp(0, __builtin_bit_cast(int, v), 0x140, 0xF, 0xF, false));
    return v;
}
DI float wave_sum(float v) { v = row16_sum(v); v += __shfl_xor(v, 16); v += __shfl_xor(v, 32); return v; }
#define XB_CNT(j)  (64 * (j))
#define XB_SUB(j)  (64 * (8 + (j)))
#define XB_GEN(j)  (64 * (16 + (j)))
#define XB_TOP     (64 * 24)
#define XB_TOPGEN  (64 * 25)
#define XB_WORDS   (64 * 26)
DI unsigned xb_ld(unsigned* p) { return __hip_atomic_load(p, __ATOMIC_RELAXED, __HIP_MEMORY_SCOPE_AGENT); }
DI unsigned xb_add(unsigned* p, unsigned v) { return __hip_atomic_fetch_add(p, v, __ATOMIC_RELAXED, __HIP_MEMORY_SCOPE_AGENT); }
DI unsigned xb_xcc_id() { return (unsigned)__builtin_amdgcn_s_getreg((3 << 11) | 20) & 0x7u; }
DI void gbar(unsigned* bar, volatile LAS unsigned* st, int wv) {
    asm volatile("s_waitcnt vmcnt(0) lgkmcnt(0)" ::: "memory");
    __syncthreads();
    if (otid(wv) == 0) {
        const unsigned nloc = st[0], nx = st[1], x = st[2];
        const unsigned old = xb_add(&bar[XB_SUB(x)], 1u);
        const unsigned gen = old / nloc;
        if (old + 1u == (gen + 1u) * nloc) {
            __builtin_amdgcn_fence(__ATOMIC_RELEASE, "agent");
            asm volatile("s_waitcnt vmcnt(0)" ::: "memory");
            const unsigned og = xb_add(&bar[XB_TOP], 1u);
            const unsigned tg = og / nx;
            if (og + 1u == (tg + 1u) * nx) xb_add(&bar[XB_TOPGEN], 1u);
            else { while (xb_ld(&bar[XB_TOPGEN]) == tg) __builtin_amdgcn_s_sleep(1); }
            __builtin_amdgcn_fence(__ATOMIC_ACQUIRE, "agent");
            xb_add(&bar[XB_GEN(x)], 1u);
            asm volatile("s_waitcnt vmcnt(0)" ::: "memory");
        } else {
            while (xb_ld(&bar[XB_GEN(x)]) == gen) __builtin_amdgcn_s_sleep(1);
            __builtin_amdgcn_fence(__ATOMIC_ACQUIRE, "agent");
            asm volatile("s_waitcnt vmcnt(0)" ::: "memory");
        }
    }
    asm volatile("" ::: "memory");
    __syncthreads();
}
DI float sigmoidf_(float x) { return __builtin_amdgcn_rcpf(1.0f + __expf(-x)); }
DI float gelu_tanh(float x) { const float u = 1.5957691216f * (x + 0.044715f * x * x * x); return x * __builtin_amdgcn_rcpf(1.0f + __expf(-u)); }
#define LDS_WAIT() asm volatile("s_waitcnt lgkmcnt(0)" ::: "memory")
#define MFMA32(a, b, c) __builtin_amdgcn_mfma_f32_32x32x16_bf16((a), (b), (c), 0, 0, 0)
DI int crow(int reg, int h) { return (reg & 3) + 8 * (reg >> 2) + 4 * h; }
DI bf16x8 pack8(float a0, float a1, float a2, float a3, float a4, float a5, float a6, float a7) {
    u32x4 p; p.x = cvt_pk_bf16(a0, a1); p.y = cvt_pk_bf16(a2, a3); p.z = cvt_pk_bf16(a4, a5); p.w = cvt_pk_bf16(a6, a7);
    return __builtin_bit_cast(bf16x8, p);
}

namespace pg8 {
constexpr int BM = 256, BK = 64, HALF = 128, HTB = HALF * BK * 2, STAGE_BYTES = 8 * HTB, NXCD = 8, WGM = 8;
DI int lds_byte(int r, int c) { const int st = (r >> 4) * 2 + (c >> 5), rr = r & 15, cc = c & 31, ob = rr * 64 + cc * 2; return st * 1024 + (ob ^ (((ob >> 9) & 1) << 5)); }
DI void stage_rc(int b, int& R, int& C) { const int st = b / 1024, sb = b % 1024, swz = sb ^ (((sb >> 9) & 1) << 5); R = (st >> 1) * 16 + swz / 64; C = (st & 1) * 32 + (swz % 64) / 2; }
DI int perm32(int rho) { const int n = rho >> 4, i = rho & 15; return 8 * (i >> 2) + 4 * n + (i & 3); }
struct Unit { int pm, pn, sub; };
struct Gemm { const bf16_t* A; const bf16_t* Bt; int lda, K; int merge; const unsigned char* ws; };
struct TileOrder {
    int nM, nN, nwg, G, c, split, off0, off1, nsub;
    DI void init(int nM_, int nN_, int G_, int c_, int split_, int off0_, int off1_, int nsub_ = 1) { nM = nM_; nN = nN_; nwg = nM * nN; G = G_; c = c_; split = split_; off0 = off0_; off1 = off1_; nsub = nsub_; }
    DI bool next(int i0, Unit& u) const {
        const int i = i0 / nsub; u.sub = i0 - i * nsub;
        const long L = (long)i * G + c; if (L >= nwg) return false;
        int wgid = (int)L; { const int q = nwg / NXCD, r = nwg % NXCD, xcd = wgid % NXCD, off = wgid / NXCD; wgid = (xcd < r ? xcd * (q + 1) : r * (q + 1) + (xcd - r) * q) + off; }
        const int nig = WGM * nN, gid = wgid / nig, fm = gid * WGM, gsz = (nM - fm) < WGM ? (nM - fm) : WGM;
        u.pm = fm + ((wgid % nig) % gsz); const int pnv = (wgid % nig) / gsz; u.pn = pnv < split ? pnv + off0 : pnv - split + off1; return true;
    }
};

enum { EM_INPROJ = 0, EM_GATE = 1, EM_BR_FIRST = 2, EM_BR_MID = 3, EM_BR_LAST = 4, EM_RESID = 5, EM_UP = 6, EM_MERGE = 7 };
struct Epi {
    int mode;
    bf16_t *o0, *o1, *o2, *o3, *o4;
    float* f3;
    float* f0; const float* f1; const float* f2;
    const float *ropec, *ropes;
    DI void up_conv(const f32x4 (&acc)[2][2][4][2], const Unit& u, int wr, int wc, int fr, int fq) const {
        const int f = u.pn * 128 + wc * 32 + 8 * fq;
        const int src1 = (fq << 4) | ((fr + 15) & 15), src2 = (fq << 4) | ((fr + 14) & 15);
        const f32x4 w0a = *(const f32x4*)(f1 + f), w0b = *(const f32x4*)(f1 + f + 4), w1a = *(const f32x4*)(f1 + DFF + f), w1b = *(const f32x4*)(f1 + DFF + f + 4);
        const f32x4 w2a = *(const f32x4*)(f1 + 2 * DFF + f), w2b = *(const f32x4*)(f1 + 2 * DFF + f + 4), cba = *(const f32x4*)(f2 + f), cbb = *(const f32x4*)(f2 + f + 4);
#pragma unroll
        for (int ai = 0; ai < 2; ++ai) {
            const int q = u.pm * 4 + ai * 2 + wr;
            f32x4 p1a_prev = {0.f, 0.f, 0.f, 0.f}, p1b_prev = p1a_prev, p2a_prev = p1a_prev, p2b_prev = p1a_prev;
#pragma unroll
            for (int m = 0; m < 4; ++m) {
                const f32x4 aa = acc[ai][0][m][0], ab = acc[ai][0][m][1], ga = acc[ai][1][m][0], gb = acc[ai][1][m][1];
                f32x4 p1a, p1b, p2a, p2b;
#pragma unroll
                for (int j = 0; j < 4; ++j) {
                    p1a[j] = __shfl(aa[j], src1); p1b[j] = __shfl(ab[j], src1); p2a[j] = __shfl(aa[j], src2); p2b[j] = __shfl(ab[j], src2);
                }
                const f32x4 t1a = fr >= 1 ? p1a : p1a_prev, t1b = fr >= 1 ? p1b : p1b_prev, t2a = fr >= 2 ? p2a : p2a_prev, t2b = fr >= 2 ? p2b : p2b_prev;
                const f32x4 ca = cba + w0a * t2a + w1a * t1a + w2a * aa, cb_ = cbb + w0b * t2b + w1b * t1b + w2b * ab;
                const int row = u.pm * BM + ai * HALF + wr * 64 + m * 16 + fr;
                u32x4 w;
                w.x = cvt_pk_bf16(gelu_tanh(ca[0]) * ga[0], gelu_tanh(ca[1]) * ga[1]); w.y = cvt_pk_bf16(gelu_tanh(ca[2]) * ga[2], gelu_tanh(ca[3]) * ga[3]);
                w.z = cvt_pk_bf16(gelu_tanh(cb_[0]) * gb[0], gelu_tanh(cb_[1]) * gb[1]); w.w = cvt_pk_bf16(gelu_tanh(cb_[2]) * gb[2], gelu_tanh(cb_[3]) * gb[3]);
                *(u32x4*)(o0 + (size_t)row * DFF + f) = w;
                if (m == 0 && fr < 2) {
                    float* sa = f0 + ((size_t)q * 4 + fr) * DFF + f; *(f32x4*)sa = aa; *(f32x4*)(sa + 4) = ab;
                    float* sg = f3 + ((size_t)q * 2 + fr) * DFF + f; *(f32x4*)sg = ga; *(f32x4*)(sg + 4) = gb;
                }
                if (m == 3 && fr >= 14) { float* sa = f0 + ((size_t)q * 4 + 2 + (fr - 14)) * DFF + f; *(f32x4*)sa = aa; *(f32x4*)(sa + 4) = ab; }
                p1a_prev = p1a; p1b_prev = p1b; p2a_prev = p2a; p2b_prev = p2b;
            }
        }
    }
    DI void operator()(const f32x4 (&acc)[2][2][4][2], const Unit& u, int wr, int wc, int fr, int fq) const {
        if (mode == EM_UP) { up_conv(acc, u, wr, wc, fr, fq); return; }
        const int mode = (this->mode == EM_MERGE) ? (((u.sub & 1) == 0) ? (int)EM_GATE : ((u.sub >> 1) == 0 ? (int)EM_BR_FIRST : ((u.sub >> 1) == 1 ? (int)EM_BR_MID : (int)EM_BR_LAST))) : this->mode;
        const int row0 = u.pm * BM + wr * 64 + fr, colb = u.pn * BM + wc * 32 + 8 * fq;
        if (mode == EM_RESID) {
            const float* gv = f2 + (size_t)(row0 >> 12) * 6144 + colb;
            const f32x4 g00 = *(const f32x4*)gv, g01 = *(const f32x4*)(gv + 4), g10 = *(const f32x4*)(gv + HALF), g11 = *(const f32x4*)(gv + HALF + 4);
#pragma unroll
            for (int ai = 0; ai < 2; ++ai) {
                f32x4 b0[4][2], b1[4][2];
#pragma unroll
                for (int m = 0; m < 4; ++m)
#pragma unroll
                    for (int bj = 0; bj < 2; ++bj) { const size_t off = (size_t)(row0 + ai * HALF + m * 16) * 1024 + colb + bj * HALF; b0[m][bj] = *(const f32x4*)(f1 + off); b1[m][bj] = *(const f32x4*)(f1 + off + 4); }
                asm volatile("" ::: "memory");
#pragma unroll
                for (int m = 0; m < 4; ++m)
#pragma unroll
                    for (int bj = 0; bj < 2; ++bj) { const size_t off = (size_t)(row0 + ai * HALF + m * 16) * 1024 + colb + bj * HALF;
                        *(f32x4*)(f0 + off) = b0[m][bj] + (bj ? g10 : g00) * acc[ai][bj][m][0]; *(f32x4*)(f0 + off + 4) = b1[m][bj] + (bj ? g11 : g01) * acc[ai][bj][m][1]; }
            }
            return;
        }
        if (mode == EM_BR_FIRST || mode == EM_BR_MID || mode == EM_BR_LAST) {
#pragma unroll
            for (int ai = 0; ai < 2; ++ai) {
                u32x4 gw[4][2], pm[4][2];
#pragma unroll
                for (int m = 0; m < 4; ++m)
#pragma unroll
                    for (int bj = 0; bj < 2; ++bj) { const size_t off = (size_t)(row0 + ai * HALF + m * 16) * 1024 + colb + bj * HALF; gw[m][bj] = *(const u32x4*)(o0 + off);
                        pm[m][bj] = (u32x4){0u, 0u, 0u, 0u}; if (mode != EM_BR_FIRST) pm[m][bj] = *(const u32x4*)(o1 + off); }
                asm volatile("" ::: "memory");
#pragma unroll
                for (int m = 0; m < 4; ++m)
#pragma unroll
                    for (int bj = 0; bj < 2; ++bj) { const size_t off = (size_t)(row0 + ai * HALF + m * 16) * 1024 + colb + bj * HALF;
                        const f32x4 v0 = acc[ai][bj][m][0], v1 = acc[ai][bj][m][1]; const u32x4 g_ = gw[m][bj], q_ = pm[m][bj];
                        u32x4 w;
                        w.x = cvt_pk_bf16(bf_lo(g_.x) * v0[0] + bf_lo(q_.x), bf_hi(g_.x) * v0[1] + bf_hi(q_.x)); w.y = cvt_pk_bf16(bf_lo(g_.y) * v0[2] + bf_lo(q_.y), bf_hi(g_.y) * v0[3] + bf_hi(q_.y));
                        w.z = cvt_pk_bf16(bf_lo(g_.z) * v1[0] + bf_lo(q_.z), bf_hi(g_.z) * v1[1] + bf_hi(q_.z)); w.w = cvt_pk_bf16(bf_lo(g_.w) * v1[2] + bf_lo(q_.w), bf_hi(g_.w) * v1[3] + bf_hi(q_.w));
                        *(u32x4*)(o1 + off) = w; }
            }
            return;
        }
#pragma unroll
        for (int ai = 0; ai < 2; ++ai) {
            f32x4 csn[4][2], snn[4][2];
            if (mode == EM_INPROJ && u.pn < 4) {
#pragma unroll
                for (int m = 0; m < 4; ++m)
#pragma unroll
                    for (int bj = 0; bj < 2; ++bj) { const int pos = (row0 + ai * HALF + m * 16) & (SEQ - 1), e0 = ((colb + bj * HALF) & 63) >> 1;
                        csn[m][bj] = *(const f32x4*)(ropec + pos * 32 + e0); snn[m][bj] = *(const f32x4*)(ropes + pos * 32 + e0); }
                asm volatile("" ::: "memory");
            }
#pragma unroll
            for (int m = 0; m < 4; ++m) {
                const int row = row0 + ai * HALF + m * 16;
#pragma unroll
                for (int bj = 0; bj < 2; ++bj) {
                    const int col0 = colb + bj * HALF;
                    f32x4 v0 = acc[ai][bj][m][0], v1 = acc[ai][bj][m][1];
                    if (mode == EM_INPROJ) {
                        bf16_t* dst;
                        if (u.pn < 4) {
                            const f32x4 cs = csn[m][bj], sn = snn[m][bj];
                            f32x4 a, b;
                            a[0] = v0[0] * cs[0] - v0[1] * sn[0]; a[1] = v0[1] * cs[0] + v0[0] * sn[0];
                            a[2] = v0[2] * cs[1] - v0[3] * sn[1]; a[3] = v0[3] * cs[1] + v0[2] * sn[1];
                            b[0] = v1[0] * cs[2] - v1[1] * sn[2]; b[1] = v1[1] * cs[2] + v1[0] * sn[2];
                            b[2] = v1[2] * cs[3] - v1[3] * sn[3]; b[3] = v1[3] * cs[3] + v1[2] * sn[3];
                            v0 = a; v1 = b;
                            dst = (u.pn < 2) ? o0 + (size_t)row * 512 + col0 : o1 + (size_t)row * 512 + (col0 - 512);
                        } else if (u.pn < 6) { dst = o2 + (size_t)row * 512 + (col0 - 1024); }
                        else if (u.pn < 13) { dst = o3 + (size_t)row * RAWC + (col0 - 1536); }
                        else {
#pragma unroll
                            for (int j = 0; j < 4; ++j) { v0[j] = gelu_tanh(v0[j]); v1[j] = gelu_tanh(v1[j]); }
                            dst = o4 + (size_t)row * 1024 + (col0 - 3328);
                        }
                        u32x4 w; w.x = cvt_pk_bf16(v0[0], v0[1]); w.y = cvt_pk_bf16(v0[2], v0[3]); w.z = cvt_pk_bf16(v1[0], v1[1]); w.w = cvt_pk_bf16(v1[2], v1[3]);
                        *(u32x4*)dst = w;
                    } else {
#pragma unroll
                        for (int j = 0; j < 4; ++j) { v0[j] = sigmoidf_(v0[j]); v1[j] = sigmoidf_(v1[j]); }
                        u32x4 w; w.x = cvt_pk_bf16(v0[0], v0[1]); w.y = cvt_pk_bf16(v0[2], v0[3]); w.z = cvt_pk_bf16(v1[0], v1[1]); w.w = cvt_pk_bf16(v1[2], v1[3]);
                        *(u32x4*)(o0 + (size_t)row * 1024 + col0) = w;
                    }
                }
            }
        }
    }
};

DI void unit_operands(const Gemm& g, int sub, const char*& A, const char*& Bt, int& lda, int& K) {
    if (!g.merge) { A = (const char*)g.A; Bt = (const char*)g.Bt; lda = g.lda; K = g.K; return; }
    const int br = sub >> 1;
    if ((sub & 1) == 0) { A = (const char*)(g.ws + WS_H); Bt = (const char*)(g.ws + WS_WIN) + (size_t)(4352 + 1024 * br) * 1024 * 2; lda = 1024; K = 1024; }
    else { A = (const char*)(g.ws + (br == 0 ? WS_YSA : (br == 1 ? WS_YSR : WS_YSG))); Bt = (const char*)(g.ws + WS_WBR) + (size_t)br * 1024 * 512 * 2; lda = 512; K = 512; }
}
DI void gemm_phase(LAS unsigned char* lds, const Gemm g, const TileOrder S, const Epi E, int wv) {
    const int tid = otid(wv), wid = __builtin_amdgcn_readfirstlane(tid >> 6), lane = tid & 63, wr = wid >> 2, wc = wid & 3, fr = lane & 15, fq = lane >> 4;
    int stR[2], stC[2], stRb[2];
#pragma unroll
    for (int i = 0; i < 2; ++i) { int R, C; stage_rc(tid * 16 + i * 8192, R, C); stR[i] = R; stC[i] = C; stRb[i] = (R & ~31) + perm32(R & 31); }
    const size_t kstep = (size_t)(BK * 2);
    const unsigned ldsw = (unsigned)wid * 1024u;
    const int aoff = lds_byte(wr * 64 + fr, fq * 8), boff = lds_byte(wc * 32 + fr, fq * 8);
#define PG8_SA(b, h) (((b) * 2 + (h)) * HTB)
#define PG8_SB(b, h) ((4 + (b) * 2 + (h)) * HTB)
#define PG8_STAGE(bufoff, gbase, voff) do { _Pragma("unroll") for (int _i = 0; _i < 2; ++_i) \
        __builtin_amdgcn_global_load_lds((const unsigned*)((const char*)(gbase) + (voff)[_i]), (LAS unsigned*)(lds + (bufoff) + ldsw + _i * 8192), 16, 0, 0); } while (0)
#define PG8_LDA(dst, b, h) do { _Pragma("unroll") for (int m = 0; m < 4; ++m) _Pragma("unroll") for (int k = 0; k < 2; ++k) dst[m][k] = *(const LAS bf16x8*)(lds + PG8_SA(b, h) + aoff + m * 2048 + k * 1024); } while (0)
#define PG8_LDB(dst, b, h) do { _Pragma("unroll") for (int n = 0; n < 2; ++n) _Pragma("unroll") for (int k = 0; k < 2; ++k) dst[n][k] = *(const LAS bf16x8*)(lds + PG8_SB(b, h) + boff + n * 2048 + k * 1024); } while (0)
#define PG8_MMA(ai, bj, At, Bt) do { __builtin_amdgcn_s_setprio(1); _Pragma("unroll") for (int m = 0; m < 4; ++m) _Pragma("unroll") for (int n = 0; n < 2; ++n) _Pragma("unroll") for (int k = 0; k < 2; ++k) \
        acc[ai][bj][m][n] = __builtin_amdgcn_mfma_f32_16x16x32_bf16(Bt[n][k], At[m][k], acc[ai][bj][m][n], 0, 0, 0); __builtin_amdgcn_s_setprio(0); } while (0)
#define PG8_WAIT_V(n) asm volatile("s_waitcnt vmcnt(" #n ")" ::: "memory")
#define PG8_WAIT_L(n) asm volatile("s_waitcnt lgkmcnt(" #n ")" ::: "memory")
#define PG8_BAR __builtin_amdgcn_s_barrier()
#define PG8_SCHED __builtin_amdgcn_sched_barrier(0)
#define PG8_SETUP(u, pA, pB, vA, vB, hA, hB, ntv) do { const char* _A; const char* _B; int _lda, _K; unit_operands(g, (u).sub, _A, _B, _lda, _K); \
        pA = _A + (size_t)(u).pm * 256 * _lda * 2; pB = _B + (size_t)(u).pn * 256 * _K * 2; hA = (size_t)HALF * _lda * 2; hB = (size_t)HALF * _K * 2; ntv = _K / BK; \
        _Pragma("unroll") for (int _i = 0; _i < 2; ++_i) { vA[_i] = (unsigned)(stR[_i] * _lda + stC[_i]) * 2u; vB[_i] = (unsigned)(stRb[_i] * _K + stC[_i]) * 2u; } } while (0)
    Unit cur, nxt; int ui = 0;
    if (!S.next(0, cur)) return;
    f32x4 acc[2][2][4][2];
#pragma unroll
    for (int a = 0; a < 2; ++a)
#pragma unroll
        for (int b = 0; b < 2; ++b)
#pragma unroll
            for (int m = 0; m < 4; ++m)
#pragma unroll
                for (int n = 0; n < 2; ++n) acc[a][b][m][n] = (f32x4){0.f, 0.f, 0.f, 0.f};
    bf16x8 At[4][2], B0[2][2], B1[2][2];
    const char *cA, *cB, *nA, *nB; unsigned vAc[2], vBc[2], vAn[2], vBn[2]; size_t hAc, hBc, hAn, hBn; int nt, ntn;
    PG8_SETUP(cur, cA, cB, vAc, vBc, hAc, hBc, nt);
    PG8_STAGE(PG8_SB(0, 0), cB, vBc); PG8_STAGE(PG8_SA(0, 0), cA, vAc); PG8_STAGE(PG8_SB(0, 1), cB + hBc, vBc); PG8_STAGE(PG8_SA(0, 1), cA + hAc, vAc);
    if (wr == 1) PG8_BAR;
    PG8_WAIT_V(4); PG8_BAR;
    PG8_STAGE(PG8_SB(1, 0), cB + kstep, vBc); PG8_STAGE(PG8_SA(1, 0), cA + kstep, vAc); PG8_STAGE(PG8_SB(1, 1), cB + hBc + kstep, vBc);
    PG8_WAIT_V(6); PG8_BAR;
    for (;;) {
        const bool has_next = S.next(ui + 1, nxt);
        if (has_next) { PG8_SETUP(nxt, nA, nB, vAn, vBn, hAn, hBn, ntn); }
        else { nA = cA; nB = cB; vAn[0] = vAc[0]; vAn[1] = vAc[1]; vBn[0] = vBc[0]; vBn[1] = vBc[1]; hAn = hAc; hBn = hBc; ntn = nt; }
        for (int t = 0; t < nt; t += 2) {
            const bool last = (t == nt - 2);
            const char* a1 = cA + (size_t)(t + 1) * kstep;
            const char* a2 = last ? nA : cA + (size_t)(t + 2) * kstep; const char* b2 = last ? nB : cB + (size_t)(t + 2) * kstep;
            const char* a3 = a2 + kstep; const char* b3 = b2 + kstep;
            unsigned vA2[2], vB2[2]; vA2[0] = last ? vAn[0] : vAc[0]; vA2[1] = last ? vAn[1] : vAc[1]; vB2[0] = last ? vBn[0] : vBc[0]; vB2[1] = last ? vBn[1] : vBc[1];
            const size_t hA2 = last ? hAn : hAc, hB2 = last ? hBn : hBc;
            PG8_LDB(B0, 0, 0); PG8_SCHED; PG8_LDA(At, 0, 0); PG8_STAGE(PG8_SA(1, 1), a1 + hAc, vAc);
            PG8_WAIT_L(8); PG8_BAR; PG8_WAIT_L(0); PG8_MMA(0, 0, At, B0); PG8_BAR; PG8_SCHED;
            PG8_LDB(B1, 0, 1); PG8_STAGE(PG8_SB(0, 0), b2, vB2);
            PG8_BAR; PG8_WAIT_L(0); PG8_MMA(0, 1, At, B1); PG8_BAR;
            PG8_LDA(At, 0, 1); PG8_STAGE(PG8_SA(0, 0), a2, vA2);
            PG8_BAR; PG8_WAIT_L(0); PG8_MMA(1, 0, At, B0); PG8_BAR; PG8_SCHED;
            PG8_STAGE(PG8_SB(0, 1), b2 + hB2, vB2);
            PG8_WAIT_V(6); PG8_BAR; PG8_MMA(1, 1, At, B1); PG8_BAR;
            PG8_LDB(B0, 1, 0); PG8_SCHED; PG8_LDA(At, 1, 0); PG8_STAGE(PG8_SA(0, 1), a2 + hA2, vA2);
            PG8_WAIT_L(8); PG8_BAR; PG8_WAIT_L(0); PG8_MMA(0, 0, At, B0); PG8_BAR; PG8_SCHED;
            PG8_LDB(B1, 1, 1); PG8_STAGE(PG8_SB(1, 0), b3, vB2);
            PG8_BAR; PG8_WAIT_L(0); PG8_MMA(0, 1, At, B1); PG8_BAR;
            PG8_LDA(At, 1, 1); PG8_STAGE(PG8_SA(1, 0), a3, vA2);
            PG8_BAR; PG8_WAIT_L(0); PG8_MMA(1, 0, At, B0); PG8_BAR; PG8_SCHED;
            PG8_STAGE(PG8_SB(1, 1), b3 + hB2, vB2);
            PG8_WAIT_V(6); PG8_BAR; PG8_MMA(1, 1, At, B1); PG8_BAR;
        }
        E(acc, cur, wr, wc, fr, fq);
        if (!has_next) break;
#pragma unroll
        for (int a = 0; a < 2; ++a)
#pragma unroll
            for (int b = 0; b < 2; ++b)
#pragma unroll
                for (int m = 0; m < 4; ++m)
#pragma unroll
                    for (int n = 0; n < 2; ++n) acc[a][b][m][n] = (f32x4){0.f, 0.f, 0.f, 0.f};
        cur = nxt; cA = nA; cB = nB; vAc[0] = vAn[0]; vAc[1] = vAn[1]; vBc[0] = vBn[0]; vBc[1] = vBn[1]; hAc = hAn; hBc = hBn; nt = ntn; ++ui;
    }
    PG8_WAIT_V(0);
    if (wr == 0) PG8_BAR;
    PG8_BAR;
#undef PG8_SA
#undef PG8_SB
#undef PG8_STAGE
#undef PG8_LDA
#undef PG8_LDB
#undef PG8_MMA
#undef PG8_WAIT_V
#undef PG8_WAIT_L
#undef PG8_BAR
#undef PG8_SCHED
#undef PG8_SETUP
}
}

template <int PERMK>
DI void transpose_item(const float* W, int K, int N, bf16_t* WT, LAS float* scr, int item, int lane) {
    const int nblk = N / 32, kb = item / nblk, nb = item % nblk, k0 = 64 * kb, n0 = 32 * nb;
    int sc = n0 + (lane & 31);
    if (PERMK == 1 && sc < 1024) { const int hd = sc >> 6, cp = sc & 63; sc = hd * 64 + 32 * (cp & 1) + (cp >> 1); }
    if (PERMK == 2) { const int tl = sc >> 8, w = sc & 255; sc = (w < 128) ? (128 * tl + w) : (DFF + 128 * tl + (w - 128)); }
#pragma unroll 8
    for (int i = 0; i < 32; ++i) { const int kk = 2 * i + (lane >> 5); scr[kk * 33 + (lane & 31)] = W[(size_t)(k0 + kk) * N + sc]; }
    LDS_WAIT();
    const int c = lane & 7;
#pragma unroll
    for (int j = 0; j < 4; ++j) { const int n = (lane >> 3) + 8 * j; const LAS float* s = scr + (8 * c) * 33 + n;
        u32x4 o; o.x = cvt_pk_bf16(s[0 * 33], s[1 * 33]); o.y = cvt_pk_bf16(s[2 * 33], s[3 * 33]); o.z = cvt_pk_bf16(s[4 * 33], s[5 * 33]); o.w = cvt_pk_bf16(s[6 * 33], s[7 * 33]);
        *(u32x4*)(WT + (size_t)(n0 + n) * K + k0 + 8 * c) = o; }
    LDS_WAIT();
}

DI void convert_weights(KP p, int l, LAS unsigned char* lds, int wv) {
    const int tid_ = otid(wv); const int wave = tid_ >> 6, lane = tid_ & 63;
    LAS float* scr = (LAS float*)(lds + wave * 8448);
    const int gw = blockIdx.x * 8 + wave, NGW = gridDim.x * 8;
    constexpr int I_IN = 16 * (INC / 32), I_BR = 8 * 32, I_OUT = 16 * 32, I_UP = 16 * (UPC / 32), I_DN = (DFF / 64) * 32, I_L64 = 16, I_L128 = 32;
    constexpr int NIT = I_IN + 3 * I_BR + I_OUT + I_UP + I_DN + 2 * I_L64 + I_L128;
    unsigned char* ws = ows(p->ws);
    for (int it = gw; it < NIT; it += NGW) {
        int r = it;
        if (r < I_IN) { transpose_item<1>(p->in[5] + (size_t)l * 1024 * INC, 1024, INC, (bf16_t*)(ws + WS_WIN), scr, r, lane); continue; } r -= I_IN;
        if (r < 3 * I_BR) { const int b = r / I_BR; transpose_item<0>(p->in[21] + ((size_t)l * 3 + b) * 512 * 1024, 512, 1024, (bf16_t*)(ws + WS_WBR) + (size_t)b * 1024 * 512, scr, r % I_BR, lane); continue; } r -= 3 * I_BR;
        if (r < I_OUT) { transpose_item<0>(p->in[22] + (size_t)l * 1024 * 1024, 1024, 1024, (bf16_t*)(ws + WS_WOUT), scr, r, lane); continue; } r -= I_OUT;
        if (r < I_UP) { transpose_item<2>(p->in[24] + (size_t)l * 1024 * UPC, 1024, UPC, (bf16_t*)(ws + WS_WUP), scr, r, lane); continue; } r -= I_UP;
        if (r < I_DN) { transpose_item<0>(p->in[27] + (size_t)l * DFF * 1024, DFF, 1024, (bf16_t*)(ws + WS_WDN), scr, r, lane); continue; } r -= I_DN;
        if (r < I_L64) { transpose_item<0>(p->in[8] + (size_t)l * 64 * 512, 64, 512, (bf16_t*)(ws + WS_LWU), scr, r, lane); continue; } r -= I_L64;
        if (r < I_L64) { transpose_item<0>(p->in[10] + (size_t)l * 64 * 512, 64, 512, (bf16_t*)(ws + WS_LAU), scr, r, lane); continue; } r -= I_L64;
        transpose_item<0>(p->in[11] + (size_t)l * 128 * 512, 128, 512, (bf16_t*)(ws + WS_LGU), scr, r, lane);
    }
}

DI void phase0(KP p, LAS unsigned char* lds, int wv) {
    const int tid = otid(wv);
    float* ropec = (float*)(p->ws + WS_ROPEC); float* ropes = (float*)(p->ws + WS_ROPES);
    for (int idx = blockIdx.x * 512 + tid; idx < SEQ * 32; idx += gridDim.x * 512) {
        const int pos = idx >> 5, e = idx & 31;
        const float inv = 1.0f / exp2f((float)e * (13.287712379549449f / 32.0f));
        const float ang = (float)pos * inv;
        double rev = (double)ang * 0.15915494309189535; rev -= rint(rev);
        const float rv = (float)rev;
        ropec[idx] = __builtin_amdgcn_cosf(rv); ropes[idx] = __builtin_amdgcn_sinf(rv);
    }
    {
        LAS float* ca = (LAS float*)lds;
        LAS float* red = (LAS float*)(lds + 16384);
        float* mod = (float*)(p->ws + WS_MOD);
        bool loaded = false;
        for (int item = blockIdx.x; item < 192; item += gridDim.x) {
            if (!loaded) { for (int i = tid; i < 4096; i += 512) { const float v = p->in[1][i]; ca[i] = v / (1.0f + __expf(-v)); } loaded = true; __syncthreads(); }
            const int l = item / 96, c0 = (item % 96) * 64, cc = tid & 63, kg = tid >> 6;
            const float* w = p->in[2] + (size_t)l * 1024 * 6144 + c0 + cc;
            float a0 = 0.f, a1 = 0.f, a2 = 0.f, a3 = 0.f;
#pragma unroll 8
            for (int k = kg * 128; k < kg * 128 + 128; ++k) { const float wv = w[(size_t)k * 6144]; a0 += ca[k] * wv; a1 += ca[1024 + k] * wv; a2 += ca[2048 + k] * wv; a3 += ca[3072 + k] * wv; }
            red[(kg * 4 + 0) * 64 + cc] = a0; red[(kg * 4 + 1) * 64 + cc] = a1; red[(kg * 4 + 2) * 64 + cc] = a2; red[(kg * 4 + 3) * 64 + cc] = a3;
            __syncthreads();
            if (tid < 256) { const int b = tid >> 6; float s = 0.f;
#pragma unroll
                for (int g = 0; g < 8; ++g) s += red[(g * 4 + b) * 64 + cc];
                mod[((size_t)l * 4 + b) * 6144 + c0 + cc] = s + p->in[3][(size_t)l * 6144 + c0 + cc]; }
            __syncthreads();
        }
        __syncthreads();
    }
    convert_weights(p, 0, lds, wv);
}

DI void norm_mod_phase(const float* x, const float* g, const float* sh, const float* sc, bf16_t* H, int wv) {
    const int tid_ = otid(wv); const int wave = tid_ >> 6, lane = tid_ & 63;
    for (int row0 = (blockIdx.x * 8 + wave) * 2; row0 < MTOK; row0 += gridDim.x * 16) {
        f32x4 v[2][4]; float s[2] = {0.f, 0.f};
#pragma unroll
        for (int q = 0; q < 2; ++q) { const f32x4* xr = (const f32x4*)(x + (size_t)(row0 + q) * DM) + lane;
#pragma unroll
            for (int j = 0; j < 4; ++j) v[q][j] = xr[64 * j]; }
#pragma unroll
        for (int q = 0; q < 2; ++q)
#pragma unroll
            for (int j = 0; j < 4; ++j) s[q] += (v[q][j][0] * v[q][j][0] + v[q][j][1] * v[q][j][1]) + (v[q][j][2] * v[q][j][2] + v[q][j][3] * v[q][j][3]);
        const float rs0 = rsqrtf(wave_sum(s[0]) * (1.0f / DM) + 1e-6f), rs1 = rsqrtf(wave_sum(s[1]) * (1.0f / DM) + 1e-6f);
        const int b = row0 >> 12;
#pragma unroll
        for (int j = 0; j < 4; ++j) {
            const int c = 4 * lane + 256 * j;
            const f32x4 gg = *(const f32x4*)(g + c), s1 = *(const f32x4*)(sc + (size_t)b * 6144 + c), s0 = *(const f32x4*)(sh + (size_t)b * 6144 + c);
#pragma unroll
            for (int q = 0; q < 2; ++q) {
                const f32x4 h = (v[q][j] * (q ? rs1 : rs0) * gg) * (s1 + 1.0f) + s0;
                u32x2 w; w.x = cvt_pk_bf16(h[0], h[1]); w.y = cvt_pk_bf16(h[2], h[3]);
                *((u32x2*)(H + (size_t)(row0 + q) * DM) + lane + 64 * j) = w;
            }
        }
    }
}
DI void final_norm_phase(float* x, const float* g, int wv) {
    const int tid_ = otid(wv); const int wave = tid_ >> 6, lane = tid_ & 63;
    for (int row = blockIdx.x * 8 + wave; row < MTOK; row += gridDim.x * 8) {
        f32x4* xr = (f32x4*)(x + (size_t)row * DM) + lane;
        f32x4 v[4]; float s = 0.f;
#pragma unroll
        for (int j = 0; j < 4; ++j) { v[j] = xr[64 * j]; s += (v[j][0] * v[j][0] + v[j][1] * v[j][1]) + (v[j][2] * v[j][2] + v[j][3] * v[j][3]); }
        const float rs = rsqrtf(wave_sum(s) * (1.0f / DM) + 1e-6f);
#pragma unroll
        for (int j = 0; j < 4; ++j) { const f32x4 gg = *(const f32x4*)(g + 4 * lane + 256 * j); xr[64 * j] = v[j] * rs * gg; }
    }
}

DI bf16x8 lerp_frag(const bf16_t* cur, const bf16_t* prv, bool hasprev, const float* mu, int act) {
    const u32x4 c = *(const u32x4*)cur; u32x4 q = {0u, 0u, 0u, 0u}; if (hasprev) q = *(const u32x4*)prv;
    const f32x4 m0 = *(const f32x4*)mu, m1 = *(const f32x4*)(mu + 4);
    float z[8];
    const unsigned cw[4] = {c.x, c.y, c.z, c.w}, qw[4] = {q.x, q.y, q.z, q.w};
#pragma unroll
    for (int j = 0; j < 4; ++j) {
        const float c0 = bf_lo(cw[j]), c1 = bf_hi(cw[j]), p0 = bf_lo(qw[j]), p1 = bf_hi(qw[j]);
        const float mA = (j < 2) ? m0[2 * j] : m1[2 * j - 4], mB = (j < 2) ? m0[2 * j + 1] : m1[2 * j - 3];
        z[2 * j] = c0 + (p0 - c0) * mA; z[2 * j + 1] = c1 + (p1 - c1) * mB;
    }
#pragma unroll
    for (int j = 0; j < 8; ++j) {
        if (act == 1) { const float e = __expf(2.0f * z[j]); z[j] = 1.0f - 2.0f / (1.0f + e); }
        else if (act == 2) z[j] = sigmoidf_(z[j]);
    }
    return pack8(z[0], z[1], z[2], z[3], z[4], z[5], z[6], z[7]);
}

DI void rwkv_derived_phase(KP p0, int l, int wv) {
    const int tid_ = otid(wv); const int wave = tid_ >> 6, lane = tid_ & 63, r = lane & 31, hh = lane >> 5;
    for (int job = blockIdx.x * 8 + wave; job < 512 * 8; job += gridDim.x * 8) {
        KP p = okp(); unsigned char* ws = ows(p->ws);
        const bf16_t* RAW = (const bf16_t*)(ws + WS_RAW);
        bf16_t *RZ = (bf16_t*)(ws + WS_RZ), *KP = (bf16_t*)(ws + WS_KP), *VZ = (bf16_t*)(ws + WS_VZ), *KKN = (bf16_t*)(ws + WS_KKN), *Bv = (bf16_t*)(ws + WS_B), *G = (bf16_t*)(ws + WS_G);
        float* W = (float*)(ws + WS_W);
        const bf16_t *LWU = (const bf16_t*)(ws + WS_LWU), *LAU = (const bf16_t*)(ws + WS_LAU), *LGU = (const bf16_t*)(ws + WS_LGU);
        const float* mu = p->in[6] + (size_t)l * RAWC; const float* w0 = p->in[7] + l * 512; const float* a0 = p->in[9] + l * 512;
        const float* k_k = p->in[12] + l * 512; const float* k_a = p->in[13] + l * 512; const float* r_k = p->in[14] + l * 512;
        const int hd = job & 7, tg = job >> 3, t = tg * 32 + r;
        const bool hp = (t & (SEQ - 1)) != 0;
        const bf16_t* cur = RAW + (size_t)t * RAWC; const bf16_t* prv = cur - RAWC;
        float ss = 0.f;
#pragma unroll
        for (int q = 0; q < 8; ++q) {
            const int c = hd * 64 + 8 * q + 4 * hh;
            const u32x2 kc = *(const u32x2*)(cur + 512 + c); u32x2 kq = {0u, 0u}; if (hp) kq = *(const u32x2*)(prv + 512 + c);
            const f32x4 mk = *(const f32x4*)(mu + 512 + c), kkw = *(const f32x4*)(k_k + c);
            const float kcur[4] = {bf_lo(kc.x), bf_hi(kc.x), bf_lo(kc.y), bf_hi(kc.y)}, kprv[4] = {bf_lo(kq.x), bf_hi(kq.x), bf_lo(kq.y), bf_hi(kq.y)};
#pragma unroll
            for (int j = 0; j < 4; ++j) { const float kk = (kcur[j] + (kprv[j] - kcur[j]) * mk[j]) * kkw[j]; ss += kk * kk; }
        }
        ss += __shfl_xor(ss, 32);
        const float inv = 1.0f / fmaxf(sqrtf(ss), 1e-12f);
        float bonus = 0.f;
        {
            bf16x8 bw[4], ba[4];
#pragma unroll
            for (int s = 0; s < 4; ++s) { const int o = 16 * s + 8 * hh; bw[s] = lerp_frag(cur + 1536 + o, prv + 1536 + o, hp, mu + 1536 + o, 1); ba[s] = lerp_frag(cur + 1600 + o, prv + 1600 + o, hp, mu + 1600 + o, 0); }
#pragma unroll 1
            for (int mt = 0; mt < 2; ++mt) {
                const int chr = hd * 64 + 32 * mt + r;
                f32x16 aw, aa;
#pragma unroll
                for (int i = 0; i < 16; ++i) { aw[i] = 0.f; aa[i] = 0.f; }
                {
                    typedef const __attribute__((address_space(1))) bf16x8* GP8;
                    const GP8 pw = (GP8)(LWU + (size_t)chr * 64 + 8 * hh), pa = (GP8)(LAU + (size_t)chr * 64 + 8 * hh);
                    bf16x8 fw[4], fa[4];
#pragma unroll
                    for (int s = 0; s < 4; ++s) { fw[s] = pw[2 * s]; fa[s] = pa[2 * s]; }
                    asm volatile("" ::: "memory");
#pragma unroll
                    for (int s = 0; s < 4; ++s) { aw = MFMA32(fw[s], bw[s], aw); aa = MFMA32(fa[s], ba[s], aa); }
                }
                u32x2 rcA[4], kcA[4], vcA[4], rpA[4], kqA[4], vpA[4];
#pragma unroll
                for (int i4 = 0; i4 < 4; ++i4) {
                    const int c = hd * 64 + 32 * mt + 8 * i4 + 4 * hh;
                    rcA[i4] = *(const u32x2*)(cur + c); kcA[i4] = *(const u32x2*)(cur + 512 + c); vcA[i4] = *(const u32x2*)(cur + 1024 + c);
                    rpA[i4] = (u32x2){0u, 0u}; kqA[i4] = (u32x2){0u, 0u}; vpA[i4] = (u32x2){0u, 0u};
                    if (hp) { rpA[i4] = *(const u32x2*)(prv + c); kqA[i4] = *(const u32x2*)(prv + 512 + c); vpA[i4] = *(const u32x2*)(prv + 1024 + c); }
                }
                asm volatile("" ::: "memory");
#pragma unroll
                for (int i4 = 0; i4 < 4; ++i4) {
                    const int c = hd * 64 + 32 * mt + 8 * i4 + 4 * hh;
                    const u32x2 rc = rcA[i4], kc = kcA[i4], vc = vcA[i4], rp = rpA[i4], kq = kqA[i4], vp = vpA[i4];
                    const f32x4 mr = *(const f32x4*)(mu + c), mk = *(const f32x4*)(mu + 512 + c), mv = *(const f32x4*)(mu + 1024 + c);
                    const f32x4 w0v = *(const f32x4*)(w0 + c), a0v = *(const f32x4*)(a0 + c), kkw = *(const f32x4*)(k_k + c), kaw = *(const f32x4*)(k_a + c), rkw = *(const f32x4*)(r_k + c);
                    const float rcur[4] = {bf_lo(rc.x), bf_hi(rc.x), bf_lo(rc.y), bf_hi(rc.y)}, rprv[4] = {bf_lo(rp.x), bf_hi(rp.x), bf_lo(rp.y), bf_hi(rp.y)};
                    const float kcur[4] = {bf_lo(kc.x), bf_hi(kc.x), bf_lo(kc.y), bf_hi(kc.y)}, kprv[4] = {bf_lo(kq.x), bf_hi(kq.x), bf_lo(kq.y), bf_hi(kq.y)};
                    const float vcur[4] = {bf_lo(vc.x), bf_hi(vc.x), bf_lo(vc.y), bf_hi(vc.y)}, vprv[4] = {bf_lo(vp.x), bf_hi(vp.x), bf_lo(vp.y), bf_hi(vp.y)};
                    f32x4 dec; float rz[4], kp[4], vz[4], kn[4], bb[4];
#pragma unroll
                    for (int j = 0; j < 4; ++j) {
                        const int i = 4 * i4 + j;
                        const float zz = -(w0v[j] + aw[i]);
                        const float sp = (zz > 20.f) ? zz : __logf(1.0f + __expf(zz));
                        const float wv = -sp - 0.5f;
                        dec[j] = __expf(-__expf(wv));
                        const float av = sigmoidf_(a0v[j] + aa[i]);
                        rz[j] = rcur[j] + (rprv[j] - rcur[j]) * mr[j];
                        const float kz = kcur[j] + (kprv[j] - kcur[j]) * mk[j];
                        vz[j] = vcur[j] + (vprv[j] - vcur[j]) * mv[j];
                        kn[j] = kz * kkw[j] * inv; bb[j] = kn[j] * av;
                        kp[j] = kz * (1.0f + (av - 1.0f) * kaw[j]);
                        bonus += rz[j] * kp[j] * rkw[j];
                    }
                    const size_t o = (size_t)t * 512 + c;
                    *(f32x4*)(W + o) = dec;
                    u32x2 w2; w2.x = cvt_pk_bf16(rz[0], rz[1]); w2.y = cvt_pk_bf16(rz[2], rz[3]); *(u32x2*)(RZ + o) = w2;
                    w2.x = cvt_pk_bf16(kp[0], kp[1]); w2.y = cvt_pk_bf16(kp[2], kp[3]); *(u32x2*)(KP + o) = w2;
                    w2.x = cvt_pk_bf16(vz[0], vz[1]); w2.y = cvt_pk_bf16(vz[2], vz[3]); *(u32x2*)(VZ + o) = w2;
                    w2.x = cvt_pk_bf16(kn[0], kn[1]); w2.y = cvt_pk_bf16(kn[2], kn[3]); *(u32x2*)(KKN + o) = w2;
                    w2.x = cvt_pk_bf16(bb[0], bb[1]); w2.y = cvt_pk_bf16(bb[2], bb[3]); *(u32x2*)(Bv + o) = w2;
                }
            }
        }
        bonus += __shfl_xor(bonus, 32);
        int t2 = t; asm volatile("" : "+v"(t2));
        if (hh == 0) ((float*)(ows(ws) + WS_BONUS))[(size_t)t2 * 8 + hd] = bonus;
        {
            bf16x8 bg[8];
#pragma unroll
            for (int s = 0; s < 8; ++s) { const int o = 16 * s + 8 * hh; bg[s] = lerp_frag(cur + 1664 + o, prv + 1664 + o, hp, mu + 1664 + o, 2); }
#pragma unroll 1
            for (int mt = 0; mt < 2; ++mt) {
                const int chr = hd * 64 + 32 * mt + r;
                f32x16 ag;
#pragma unroll
                for (int i = 0; i < 16; ++i) ag[i] = 0.f;
                {
                    typedef const __attribute__((address_space(1))) bf16x8* GP8;
                    const GP8 pg = (GP8)(LGU + (size_t)chr * 128 + 8 * hh);
                    bf16x8 fg[8];
#pragma unroll
                    for (int s = 0; s < 8; ++s) fg[s] = pg[2 * s];
                    asm volatile("" ::: "memory");
#pragma unroll
                    for (int s = 0; s < 8; ++s) ag = MFMA32(fg[s], bg[s], ag);
                }
#pragma unroll
                for (int i4 = 0; i4 < 4; ++i4) {
                    const size_t o = (size_t)t2 * 512 + hd * 64 + 32 * mt + 8 * i4 + 4 * hh;
                    u32x2 w2; w2.x = cvt_pk_bf16(ag[4 * i4], ag[4 * i4 + 1]); w2.y = cvt_pk_bf16(ag[4 * i4 + 2], ag[4 * i4 + 3]); *(u32x2*)(G + o) = w2;
                }
            }
        }
    }
}

constexpr int SC_T = 32, SC_STEP = 1344, SC_BUF = SC_T * SC_STEP;
struct ScanRegs { f32x4 w0, w1; u32x4 kn, bb, kp, rz, vv; };
DI void scan_gload(KP p, ScanRegs& R, int b, int h, int rg, int ck, int pt) {
    const unsigned char* ws = ows(p->ws);
    const size_t tok0 = (size_t)b * SEQ + (size_t)ck * SC_T;
    { const int st = pt >> 4, sub = pt & 15; R.w0 = *(const f32x4*)((const float*)(ws + WS_W) + (tok0 + st) * 512 + h * 64 + 4 * sub); }
    { const int pp = pt + 256, st = pp >> 4, sub = pp & 15; R.w1 = *(const f32x4*)((const float*)(ws + WS_W) + (tok0 + st) * 512 + h * 64 + 4 * sub); }
    const int st = pt >> 3, sub = pt & 7; const size_t go = (tok0 + st) * 512 + h * 64 + 8 * sub;
    R.kn = *(const u32x4*)((const bf16_t*)(ws + WS_KKN) + go); R.bb = *(const u32x4*)((const bf16_t*)(ws + WS_B) + go);
    R.kp = *(const u32x4*)((const bf16_t*)(ws + WS_KP) + go); R.rz = *(const u32x4*)((const bf16_t*)(ws + WS_RZ) + go);
    R.vv = (u32x4){0u, 0u, 0u, 0u};
    if (pt < 64) { const int s2 = pt >> 1, hf = pt & 1; R.vv = *(const u32x4*)((const bf16_t*)(ws + WS_VZ) + (tok0 + s2) * 512 + h * 64 + rg * 16 + 8 * hf); }
}
DI void scan_write(const ScanRegs& R, LAS unsigned char* buf, int pt) {
    { const int st = pt >> 4, sub = pt & 15; *(LAS f32x4*)(buf + st * SC_STEP + sub * 16) = R.w0; }
    { const int pp = pt + 256, st = pp >> 4, sub = pp & 15; *(LAS f32x4*)(buf + st * SC_STEP + sub * 16) = R.w1; }
    const int st = pt >> 3, sub = pt & 7;
    const u32x4 kn = R.kn, bb = R.bb, kp = R.kp, rz = R.rz;
    LAS unsigned char* d = buf + st * SC_STEP + sub * 32;
    *(LAS f32x4*)(d + 256) = (f32x4){-bf_lo(kn.x), -bf_hi(kn.x), -bf_lo(kn.y), -bf_hi(kn.y)}; *(LAS f32x4*)(d + 256 + 16) = (f32x4){-bf_lo(kn.z), -bf_hi(kn.z), -bf_lo(kn.w), -bf_hi(kn.w)};
    *(LAS f32x4*)(d + 512) = (f32x4){bf_lo(bb.x), bf_hi(bb.x), bf_lo(bb.y), bf_hi(bb.y)}; *(LAS f32x4*)(d + 512 + 16) = (f32x4){bf_lo(bb.z), bf_hi(bb.z), bf_lo(bb.w), bf_hi(bb.w)};
    *(LAS f32x4*)(d + 768) = (f32x4){bf_lo(kp.x), bf_hi(kp.x), bf_lo(kp.y), bf_hi(kp.y)}; *(LAS f32x4*)(d + 768 + 16) = (f32x4){bf_lo(kp.z), bf_hi(kp.z), bf_lo(kp.w), bf_hi(kp.w)};
    *(LAS f32x4*)(d + 1024) = (f32x4){bf_lo(rz.x), bf_hi(rz.x), bf_lo(rz.y), bf_hi(rz.y)}; *(LAS f32x4*)(d + 1024 + 16) = (f32x4){bf_lo(rz.z), bf_hi(rz.z), bf_lo(rz.w), bf_hi(rz.w)};
    if (pt < 64) { const int s2 = pt >> 1, hf = pt & 1; const u32x4 vv = R.vv;
        LAS unsigned char* dv = buf + s2 * SC_STEP + 1280 + hf * 32;
        *(LAS f32x4*)dv = (f32x4){bf_lo(vv.x), bf_hi(vv.x), bf_lo(vv.y), bf_hi(vv.y)}; *(LAS f32x4*)(dv + 16) = (f32x4){bf_lo(vv.z), bf_hi(vv.z), bf_lo(vv.w), bf_hi(vv.w)}; }
}
DI void rwkv_scan_phase(KP p, LAS unsigned char* lds, int wv) {
    const int tid = otid(wv), wave = tid >> 6, lane = tid & 63;
    float* YRAW = (float*)(p->ws + WS_YRAW);
    for (int job = blockIdx.x; job < 128; job += gridDim.x) {
        const int jx = job & 7, jk = job >> 3;
        const int chain = jx + 8 * (jk >> 2), rg = jk & 3, b = chain >> 3, h = chain & 7;
        __syncthreads();
        ScanRegs R0, R1;
        if (wave >= 4) { scan_gload(p, R0, b, h, rg, 0, tid - 256); scan_write(R0, lds, tid - 256); scan_gload(p, R0, b, h, rg, 1, tid - 256); scan_gload(p, R1, b, h, rg, 2, tid - 256); }
        __syncthreads();
        f32x4 S = {0.f, 0.f, 0.f, 0.f};
        const int jl = lane & 15, rl = 4 * (wave & 3) + (lane >> 4);
        for (int ck2 = 0; ck2 < SEQ / SC_T; ck2 += 2) {
#pragma unroll
            for (int half = 0; half < 2; ++half) {
                const int ck = ck2 + half;
                LAS unsigned char* cb = lds + (ck & 1) * SC_BUF;
                if (wave >= 4) {
                    if (ck + 1 < SEQ / SC_T) {
                        if (half == 0) { scan_write(R0, lds + ((ck + 1) & 1) * SC_BUF, tid - 256); if (ck + 3 < SEQ / SC_T) scan_gload(p, R0, b, h, rg, ck + 3, tid - 256); }
                        else           { scan_write(R1, lds + ((ck + 1) & 1) * SC_BUF, tid - 256); if (ck + 3 < SEQ / SC_T) scan_gload(p, R1, b, h, rg, ck + 3, tid - 256); }
                    }
                } else {
                    float* yo = YRAW + ((size_t)b * SEQ + (size_t)ck * SC_T + jl) * 512 + h * 64 + rg * 16 + rl;
                    const LAS unsigned char* sb = cb + jl * 16; const LAS unsigned char* vb = cb + 1280 + rl * 4;
                    f32x4 w4 = *(const LAS f32x4*)sb, an = *(const LAS f32x4*)(sb + 256), b4 = *(const LAS f32x4*)(sb + 512), k4 = *(const LAS f32x4*)(sb + 768), r4 = *(const LAS f32x4*)(sb + 1024);
                    float vi = *(const LAS float*)vb;
                    float ysel = 0.f;
#pragma unroll
                    for (int s = 0; s < SC_T; ++s) {
                        f32x4 w4n = w4, ann = an, b4n = b4, k4n = k4, r4n = r4; float vin = vi;
                        if (s + 1 < SC_T) {
                            const LAS unsigned char* sn = sb + (s + 1) * SC_STEP;
                            w4n = *(const LAS f32x4*)sn; ann = *(const LAS f32x4*)(sn + 256); b4n = *(const LAS f32x4*)(sn + 512); k4n = *(const LAS f32x4*)(sn + 768); r4n = *(const LAS f32x4*)(sn + 1024);
                            vin = *(const LAS float*)(vb + (s + 1) * SC_STEP);
                        }
                        float sa = (S[0] * an[0] + S[1] * an[1]) + (S[2] * an[2] + S[3] * an[3]);
                        sa = row16_sum(sa);
                        S = S * w4 + (b4 * sa + k4 * vi);
                        float y = (S[0] * r4[0] + S[1] * r4[1]) + (S[2] * r4[2] + S[3] * r4[3]);
                        y = row16_sum(y);
                        ysel = (jl == (s & 15)) ? y : ysel;
                        if ((s & 15) == 15) yo[(size_t)(s - 15) * 512] = ysel;
                        w4 = w4n; an = ann; b4 = b4n; k4 = k4n; r4 = r4n; vi = vin;
                    }
                }
                __syncthreads();
            }
        }
    }
}

DI void rwkv_post_phase(KP p, int l, int wv) {
    const unsigned char* ws = ows(p->ws);
    const float* YRAW = (const float*)(ws + WS_YRAW); const bf16_t* VZ = (const bf16_t*)(ws + WS_VZ); const bf16_t* G = (const bf16_t*)(ws + WS_G);
    const float* BONUS = (const float*)(ws + WS_BONUS); bf16_t* YS = (bf16_t*)(p->ws + WS_YSR);
    const float* gnw = p->in[15] + l * 512; const float* gnb = p->in[16] + l * 512;
    const int tid_ = otid(wv); const int wave = tid_ >> 6, lane = tid_ & 63, c = 8 * lane;
    const f32x4 gw0 = *(const f32x4*)(gnw + c), gw1 = *(const f32x4*)(gnw + c + 4), gb0 = *(const f32x4*)(gnb + c), gb1 = *(const f32x4*)(gnb + c + 4);
    for (int t = blockIdx.x * 8 + wave; t < MTOK; t += gridDim.x * 8) {
        const size_t o = (size_t)t * 512 + c;
        const f32x4 y0 = *(const f32x4*)(YRAW + o), y1 = *(const f32x4*)(YRAW + o + 4);
        float s = (y0[0] + y0[1]) + (y0[2] + y0[3]) + (y1[0] + y1[1]) + (y1[2] + y1[3]);
        s += __shfl_xor(s, 1); s += __shfl_xor(s, 2); s += __shfl_xor(s, 4);
        const float mean = s * (1.0f / 64.0f);
        const f32x4 d0 = y0 - mean, d1 = y1 - mean;
        float q = (d0[0] * d0[0] + d0[1] * d0[1]) + (d0[2] * d0[2] + d0[3] * d0[3]) + (d1[0] * d1[0] + d1[1] * d1[1]) + (d1[2] * d1[2] + d1[3] * d1[3]);
        q += __shfl_xor(q, 1); q += __shfl_xor(q, 2); q += __shfl_xor(q, 4);
        const float rstd = rsqrtf(q * (1.0f / 64.0f) + 64e-5f);
        const float bon = BONUS[(size_t)t * 8 + (lane >> 3)];
        const u32x4 vv = *(const u32x4*)(VZ + o), gg = *(const u32x4*)(G + o);
        const f32x4 v0 = {bf_lo(vv.x), bf_hi(vv.x), bf_lo(vv.y), bf_hi(vv.y)}, v1 = {bf_lo(vv.z), bf_hi(vv.z), bf_lo(vv.w), bf_hi(vv.w)};
        const f32x4 g0 = {bf_lo(gg.x), bf_hi(gg.x), bf_lo(gg.y), bf_hi(gg.y)}, g1 = {bf_lo(gg.z), bf_hi(gg.z), bf_lo(gg.w), bf_hi(gg.w)};
        const f32x4 r0 = (d0 * rstd * gw0 + gb0 + v0 * bon) * g0, r1 = (d1 * rstd * gw1 + gb1 + v1 * bon) * g1;
        u32x4 w; w.x = cvt_pk_bf16(r0[0], r0[1]); w.y = cvt_pk_bf16(r0[2], r0[3]); w.z = cvt_pk_bf16(r1[0], r1[1]); w.w = cvt_pk_bf16(r1[2], r1[3]);
        *(u32x4*)(YS + o) = w;
    }
}

DI void attn_job(const bf16_t* Q, const bf16_t* K, const bf16_t* V, bf16_t* YS, float* LSE, LAS unsigned char* vl, int b, int h, int d, int rho, int J0, bool first, int lane) {
    asm volatile("" : "+v"(lane));
    const int r = lane & 31, hh = lane >> 5;
    const size_t tokq = (size_t)b * SEQ + (size_t)(J0 + r) * d + rho;
    typedef const __attribute__((address_space(1))) bf16x8* GP8;
    typedef const __attribute__((address_space(1))) u32x4* GP4;
    bf16x8 bq[4];
    { const GP8 qp = (GP8)(Q + tokq * 512 + h * 64 + 8 * hh);
#pragma unroll
      for (int s = 0; s < 4; ++s) bq[s] = qp[2 * s]; }
    bf16x8 ak[5][4];
#pragma unroll
    for (int kt = 0; kt < 5; ++kt) {
        const int Jk = J0 - 128 + 32 * kt + r;
        const size_t tokk = (size_t)b * SEQ + (size_t)(Jk >= 0 ? Jk : 0) * d + rho;
        const GP8 kp = (GP8)(K + tokk * 512 + h * 64 + 8 * hh);
#pragma unroll
        for (int s = 0; s < 4; ++s) ak[kt][s] = kp[2 * s];
    }
    asm volatile("" ::: "memory");
    f32x16 sc[5];
#pragma unroll
    for (int kt = 0; kt < 5; ++kt) {
        const bool valid = (J0 - 128 + 32 * kt + r) >= 0;
        f32x16 a;
#pragma unroll
        for (int i = 0; i < 16; ++i) a[i] = 0.f;
#pragma unroll
        for (int s = 0; s < 4; ++s) {
            bf16x8 kf = ak[kt][s];
            if (!valid) kf = (bf16x8){0, 0, 0, 0, 0, 0, 0, 0};
            a = MFMA32(kf, bq[s], a);
        }
        sc[kt] = a;
    }
    float m = -1e30f;
#pragma unroll
    for (int kt = 0; kt < 5; ++kt)
#pragma unroll
        for (int i = 0; i < 16; ++i) {
            const int kidx = 32 * kt + crow(i, hh); const int dist = 128 + r - kidx;
            const bool ok = (dist >= 0) && (dist <= 128) && (J0 - 128 + kidx >= 0);
            const float v = ok ? sc[kt][i] * 0.125f : -1e30f;
            sc[kt][i] = v; m = fmaxf(m, v);
        }
    m = fmaxf(m, __shfl_xor(m, 32));
    float lsum = 0.f;
#pragma unroll
    for (int kt = 0; kt < 5; ++kt)
#pragma unroll
        for (int i = 0; i < 16; ++i) { const float pv = __expf(sc[kt][i] - m); sc[kt][i] = pv; lsum += pv; }
    lsum += __shfl_xor(lsum, 32);
    const float lse = m + __logf(lsum);
    f32x16 o[2];
#pragma unroll
    for (int i = 0; i < 16; ++i) { o[0][i] = 0.f; o[1][i] = 0.f; }
    u32x4 vr[4];
    {
        const int key = lane >> 1, hf = lane & 1; const int Jk = J0 - 128 + key;
        const size_t tokv = (size_t)b * SEQ + (size_t)(Jk >= 0 ? Jk : 0) * d + rho;
        const GP4 src = (GP4)(V + tokv * 512 + h * 64 + 32 * hf);
        vr[0] = src[0]; vr[1] = src[1]; vr[2] = src[2]; vr[3] = src[3];
    }
#pragma unroll
    for (int kt = 0; kt < 5; ++kt) {
        {
            const int key = lane >> 1, hf = lane & 1;
            LAS u32x4* dst = (LAS u32x4*)(vl + key * 128 + hf * 64);
            dst[0] = vr[0]; dst[1] = vr[1]; dst[2] = vr[2]; dst[3] = vr[3];
            if (kt + 1 < 5) {
                const int Jk = J0 - 128 + 32 * (kt + 1) + key;
                const size_t tokv = (size_t)b * SEQ + (size_t)(Jk >= 0 ? Jk : 0) * d + rho;
                const GP4 src = (GP4)(V + tokv * 512 + h * 64 + 32 * hf);
                vr[0] = src[0]; vr[1] = src[1]; vr[2] = src[2]; vr[3] = src[3];
            }
        }
        LDS_WAIT();
#pragma unroll
        for (int s = 0; s < 2; ++s) {
            const bf16x8 xs = pack8(sc[kt][8 * s], sc[kt][8 * s + 1], sc[kt][8 * s + 2], sc[kt][8 * s + 3], sc[kt][8 * s + 4], sc[kt][8 * s + 5], sc[kt][8 * s + 6], sc[kt][8 * s + 7]);
#pragma unroll
            for (int mt = 0; mt < 2; ++mt) {
                bf16x8 pa;
#pragma unroll
                for (int j = 0; j < 8; ++j) { const int key = 16 * s + 8 * (j >> 2) + 4 * hh + (j & 3); pa[j] = (short)*(const LAS bf16_t*)(vl + key * 128 + (r + 32 * mt) * 2); }
                o[mt] = MFMA32(pa, xs, o[mt]);
            }
        }
        LDS_WAIT();
    }
    const float il = 1.0f / lsum;
    float wp = 0.f, wc = 1.0f, nl = lse;
    if (!first) { const float lp = LSE[tokq * 8 + h]; const float mx = fmaxf(lp, lse); const float ep = __expf(lp - mx), ec = __expf(lse - mx); nl = mx + __logf(ep + ec); wp = ep / (ep + ec); wc = ec / (ep + ec); }
#pragma unroll
    for (int mt = 0; mt < 2; ++mt)
#pragma unroll
        for (int g4 = 0; g4 < 4; ++g4) {
            bf16_t* dst = YS + tokq * 512 + h * 64 + 32 * mt + 8 * g4 + 4 * hh;
            float v[4];
#pragma unroll
            for (int j = 0; j < 4; ++j) v[j] = o[mt][4 * g4 + j] * il * wc;
            if (!first) { const u32x2 pw = *(const u32x2*)dst; v[0] += bf_lo(pw.x) * wp; v[1] += bf_hi(pw.x) * wp; v[2] += bf_lo(pw.y) * wp; v[3] += bf_hi(pw.y) * wp; }
            u32x2 w2; w2.x = cvt_pk_bf16(v[0], v[1]); w2.y = cvt_pk_bf16(v[2], v[3]); *(u32x2*)dst = w2;
        }
    if (hh == 0) LSE[tokq * 8 + h] = nl;
}

DI void attention_phase(KP p, LAS unsigned char* lds, int wv) {
    unsigned char* ws = ows(p->ws);
    const bf16_t *Q = (const bf16_t*)(ws + WS_Q), *K = (const bf16_t*)(ws + WS_K), *V = (const bf16_t*)(ws + WS_V);
    bf16_t* YS = (bf16_t*)(ws + WS_YSA); float* LSE = (float*)(ws + WS_LSE);
    const int tid_ = otid(wv); const int wave = tid_ >> 6, lane = tid_ & 63;
    LAS unsigned char* vl = lds + wave * 4096;
    for (int item0 = blockIdx.x; item0 < 256; item0 += gridDim.x) {
        const int item = (((item0 & 7) * 4 + (item0 >> 6)) << 3) | ((item0 >> 3) & 7);
        const int b = item >> 6, h = (item >> 3) & 7, qb = item & 7, P0 = qb * 512;
#pragma unroll 1
        for (int cfg = 0; cfg < 3; ++cfg) {
#pragma unroll 1
            for (int jj = wave; jj < 16; jj += 8) {
                int d, rho, J0;
                if (cfg == 0) { d = 1; rho = 0; J0 = P0 + 32 * jj; }
                else if (cfg == 1) { d = 4; rho = jj & 3; J0 = (P0 >> 2) + 32 * (jj >> 2); }
                else { d = 16; rho = jj; J0 = P0 >> 4; }
                attn_job(Q, K, V, YS, LSE, vl, b, h, d, rho, J0, cfg == 0, lane);
            }
            asm volatile("s_waitcnt vmcnt(0)" ::: "memory");
            __syncthreads();
        }
    }
}

DI void gmlp_phase(KP p, int l, LAS unsigned char* lds, int wv) {
    unsigned char* ws = ows(p->ws);
    const bf16_t* UV = (const bf16_t*)(ws + WS_UV); bf16_t* YS = (bf16_t*)(ws + WS_YSG);
    const float* lng = p->in[17] + l * 512; const float* lnb = p->in[18] + l * 512;
    const float* wsp = p->in[19] + (size_t)l * 8 * 128 * 128; const float* bsp = p->in[20] + (size_t)l * 8 * 128;
    const int tid_ = otid(wv); const int wave = tid_ >> 6, lane = tid_ & 63, r = lane & 31, hh = lane >> 5;
    LAS float* stats = (LAS float*)(lds + 8 * 17408);
    LAS bf16_t* VT = (LAS bf16_t*)(lds + wave * 17408);
    for (int item0 = blockIdx.x; item0 < 256; item0 += gridDim.x) {
        const int item = ((((item0 & 7) << 4) | (item0 >> 4)) << 1) | ((item0 >> 3) & 1);
        const size_t tok0 = (size_t)(item >> 1) * 128;
        __syncthreads();
        for (int tt = 0; tt < 16; ++tt) {
            const int tl = wave * 16 + tt;
            const u32x4 x = *(const u32x4*)(UV + (tok0 + tl) * 1024 + 512 + 8 * lane);
            const float f[8] = {bf_lo(x.x), bf_hi(x.x), bf_lo(x.y), bf_hi(x.y), bf_lo(x.z), bf_hi(x.z), bf_lo(x.w), bf_hi(x.w)};
            float s = 0.f;
#pragma unroll
            for (int j = 0; j < 8; ++j) s += f[j];
            const float mean = wave_sum(s) * (1.0f / 512.0f); float q = 0.f;
#pragma unroll
            for (int j = 0; j < 8; ++j) { const float dd = f[j] - mean; q += dd * dd; }
            const float rstd = rsqrtf(wave_sum(q) * (1.0f / 512.0f) + 1e-5f);
            if (lane == 0) { stats[2 * tl] = mean; stats[2 * tl + 1] = rstd; }
        }
        __syncthreads();
        const int g = (item & 1) * 4 + (wave & 3);
        if (wave < 4) {
        {
            const int d0 = 8 * (lane & 7);
            const f32x4 lg0 = *(const f32x4*)(lng + g * 64 + d0), lg1 = *(const f32x4*)(lng + g * 64 + d0 + 4), lb0 = *(const f32x4*)(lnb + g * 64 + d0), lb1 = *(const f32x4*)(lnb + g * 64 + d0 + 4);
            for (int it = 0; it < 16; ++it) {
                const int tl = it * 8 + (lane >> 3);
                const u32x4 x = *(const u32x4*)(UV + (tok0 + tl) * 1024 + 512 + g * 64 + d0);
                const float mean = stats[2 * tl], rstd = stats[2 * tl + 1];
                const float f[8] = {bf_lo(x.x), bf_hi(x.x), bf_lo(x.y), bf_hi(x.y), bf_lo(x.z), bf_hi(x.z), bf_lo(x.w), bf_hi(x.w)};
#pragma unroll
                for (int e = 0; e < 8; ++e) {
                    const float gg = e < 4 ? lg0[e & 3] : lg1[e & 3], bb = e < 4 ? lb0[e & 3] : lb1[e & 3];
                    const float y = (f[e] - mean) * rstd * gg + bb;
                    VT[(d0 + e) * 136 + tl] = (bf16_t)(cvt_pk_bf16(y, 0.f) & 0xffffu);
                }
            }
        }
        LDS_WAIT();
#pragma unroll 1
        for (int nt = 0; nt < 4; ++nt) {
            f32x16 acc[2];
#pragma unroll
            for (int i = 0; i < 16; ++i) { acc[0][i] = 0.f; acc[1][i] = 0.f; }
            const int irow = 32 * nt + r;
            for (int s = 0; s < 2 * (nt + 1); ++s) {
                const int j0 = 16 * s + 8 * hh;
                const float* wr_ = wsp + ((size_t)g * 128 + irow) * 128 + j0;
                const f32x4 wa = *(const f32x4*)wr_, wb = *(const f32x4*)(wr_ + 4);
                float wv[8] = {wa[0], wa[1], wa[2], wa[3], wb[0], wb[1], wb[2], wb[3]};
#pragma unroll
                for (int j = 0; j < 8; ++j) if (j0 + j > irow) wv[j] = 0.f;
                const bf16x8 bfr = pack8(wv[0], wv[1], wv[2], wv[3], wv[4], wv[5], wv[6], wv[7]);
#pragma unroll
                for (int mt = 0; mt < 2; ++mt) {
                    const bf16x8 afr = *(const LAS bf16x8*)(VT + (32 * mt + r) * 136 + j0);
                    acc[mt] = MFMA32(afr, bfr, acc[mt]);
                }
            }
            const size_t tok = tok0 + irow; const float bs = bsp[g * 128 + irow];
#pragma unroll
            for (int mt = 0; mt < 2; ++mt)
#pragma unroll
                for (int g4 = 0; g4 < 4; ++g4) {
                    const int c = g * 64 + 32 * mt + 8 * g4 + 4 * hh;
                    const u32x2 uu = *(const u32x2*)(UV + tok * 1024 + c);
                    const float o0 = bf_lo(uu.x) * (acc[mt][4 * g4] + bs), o1 = bf_hi(uu.x) * (acc[mt][4 * g4 + 1] + bs), o2 = bf_lo(uu.y) * (acc[mt][4 * g4 + 2] + bs), o3 = bf_hi(uu.y) * (acc[mt][4 * g4 + 3] + bs);
                    u32x2 w2; w2.x = cvt_pk_bf16(o0, o1); w2.y = cvt_pk_bf16(o2, o3); *(u32x2*)(YS + tok * 512 + c) = w2;
                }
        }
        }
    }
}

DI void ffn_fix_phase(KP p, int l, int wv) {
    unsigned char* ws = ows(p->ws);
    bf16_t* ACT = (bf16_t*)(ws + WS_UP); const float* SA = (const float*)(ws + WS_SIDEA); const float* SG = (const float*)(ws + WS_SIDEG);
    const float* cw = p->in[25] + (size_t)l * 3 * DFF; const float* cb = p->in[26] + (size_t)l * DFF;
    constexpr int NCG = DFF / 8;
    const int tid_ = otid(wv);
    for (int item = blockIdx.x * 512 + tid_; item < 256 * 2 * NCG; item += gridDim.x * 512) {
        const int cgi = item % NCG, qe = item / NCG, q = qe >> 1, e = qe & 1, f = 8 * cgi;
        const bool first = (q & 63) == 0;
        float o[8];
#pragma unroll
        for (int hf = 0; hf < 2; ++hf) {
            const int ff = f + 4 * hf;
            const f32x4 at = *(const f32x4*)(SA + ((size_t)q * 4 + e) * DFF + ff);
            f32x4 t1 = {0.f, 0.f, 0.f, 0.f}, t2 = {0.f, 0.f, 0.f, 0.f};
            if (e == 1) t1 = *(const f32x4*)(SA + ((size_t)q * 4 + 0) * DFF + ff);
            else if (!first) t1 = *(const f32x4*)(SA + ((size_t)(q - 1) * 4 + 3) * DFF + ff);
            if (!first) t2 = *(const f32x4*)(SA + ((size_t)(q - 1) * 4 + (e == 1 ? 3 : 2)) * DFF + ff);
            const f32x4 g = *(const f32x4*)(SG + ((size_t)q * 2 + e) * DFF + ff);
            const f32x4 w0 = *(const f32x4*)(cw + ff), w1 = *(const f32x4*)(cw + DFF + ff), w2 = *(const f32x4*)(cw + 2 * DFF + ff), bb = *(const f32x4*)(cb + ff);
            const f32x4 c = bb + w0 * t2 + w1 * t1 + w2 * at;
#pragma unroll
            for (int j = 0; j < 4; ++j) o[4 * hf + j] = gelu_tanh(c[j]) * g[j];
        }
        u32x4 w; w.x = cvt_pk_bf16(o[0], o[1]); w.y = cvt_pk_bf16(o[2], o[3]); w.z = cvt_pk_bf16(o[4], o[5]); w.w = cvt_pk_bf16(o[6], o[7]);
        *(u32x4*)(ACT + (size_t)(64 * q + e) * DFF + f) = w;
    }
}

__global__ void __launch_bounds__(512) fwd_megakernel(Params p_unused) {
    extern __shared__ __attribute__((aligned(16))) unsigned char lds_raw[];
    LAS unsigned char* lds = (LAS unsigned char*)lds_raw;
    cg::grid_group grid = cg::this_grid();
    KP p = okp();
    unsigned char* ws = p->ws;
    const int G = gridDim.x, c = blockIdx.x;
    const int wv = __builtin_amdgcn_readfirstlane((int)(threadIdx.x >> 6));
    pg8::Epi E; pg8::TileOrder S; pg8::Gemm g;

    unsigned* bar = (unsigned*)(ws + WS_BAR);
    volatile LAS unsigned* xst = (volatile LAS unsigned*)(lds + LDS_BYTES - 16);
    const unsigned myx = xb_xcc_id();
    if (otid(wv) == 0) { xb_add(&bar[XB_CNT(myx)], 1u); __builtin_amdgcn_fence(__ATOMIC_RELEASE, "agent"); }
    grid.sync();
    if (otid(wv) == 0) {
        unsigned mine = 0u, cnt = 0u;
#pragma unroll
        for (unsigned j = 0; j < 8; ++j) { const unsigned c = xb_ld(&bar[XB_CNT(j)]); cnt += (c > 0u) ? 1u : 0u; mine = (j == myx) ? c : mine; }
        xst[0] = mine > 0u ? mine : 1u; xst[1] = cnt > 0u ? cnt : 1u; xst[2] = myx;
    }
    __syncthreads();
    phase0(p, lds, wv);
    gbar(bar, xst, wv);
#pragma unroll 1
    for (int st = 0; st < 2 * 12; ++st) {
        const int l = st / 12, step = st % 12;
        p = okp(); ws = ows(p->ws);
        const float* mod = (const float*)(ws + WS_MOD); const bf16_t* H = (const bf16_t*)(ws + WS_H);
        const float* ml = mod + (size_t)l * 4 * 6144;
        const float* xin = (l == 0) ? p->in[0] : p->out;
        bool do_gemm = false;
        E = pg8::Epi{}; g.merge = 0; g.ws = ws;
        if (step == 0) {
            if (l > 0) convert_weights(p, l, lds, wv);
            norm_mod_phase(xin, p->in[4] + l * DM, ml + 0, ml + 1024, (bf16_t*)(ws + WS_H), wv);
        } else if (step == 1 || step == 4) {
            if (step == 4) rwkv_post_phase(p, l, wv);
            E.mode = pg8::EM_INPROJ; E.o0 = (bf16_t*)(ws + WS_Q); E.o1 = (bf16_t*)(ws + WS_K); E.o2 = (bf16_t*)(ws + WS_V); E.o3 = (bf16_t*)(ws + WS_RAW); E.o4 = (bf16_t*)(ws + WS_UV);
            E.ropec = (const float*)(ws + WS_ROPEC); E.ropes = (const float*)(ws + WS_ROPES);
            g.A = H; g.Bt = (const bf16_t*)(ws + WS_WIN); g.lda = 1024; g.K = 1024;
            if (step == 1) S.init(64, 7, G, c, 7, 6, 0); else S.init(64, 10, G, c, 6, 0, 13);
            do_gemm = true;
        } else if (step == 2) { rwkv_derived_phase(p, l, wv); }
        else if (step == 3) { rwkv_scan_phase(p, lds, wv); }
        else if (step == 5) { attention_phase(p, lds, wv); gmlp_phase(p, l, lds, wv); }
        else if (step == 6) {
            E.mode = pg8::EM_MERGE; E.o0 = (bf16_t*)(ws + WS_GATE); E.o1 = (bf16_t*)(ws + WS_MB);
            g.merge = 1; g.A = H; g.Bt = (const bf16_t*)(ws + WS_WIN); g.lda = 1024; g.K = 1024;
            S.init(64, 4, G, c, 4, 0, 0, 6);
            do_gemm = true;
        } else if (step == 7) {
            E.mode = pg8::EM_RESID; E.f0 = p->out; E.f1 = xin; E.f2 = ml + 2048;
            g.A = (const bf16_t*)(ws + WS_MB); g.Bt = (const bf16_t*)(ws + WS_WOUT); g.lda = 1024; g.K = 1024;
            S.init(64, 4, G, c, 4, 0, 0); do_gemm = true;
        } else if (step == 8) { norm_mod_phase(p->out, p->in[23] + l * DM, ml + 3072, ml + 4096, (bf16_t*)(ws + WS_H), wv); }
        else if (step == 9) {
            E.mode = pg8::EM_UP; E.o0 = (bf16_t*)(ws + WS_UP); E.f0 = (float*)(ws + WS_SIDEA); E.f3 = (float*)(ws + WS_SIDEG); E.f1 = p->in[25] + (size_t)l * 3 * DFF; E.f2 = p->in[26] + (size_t)l * DFF;
            g.A = H; g.Bt = (const bf16_t*)(ws + WS_WUP); g.lda = 1024; g.K = 1024;
            S.init(64, 22, G, c, 22, 0, 0); do_gemm = true;
        } else if (step == 10) { ffn_fix_phase(p, l, wv); }
        else {
            E.mode = pg8::EM_RESID; E.f0 = p->out; E.f1 = p->out; E.f2 = ml + 5120;
            g.A = (const bf16_t*)(ws + WS_UP); g.Bt = (const bf16_t*)(ws + WS_WDN); g.lda = DFF; g.K = DFF;
            S.init(64, 4, G, c, 4, 0, 0); do_gemm = true;
        }
        if (do_gemm) pg8::gemm_phase(lds, g, S, E, wv);
        gbar((unsigned*)(ws + WS_BAR), xst, wv);
    }
    p = okp();
    final_norm_phase(p->out, p->in[28], wv);
}

extern "C" void kernel_launch(void* const* d_in, const int* in_sizes, int n_in, void* d_out, int out_size, void* d_ws, size_t ws_size, hipStream_t stream) {
    static int grid_blocks = 0;
    if (grid_blocks == 0) {
        int dev = 0, cus = 0, per_cu = 0;
        hipGetDevice(&dev);
        hipDeviceGetAttribute(&cus, hipDeviceAttributeMultiprocessorCount, dev);
        if (hipFuncSetAttribute((const void*)fwd_megakernel, hipFuncAttributeMaxDynamicSharedMemorySize, LDS_BYTES) != hipSuccess) { fprintf(stderr, "hipFuncSetAttribute failed\n"); }
        hipOccupancyMaxActiveBlocksPerMultiprocessor(&per_cu, (const void*)fwd_megakernel, 512, LDS_BYTES);
        if (per_cu < 1) { fprintf(stderr, "occupancy query returned %d\n", per_cu); per_cu = 1; }
        if (per_cu > 1) per_cu = 1;
        grid_blocks = cus * per_cu;
        (void)hipGetLastError();
    }
    if (n_in != 29 || ws_size < 256 * MiB) { fprintf(stderr, "unexpected inputs/workspace\n"); return; }
    (void)hipMemsetAsync((unsigned char*)d_ws + WS_BAR, 0, XB_WORDS * 4, stream);
    Params p{};
    for (int i = 0; i < 29; ++i) p.in[i] = (const float*)d_in[i];
    p.out = (float*)d_out; p.ws = (unsigned char*)d_ws;
    void* args[] = {&p};
    hipError_t e = hipLaunchCooperativeKernel((const void*)fwd_megakernel, dim3(grid_blocks), dim3(512), args, LDS_BYTES, stream);
    if (e != hipSuccess) fprintf(stderr, "cooperative launch failed: %s (grid %d)\n", hipGetErrorString(e), grid_blocks);
}
```

```cpp
#include <hip/hip_runtime.h>
#include <hip/hip_cooperative_groups.h>
#include <cstdio>
#include <cstdint>
namespace cg = cooperative_groups;

#define LAS __attribute__((address_space(3)))
#define DI __device__ __forceinline__
typedef unsigned short bf16_t;
typedef short bf16x8 __attribute__((ext_vector_type(8)));
typedef float f32x4 __attribute__((ext_vector_type(4)));
typedef float f32x16 __attribute__((ext_vector_type(16)));
typedef unsigned u32x4 __attribute__((ext_vector_type(4)));
typedef unsigned u32x2 __attribute__((ext_vector_type(2)));

constexpr int DM = 1024, SEQ = 4096, MTOK = 16384, INC = 7424, DFF = 2816, UPC = 5632, RAWC = 1792;
constexpr int LDS_BYTES = 147456;
constexpr size_t MiB = 1048576;
constexpr size_t WS_WIN = 0, WS_WBR = WS_WIN + (size_t)INC * 1024 * 2, WS_WOUT = WS_WBR + 3u * 1024 * 512 * 2, WS_WUP = WS_WOUT + 1024u * 1024 * 2,
                 WS_WDN = WS_WUP + (size_t)UPC * 1024 * 2, WS_LWU = WS_WDN + (size_t)DFF * 1024 * 2, WS_LAU = WS_LWU + 65536, WS_LGU = WS_LAU + 65536;
constexpr size_t WS_H = 37 * MiB;
constexpr size_t WS_SMALL = 69 * MiB, WS_MOD = WS_SMALL, WS_ROPEC = WS_MOD + 262144, WS_ROPES = WS_ROPEC + 524288, WS_BONUS = WS_ROPES + 524288, WS_LSE = WS_BONUS + 524288;
constexpr size_t WS_BAR = WS_LSE + 524288;
constexpr size_t DB = 72 * MiB;
constexpr size_t WS_RAW = DB, WS_RZ = DB + 56 * MiB, WS_KP = DB + 72 * MiB, WS_KKN = DB + 88 * MiB, WS_B = DB + 104 * MiB, WS_W = DB + 120 * MiB, WS_VZ = DB + 152 * MiB, WS_G = DB + 168 * MiB;
constexpr size_t WS_YRAW = DB, WS_YSR = DB + 32 * MiB;
constexpr size_t WS_Q = DB + 56 * MiB, WS_K = DB + 72 * MiB, WS_V = DB + 88 * MiB, WS_UV = DB + 104 * MiB;
constexpr size_t WS_YSA = DB + 152 * MiB, WS_YSG = DB + 168 * MiB;
constexpr size_t WS_GATE = DB, WS_M32 = DB + 48 * MiB, WS_MB = DB + 112 * MiB;
constexpr size_t WS_UP = DB;
constexpr size_t WS_SIDEA = DB + 88 * MiB, WS_SIDEG = DB + 100 * MiB;
static_assert(WS_LGU + 131072 <= WS_H, "weights region overflow");
static_assert(WS_BAR + 64 * 26 * 4 <= DB, "small region overflow");

struct Params {
    const float* in[29];
    float* out;
    unsigned char* ws;
};

typedef const __attribute__((address_space(4))) Params* KP;
DI KP okp() { unsigned long long k = (unsigned long long)__builtin_amdgcn_kernarg_segment_ptr(); asm volatile("" : "+s"(k)); return (KP)k; }
typedef float f32x2_t __attribute__((ext_vector_type(2)));
typedef __bf16 bf16x2_t __attribute__((ext_vector_type(2)));
DI unsigned cvt_pk_bf16(float lo, float hi) { const f32x2_t v = {lo, hi}; const bf16x2_t r = __builtin_convertvector(v, bf16x2_t); return __builtin_bit_cast(unsigned, r); }
DI float bf_lo(unsigned w) { return __uint_as_float(w << 16); }
DI float bf_hi(unsigned w) { return __uint_as_float(w & 0xffff0000u); }
DI int otid(int wv) { int ln; asm volatile("v_mbcnt_lo_u32_b32 %0, -1, 0\n\tv_mbcnt_hi_u32_b32 %0, -1, %0" : "=v"(ln)); return wv * 64 + ln; }
DI unsigned char* ows(unsigned char* w) { asm volatile("" : "+s"(w)); return w; }
DI float row16_sum(float v) {
    v += __builtin_bit_cast(float, __builtin_amdgcn_update_dpp(0, __builtin_bit_cast(int, v), 0xB1, 0xF, 0xF, false));
    v += __builtin_bit_cast(float, __builtin_amdgcn_update_dpp(0, __builtin_bit_cast(int, v), 0x4E, 0xF, 0xF, false));
    v += __builtin_bit_cast(float, __builtin_amdgcn_update_dpp(0, __builtin_bit_cast(int, v), 0x141, 0xF, 0xF, false));
    v += __builtin_bit_cast(float, __builtin_amdgcn_update_dpp(0, __builtin_bit_cast(int, v), 0x140, 0xF, 0xF, false));
    return v;
}
DI float wave_sum(float v) { v = row16_sum(v); v += __shfl_xor(v, 16); v += __shfl_xor(v, 32); return v; }
#define XB_CNT(j)  (64 * (j))
#define XB_SUB(j)  (64 * (8 + (j)))
#define XB_GEN(j)  (64 * (16 + (j)))
#define XB_TOP     (64 * 24)
#define XB_TOPGEN  (64 * 25)
#define XB_WORDS   (64 * 26)
DI unsigned xb_ld(unsigned* p) { return __hip_atomic_load(p, __ATOMIC_RELAXED, __HIP_MEMORY_SCOPE_AGENT); }
DI unsigned xb_add(unsigned* p, unsigned v) { return __hip_atomic_fetch_add(p, v, __ATOMIC_RELAXED, __HIP_MEMORY_SCOPE_AGENT); }
DI unsigned xb_xcc_id() { return (unsigned)__builtin_amdgcn_s_getreg((3 << 11) | 20) & 0x7u; }
DI void gbar(unsigned* bar, volatile LAS unsigned* st, int wv) {
    asm volatile("s_waitcnt vmcnt(0) lgkmcnt(0)" ::: "memory");
    __syncthreads();
    if (otid(wv) == 0) {
        const unsigned nloc = st[0], nx = st[1], x = st[2];
        const unsigned old = xb_add(&bar[XB_SUB(x)], 1u);
        const unsigned gen = old / nloc;
        if (old + 1u == (gen + 1u) * nloc) {
            __builtin_amdgcn_fence(__ATOMIC_RELEASE, "agent");
            asm volatile("s_waitcnt vmcnt(0)" ::: "memory");
            const unsigned og = xb_add(&bar[XB_TOP], 1u);
            const unsigned tg = og / nx;
            if (og + 1u == (tg + 1u) * nx) xb_add(&bar[XB_TOPGEN], 1u);
            else { while (xb_ld(&bar[XB_TOPGEN]) == tg) __builtin_amdgcn_s_sleep(1); }
            __builtin_amdgcn_fence(__ATOMIC_ACQUIRE, "agent");
            xb_add(&bar[XB_GEN(x)], 1u);
            asm volatile("s_waitcnt vmcnt(0)" ::: "memory");
        } else {
            while (xb_ld(&bar[XB_GEN(x)]) == gen) __builtin_amdgcn_s_sleep(1);
            __builtin_amdgcn_fence(__ATOMIC_ACQUIRE, "agent");
            asm volatile("s_waitcnt vmcnt(0)" ::: "memory");
        }
    }
    asm volatile("" ::: "memory");
    __syncthreads();
}
DI float sigmoidf_(float x) { return __builtin_amdgcn_rcpf(1.0f + __expf(-x)); }
DI float gelu_tanh(float x) { const float u = 1.5957691216f * (x + 0.044715f * x * x * x); return x * __builtin_amdgcn_rcpf(1.0f + __expf(-u)); }
#define LDS_WAIT() asm volatile("s_waitcnt lgkmcnt(0)" ::: "memory")
#define MFMA32(a, b, c) __builtin_amdgcn_mfma_f32_32x32x16_bf16((a), (b), (c), 0, 0, 0)
DI int crow(int reg, int h) { return (reg & 3) + 8 * (reg >> 2) + 4 * h; }
DI bf16x8 pack8(float a0, float a1, float a2, float a3, float a4, float a5, float a6, float a7) {
    u32x4 p; p.x = cvt_pk_bf16(a0, a1); p.y = cvt_pk_bf16(a2, a3); p.z = cvt_pk_bf16(a4, a5); p.w = cvt_pk_bf16(a6, a7);
    return __builtin_bit_cast(bf16x8, p);
}

namespace pg8 {
constexpr int BM = 256, BK = 64, HALF = 128, HTB = HALF * BK * 2, STAGE_BYTES = 8 * HTB, NXCD = 8, WGM = 8;
DI int lds_byte(int r, int c) { const int st = (r >> 4) * 2 + (c >> 5), rr = r & 15, cc = c & 31, ob = rr * 64 + cc * 2; return st * 1024 + (ob ^ (((ob >> 9) & 1) << 5)); }
DI void stage_rc(int b, int& R, int& C) { const int st = b / 1024, sb = b % 1024, swz = sb ^ (((sb >> 9) & 1) << 5); R = (st >> 1) * 16 + swz / 64; C = (st & 1) * 32 + (swz % 64) / 2; }
DI int perm32(int rho) { const int n = rho >> 4, i = rho & 15; return 8 * (i >> 2) + 4 * n + (i & 3); }
struct Unit { int pm, pn, sub; };
struct Gemm { const bf16_t* A; const bf16_t* Bt; int lda, K; int merge; const unsigned char* ws; };
struct TileOrder {
    int nM, nN, nwg, G, c, split, off0, off1, nsub;
    DI void init(int nM_, int nN_, int G_, int c_, int split_, int off0_, int off1_, int nsub_ = 1) { nM = nM_; nN = nN_; nwg = nM * nN; G = G_; c = c_; split = split_; off0 = off0_; off1 = off1_; nsub = nsub_; }
    DI bool next(int i0, Unit& u) const {
        const int i = i0 / nsub; u.sub = i0 - i * nsub;
        const long L = (long)i * G + c; if (L >= nwg) return false;
        int wgid = (int)L; { const int q = nwg / NXCD, r = nwg % NXCD, xcd = wgid % NXCD, off = wgid / NXCD; wgid = (xcd < r ? xcd * (q + 1) : r * (q + 1) + (xcd - r) * q) + off; }
        const int nig = WGM * nN, gid = wgid / nig, fm = gid * WGM, gsz = (nM - fm) < WGM ? (nM - fm) : WGM;
        u.pm = fm + ((wgid % nig) % gsz); const int pnv = (wgid % nig) / gsz; u.pn = pnv < split ? pnv + off0 : pnv - split + off1; return true;
    }
};

enum { EM_INPROJ = 0, EM_GATE = 1, EM_BR_FIRST = 2, EM_BR_MID = 3, EM_BR_LAST = 4, EM_RESID = 5, EM_UP = 6, EM_MERGE = 7 };
struct Epi {
    int mode;
    bf16_t *o0, *o1, *o2, *o3, *o4;
    float* f3;
    float* f0; const float* f1; const float* f2;
    const float *ropec, *ropes;
    DI void up_conv(const f32x4 (&acc)[2][2][4][2], const Unit& u, int wr, int wc, int fr, int fq) const {
        const int f = u.pn * 128 + wc * 32 + 8 * fq;
        const int src1 = (fq << 4) | ((fr + 15) & 15), src2 = (fq << 4) | ((fr + 14) & 15);
        const f32x4 w0a = *(const f32x4*)(f1 + f), w0b = *(const f32x4*)(f1 + f + 4), w1a = *(const f32x4*)(f1 + DFF + f), w1b = *(const f32x4*)(f1 + DFF + f + 4);
        const f32x4 w2a = *(const f32x4*)(f1 + 2 * DFF + f), w2b = *(const f32x4*)(f1 + 2 * DFF + f + 4), cba = *(const f32x4*)(f2 + f), cbb = *(const f32x4*)(f2 + f + 4);
#pragma unroll
        for (int ai = 0; ai < 2; ++ai) {
            const int q = u.pm * 4 + ai * 2 + wr;
            f32x4 p1a_prev = {0.f, 0.f, 0.f, 0.f}, p1b_prev = p1a_prev, p2a_prev = p1a_prev, p2b_prev = p1a_prev;
#pragma unroll
            for (int m = 0; m < 4; ++m) {
                const f32x4 aa = acc[ai][0][m][0], ab = acc[ai][0][m][1], ga = acc[ai][1][m][0], gb = acc[ai][1][m][1];
                f32x4 p1a, p1b, p2a, p2b;
#pragma unroll
                for (int j = 0; j < 4; ++j) {
                    p1a[j] = __shfl(aa[j], src1); p1b[j] = __shfl(ab[j], src1); p2a[j] = __shfl(aa[j], src2); p2b[j] = __shfl(ab[j], src2);
                }
                const f32x4 t1a = fr >= 1 ? p1a : p1a_prev, t1b = fr >= 1 ? p1b : p1b_prev, t2a = fr >= 2 ? p2a : p2a_prev, t2b = fr >= 2 ? p2b : p2b_prev;
                const f32x4 ca = cba + w0a * t2a + w1a * t1a + w2a * aa, cb_ = cbb + w0b * t2b + w1b * t1b + w2b * ab;
                const int row = u.pm * BM + ai * HALF + wr * 64 + m * 16 + fr;
                u32x4 w;
                w.x = cvt_pk_bf16(gelu_tanh(ca[0]) * ga[0], gelu_tanh(ca[1]) * ga[1]); w.y = cvt_pk_bf16(gelu_tanh(ca[2]) * ga[2], gelu_tanh(ca[3]) * ga[3]);
                w.z = cvt_pk_bf16(gelu_tanh(cb_[0]) * gb[0], gelu_tanh(cb_[1]) * gb[1]); w.w = cvt_pk_bf16(gelu_tanh(cb_[2]) * gb[2], gelu_tanh(cb_[3]) * gb[3]);
                *(u32x4*)(o0 + (size_t)row * DFF + f) = w;
                if (m == 0 && fr < 2) {
                    float* sa = f0 + ((size_t)q * 4 + fr) * DFF + f; *(f32x4*)sa = aa; *(f32x4*)(sa + 4) = ab;
                    float* sg = f3 + ((size_t)q * 2 + fr) * DFF + f; *(f32x4*)sg = ga; *(f32x4*)(sg + 4) = gb;
                }
                if (m == 3 && fr >= 14) { float* sa = f0 + ((size_t)q * 4 + 2 + (fr - 14)) * DFF + f; *(f32x4*)sa = aa; *(f32x4*)(sa + 4) = ab; }
                p1a_prev = p1a; p1b_prev = p1b; p2a_prev = p2a; p2b_prev = p2b;
            }
        }
    }
    DI void operator()(const f32x4 (&acc)[2][2][4][2], const Unit& u, int wr, int wc, int fr, int fq) const {
        if (mode == EM_UP) { up_conv(acc, u, wr, wc, fr, fq); return; }
        const int mode = (this->mode == EM_MERGE) ? (((u.sub & 1) == 0) ? (int)EM_GATE : ((u.sub >> 1) == 0 ? (int)EM_BR_FIRST : ((u.sub >> 1) == 1 ? (int)EM_BR_MID : (int)EM_BR_LAST))) : this->mode;
        const int row0 = u.pm * BM + wr * 64 + fr, colb = u.pn * BM + wc * 32 + 8 * fq;
        if (mode == EM_RESID) {
            const float* gv = f2 + (size_t)(row0 >> 12) * 6144 + colb;
            const f32x4 g00 = *(const f32x4*)gv, g01 = *(const f32x4*)(gv + 4), g10 = *(const f32x4*)(gv + HALF), g11 = *(const f32x4*)(gv + HALF + 4);
#pragma unroll
            for (int ai = 0; ai < 2; ++ai) {
                f32x4 b0[4][2], b1[4][2];
#pragma unroll
                for (int m = 0; m < 4; ++m)
#pragma unroll
                    for (int bj = 0; bj < 2; ++bj) { const size_t off = (size_t)(row0 + ai * HALF + m * 16) * 1024 + colb + bj * HALF; b0[m][bj] = *(const f32x4*)(f1 + off); b1[m][bj] = *(const f32x4*)(f1 + off + 4); }
                asm volatile("" ::: "memory");
#pragma unroll
                for (int m = 0; m < 4; ++m)
#pragma unroll
                    for (int bj = 0; bj < 2; ++bj) { const size_t off = (size_t)(row0 + ai * HALF + m * 16) * 1024 + colb + bj * HALF;
                        *(f32x4*)(f0 + off) = b0[m][bj] + (bj ? g10 : g00) * acc[ai][bj][m][0]; *(f32x4*)(f0 + off + 4) = b1[m][bj] + (bj ? g11 : g01) * acc[ai][bj][m][1]; }
            }
            return;
        }
        if (mode == EM_BR_FIRST || mode == EM_BR_MID || mode == EM_BR_LAST) {
#pragma unroll
            for (int ai = 0; ai < 2; ++ai) {
                u32x4 gw[4][2], pm[4][2];
#pragma unroll
                for (int m = 0; m < 4; ++m)
#pragma unroll
                    for (int bj = 0; bj < 2; ++bj) { const size_t off = (size_t)(row0 + ai * HALF + m * 16) * 1024 + colb + bj * HALF; gw[m][bj] = *(const u32x4*)(o0 + off);
                        pm[m][bj] = (u32x4){0u, 0u, 0u, 0u}; if (mode != EM_BR_FIRST) pm[m][bj] = *(const u32x4*)(o1 + off); }
                asm volatile("" ::: "memory");
#pragma unroll
                for (int m = 0; m < 4; ++m)
#pragma unroll
                    for (int bj = 0; bj < 2; ++bj) { const size_t off = (size_t)(row0 + ai * HALF + m * 16) * 1024 + colb + bj * HALF;
                        const f32x4 v0 = acc[ai][bj][m][0], v1 = acc[ai][bj][m][1]; const u32x4 g_ = gw[m][bj], q_ = pm[m][bj];
                        u32x4 w;
                        w.x = cvt_pk_bf16(bf_lo(g_.x) * v0[0] + bf_lo(q_.x), bf_hi(g_.x) * v0[1] + bf_hi(q_.x)); w.y = cvt_pk_bf16(bf_lo(g_.y) * v0[2] + bf_lo(q_.y), bf_hi(g_.y) * v0[3] + bf_hi(q_.y));
                        w.z = cvt_pk_bf16(bf_lo(g_.z) * v1[0] + bf_lo(q_.z), bf_hi(g_.z) * v1[1] + bf_hi(q_.z)); w.w = cvt_pk_bf16(bf_lo(g_.w) * v1[2] + bf_lo(q_.w), bf_hi(g_.w) * v1[3] + bf_hi(q_.w));
                        *(u32x4*)(o1 + off) = w; }
            }
            return;
        }
#pragma unroll
        for (int ai = 0; ai < 2; ++ai) {
            f32x4 csn[4][2], snn[4][2];
            if (mode == EM_INPROJ && u.pn < 4) {
#pragma unroll
                for (int m = 0; m < 4; ++m)
#pragma unroll
                    for (int bj = 0; bj < 2; ++bj) { const int pos = (row0 + ai * HALF + m * 16) & (SEQ - 1), e0 = ((colb + bj * HALF) & 63) >> 1;
                        csn[m][bj] = *(const f32x4*)(ropec + pos * 32 + e0); snn[m][bj] = *(const f32x4*)(ropes + pos * 32 + e0); }
                asm volatile("" ::: "memory");
            }
#pragma unroll
            for (int m = 0; m < 4; ++m) {
                const int row = row0 + ai * HALF + m * 16;
#pragma unroll
                for (int bj = 0; bj < 2; ++bj) {
                    const int col0 = colb + bj * HALF;
                    f32x4 v0 = acc[ai][bj][m][0], v1 = acc[ai][bj][m][1];
                    if (mode == EM_INPROJ) {
                        bf16_t* dst;
                        if (u.pn < 4) {
                            const f32x4 cs = csn[m][bj], sn = snn[m][bj];
                            f32x4 a, b;
                            a[0] = v0[0] * cs[0] - v0[1] * sn[0]; a[1] = v0[1] * cs[0] + v0[0] * sn[0];
                            a[2] = v0[2] * cs[1] - v0[3] * sn[1]; a[3] = v0[3] * cs[1] + v0[2] * sn[1];
                            b[0] = v1[0] * cs[2] - v1[1] * sn[2]; b[1] = v1[1] * cs[2] + v1[0] * sn[2];
                            b[2] = v1[2] * cs[3] - v1[3] * sn[3]; b[3] = v1[3] * cs[3] + v1[2] * sn[3];
                            v0 = a; v1 = b;
                            dst = (u.pn < 2) ? o0 + (size_t)row * 512 + col0 : o1 + (size_t)row * 512 + (col0 - 512);
                        } else if (u.pn < 6) { dst = o2 + (size_t)row * 512 + (col0 - 1024); }
                        else if (u.pn < 13) { dst = o3 + (size_t)row * RAWC + (col0 - 1536); }
                        else {
#pragma unroll
                            for (int j = 0; j < 4; ++j) { v0[j] = gelu_tanh(v0[j]); v1[j] = gelu_tanh(v1[j]); }
                            dst = o4 + (size_t)row * 1024 + (col0 - 3328);
                        }
                        u32x4 w; w.x = cvt_pk_bf16(v0[0], v0[1]); w.y = cvt_pk_bf16(v0[2], v0[3]); w.z = cvt_pk_bf16(v1[0], v1[1]); w.w = cvt_pk_bf16(v1[2], v1[3]);
                        *(u32x4*)dst = w;
                    } else {
#pragma unroll
                        for (int j = 0; j < 4; ++j) { v0[j] = sigmoidf_(v0[j]); v1[j] = sigmoidf_(v1[j]); }
                        u32x4 w; w.x = cvt_pk_bf16(v0[0], v0[1]); w.y = cvt_pk_bf16(v0[2], v0[3]); w.z = cvt_pk_bf16(v1[0], v1[1]); w.w = cvt_pk_bf16(v1[2], v1[3]);
                        *(u32x4*)(o0 + (size_t)row * 1024 + col0) = w;
                    }
                }
            }
        }
    }
};

DI void unit_operands(const Gemm& g, int sub, const char*& A, const char*& Bt, int& lda, int& K) {
    if (!g.merge) { A = (const char*)g.A; Bt = (const char*)g.Bt; lda = g.lda; K = g.K; return; }
    const int br = sub >> 1;
    if ((sub & 1) == 0) { A = (const char*)(g.ws + WS_H); Bt = (const char*)(g.ws + WS_WIN) + (size_t)(4352 + 1024 * br) * 1024 * 2; lda = 1024; K = 1024; }
    else { A = (const char*)(g.ws + (br == 0 ? WS_YSA : (br == 1 ? WS_YSR : WS_YSG))); Bt = (const char*)(g.ws + WS_WBR) + (size_t)br * 1024 * 512 * 2; lda = 512; K = 512; }
}
DI void gemm_phase(LAS unsigned char* lds, const Gemm g, const TileOrder S, const Epi E, int wv) {
    const int tid = otid(wv), wid = __builtin_amdgcn_readfirstlane(tid >> 6), lane = tid & 63, wr = wid >> 2, wc = wid & 3, fr = lane & 15, fq = lane >> 4;
    int stR[2], stC[2], stRb[2];
#pragma unroll
    for (int i = 0; i < 2; ++i) { int R, C; stage_rc(tid * 16 + i * 8192, R, C); stR[i] = R; stC[i] = C; stRb[i] = (R & ~31) + perm32(R & 31); }
    const size_t kstep = (size_t)(BK * 2);
    const unsigned ldsw = (unsigned)wid * 1024u;
    const int aoff = lds_byte(wr * 64 + fr, fq * 8), boff = lds_byte(wc * 32 + fr, fq * 8);
#define PG8_SA(b, h) (((b) * 2 + (h)) * HTB)
#define PG8_SB(b, h) ((4 + (b) * 2 + (h)) * HTB)
#define PG8_STAGE(bufoff, gbase, voff) do { _Pragma("unroll") for (int _i = 0; _i < 2; ++_i) \
        __builtin_amdgcn_global_load_lds((const unsigned*)((const char*)(gbase) + (voff)[_i]), (LAS unsigned*)(lds + (bufoff) + ldsw + _i * 8192), 16, 0, 0); } while (0)
#define PG8_LDA(dst, b, h) do { _Pragma("unroll") for (int m = 0; m < 4; ++m) _Pragma("unroll") for (int k = 0; k < 2; ++k) dst[m][k] = *(const LAS bf16x8*)(lds + PG8_SA(b, h) + aoff + m * 2048 + k * 1024); } while (0)
#define PG8_LDB(dst, b, h) do { _Pragma("unroll") for (int n = 0; n < 2; ++n) _Pragma("unroll") for (int k = 0; k < 2; ++k) dst[n][k] = *(const LAS bf16x8*)(lds + PG8_SB(b, h) + boff + n * 2048 + k * 1024); } while (0)
#define PG8_MMA(ai, bj, At, Bt) do { __builtin_amdgcn_s_setprio(1); _Pragma("unroll") for (int m = 0; m < 4; ++m) _Pragma("unroll") for (int n = 0; n < 2; ++n) _Pragma("unroll") for (int k = 0; k < 2; ++k) \
        acc[ai][bj][m][n] = __builtin_amdgcn_mfma_f32_16x16x32_bf16(Bt[n][k], At[m][k], acc[ai][bj][m][n], 0, 0, 0); __builtin_amdgcn_s_setprio(0); } while (0)
#define PG8_WAIT_V(n) asm volatile("s_waitcnt vmcnt(" #n ")" ::: "memory")
#define PG8_WAIT_L(n) asm volatile("s_waitcnt lgkmcnt(" #n ")" ::: "memory")
#define PG8_BAR __builtin_amdgcn_s_barrier()
#define PG8_SCHED __builtin_amdgcn_sched_barrier(0)
#define PG8_SETUP(u, pA, pB, vA, vB, hA, hB, ntv) do { const char* _A; const char* _B; int _lda, _K; unit_operands(g, (u).sub, _A, _B, _lda, _K); \
        pA = _A + (size_t)(u).pm * 256 * _lda * 2; pB = _B + (size_t)(u).pn * 256 * _K * 2; hA = (size_t)HALF * _lda * 2; hB = (size_t)HALF * _K * 2; ntv = _K / BK; \
        _Pragma("unroll") for (int _i = 0; _i < 2; ++_i) { vA[_i] = (unsigned)(stR[_i] * _lda + stC[_i]) * 2u; vB[_i] = (unsigned)(stRb[_i] * _K + stC[_i]) * 2u; } } while (0)
    Unit cur, nxt; int ui = 0;
    if (!S.next(0, cur)) return;
    f32x4 acc[2][2][4][2];
#pragma unroll
    for (int a = 0; a < 2; ++a)
#pragma unroll
        for (int b = 0; b < 2; ++b)
#pragma unroll
            for (int m = 0; m < 4; ++m)
#pragma unroll
                for (int n = 0; n < 2; ++n) acc[a][b][m][n] = (f32x4){0.f, 0.f, 0.f, 0.f};
    bf16x8 At[4][2], B0[2][2], B1[2][2];
    const char *cA, *cB, *nA, *nB; unsigned vAc[2], vBc[2], vAn[2], vBn[2]; size_t hAc, hBc, hAn, hBn; int nt, ntn;
    PG8_SETUP(cur, cA, cB, vAc, vBc, hAc, hBc, nt);
    PG8_STAGE(PG8_SB(0, 0), cB, vBc); PG8_STAGE(PG8_SA(0, 0), cA, vAc); PG8_STAGE(PG8_SB(0, 1), cB + hBc, vBc); PG8_STAGE(PG8_SA(0, 1), cA + hAc, vAc);
    if (wr == 1) PG8_BAR;
    PG8_WAIT_V(4); PG8_BAR;
    PG8_STAGE(PG8_SB(1, 0), cB + kstep, vBc); PG8_STAGE(PG8_SA(1, 0), cA + kstep, vAc); PG8_STAGE(PG8_SB(1, 1), cB + hBc + kstep, vBc);
    PG8_WAIT_V(6); PG8_BAR;
    for (;;) {
        const bool has_next = S.next(ui + 1, nxt);
        if (has_next) { PG8_SETUP(nxt, nA, nB, vAn, vBn, hAn, hBn, ntn); }
        else { nA = cA; nB = cB; vAn[0] = vAc[0]; vAn[1] = vAc[1]; vBn[0] = vBc[0]; vBn[1] = vBc[1]; hAn = hAc; hBn = hBc; ntn = nt; }
        for (int t = 0; t < nt; t += 2) {
            const bool last = (t == nt - 2);
            const char* a1 = cA + (size_t)(t + 1) * kstep;
            const char* a2 = last ? nA : cA + (size_t)(t + 2) * kstep; const char* b2 = last ? nB : cB + (size_t)(t + 2) * kstep;
            const char* a3 = a2 + kstep; const char* b3 = b2 + kstep;
            unsigned vA2[2], vB2[2]; vA2[0] = last ? vAn[0] : vAc[0]; vA2[1] = last ? vAn[1] : vAc[1]; vB2[0] = last ? vBn[0] : vBc[0]; vB2[1] = last ? vBn[1] : vBc[1];
            const size_t hA2 = last ? hAn : hAc, hB2 = last ? hBn : hBc;
            PG8_LDB(B0, 0, 0); PG8_SCHED; PG8_LDA(At, 0, 0); PG8_STAGE(PG8_SA(1, 1), a1 + hAc, vAc);
            PG8_WAIT_L(8); PG8_BAR; PG8_WAIT_L(0); PG8_MMA(0, 0, At, B0); PG8_BAR; PG8_SCHED;
            PG8_LDB(B1, 0, 1); PG8_STAGE(PG8_SB(0, 0), b2, vB2);
            PG8_BAR; PG8_WAIT_L(0); PG8_MMA(0, 1, At, B1); PG8_BAR;
            PG8_LDA(At, 0, 1); PG8_STAGE(PG8_SA(0, 0), a2, vA2);
            PG8_BAR; PG8_WAIT_L(0); PG8_MMA(1, 0, At, B0); PG8_BAR; PG8_SCHED;
            PG8_STAGE(PG8_SB(0, 1), b2 + hB2, vB2);
            PG8_WAIT_V(6); PG8_BAR; PG8_MMA(1, 1, At, B1); PG8_BAR;
            PG8_LDB(B0, 1, 0); PG8_SCHED; PG8_LDA(At, 1, 0); PG8_STAGE(PG8_SA(0, 1), a2 + hA2, vA2);
            PG8_WAIT_L(8); PG8_BAR; PG8_WAIT_L(0); PG8_MMA(0, 0, At, B0); PG8_BAR; PG8_SCHED;
            PG8_LDB(B1, 1, 1); PG8_STAGE(PG8_SB(1, 0), b3, vB2);
            PG8_BAR; PG8_WAIT_L(0); PG8_MMA(0, 1, At, B1); PG8_BAR;
            PG8_LDA(At, 1, 1); PG8_STAGE(PG8_SA(1, 0), a3, vA2);
            PG8_BAR; PG8_WAIT_L(0); PG8_MMA(1, 0, At, B0); PG8_BAR; PG8_SCHED;
            PG8_STAGE(PG8_SB(1, 1), b3 + hB2, vB2);
            PG8_WAIT_V(6); PG8_BAR; PG8_MMA(1, 1, At, B1); PG8_BAR;
        }
        E(acc, cur, wr, wc, fr, fq);
        if (!has_next) break;
#pragma unroll
        for (int a = 0; a < 2; ++a)
#pragma unroll
            for (int b = 0; b < 2; ++b)
#pragma unroll
                for (int m = 0; m < 4; ++m)
#pragma unroll
                    for (int n = 0; n < 2; ++n) acc[a][b][m][n] = (f32x4){0.f, 0.f, 0.f, 0.f};
        cur = nxt; cA = nA; cB = nB; vAc[0] = vAn[0]; vAc[1] = vAn[1]; vBc[0] = vBn[0]; vBc[1] = vBn[1]; hAc = hAn; hBc = hBn; nt = ntn; ++ui;
    }
    PG8_WAIT_V(0);
    if (wr == 0) PG8_BAR;
    PG8_BAR;
#undef PG8_SA
#undef PG8_SB
#undef PG8_STAGE
#undef PG8_LDA
#undef PG8_LDB
#undef PG8_MMA
#undef PG8_WAIT_V
#undef PG8_WAIT_L
#undef PG8_BAR
#undef PG8_SCHED
#undef PG8_SETUP
}
}

template <int PERMK>
DI void transpose_item(const float* W, int K, int N, bf16_t* WT, LAS float* scr, int item, int lane) {
    const int nblk = N / 32, kb = item / nblk, nb = item % nblk, k0 = 64 * kb, n0 = 32 * nb;
    int sc = n0 + (lane & 31);
    if (PERMK == 1 && sc < 1024) { const int hd = sc >> 6, cp = sc & 63; sc = hd * 64 + 32 * (cp & 1) + (cp >> 1); }
    if (PERMK == 2) { const int tl = sc >> 8, w = sc & 255; sc = (w < 128) ? (128 * tl + w) : (DFF + 128 * tl + (w - 128)); }
#pragma unroll 8
    for (int i = 0; i < 32; ++i) { const int kk = 2 * i + (lane >> 5); scr[kk * 33 + (lane & 31)] = W[(size_t)(k0 + kk) * N + sc]; }
    LDS_WAIT();
    const int c = lane & 7;
#pragma unroll
    for (int j = 0; j < 4; ++j) { const int n = (lane >> 3) + 8 * j; const LAS float* s = scr + (8 * c) * 33 + n;
        u32x4 o; o.x = cvt_pk_bf16(s[0 * 33], s[1 * 33]); o.y = cvt_pk_bf16(s[2 * 33], s[3 * 33]); o.z = cvt_pk_bf16(s[4 * 33], s[5 * 33]); o.w = cvt_pk_bf16(s[6 * 33], s[7 * 33]);
        *(u32x4*)(WT + (size_t)(n0 + n) * K + k0 + 8 * c) = o; }
    LDS_WAIT();
}

DI void convert_weights(KP p, int l, LAS unsigned char* lds, int wv) {
    const int tid_ = otid(wv); const int wave = tid_ >> 6, lane = tid_ & 63;
    LAS float* scr = (LAS float*)(lds + wave * 8448);
    const int gw = blockIdx.x * 8 + wave, NGW = gridDim.x * 8;
    constexpr int I_IN = 16 * (INC / 32), I_BR = 8 * 32, I_OUT = 16 * 32, I_UP = 16 * (UPC / 32), I_DN = (DFF / 64) * 32, I_L64 = 16, I_L128 = 32;
    constexpr int NIT = I_IN + 3 * I_BR + I_OUT + I_UP + I_DN + 2 * I_L64 + I_L128;
    unsigned char* ws = ows(p->ws);
    for (int it = gw; it < NIT; it += NGW) {
        int r = it;
        if (r < I_IN) { transpose_item<1>(p->in[5] + (size_t)l * 1024 * INC, 1024, INC, (bf16_t*)(ws + WS_WIN), scr, r, lane); continue; } r -= I_IN;
        if (r < 3 * I_BR) { const int b = r / I_BR; transpose_item<0>(p->in[21] + ((size_t)l * 3 + b) * 512 * 1024, 512, 1024, (bf16_t*)(ws + WS_WBR) + (size_t)b * 1024 * 512, scr, r % I_BR, lane); continue; } r -= 3 * I_BR;
        if (r < I_OUT) { transpose_item<0>(p->in[22] + (size_t)l * 1024 * 1024, 1024, 1024, (bf16_t*)(ws + WS_WOUT), scr, r, lane); continue; } r -= I_OUT;
        if (r < I_UP) { transpose_item<2>(p->in[24] + (size_t)l * 1024 * UPC, 1024, UPC, (bf16_t*)(ws + WS_WUP), scr, r, lane); continue; } r -= I_UP;
        if (r < I_DN) { transpose_item<0>(p->in[27] + (size_t)l * DFF * 1024, DFF, 1024, (bf16_t*)(ws + WS_WDN), scr, r, lane); continue; } r -= I_DN;
        if (r < I_L64) { transpose_item<0>(p->in[8] + (size_t)l * 64 * 512, 64, 512, (bf16_t*)(ws + WS_LWU), scr, r, lane); continue; } r -= I_L64;
        if (r < I_L64) { transpose_item<0>(p->in[10] + (size_t)l * 64 * 512, 64, 512, (bf16_t*)(ws + WS_LAU), scr, r, lane); continue; } r -= I_L64;
        transpose_item<0>(p->in[11] + (size_t)l * 128 * 512, 128, 512, (bf16_t*)(ws + WS_LGU), scr, r, lane);
    }
}

DI void phase0(KP p, LAS unsigned char* lds, int wv) {
    const int tid = otid(wv);
    float* ropec = (float*)(p->ws + WS_ROPEC); float* ropes = (float*)(p->ws + WS_ROPES);
    for (int idx = blockIdx.x * 512 + tid; idx < SEQ * 32; idx += gridDim.x * 512) {
        const int pos = idx >> 5, e = idx & 31;
        const float inv = 1.0f / exp2f((float)e * (13.287712379549449f / 32.0f));
        const float ang = (float)pos * inv;
        double rev = (double)ang * 0.15915494309189535; rev -= rint(rev);
        const float rv = (float)rev;
        ropec[idx] = __builtin_amdgcn_cosf(rv); ropes[idx] = __builtin_amdgcn_sinf(rv);
    }
    {
        LAS float* ca = (LAS float*)lds;
        LAS float* red = (LAS float*)(lds + 16384);
        float* mod = (float*)(p->ws + WS_MOD);
        bool loaded = false;
        for (int item = blockIdx.x; item < 192; item += gridDim.x) {
            if (!loaded) { for (int i = tid; i < 4096; i += 512) { const float v = p->in[1][i]; ca[i] = v / (1.0f + __expf(-v)); } loaded = true; __syncthreads(); }
            const int l = item / 96, c0 = (item % 96) * 64, cc = tid & 63, kg = tid >> 6;
            const float* w = p->in[2] + (size_t)l * 1024 * 6144 + c0 + cc;
            float a0 = 0.f, a1 = 0.f, a2 = 0.f, a3 = 0.f;
#pragma unroll 8
            for (int k = kg * 128; k < kg * 128 + 128; ++k) { const float wv = w[(size_t)k * 6144]; a0 += ca[k] * wv; a1 += ca[1024 + k] * wv; a2 += ca[2048 + k] * wv; a3 += ca[3072 + k] * wv; }
            red[(kg * 4 + 0) * 64 + cc] = a0; red[(kg * 4 + 1) * 64 + cc] = a1; red[(kg * 4 + 2) * 64 + cc] = a2; red[(kg * 4 + 3) * 64 + cc] = a3;
            __syncthreads();
            if (tid < 256) { const int b = tid >> 6; float s = 0.f;
#pragma unroll
                for (int g = 0; g < 8; ++g) s += red[(g * 4 + b) * 64 + cc];
                mod[((size_t)l * 4 + b) * 6144 + c0 + cc] = s + p->in[3][(size_t)l * 6144 + c0 + cc]; }
            __syncthreads();
        }
        __syncthreads();
    }
    convert_weights(p, 0, lds, wv);
}

DI void norm_mod_phase(const float* x, const float* g, const float* sh, const float* sc, bf16_t* H, int wv) {
    const int tid_ = otid(wv); const int wave = tid_ >> 6, lane = tid_ & 63;
    for (int row0 = (blockIdx.x * 8 + wave) * 2; row0 < MTOK; row0 += gridDim.x * 16) {
        f32x4 v[2][4]; float s[2] = {0.f, 0.f};
#pragma unroll
        for (int q = 0; q < 2; ++q) { const f32x4* xr = (const f32x4*)(x + (size_t)(row0 + q) * DM) + lane;
#pragma unroll
            for (int j = 0; j < 4; ++j) v[q][j] = xr[64 * j]; }
#pragma unroll
        for (int q = 0; q < 2; ++q)
#pragma unroll
            for (int j = 0; j < 4; ++j) s[q] += (v[q][j][0] * v[q][j][0] + v[q][j][1] * v[q][j][1]) + (v[q][j][2] * v[q][j][2] + v[q][j][3] * v[q][j][3]);
        const float rs0 = rsqrtf(wave_sum(s[0]) * (1.0f / DM) + 1e-6f), rs1 = rsqrtf(wave_sum(s[1]) * (1.0f / DM) + 1e-6f);
        const int b = row0 >> 12;
#pragma unroll
        for (int j = 0; j < 4; ++j) {
            const int c = 4 * lane + 256 * j;
            const f32x4 gg = *(const f32x4*)(g + c), s1 = *(const f32x4*)(sc + (size_t)b * 6144 + c), s0 = *(const f32x4*)(sh + (size_t)b * 6144 + c);
#pragma unroll
            for (int q = 0; q < 2; ++q) {
                const f32x4 h = (v[q][j] * (q ? rs1 : rs0) * gg) * (s1 + 1.0f) + s0;
                u32x2 w; w.x = cvt_pk_bf16(h[0], h[1]); w.y = cvt_pk_bf16(h[2], h[3]);
                *((u32x2*)(H + (size_t)(row0 + q) * DM) + lane + 64 * j) = w;
            }
        }
    }
}
DI void final_norm_phase(float* x, const float* g, int wv) {
    const int tid_ = otid(wv); const int wave = tid_ >> 6, lane = tid_ & 63;
    for (int row = blockIdx.x * 8 + wave; row < MTOK; row += gridDim.x * 8) {
        f32x4* xr = (f32x4*)(x + (size_t)row * DM) + lane;
        f32x4 v[4]; float s = 0.f;
#pragma unroll
        for (int j = 0; j < 4; ++j) { v[j] = xr[64 * j]; s += (v[j][0] * v[j][0] + v[j][1] * v[j][1]) + (v[j][2] * v[j][2] + v[j][3] * v[j][3]); }
        const float rs = rsqrtf(wave_sum(s) * (1.0f / DM) + 1e-6f);
#pragma unroll
        for (int j = 0; j < 4; ++j) { const f32x4 gg = *(const f32x4*)(g + 4 * lane + 256 * j); xr[64 * j] = v[j] * rs * gg; }
    }
}

DI bf16x8 lerp_frag(const bf16_t* cur, const bf16_t* prv, bool hasprev, const float* mu, int act) {
    const u32x4 c = *(const u32x4*)cur; u32x4 q = {0u, 0u, 0u, 0u}; if (hasprev) q = *(const u32x4*)prv;
    const f32x4 m0 = *(const f32x4*)mu, m1 = *(const f32x4*)(mu + 4);
    float z[8];
    const unsigned cw[4] = {c.x, c.y, c.z, c.w}, qw[4] = {q.x, q.y, q.z, q.w};
#pragma unroll
    for (int j = 0; j < 4; ++j) {
        const float c0 = bf_lo(cw[j]), c1 = bf_hi(cw[j]), p0 = bf_lo(qw[j]), p1 = bf_hi(qw[j]);
        const float mA = (j < 2) ? m0[2 * j] : m1[2 * j - 4], mB = (j < 2) ? m0[2 * j + 1] : m1[2 * j - 3];
        z[2 * j] = c0 + (p0 - c0) * mA; z[2 * j + 1] = c1 + (p1 - c1) * mB;
    }
#pragma unroll
    for (int j = 0; j < 8; ++j) {
        if (act == 1) { const float e = __expf(2.0f * z[j]); z[j] = 1.0f - 2.0f / (1.0f + e); }
        else if (act == 2) z[j] = sigmoidf_(z[j]);
    }
    return pack8(z[0], z[1], z[2], z[3], z[4], z[5], z[6], z[7]);
}

DI void rwkv_derived_phase(KP p0, int l, LAS unsigned char* lds, int wv) {
    const int tid_ = otid(wv); const int wave = tid_ >> 6, lane = tid_ & 63, r = lane & 31, hh = lane >> 5;
    LAS float* lp = (LAS float*)(lds + wave * 2048);
    {
        const int ch = wave * 64 + lane;
        lp[0 * 64 + lane] = p0->in[6][(size_t)l * RAWC + ch]; lp[1 * 64 + lane] = p0->in[6][(size_t)l * RAWC + 512 + ch]; lp[2 * 64 + lane] = p0->in[6][(size_t)l * RAWC + 1024 + ch];
        lp[3 * 64 + lane] = p0->in[7][l * 512 + ch]; lp[4 * 64 + lane] = p0->in[9][l * 512 + ch]; lp[5 * 64 + lane] = p0->in[12][l * 512 + ch];
        lp[6 * 64 + lane] = p0->in[13][l * 512 + ch]; lp[7 * 64 + lane] = p0->in[14][l * 512 + ch];
        LDS_WAIT();
    }
    for (int job = blockIdx.x * 8 + wave; job < 512 * 8; job += gridDim.x * 8) {
        KP p = okp(); unsigned char* ws = ows(p->ws);
        const bf16_t* RAW = (const bf16_t*)(ws + WS_RAW);
        bf16_t *RZ = (bf16_t*)(ws + WS_RZ), *KP = (bf16_t*)(ws + WS_KP), *VZ = (bf16_t*)(ws + WS_VZ), *KKN = (bf16_t*)(ws + WS_KKN), *Bv = (bf16_t*)(ws + WS_B), *G = (bf16_t*)(ws + WS_G);
        float* W = (float*)(ws + WS_W);
        const bf16_t *LWU = (const bf16_t*)(ws + WS_LWU), *LAU = (const bf16_t*)(ws + WS_LAU), *LGU = (const bf16_t*)(ws + WS_LGU);
        const float* mu = p->in[6] + (size_t)l * RAWC; const float* w0 = p->in[7] + l * 512; const float* a0 = p->in[9] + l * 512;
        const float* k_k = p->in[12] + l * 512; const float* k_a = p->in[13] + l * 512; const float* r_k = p->in[14] + l * 512;
        const int hd = job & 7, tg = job >> 3, t = tg * 32 + r;
        const bool hp = (t & (SEQ - 1)) != 0;
        const bf16_t* cur = RAW + (size_t)t * RAWC; const bf16_t* prv = cur - RAWC;
        float ss = 0.f;
#pragma unroll
        for (int q = 0; q < 8; ++q) {
            const int c = hd * 64 + 8 * q + 4 * hh;
            const u32x2 kc = *(const u32x2*)(cur + 512 + c); u32x2 kq = {0u, 0u}; if (hp) kq = *(const u32x2*)(prv + 512 + c);
            const f32x4 mk = *(const LAS f32x4*)(lp + 1 * 64 + 8 * q + 4 * hh), kkw = *(const LAS f32x4*)(lp + 5 * 64 + 8 * q + 4 * hh);
            const float kcur[4] = {bf_lo(kc.x), bf_hi(kc.x), bf_lo(kc.y), bf_hi(kc.y)}, kprv[4] = {bf_lo(kq.x), bf_hi(kq.x), bf_lo(kq.y), bf_hi(kq.y)};
#pragma unroll
            for (int j = 0; j < 4; ++j) { const float kk = (kcur[j] + (kprv[j] - kcur[j]) * mk[j]) * kkw[j]; ss += kk * kk; }
        }
        ss += __shfl_xor(ss, 32);
        const float inv = 1.0f / fmaxf(sqrtf(ss), 1e-12f);
        float bonus = 0.f;
        {
            bf16x8 bw[4], ba[4];
#pragma unroll
            for (int s = 0; s < 4; ++s) { const int o = 16 * s + 8 * hh; bw[s] = lerp_frag(cur + 1536 + o, prv + 1536 + o, hp, mu + 1536 + o, 1); ba[s] = lerp_frag(cur + 1600 + o, prv + 1600 + o, hp, mu + 1600 + o, 0); }
#pragma unroll 1
            for (int mt = 0; mt < 2; ++mt) {
                const int chr = hd * 64 + 32 * mt + r;
                f32x16 aw, aa;
#pragma unroll
                for (int i = 0; i < 16; ++i) { aw[i] = 0.f; aa[i] = 0.f; }
                {
                    typedef const __attribute__((address_space(1))) bf16x8* GP8;
                    const GP8 pw = (GP8)(LWU + (size_t)chr * 64 + 8 * hh), pa = (GP8)(LAU + (size_t)chr * 64 + 8 * hh);
                    bf16x8 fw[4], fa[4];
#pragma unroll
                    for (int s = 0; s < 4; ++s) { fw[s] = pw[2 * s]; fa[s] = pa[2 * s]; }
                    asm volatile("" ::: "memory");
#pragma unroll
                    for (int s = 0; s < 4; ++s) { aw = MFMA32(fw[s], bw[s], aw); aa = MFMA32(fa[s], ba[s], aa); }
                }
                u32x2 rcA[4], kcA[4], vcA[4], rpA[4], kqA[4], vpA[4];
#pragma unroll
                for (int i4 = 0; i4 < 4; ++i4) {
                    const int c = hd * 64 + 32 * mt + 8 * i4 + 4 * hh;
                    rcA[i4] = *(const u32x2*)(cur + c); kcA[i4] = *(const u32x2*)(cur + 512 + c); vcA[i4] = *(const u32x2*)(cur + 1024 + c);
                    rpA[i4] = (u32x2){0u, 0u}; kqA[i4] = (u32x2){0u, 0u}; vpA[i4] = (u32x2){0u, 0u};
                    if (hp) { rpA[i4] = *(const u32x2*)(prv + c); kqA[i4] = *(const u32x2*)(prv + 512 + c); vpA[i4] = *(const u32x2*)(prv + 1024 + c); }
                }
                asm volatile("" ::: "memory");
#pragma unroll
                for (int i4 = 0; i4 < 4; ++i4) {
                    const int c = hd * 64 + 32 * mt + 8 * i4 + 4 * hh;
                    const u32x2 rc = rcA[i4], kc = kcA[i4], vc = vcA[i4], rp = rpA[i4], kq = kqA[i4], vp = vpA[i4];
                    const int cl = 32 * mt + 8 * i4 + 4 * hh;
                    const f32x4 mr = *(const LAS f32x4*)(lp + cl), mk = *(const LAS f32x4*)(lp + 64 + cl), mv = *(const LAS f32x4*)(lp + 128 + cl);
                    const f32x4 w0v = *(const LAS f32x4*)(lp + 192 + cl), a0v = *(const LAS f32x4*)(lp + 256 + cl), kkw = *(const LAS f32x4*)(lp + 320 + cl), kaw = *(const LAS f32x4*)(lp + 384 + cl), rkw = *(const LAS f32x4*)(lp + 448 + cl);
                    const float rcur[4] = {bf_lo(rc.x), bf_hi(rc.x), bf_lo(rc.y), bf_hi(rc.y)}, rprv[4] = {bf_lo(rp.x), bf_hi(rp.x), bf_lo(rp.y), bf_hi(rp.y)};
                    const float kcur[4] = {bf_lo(kc.x), bf_hi(kc.x), bf_lo(kc.y), bf_hi(kc.y)}, kprv[4] = {bf_lo(kq.x), bf_hi(kq.x), bf_lo(kq.y), bf_hi(kq.y)};
                    const float vcur[4] = {bf_lo(vc.x), bf_hi(vc.x), bf_lo(vc.y), bf_hi(vc.y)}, vprv[4] = {bf_lo(vp.x), bf_hi(vp.x), bf_lo(vp.y), bf_hi(vp.y)};
                    f32x4 dec; float rz[4], kp[4], vz[4], kn[4], bb[4];
#pragma unroll
                    for (int j = 0; j < 4; ++j) {
                        const int i = 4 * i4 + j;
                        const float zz = -(w0v[j] + aw[i]);
                        const float sp = (zz > 20.f) ? zz : __logf(1.0f + __expf(zz));
                        const float wv = -sp - 0.5f;
                        dec[j] = __expf(-__expf(wv));
                        const float av = sigmoidf_(a0v[j] + aa[i]);
                        rz[j] = rcur[j] + (rprv[j] - rcur[j]) * mr[j];
                        const float kz = kcur[j] + (kprv[j] - kcur[j]) * mk[j];
                        vz[j] = vcur[j] + (vprv[j] - vcur[j]) * mv[j];
                        kn[j] = kz * kkw[j] * inv; bb[j] = kn[j] * av;
                        kp[j] = kz * (1.0f + (av - 1.0f) * kaw[j]);
                        bonus += rz[j] * kp[j] * rkw[j];
                    }
                    const size_t o = (size_t)t * 512 + c;
                    *(f32x4*)(W + o) = dec;
                    u32x2 w2; w2.x = cvt_pk_bf16(rz[0], rz[1]); w2.y = cvt_pk_bf16(rz[2], rz[3]); *(u32x2*)(RZ + o) = w2;
                    w2.x = cvt_pk_bf16(kp[0], kp[1]); w2.y = cvt_pk_bf16(kp[2], kp[3]); *(u32x2*)(KP + o) = w2;
                    w2.x = cvt_pk_bf16(vz[0], vz[1]); w2.y = cvt_pk_bf16(vz[2], vz[3]); *(u32x2*)(VZ + o) = w2;
                    w2.x = cvt_pk_bf16(kn[0], kn[1]); w2.y = cvt_pk_bf16(kn[2], kn[3]); *(u32x2*)(KKN + o) = w2;
                    w2.x = cvt_pk_bf16(bb[0], bb[1]); w2.y = cvt_pk_bf16(bb[2], bb[3]); *(u32x2*)(Bv + o) = w2;
                }
            }
        }
        bonus += __shfl_xor(bonus, 32);
        int t2 = t; asm volatile("" : "+v"(t2));
        if (hh == 0) ((float*)(ows(ws) + WS_BONUS))[(size_t)t2 * 8 + hd] = bonus;
        {
            bf16x8 bg[8];
#pragma unroll
            for (int s = 0; s < 8; ++s) { const int o = 16 * s + 8 * hh; bg[s] = lerp_frag(cur + 1664 + o, prv + 1664 + o, hp, mu + 1664 + o, 2); }
#pragma unroll 1
            for (int mt = 0; mt < 2; ++mt) {
                const int chr = hd * 64 + 32 * mt + r;
                f32x16 ag;
#pragma unroll
                for (int i = 0; i < 16; ++i) ag[i] = 0.f;
                {
                    typedef const __attribute__((address_space(1))) bf16x8* GP8;
                    const GP8 pg = (GP8)(LGU + (size_t)chr * 128 + 8 * hh);
                    bf16x8 fg[8];
#pragma unroll
                    for (int s = 0; s < 8; ++s) fg[s] = pg[2 * s];
                    asm volatile("" ::: "memory");
#pragma unroll
                    for (int s = 0; s < 8; ++s) ag = MFMA32(fg[s], bg[s], ag);
                }
#pragma unroll
                for (int i4 = 0; i4 < 4; ++i4) {
                    const size_t o = (size_t)t2 * 512 + hd * 64 + 32 * mt + 8 * i4 + 4 * hh;
                    u32x2 w2; w2.x = cvt_pk_bf16(ag[4 * i4], ag[4 * i4 + 1]); w2.y = cvt_pk_bf16(ag[4 * i4 + 2], ag[4 * i4 + 3]); *(u32x2*)(G + o) = w2;
                }
            }
        }
    }
}

constexpr int SC_T = 32, SC_STEP = 1344, SC_BUF = SC_T * SC_STEP;
struct ScanRegs { f32x4 w0, w1; u32x4 kn, bb, kp, rz, vv; };
DI void scan_gload(KP p, ScanRegs& R, int b, int h, int rg, int ck, int pt) {
    const unsigned char* ws = ows(p->ws);
    const size_t tok0 = (size_t)b * SEQ + (size_t)ck * SC_T;
    { const int st = pt >> 4, sub = pt & 15; R.w0 = *(const f32x4*)((const float*)(ws + WS_W) + (tok0 + st) * 512 + h * 64 + 4 * sub); }
    { const int pp = pt + 256, st = pp >> 4, sub = pp & 15; R.w1 = *(const f32x4*)((const float*)(ws + WS_W) + (tok0 + st) * 512 + h * 64 + 4 * sub); }
    const int st = pt >> 3, sub = pt & 7; const size_t go = (tok0 + st) * 512 + h * 64 + 8 * sub;
    R.kn = *(const u32x4*)((const bf16_t*)(ws + WS_KKN) + go); R.bb = *(const u32x4*)((const bf16_t*)(ws + WS_B) + go);
    R.kp = *(const u32x4*)((const bf16_t*)(ws + WS_KP) + go); R.rz = *(const u32x4*)((const bf16_t*)(ws + WS_RZ) + go);
    R.vv = (u32x4){0u, 0u, 0u, 0u};
    if (pt < 64) { const int s2 = pt >> 1, hf = pt & 1; R.vv = *(const u32x4*)((const bf16_t*)(ws + WS_VZ) + (tok0 + s2) * 512 + h * 64 + rg * 16 + 8 * hf); }
}
DI void scan_write(const ScanRegs& R, LAS unsigned char* buf, int pt) {
    { const int st = pt >> 4, sub = pt & 15; *(LAS f32x4*)(buf + st * SC_STEP + sub * 16) = R.w0; }
    { const int pp = pt + 256, st = pp >> 4, sub = pp & 15; *(LAS f32x4*)(buf + st * SC_STEP + sub * 16) = R.w1; }
    const int st = pt >> 3, sub = pt & 7;
    const u32x4 kn = R.kn, bb = R.bb, kp = R.kp, rz = R.rz;
    LAS unsigned char* d = buf + st * SC_STEP + sub * 32;
    *(LAS f32x4*)(d + 256) = (f32x4){-bf_lo(kn.x), -bf_hi(kn.x), -bf_lo(kn.y), -bf_hi(kn.y)}; *(LAS f32x4*)(d + 256 + 16) = (f32x4){-bf_lo(kn.z), -bf_hi(kn.z), -bf_lo(kn.w), -bf_hi(kn.w)};
    *(LAS f32x4*)(d + 512) = (f32x4){bf_lo(bb.x), bf_hi(bb.x), bf_lo(bb.y), bf_hi(bb.y)}; *(LAS f32x4*)(d + 512 + 16) = (f32x4){bf_lo(bb.z), bf_hi(bb.z), bf_lo(bb.w), bf_hi(bb.w)};
    *(LAS f32x4*)(d + 768) = (f32x4){bf_lo(kp.x), bf_hi(kp.x), bf_lo(kp.y), bf_hi(kp.y)}; *(LAS f32x4*)(d + 768 + 16) = (f32x4){bf_lo(kp.z), bf_hi(kp.z), bf_lo(kp.w), bf_hi(kp.w)};
    *(LAS f32x4*)(d + 1024) = (f32x4){bf_lo(rz.x), bf_hi(rz.x), bf_lo(rz.y), bf_hi(rz.y)}; *(LAS f32x4*)(d + 1024 + 16) = (f32x4){bf_lo(rz.z), bf_hi(rz.z), bf_lo(rz.w), bf_hi(rz.w)};
    if (pt < 64) { const int s2 = pt >> 1, hf = pt & 1; const u32x4 vv = R.vv;
        LAS unsigned char* dv = buf + s2 * SC_STEP + 1280 + hf * 32;
        *(LAS f32x4*)dv = (f32x4){bf_lo(vv.x), bf_hi(vv.x), bf_lo(vv.y), bf_hi(vv.y)}; *(LAS f32x4*)(dv + 16) = (f32x4){bf_lo(vv.z), bf_hi(vv.z), bf_lo(vv.w), bf_hi(vv.w)}; }
}
DI void rwkv_scan_phase(KP p, LAS unsigned char* lds, int wv) {
    const int tid = otid(wv), wave = tid >> 6, lane = tid & 63;
    float* YRAW = (float*)(p->ws + WS_YRAW);
    for (int job = blockIdx.x; job < 128; job += gridDim.x) {
        const int jx = job & 7, jk = job >> 3;
        const int chain = jx + 8 * (jk >> 2), rg = jk & 3, b = chain >> 3, h = chain & 7;
        __syncthreads();
        ScanRegs R0, R1;
        if (wave >= 4) { scan_gload(p, R0, b, h, rg, 0, tid - 256); scan_write(R0, lds, tid - 256); scan_gload(p, R0, b, h, rg, 1, tid - 256); scan_gload(p, R1, b, h, rg, 2, tid - 256); }
        __syncthreads();
        f32x4 S = {0.f, 0.f, 0.f, 0.f};
        const int jl = lane & 15, rl = 4 * (wave & 3) + (lane >> 4);
        for (int ck2 = 0; ck2 < SEQ / SC_T; ck2 += 2) {
#pragma unroll
            for (int half = 0; half < 2; ++half) {
                const int ck = ck2 + half;
                LAS unsigned char* cb = lds + (ck & 1) * SC_BUF;
                if (wave >= 4) {
                    if (ck + 1 < SEQ / SC_T) {
                        if (half == 0) { scan_write(R0, lds + ((ck + 1) & 1) * SC_BUF, tid - 256); if (ck + 3 < SEQ / SC_T) scan_gload(p, R0, b, h, rg, ck + 3, tid - 256); }
                        else           { scan_write(R1, lds + ((ck + 1) & 1) * SC_BUF, tid - 256); if (ck + 3 < SEQ / SC_T) scan_gload(p, R1, b, h, rg, ck + 3, tid - 256); }
                    }
                } else {
                    float* yo = YRAW + ((size_t)b * SEQ + (size_t)ck * SC_T + jl) * 512 + h * 64 + rg * 16 + rl;
                    const LAS unsigned char* sb = cb + jl * 16; const LAS unsigned char* vb = cb + 1280 + rl * 4;
                    f32x4 w4 = *(const LAS f32x4*)sb, an = *(const LAS f32x4*)(sb + 256), b4 = *(const LAS f32x4*)(sb + 512), k4 = *(const LAS f32x4*)(sb + 768), r4 = *(const LAS f32x4*)(sb + 1024);
                    float vi = *(const LAS float*)vb;
                    float ysel = 0.f;
#pragma unroll
                    for (int s = 0; s < SC_T; ++s) {
                        f32x4 w4n = w4, ann = an, b4n = b4, k4n = k4, r4n = r4; float vin = vi;
                        if (s + 1 < SC_T) {
                            const LAS unsigned char* sn = sb + (s + 1) * SC_STEP;
                            w4n = *(const LAS f32x4*)sn; ann = *(const LAS f32x4*)(sn + 256); b4n = *(const LAS f32x4*)(sn + 512); k4n = *(const LAS f32x4*)(sn + 768); r4n = *(const LAS f32x4*)(sn + 1024);
                            vin = *(const LAS float*)(vb + (s + 1) * SC_STEP);
                        }
                        float sa = (S[0] * an[0] + S[1] * an[1]) + (S[2] * an[2] + S[3] * an[3]);
                        sa = row16_sum(sa);
                        S = S * w4 + (b4 * sa + k4 * vi);
                        float y = (S[0] * r4[0] + S[1] * r4[1]) + (S[2] * r4[2] + S[3] * r4[3]);
                        y = row16_sum(y);
                        ysel = (jl == (s & 15)) ? y : ysel;
                        if ((s & 15) == 15) yo[(size_t)(s - 15) * 512] = ysel;
                        w4 = w4n; an = ann; b4 = b4n; k4 = k4n; r4 = r4n; vi = vin;
                    }
                }
                __syncthreads();
            }
        }
    }
}

DI void rwkv_post_phase(KP p, int l, int wv) {
    const unsigned char* ws = ows(p->ws);
    const float* YRAW = (const float*)(ws + WS_YRAW); const bf16_t* VZ = (const bf16_t*)(ws + WS_VZ); const bf16_t* G = (const bf16_t*)(ws + WS_G);
    const float* BONUS = (const float*)(ws + WS_BONUS); bf16_t* YS = (bf16_t*)(p->ws + WS_YSR);
    const float* gnw = p->in[15] + l * 512; const float* gnb = p->in[16] + l * 512;
    const int tid_ = otid(wv); const int wave = tid_ >> 6, lane = tid_ & 63, c = 8 * lane;
    const f32x4 gw0 = *(const f32x4*)(gnw + c), gw1 = *(const f32x4*)(gnw + c + 4), gb0 = *(const f32x4*)(gnb + c), gb1 = *(const f32x4*)(gnb + c + 4);
    for (int t = blockIdx.x * 8 + wave; t < MTOK; t += gridDim.x * 8) {
        const size_t o = (size_t)t * 512 + c;
        const f32x4 y0 = *(const f32x4*)(YRAW + o), y1 = *(const f32x4*)(YRAW + o + 4);
        float s = (y0[0] + y0[1]) + (y0[2] + y0[3]) + (y1[0] + y1[1]) + (y1[2] + y1[3]);
        s += __shfl_xor(s, 1); s += __shfl_xor(s, 2); s += __shfl_xor(s, 4);
        const float mean = s * (1.0f / 64.0f);
        const f32x4 d0 = y0 - mean, d1 = y1 - mean;
        float q = (d0[0] * d0[0] + d0[1] * d0[1]) + (d0[2] * d0[2] + d0[3] * d0[3]) + (d1[0] * d1[0] + d1[1] * d1[1]) + (d1[2] * d1[2] + d1[3] * d1[3]);
        q += __shfl_xor(q, 1); q += __shfl_xor(q, 2); q += __shfl_xor(q, 4);
        const float rstd = rsqrtf(q * (1.0f / 64.0f) + 64e-5f);
        const float bon = BONUS[(size_t)t * 8 + (lane >> 3)];
        const u32x4 vv = *(const u32x4*)(VZ + o), gg = *(const u32x4*)(G + o);
        const f32x4 v0 = {bf_lo(vv.x), bf_hi(vv.x), bf_lo(vv.y), bf_hi(vv.y)}, v1 = {bf_lo(vv.z), bf_hi(vv.z), bf_lo(vv.w), bf_hi(vv.w)};
        const f32x4 g0 = {bf_lo(gg.x), bf_hi(gg.x), bf_lo(gg.y), bf_hi(gg.y)}, g1 = {bf_lo(gg.z), bf_hi(gg.z), bf_lo(gg.w), bf_hi(gg.w)};
        const f32x4 r0 = (d0 * rstd * gw0 + gb0 + v0 * bon) * g0, r1 = (d1 * rstd * gw1 + gb1 + v1 * bon) * g1;
        u32x4 w; w.x = cvt_pk_bf16(r0[0], r0[1]); w.y = cvt_pk_bf16(r0[2], r0[3]); w.z = cvt_pk_bf16(r1[0], r1[1]); w.w = cvt_pk_bf16(r1[2], r1[3]);
        *(u32x4*)(YS + o) = w;
    }
}

DI void attn_job(const bf16_t* Q, const bf16_t* K, const bf16_t* V, bf16_t* YS, float* LSE, LAS unsigned char* vl, int b, int h, int d, int rho, int J0, bool first, int lane) {
    asm volatile("" : "+v"(lane));
    const int r = lane & 31, hh = lane >> 5;
    const size_t tokq = (size_t)b * SEQ + (size_t)(J0 + r) * d + rho;
    typedef const __attribute__((address_space(1))) bf16x8* GP8;
    typedef const __attribute__((address_space(1))) u32x4* GP4;
    bf16x8 bq[4];
    { const GP8 qp = (GP8)(Q + tokq * 512 + h * 64 + 8 * hh);
#pragma unroll
      for (int s = 0; s < 4; ++s) bq[s] = qp[2 * s]; }
    bf16x8 ak[5][4];
#pragma unroll
    for (int kt = 0; kt < 5; ++kt) {
        const int Jk = J0 - 128 + 32 * kt + r;
        const size_t tokk = (size_t)b * SEQ + (size_t)(Jk >= 0 ? Jk : 0) * d + rho;
        const GP8 kp = (GP8)(K + tokk * 512 + h * 64 + 8 * hh);
#pragma unroll
        for (int s = 0; s < 4; ++s) ak[kt][s] = kp[2 * s];
    }
    asm volatile("" ::: "memory");
    f32x16 sc[5];
#pragma unroll
    for (int kt = 0; kt < 5; ++kt) {
        const bool valid = (J0 - 128 + 32 * kt + r) >= 0;
        f32x16 a;
#pragma unroll
        for (int i = 0; i < 16; ++i) a[i] = 0.f;
#pragma unroll
        for (int s = 0; s < 4; ++s) {
            bf16x8 kf = ak[kt][s];
            if (!valid) kf = (bf16x8){0, 0, 0, 0, 0, 0, 0, 0};
            a = MFMA32(kf, bq[s], a);
        }
        sc[kt] = a;
    }
    float m = -1e30f;
#pragma unroll
    for (int kt = 0; kt < 5; ++kt)
#pragma unroll
        for (int i = 0; i < 16; ++i) {
            const int kidx = 32 * kt + crow(i, hh); const int dist = 128 + r - kidx;
            const bool ok = (dist >= 0) && (dist <= 128) && (J0 - 128 + kidx >= 0);
            const float v = ok ? sc[kt][i] * 0.125f : -1e30f;
            sc[kt][i] = v; m = fmaxf(m, v);
        }
    m = fmaxf(m, __shfl_xor(m, 32));
    float lsum = 0.f;
#pragma unroll
    for (int kt = 0; kt < 5; ++kt)
#pragma unroll
        for (int i = 0; i < 16; ++i) { const float pv = __expf(sc[kt][i] - m); sc[kt][i] = pv; lsum += pv; }
    lsum += __shfl_xor(lsum, 32);
    const float lse = m + __logf(lsum);
    f32x16 o[2];
#pragma unroll
    for (int i = 0; i < 16; ++i) { o[0][i] = 0.f; o[1][i] = 0.f; }
    u32x4 vr[4];
    {
        const int key = lane >> 1, hf = lane & 1; const int Jk = J0 - 128 + key;
        const size_t tokv = (size_t)b * SEQ + (size_t)(Jk >= 0 ? Jk : 0) * d + rho;
        const GP4 src = (GP4)(V + tokv * 512 + h * 64 + 32 * hf);
        vr[0] = src[0]; vr[1] = src[1]; vr[2] = src[2]; vr[3] = src[3];
    }
#pragma unroll
    for (int kt = 0; kt < 5; ++kt) {
        {
            const int key = lane >> 1, hf = lane & 1;
            LAS u32x4* dst = (LAS u32x4*)(vl + key * 128 + hf * 64);
            dst[0] = vr[0]; dst[1] = vr[1]; dst[2] = vr[2]; dst[3] = vr[3];
            if (kt + 1 < 5) {
                const int Jk = J0 - 128 + 32 * (kt + 1) + key;
                const size_t tokv = (size_t)b * SEQ + (size_t)(Jk >= 0 ? Jk : 0) * d + rho;
                const GP4 src = (GP4)(V + tokv * 512 + h * 64 + 32 * hf);
                vr[0] = src[0]; vr[1] = src[1]; vr[2] = src[2]; vr[3] = src[3];
            }
        }
        LDS_WAIT();
#pragma unroll
        for (int s = 0; s < 2; ++s) {
            const bf16x8 xs = pack8(sc[kt][8 * s], sc[kt][8 * s + 1], sc[kt][8 * s + 2], sc[kt][8 * s + 3], sc[kt][8 * s + 4], sc[kt][8 * s + 5], sc[kt][8 * s + 6], sc[kt][8 * s + 7]);
#pragma unroll
            for (int mt = 0; mt < 2; ++mt) {
                bf16x8 pa;
#pragma unroll
                for (int j = 0; j < 8; ++j) { const int key = 16 * s + 8 * (j >> 2) + 4 * hh + (j & 3); pa[j] = (short)*(const LAS bf16_t*)(vl + key * 128 + (r + 32 * mt) * 2); }
                o[mt] = MFMA32(pa, xs, o[mt]);
            }
        }
        LDS_WAIT();
    }
    const float il = 1.0f / lsum;
    float wp = 0.f, wc = 1.0f, nl = lse;
    if (!first) { const float lp = LSE[tokq * 8 + h]; const float mx = fmaxf(lp, lse); const float ep = __expf(lp - mx), ec = __expf(lse - mx); nl = mx + __logf(ep + ec); wp = ep / (ep + ec); wc = ec / (ep + ec); }
#pragma unroll
    for (int mt = 0; mt < 2; ++mt)
#pragma unroll
        for (int g4 = 0; g4 < 4; ++g4) {
            bf16_t* dst = YS + tokq * 512 + h * 64 + 32 * mt + 8 * g4 + 4 * hh;
            float v[4];
#pragma unroll
            for (int j = 0; j < 4; ++j) v[j] = o[mt][4 * g4 + j] * il * wc;
            if (!first) { const u32x2 pw = *(const u32x2*)dst; v[0] += bf_lo(pw.x) * wp; v[1] += bf_hi(pw.x) * wp; v[2] += bf_lo(pw.y) * wp; v[3] += bf_hi(pw.y) * wp; }
            u32x2 w2; w2.x = cvt_pk_bf16(v[0], v[1]); w2.y = cvt_pk_bf16(v[2], v[3]); *(u32x2*)dst = w2;
        }
    if (hh == 0) LSE[tokq * 8 + h] = nl;
}

DI void attention_phase(KP p, LAS unsigned char* lds, int wv) {
    unsigned char* ws = ows(p->ws);
    const bf16_t *Q = (const bf16_t*)(ws + WS_Q), *K = (const bf16_t*)(ws + WS_K), *V = (const bf16_t*)(ws + WS_V);
    bf16_t* YS = (bf16_t*)(ws + WS_YSA); float* LSE = (float*)(ws + WS_LSE);
    const int tid_ = otid(wv); const int wave = tid_ >> 6, lane = tid_ & 63;
    LAS unsigned char* vl = lds + wave * 4096;
    for (int item0 = blockIdx.x; item0 < 256; item0 += gridDim.x) {
        const int item = (((item0 & 7) * 4 + (item0 >> 6)) << 3) | ((item0 >> 3) & 7);
        const int b = item >> 6, h = (item >> 3) & 7, qb = item & 7, P0 = qb * 512;
#pragma unroll 1
        for (int cfg = 0; cfg < 3; ++cfg) {
#pragma unroll 1
            for (int jj = wave; jj < 16; jj += 8) {
                int d, rho, J0;
                if (cfg == 0) { d = 1; rho = 0; J0 = P0 + 32 * jj; }
                else if (cfg == 1) { d = 4; rho = jj & 3; J0 = (P0 >> 2) + 32 * (jj >> 2); }
                else { d = 16; rho = jj; J0 = P0 >> 4; }
                attn_job(Q, K, V, YS, LSE, vl, b, h, d, rho, J0, cfg == 0, lane);
            }
            asm volatile("s_waitcnt vmcnt(0)" ::: "memory");
            __syncthreads();
        }
    }
}

DI void gmlp_phase(KP p, int l, LAS unsigned char* lds, int wv) {
    unsigned char* ws = ows(p->ws);
    const bf16_t* UV = (const bf16_t*)(ws + WS_UV); bf16_t* YS = (bf16_t*)(ws + WS_YSG);
    const float* lng = p->in[17] + l * 512; const float* lnb = p->in[18] + l * 512;
    const float* wsp = p->in[19] + (size_t)l * 8 * 128 * 128; const float* bsp = p->in[20] + (size_t)l * 8 * 128;
    const int tid_ = otid(wv); const int wave = tid_ >> 6, lane = tid_ & 63, r = lane & 31, hh = lane >> 5;
    LAS float* stats = (LAS float*)(lds + 8 * 17408);
    LAS bf16_t* VT = (LAS bf16_t*)(lds + wave * 17408);
    for (int item0 = blockIdx.x; item0 < 256; item0 += gridDim.x) {
        const int item = ((((item0 & 7) << 4) | (item0 >> 4)) << 1) | ((item0 >> 3) & 1);
        const size_t tok0 = (size_t)(item >> 1) * 128;
        __syncthreads();
        for (int tt = 0; tt < 16; ++tt) {
            const int tl = wave * 16 + tt;
            const u32x4 x = *(const u32x4*)(UV + (tok0 + tl) * 1024 + 512 + 8 * lane);
            const float f[8] = {bf_lo(x.x), bf_hi(x.x), bf_lo(x.y), bf_hi(x.y), bf_lo(x.z), bf_hi(x.z), bf_lo(x.w), bf_hi(x.w)};
            float s = 0.f;
#pragma unroll
            for (int j = 0; j < 8; ++j) s += f[j];
            const float mean = wave_sum(s) * (1.0f / 512.0f); float q = 0.f;
#pragma unroll
            for (int j = 0; j < 8; ++j) { const float dd = f[j] - mean; q += dd * dd; }
            const float rstd = rsqrtf(wave_sum(q) * (1.0f / 512.0f) + 1e-5f);
            if (lane == 0) { stats[2 * tl] = mean; stats[2 * tl + 1] = rstd; }
        }
        __syncthreads();
        const int g = (item & 1) * 4 + (wave & 3);
        if (wave < 4) {
        {
            const int d0 = 8 * (lane & 7);
            const f32x4 lg0 = *(const f32x4*)(lng + g * 64 + d0), lg1 = *(const f32x4*)(lng + g * 64 + d0 + 4), lb0 = *(const f32x4*)(lnb + g * 64 + d0), lb1 = *(const f32x4*)(lnb + g * 64 + d0 + 4);
            for (int it = 0; it < 16; ++it) {
                const int tl = it * 8 + (lane >> 3);
                const u32x4 x = *(const u32x4*)(UV + (tok0 + tl) * 1024 + 512 + g * 64 + d0);
                const float mean = stats[2 * tl], rstd = stats[2 * tl + 1];
                const float f[8] = {bf_lo(x.x), bf_hi(x.x), bf_lo(x.y), bf_hi(x.y), bf_lo(x.z), bf_hi(x.z), bf_lo(x.w), bf_hi(x.w)};
#pragma unroll
                for (int e = 0; e < 8; ++e) {
                    const float gg = e < 4 ? lg0[e & 3] : lg1[e & 3], bb = e < 4 ? lb0[e & 3] : lb1[e & 3];
                    const float y = (f[e] - mean) * rstd * gg + bb;
                    VT[(d0 + e) * 136 + tl] = (bf16_t)(cvt_pk_bf16(y, 0.f) & 0xffffu);
                }
            }
        }
        LDS_WAIT();
#pragma unroll 1
        for (int nt = 0; nt < 4; ++nt) {
            f32x16 acc[2];
#pragma unroll
            for (int i = 0; i < 16; ++i) { acc[0][i] = 0.f; acc[1][i] = 0.f; }
            const int irow = 32 * nt + r;
            for (int s = 0; s < 2 * (nt + 1); ++s) {
                const int j0 = 16 * s + 8 * hh;
                const float* wr_ = wsp + ((size_t)g * 128 + irow) * 128 + j0;
                const f32x4 wa = *(const f32x4*)wr_, wb = *(const f32x4*)(wr_ + 4);
                float wv[8] = {wa[0], wa[1], wa[2], wa[3], wb[0], wb[1], wb[2], wb[3]};
#pragma unroll
                for (int j = 0; j < 8; ++j) if (j0 + j > irow) wv[j] = 0.f;
                const bf16x8 bfr = pack8(wv[0], wv[1], wv[2], wv[3], wv[4], wv[5], wv[6], wv[7]);
#pragma unroll
                for (int mt = 0; mt < 2; ++mt) {
                    const bf16x8 afr = *(const LAS bf16x8*)(VT + (32 * mt + r) * 136 + j0);
                    acc[mt] = MFMA32(afr, bfr, acc[mt]);
                }
            }
            const size_t tok = tok0 + irow; const float bs = bsp[g * 128 + irow];
#pragma unroll
            for (int mt = 0; mt < 2; ++mt)
#pragma unroll
                for (int g4 = 0; g4 < 4; ++g4) {
                    const int c = g * 64 + 32 * mt + 8 * g4 + 4 * hh;
                    const u32x2 uu = *(const u32x2*)(UV + tok * 1024 + c);
                    const float o0 = bf_lo(uu.x) * (acc[mt][4 * g4] + bs), o1 = bf_hi(uu.x) * (acc[mt][4 * g4 + 1] + bs), o2 = bf_lo(uu.y) * (acc[mt][4 * g4 + 2] + bs), o3 = bf_hi(uu.y) * (acc[mt][4 * g4 + 3] + bs);
                    u32x2 w2; w2.x = cvt_pk_bf16(o0, o1); w2.y = cvt_pk_bf16(o2, o3); *(u32x2*)(YS + tok * 512 + c) = w2;
                }
        }
        }
    }
}

DI void ffn_fix_phase(KP p, int l, int wv) {
    unsigned char* ws = ows(p->ws);
    bf16_t* ACT = (bf16_t*)(ws + WS_UP); const float* SA = (const float*)(ws + WS_SIDEA); const float* SG = (const float*)(ws + WS_SIDEG);
    const float* cw = p->in[25] + (size_t)l * 3 * DFF; const float* cb = p->in[26] + (size_t)l * DFF;
    constexpr int NCG = DFF / 8;
    const int tid_ = otid(wv);
    for (int item = blockIdx.x * 512 + tid_; item < 256 * 2 * NCG; item += gridDim.x * 512) {
        const int cgi = item % NCG, qe = item / NCG, q = qe >> 1, e = qe & 1, f = 8 * cgi;
        const bool first = (q & 63) == 0;
        float o[8];
#pragma unroll
        for (int hf = 0; hf < 2; ++hf) {
            const int ff = f + 4 * hf;
            const f32x4 at = *(const f32x4*)(SA + ((size_t)q * 4 + e) * DFF + ff);
            f32x4 t1 = {0.f, 0.f, 0.f, 0.f}, t2 = {0.f, 0.f, 0.f, 0.f};
            if (e == 1) t1 = *(const f32x4*)(SA + ((size_t)q * 4 + 0) * DFF + ff);
            else if (!first) t1 = *(const f32x4*)(SA + ((size_t)(q - 1) * 4 + 3) * DFF + ff);
            if (!first) t2 = *(const f32x4*)(SA + ((size_t)(q - 1) * 4 + (e == 1 ? 3 : 2)) * DFF + ff);
            const f32x4 g = *(const f32x4*)(SG + ((size_t)q * 2 + e) * DFF + ff);
            const f32x4 w0 = *(const f32x4*)(cw + ff), w1 = *(const f32x4*)(cw + DFF + ff), w2 = *(const f32x4*)(cw + 2 * DFF + ff), bb = *(const f32x4*)(cb + ff);
            const f32x4 c = bb + w0 * t2 + w1 * t1 + w2 * at;
#pragma unroll
            for (int j = 0; j < 4; ++j) o[4 * hf + j] = gelu_tanh(c[j]) * g[j];
        }
        u32x4 w; w.x = cvt_pk_bf16(o[0], o[1]); w.y = cvt_pk_bf16(o[2], o[3]); w.z = cvt_pk_bf16(o[4], o[5]); w.w = cvt_pk_bf16(o[6], o[7]);
        *(u32x4*)(ACT + (size_t)(64 * q + e) * DFF + f) = w;
    }
}

__global__ void __launch_bounds__(512) fwd_megakernel(Params p_unused) {
    extern __shared__ __attribute__((aligned(16))) unsigned char lds_raw[];
    LAS unsigned char* lds = (LAS unsigned char*)lds_raw;
    cg::grid_group grid = cg::this_grid();
    KP p = okp();
    unsigned char* ws = p->ws;
    const int G = gridDim.x, c = blockIdx.x;
    const int wv = __builtin_amdgcn_readfirstlane((int)(threadIdx.x >> 6));
    pg8::Epi E; pg8::TileOrder S; pg8::Gemm g;

    unsigned* bar = (unsigned*)(ws + WS_BAR);
    volatile LAS unsigned* xst = (volatile LAS unsigned*)(lds + LDS_BYTES - 16);
    const unsigned myx = xb_xcc_id();
    if (otid(wv) == 0) { xb_add(&bar[XB_CNT(myx)], 1u); __builtin_amdgcn_fence(__ATOMIC_RELEASE, "agent"); }
    grid.sync();
    if (otid(wv) == 0) {
        unsigned mine = 0u, cnt = 0u;
#pragma unroll
        for (unsigned j = 0; j < 8; ++j) { const unsigned c = xb_ld(&bar[XB_CNT(j)]); cnt += (c > 0u) ? 1u : 0u; mine = (j == myx) ? c : mine; }
        xst[0] = mine > 0u ? mine : 1u; xst[1] = cnt > 0u ? cnt : 1u; xst[2] = myx;
    }
    __syncthreads();
    phase0(p, lds, wv);
    gbar(bar, xst, wv);
#pragma unroll 1
    for (int st = 0; st < 2 * 12; ++st) {
        const int l = st / 12, step = st % 12;
        p = okp(); ws = ows(p->ws);
        const float* mod = (const float*)(ws + WS_MOD); const bf16_t* H = (const bf16_t*)(ws + WS_H);
        const float* ml = mod + (size_t)l * 4 * 6144;
        const float* xin = (l == 0) ? p->in[0] : p->out;
        bool do_gemm = false;
        E = pg8::Epi{}; g.merge = 0; g.ws = ws;
        if (step == 0) {
            if (l > 0) convert_weights(p, l, lds, wv);
            norm_mod_phase(xin, p->in[4] + l * DM, ml + 0, ml + 1024, (bf16_t*)(ws + WS_H), wv);
        } else if (step == 1 || step == 4) {
            if (step == 4) rwkv_post_phase(p, l, wv);
            E.mode = pg8::EM_INPROJ; E.o0 = (bf16_t*)(ws + WS_Q); E.o1 = (bf16_t*)(ws + WS_K); E.o2 = (bf16_t*)(ws + WS_V); E.o3 = (bf16_t*)(ws + WS_RAW); E.o4 = (bf16_t*)(ws + WS_UV);
            E.ropec = (const float*)(ws + WS_ROPEC); E.ropes = (const float*)(ws + WS_ROPES);
            g.A = H; g.Bt = (const bf16_t*)(ws + WS_WIN); g.lda = 1024; g.K = 1024;
            if (step == 1) S.init(64, 7, G, c, 7, 6, 0); else S.init(64, 10, G, c, 6, 0, 13);
            do_gemm = true;
        } else if (step == 2) { rwkv_derived_phase(p, l, lds, wv); }
        else if (step == 3) { rwkv_scan_phase(p, lds, wv); }
        else if (step == 5) { attention_phase(p, lds, wv); gmlp_phase(p, l, lds, wv); }
        else if (step == 6) {
            E.mode = pg8::EM_MERGE; E.o0 = (bf16_t*)(ws + WS_GATE); E.o1 = (bf16_t*)(ws + WS_MB);
            g.merge = 1; g.A = H; g.Bt = (const bf16_t*)(ws + WS_WIN); g.lda = 1024; g.K = 1024;
            S.init(64, 4, G, c, 4, 0, 0, 6);
            do_gemm = true;
        } else if (step == 7) {
            E.mode = pg8::EM_RESID; E.f0 = p->out; E.f1 = xin; E.f2 = ml + 2048;
            g.A = (const bf16_t*)(ws + WS_MB); g.Bt = (const bf16_t*)(ws + WS_WOUT); g.lda = 1024; g.K = 1024;
            S.init(64, 4, G, c, 4, 0, 0); do_gemm = true;
        } else if (step == 8) { norm_mod_phase(p->out, p->in[23] + l * DM, ml + 3072, ml + 4096, (bf16_t*)(ws + WS_H), wv); }
        else if (step == 9) {
            E.mode = pg8::EM_UP; E.o0 = (bf16_t*)(ws + WS_UP); E.f0 = (float*)(ws + WS_SIDEA); E.f3 = (float*)(ws + WS_SIDEG); E.f1 = p->in[25] + (size_t)l * 3 * DFF; E.f2 = p->in[26] + (size_t)l * DFF;
            g.A = H; g.Bt = (const bf16_t*)(ws + WS_WUP); g.lda = 1024; g.K = 1024;
            S.init(64, 22, G, c, 22, 0, 0); do_gemm = true;
        } else if (step == 10) { ffn_fix_phase(p, l, wv); }
        else {
            E.mode = pg8::EM_RESID; E.f0 = p->out; E.f1 = p->out; E.f2 = ml + 5120;
            g.A = (const bf16_t*)(ws + WS_UP); g.Bt = (const bf16_t*)(ws + WS_WDN); g.lda = DFF; g.K = DFF;
            S.init(64, 4, G, c, 4, 0, 0); do_gemm = true;
        }
        if (do_gemm) pg8::gemm_phase(lds, g, S, E, wv);
        gbar((unsigned*)(ws + WS_BAR), xst, wv);
    }
    p = okp();
    final_norm_phase(p->out, p->in[28], wv);
}

extern "C" void kernel_launch(void* const* d_in, const int* in_sizes, int n_in, void* d_out, int out_size, void* d_ws, size_t ws_size, hipStream_t stream) {
    static int grid_blocks = 0;
    if (grid_blocks == 0) {
        int dev = 0, cus = 0, per_cu = 0;
        hipGetDevice(&dev);
        hipDeviceGetAttribute(&cus, hipDeviceAttributeMultiprocessorCount, dev);
        if (hipFuncSetAttribute((const void*)fwd_megakernel, hipFuncAttributeMaxDynamicSharedMemorySize, LDS_BYTES) != hipSuccess) { fprintf(stderr, "hipFuncSetAttribute failed\n"); }
        hipOccupancyMaxActiveBlocksPerMultiprocessor(&per_cu, (const void*)fwd_megakernel, 512, LDS_BYTES);
        if (per_cu < 1) { fprintf(stderr, "occupancy query returned %d\n", per_cu); per_cu = 1; }
        if (per_cu > 1) per_cu = 1;
        grid_blocks = cus * per_cu;
        (void)hipGetLastError();
    }
    if (n_in != 29 || ws_size < 256 * MiB) { fprintf(stderr, "unexpected inputs/workspace\n"); return; }
    (void)hipMemsetAsync((unsigned char*)d_ws + WS_BAR, 0, XB_WORDS * 4, stream);
    Params p{};
    for (int i = 0; i < 29; ++i) p.in[i] = (const float*)d_in[i];
    p.out = (float*)d_out; p.ws = (unsigned char*)d_ws;
    void* args[] = {&p};
    hipError_t e = hipLaunchCooperativeKernel((const void*)fwd_megakernel, dim3(grid_blocks), dim3(512), args, LDS_BYTES, stream);
    if (e != hipSuccess) fprintf(stderr, "cooperative launch failed: %s (grid %d)\n", hipGetErrorString(e), grid_blocks);
}
```

```cpp
#include <hip/hip_runtime.h>
#include <hip/hip_cooperative_groups.h>
#include <cstdio>
#include <cstdint>
namespace cg = cooperative_groups;

#define LAS __attribute__((address_space(3)))
#define DI __device__ __forceinline__
typedef unsigned short bf16_t;
typedef short bf16x8 __attribute__((ext_vector_type(8)));
typedef float f32x4 __attribute__((ext_vector_type(4)));
typedef float f32x16 __attribute__((ext_vector_type(16)));
typedef unsigned u32x4 __attribute__((ext_vector_type(4)));
typedef unsigned u32x2 __attribute__((ext_vector_type(2)));

constexpr int DM = 1024, SEQ = 4096, MTOK = 16384, INC = 7424, DFF = 2816, UPC = 5632, RAWC = 1792;
constexpr int LDS_BYTES = 147456;
constexpr size_t MiB = 1048576;
constexpr size_t WS_WIN = 0, WS_WBR = WS_WIN + (size_t)INC * 1024 * 2, WS_WOUT = WS_WBR + 3u * 1024 * 512 * 2, WS_WUP = WS_WOUT + 1024u * 1024 * 2,
                 WS_WDN = WS_WUP + (size_t)UPC * 1024 * 2, WS_LWU = WS_WDN + (size_t)DFF * 1024 * 2, WS_LAU = WS_LWU + 65536, WS_LGU = WS_LAU + 65536;
constexpr size_t WS_H = 37 * MiB;
constexpr size_t WS_SMALL = 69 * MiB, WS_MOD = WS_SMALL, WS_ROPEC = WS_MOD + 262144, WS_ROPES = WS_ROPEC + 524288, WS_BONUS = WS_ROPES + 524288, WS_LSE = WS_BONUS + 524288;
constexpr size_t WS_BAR = WS_LSE + 524288;
constexpr size_t DB = 72 * MiB;
constexpr size_t WS_RAW = DB, WS_RZ = DB + 56 * MiB, WS_KP = DB + 72 * MiB, WS_KKN = DB + 88 * MiB, WS_B = DB + 104 * MiB, WS_W = DB + 120 * MiB, WS_VZ = DB + 152 * MiB, WS_G = DB + 168 * MiB;
constexpr size_t WS_YRAW = DB, WS_YSR = DB + 32 * MiB;
constexpr size_t WS_Q = DB + 56 * MiB, WS_K = DB + 72 * MiB, WS_V = DB + 88 * MiB, WS_UV = DB + 104 * MiB;
constexpr size_t WS_YSA = DB + 152 * MiB, WS_YSG = DB + 168 * MiB;
constexpr size_t WS_GATE = DB, WS_M32 = DB + 48 * MiB, WS_MB = DB + 112 * MiB;
constexpr size_t WS_UP = DB;
constexpr size_t WS_SIDEA = DB + 88 * MiB, WS_SIDEG = DB + 100 * MiB;
static_assert(WS_LGU + 131072 <= WS_H, "weights region overflow");
static_assert(WS_BAR + 64 * 26 * 4 <= DB, "small region overflow");

struct Params {
    const float* in[29];
    float* out;
    unsigned char* ws;
};

typedef const __attribute__((address_space(4))) Params* KP;
DI KP okp() { unsigned long long k = (unsigned long long)__builtin_amdgcn_kernarg_segment_ptr(); asm volatile("" : "+s"(k)); return (KP)k; }
typedef float f32x2_t __attribute__((ext_vector_type(2)));
typedef __bf16 bf16x2_t __attribute__((ext_vector_type(2)));
DI unsigned cvt_pk_bf16(float lo, float hi) { const f32x2_t v = {lo, hi}; const bf16x2_t r = __builtin_convertvector(v, bf16x2_t); return __builtin_bit_cast(unsigned, r); }
DI float bf_lo(unsigned w) { return __uint_as_float(w << 16); }
DI float bf_hi(unsigned w) { return __uint_as_float(w & 0xffff0000u); }
DI int otid(int wv) { int ln; asm volatile("v_mbcnt_lo_u32_b32 %0, -1, 0\n\tv_mbcnt_hi_u32_b32 %0, -1, %0" : "=v"(ln)); return wv * 64 + ln; }
DI unsigned char* ows(unsigned char* w) { asm volatile("" : "+s"(w)); return w; }
DI float row16_sum(float v) {
    v += __builtin_bit_cast(float, __builtin_amdgcn_update_dpp(0, __builtin_bit_cast(int, v), 0xB1, 0xF, 0xF, false));
    v += __builtin_bit_cast(float, __builtin_amdgcn_update_dpp(0, __builtin_bit_cast(int, v), 0x4E, 0xF, 0xF, false));
    v += __builtin_bit_cast(float, __builtin_amdgcn_update_dpp(0, __builtin_bit_cast(int, v), 0x141, 0xF, 0xF, false));
    v += __builtin_bit_cast(float, __builtin_amdgcn_update_dpp(0, __builtin_bit_cast(int, v), 0x140, 0xF, 0xF, false));
    return v;
}
DI float wave_sum(float v) { v = row16_sum(v); v += __shfl_xor(v, 16); v += __shfl_xor(v, 32); return v; }
#define XB_CNT(j)  (64 * (j))
#define XB_SUB(j)  (64 * (8 + (j)))
#define XB_GEN(j)  (64 * (16 + (j)))
#define XB_TOP     (64 * 24)
#define XB_TOPGEN  (64 * 25)
#define XB_WORDS   (64 * 26)
DI unsigned xb_ld(unsigned* p) { return __hip_atomic_load(p, __ATOMIC_RELAXED, __HIP_MEMORY_SCOPE_AGENT); }
DI unsigned xb_add(unsigned* p, unsigned v) { return __hip_atomic_fetch_add(p, v, __ATOMIC_RELAXED, __HIP_MEMORY_SCOPE_AGENT); }
DI unsigned xb_xcc_id() { return (unsigned)__builtin_amdgcn_s_getreg((3 << 11) | 20) & 0x7u; }
DI void gbar(unsigned* bar, volatile LAS unsigned* st, int wv) {
    asm volatile("s_waitcnt vmcnt(0) lgkmcnt(0)" ::: "memory");
    __syncthreads();
    if (otid(wv) == 0) {
        const unsigned nloc = st[0], nx = st[1], x = st[2];
        const unsigned old = xb_add(&bar[XB_SUB(x)], 1u);
        const unsigned gen = old / nloc;
        if (old + 1u == (gen + 1u) * nloc) {
            __builtin_amdgcn_fence(__ATOMIC_RELEASE, "agent");
            asm volatile("s_waitcnt vmcnt(0)" ::: "memory");
            const unsigned og = xb_add(&bar[XB_TOP], 1u);
            const unsigned tg = og / nx;
            if (og + 1u == (tg + 1u) * nx) xb_add(&bar[XB_TOPGEN], 1u);
            else { while (xb_ld(&bar[XB_TOPGEN]) == tg) __builtin_amdgcn_s_sleep(1); }
            __builtin_amdgcn_fence(__ATOMIC_ACQUIRE, "agent");
            xb_add(&bar[XB_GEN(x)], 1u);
            asm volatile("s_waitcnt vmcnt(0)" ::: "memory");
        } else {
            while (xb_ld(&bar[XB_GEN(x)]) == gen) __builtin_amdgcn_s_sleep(1);
            __builtin_amdgcn_fence(__ATOMIC_ACQUIRE, "agent");
            asm volatile("s_waitcnt vmcnt(0)" ::: "memory");
        }
    }
    asm volatile("" ::: "memory");
    __syncthreads();
}
DI float sigmoidf_(float x) { return __builtin_amdgcn_rcpf(1.0f + __expf(-x)); }
DI float gelu_tanh(float x) { const float u = 1.5957691216f * (x + 0.044715f * x * x * x); return x * __builtin_amdgcn_rcpf(1.0f + __expf(-u)); }
#define LDS_WAIT() asm volatile("s_waitcnt lgkmcnt(0)" ::: "memory")
#define MFMA32(a, b, c) __builtin_amdgcn_mfma_f32_32x32x16_bf16((a), (b), (c), 0, 0, 0)
DI int crow(int reg, int h) { return (reg & 3) + 8 * (reg >> 2) + 4 * h; }
DI bf16x8 pack8(float a0, float a1, float a2, float a3, float a4, float a5, float a6, float a7) {
    u32x4 p; p.x = cvt_pk_bf16(a0, a1); p.y = cvt_pk_bf16(a2, a3); p.z = cvt_pk_bf16(a4, a5); p.w = cvt_pk_bf16(a6, a7);
    return __builtin_bit_cast(bf16x8, p);
}

namespace pg8 {
constexpr int BM = 256, BK = 64, HALF = 128, HTB = HALF * BK * 2, STAGE_BYTES = 8 * HTB, NXCD = 8, WGM = 8;
DI int lds_byte(int r, int c) { const int st = (r >> 4) * 2 + (c >> 5), rr = r & 15, cc = c & 31, ob = rr * 64 + cc * 2; return st * 1024 + (ob ^ (((ob >> 9) & 1) << 5)); }
DI void stage_rc(int b, int& R, int& C) { const int st = b / 1024, sb = b % 1024, swz = sb ^ (((sb >> 9) & 1) << 5); R = (st >> 1) * 16 + swz / 64; C = (st & 1) * 32 + (swz % 64) / 2; }
DI int perm32(int rho) { const int n = rho >> 4, i = rho & 15; return 8 * (i >> 2) + 4 * n + (i & 3); }
struct Unit { int pm, pn, sub; };
struct Gemm { const bf16_t* A; const bf16_t* Bt; int lda, K; int merge; const unsigned char* ws; };
struct TileOrder {
    int nM, nN, nwg, G, c, split, off0, off1, nsub;
    DI void init(int nM_, int nN_, int G_, int c_, int split_, int off0_, int off1_, int nsub_ = 1) { nM = nM_; nN = nN_; nwg = nM * nN; G = G_; c = c_; split = split_; off0 = off0_; off1 = off1_; nsub = nsub_; }
    DI bool next(int i0, Unit& u) const {
        const int i = i0 / nsub; u.sub = i0 - i * nsub;
        const long L = (long)i * G + c; if (L >= nwg) return false;
        int wgid = (int)L; { const int q = nwg / NXCD, r = nwg % NXCD, xcd = wgid % NXCD, off = wgid / NXCD; wgid = (xcd < r ? xcd * (q + 1) : r * (q + 1) + (xcd - r) * q) + off; }
        const int nig = WGM * nN, gid = wgid / nig, fm = gid * WGM, gsz = (nM - fm) < WGM ? (nM - fm) : WGM;
        u.pm = fm + ((wgid % nig) % gsz); const int pnv = (wgid % nig) / gsz; u.pn = pnv < split ? pnv + off0 : pnv - split + off1; return true;
    }
};

enum { EM_INPROJ = 0, EM_GATE = 1, EM_BR_FIRST = 2, EM_BR_MID = 3, EM_BR_LAST = 4, EM_RESID = 5, EM_UP = 6, EM_MERGE = 7 };
struct Epi {
    int mode;
    bf16_t *o0, *o1, *o2, *o3, *o4;
    float* f3;
    float* f0; const float* f1; const float* f2;
    const float *ropec, *ropes;
    DI void up_conv(const f32x4 (&acc)[2][2][4][2], const Unit& u, int wr, int wc, int fr, int fq) const {
        const int f = u.pn * 128 + wc * 32 + 8 * fq;
        const int src1 = (fq << 4) | ((fr + 15) & 15), src2 = (fq << 4) | ((fr + 14) & 15);
        const f32x4 w0a = *(const f32x4*)(f1 + f), w0b = *(const f32x4*)(f1 + f + 4), w1a = *(const f32x4*)(f1 + DFF + f), w1b = *(const f32x4*)(f1 + DFF + f + 4);
        const f32x4 w2a = *(const f32x4*)(f1 + 2 * DFF + f), w2b = *(const f32x4*)(f1 + 2 * DFF + f + 4), cba = *(const f32x4*)(f2 + f), cbb = *(const f32x4*)(f2 + f + 4);
#pragma unroll
        for (int ai = 0; ai < 2; ++ai) {
            const int q = u.pm * 4 + ai * 2 + wr;
            f32x4 p1a_prev = {0.f, 0.f, 0.f, 0.f}, p1b_prev = p1a_prev, p2a_prev = p1a_prev, p2b_prev = p1a_prev;
#pragma unroll
            for (int m = 0; m < 4; ++m) {
                const f32x4 aa = acc[ai][0][m][0], ab = acc[ai][0][m][1], ga = acc[ai][1][m][0], gb = acc[ai][1][m][1];
                f32x4 p1a, p1b, p2a, p2b;
#pragma unroll
                for (int j = 0; j < 4; ++j) {
                    p1a[j] = __shfl(aa[j], src1); p1b[j] = __shfl(ab[j], src1); p2a[j] = __shfl(aa[j], src2); p2b[j] = __shfl(ab[j], src2);
                }
                const f32x4 t1a = fr >= 1 ? p1a : p1a_prev, t1b = fr >= 1 ? p1b : p1b_prev, t2a = fr >= 2 ? p2a : p2a_prev, t2b = fr >= 2 ? p2b : p2b_prev;
                const f32x4 ca = cba + w0a * t2a + w1a * t1a + w2a * aa, cb_ = cbb + w0b * t2b + w1b * t1b + w2b * ab;
                const int row = u.pm * BM + ai * HALF + wr * 64 + m * 16 + fr;
                u32x4 w;
                w.x = cvt_pk_bf16(gelu_tanh(ca[0]) * ga[0], gelu_tanh(ca[1]) * ga[1]); w.y = cvt_pk_bf16(gelu_tanh(ca[2]) * ga[2], gelu_tanh(ca[3]) * ga[3]);
                w.z = cvt_pk_bf16(gelu_tanh(cb_[0]) * gb[0], gelu_tanh(cb_[1]) * gb[1]); w.w = cvt_pk_bf16(gelu_tanh(cb_[2]) * gb[2], gelu_tanh(cb_[3]) * gb[3]);
                *(u32x4*)(o0 + (size_t)row * DFF + f) = w;
                if (m == 0 && fr < 2) {
                    float* sa = f0 + ((size_t)q * 4 + fr) * DFF + f; *(f32x4*)sa = aa; *(f32x4*)(sa + 4) = ab;
                    float* sg = f3 + ((size_t)q * 2 + fr) * DFF + f; *(f32x4*)sg = ga; *(f32x4*)(sg + 4) = gb;
                }
                if (m == 3 && fr >= 14) { float* sa = f0 + ((size_t)q * 4 + 2 + (fr - 14)) * DFF + f; *(f32x4*)sa = aa; *(f32x4*)(sa + 4) = ab; }
                p1a_prev = p1a; p1b_prev = p1b; p2a_prev = p2a; p2b_prev = p2b;
            }
        }
    }
    DI void operator()(const f32x4 (&acc)[2][2][4][2], const Unit& u, int wr, int wc, int fr, int fq) const {
        if (mode == EM_UP) { up_conv(acc, u, wr, wc, fr, fq); return; }
        const int mode = (this->mode == EM_MERGE) ? (((u.sub & 1) == 0) ? (int)EM_GATE : ((u.sub >> 1) == 0 ? (int)EM_BR_FIRST : ((u.sub >> 1) == 1 ? (int)EM_BR_MID : (int)EM_BR_LAST))) : this->mode;
        const int row0 = u.pm * BM + wr * 64 + fr, colb = u.pn * BM + wc * 32 + 8 * fq;
        if (mode == EM_RESID) {
            const float* gv = f2 + (size_t)(row0 >> 12) * 6144 + colb;
            const f32x4 g00 = *(const f32x4*)gv, g01 = *(const f32x4*)(gv + 4), g10 = *(const f32x4*)(gv + HALF), g11 = *(const f32x4*)(gv + HALF + 4);
#pragma unroll
            for (int ai = 0; ai < 2; ++ai) {
                f32x4 b0[4][2], b1[4][2];
#pragma unroll
                for (int m = 0; m < 4; ++m)
#pragma unroll
                    for (int bj = 0; bj < 2; ++bj) { const size_t off = (size_t)(row0 + ai * HALF + m * 16) * 1024 + colb + bj * HALF; b0[m][bj] = *(const f32x4*)(f1 + off); b1[m][bj] = *(const f32x4*)(f1 + off + 4); }
                asm volatile("" ::: "memory");
#pragma unroll
                for (int m = 0; m < 4; ++m)
#pragma unroll
                    for (int bj = 0; bj < 2; ++bj) { const size_t off = (size_t)(row0 + ai * HALF + m * 16) * 1024 + colb + bj * HALF;
                        *(f32x4*)(f0 + off) = b0[m][bj] + (bj ? g10 : g00) * acc[ai][bj][m][0]; *(f32x4*)(f0 + off + 4) = b1[m][bj] + (bj ? g11 : g01) * acc[ai][bj][m][1]; }
            }
            return;
        }
        if (mode == EM_BR_FIRST || mode == EM_BR_MID || mode == EM_BR_LAST) {
#pragma unroll
            for (int ai = 0; ai < 2; ++ai) {
                u32x4 gw[4][2], pm[4][2];
#pragma unroll
                for (int m = 0; m < 4; ++m)
#pragma unroll
                    for (int bj = 0; bj < 2; ++bj) { const size_t off = (size_t)(row0 + ai * HALF + m * 16) * 1024 + colb + bj * HALF; gw[m][bj] = *(const u32x4*)(o0 + off);
                        pm[m][bj] = (u32x4){0u, 0u, 0u, 0u}; if (mode != EM_BR_FIRST) pm[m][bj] = *(const u32x4*)(o1 + off); }
                asm volatile("" ::: "memory");
#pragma unroll
                for (int m = 0; m < 4; ++m)
#pragma unroll
                    for (int bj = 0; bj < 2; ++bj) { const size_t off = (size_t)(row0 + ai * HALF + m * 16) * 1024 + colb + bj * HALF;
                        const f32x4 v0 = acc[ai][bj][m][0], v1 = acc[ai][bj][m][1]; const u32x4 g_ = gw[m][bj], q_ = pm[m][bj];
                        u32x4 w;
                        w.x = cvt_pk_bf16(bf_lo(g_.x) * v0[0] + bf_lo(q_.x), bf_hi(g_.x) * v0[1] + bf_hi(q_.x)); w.y = cvt_pk_bf16(bf_lo(g_.y) * v0[2] + bf_lo(q_.y), bf_hi(g_.y) * v0[3] + bf_hi(q_.y));
                        w.z = cvt_pk_bf16(bf_lo(g_.z) * v1[0] + bf_lo(q_.z), bf_hi(g_.z) * v1[1] + bf_hi(q_.z)); w.w = cvt_pk_bf16(bf_lo(g_.w) * v1[2] + bf_lo(q_.w), bf_hi(g_.w) * v1[3] + bf_hi(q_.w));
                        *(u32x4*)(o1 + off) = w; }
            }
            return;
        }
#pragma unroll
        for (int ai = 0; ai < 2; ++ai) {
            f32x4 csn[4][2], snn[4][2];
            if (mode == EM_INPROJ && u.pn < 4) {
#pragma unroll
                for (int m = 0; m < 4; ++m)
#pragma unroll
                    for (int bj = 0; bj < 2; ++bj) { const int pos = (row0 + ai * HALF + m * 16) & (SEQ - 1), e0 = ((colb + bj * HALF) & 63) >> 1;
                        csn[m][bj] = *(const f32x4*)(ropec + pos * 32 + e0); snn[m][bj] = *(const f32x4*)(ropes + pos * 32 + e0); }
                asm volatile("" ::: "memory");
            }
#pragma unroll
            for (int m = 0; m < 4; ++m) {
                const int row = row0 + ai * HALF + m * 16;
#pragma unroll
                for (int bj = 0; bj < 2; ++bj) {
                    const int col0 = colb + bj * HALF;
                    f32x4 v0 = acc[ai][bj][m][0], v1 = acc[ai][bj][m][1];
                    if (mode == EM_INPROJ) {
                        bf16_t* dst;
                        if (u.pn < 4) {
                            const f32x4 cs = csn[m][bj], sn = snn[m][bj];
                            f32x4 a, b;
                            a[0] = v0[0] * cs[0] - v0[1] * sn[0]; a[1] = v0[1] * cs[0] + v0[0] * sn[0];
                            a[2] = v0[2] * cs[1] - v0[3] * sn[1]; a[3] = v0[3] * cs[1] + v0[2] * sn[1];
                            b[0] = v1[0] * cs[2] - v1[1] * sn[2]; b[1] = v1[1] * cs[2] + v1[0] * sn[2];
                            b[2] = v1[2] * cs[3] - v1[3] * sn[3]; b[3] = v1[3] * cs[3] + v1[2] * sn[3];
                            v0 = a; v1 = b;
                            dst = (u.pn < 2) ? o0 + (size_t)row * 512 + col0 : o1 + (size_t)row * 512 + (col0 - 512);
                        } else if (u.pn < 6) { dst = o2 + (size_t)row * 512 + (col0 - 1024); }
                        else if (u.pn < 13) { dst = o3 + (size_t)row * RAWC + (col0 - 1536); }
                        else {
#pragma unroll
                            for (int j = 0; j < 4; ++j) { v0[j] = gelu_tanh(v0[j]); v1[j] = gelu_tanh(v1[j]); }
                            dst = o4 + (size_t)row * 1024 + (col0 - 3328);
                        }
                        u32x4 w; w.x = cvt_pk_bf16(v0[0], v0[1]); w.y = cvt_pk_bf16(v0[2], v0[3]); w.z = cvt_pk_bf16(v1[0], v1[1]); w.w = cvt_pk_bf16(v1[2], v1[3]);
                        *(u32x4*)dst = w;
                    } else {
#pragma unroll
                        for (int j = 0; j < 4; ++j) { v0[j] = sigmoidf_(v0[j]); v1[j] = sigmoidf_(v1[j]); }
                        u32x4 w; w.x = cvt_pk_bf16(v0[0], v0[1]); w.y = cvt_pk_bf16(v0[2], v0[3]); w.z = cvt_pk_bf16(v1[0], v1[1]); w.w = cvt_pk_bf16(v1[2], v1[3]);
                        *(u32x4*)(o0 + (size_t)row * 1024 + col0) = w;
                    }
                }
            }
        }
    }
};

DI void unit_operands(const Gemm& g, int sub, const char*& A, const char*& Bt, int& lda, int& K) {
    if (!g.merge) { A = (const char*)g.A; Bt = (const char*)g.Bt; lda = g.lda; K = g.K; return; }
    const int br = sub >> 1;
    if ((sub & 1) == 0) { A = (const char*)(g.ws + WS_H); Bt = (const char*)(g.ws + WS_WIN) + (size_t)(4352 + 1024 * br) * 1024 * 2; lda = 1024; K = 1024; }
    else { A = (const char*)(g.ws + (br == 0 ? WS_YSA : (br == 1 ? WS_YSR : WS_YSG))); Bt = (const char*)(g.ws + WS_WBR) + (size_t)br * 1024 * 512 * 2; lda = 512; K = 512; }
}
DI void gemm_phase(LAS unsigned char* lds, const Gemm g, const TileOrder S, const Epi E, int wv) {
    const int tid = otid(wv), wid = __builtin_amdgcn_readfirstlane(tid >> 6), lane = tid & 63, wr = wid >> 2, wc = wid & 3, fr = lane & 15, fq = lane >> 4;
    int stR[2], stC[2], stRb[2];
#pragma unroll
    for (int i = 0; i < 2; ++i) { int R, C; stage_rc(tid * 16 + i * 8192, R, C); stR[i] = R; stC[i] = C; stRb[i] = (R & ~31) + perm32(R & 31); }
    const size_t kstep = (size_t)(BK * 2);
    const unsigned ldsw = (unsigned)wid * 1024u;
    const int aoff = lds_byte(wr * 64 + fr, fq * 8), boff = lds_byte(wc * 32 + fr, fq * 8);
#define PG8_SA(b, h) (((b) * 2 + (h)) * HTB)
#define PG8_SB(b, h) ((4 + (b) * 2 + (h)) * HTB)
#define PG8_STAGE(bufoff, gbase, voff) do { _Pragma("unroll") for (int _i = 0; _i < 2; ++_i) \
        __builtin_amdgcn_global_load_lds((const unsigned*)((const char*)(gbase) + (voff)[_i]), (LAS unsigned*)(lds + (bufoff) + ldsw + _i * 8192), 16, 0, 0); } while (0)
#define PG8_LDA(dst, b, h) do { _Pragma("unroll") for (int m = 0; m < 4; ++m) _Pragma("unroll") for (int k = 0; k < 2; ++k) dst[m][k] = *(const LAS bf16x8*)(lds + PG8_SA(b, h) + aoff + m * 2048 + k * 1024); } while (0)
#define PG8_LDB(dst, b, h) do { _Pragma("unroll") for (int n = 0; n < 2; ++n) _Pragma("unroll") for (int k = 0; k < 2; ++k) dst[n][k] = *(const LAS bf16x8*)(lds + PG8_SB(b, h) + boff + n * 2048 + k * 1024); } while (0)
#define PG8_MMA(ai, bj, At, Bt) do { __builtin_amdgcn_s_setprio(1); _Pragma("unroll") for (int m = 0; m < 4; ++m) _Pragma("unroll") for (int n = 0; n < 2; ++n) _Pragma("unroll") for (int k = 0; k < 2; ++k) \
        acc[ai][bj][m][n] = __builtin_amdgcn_mfma_f32_16x16x32_bf16(Bt[n][k], At[m][k], acc[ai][bj][m][n], 0, 0, 0); __builtin_amdgcn_s_setprio(0); } while (0)
#define PG8_WAIT_V(n) asm volatile("s_waitcnt vmcnt(" #n ")" ::: "memory")
#define PG8_WAIT_L(n) asm volatile("s_waitcnt lgkmcnt(" #n ")" ::: "memory")
#define PG8_BAR __builtin_amdgcn_s_barrier()
#define PG8_SCHED __builtin_amdgcn_sched_barrier(0)
#define PG8_SETUP(u, pA, pB, vA, vB, hA, hB, ntv) do { const char* _A; const char* _B; int _lda, _K; unit_operands(g, (u).sub, _A, _B, _lda, _K); \
        pA = _A + (size_t)(u).pm * 256 * _lda * 2; pB = _B + (size_t)(u).pn * 256 * _K * 2; hA = (size_t)HALF * _lda * 2; hB = (size_t)HALF * _K * 2; ntv = _K / BK; \
        _Pragma("unroll") for (int _i = 0; _i < 2; ++_i) { vA[_i] = (unsigned)(stR[_i] * _lda + stC[_i]) * 2u; vB[_i] = (unsigned)(stRb[_i] * _K + stC[_i]) * 2u; } } while (0)
    Unit cur, nxt; int ui = 0;
    if (!S.next(0, cur)) return;
    f32x4 acc[2][2][4][2];
#pragma unroll
    for (int a = 0; a < 2; ++a)
#pragma unroll
        for (int b = 0; b < 2; ++b)
#pragma unroll
            for (int m = 0; m < 4; ++m)
#pragma unroll
                for (int n = 0; n < 2; ++n) acc[a][b][m][n] = (f32x4){0.f, 0.f, 0.f, 0.f};
    bf16x8 At[4][2], B0[2][2], B1[2][2];
    const char *cA, *cB, *nA, *nB; unsigned vAc[2], vBc[2], vAn[2], vBn[2]; size_t hAc, hBc, hAn, hBn; int nt, ntn;
    PG8_SETUP(cur, cA, cB, vAc, vBc, hAc, hBc, nt);
    PG8_STAGE(PG8_SB(0, 0), cB, vBc); PG8_STAGE(PG8_SA(0, 0), cA, vAc); PG8_STAGE(PG8_SB(0, 1), cB + hBc, vBc); PG8_STAGE(PG8_SA(0, 1), cA + hAc, vAc);
    if (wr == 1) PG8_BAR;
    PG8_WAIT_V(4); PG8_BAR;
    PG8_STAGE(PG8_SB(1, 0), cB + kstep, vBc); PG8_STAGE(PG8_SA(1, 0), cA + kstep, vAc); PG8_STAGE(PG8_SB(1, 1), cB + hBc + kstep, vBc);
    PG8_WAIT_V(6); PG8_BAR;
    for (;;) {
        const bool has_next = S.next(ui + 1, nxt);
        if (has_next) { PG8_SETUP(nxt, nA, nB, vAn, vBn, hAn, hBn, ntn); }
        else { nA = cA; nB = cB; vAn[0] = vAc[0]; vAn[1] = vAc[1]; vBn[0] = vBc[0]; vBn[1] = vBc[1]; hAn = hAc; hBn = hBc; ntn = nt; }
        for (int t = 0; t < nt; t += 2) {
            const bool last = (t == nt - 2);
            const char* a1 = cA + (size_t)(t + 1) * kstep;
            const char* a2 = last ? nA : cA + (size_t)(t + 2) * kstep; const char* b2 = last ? nB : cB + (size_t)(t + 2) * kstep;
            const char* a3 = a2 + kstep; const char* b3 = b2 + kstep;
            unsigned vA2[2], vB2[2]; vA2[0] = last ? vAn[0] : vAc[0]; vA2[1] = last ? vAn[1] : vAc[1]; vB2[0] = last ? vBn[0] : vBc[0]; vB2[1] = last ? vBn[1] : vBc[1];
            const size_t hA2 = last ? hAn : hAc, hB2 = last ? hBn : hBc;
            PG8_LDB(B0, 0, 0); PG8_SCHED; PG8_LDA(At, 0, 0); PG8_STAGE(PG8_SA(1, 1), a1 + hAc, vAc);
            PG8_WAIT_L(8); PG8_BAR; PG8_WAIT_L(0); PG8_MMA(0, 0, At, B0); PG8_BAR; PG8_SCHED;
            PG8_LDB(B1, 0, 1); PG8_STAGE(PG8_SB(0, 0), b2, vB2);
            PG8_BAR; PG8_WAIT_L(0); PG8_MMA(0, 1, At, B1); PG8_BAR;
            PG8_LDA(At, 0, 1); PG8_STAGE(PG8_SA(0, 0), a2, vA2);
            PG8_BAR; PG8_WAIT_L(0); PG8_MMA(1, 0, At, B0); PG8_BAR; PG8_SCHED;
            PG8_STAGE(PG8_SB(0, 1), b2 + hB2, vB2);
            PG8_WAIT_V(6); PG8_BAR; PG8_MMA(1, 1, At, B1); PG8_BAR;
            PG8_LDB(B0, 1, 0); PG8_SCHED; PG8_LDA(At, 1, 0); PG8_STAGE(PG8_SA(0, 1), a2 + hA2, vA2);
            PG8_WAIT_L(8); PG8_BAR; PG8_WAIT_L(0); PG8_MMA(0, 0, At, B0); PG8_BAR; PG8_SCHED;
            PG8_LDB(B1, 1, 1); PG8_STAGE(PG8_SB(1, 0), b3, vB2);
            PG8_BAR; PG8_WAIT_L(0); PG8_MMA(0, 1, At, B1); PG8_BAR;
            PG8_LDA(At, 1, 1); PG8_STAGE(PG8_SA(1, 0), a3, vA2);
            PG8_BAR; PG8_WAIT_L(0); PG8_MMA(1, 0, At, B0); PG8_BAR; PG8_SCHED;
            PG8_STAGE(PG8_SB(1, 1), b3 + hB2, vB2);
            PG8_WAIT_V(6); PG8_BAR; PG8_MMA(1, 1, At, B1); PG8_BAR;
        }
        E(acc, cur, wr, wc, fr, fq);
        if (!has_next) break;
#pragma unroll
        for (int a = 0; a < 2; ++a)
#pragma unroll
            for (int b = 0; b < 2; ++b)
#pragma unroll
                for (int m = 0; m < 4; ++m)
#pragma unroll
                    for (int n = 0; n < 2; ++n) acc[a][b][m][n] = (f32x4){0.f, 0.f, 0.f, 0.f};
        cur = nxt; cA = nA; cB = nB; vAc[0] = vAn[0]; vAc[1] = vAn[1]; vBc[0] = vBn[0]; vBc[1] = vBn[1]; hAc = hAn; hBc = hBn; nt = ntn; ++ui;
    }
    PG8_WAIT_V(0);
    if (wr == 0) PG8_BAR;
    PG8_BAR;
#undef PG8_SA
#undef PG8_SB
#undef PG8_STAGE
#undef PG8_LDA
#undef PG8_LDB
#undef PG8_MMA
#undef PG8_WAIT_V
#undef PG8_WAIT_L
#undef PG8_BAR
#undef PG8_SCHED
#undef PG8_SETUP
}
}

template <int PERMK>
DI void transpose_item(const float* W, int K, int N, bf16_t* WT, LAS float* scr, int item, int lane) {
    const int nblk = N / 32, kb = item / nblk, nb = item % nblk, k0 = 64 * kb, n0 = 32 * nb;
    int sc = n0 + (lane & 31);
    if (PERMK == 1 && sc < 1024) { const int hd = sc >> 6, cp = sc & 63; sc = hd * 64 + 32 * (cp & 1) + (cp >> 1); }
    if (PERMK == 2) { const int tl = sc >> 8, w = sc & 255; sc = (w < 128) ? (128 * tl + w) : (DFF + 128 * tl + (w - 128)); }
#pragma unroll 8
    for (int i = 0; i < 32; ++i) { const int kk = 2 * i + (lane >> 5); scr[kk * 33 + (lane & 31)] = W[(size_t)(k0 + kk) * N + sc]; }
    LDS_WAIT();
    const int c = lane & 7;
#pragma unroll
    for (int j = 0; j < 4; ++j) { const int n = (lane >> 3) + 8 * j; const LAS float* s = scr + (8 * c) * 33 + n;
        u32x4 o; o.x = cvt_pk_bf16(s[0 * 33], s[1 * 33]); o.y = cvt_pk_bf16(s[2 * 33], s[3 * 33]); o.z = cvt_pk_bf16(s[4 * 33], s[5 * 33]); o.w = cvt_pk_bf16(s[6 * 33], s[7 * 33]);
        *(u32x4*)(WT + (size_t)(n0 + n) * K + k0 + 8 * c) = o; }
    LDS_WAIT();
}

DI void convert_weights(KP p, int l, LAS unsigned char* lds, int wv) {
    const int tid_ = otid(wv); const int wave = tid_ >> 6, lane = tid_ & 63;
    LAS float* scr = (LAS float*)(lds + wave * 8448);
    const int gw = blockIdx.x * 8 + wave, NGW = gridDim.x * 8;
    constexpr int I_IN = 16 * (INC / 32), I_BR = 8 * 32, I_OUT = 16 * 32, I_UP = 16 * (UPC / 32), I_DN = (DFF / 64) * 32, I_L64 = 16, I_L128 = 32;
    constexpr int NIT = I_IN + 3 * I_BR + I_OUT + I_UP + I_DN + 2 * I_L64 + I_L128;
    unsigned char* ws = ows(p->ws);
    for (int it = gw; it < NIT; it += NGW) {
        int r = it;
        if (r < I_IN) { transpose_item<1>(p->in[5] + (size_t)l * 1024 * INC, 1024, INC, (bf16_t*)(ws + WS_WIN), scr, r, lane); continue; } r -= I_IN;
        if (r < 3 * I_BR) { const int b = r / I_BR; transpose_item<0>(p->in[21] + ((size_t)l * 3 + b) * 512 * 1024, 512, 1024, (bf16_t*)(ws + WS_WBR) + (size_t)b * 1024 * 512, scr, r % I_BR, lane); continue; } r -= 3 * I_BR;
        if (r < I_OUT) { transpose_item<0>(p->in[22] + (size_t)l * 1024 * 1024, 1024, 1024, (bf16_t*)(ws + WS_WOUT), scr, r, lane); continue; } r -= I_OUT;
        if (r < I_UP) { transpose_item<2>(p->in[24] + (size_t)l * 1024 * UPC, 1024, UPC, (bf16_t*)(ws + WS_WUP), scr, r, lane); continue; } r -= I_UP;
        if (r < I_DN) { transpose_item<0>(p->in[27] + (size_t)l * DFF * 1024, DFF, 1024, (bf16_t*)(ws + WS_WDN), scr, r, lane); continue; } r -= I_DN;
        if (r < I_L64) { transpose_item<0>(p->in[8] + (size_t)l * 64 * 512, 64, 512, (bf16_t*)(ws + WS_LWU), scr, r, lane); continue; } r -= I_L64;
        if (r < I_L64) { transpose_item<0>(p->in[10] + (size_t)l * 64 * 512, 64, 512, (bf16_t*)(ws + WS_LAU), scr, r, lane); continue; } r -= I_L64;
        transpose_item<0>(p->in[11] + (size_t)l * 128 * 512, 128, 512, (bf16_t*)(ws + WS_LGU), scr, r, lane);
    }
}

DI void phase0(KP p, LAS unsigned char* lds, int wv) {
    const int tid = otid(wv);
    float* ropec = (float*)(p->ws + WS_ROPEC); float* ropes = (float*)(p->ws + WS_ROPES);
    for (int idx = blockIdx.x * 512 + tid; idx < SEQ * 32; idx += gridDim.x * 512) {
        const int pos = idx >> 5, e = idx & 31;
        const float inv = 1.0f / exp2f((float)e * (13.287712379549449f / 32.0f));
        const float ang = (float)pos * inv;
        double rev = (double)ang * 0.15915494309189535; rev -= rint(rev);
        const float rv = (float)rev;
        ropec[idx] = __builtin_amdgcn_cosf(rv); ropes[idx] = __builtin_amdgcn_sinf(rv);
    }
    {
        LAS float* ca = (LAS float*)lds;
        LAS float* red = (LAS float*)(lds + 16384);
        float* mod = (float*)(p->ws + WS_MOD);
        bool loaded = false;
        for (int item = blockIdx.x; item < 192; item += gridDim.x) {
            if (!loaded) { for (int i = tid; i < 4096; i += 512) { const float v = p->in[1][i]; ca[i] = v / (1.0f + __expf(-v)); } loaded = true; __syncthreads(); }
            const int l = item / 96, c0 = (item % 96) * 64, cc = tid & 63, kg = tid >> 6;
            const float* w = p->in[2] + (size_t)l * 1024 * 6144 + c0 + cc;
            float a0 = 0.f, a1 = 0.f, a2 = 0.f, a3 = 0.f;
#pragma unroll 8
            for (int k = kg * 128; k < kg * 128 + 128; ++k) { const float wv = w[(size_t)k * 6144]; a0 += ca[k] * wv; a1 += ca[1024 + k] * wv; a2 += ca[2048 + k] * wv; a3 += ca[3072 + k] * wv; }
            red[(kg * 4 + 0) * 64 + cc] = a0; red[(kg * 4 + 1) * 64 + cc] = a1; red[(kg * 4 + 2) * 64 + cc] = a2; red[(kg * 4 + 3) * 64 + cc] = a3;
            __syncthreads();
            if (tid < 256) { const int b = tid >> 6; float s = 0.f;
#pragma unroll
                for (int g = 0; g < 8; ++g) s += red[(g * 4 + b) * 64 + cc];
                mod[((size_t)l * 4 + b) * 6144 + c0 + cc] = s + p->in[3][(size_t)l * 6144 + c0 + cc]; }
            __syncthreads();
        }
        __syncthreads();
    }
    convert_weights(p, 0, lds, wv);
}

DI void norm_mod_phase(const float* x, const float* g, const float* sh, const float* sc, bf16_t* H, int wv) {
    const int tid_ = otid(wv); const int wave = tid_ >> 6, lane = tid_ & 63;
    for (int row0 = (blockIdx.x * 8 + wave) * 2; row0 < MTOK; row0 += gridDim.x * 16) {
        f32x4 v[2][4]; float s[2] = {0.f, 0.f};
#pragma unroll
        for (int q = 0; q < 2; ++q) { const f32x4* xr = (const f32x4*)(x + (size_t)(row0 + q) * DM) + lane;
#pragma unroll
            for (int j = 0; j < 4; ++j) v[q][j] = xr[64 * j]; }
#pragma unroll
        for (int q = 0; q < 2; ++q)
#pragma unroll
            for (int j = 0; j < 4; ++j) s[q] += (v[q][j][0] * v[q][j][0] + v[q][j][1] * v[q][j][1]) + (v[q][j][2] * v[q][j][2] + v[q][j][3] * v[q][j][3]);
        const float rs0 = rsqrtf(wave_sum(s[0]) * (1.0f / DM) + 1e-6f), rs1 = rsqrtf(wave_sum(s[1]) * (1.0f / DM) + 1e-6f);
        const int b = row0 >> 12;
#pragma unroll
        for (int j = 0; j < 4; ++j) {
            const int c = 4 * lane + 256 * j;
            const f32x4 gg = *(const f32x4*)(g + c), s1 = *(const f32x4*)(sc + (size_t)b * 6144 + c), s0 = *(const f32x4*)(sh + (size_t)b * 6144 + c);
#pragma unroll
            for (int q = 0; q < 2; ++q) {
                const f32x4 h = (v[q][j] * (q ? rs1 : rs0) * gg) * (s1 + 1.0f) + s0;
                u32x2 w; w.x = cvt_pk_bf16(h[0], h[1]); w.y = cvt_pk_bf16(h[2], h[3]);
                *((u32x2*)(H + (size_t)(row0 + q) * DM) + lane + 64 * j) = w;
            }
        }
    }
}
DI void final_norm_phase(float* x, const float* g, int wv) {
    const int tid_ = otid(wv); const int wave = tid_ >> 6, lane = tid_ & 63;
    for (int row = blockIdx.x * 8 + wave; row < MTOK; row += gridDim.x * 8) {
        f32x4* xr = (f32x4*)(x + (size_t)row * DM) + lane;
        f32x4 v[4]; float s = 0.f;
#pragma unroll
        for (int j = 0; j < 4; ++j) { v[j] = xr[64 * j]; s += (v[j][0] * v[j][0] + v[j][1] * v[j][1]) + (v[j][2] * v[j][2] + v[j][3] * v[j][3]); }
        const float rs = rsqrtf(wave_sum(s) * (1.0f / DM) + 1e-6f);
#pragma unroll
        for (int j = 0; j < 4; ++j) { const f32x4 gg = *(const f32x4*)(g + 4 * lane + 256 * j); xr[64 * j] = v[j] * rs * gg; }
    }
}

DI bf16x8 lerp_frag(const bf16_t* cur, const bf16_t* prv, bool hasprev, const float* mu, int act) {
    const u32x4 c = *(const u32x4*)cur; u32x4 q = {0u, 0u, 0u, 0u}; if (hasprev) q = *(const u32x4*)prv;
    const f32x4 m0 = *(const f32x4*)mu, m1 = *(const f32x4*)(mu + 4);
    float z[8];
    const unsigned cw[4] = {c.x, c.y, c.z, c.w}, qw[4] = {q.x, q.y, q.z, q.w};
#pragma unroll
    for (int j = 0; j < 4; ++j) {
        const float c0 = bf_lo(cw[j]), c1 = bf_hi(cw[j]), p0 = bf_lo(qw[j]), p1 = bf_hi(qw[j]);
        const float mA = (j < 2) ? m0[2 * j] : m1[2 * j - 4], mB = (j < 2) ? m0[2 * j + 1] : m1[2 * j - 3];
        z[2 * j] = c0 + (p0 - c0) * mA; z[2 * j + 1] = c1 + (p1 - c1) * mB;
    }
#pragma unroll
    for (int j = 0; j < 8; ++j) {
        if (act == 1) { const float e = __expf(2.0f * z[j]); z[j] = 1.0f - 2.0f / (1.0f + e); }
        else if (act == 2) z[j] = sigmoidf_(z[j]);
    }
    return pack8(z[0], z[1], z[2], z[3], z[4], z[5], z[6], z[7]);
}

DI void rwkv_derived_phase(KP p0, int l, LAS unsigned char* lds, int wv) {
    const int tid_ = otid(wv); const int wave = tid_ >> 6, lane = tid_ & 63, r = lane & 31, hh = lane >> 5;
    LAS float* lp = (LAS float*)(lds + wave * 2048);
    {
        const int ch = wave * 64 + lane;
        lp[0 * 64 + lane] = p0->in[6][(size_t)l * RAWC + ch]; lp[1 * 64 + lane] = p0->in[6][(size_t)l * RAWC + 512 + ch]; lp[2 * 64 + lane] = p0->in[6][(size_t)l * RAWC + 1024 + ch];
        lp[3 * 64 + lane] = p0->in[7][l * 512 + ch]; lp[4 * 64 + lane] = p0->in[9][l * 512 + ch]; lp[5 * 64 + lane] = p0->in[12][l * 512 + ch];
        lp[6 * 64 + lane] = p0->in[13][l * 512 + ch]; lp[7 * 64 + lane] = p0->in[14][l * 512 + ch];
        LDS_WAIT();
    }
    for (int job = blockIdx.x * 8 + wave; job < 512 * 8; job += gridDim.x * 8) {
        KP p = okp(); unsigned char* ws = ows(p->ws);
        const bf16_t* RAW = (const bf16_t*)(ws + WS_RAW);
        bf16_t *RZ = (bf16_t*)(ws + WS_RZ), *KP = (bf16_t*)(ws + WS_KP), *VZ = (bf16_t*)(ws + WS_VZ), *KKN = (bf16_t*)(ws + WS_KKN), *Bv = (bf16_t*)(ws + WS_B), *G = (bf16_t*)(ws + WS_G);
        float* W = (float*)(ws + WS_W);
        const bf16_t *LWU = (const bf16_t*)(ws + WS_LWU), *LAU = (const bf16_t*)(ws + WS_LAU), *LGU = (const bf16_t*)(ws + WS_LGU);
        const float* mu = p->in[6] + (size_t)l * RAWC; const float* w0 = p->in[7] + l * 512; const float* a0 = p->in[9] + l * 512;
        const float* k_k = p->in[12] + l * 512; const float* k_a = p->in[13] + l * 512; const float* r_k = p->in[14] + l * 512;
        const int hd = job & 7, tg = job >> 3, t = tg * 32 + r;
        const bool hp = (t & (SEQ - 1)) != 0;
        const bf16_t* cur = RAW + (size_t)t * RAWC; const bf16_t* prv = cur - RAWC;
        float ss = 0.f;
#pragma unroll
        for (int q = 0; q < 8; ++q) {
            const int c = hd * 64 + 8 * q + 4 * hh;
            const u32x2 kc = *(const u32x2*)(cur + 512 + c); u32x2 kq = {0u, 0u}; if (hp) kq = *(const u32x2*)(prv + 512 + c);
            const f32x4 mk = *(const LAS f32x4*)(lp + 1 * 64 + 8 * q + 4 * hh), kkw = *(const LAS f32x4*)(lp + 5 * 64 + 8 * q + 4 * hh);
            const float kcur[4] = {bf_lo(kc.x), bf_hi(kc.x), bf_lo(kc.y), bf_hi(kc.y)}, kprv[4] = {bf_lo(kq.x), bf_hi(kq.x), bf_lo(kq.y), bf_hi(kq.y)};
#pragma unroll
            for (int j = 0; j < 4; ++j) { const float kk = (kcur[j] + (kprv[j] - kcur[j]) * mk[j]) * kkw[j]; ss += kk * kk; }
        }
        ss += __shfl_xor(ss, 32);
        const float inv = 1.0f / fmaxf(sqrtf(ss), 1e-12f);
        float bonus = 0.f;
        {
            bf16x8 bw[4], ba[4];
#pragma unroll
            for (int s = 0; s < 4; ++s) { const int o = 16 * s + 8 * hh; bw[s] = lerp_frag(cur + 1536 + o, prv + 1536 + o, hp, mu + 1536 + o, 1); ba[s] = lerp_frag(cur + 1600 + o, prv + 1600 + o, hp, mu + 1600 + o, 0); }
#pragma unroll 1
            for (int mt = 0; mt < 2; ++mt) {
                const int chr = hd * 64 + 32 * mt + r;
                f32x16 aw, aa;
#pragma unroll
                for (int i = 0; i < 16; ++i) { aw[i] = 0.f; aa[i] = 0.f; }
                {
                    typedef const __attribute__((address_space(1))) bf16x8* GP8;
                    const GP8 pw = (GP8)(LWU + (size_t)chr * 64 + 8 * hh), pa = (GP8)(LAU + (size_t)chr * 64 + 8 * hh);
                    bf16x8 fw[4], fa[4];
#pragma unroll
                    for (int s = 0; s < 4; ++s) { fw[s] = pw[2 * s]; fa[s] = pa[2 * s]; }
                    asm volatile("" ::: "memory");
#pragma unroll
                    for (int s = 0; s < 4; ++s) { aw = MFMA32(fw[s], bw[s], aw); aa = MFMA32(fa[s], ba[s], aa); }
                }
                u32x2 rcA[4], kcA[4], vcA[4], rpA[4], kqA[4], vpA[4];
#pragma unroll
                for (int i4 = 0; i4 < 4; ++i4) {
                    const int c = hd * 64 + 32 * mt + 8 * i4 + 4 * hh;
                    rcA[i4] = *(const u32x2*)(cur + c); kcA[i4] = *(const u32x2*)(cur + 512 + c); vcA[i4] = *(const u32x2*)(cur + 1024 + c);
                    rpA[i4] = (u32x2){0u, 0u}; kqA[i4] = (u32x2){0u, 0u}; vpA[i4] = (u32x2){0u, 0u};
                    if (hp) { rpA[i4] = *(const u32x2*)(prv + c); kqA[i4] = *(const u32x2*)(prv + 512 + c); vpA[i4] = *(const u32x2*)(prv + 1024 + c); }
                }
                asm volatile("" ::: "memory");
#pragma unroll
                for (int i4 = 0; i4 < 4; ++i4) {
                    const int c = hd * 64 + 32 * mt + 8 * i4 + 4 * hh;
                    const u32x2 rc = rcA[i4], kc = kcA[i4], vc = vcA[i4], rp = rpA[i4], kq = kqA[i4], vp = vpA[i4];
                    const int cl = 32 * mt + 8 * i4 + 4 * hh;
                    const f32x4 mr = *(const LAS f32x4*)(lp + cl), mk = *(const LAS f32x4*)(lp + 64 + cl), mv = *(const LAS f32x4*)(lp + 128 + cl);
                    const f32x4 w0v = *(const LAS f32x4*)(lp + 192 + cl), a0v = *(const LAS f32x4*)(lp + 256 + cl), kkw = *(const LAS f32x4*)(lp + 320 + cl), kaw = *(const LAS f32x4*)(lp + 384 + cl), rkw = *(const LAS f32x4*)(lp + 448 + cl);
                    const float rcur[4] = {bf_lo(rc.x), bf_hi(rc.x), bf_lo(rc.y), bf_hi(rc.y)}, rprv[4] = {bf_lo(rp.x), bf_hi(rp.x), bf_lo(rp.y), bf_hi(rp.y)};
                    const float kcur[4] = {bf_lo(kc.x), bf_hi(kc.x), bf_lo(kc.y), bf_hi(kc.y)}, kprv[4] = {bf_lo(kq.x), bf_hi(kq.x), bf_lo(kq.y), bf_hi(kq.y)};
                    const float vcur[4] = {bf_lo(vc.x), bf_hi(vc.x), bf_lo(vc.y), bf_hi(vc.y)}, vprv[4] = {bf_lo(vp.x), bf_hi(vp.x), bf_lo(vp.y), bf_hi(vp.y)};
                    f32x4 dec; float rz[4], kp[4], vz[4], kn[4], bb[4];
#pragma unroll
                    for (int j = 0; j < 4; ++j) {
                        const int i = 4 * i4 + j;
                        const float zz = -(w0v[j] + aw[i]);
                        const float sp = (zz > 20.f) ? zz : __logf(1.0f + __expf(zz));
                        const float wv = -sp - 0.5f;
                        dec[j] = __expf(-__expf(wv));
                        const float av = sigmoidf_(a0v[j] + aa[i]);
                        rz[j] = rcur[j] + (rprv[j] - rcur[j]) * mr[j];
                        const float kz = kcur[j] + (kprv[j] - kcur[j]) * mk[j];
                        vz[j] = vcur[j] + (vprv[j] - vcur[j]) * mv[j];
                        kn[j] = kz * kkw[j] * inv; bb[j] = kn[j] * av;
                        kp[j] = kz * (1.0f + (av - 1.0f) * kaw[j]);
                        bonus += rz[j] * kp[j] * rkw[j];
                    }
                    const size_t o = (size_t)t * 512 + c;
                    *(f32x4*)(W + o) = dec;
                    u32x2 w2; w2.x = cvt_pk_bf16(rz[0], rz[1]); w2.y = cvt_pk_bf16(rz[2], rz[3]); *(u32x2*)(RZ + o) = w2;
                    w2.x = cvt_pk_bf16(kp[0], kp[1]); w2.y = cvt_pk_bf16(kp[2], kp[3]); *(u32x2*)(KP + o) = w2;
                    w2.x = cvt_pk_bf16(vz[0], vz[1]); w2.y = cvt_pk_bf16(vz[2], vz[3]); *(u32x2*)(VZ + o) = w2;
                    w2.x = cvt_pk_bf16(kn[0], kn[1]); w2.y = cvt_pk_bf16(kn[2], kn[3]); *(u32x2*)(KKN + o) = w2;
                    w2.x = cvt_pk_bf16(bb[0], bb[1]); w2.y = cvt_pk_bf16(bb[2], bb[3]); *(u32x2*)(Bv + o) = w2;
                }
            }
        }
        bonus += __shfl_xor(bonus, 32);
        int t2 = t; asm volatile("" : "+v"(t2));
        if (hh == 0) ((float*)(ows(ws) + WS_BONUS))[(size_t)t2 * 8 + hd] = bonus;
        {
            bf16x8 bg[8];
#pragma unroll
            for (int s = 0; s < 8; ++s) { const int o = 16 * s + 8 * hh; bg[s] = lerp_frag(cur + 1664 + o, prv + 1664 + o, hp, mu + 1664 + o, 2); }
#pragma unroll 1
            for (int mt = 0; mt < 2; ++mt) {
                const int chr = hd * 64 + 32 * mt + r;
                f32x16 ag;
#pragma unroll
                for (int i = 0; i < 16; ++i) ag[i] = 0.f;
                {
                    typedef const __attribute__((address_space(1))) bf16x8* GP8;
                    const GP8 pg = (GP8)(LGU + (size_t)chr * 128 + 8 * hh);
                    bf16x8 fg[8];
#pragma unroll
                    for (int s = 0; s < 8; ++s) fg[s] = pg[2 * s];
                    asm volatile("" ::: "memory");
#pragma unroll
                    for (int s = 0; s < 8; ++s) ag = MFMA32(fg[s], bg[s], ag);
                }
#pragma unroll
                for (int i4 = 0; i4 < 4; ++i4) {
                    const size_t o = (size_t)t2 * 512 + hd * 64 + 32 * mt + 8 * i4 + 4 * hh;
                    u32x2 w2; w2.x = cvt_pk_bf16(ag[4 * i4], ag[4 * i4 + 1]); w2.y = cvt_pk_bf16(ag[4 * i4 + 2], ag[4 * i4 + 3]); *(u32x2*)(G + o) = w2;
                }
            }
        }
    }
}

constexpr int SC_T = 32, SC_STEP = 1344, SC_BUF = SC_T * SC_STEP;
struct ScanRegs { f32x4 w0, w1; u32x4 kn, bb, kp, rz, vv; };
DI void scan_gload(KP p, ScanRegs& R, int b, int h, int rg, int ck, int pt) {
    const unsigned char* ws = ows(p->ws);
    const size_t tok0 = (size_t)b * SEQ + (size_t)ck * SC_T;
    { const int st = pt >> 4, sub = pt & 15; R.w0 = *(const f32x4*)((const float*)(ws + WS_W) + (tok0 + st) * 512 + h * 64 + 4 * sub); }
    { const int pp = pt + 256, st = pp >> 4, sub = pp & 15; R.w1 = *(const f32x4*)((const float*)(ws + WS_W) + (tok0 + st) * 512 + h * 64 + 4 * sub); }
    const int st = pt >> 3, sub = pt & 7; const size_t go = (tok0 + st) * 512 + h * 64 + 8 * sub;
    R.kn = *(const u32x4*)((const bf16_t*)(ws + WS_KKN) + go); R.bb = *(const u32x4*)((const bf16_t*)(ws + WS_B) + go);
    R.kp = *(const u32x4*)((const bf16_t*)(ws + WS_KP) + go); R.rz = *(const u32x4*)((const bf16_t*)(ws + WS_RZ) + go);
    R.vv = (u32x4){0u, 0u, 0u, 0u};
    if (pt < 64) { const int s2 = pt >> 1, hf = pt & 1; R.vv = *(const u32x4*)((const bf16_t*)(ws + WS_VZ) + (tok0 + s2) * 512 + h * 64 + rg * 16 + 8 * hf); }
}
DI void scan_write(const ScanRegs& R, LAS unsigned char* buf, int pt) {
    { const int st = pt >> 4, sub = pt & 15; *(LAS f32x4*)(buf + st * SC_STEP + sub * 16) = R.w0; }
    { const int pp = pt + 256, st = pp >> 4, sub = pp & 15; *(LAS f32x4*)(buf + st * SC_STEP + sub * 16) = R.w1; }
    const int st = pt >> 3, sub = pt & 7;
    const u32x4 kn = R.kn, bb = R.bb, kp = R.kp, rz = R.rz;
    LAS unsigned char* d = buf + st * SC_STEP + sub * 32;
    *(LAS f32x4*)(d + 256) = (f32x4){-bf_lo(kn.x), -bf_hi(kn.x), -bf_lo(kn.y), -bf_hi(kn.y)}; *(LAS f32x4*)(d + 256 + 16) = (f32x4){-bf_lo(kn.z), -bf_hi(kn.z), -bf_lo(kn.w), -bf_hi(kn.w)};
    *(LAS f32x4*)(d + 512) = (f32x4){bf_lo(bb.x), bf_hi(bb.x), bf_lo(bb.y), bf_hi(bb.y)}; *(LAS f32x4*)(d + 512 + 16) = (f32x4){bf_lo(bb.z), bf_hi(bb.z), bf_lo(bb.w), bf_hi(bb.w)};
    *(LAS f32x4*)(d + 768) = (f32x4){bf_lo(kp.x), bf_hi(kp.x), bf_lo(kp.y), bf_hi(kp.y)}; *(LAS f32x4*)(d + 768 + 16) = (f32x4){bf_lo(kp.z), bf_hi(kp.z), bf_lo(kp.w), bf_hi(kp.w)};
    *(LAS f32x4*)(d + 1024) = (f32x4){bf_lo(rz.x), bf_hi(rz.x), bf_lo(rz.y), bf_hi(rz.y)}; *(LAS f32x4*)(d + 1024 + 16) = (f32x4){bf_lo(rz.z), bf_hi(rz.z), bf_lo(rz.w), bf_hi(rz.w)};
    if (pt < 64) { const int s2 = pt >> 1, hf = pt & 1; const u32x4 vv = R.vv;
        LAS unsigned char* dv = buf + s2 * SC_STEP + 1280 + hf * 32;
        *(LAS f32x4*)dv = (f32x4){bf_lo(vv.x), bf_hi(vv.x), bf_lo(vv.y), bf_hi(vv.y)}; *(LAS f32x4*)(dv + 16) = (f32x4){bf_lo(vv.z), bf_hi(vv.z), bf_lo(vv.w), bf_hi(vv.w)}; }
}
DI void rwkv_scan_phase(KP p, LAS unsigned char* lds, int wv) {
    const int tid = otid(wv), wave = tid >> 6, lane = tid & 63;
    float* YRAW = (float*)(p->ws + WS_YRAW);
    for (int job = blockIdx.x; job < 128; job += gridDim.x) {
        const int jx = job & 7, jk = job >> 3;
        const int chain = jx + 8 * (jk >> 2), rg = jk & 3, b = chain >> 3, h = chain & 7;
        __syncthreads();
        ScanRegs R0, R1;
        if (wave >= 4) { scan_gload(p, R0, b, h, rg, 0, tid - 256); scan_write(R0, lds, tid - 256); scan_gload(p, R0, b, h, rg, 1, tid - 256); scan_gload(p, R1, b, h, rg, 2, tid - 256); }
        __syncthreads();
        f32x4 S = {0.f, 0.f, 0.f, 0.f};
        const int jl = lane & 15, rl = 4 * (wave & 3) + (lane >> 4);
        for (int ck2 = 0; ck2 < SEQ / SC_T; ck2 += 2) {
#pragma unroll
            for (int half = 0; half < 2; ++half) {
                const int ck = ck2 + half;
                LAS unsigned char* cb = lds + (ck & 1) * SC_BUF;
                if (wave >= 4) {
                    if (ck + 1 < SEQ / SC_T) {
                        if (half == 0) { scan_write(R0, lds + ((ck + 1) & 1) * SC_BUF, tid - 256); if (ck + 3 < SEQ / SC_T) scan_gload(p, R0, b, h, rg, ck + 3, tid - 256); }
                        else           { scan_write(R1, lds + ((ck + 1) & 1) * SC_BUF, tid - 256); if (ck + 3 < SEQ / SC_T) scan_gload(p, R1, b, h, rg, ck + 3, tid - 256); }
                    }
                } else {
                    float* yo = YRAW + ((size_t)b * SEQ + (size_t)ck * SC_T + jl) * 512 + h * 64 + rg * 16 + rl;
                    const LAS unsigned char* sb = cb + jl * 16; const LAS unsigned char* vb = cb + 1280 + rl * 4;
                    f32x4 w4 = *(const LAS f32x4*)sb, an = *(const LAS f32x4*)(sb + 256), b4 = *(const LAS f32x4*)(sb + 512), k4 = *(const LAS f32x4*)(sb + 768), r4 = *(const LAS f32x4*)(sb + 1024);
                    float vi = *(const LAS float*)vb;
                    float yp[16];
#pragma unroll
                    for (int s = 0; s < SC_T; ++s) {
                        f32x4 w4n = w4, ann = an, b4n = b4, k4n = k4, r4n = r4; float vin = vi;
                        if (s + 1 < SC_T) {
                            const LAS unsigned char* sn = sb + (s + 1) * SC_STEP;
                            w4n = *(const LAS f32x4*)sn; ann = *(const LAS f32x4*)(sn + 256); b4n = *(const LAS f32x4*)(sn + 512); k4n = *(const LAS f32x4*)(sn + 768); r4n = *(const LAS f32x4*)(sn + 1024);
                            vin = *(const LAS float*)(vb + (s + 1) * SC_STEP);
                        }
                        float sa = (S[0] * an[0] + S[1] * an[1]) + (S[2] * an[2] + S[3] * an[3]);
                        sa = row16_sum(sa);
                        S = S * w4 + (b4 * sa + k4 * vi);
                        yp[s & 15] = (S[0] * r4[0] + S[1] * r4[1]) + (S[2] * r4[2] + S[3] * r4[3]);
                        if ((s & 15) == 15) {
                            const bool b0 = (jl & 1) != 0, b1 = (jl & 2) != 0, b2 = (jl & 4) != 0, b3 = (jl & 8) != 0;
                            float u8[8], w4_[4], x2[2];
#pragma unroll
                            for (int k = 0; k < 8; ++k) { const float keep = b0 ? yp[2 * k + 1] : yp[2 * k], send = b0 ? yp[2 * k] : yp[2 * k + 1];
                                u8[k] = keep + __builtin_bit_cast(float, __builtin_amdgcn_update_dpp(0, __builtin_bit_cast(int, send), 0xB1, 0xF, 0xF, false)); }
#pragma unroll
                            for (int k = 0; k < 4; ++k) { const float keep = b1 ? u8[2 * k + 1] : u8[2 * k], send = b1 ? u8[2 * k] : u8[2 * k + 1];
                                w4_[k] = keep + __builtin_bit_cast(float, __builtin_amdgcn_update_dpp(0, __builtin_bit_cast(int, send), 0x4E, 0xF, 0xF, false)); }
#pragma unroll
                            for (int k = 0; k < 2; ++k) { const float keep = b2 ? w4_[2 * k + 1] : w4_[2 * k], send = b2 ? w4_[2 * k] : w4_[2 * k + 1];
                                x2[k] = keep + __builtin_bit_cast(float, __builtin_amdgcn_ds_swizzle(__builtin_bit_cast(int, send), 0x101F)); }
                            const float keep = b3 ? x2[1] : x2[0], send = b3 ? x2[0] : x2[1];
                            const float ysum = keep + __builtin_bit_cast(float, __builtin_amdgcn_ds_swizzle(__builtin_bit_cast(int, send), 0x201F));
                            yo[(size_t)(s - 15) * 512] = ysum;
                        }
                        w4 = w4n; an = ann; b4 = b4n; k4 = k4n; r4 = r4n; vi = vin;
                    }
                }
                __syncthreads();
            }
        }
    }
}

DI void rwkv_post_phase(KP p, int l, int wv) {
    const unsigned char* ws = ows(p->ws);
    const float* YRAW = (const float*)(ws + WS_YRAW); const bf16_t* VZ = (const bf16_t*)(ws + WS_VZ); const bf16_t* G = (const bf16_t*)(ws + WS_G);
    const float* BONUS = (const float*)(ws + WS_BONUS); bf16_t* YS = (bf16_t*)(p->ws + WS_YSR);
    const float* gnw = p->in[15] + l * 512; const float* gnb = p->in[16] + l * 512;
    const int tid_ = otid(wv); const int wave = tid_ >> 6, lane = tid_ & 63, c = 8 * lane;
    const f32x4 gw0 = *(const f32x4*)(gnw + c), gw1 = *(const f32x4*)(gnw + c + 4), gb0 = *(const f32x4*)(gnb + c), gb1 = *(const f32x4*)(gnb + c + 4);
    for (int t = blockIdx.x * 8 + wave; t < MTOK; t += gridDim.x * 8) {
        const size_t o = (size_t)t * 512 + c;
        const f32x4 y0 = *(const f32x4*)(YRAW + o), y1 = *(const f32x4*)(YRAW + o + 4);
        float s = (y0[0] + y0[1]) + (y0[2] + y0[3]) + (y1[0] + y1[1]) + (y1[2] + y1[3]);
        s += __shfl_xor(s, 1); s += __shfl_xor(s, 2); s += __shfl_xor(s, 4);
        const float mean = s * (1.0f / 64.0f);
        const f32x4 d0 = y0 - mean, d1 = y1 - mean;
        float q = (d0[0] * d0[0] + d0[1] * d0[1]) + (d0[2] * d0[2] + d0[3] * d0[3]) + (d1[0] * d1[0] + d1[1] * d1[1]) + (d1[2] * d1[2] + d1[3] * d1[3]);
        q += __shfl_xor(q, 1); q += __shfl_xor(q, 2); q += __shfl_xor(q, 4);
        const float rstd = rsqrtf(q * (1.0f / 64.0f) + 64e-5f);
        const float bon = BONUS[(size_t)t * 8 + (lane >> 3)];
        const u32x4 vv = *(const u32x4*)(VZ + o), gg = *(const u32x4*)(G + o);
        const f32x4 v0 = {bf_lo(vv.x), bf_hi(vv.x), bf_lo(vv.y), bf_hi(vv.y)}, v1 = {bf_lo(vv.z), bf_hi(vv.z), bf_lo(vv.w), bf_hi(vv.w)};
        const f32x4 g0 = {bf_lo(gg.x), bf_hi(gg.x), bf_lo(gg.y), bf_hi(gg.y)}, g1 = {bf_lo(gg.z), bf_hi(gg.z), bf_lo(gg.w), bf_hi(gg.w)};
        const f32x4 r0 = (d0 * rstd * gw0 + gb0 + v0 * bon) * g0, r1 = (d1 * rstd * gw1 + gb1 + v1 * bon) * g1;
        u32x4 w; w.x = cvt_pk_bf16(r0[0], r0[1]); w.y = cvt_pk_bf16(r0[2], r0[3]); w.z = cvt_pk_bf16(r1[0], r1[1]); w.w = cvt_pk_bf16(r1[2], r1[3]);
        *(u32x4*)(YS + o) = w;
    }
}

DI void attn_job(const bf16_t* Q, const bf16_t* K, const bf16_t* V, bf16_t* YS, float* LSE, LAS unsigned char* vl, int b, int h, int d, int rho, int J0, bool first, int lane) {
    asm volatile("" : "+v"(lane));
    const int r = lane & 31, hh = lane >> 5;
    const size_t tokq = (size_t)b * SEQ + (size_t)(J0 + r) * d + rho;
    typedef const __attribute__((address_space(1))) bf16x8* GP8;
    typedef const __attribute__((address_space(1))) u32x4* GP4;
    bf16x8 bq[4];
    { const GP8 qp = (GP8)(Q + tokq * 512 + h * 64 + 8 * hh);
#pragma unroll
      for (int s = 0; s < 4; ++s) bq[s] = qp[2 * s]; }
    bf16x8 ak[5][4];
#pragma unroll
    for (int kt = 0; kt < 5; ++kt) {
        const int Jk = J0 - 128 + 32 * kt + r;
        const size_t tokk = (size_t)b * SEQ + (size_t)(Jk >= 0 ? Jk : 0) * d + rho;
        const GP8 kp = (GP8)(K + tokk * 512 + h * 64 + 8 * hh);
#pragma unroll
        for (int s = 0; s < 4; ++s) ak[kt][s] = kp[2 * s];
    }
    asm volatile("" ::: "memory");
    f32x16 sc[5];
#pragma unroll
    for (int kt = 0; kt < 5; ++kt) {
        const bool valid = (J0 - 128 + 32 * kt + r) >= 0;
        f32x16 a;
#pragma unroll
        for (int i = 0; i < 16; ++i) a[i] = 0.f;
#pragma unroll
        for (int s = 0; s < 4; ++s) {
            bf16x8 kf = ak[kt][s];
            if (!valid) kf = (bf16x8){0, 0, 0, 0, 0, 0, 0, 0};
            a = MFMA32(kf, bq[s], a);
        }
        sc[kt] = a;
    }
    float m = -1e30f;
#pragma unroll
    for (int kt = 0; kt < 5; ++kt)
#pragma unroll
        for (int i = 0; i < 16; ++i) {
            const int kidx = 32 * kt + crow(i, hh); const int dist = 128 + r - kidx;
            const bool ok = (dist >= 0) && (dist <= 128) && (J0 - 128 + kidx >= 0);
            const float v = ok ? sc[kt][i] * 0.125f : -1e30f;
            sc[kt][i] = v; m = fmaxf(m, v);
        }
    m = fmaxf(m, __shfl_xor(m, 32));
    float lsum = 0.f;
#pragma unroll
    for (int kt = 0; kt < 5; ++kt)
#pragma unroll
        for (int i = 0; i < 16; ++i) { const float pv = __expf(sc[kt][i] - m); sc[kt][i] = pv; lsum += pv; }
    lsum += __shfl_xor(lsum, 32);
    const float lse = m + __logf(lsum);
    f32x16 o[2];
#pragma unroll
    for (int i = 0; i < 16; ++i) { o[0][i] = 0.f; o[1][i] = 0.f; }
    u32x4 vr[4];
    {
        const int key = lane >> 1, hf = lane & 1; const int Jk = J0 - 128 + key;
        const size_t tokv = (size_t)b * SEQ + (size_t)(Jk >= 0 ? Jk : 0) * d + rho;
        const GP4 src = (GP4)(V + tokv * 512 + h * 64 + 32 * hf);
        vr[0] = src[0]; vr[1] = src[1]; vr[2] = src[2]; vr[3] = src[3];
    }
#pragma unroll
    for (int kt = 0; kt < 5; ++kt) {
        {
            const int key = lane >> 1, hf = lane & 1;
            LAS u32x4* dst = (LAS u32x4*)(vl + key * 128 + hf * 64);
            dst[0] = vr[0]; dst[1] = vr[1]; dst[2] = vr[2]; dst[3] = vr[3];
            if (kt + 1 < 5) {
                const int Jk = J0 - 128 + 32 * (kt + 1) + key;
                const size_t tokv = (size_t)b * SEQ + (size_t)(Jk >= 0 ? Jk : 0) * d + rho;
                const GP4 src = (GP4)(V + tokv * 512 + h * 64 + 32 * hf);
                vr[0] = src[0]; vr[1] = src[1]; vr[2] = src[2]; vr[3] = src[3];
            }
        }
        LDS_WAIT();
#pragma unroll
        for (int s = 0; s < 2; ++s) {
            const bf16x8 xs = pack8(sc[kt][8 * s], sc[kt][8 * s + 1], sc[kt][8 * s + 2], sc[kt][8 * s + 3], sc[kt][8 * s + 4], sc[kt][8 * s + 5], sc[kt][8 * s + 6], sc[kt][8 * s + 7]);
#pragma unroll
            for (int mt = 0; mt < 2; ++mt) {
                bf16x8 pa;
#pragma unroll
                for (int j = 0; j < 8; ++j) { const int key = 16 * s + 8 * (j >> 2) + 4 * hh + (j & 3); pa[j] = (short)*(const LAS bf16_t*)(vl + key * 128 + (r + 32 * mt) * 2); }
                o[mt] = MFMA32(pa, xs, o[mt]);
            }
        }
        LDS_WAIT();
    }
    const float il = 1.0f / lsum;
    float wp = 0.f, wc = 1.0f, nl = lse;
    if (!first) { const float lp = LSE[tokq * 8 + h]; const float mx = fmaxf(lp, lse); const float ep = __expf(lp - mx), ec = __expf(lse - mx); nl = mx + __logf(ep + ec); wp = ep / (ep + ec); wc = ec / (ep + ec); }
#pragma unroll
    for (int mt = 0; mt < 2; ++mt)
#pragma unroll
        for (int g4 = 0; g4 < 4; ++g4) {
            bf16_t* dst = YS + tokq * 512 + h * 64 + 32 * mt + 8 * g4 + 4 * hh;
            float v[4];
#pragma unroll
            for (int j = 0; j < 4; ++j) v[j] = o[mt][4 * g4 + j] * il * wc;
            if (!first) { const u32x2 pw = *(const u32x2*)dst; v[0] += bf_lo(pw.x) * wp; v[1] += bf_hi(pw.x) * wp; v[2] += bf_lo(pw.y) * wp; v[3] += bf_hi(pw.y) * wp; }
            u32x2 w2; w2.x = cvt_pk_bf16(v[0], v[1]); w2.y = cvt_pk_bf16(v[2], v[3]); *(u32x2*)dst = w2;
        }
    if (hh == 0) LSE[tokq * 8 + h] = nl;
}

DI void attention_phase(KP p, LAS unsigned char* lds, int wv) {
    unsigned char* ws = ows(p->ws);
    const bf16_t *Q = (const bf16_t*)(ws + WS_Q), *K = (const bf16_t*)(ws + WS_K), *V = (const bf16_t*)(ws + WS_V);
    bf16_t* YS = (bf16_t*)(ws + WS_YSA); float* LSE = (float*)(ws + WS_LSE);
    const int tid_ = otid(wv); const int wave = tid_ >> 6, lane = tid_ & 63;
    LAS unsigned char* vl = lds + wave * 4096;
    for (int item0 = blockIdx.x; item0 < 256; item0 += gridDim.x) {
        const int item = (((item0 & 7) * 4 + (item0 >> 6)) << 3) | ((item0 >> 3) & 7);
        const int b = item >> 6, h = (item >> 3) & 7, qb = item & 7, P0 = qb * 512;
#pragma unroll 1
        for (int cfg = 0; cfg < 3; ++cfg) {
#pragma unroll 1
            for (int jj = wave; jj < 16; jj += 8) {
                int d, rho, J0;
                if (cfg == 0) { d = 1; rho = 0; J0 = P0 + 32 * jj; }
                else if (cfg == 1) { d = 4; rho = jj & 3; J0 = (P0 >> 2) + 32 * (jj >> 2); }
                else { d = 16; rho = jj; J0 = P0 >> 4; }
                attn_job(Q, K, V, YS, LSE, vl, b, h, d, rho, J0, cfg == 0, lane);
            }
            asm volatile("s_waitcnt vmcnt(0)" ::: "memory");
            __syncthreads();
        }
    }
}

DI void gmlp_phase(KP p, int l, LAS unsigned char* lds, int wv) {
    unsigned char* ws = ows(p->ws);
    const bf16_t* UV = (const bf16_t*)(ws + WS_UV); bf16_t* YS = (bf16_t*)(ws + WS_YSG);
    const float* lng = p->in[17] + l * 512; const float* lnb = p->in[18] + l * 512;
    const float* wsp = p->in[19] + (size_t)l * 8 * 128 * 128; const float* bsp = p->in[20] + (size_t)l * 8 * 128;
    const int tid_ = otid(wv); const int wave = tid_ >> 6, lane = tid_ & 63, r = lane & 31, hh = lane >> 5;
    LAS float* stats = (LAS float*)(lds + 8 * 17408);
    LAS bf16_t* VT = (LAS bf16_t*)(lds + wave * 17408);
    for (int item0 = blockIdx.x; item0 < 256; item0 += gridDim.x) {
        const int item = ((((item0 & 7) << 4) | (item0 >> 4)) << 1) | ((item0 >> 3) & 1);
        const size_t tok0 = (size_t)(item >> 1) * 128;
        __syncthreads();
        for (int tt = 0; tt < 16; ++tt) {
            const int tl = wave * 16 + tt;
            const u32x4 x = *(const u32x4*)(UV + (tok0 + tl) * 1024 + 512 + 8 * lane);
            const float f[8] = {bf_lo(x.x), bf_hi(x.x), bf_lo(x.y), bf_hi(x.y), bf_lo(x.z), bf_hi(x.z), bf_lo(x.w), bf_hi(x.w)};
            float s = 0.f;
#pragma unroll
            for (int j = 0; j < 8; ++j) s += f[j];
            const float mean = wave_sum(s) * (1.0f / 512.0f); float q = 0.f;
#pragma unroll
            for (int j = 0; j < 8; ++j) { const float dd = f[j] - mean; q += dd * dd; }
            const float rstd = rsqrtf(wave_sum(q) * (1.0f / 512.0f) + 1e-5f);
            if (lane == 0) { stats[2 * tl] = mean; stats[2 * tl + 1] = rstd; }
        }
        __syncthreads();
        const int g = (item & 1) * 4 + (wave & 3);
        if (wave < 4) {
        {
            const int d0 = 8 * (lane & 7);
            const f32x4 lg0 = *(const f32x4*)(lng + g * 64 + d0), lg1 = *(const f32x4*)(lng + g * 64 + d0 + 4), lb0 = *(const f32x4*)(lnb + g * 64 + d0), lb1 = *(const f32x4*)(lnb + g * 64 + d0 + 4);
            for (int it = 0; it < 16; ++it) {
                const int tl = it * 8 + (lane >> 3);
                const u32x4 x = *(const u32x4*)(UV + (tok0 + tl) * 1024 + 512 + g * 64 + d0);
                const float mean = stats[2 * tl], rstd = stats[2 * tl + 1];
                const float f[8] = {bf_lo(x.x), bf_hi(x.x), bf_lo(x.y), bf_hi(x.y), bf_lo(x.z), bf_hi(x.z), bf_lo(x.w), bf_hi(x.w)};
#pragma unroll
                for (int e = 0; e < 8; ++e) {
                    const float gg = e < 4 ? lg0[e & 3] : lg1[e & 3], bb = e < 4 ? lb0[e & 3] : lb1[e & 3];
                    const float y = (f[e] - mean) * rstd * gg + bb;
                    VT[(d0 + e) * 136 + tl] = (bf16_t)(cvt_pk_bf16(y, 0.f) & 0xffffu);
                }
            }
        }
        LDS_WAIT();
#pragma unroll 1
        for (int nt = 0; nt < 4; ++nt) {
            f32x16 acc[2];
#pragma unroll
            for (int i = 0; i < 16; ++i) { acc[0][i] = 0.f; acc[1][i] = 0.f; }
            const int irow = 32 * nt + r;
            for (int s = 0; s < 2 * (nt + 1); ++s) {
                const int j0 = 16 * s + 8 * hh;
                const float* wr_ = wsp + ((size_t)g * 128 + irow) * 128 + j0;
                const f32x4 wa = *(const f32x4*)wr_, wb = *(const f32x4*)(wr_ + 4);
                float wv[8] = {wa[0], wa[1], wa[2], wa[3], wb[0], wb[1], wb[2], wb[3]};
#pragma unroll
                for (int j = 0; j < 8; ++j) if (j0 + j > irow) wv[j] = 0.f;
                const bf16x8 bfr = pack8(wv[0], wv[1], wv[2], wv[3], wv[4], wv[5], wv[6], wv[7]);
#pragma unroll
                for (int mt = 0; mt < 2; ++mt) {
                    const bf16x8 afr = *(const LAS bf16x8*)(VT + (32 * mt + r) * 136 + j0);
                    acc[mt] = MFMA32(afr, bfr, acc[mt]);
                }
            }
            const size_t tok = tok0 + irow; const float bs = bsp[g * 128 + irow];
#pragma unroll
            for (int mt = 0; mt < 2; ++mt)
#pragma unroll
                for (int g4 = 0; g4 < 4; ++g4) {
                    const int c = g * 64 + 32 * mt + 8 * g4 + 4 * hh;
                    const u32x2 uu = *(const u32x2*)(UV + tok * 1024 + c);
                    const float o0 = bf_lo(uu.x) * (acc[mt][4 * g4] + bs), o1 = bf_hi(uu.x) * (acc[mt][4 * g4 + 1] + bs), o2 = bf_lo(uu.y) * (acc[mt][4 * g4 + 2] + bs), o3 = bf_hi(uu.y) * (acc[mt][4 * g4 + 3] + bs);
                    u32x2 w2; w2.x = cvt_pk_bf16(o0, o1); w2.y = cvt_pk_bf16(o2, o3); *(u32x2*)(YS + tok * 512 + c) = w2;
                }
        }
        }
    }
}

DI void ffn_fix_phase(KP p, int l, int wv) {
    unsigned char* ws = ows(p->ws);
    bf16_t* ACT = (bf16_t*)(ws + WS_UP); const float* SA = (const float*)(ws + WS_SIDEA); const float* SG = (const float*)(ws + WS_SIDEG);
    const float* cw = p->in[25] + (size_t)l * 3 * DFF; const float* cb = p->in[26] + (size_t)l * DFF;
    constexpr int NCG = DFF / 8;
    const int tid_ = otid(wv);
    for (int item = blockIdx.x * 512 + tid_; item < 256 * 2 * NCG; item += gridDim.x * 512) {
        const int cgi = item % NCG, qe = item / NCG, q = qe >> 1, e = qe & 1, f = 8 * cgi;
        const bool first = (q & 63) == 0;
        float o[8];
#pragma unroll
        for (int hf = 0; hf < 2; ++hf) {
            const int ff = f + 4 * hf;
            const f32x4 at = *(const f32x4*)(SA + ((size_t)q * 4 + e) * DFF + ff);
            f32x4 t1 = {0.f, 0.f, 0.f, 0.f}, t2 = {0.f, 0.f, 0.f, 0.f};
            if (e == 1) t1 = *(const f32x4*)(SA + ((size_t)q * 4 + 0) * DFF + ff);
            else if (!first) t1 = *(const f32x4*)(SA + ((size_t)(q - 1) * 4 + 3) * DFF + ff);
            if (!first) t2 = *(const f32x4*)(SA + ((size_t)(q - 1) * 4 + (e == 1 ? 3 : 2)) * DFF + ff);
            const f32x4 g = *(const f32x4*)(SG + ((size_t)q * 2 + e) * DFF + ff);
            const f32x4 w0 = *(const f32x4*)(cw + ff), w1 = *(const f32x4*)(cw + DFF + ff), w2 = *(const f32x4*)(cw + 2 * DFF + ff), bb = *(const f32x4*)(cb + ff);
            const f32x4 c = bb + w0 * t2 + w1 * t1 + w2 * at;
#pragma unroll
            for (int j = 0; j < 4; ++j) o[4 * hf + j] = gelu_tanh(c[j]) * g[j];
        }
        u32x4 w; w.x = cvt_pk_bf16(o[0], o[1]); w.y = cvt_pk_bf16(o[2], o[3]); w.z = cvt_pk_bf16(o[4], o[5]); w.w = cvt_pk_bf16(o[6], o[7]);
        *(u32x4*)(ACT + (size_t)(64 * q + e) * DFF + f) = w;
    }
}

__global__ void __launch_bounds__(512) fwd_megakernel(Params p_unused) {
    extern __shared__ __attribute__((aligned(16))) unsigned char lds_raw[];
    LAS unsigned char* lds = (LAS unsigned char*)lds_raw;
    cg::grid_group grid = cg::this_grid();
    KP p = okp();
    unsigned char* ws = p->ws;
    const int G = gridDim.x, c = blockIdx.x;
    const int wv = __builtin_amdgcn_readfirstlane((int)(threadIdx.x >> 6));
    pg8::Epi E; pg8::TileOrder S; pg8::Gemm g;

    unsigned* bar = (unsigned*)(ws + WS_BAR);
    volatile LAS unsigned* xst = (volatile LAS unsigned*)(lds + LDS_BYTES - 16);
    const unsigned myx = xb_xcc_id();
    if (otid(wv) == 0) { xb_add(&bar[XB_CNT(myx)], 1u); __builtin_amdgcn_fence(__ATOMIC_RELEASE, "agent"); }
    grid.sync();
    if (otid(wv) == 0) {
        unsigned mine = 0u, cnt = 0u;
#pragma unroll
        for (unsigned j = 0; j < 8; ++j) { const unsigned c = xb_ld(&bar[XB_CNT(j)]); cnt += (c > 0u) ? 1u : 0u; mine = (j == myx) ? c : mine; }
        xst[0] = mine > 0u ? mine : 1u; xst[1] = cnt > 0u ? cnt : 1u; xst[2] = myx;
    }
    __syncthreads();
    phase0(p, lds, wv);
    gbar(bar, xst, wv);
#pragma unroll 1
    for (int st = 0; st < 2 * 12; ++st) {
        const int l = st / 12, step = st % 12;
        p = okp(); ws = ows(p->ws);
        const float* mod = (const float*)(ws + WS_MOD); const bf16_t* H = (const bf16_t*)(ws + WS_H);
        const float* ml = mod + (size_t)l * 4 * 6144;
        const float* xin = (l == 0) ? p->in[0] : p->out;
        bool do_gemm = false;
        E = pg8::Epi{}; g.merge = 0; g.ws = ws;
        if (step == 0) {
            if (l > 0) convert_weights(p, l, lds, wv);
            norm_mod_phase(xin, p->in[4] + l * DM, ml + 0, ml + 1024, (bf16_t*)(ws + WS_H), wv);
        } else if (step == 1 || step == 4) {
            if (step == 4) rwkv_post_phase(p, l, wv);
            E.mode = pg8::EM_INPROJ; E.o0 = (bf16_t*)(ws + WS_Q); E.o1 = (bf16_t*)(ws + WS_K); E.o2 = (bf16_t*)(ws + WS_V); E.o3 = (bf16_t*)(ws + WS_RAW); E.o4 = (bf16_t*)(ws + WS_UV);
            E.ropec = (const float*)(ws + WS_ROPEC); E.ropes = (const float*)(ws + WS_ROPES);
            g.A = H; g.Bt = (const bf16_t*)(ws + WS_WIN); g.lda = 1024; g.K = 1024;
            if (step == 1) S.init(64, 7, G, c, 7, 6, 0); else S.init(64, 10, G, c, 6, 0, 13);
            do_gemm = true;
        } else if (step == 2) { rwkv_derived_phase(p, l, lds, wv); }
        else if (step == 3) { rwkv_scan_phase(p, lds, wv); }
        else if (step == 5) { attention_phase(p, lds, wv); gmlp_phase(p, l, lds, wv); }
        else if (step == 6) {
            E.mode = pg8::EM_MERGE; E.o0 = (bf16_t*)(ws + WS_GATE); E.o1 = (bf16_t*)(ws + WS_MB);
            g.merge = 1; g.A = H; g.Bt = (const bf16_t*)(ws + WS_WIN); g.lda = 1024; g.K = 1024;
            S.init(64, 4, G, c, 4, 0, 0, 6);
            do_gemm = true;
        } else if (step == 7) {
            E.mode = pg8::EM_RESID; E.f0 = p->out; E.f1 = xin; E.f2 = ml + 2048;
            g.A = (const bf16_t*)(ws + WS_MB); g.Bt = (const bf16_t*)(ws + WS_WOUT); g.lda = 1024; g.K = 1024;
            S.init(64, 4, G, c, 4, 0, 0); do_gemm = true;
        } else if (step == 8) { norm_mod_phase(p->out, p->in[23] + l * DM, ml + 3072, ml + 4096, (bf16_t*)(ws + WS_H), wv); }
        else if (step == 9) {
            E.mode = pg8::EM_UP; E.o0 = (bf16_t*)(ws + WS_UP); E.f0 = (float*)(ws + WS_SIDEA); E.f3 = (float*)(ws + WS_SIDEG); E.f1 = p->in[25] + (size_t)l * 3 * DFF; E.f2 = p->in[26] + (size_t)l * DFF;
            g.A = H; g.Bt = (const bf16_t*)(ws + WS_WUP); g.lda = 1024; g.K = 1024;
            S.init(64, 22, G, c, 22, 0, 0); do_gemm = true;
        } else if (step == 10) { ffn_fix_phase(p, l, wv); }
        else {
            E.mode = pg8::EM_RESID; E.f0 = p->out; E.f1 = p->out; E.f2 = ml + 5120;
            g.A = (const bf16_t*)(ws + WS_UP); g.Bt = (const bf16_t*)(ws + WS_WDN); g.lda = DFF; g.K = DFF;
            S.init(64, 4, G, c, 4, 0, 0); do_gemm = true;
        }
        if (do_gemm) pg8::gemm_phase(lds, g, S, E, wv);
        gbar((unsigned*)(ws + WS_BAR), xst, wv);
    }
    p = okp();
    final_norm_phase(p->out, p->in[28], wv);
}

extern "C" void kernel_launch(void* const* d_in, const int* in_sizes, int n_in, void* d_out, int out_size, void* d_ws, size_t ws_size, hipStream_t stream) {
    static int grid_blocks = 0;
    if (grid_blocks == 0) {
        int dev = 0, cus = 0, per_cu = 0;
        hipGetDevice(&dev);
        hipDeviceGetAttribute(&cus, hipDeviceAttributeMultiprocessorCount, dev);
        if (hipFuncSetAttribute((const void*)fwd_megakernel, hipFuncAttributeMaxDynamicSharedMemorySize, LDS_BYTES) != hipSuccess) { fprintf(stderr, "hipFuncSetAttribute failed\n"); }
        hipOccupancyMaxActiveBlocksPerMultiprocessor(&per_cu, (const void*)fwd_megakernel, 512, LDS_BYTES);
        if (per_cu < 1) { fprintf(stderr, "occupancy query returned %d\n", per_cu); per_cu = 1; }
        if (per_cu > 1) per_cu = 1;
        grid_blocks = cus * per_cu;
        (void)hipGetLastError();
    }
    if (n_in != 29 || ws_size < 256 * MiB) { fprintf(stderr, "unexpected inputs/workspace\n"); return; }
    (void)hipMemsetAsync((unsigned char*)d_ws + WS_BAR, 0, XB_WORDS * 4, stream);
    Params p{};
    for (int i = 0; i < 29; ++i) p.in[i] = (const float*)d_in[i];
    p.out = (float*)d_out; p.ws = (unsigned char*)d_ws;
    void* args[] = {&p};
    hipError_t e = hipLaunchCooperativeKernel((const void*)fwd_megakernel, dim3(grid_blocks), dim3(512), args, LDS_BYTES, stream);
    if (e != hipSuccess) fprintf(stderr, "cooperative launch failed: %s (grid %d)\n", hipGetErrorString(e), grid_blocks);
}
```

```cpp
#include <hip/hip_runtime.h>
#include <hip/hip_cooperative_groups.h>
#include <cstdio>
#include <cstdint>
namespace cg = cooperative_groups;

#define LAS __attribute__((address_space(3)))
#define DI __device__ __forceinline__
typedef unsigned short bf16_t;
typedef short bf16x8 __attribute__((ext_vector_type(8)));
typedef float f32x4 __attribute__((ext_vector_type(4)));
typedef float f32x16 __attribute__((ext_vector_type(16)));
typedef unsigned u32x4 __attribute__((ext_vector_type(4)));
typedef unsigned u32x2 __attribute__((ext_vector_type(2)));

constexpr int DM = 1024, SEQ = 4096, MTOK = 16384, INC = 7424, DFF = 2816, UPC = 5632, RAWC = 1792;
constexpr int LDS_BYTES = 147456;
constexpr size_t MiB = 1048576;
constexpr size_t WS_WIN = 0, WS_WBR = WS_WIN + (size_t)INC * 1024 * 2, WS_WOUT = WS_WBR + 3u * 1024 * 512 * 2, WS_WUP = WS_WOUT + 1024u * 1024 * 2,
                 WS_WDN = WS_WUP + (size_t)UPC * 1024 * 2, WS_LWU = WS_WDN + (size_t)DFF * 1024 * 2, WS_LAU = WS_LWU + 65536, WS_LGU = WS_LAU + 65536;
constexpr size_t WS_H = 37 * MiB;
constexpr size_t WS_SMALL = 69 * MiB, WS_MOD = WS_SMALL, WS_ROPEC = WS_MOD + 262144, WS_ROPES = WS_ROPEC + 524288, WS_BONUS = WS_ROPES + 524288, WS_LSE = WS_BONUS + 524288;
constexpr size_t WS_BAR = WS_LSE + 524288;
constexpr size_t DB = 72 * MiB;
constexpr size_t WS_RAW = DB, WS_RZ = DB + 56 * MiB, WS_KP = DB + 72 * MiB, WS_KKN = DB + 88 * MiB, WS_B = DB + 104 * MiB, WS_W = DB + 120 * MiB, WS_VZ = DB + 152 * MiB, WS_G = DB + 168 * MiB;
constexpr size_t WS_YRAW = DB, WS_YSR = DB + 32 * MiB;
constexpr size_t WS_Q = DB + 56 * MiB, WS_K = DB + 72 * MiB, WS_V = DB + 88 * MiB, WS_UV = DB + 104 * MiB;
constexpr size_t WS_YSA = DB + 152 * MiB, WS_YSG = DB + 168 * MiB;
constexpr size_t WS_GATE = DB, WS_M32 = DB + 48 * MiB, WS_MB = DB + 112 * MiB;
constexpr size_t WS_UP = DB;
constexpr size_t WS_SIDEA = DB + 88 * MiB, WS_SIDEG = DB + 100 * MiB;
static_assert(WS_LGU + 131072 <= WS_H, "weights region overflow");
static_assert(WS_BAR + 64 * 26 * 4 <= DB, "small region overflow");

struct Params {
    const float* in[29];
    float* out;
    unsigned char* ws;
};

typedef const __attribute__((address_space(4))) Params* KP;
DI KP okp() { unsigned long long k = (unsigned long long)__builtin_amdgcn_kernarg_segment_ptr(); asm volatile("" : "+s"(k)); return (KP)k; }
typedef float f32x2_t __attribute__((ext_vector_type(2)));
typedef __bf16 bf16x2_t __attribute__((ext_vector_type(2)));
DI unsigned cvt_pk_bf16(float lo, float hi) { const f32x2_t v = {lo, hi}; const bf16x2_t r = __builtin_convertvector(v, bf16x2_t); return __builtin_bit_cast(unsigned, r); }
DI float bf_lo(unsigned w) { return __uint_as_float(w << 16); }
DI float bf_hi(unsigned w) { return __uint_as_float(w & 0xffff0000u); }
DI int otid(int wv) { int ln; asm volatile("v_mbcnt_lo_u32_b32 %0, -1, 0\n\tv_mbcnt_hi_u32_b32 %0, -1, %0" : "=v"(ln)); return wv * 64 + ln; }
DI unsigned char* ows(unsigned char* w) { asm volatile("" : "+s"(w)); return w; }
DI float row16_sum(float v) {
    v += __builtin_bit_cast(float, __builtin_amdgcn_update_dpp(0, __builtin_bit_cast(int, v), 0xB1, 0xF, 0xF, false));
    v += __builtin_bit_cast(float, __builtin_amdgcn_update_dpp(0, __builtin_bit_cast(int, v), 0x4E, 0xF, 0xF, false));
    v += __builtin_bit_cast(float, __builtin_amdgcn_update_dpp(0, __builtin_bit_cast(int, v), 0x141, 0xF, 0xF, false));
    v += __builtin_bit_cast(float, __builtin_amdgcn_update_dpp(0, __builtin_bit_cast(int, v), 0x140, 0xF, 0xF, false));
    return v;
}
DI float wave_sum(float v) { v = row16_sum(v); v += __shfl_xor(v, 16); v += __shfl_xor(v, 32); return v; }
#define XB_CNT(j)  (64 * (j))
#define XB_SUB(j)  (64 * (8 + (j)))
#define XB_GEN(j)  (64 * (16 + (j)))
#define XB_TOP     (64 * 24)
#define XB_TOPGEN  (64 * 25)
#define XB_WORDS   (64 * 26)
DI unsigned xb_ld(unsigned* p) { return __hip_atomic_load(p, __ATOMIC_RELAXED, __HIP_MEMORY_SCOPE_AGENT); }
DI unsigned xb_add(unsigned* p, unsigned v) { return __hip_atomic_fetch_add(p, v, __ATOMIC_RELAXED, __HIP_MEMORY_SCOPE_AGENT); }
DI unsigned xb_xcc_id() { return (unsigned)__builtin_amdgcn_s_getreg((3 << 11) | 20) & 0x7u; }
DI void gbar(unsigned* bar, volatile LAS unsigned* st, int wv) {
    asm volatile("s_waitcnt vmcnt(0) lgkmcnt(0)" ::: "memory");
    __syncthreads();
    if (otid(wv) == 0) {
        const unsigned nloc = st[0], nx = st[1], x = st[2];
        const unsigned old = xb_add(&bar[XB_SUB(x)], 1u);
        const unsigned gen = old / nloc;
        if (old + 1u == (gen + 1u) * nloc) {
            __builtin_amdgcn_fence(__ATOMIC_RELEASE, "agent");
            asm volatile("s_waitcnt vmcnt(0)" ::: "memory");
            const unsigned og = xb_add(&bar[XB_TOP], 1u);
            const unsigned tg = og / nx;
            if (og + 1u == (tg + 1u) * nx) xb_add(&bar[XB_TOPGEN], 1u);
            else { while (xb_ld(&bar[XB_TOPGEN]) == tg) __builtin_amdgcn_s_sleep(1); }
            __builtin_amdgcn_fence(__ATOMIC_ACQUIRE, "agent");
            xb_add(&bar[XB_GEN(x)], 1u);
            asm volatile("s_waitcnt vmcnt(0)" ::: "memory");
        } else {
            while (xb_ld(&bar[XB_GEN(x)]) == gen) __builtin_amdgcn_s_sleep(1);
            __builtin_amdgcn_fence(__ATOMIC_ACQUIRE, "agent");
            asm volatile("s_waitcnt vmcnt(0)" ::: "memory");
        }
    }
    asm volatile("" ::: "memory");
    __syncthreads();
}
DI float sigmoidf_(float x) { return __builtin_amdgcn_rcpf(1.0f + __expf(-x)); }
DI float gelu_tanh(float x) { const float u = 1.5957691216f * (x + 0.044715f * x * x * x); return x * __builtin_amdgcn_rcpf(1.0f + __expf(-u)); }
#define LDS_WAIT() asm volatile("s_waitcnt lgkmcnt(0)" ::: "memory")
#define MFMA32(a, b, c) __builtin_amdgcn_mfma_f32_32x32x16_bf16((a), (b), (c), 0, 0, 0)
DI int crow(int reg, int h) { return (reg & 3) + 8 * (reg >> 2) + 4 * h; }
DI bf16x8 pack8(float a0, float a1, float a2, float a3, float a4, float a5, float a6, float a7) {
    u32x4 p; p.x = cvt_pk_bf16(a0, a1); p.y = cvt_pk_bf16(a2, a3); p.z = cvt_pk_bf16(a4, a5); p.w = cvt_pk_bf16(a6, a7);
    return __builtin_bit_cast(bf16x8, p);
}

namespace pg8 {
constexpr int BM = 256, BK = 64, HALF = 128, HTB = HALF * BK * 2, STAGE_BYTES = 8 * HTB, NXCD = 8, WGM = 8;
DI int lds_byte(int r, int c) { const int st = (r >> 4) * 2 + (c >> 5), rr = r & 15, cc = c & 31, ob = rr * 64 + cc * 2; return st * 1024 + (ob ^ (((ob >> 9) & 1) << 5)); }
DI void stage_rc(int b, int& R, int& C) { const int st = b / 1024, sb = b % 1024, swz = sb ^ (((sb >> 9) & 1) << 5); R = (st >> 1) * 16 + swz / 64; C = (st & 1) * 32 + (swz % 64) / 2; }
DI int perm32(int rho) { const int n = rho >> 4, i = rho & 15; return 8 * (i >> 2) + 4 * n + (i & 3); }
struct Unit { int pm, pn, sub; };
struct Gemm { const bf16_t* A; const bf16_t* Bt; int lda, K; int merge; const unsigned char* ws; };
struct TileOrder {
    int nM, nN, nwg, G, c, split, off0, off1, nsub;
    DI void init(int nM_, int nN_, int G_, int c_, int split_, int off0_, int off1_, int nsub_ = 1) { nM = nM_; nN = nN_; nwg = nM * nN; G = G_; c = c_; split = split_; off0 = off0_; off1 = off1_; nsub = nsub_; }
    DI bool next(int i0, Unit& u) const {
        const int i = i0 / nsub; u.sub = i0 - i * nsub;
        const long L = (long)i * G + c; if (L >= nwg) return false;
        int wgid = (int)L; { const int q = nwg / NXCD, r = nwg % NXCD, xcd = wgid % NXCD, off = wgid / NXCD; wgid = (xcd < r ? xcd * (q + 1) : r * (q + 1) + (xcd - r) * q) + off; }
        const int nig = WGM * nN, gid = wgid / nig, fm = gid * WGM, gsz = (nM - fm) < WGM ? (nM - fm) : WGM;
        u.pm = fm + ((wgid % nig) % gsz); const int pnv = (wgid % nig) / gsz; u.pn = pnv < split ? pnv + off0 : pnv - split + off1; return true;
    }
};

enum { EM_INPROJ = 0, EM_GATE = 1, EM_BR_FIRST = 2, EM_BR_MID = 3, EM_BR_LAST = 4, EM_RESID = 5, EM_UP = 6, EM_MERGE = 7 };
struct Epi {
    int mode;
    bf16_t *o0, *o1, *o2, *o3, *o4;
    float* f3;
    float* f0; const float* f1; const float* f2;
    const float *ropec, *ropes;
    DI void up_conv(const f32x4 (&acc)[2][2][4][2], const Unit& u, int wr, int wc, int fr, int fq) const {
        const int f = u.pn * 128 + wc * 32 + 8 * fq;
        const int src1 = (fq << 4) | ((fr + 15) & 15), src2 = (fq << 4) | ((fr + 14) & 15);
        const f32x4 w0a = *(const f32x4*)(f1 + f), w0b = *(const f32x4*)(f1 + f + 4), w1a = *(const f32x4*)(f1 + DFF + f), w1b = *(const f32x4*)(f1 + DFF + f + 4);
        const f32x4 w2a = *(const f32x4*)(f1 + 2 * DFF + f), w2b = *(const f32x4*)(f1 + 2 * DFF + f + 4), cba = *(const f32x4*)(f2 + f), cbb = *(const f32x4*)(f2 + f + 4);
#pragma unroll
        for (int ai = 0; ai < 2; ++ai) {
            const int q = u.pm * 4 + ai * 2 + wr;
            f32x4 p1a_prev = {0.f, 0.f, 0.f, 0.f}, p1b_prev = p1a_prev, p2a_prev = p1a_prev, p2b_prev = p1a_prev;
#pragma unroll
            for (int m = 0; m < 4; ++m) {
                const f32x4 aa = acc[ai][0][m][0], ab = acc[ai][0][m][1], ga = acc[ai][1][m][0], gb = acc[ai][1][m][1];
                f32x4 p1a, p1b, p2a, p2b;
#pragma unroll
                for (int j = 0; j < 4; ++j) {
                    p1a[j] = __shfl(aa[j], src1); p1b[j] = __shfl(ab[j], src1); p2a[j] = __shfl(aa[j], src2); p2b[j] = __shfl(ab[j], src2);
                }
                const f32x4 t1a = fr >= 1 ? p1a : p1a_prev, t1b = fr >= 1 ? p1b : p1b_prev, t2a = fr >= 2 ? p2a : p2a_prev, t2b = fr >= 2 ? p2b : p2b_prev;
                const f32x4 ca = cba + w0a * t2a + w1a * t1a + w2a * aa, cb_ = cbb + w0b * t2b + w1b * t1b + w2b * ab;
                const int row = u.pm * BM + ai * HALF + wr * 64 + m * 16 + fr;
                u32x4 w;
                w.x = cvt_pk_bf16(gelu_tanh(ca[0]) * ga[0], gelu_tanh(ca[1]) * ga[1]); w.y = cvt_pk_bf16(gelu_tanh(ca[2]) * ga[2], gelu_tanh(ca[3]) * ga[3]);
                w.z = cvt_pk_bf16(gelu_tanh(cb_[0]) * gb[0], gelu_tanh(cb_[1]) * gb[1]); w.w = cvt_pk_bf16(gelu_tanh(cb_[2]) * gb[2], gelu_tanh(cb_[3]) * gb[3]);
                *(u32x4*)(o0 + (size_t)row * DFF + f) = w;
                if (m == 0 && fr < 2) {
                    float* sa = f0 + ((size_t)q * 4 + fr) * DFF + f; *(f32x4*)sa = aa; *(f32x4*)(sa + 4) = ab;
                    float* sg = f3 + ((size_t)q * 2 + fr) * DFF + f; *(f32x4*)sg = ga; *(f32x4*)(sg + 4) = gb;
                }
                if (m == 3 && fr >= 14) { float* sa = f0 + ((size_t)q * 4 + 2 + (fr - 14)) * DFF + f; *(f32x4*)sa = aa; *(f32x4*)(sa + 4) = ab; }
                p1a_prev = p1a; p1b_prev = p1b; p2a_prev = p2a; p2b_prev = p2b;
            }
        }
    }
    DI void operator()(const f32x4 (&acc)[2][2][4][2], const Unit& u, int wr, int wc, int fr, int fq) const {
        if (mode == EM_UP) { up_conv(acc, u, wr, wc, fr, fq); return; }
        const int mode = (this->mode == EM_MERGE) ? (((u.sub & 1) == 0) ? (int)EM_GATE : ((u.sub >> 1) == 0 ? (int)EM_BR_FIRST : ((u.sub >> 1) == 1 ? (int)EM_BR_MID : (int)EM_BR_LAST))) : this->mode;
        const int row0 = u.pm * BM + wr * 64 + fr, colb = u.pn * BM + wc * 32 + 8 * fq;
        if (mode == EM_RESID) {
            const float* gv = f2 + (size_t)(row0 >> 12) * 6144 + colb;
            const f32x4 g00 = *(const f32x4*)gv, g01 = *(const f32x4*)(gv + 4), g10 = *(const f32x4*)(gv + HALF), g11 = *(const f32x4*)(gv + HALF + 4);
#pragma unroll
            for (int ai = 0; ai < 2; ++ai) {
                f32x4 b0[4][2], b1[4][2];
#pragma unroll
                for (int m = 0; m < 4; ++m)
#pragma unroll
                    for (int bj = 0; bj < 2; ++bj) { const size_t off = (size_t)(row0 + ai * HALF + m * 16) * 1024 + colb + bj * HALF; b0[m][bj] = *(const f32x4*)(f1 + off); b1[m][bj] = *(const f32x4*)(f1 + off + 4); }
                asm volatile("" ::: "memory");
#pragma unroll
                for (int m = 0; m < 4; ++m)
#pragma unroll
                    for (int bj = 0; bj < 2; ++bj) { const size_t off = (size_t)(row0 + ai * HALF + m * 16) * 1024 + colb + bj * HALF;
                        *(f32x4*)(f0 + off) = b0[m][bj] + (bj ? g10 : g00) * acc[ai][bj][m][0]; *(f32x4*)(f0 + off + 4) = b1[m][bj] + (bj ? g11 : g01) * acc[ai][bj][m][1]; }
            }
            return;
        }
        if (mode == EM_BR_FIRST || mode == EM_BR_MID || mode == EM_BR_LAST) {
#pragma unroll
            for (int ai = 0; ai < 2; ++ai) {
                u32x4 gw[4][2], pm[4][2];
#pragma unroll
                for (int m = 0; m < 4; ++m)
#pragma unroll
                    for (int bj = 0; bj < 2; ++bj) { const size_t off = (size_t)(row0 + ai * HALF + m * 16) * 1024 + colb + bj * HALF; gw[m][bj] = *(const u32x4*)(o0 + off);
                        pm[m][bj] = (u32x4){0u, 0u, 0u, 0u}; if (mode != EM_BR_FIRST) pm[m][bj] = *(const u32x4*)(o1 + off); }
                asm volatile("" ::: "memory");
#pragma unroll
                for (int m = 0; m < 4; ++m)
#pragma unroll
                    for (int bj = 0; bj < 2; ++bj) { const size_t off = (size_t)(row0 + ai * HALF + m * 16) * 1024 + colb + bj * HALF;
                        const f32x4 v0 = acc[ai][bj][m][0], v1 = acc[ai][bj][m][1]; const u32x4 g_ = gw[m][bj], q_ = pm[m][bj];
                        u32x4 w;
                        w.x = cvt_pk_bf16(bf_lo(g_.x) * v0[0] + bf_lo(q_.x), bf_hi(g_.x) * v0[1] + bf_hi(q_.x)); w.y = cvt_pk_bf16(bf_lo(g_.y) * v0[2] + bf_lo(q_.y), bf_hi(g_.y) * v0[3] + bf_hi(q_.y));
                        w.z = cvt_pk_bf16(bf_lo(g_.z) * v1[0] + bf_lo(q_.z), bf_hi(g_.z) * v1[1] + bf_hi(q_.z)); w.w = cvt_pk_bf16(bf_lo(g_.w) * v1[2] + bf_lo(q_.w), bf_hi(g_.w) * v1[3] + bf_hi(q_.w));
                        *(u32x4*)(o1 + off) = w; }
            }
            return;
        }
#pragma unroll
        for (int ai = 0; ai < 2; ++ai) {
            f32x4 csn[4][2], snn[4][2];
            if (mode == EM_INPROJ && u.pn < 4) {
#pragma unroll
                for (int m = 0; m < 4; ++m)
#pragma unroll
                    for (int bj = 0; bj < 2; ++bj) { const int pos = (row0 + ai * HALF + m * 16) & (SEQ - 1), e0 = ((colb + bj * HALF) & 63) >> 1;
                        csn[m][bj] = *(const f32x4*)(ropec + pos * 32 + e0); snn[m][bj] = *(const f32x4*)(ropes + pos * 32 + e0); }
                asm volatile("" ::: "memory");
            }
#pragma unroll
            for (int m = 0; m < 4; ++m) {
                const int row = row0 + ai * HALF + m * 16;
#pragma unroll
                for (int bj = 0; bj < 2; ++bj) {
                    const int col0 = colb + bj * HALF;
                    f32x4 v0 = acc[ai][bj][m][0], v1 = acc[ai][bj][m][1];
                    if (mode == EM_INPROJ) {
                        bf16_t* dst;
                        if (u.pn < 4) {
                            const f32x4 cs = csn[m][bj], sn = snn[m][bj];
                            f32x4 a, b;
                            a[0] = v0[0] * cs[0] - v0[1] * sn[0]; a[1] = v0[1] * cs[0] + v0[0] * sn[0];
                            a[2] = v0[2] * cs[1] - v0[3] * sn[1]; a[3] = v0[3] * cs[1] + v0[2] * sn[1];
                            b[0] = v1[0] * cs[2] - v1[1] * sn[2]; b[1] = v1[1] * cs[2] + v1[0] * sn[2];
                            b[2] = v1[2] * cs[3] - v1[3] * sn[3]; b[3] = v1[3] * cs[3] + v1[2] * sn[3];
                            v0 = a; v1 = b;
                            dst = (u.pn < 2) ? o0 + (size_t)row * 512 + col0 : o1 + (size_t)row * 512 + (col0 - 512);
                        } else if (u.pn < 6) { dst = o2 + (size_t)row * 512 + (col0 - 1024); }
                        else if (u.pn < 13) { dst = o3 + (size_t)row * RAWC + (col0 - 1536); }
                        else {
#pragma unroll
                            for (int j = 0; j < 4; ++j) { v0[j] = gelu_tanh(v0[j]); v1[j] = gelu_tanh(v1[j]); }
                            dst = o4 + (size_t)row * 1024 + (col0 - 3328);
                        }
                        u32x4 w; w.x = cvt_pk_bf16(v0[0], v0[1]); w.y = cvt_pk_bf16(v0[2], v0[3]); w.z = cvt_pk_bf16(v1[0], v1[1]); w.w = cvt_pk_bf16(v1[2], v1[3]);
                        *(u32x4*)dst = w;
                    } else {
#pragma unroll
                        for (int j = 0; j < 4; ++j) { v0[j] = sigmoidf_(v0[j]); v1[j] = sigmoidf_(v1[j]); }
                        u32x4 w; w.x = cvt_pk_bf16(v0[0], v0[1]); w.y = cvt_pk_bf16(v0[2], v0[3]); w.z = cvt_pk_bf16(v1[0], v1[1]); w.w = cvt_pk_bf16(v1[2], v1[3]);
                        *(u32x4*)(o0 + (size_t)row * 1024 + col0) = w;
                    }
                }
            }
        }
    }
};

DI void unit_operands(const Gemm& g, int sub, const char*& A, const char*& Bt, int& lda, int& K) {
    if (!g.merge) { A = (const char*)g.A; Bt = (const char*)g.Bt; lda = g.lda; K = g.K; return; }
    const int br = sub >> 1;
    if ((sub & 1) == 0) { A = (const char*)(g.ws + WS_H); Bt = (const char*)(g.ws + WS_WIN) + (size_t)(4352 + 1024 * br) * 1024 * 2; lda = 1024; K = 1024; }
    else { A = (const char*)(g.ws + (br == 0 ? WS_YSA : (br == 1 ? WS_YSR : WS_YSG))); Bt = (const char*)(g.ws + WS_WBR) + (size_t)br * 1024 * 512 * 2; lda = 512; K = 512; }
}
DI void gemm_phase(LAS unsigned char* lds, const Gemm g, const TileOrder S, const Epi E, int wv) {
    const int tid = otid(wv), wid = __builtin_amdgcn_readfirstlane(tid >> 6), lane = tid & 63, wr = wid >> 2, wc = wid & 3, fr = lane & 15, fq = lane >> 4;
    int stR[2], stC[2], stRb[2];
#pragma unroll
    for (int i = 0; i < 2; ++i) { int R, C; stage_rc(tid * 16 + i * 8192, R, C); stR[i] = R; stC[i] = C; stRb[i] = (R & ~31) + perm32(R & 31); }
    const size_t kstep = (size_t)(BK * 2);
    const unsigned ldsw = (unsigned)wid * 1024u;
    const int aoff = lds_byte(wr * 64 + fr, fq * 8), boff = lds_byte(wc * 32 + fr, fq * 8);
#define PG8_SA(b, h) (((b) * 2 + (h)) * HTB)
#define PG8_SB(b, h) ((4 + (b) * 2 + (h)) * HTB)
#define PG8_STAGE(bufoff, gbase, voff) do { _Pragma("unroll") for (int _i = 0; _i < 2; ++_i) \
        __builtin_amdgcn_global_load_lds((const unsigned*)((const char*)(gbase) + (voff)[_i]), (LAS unsigned*)(lds + (bufoff) + ldsw + _i * 8192), 16, 0, 0); } while (0)
#define PG8_LDA(dst, b, h) do { _Pragma("unroll") for (int m = 0; m < 4; ++m) _Pragma("unroll") for (int k = 0; k < 2; ++k) dst[m][k] = *(const LAS bf16x8*)(lds + PG8_SA(b, h) + aoff + m * 2048 + k * 1024); } while (0)
#define PG8_LDB(dst, b, h) do { _Pragma("unroll") for (int n = 0; n < 2; ++n) _Pragma("unroll") for (int k = 0; k < 2; ++k) dst[n][k] = *(const LAS bf16x8*)(lds + PG8_SB(b, h) + boff + n * 2048 + k * 1024); } while (0)
#define PG8_MMA(ai, bj, At, Bt) do { __builtin_amdgcn_s_setprio(1); _Pragma("unroll") for (int m = 0; m < 4; ++m) _Pragma("unroll") for (int n = 0; n < 2; ++n) _Pragma("unroll") for (int k = 0; k < 2; ++k) \
        acc[ai][bj][m][n] = __builtin_amdgcn_mfma_f32_16x16x32_bf16(Bt[n][k], At[m][k], acc[ai][bj][m][n], 0, 0, 0); __builtin_amdgcn_s_setprio(0); } while (0)
#define PG8_WAIT_V(n) asm volatile("s_waitcnt vmcnt(" #n ")" ::: "memory")
#define PG8_WAIT_L(n) asm volatile("s_waitcnt lgkmcnt(" #n ")" ::: "memory")
#define PG8_BAR __builtin_amdgcn_s_barrier()
#define PG8_SCHED __builtin_amdgcn_sched_barrier(0)
#define PG8_SETUP(u, pA, pB, vA, vB, hA, hB, ntv) do { const char* _A; const char* _B; int _lda, _K; unit_operands(g, (u).sub, _A, _B, _lda, _K); \
        pA = _A + (size_t)(u).pm * 256 * _lda * 2; pB = _B + (size_t)(u).pn * 256 * _K * 2; hA = (size_t)HALF * _lda * 2; hB = (size_t)HALF * _K * 2; ntv = _K / BK; \
        _Pragma("unroll") for (int _i = 0; _i < 2; ++_i) { vA[_i] = (unsigned)(stR[_i] * _lda + stC[_i]) * 2u; vB[_i] = (unsigned)(stRb[_i] * _K + stC[_i]) * 2u; } } while (0)
    Unit cur, nxt; int ui = 0;
    if (!S.next(0, cur)) return;
    f32x4 acc[2][2][4][2];
#pragma unroll
    for (int a = 0; a < 2; ++a)
#pragma unroll
        for (int b = 0; b < 2; ++b)
#pragma unroll
            for (int m = 0; m < 4; ++m)
#pragma unroll
                for (int n = 0; n < 2; ++n) acc[a][b][m][n] = (f32x4){0.f, 0.f, 0.f, 0.f};
    bf16x8 At[4][2], B0[2][2], B1[2][2];
    const char *cA, *cB, *nA, *nB; unsigned vAc[2], vBc[2], vAn[2], vBn[2]; size_t hAc, hBc, hAn, hBn; int nt, ntn;
    PG8_SETUP(cur, cA, cB, vAc, vBc, hAc, hBc, nt);
    PG8_STAGE(PG8_SB(0, 0), cB, vBc); PG8_STAGE(PG8_SA(0, 0), cA, vAc); PG8_STAGE(PG8_SB(0, 1), cB + hBc, vBc); PG8_STAGE(PG8_SA(0, 1), cA + hAc, vAc);
    if (wr == 1) PG8_BAR;
    PG8_WAIT_V(4); PG8_BAR;
    PG8_STAGE(PG8_SB(1, 0), cB + kstep, vBc); PG8_STAGE(PG8_SA(1, 0), cA + kstep, vAc); PG8_STAGE(PG8_SB(1, 1), cB + hBc + kstep, vBc);
    PG8_WAIT_V(6); PG8_BAR;
    for (;;) {
        const bool has_next = S.next(ui + 1, nxt);
        if (has_next) { PG8_SETUP(nxt, nA, nB, vAn, vBn, hAn, hBn, ntn); }
        else { nA = cA; nB = cB; vAn[0] = vAc[0]; vAn[1] = vAc[1]; vBn[0] = vBc[0]; vBn[1] = vBc[1]; hAn = hAc; hBn = hBc; ntn = nt; }
        for (int t = 0; t < nt; t += 2) {
            const bool last = (t == nt - 2);
            const char* a1 = cA + (size_t)(t + 1) * kstep;
            const char* a2 = last ? nA : cA + (size_t)(t + 2) * kstep; const char* b2 = last ? nB : cB + (size_t)(t + 2) * kstep;
            const char* a3 = a2 + kstep; const char* b3 = b2 + kstep;
            unsigned vA2[2], vB2[2]; vA2[0] = last ? vAn[0] : vAc[0]; vA2[1] = last ? vAn[1] : vAc[1]; vB2[0] = last ? vBn[0] : vBc[0]; vB2[1] = last ? vBn[1] : vBc[1];
            const size_t hA2 = last ? hAn : hAc, hB2 = last ? hBn : hBc;
            PG8_LDB(B0, 0, 0); PG8_SCHED; PG8_LDA(At, 0, 0); PG8_STAGE(PG8_SA(1, 1), a1 + hAc, vAc);
            PG8_WAIT_L(8); PG8_BAR; PG8_WAIT_L(0); PG8_MMA(0, 0, At, B0); PG8_BAR; PG8_SCHED;
            PG8_LDB(B1, 0, 1); PG8_STAGE(PG8_SB(0, 0), b2, vB2);
            PG8_BAR; PG8_WAIT_L(0); PG8_MMA(0, 1, At, B1); PG8_BAR;
            PG8_LDA(At, 0, 1); PG8_STAGE(PG8_SA(0, 0), a2, vA2);
            PG8_BAR; PG8_WAIT_L(0); PG8_MMA(1, 0, At, B0); PG8_BAR; PG8_SCHED;
            PG8_STAGE(PG8_SB(0, 1), b2 + hB2, vB2);
            PG8_WAIT_V(6); PG8_BAR; PG8_MMA(1, 1, At, B1); PG8_BAR;
            PG8_LDB(B0, 1, 0); PG8_SCHED; PG8_LDA(At, 1, 0); PG8_STAGE(PG8_SA(0, 1), a2 + hA2, vA2);
            PG8_WAIT_L(8); PG8_BAR; PG8_WAIT_L(0); PG8_MMA(0, 0, At, B0); PG8_BAR; PG8_SCHED;
            PG8_LDB(B1, 1, 1); PG8_STAGE(PG8_SB(1, 0), b3, vB2);
            PG8_BAR; PG8_WAIT_L(0); PG8_MMA(0, 1, At, B1); PG8_BAR;
            PG8_LDA(At, 1, 1); PG8_STAGE(PG8_SA(1, 0), a3, vA2);
            PG8_BAR; PG8_WAIT_L(0); PG8_MMA(1, 0, At, B0); PG8_BAR; PG8_SCHED;
            PG8_STAGE(PG8_SB(1, 1), b3 + hB2, vB2);
            PG8_WAIT_V(6); PG8_BAR; PG8_MMA(1, 1, At, B1); PG8_BAR;
        }
        E(acc, cur, wr, wc, fr, fq);
        if (!has_next) break;
#pragma unroll
        for (int a = 0; a < 2; ++a)
#pragma unroll
            for (int b = 0; b < 2; ++b)
#pragma unroll
                for (int m = 0; m < 4; ++m)
#pragma unroll
                    for (int n = 0; n < 2; ++n) acc[a][b][m][n] = (f32x4){0.f, 0.f, 0.f, 0.f};
        cur = nxt; cA = nA; cB = nB; vAc[0] = vAn[0]; vAc[1] = vAn[1]; vBc[0] = vBn[0]; vBc[1] = vBn[1]; hAc = hAn; hBc = hBn; nt = ntn; ++ui;
    }
    PG8_WAIT_V(0);
    if (wr == 0) PG8_BAR;
    PG8_BAR;
#undef PG8_SA
#undef PG8_SB
#undef PG8_STAGE
#undef PG8_LDA
#undef PG8_LDB
#undef PG8_MMA
#undef PG8_WAIT_V
#undef PG8_WAIT_L
#undef PG8_BAR
#undef PG8_SCHED
#undef PG8_SETUP
}
}

template <int PERMK>
DI void transpose_item(const float* W, int K, int N, bf16_t* WT, LAS float* scr, int item, int lane) {
    const int nblk = N / 32, kb = item / nblk, nb = item % nblk, k0 = 64 * kb, n0 = 32 * nb;
    int sc = n0 + (lane & 31);
    if (PERMK == 1 && sc < 1024) { const int hd = sc >> 6, cp = sc & 63; sc = hd * 64 + 32 * (cp & 1) + (cp >> 1); }
    if (PERMK == 2) { const int tl = sc >> 8, w = sc & 255; sc = (w < 128) ? (128 * tl + w) : (DFF + 128 * tl + (w - 128)); }
#pragma unroll 8
    for (int i = 0; i < 32; ++i) { const int kk = 2 * i + (lane >> 5); scr[kk * 33 + (lane & 31)] = W[(size_t)(k0 + kk) * N + sc]; }
    LDS_WAIT();
    const int c = lane & 7;
#pragma unroll
    for (int j = 0; j < 4; ++j) { const int n = (lane >> 3) + 8 * j; const LAS float* s = scr + (8 * c) * 33 + n;
        u32x4 o; o.x = cvt_pk_bf16(s[0 * 33], s[1 * 33]); o.y = cvt_pk_bf16(s[2 * 33], s[3 * 33]); o.z = cvt_pk_bf16(s[4 * 33], s[5 * 33]); o.w = cvt_pk_bf16(s[6 * 33], s[7 * 33]);
        *(u32x4*)(WT + (size_t)(n0 + n) * K + k0 + 8 * c) = o; }
    LDS_WAIT();
}

DI void convert_weights(KP p, int l, LAS unsigned char* lds, int wv) {
    const int tid_ = otid(wv); const int wave = tid_ >> 6, lane = tid_ & 63;
    LAS float* scr = (LAS float*)(lds + wave * 8448);
    const int gw = blockIdx.x * 8 + wave, NGW = gridDim.x * 8;
    constexpr int I_IN = 16 * (INC / 32), I_BR = 8 * 32, I_OUT = 16 * 32, I_UP = 16 * (UPC / 32), I_DN = (DFF / 64) * 32, I_L64 = 16, I_L128 = 32;
    constexpr int NIT = I_IN + 3 * I_BR + I_OUT + I_UP + I_DN + 2 * I_L64 + I_L128;
    unsigned char* ws = ows(p->ws);
    for (int it = gw; it < NIT; it += NGW) {
        int r = it;
        if (r < I_IN) { transpose_item<1>(p->in[5] + (size_t)l * 1024 * INC, 1024, INC, (bf16_t*)(ws + WS_WIN), scr, r, lane); continue; } r -= I_IN;
        if (r < 3 * I_BR) { const int b = r / I_BR; transpose_item<0>(p->in[21] + ((size_t)l * 3 + b) * 512 * 1024, 512, 1024, (bf16_t*)(ws + WS_WBR) + (size_t)b * 1024 * 512, scr, r % I_BR, lane); continue; } r -= 3 * I_BR;
        if (r < I_OUT) { transpose_item<0>(p->in[22] + (size_t)l * 1024 * 1024, 1024, 1024, (bf16_t*)(ws + WS_WOUT), scr, r, lane); continue; } r -= I_OUT;
        if (r < I_UP) { transpose_item<2>(p->in[24] + (size_t)l * 1024 * UPC, 1024, UPC, (bf16_t*)(ws + WS_WUP), scr, r, lane); continue; } r -= I_UP;
        if (r < I_DN) { transpose_item<0>(p->in[27] + (size_t)l * DFF * 1024, DFF, 1024, (bf16_t*)(ws + WS_WDN), scr, r, lane); continue; } r -= I_DN;
        if (r < I_L64) { transpose_item<0>(p->in[8] + (size_t)l * 64 * 512, 64, 512, (bf16_t*)(ws + WS_LWU), scr, r, lane); continue; } r -= I_L64;
        if (r < I_L64) { transpose_item<0>(p->in[10] + (size_t)l * 64 * 512, 64, 512, (bf16_t*)(ws + WS_LAU), scr, r, lane); continue; } r -= I_L64;
        transpose_item<0>(p->in[11] + (size_t)l * 128 * 512, 128, 512, (bf16_t*)(ws + WS_LGU), scr, r, lane);
    }
}

DI void phase0(KP p, LAS unsigned char* lds, int wv) {
    const int tid = otid(wv);
    float* ropec = (float*)(p->ws + WS_ROPEC); float* ropes = (float*)(p->ws + WS_ROPES);
    for (int idx = blockIdx.x * 512 + tid; idx < SEQ * 32; idx += gridDim.x * 512) {
        const int pos = idx >> 5, e = idx & 31;
        const float inv = 1.0f / exp2f((float)e * (13.287712379549449f / 32.0f));
        const float ang = (float)pos * inv;
        double rev = (double)ang * 0.15915494309189535; rev -= rint(rev);
        const float rv = (float)rev;
        ropec[idx] = __builtin_amdgcn_cosf(rv); ropes[idx] = __builtin_amdgcn_sinf(rv);
    }
    {
        LAS float* ca = (LAS float*)lds;
        LAS float* red = (LAS float*)(lds + 16384);
        float* mod = (float*)(p->ws + WS_MOD);
        bool loaded = false;
        for (int item = blockIdx.x; item < 192; item += gridDim.x) {
            if (!loaded) { for (int i = tid; i < 4096; i += 512) { const float v = p->in[1][i]; ca[i] = v / (1.0f + __expf(-v)); } loaded = true; __syncthreads(); }
            const int l = item / 96, c0 = (item % 96) * 64, cc = tid & 63, kg = tid >> 6;
            const float* w = p->in[2] + (size_t)l * 1024 * 6144 + c0 + cc;
            float a0 = 0.f, a1 = 0.f, a2 = 0.f, a3 = 0.f;
#pragma unroll 8
            for (int k = kg * 128; k < kg * 128 + 128; ++k) { const float wv = w[(size_t)k * 6144]; a0 += ca[k] * wv; a1 += ca[1024 + k] * wv; a2 += ca[2048 + k] * wv; a3 += ca[3072 + k] * wv; }
            red[(kg * 4 + 0) * 64 + cc] = a0; red[(kg * 4 + 1) * 64 + cc] = a1; red[(kg * 4 + 2) * 64 + cc] = a2; red[(kg * 4 + 3) * 64 + cc] = a3;
            __syncthreads();
            if (tid < 256) { const int b = tid >> 6; float s = 0.f;
#pragma unroll
                for (int g = 0; g < 8; ++g) s += red[(g * 4 + b) * 64 + cc];
                mod[((size_t)l * 4 + b) * 6144 + c0 + cc] = s + p->in[3][(size_t)l * 6144 + c0 + cc]; }
            __syncthreads();
        }
        __syncthreads();
    }
    convert_weights(p, 0, lds, wv);
}

DI void norm_mod_phase(const float* x, const float* g, const float* sh, const float* sc, bf16_t* H, int wv) {
    const int tid_ = otid(wv); const int wave = tid_ >> 6, lane = tid_ & 63;
    for (int row0 = (blockIdx.x * 8 + wave) * 2; row0 < MTOK; row0 += gridDim.x * 16) {
        f32x4 v[2][4]; float s[2] = {0.f, 0.f};
#pragma unroll
        for (int q = 0; q < 2; ++q) { const f32x4* xr = (const f32x4*)(x + (size_t)(row0 + q) * DM) + lane;
#pragma unroll
            for (int j = 0; j < 4; ++j) v[q][j] = xr[64 * j]; }
#pragma unroll
        for (int q = 0; q < 2; ++q)
#pragma unroll
            for (int j = 0; j < 4; ++j) s[q] += (v[q][j][0] * v[q][j][0] + v[q][j][1] * v[q][j][1]) + (v[q][j][2] * v[q][j][2] + v[q][j][3] * v[q][j][3]);
        const float rs0 = rsqrtf(wave_sum(s[0]) * (1.0f / DM) + 1e-6f), rs1 = rsqrtf(wave_sum(s[1]) * (1.0f / DM) + 1e-6f);
        const int b = row0 >> 12;
#pragma unroll
        for (int j = 0; j < 4; ++j) {
            const int c = 4 * lane + 256 * j;
            const f32x4 gg = *(const f32x4*)(g + c), s1 = *(const f32x4*)(sc + (size_t)b * 6144 + c), s0 = *(const f32x4*)(sh + (size_t)b * 6144 + c);
#pragma unroll
            for (int q = 0; q < 2; ++q) {
                const f32x4 h = (v[q][j] * (q ? rs1 : rs0) * gg) * (s1 + 1.0f) + s0;
                u32x2 w; w.x = cvt_pk_bf16(h[0], h[1]); w.y = cvt_pk_bf16(h[2], h[3]);
                *((u32x2*)(H + (size_t)(row0 + q) * DM) + lane + 64 * j) = w;
            }
        }
    }
}
DI void final_norm_phase(float* x, const float* g, int wv) {
    const int tid_ = otid(wv); const int wave = tid_ >> 6, lane = tid_ & 63;
    for (int row = blockIdx.x * 8 + wave; row < MTOK; row += gridDim.x * 8) {
        f32x4* xr = (f32x4*)(x + (size_t)row * DM) + lane;
        f32x4 v[4]; float s = 0.f;
#pragma unroll
        for (int j = 0; j < 4; ++j) { v[j] = xr[64 * j]; s += (v[j][0] * v[j][0] + v[j][1] * v[j][1]) + (v[j][2] * v[j][2] + v[j][3] * v[j][3]); }
        const float rs = rsqrtf(wave_sum(s) * (1.0f / DM) + 1e-6f);
#pragma unroll
        for (int j = 0; j < 4; ++j) { const f32x4 gg = *(const f32x4*)(g + 4 * lane + 256 * j); xr[64 * j] = v[j] * rs * gg; }
    }
}

DI bf16x8 lerp_frag(const bf16_t* cur, const bf16_t* prv, bool hasprev, const float* mu, int act) {
    const u32x4 c = *(const u32x4*)cur; u32x4 q = {0u, 0u, 0u, 0u}; if (hasprev) q = *(const u32x4*)prv;
    const f32x4 m0 = *(const f32x4*)mu, m1 = *(const f32x4*)(mu + 4);
    float z[8];
    const unsigned cw[4] = {c.x, c.y, c.z, c.w}, qw[4] = {q.x, q.y, q.z, q.w};
#pragma unroll
    for (int j = 0; j < 4; ++j) {
        const float c0 = bf_lo(cw[j]), c1 = bf_hi(cw[j]), p0 = bf_lo(qw[j]), p1 = bf_hi(qw[j]);
        const float mA = (j < 2) ? m0[2 * j] : m1[2 * j - 4], mB = (j < 2) ? m0[2 * j + 1] : m1[2 * j - 3];
        z[2 * j] = c0 + (p0 - c0) * mA; z[2 * j + 1] = c1 + (p1 - c1) * mB;
    }
#pragma unroll
    for (int j = 0; j < 8; ++j) {
        if (act == 1) { const float e = __expf(2.0f * z[j]); z[j] = 1.0f - 2.0f / (1.0f + e); }
        else if (act == 2) z[j] = sigmoidf_(z[j]);
    }
    return pack8(z[0], z[1], z[2], z[3], z[4], z[5], z[6], z[7]);
}

DI void rwkv_derived_phase(KP p0, int l, LAS unsigned char* lds, int wv) {
    const int tid_ = otid(wv); const int wave = tid_ >> 6, lane = tid_ & 63, r = lane & 31, hh = lane >> 5;
    LAS float* lp = (LAS float*)(lds + wave * 2048);
    {
        const int ch = wave * 64 + lane;
        lp[0 * 64 + lane] = p0->in[6][(size_t)l * RAWC + ch]; lp[1 * 64 + lane] = p0->in[6][(size_t)l * RAWC + 512 + ch]; lp[2 * 64 + lane] = p0->in[6][(size_t)l * RAWC + 1024 + ch];
        lp[3 * 64 + lane] = p0->in[7][l * 512 + ch]; lp[4 * 64 + lane] = p0->in[9][l * 512 + ch]; lp[5 * 64 + lane] = p0->in[12][l * 512 + ch];
        lp[6 * 64 + lane] = p0->in[13][l * 512 + ch]; lp[7 * 64 + lane] = p0->in[14][l * 512 + ch];
        LDS_WAIT();
    }
    for (int job = blockIdx.x * 8 + wave; job < 512 * 8; job += gridDim.x * 8) {
        KP p = okp(); unsigned char* ws = ows(p->ws);
        const bf16_t* RAW = (const bf16_t*)(ws + WS_RAW);
        bf16_t *RZ = (bf16_t*)(ws + WS_RZ), *KP = (bf16_t*)(ws + WS_KP), *VZ = (bf16_t*)(ws + WS_VZ), *KKN = (bf16_t*)(ws + WS_KKN), *Bv = (bf16_t*)(ws + WS_B), *G = (bf16_t*)(ws + WS_G);
        float* W = (float*)(ws + WS_W);
        const bf16_t *LWU = (const bf16_t*)(ws + WS_LWU), *LAU = (const bf16_t*)(ws + WS_LAU), *LGU = (const bf16_t*)(ws + WS_LGU);
        const float* mu = p->in[6] + (size_t)l * RAWC; const float* w0 = p->in[7] + l * 512; const float* a0 = p->in[9] + l * 512;
        const float* k_k = p->in[12] + l * 512; const float* k_a = p->in[13] + l * 512; const float* r_k = p->in[14] + l * 512;
        const int hd = job & 7, tg = job >> 3, t = tg * 32 + r;
        const bool hp = (t & (SEQ - 1)) != 0;
        const bf16_t* cur = RAW + (size_t)t * RAWC; const bf16_t* prv = cur - RAWC;
        float ss = 0.f;
#pragma unroll
        for (int q = 0; q < 8; ++q) {
            const int c = hd * 64 + 8 * q + 4 * hh;
            const u32x2 kc = *(const u32x2*)(cur + 512 + c); u32x2 kq = {0u, 0u}; if (hp) kq = *(const u32x2*)(prv + 512 + c);
            const f32x4 mk = *(const LAS f32x4*)(lp + 1 * 64 + 8 * q + 4 * hh), kkw = *(const LAS f32x4*)(lp + 5 * 64 + 8 * q + 4 * hh);
            const float kcur[4] = {bf_lo(kc.x), bf_hi(kc.x), bf_lo(kc.y), bf_hi(kc.y)}, kprv[4] = {bf_lo(kq.x), bf_hi(kq.x), bf_lo(kq.y), bf_hi(kq.y)};
#pragma unroll
            for (int j = 0; j < 4; ++j) { const float kk = (kcur[j] + (kprv[j] - kcur[j]) * mk[j]) * kkw[j]; ss += kk * kk; }
        }
        ss += __shfl_xor(ss, 32);
        const float inv = 1.0f / fmaxf(sqrtf(ss), 1e-12f);
        float bonus = 0.f;
        {
            bf16x8 bw[4], ba[4];
#pragma unroll
            for (int s = 0; s < 4; ++s) { const int o = 16 * s + 8 * hh; bw[s] = lerp_frag(cur + 1536 + o, prv + 1536 + o, hp, mu + 1536 + o, 1); ba[s] = lerp_frag(cur + 1600 + o, prv + 1600 + o, hp, mu + 1600 + o, 0); }
#pragma unroll 1
            for (int mt = 0; mt < 2; ++mt) {
                const int chr = hd * 64 + 32 * mt + r;
                f32x16 aw, aa;
#pragma unroll
                for (int i = 0; i < 16; ++i) { aw[i] = 0.f; aa[i] = 0.f; }
                {
                    typedef const __attribute__((address_space(1))) bf16x8* GP8;
                    const GP8 pw = (GP8)(LWU + (size_t)chr * 64 + 8 * hh), pa = (GP8)(LAU + (size_t)chr * 64 + 8 * hh);
                    bf16x8 fw[4], fa[4];
#pragma unroll
                    for (int s = 0; s < 4; ++s) { fw[s] = pw[2 * s]; fa[s] = pa[2 * s]; }
                    asm volatile("" ::: "memory");
#pragma unroll
                    for (int s = 0; s < 4; ++s) { aw = MFMA32(fw[s], bw[s], aw); aa = MFMA32(fa[s], ba[s], aa); }
                }
                u32x2 rcA[4], kcA[4], vcA[4], rpA[4], kqA[4], vpA[4];
#pragma unroll
                for (int i4 = 0; i4 < 4; ++i4) {
                    const int c = hd * 64 + 32 * mt + 8 * i4 + 4 * hh;
                    rcA[i4] = *(const u32x2*)(cur + c); kcA[i4] = *(const u32x2*)(cur + 512 + c); vcA[i4] = *(const u32x2*)(cur + 1024 + c);
                    rpA[i4] = (u32x2){0u, 0u}; kqA[i4] = (u32x2){0u, 0u}; vpA[i4] = (u32x2){0u, 0u};
                    if (hp) { rpA[i4] = *(const u32x2*)(prv + c); kqA[i4] = *(const u32x2*)(prv + 512 + c); vpA[i4] = *(const u32x2*)(prv + 1024 + c); }
                }
                asm volatile("" ::: "memory");
#pragma unroll
                for (int i4 = 0; i4 < 4; ++i4) {
                    const int c = hd * 64 + 32 * mt + 8 * i4 + 4 * hh;
                    const u32x2 rc = rcA[i4], kc = kcA[i4], vc = vcA[i4], rp = rpA[i4], kq = kqA[i4], vp = vpA[i4];
                    const int cl = 32 * mt + 8 * i4 + 4 * hh;
                    const f32x4 mr = *(const LAS f32x4*)(lp + cl), mk = *(const LAS f32x4*)(lp + 64 + cl), mv = *(const LAS f32x4*)(lp + 128 + cl);
                    const f32x4 w0v = *(const LAS f32x4*)(lp + 192 + cl), a0v = *(const LAS f32x4*)(lp + 256 + cl), kkw = *(const LAS f32x4*)(lp + 320 + cl), kaw = *(const LAS f32x4*)(lp + 384 + cl), rkw = *(const LAS f32x4*)(lp + 448 + cl);
                    const float rcur[4] = {bf_lo(rc.x), bf_hi(rc.x), bf_lo(rc.y), bf_hi(rc.y)}, rprv[4] = {bf_lo(rp.x), bf_hi(rp.x), bf_lo(rp.y), bf_hi(rp.y)};
                    const float kcur[4] = {bf_lo(kc.x), bf_hi(kc.x), bf_lo(kc.y), bf_hi(kc.y)}, kprv[4] = {bf_lo(kq.x), bf_hi(kq.x), bf_lo(kq.y), bf_hi(kq.y)};
                    const float vcur[4] = {bf_lo(vc.x), bf_hi(vc.x), bf_lo(vc.y), bf_hi(vc.y)}, vprv[4] = {bf_lo(vp.x), bf_hi(vp.x), bf_lo(vp.y), bf_hi(vp.y)};
                    f32x4 dec; float rz[4], kp[4], vz[4], kn[4], bb[4];
#pragma unroll
                    for (int j = 0; j < 4; ++j) {
                        const int i = 4 * i4 + j;
                        const float zz = -(w0v[j] + aw[i]);
                        const float sp = (zz > 20.f) ? zz : __logf(1.0f + __expf(zz));
                        const float wv = -sp - 0.5f;
                        dec[j] = __expf(-__expf(wv));
                        const float av = sigmoidf_(a0v[j] + aa[i]);
                        rz[j] = rcur[j] + (rprv[j] - rcur[j]) * mr[j];
                        const float kz = kcur[j] + (kprv[j] - kcur[j]) * mk[j];
                        vz[j] = vcur[j] + (vprv[j] - vcur[j]) * mv[j];
                        kn[j] = kz * kkw[j] * inv; bb[j] = kn[j] * av;
                        kp[j] = kz * (1.0f + (av - 1.0f) * kaw[j]);
                        bonus += rz[j] * kp[j] * rkw[j];
                    }
                    const size_t o = (size_t)t * 512 + c;
                    *(f32x4*)(W + o) = dec;
                    u32x2 w2; w2.x = cvt_pk_bf16(rz[0], rz[1]); w2.y = cvt_pk_bf16(rz[2], rz[3]); *(u32x2*)(RZ + o) = w2;
                    w2.x = cvt_pk_bf16(kp[0], kp[1]); w2.y = cvt_pk_bf16(kp[2], kp[3]); *(u32x2*)(KP + o) = w2;
                    w2.x = cvt_pk_bf16(vz[0], vz[1]); w2.y = cvt_pk_bf16(vz[2], vz[3]); *(u32x2*)(VZ + o) = w2;
                    w2.x = cvt_pk_bf16(kn[0], kn[1]); w2.y = cvt_pk_bf16(kn[2], kn[3]); *(u32x2*)(KKN + o) = w2;
                    w2.x = cvt_pk_bf16(bb[0], bb[1]); w2.y = cvt_pk_bf16(bb[2], bb[3]); *(u32x2*)(Bv + o) = w2;
                }
            }
        }
        bonus += __shfl_xor(bonus, 32);
        int t2 = t; asm volatile("" : "+v"(t2));
        if (hh == 0) ((float*)(ows(ws) + WS_BONUS))[(size_t)t2 * 8 + hd] = bonus;
        {
            bf16x8 bg[8];
#pragma unroll
            for (int s = 0; s < 8; ++s) { const int o = 16 * s + 8 * hh; bg[s] = lerp_frag(cur + 1664 + o, prv + 1664 + o, hp, mu + 1664 + o, 2); }
#pragma unroll 1
            for (int mt = 0; mt < 2; ++mt) {
                const int chr = hd * 64 + 32 * mt + r;
                f32x16 ag;
#pragma unroll
                for (int i = 0; i < 16; ++i) ag[i] = 0.f;
                {
                    typedef const __attribute__((address_space(1))) bf16x8* GP8;
                    const GP8 pg = (GP8)(LGU + (size_t)chr * 128 + 8 * hh);
                    bf16x8 fg[8];
#pragma unroll
                    for (int s = 0; s < 8; ++s) fg[s] = pg[2 * s];
                    asm volatile("" ::: "memory");
#pragma unroll
                    for (int s = 0; s < 8; ++s) ag = MFMA32(fg[s], bg[s], ag);
                }
#pragma unroll
                for (int i4 = 0; i4 < 4; ++i4) {
                    const size_t o = (size_t)t2 * 512 + hd * 64 + 32 * mt + 8 * i4 + 4 * hh;
                    u32x2 w2; w2.x = cvt_pk_bf16(ag[4 * i4], ag[4 * i4 + 1]); w2.y = cvt_pk_bf16(ag[4 * i4 + 2], ag[4 * i4 + 3]); *(u32x2*)(G + o) = w2;
                }
            }
        }
    }
}

constexpr int SC_T = 32, SC_STEP = 1344, SC_BUF = SC_T * SC_STEP;
struct ScanRegs { f32x4 w0, w1; u32x4 kn, bb, kp, rz, vv; };
DI void scan_gload(KP p, ScanRegs& R, int b, int h, int rg, int ck, int pt) {
    const unsigned char* ws = ows(p->ws);
    const size_t tok0 = (size_t)b * SEQ + (size_t)ck * SC_T;
    { const int st = pt >> 4, sub = pt & 15; R.w0 = *(const f32x4*)((const float*)(ws + WS_W) + (tok0 + st) * 512 + h * 64 + 4 * sub); }
    { const int pp = pt + 256, st = pp >> 4, sub = pp & 15; R.w1 = *(const f32x4*)((const float*)(ws + WS_W) + (tok0 + st) * 512 + h * 64 + 4 * sub); }
    const int st = pt >> 3, sub = pt & 7; const size_t go = (tok0 + st) * 512 + h * 64 + 8 * sub;
    R.kn = *(const u32x4*)((const bf16_t*)(ws + WS_KKN) + go); R.bb = *(const u32x4*)((const bf16_t*)(ws + WS_B) + go);
    R.kp = *(const u32x4*)((const bf16_t*)(ws + WS_KP) + go); R.rz = *(const u32x4*)((const bf16_t*)(ws + WS_RZ) + go);
    R.vv = (u32x4){0u, 0u, 0u, 0u};
    if (pt < 64) { const int s2 = pt >> 1, hf = pt & 1; R.vv = *(const u32x4*)((const bf16_t*)(ws + WS_VZ) + (tok0 + s2) * 512 + h * 64 + rg * 16 + 8 * hf); }
}
DI void scan_write(const ScanRegs& R, LAS unsigned char* buf, int pt) {
    { const int st = pt >> 4, sub = pt & 15; *(LAS f32x4*)(buf + st * SC_STEP + sub * 16) = R.w0; }
    { const int pp = pt + 256, st = pp >> 4, sub = pp & 15; *(LAS f32x4*)(buf + st * SC_STEP + sub * 16) = R.w1; }
    const int st = pt >> 3, sub = pt & 7;
    const u32x4 kn = R.kn, bb = R.bb, kp = R.kp, rz = R.rz;
    LAS unsigned char* d = buf + st * SC_STEP + sub * 32;
    *(LAS f32x4*)(d + 256) = (f32x4){-bf_lo(kn.x), -bf_hi(kn.x), -bf_lo(kn.y), -bf_hi(kn.y)}; *(LAS f32x4*)(d + 256 + 16) = (f32x4){-bf_lo(kn.z), -bf_hi(kn.z), -bf_lo(kn.w), -bf_hi(kn.w)};
    *(LAS f32x4*)(d + 512) = (f32x4){bf_lo(bb.x), bf_hi(bb.x), bf_lo(bb.y), bf_hi(bb.y)}; *(LAS f32x4*)(d + 512 + 16) = (f32x4){bf_lo(bb.z), bf_hi(bb.z), bf_lo(bb.w), bf_hi(bb.w)};
    *(LAS f32x4*)(d + 768) = (f32x4){bf_lo(kp.x), bf_hi(kp.x), bf_lo(kp.y), bf_hi(kp.y)}; *(LAS f32x4*)(d + 768 + 16) = (f32x4){bf_lo(kp.z), bf_hi(kp.z), bf_lo(kp.w), bf_hi(kp.w)};
    *(LAS f32x4*)(d + 1024) = (f32x4){bf_lo(rz.x), bf_hi(rz.x), bf_lo(rz.y), bf_hi(rz.y)}; *(LAS f32x4*)(d + 1024 + 16) = (f32x4){bf_lo(rz.z), bf_hi(rz.z), bf_lo(rz.w), bf_hi(rz.w)};
    if (pt < 64) { const int s2 = pt >> 1, hf = pt & 1; const u32x4 vv = R.vv;
        LAS unsigned char* dv = buf + s2 * SC_STEP + 1280 + hf * 32;
        *(LAS f32x4*)dv = (f32x4){bf_lo(vv.x), bf_hi(vv.x), bf_lo(vv.y), bf_hi(vv.y)}; *(LAS f32x4*)(dv + 16) = (f32x4){bf_lo(vv.z), bf_hi(vv.z), bf_lo(vv.w), bf_hi(vv.w)}; }
}
DI void rwkv_scan_phase(KP p, LAS unsigned char* lds, int wv) {
    const int tid = otid(wv), wave = tid >> 6, lane = tid & 63;
    float* YRAW = (float*)(p->ws + WS_YRAW);
    for (int job = blockIdx.x; job < 128; job += gridDim.x) {
        const int jx = job & 7, jk = job >> 3;
        const int chain = jx + 8 * (jk >> 2), rg = jk & 3, b = chain >> 3, h = chain & 7;
        __syncthreads();
        ScanRegs R0, R1;
        if (wave >= 4) { scan_gload(p, R0, b, h, rg, 0, tid - 256); scan_write(R0, lds, tid - 256); scan_gload(p, R0, b, h, rg, 1, tid - 256); scan_gload(p, R1, b, h, rg, 2, tid - 256); }
        __syncthreads();
        f32x4 S = {0.f, 0.f, 0.f, 0.f};
        const int jl = lane & 15, rl = 4 * (wave & 3) + (lane >> 4);
        for (int ck2 = 0; ck2 < SEQ / SC_T; ck2 += 2) {
#pragma unroll
            for (int half = 0; half < 2; ++half) {
                const int ck = ck2 + half;
                LAS unsigned char* cb = lds + (ck & 1) * SC_BUF;
                if (wave >= 4) {
                    if (ck + 1 < SEQ / SC_T) {
                        if (half == 0) { scan_write(R0, lds + ((ck + 1) & 1) * SC_BUF, tid - 256); if (ck + 3 < SEQ / SC_T) scan_gload(p, R0, b, h, rg, ck + 3, tid - 256); }
                        else           { scan_write(R1, lds + ((ck + 1) & 1) * SC_BUF, tid - 256); if (ck + 3 < SEQ / SC_T) scan_gload(p, R1, b, h, rg, ck + 3, tid - 256); }
                    }
                } else {
                    float* yo = YRAW + ((size_t)b * SEQ + (size_t)ck * SC_T + jl) * 512 + h * 64 + rg * 16 + rl;
                    const LAS unsigned char* sb = cb + jl * 16; const LAS unsigned char* vb = cb + 1280 + rl * 4;
                    f32x4 w4 = *(const LAS f32x4*)sb, an = *(const LAS f32x4*)(sb + 256), b4 = *(const LAS f32x4*)(sb + 512), k4 = *(const LAS f32x4*)(sb + 768), r4 = *(const LAS f32x4*)(sb + 1024);
                    float vi = *(const LAS float*)vb;
                    f32x4 w4n = *(const LAS f32x4*)(sb + SC_STEP), ann = *(const LAS f32x4*)(sb + SC_STEP + 256), b4n = *(const LAS f32x4*)(sb + SC_STEP + 512), k4n = *(const LAS f32x4*)(sb + SC_STEP + 768), r4n = *(const LAS f32x4*)(sb + SC_STEP + 1024);
                    float vin = *(const LAS float*)(vb + SC_STEP);
                    float yp[16];
#pragma unroll
                    for (int s = 0; s < SC_T; ++s) {
                        f32x4 w4m = w4n, anm = ann, b4m = b4n, k4m = k4n, r4m = r4n; float vim = vin;
                        if (s + 2 < SC_T) {
                            const LAS unsigned char* sn = sb + (s + 2) * SC_STEP;
                            w4m = *(const LAS f32x4*)sn; anm = *(const LAS f32x4*)(sn + 256); b4m = *(const LAS f32x4*)(sn + 512); k4m = *(const LAS f32x4*)(sn + 768); r4m = *(const LAS f32x4*)(sn + 1024);
                            vim = *(const LAS float*)(vb + (s + 2) * SC_STEP);
                        }
                        float sa = fmaf(S[3], an[3], fmaf(S[2], an[2], fmaf(S[1], an[1], S[0] * an[0])));
                        sa = row16_sum(sa);
                        S = S * w4 + (b4 * sa + k4 * vi);
                        yp[s & 15] = fmaf(S[3], r4[3], fmaf(S[2], r4[2], fmaf(S[1], r4[1], S[0] * r4[0])));
                        if ((s & 15) == 15) {
                            const bool b0 = (jl & 1) != 0, b1 = (jl & 2) != 0, b2 = (jl & 4) != 0, b3 = (jl & 8) != 0;
                            float u8[8], w4_[4], x2[2];
#pragma unroll
                            for (int k = 0; k < 8; ++k) { const float keep = b0 ? yp[2 * k + 1] : yp[2 * k], send = b0 ? yp[2 * k] : yp[2 * k + 1];
                                u8[k] = keep + __builtin_bit_cast(float, __builtin_amdgcn_update_dpp(0, __builtin_bit_cast(int, send), 0xB1, 0xF, 0xF, false)); }
#pragma unroll
                            for (int k = 0; k < 4; ++k) { const float keep = b1 ? u8[2 * k + 1] : u8[2 * k], send = b1 ? u8[2 * k] : u8[2 * k + 1];
                                w4_[k] = keep + __builtin_bit_cast(float, __builtin_amdgcn_update_dpp(0, __builtin_bit_cast(int, send), 0x4E, 0xF, 0xF, false)); }
#pragma unroll
                            for (int k = 0; k < 2; ++k) { const float keep = b2 ? w4_[2 * k + 1] : w4_[2 * k], send = b2 ? w4_[2 * k] : w4_[2 * k + 1];
                                x2[k] = keep + __builtin_bit_cast(float, __builtin_amdgcn_ds_swizzle(__builtin_bit_cast(int, send), 0x101F)); }
                            const float keep = b3 ? x2[1] : x2[0], send = b3 ? x2[0] : x2[1];
                            const float ysum = keep + __builtin_bit_cast(float, __builtin_amdgcn_ds_swizzle(__builtin_bit_cast(int, send), 0x201F));
                            yo[(size_t)(s - 15) * 512] = ysum;
                        }
                        w4 = w4n; an = ann; b4 = b4n; k4 = k4n; r4 = r4n; vi = vin;
                        w4n = w4m; ann = anm; b4n = b4m; k4n = k4m; r4n = r4m; vin = vim;
                    }
                }
                __syncthreads();
            }
        }
    }
}

DI void rwkv_post_phase(KP p, int l, int wv) {
    const unsigned char* ws = ows(p->ws);
    const float* YRAW = (const float*)(ws + WS_YRAW); const bf16_t* VZ = (const bf16_t*)(ws + WS_VZ); const bf16_t* G = (const bf16_t*)(ws + WS_G);
    const float* BONUS = (const float*)(ws + WS_BONUS); bf16_t* YS = (bf16_t*)(p->ws + WS_YSR);
    const float* gnw = p->in[15] + l * 512; const float* gnb = p->in[16] + l * 512;
    const int tid_ = otid(wv); const int wave = tid_ >> 6, lane = tid_ & 63, c = 8 * lane;
    const f32x4 gw0 = *(const f32x4*)(gnw + c), gw1 = *(const f32x4*)(gnw + c + 4), gb0 = *(const f32x4*)(gnb + c), gb1 = *(const f32x4*)(gnb + c + 4);
    for (int t = blockIdx.x * 8 + wave; t < MTOK; t += gridDim.x * 8) {
        const size_t o = (size_t)t * 512 + c;
        const f32x4 y0 = *(const f32x4*)(YRAW + o), y1 = *(const f32x4*)(YRAW + o + 4);
        float s = (y0[0] + y0[1]) + (y0[2] + y0[3]) + (y1[0] + y1[1]) + (y1[2] + y1[3]);
        s += __shfl_xor(s, 1); s += __shfl_xor(s, 2); s += __shfl_xor(s, 4);
        const float mean = s * (1.0f / 64.0f);
        const f32x4 d0 = y0 - mean, d1 = y1 - mean;
        float q = (d0[0] * d0[0] + d0[1] * d0[1]) + (d0[2] * d0[2] + d0[3] * d0[3]) + (d1[0] * d1[0] + d1[1] * d1[1]) + (d1[2] * d1[2] + d1[3] * d1[3]);
        q += __shfl_xor(q, 1); q += __shfl_xor(q, 2); q += __shfl_xor(q, 4);
        const float rstd = rsqrtf(q * (1.0f / 64.0f) + 64e-5f);
        const float bon = BONUS[(size_t)t * 8 + (lane >> 3)];
        const u32x4 vv = *(const u32x4*)(VZ + o), gg = *(const u32x4*)(G + o);
        const f32x4 v0 = {bf_lo(vv.x), bf_hi(vv.x), bf_lo(vv.y), bf_hi(vv.y)}, v1 = {bf_lo(vv.z), bf_hi(vv.z), bf_lo(vv.w), bf_hi(vv.w)};
        const f32x4 g0 = {bf_lo(gg.x), bf_hi(gg.x), bf_lo(gg.y), bf_hi(gg.y)}, g1 = {bf_lo(gg.z), bf_hi(gg.z), bf_lo(gg.w), bf_hi(gg.w)};
        const f32x4 r0 = (d0 * rstd * gw0 + gb0 + v0 * bon) * g0, r1 = (d1 * rstd * gw1 + gb1 + v1 * bon) * g1;
        u32x4 w; w.x = cvt_pk_bf16(r0[0], r0[1]); w.y = cvt_pk_bf16(r0[2], r0[3]); w.z = cvt_pk_bf16(r1[0], r1[1]); w.w = cvt_pk_bf16(r1[2], r1[3]);
        *(u32x4*)(YS + o) = w;
    }
}

DI void attn_job(const bf16_t* Q, const bf16_t* K, const bf16_t* V, bf16_t* YS, float* LSE, LAS unsigned char* vl, int b, int h, int d, int rho, int J0, bool first, int lane) {
    asm volatile("" : "+v"(lane));
    const int r = lane & 31, hh = lane >> 5;
    const size_t tokq = (size_t)b * SEQ + (size_t)(J0 + r) * d + rho;
    typedef const __attribute__((address_space(1))) bf16x8* GP8;
    typedef const __attribute__((address_space(1))) u32x4* GP4;
    bf16x8 bq[4];
    { const GP8 qp = (GP8)(Q + tokq * 512 + h * 64 + 8 * hh);
#pragma unroll
      for (int s = 0; s < 4; ++s) bq[s] = qp[2 * s]; }
    bf16x8 ak[5][4];
#pragma unroll
    for (int kt = 0; kt < 5; ++kt) {
        const int Jk = J0 - 128 + 32 * kt + r;
        const size_t tokk = (size_t)b * SEQ + (size_t)(Jk >= 0 ? Jk : 0) * d + rho;
        const GP8 kp = (GP8)(K + tokk * 512 + h * 64 + 8 * hh);
#pragma unroll
        for (int s = 0; s < 4; ++s) ak[kt][s] = kp[2 * s];
    }
    asm volatile("" ::: "memory");
    f32x16 sc[5];
#pragma unroll
    for (int kt = 0; kt < 5; ++kt) {
        const bool valid = (J0 - 128 + 32 * kt + r) >= 0;
        f32x16 a;
#pragma unroll
        for (int i = 0; i < 16; ++i) a[i] = 0.f;
#pragma unroll
        for (int s = 0; s < 4; ++s) {
            bf16x8 kf = ak[kt][s];
            if (!valid) kf = (bf16x8){0, 0, 0, 0, 0, 0, 0, 0};
            a = MFMA32(kf, bq[s], a);
        }
        sc[kt] = a;
    }
    float m = -1e30f;
#pragma unroll
    for (int kt = 0; kt < 5; ++kt)
#pragma unroll
        for (int i = 0; i < 16; ++i) {
            const int kidx = 32 * kt + crow(i, hh); const int dist = 128 + r - kidx;
            const bool ok = (dist >= 0) && (dist <= 128) && (J0 - 128 + kidx >= 0);
            const float v = ok ? sc[kt][i] * 0.125f : -1e30f;
            sc[kt][i] = v; m = fmaxf(m, v);
        }
    m = fmaxf(m, __shfl_xor(m, 32));
    float lsum = 0.f;
#pragma unroll
    for (int kt = 0; kt < 5; ++kt)
#pragma unroll
        for (int i = 0; i < 16; ++i) { const float pv = __expf(sc[kt][i] - m); sc[kt][i] = pv; lsum += pv; }
    lsum += __shfl_xor(lsum, 32);
    const float lse = m + __logf(lsum);
    f32x16 o[2];
#pragma unroll
    for (int i = 0; i < 16; ++i) { o[0][i] = 0.f; o[1][i] = 0.f; }
    u32x4 vr[4];
    {
        const int key = lane >> 1, hf = lane & 1; const int Jk = J0 - 128 + key;
        const size_t tokv = (size_t)b * SEQ + (size_t)(Jk >= 0 ? Jk : 0) * d + rho;
        const GP4 src = (GP4)(V + tokv * 512 + h * 64 + 32 * hf);
        vr[0] = src[0]; vr[1] = src[1]; vr[2] = src[2]; vr[3] = src[3];
    }
#pragma unroll
    for (int kt = 0; kt < 5; ++kt) {
        {
            const int key = lane >> 1, hf = lane & 1;
            LAS u32x4* dst = (LAS u32x4*)(vl + key * 128 + hf * 64);
            dst[0] = vr[0]; dst[1] = vr[1]; dst[2] = vr[2]; dst[3] = vr[3];
            if (kt + 1 < 5) {
                const int Jk = J0 - 128 + 32 * (kt + 1) + key;
                const size_t tokv = (size_t)b * SEQ + (size_t)(Jk >= 0 ? Jk : 0) * d + rho;
                const GP4 src = (GP4)(V + tokv * 512 + h * 64 + 32 * hf);
                vr[0] = src[0]; vr[1] = src[1]; vr[2] = src[2]; vr[3] = src[3];
            }
        }
        LDS_WAIT();
#pragma unroll
        for (int s = 0; s < 2; ++s) {
            const bf16x8 xs = pack8(sc[kt][8 * s], sc[kt][8 * s + 1], sc[kt][8 * s + 2], sc[kt][8 * s + 3], sc[kt][8 * s + 4], sc[kt][8 * s + 5], sc[kt][8 * s + 6], sc[kt][8 * s + 7]);
#pragma unroll
            for (int mt = 0; mt < 2; ++mt) {
                bf16x8 pa;
#pragma unroll
                for (int j = 0; j < 8; ++j) { const int key = 16 * s + 8 * (j >> 2) + 4 * hh + (j & 3); pa[j] = (short)*(const LAS bf16_t*)(vl + key * 128 + (r + 32 * mt) * 2); }
                o[mt] = MFMA32(pa, xs, o[mt]);
            }
        }
        LDS_WAIT();
    }
    const float il = 1.0f / lsum;
    float wp = 0.f, wc = 1.0f, nl = lse;
    if (!first) { const float lp = LSE[tokq * 8 + h]; const float mx = fmaxf(lp, lse); const float ep = __expf(lp - mx), ec = __expf(lse - mx); nl = mx + __logf(ep + ec); wp = ep / (ep + ec); wc = ec / (ep + ec); }
#pragma unroll
    for (int mt = 0; mt < 2; ++mt)
#pragma unroll
        for (int g4 = 0; g4 < 4; ++g4) {
            bf16_t* dst = YS + tokq * 512 + h * 64 + 32 * mt + 8 * g4 + 4 * hh;
            float v[4];
#pragma unroll
            for (int j = 0; j < 4; ++j) v[j] = o[mt][4 * g4 + j] * il * wc;
            if (!first) { const u32x2 pw = *(const u32x2*)dst; v[0] += bf_lo(pw.x) * wp; v[1] += bf_hi(pw.x) * wp; v[2] += bf_lo(pw.y) * wp; v[3] += bf_hi(pw.y) * wp; }
            u32x2 w2; w2.x = cvt_pk_bf16(v[0], v[1]); w2.y = cvt_pk_bf16(v[2], v[3]); *(u32x2*)dst = w2;
        }
    if (hh == 0) LSE[tokq * 8 + h] = nl;
}

DI void attention_phase(KP p, LAS unsigned char* lds, int wv) {
    unsigned char* ws = ows(p->ws);
    const bf16_t *Q = (const bf16_t*)(ws + WS_Q), *K = (const bf16_t*)(ws + WS_K), *V = (const bf16_t*)(ws + WS_V);
    bf16_t* YS = (bf16_t*)(ws + WS_YSA); float* LSE = (float*)(ws + WS_LSE);
    const int tid_ = otid(wv); const int wave = tid_ >> 6, lane = tid_ & 63;
    LAS unsigned char* vl = lds + wave * 4096;
    for (int item0 = blockIdx.x; item0 < 256; item0 += gridDim.x) {
        const int item = (((item0 & 7) * 4 + (item0 >> 6)) << 3) | ((item0 >> 3) & 7);
        const int b = item >> 6, h = (item >> 3) & 7, qb = item & 7, P0 = qb * 512;
#pragma unroll 1
        for (int cfg = 0; cfg < 3; ++cfg) {
#pragma unroll 1
            for (int jj = wave; jj < 16; jj += 8) {
                int d, rho, J0;
                if (cfg == 0) { d = 1; rho = 0; J0 = P0 + 32 * jj; }
                else if (cfg == 1) { d = 4; rho = jj & 3; J0 = (P0 >> 2) + 32 * (jj >> 2); }
                else { d = 16; rho = jj; J0 = P0 >> 4; }
                attn_job(Q, K, V, YS, LSE, vl, b, h, d, rho, J0, cfg == 0, lane);
            }
            asm volatile("s_waitcnt vmcnt(0)" ::: "memory");
            __syncthreads();
        }
    }
}

DI void gmlp_phase(KP p, int l, LAS unsigned char* lds, int wv) {
    unsigned char* ws = ows(p->ws);
    const bf16_t* UV = (const bf16_t*)(ws + WS_UV); bf16_t* YS = (bf16_t*)(ws + WS_YSG);
    const float* lng = p->in[17] + l * 512; const float* lnb = p->in[18] + l * 512;
    const float* wsp = p->in[19] + (size_t)l * 8 * 128 * 128; const float* bsp = p->in[20] + (size_t)l * 8 * 128;
    const int tid_ = otid(wv); const int wave = tid_ >> 6, lane = tid_ & 63, r = lane & 31, hh = lane >> 5;
    LAS float* stats = (LAS float*)(lds + 8 * 17408);
    LAS bf16_t* VT = (LAS bf16_t*)(lds + wave * 17408);
    for (int item0 = blockIdx.x; item0 < 256; item0 += gridDim.x) {
        const int item = ((((item0 & 7) << 4) | (item0 >> 4)) << 1) | ((item0 >> 3) & 1);
        const size_t tok0 = (size_t)(item >> 1) * 128;
        __syncthreads();
        for (int tt = 0; tt < 16; ++tt) {
            const int tl = wave * 16 + tt;
            const u32x4 x = *(const u32x4*)(UV + (tok0 + tl) * 1024 + 512 + 8 * lane);
            const float f[8] = {bf_lo(x.x), bf_hi(x.x), bf_lo(x.y), bf_hi(x.y), bf_lo(x.z), bf_hi(x.z), bf_lo(x.w), bf_hi(x.w)};
            float s = 0.f;
#pragma unroll
            for (int j = 0; j < 8; ++j) s += f[j];
            const float mean = wave_sum(s) * (1.0f / 512.0f); float q = 0.f;
#pragma unroll
            for (int j = 0; j < 8; ++j) { const float dd = f[j] - mean; q += dd * dd; }
            const float rstd = rsqrtf(wave_sum(q) * (1.0f / 512.0f) + 1e-5f);
            if (lane == 0) { stats[2 * tl] = mean; stats[2 * tl + 1] = rstd; }
        }
        __syncthreads();
        const int g = (item & 1) * 4 + (wave & 3);
        if (wave < 4) {
        {
            const int d0 = 8 * (lane & 7);
            const f32x4 lg0 = *(const f32x4*)(lng + g * 64 + d0), lg1 = *(const f32x4*)(lng + g * 64 + d0 + 4), lb0 = *(const f32x4*)(lnb + g * 64 + d0), lb1 = *(const f32x4*)(lnb + g * 64 + d0 + 4);
            for (int it = 0; it < 16; ++it) {
                const int tl = it * 8 + (lane >> 3);
                const u32x4 x = *(const u32x4*)(UV + (tok0 + tl) * 1024 + 512 + g * 64 + d0);
                const float mean = stats[2 * tl], rstd = stats[2 * tl + 1];
                const float f[8] = {bf_lo(x.x), bf_hi(x.x), bf_lo(x.y), bf_hi(x.y), bf_lo(x.z), bf_hi(x.z), bf_lo(x.w), bf_hi(x.w)};
#pragma unroll
                for (int e = 0; e < 8; ++e) {
                    const float gg = e < 4 ? lg0[e & 3] : lg1[e & 3], bb = e < 4 ? lb0[e & 3] : lb1[e & 3];
                    const float y = (f[e] - mean) * rstd * gg + bb;
                    VT[(d0 + e) * 136 + tl] = (bf16_t)(cvt_pk_bf16(y, 0.f) & 0xffffu);
                }
            }
        }
        LDS_WAIT();
#pragma unroll 1
        for (int nt = 0; nt < 4; ++nt) {
            f32x16 acc[2];
#pragma unroll
            for (int i = 0; i < 16; ++i) { acc[0][i] = 0.f; acc[1][i] = 0.f; }
            const int irow = 32 * nt + r;
            for (int s = 0; s < 2 * (nt + 1); ++s) {
                const int j0 = 16 * s + 8 * hh;
                const float* wr_ = wsp + ((size_t)g * 128 + irow) * 128 + j0;
                const f32x4 wa = *(const f32x4*)wr_, wb = *(const f32x4*)(wr_ + 4);
                float wv[8] = {wa[0], wa[1], wa[2], wa[3], wb[0], wb[1], wb[2], wb[3]};
#pragma unroll
                for (int j = 0; j < 8; ++j) if (j0 + j > irow) wv[j] = 0.f;
                const bf16x8 bfr = pack8(wv[0], wv[1], wv[2], wv[3], wv[4], wv[5], wv[6], wv[7]);
#pragma unroll
                for (int mt = 0; mt < 2; ++mt) {
                    const bf16x8 afr = *(const LAS bf16x8*)(VT + (32 * mt + r) * 136 + j0);
                    acc[mt] = MFMA32(afr, bfr, acc[mt]);
                }
            }
            const size_t tok = tok0 + irow; const float bs = bsp[g * 128 + irow];
#pragma unroll
            for (int mt = 0; mt < 2; ++mt)
#pragma unroll
                for (int g4 = 0; g4 < 4; ++g4) {
                    const int c = g * 64 + 32 * mt + 8 * g4 + 4 * hh;
                    const u32x2 uu = *(const u32x2*)(UV + tok * 1024 + c);
                    const float o0 = bf_lo(uu.x) * (acc[mt][4 * g4] + bs), o1 = bf_hi(uu.x) * (acc[mt][4 * g4 + 1] + bs), o2 = bf_lo(uu.y) * (acc[mt][4 * g4 + 2] + bs), o3 = bf_hi(uu.y) * (acc[mt][4 * g4 + 3] + bs);
                    u32x2 w2; w2.x = cvt_pk_bf16(o0, o1); w2.y = cvt_pk_bf16(o2, o3); *(u32x2*)(YS + tok * 512 + c) = w2;
                }
        }
        }
    }
}

DI void ffn_fix_phase(KP p, int l, int wv) {
    unsigned char* ws = ows(p->ws);
    bf16_t* ACT = (bf16_t*)(ws + WS_UP); const float* SA = (const float*)(ws + WS_SIDEA); const float* SG = (const float*)(ws + WS_SIDEG);
    const float* cw = p->in[25] + (size_t)l * 3 * DFF; const float* cb = p->in[26] + (size_t)l * DFF;
    constexpr int NCG = DFF / 8;
    const int tid_ = otid(wv);
    for (int item = blockIdx.x * 512 + tid_; item < 256 * 2 * NCG; item += gridDim.x * 512) {
        const int cgi = item % NCG, qe = item / NCG, q = qe >> 1, e = qe & 1, f = 8 * cgi;
        const bool first = (q & 63) == 0;
        float o[8];
#pragma unroll
        for (int hf = 0; hf < 2; ++hf) {
            const int ff = f + 4 * hf;
            const f32x4 at = *(const f32x4*)(SA + ((size_t)q * 4 + e) * DFF + ff);
            f32x4 t1 = {0.f, 0.f, 0.f, 0.f}, t2 = {0.f, 0.f, 0.f, 0.f};
            if (e == 1) t1 = *(const f32x4*)(SA + ((size_t)q * 4 + 0) * DFF + ff);
            else if (!first) t1 = *(const f32x4*)(SA + ((size_t)(q - 1) * 4 + 3) * DFF + ff);
            if (!first) t2 = *(const f32x4*)(SA + ((size_t)(q - 1) * 4 + (e == 1 ? 3 : 2)) * DFF + ff);
            const f32x4 g = *(const f32x4*)(SG + ((size_t)q * 2 + e) * DFF + ff);
            const f32x4 w0 = *(const f32x4*)(cw + ff), w1 = *(const f32x4*)(cw + DFF + ff), w2 = *(const f32x4*)(cw + 2 * DFF + ff), bb = *(const f32x4*)(cb + ff);
            const f32x4 c = bb + w0 * t2 + w1 * t1 + w2 * at;
#pragma unroll
            for (int j = 0; j < 4; ++j) o[4 * hf + j] = gelu_tanh(c[j]) * g[j];
        }
        u32x4 w; w.x = cvt_pk_bf16(o[0], o[1]); w.y = cvt_pk_bf16(o[2], o[3]); w.z = cvt_pk_bf16(o[4], o[5]); w.w = cvt_pk_bf16(o[6], o[7]);
        *(u32x4*)(ACT + (size_t)(64 * q + e) * DFF + f) = w;
    }
}

__global__ void __launch_bounds__(512) fwd_megakernel(Params p_unused) {
    extern __shared__ __attribute__((aligned(16))) unsigned char lds_raw[];
    LAS unsigned char* lds = (LAS unsigned char*)lds_raw;
    cg::grid_group grid = cg::this_grid();
    KP p = okp();
    unsigned char* ws = p->ws;
    const int G = gridDim.x, c = blockIdx.x;
    const int wv = __builtin_amdgcn_readfirstlane((int)(threadIdx.x >> 6));
    pg8::Epi E; pg8::TileOrder S; pg8::Gemm g;

    unsigned* bar = (unsigned*)(ws + WS_BAR);
    volatile LAS unsigned* xst = (volatile LAS unsigned*)(lds + LDS_BYTES - 16);
    const unsigned myx = xb_xcc_id();
    if (otid(wv) == 0) { xb_add(&bar[XB_CNT(myx)], 1u); __builtin_amdgcn_fence(__ATOMIC_RELEASE, "agent"); }
    grid.sync();
    if (otid(wv) == 0) {
        unsigned mine = 0u, cnt = 0u;
#pragma unroll
        for (unsigned j = 0; j < 8; ++j) { const unsigned c = xb_ld(&bar[XB_CNT(j)]); cnt += (c > 0u) ? 1u : 0u; mine = (j == myx) ? c : mine; }
        xst[0] = mine > 0u ? mine : 1u; xst[1] = cnt > 0u ? cnt : 1u; xst[2] = myx;
    }
    __syncthreads();
    phase0(p, lds, wv);
    gbar(bar, xst, wv);
#pragma unroll 1
    for (int st = 0; st < 2 * 12; ++st) {
        const int l = st / 12, step = st % 12;
        p = okp(); ws = ows(p->ws);
        const float* mod = (const float*)(ws + WS_MOD); const bf16_t* H = (const bf16_t*)(ws + WS_H);
        const float* ml = mod + (size_t)l * 4 * 6144;
        const float* xin = (l == 0) ? p->in[0] : p->out;
        bool do_gemm = false;
        E = pg8::Epi{}; g.merge = 0; g.ws = ws;
        if (step == 0) {
            if (l > 0) convert_weights(p, l, lds, wv);
            norm_mod_phase(xin, p->in[4] + l * DM, ml + 0, ml + 1024, (bf16_t*)(ws + WS_H), wv);
        } else if (step == 1 || step == 4) {
            if (step == 4) rwkv_post_phase(p, l, wv);
            E.mode = pg8::EM_INPROJ; E.o0 = (bf16_t*)(ws + WS_Q); E.o1 = (bf16_t*)(ws + WS_K); E.o2 = (bf16_t*)(ws + WS_V); E.o3 = (bf16_t*)(ws + WS_RAW); E.o4 = (bf16_t*)(ws + WS_UV);
            E.ropec = (const float*)(ws + WS_ROPEC); E.ropes = (const float*)(ws + WS_ROPES);
            g.A = H; g.Bt = (const bf16_t*)(ws + WS_WIN); g.lda = 1024; g.K = 1024;
            if (step == 1) S.init(64, 7, G, c, 7, 6, 0); else S.init(64, 10, G, c, 6, 0, 13);
            do_gemm = true;
        } else if (step == 2) { rwkv_derived_phase(p, l, lds, wv); }
        else if (step == 3) { rwkv_scan_phase(p, lds, wv); }
        else if (step == 5) { attention_phase(p, lds, wv); gmlp_phase(p, l, lds, wv); }
        else if (step == 6) {
            E.mode = pg8::EM_MERGE; E.o0 = (bf16_t*)(ws + WS_GATE); E.o1 = (bf16_t*)(ws + WS_MB);
            g.merge = 1; g.A = H; g.Bt = (const bf16_t*)(ws + WS_WIN); g.lda = 1024; g.K = 1024;
            S.init(64, 4, G, c, 4, 0, 0, 6);
            do_gemm = true;
        } else if (step == 7) {
            E.mode = pg8::EM_RESID; E.f0 = p->out; E.f1 = xin; E.f2 = ml + 2048;
            g.A = (const bf16_t*)(ws + WS_MB); g.Bt = (const bf16_t*)(ws + WS_WOUT); g.lda = 1024; g.K = 1024;
            S.init(64, 4, G, c, 4, 0, 0); do_gemm = true;
        } else if (step == 8) { norm_mod_phase(p->out, p->in[23] + l * DM, ml + 3072, ml + 4096, (bf16_t*)(ws + WS_H), wv); }
        else if (step == 9) {
            E.mode = pg8::EM_UP; E.o0 = (bf16_t*)(ws + WS_UP); E.f0 = (float*)(ws + WS_SIDEA); E.f3 = (float*)(ws + WS_SIDEG); E.f1 = p->in[25] + (size_t)l * 3 * DFF; E.f2 = p->in[26] + (size_t)l * DFF;
            g.A = H; g.Bt = (const bf16_t*)(ws + WS_WUP); g.lda = 1024; g.K = 1024;
            S.init(64, 22, G, c, 22, 0, 0); do_gemm = true;
        } else if (step == 10) { ffn_fix_phase(p, l, wv); }
        else {
            E.mode = pg8::EM_RESID; E.f0 = p->out; E.f1 = p->out; E.f2 = ml + 5120;
            g.A = (const bf16_t*)(ws + WS_UP); g.Bt = (const bf16_t*)(ws + WS_WDN); g.lda = DFF; g.K = DFF;
            S.init(64, 4, G, c, 4, 0, 0); do_gemm = true;
        }
        if (do_gemm) pg8::gemm_phase(lds, g, S, E, wv);
        gbar((unsigned*)(ws + WS_BAR), xst, wv);
    }
    p = okp();
    final_norm_phase(p->out, p->in[28], wv);
}

extern "C" void kernel_launch(void* const* d_in, const int* in_sizes, int n_in, void* d_out, int out_size, void* d_ws, size_t ws_size, hipStream_t stream) {
    static int grid_blocks = 0;
    if (grid_blocks == 0) {
        int dev = 0, cus = 0, per_cu = 0;
        hipGetDevice(&dev);
        hipDeviceGetAttribute(&cus, hipDeviceAttributeMultiprocessorCount, dev);
        if (hipFuncSetAttribute((const void*)fwd_megakernel, hipFuncAttributeMaxDynamicSharedMemorySize, LDS_BYTES) != hipSuccess) { fprintf(stderr, "hipFuncSetAttribute failed\n"); }
        hipOccupancyMaxActiveBlocksPerMultiprocessor(&per_cu, (const void*)fwd_megakernel, 512, LDS_BYTES);
        if (per_cu < 1) { fprintf(stderr, "occupancy query returned %d\n", per_cu); per_cu = 1; }
        if (per_cu > 1) per_cu = 1;
        grid_blocks = cus * per_cu;
        (void)hipGetLastError();
    }
    if (n_in != 29 || ws_size < 256 * MiB) { fprintf(stderr, "unexpected inputs/workspace\n"); return; }
    (void)hipMemsetAsync((unsigned char*)d_ws + WS_BAR, 0, XB_WORDS * 4, stream);
    Params p{};
    for (int i = 0; i < 29; ++i) p.in[i] = (const float*)d_in[i];
    p.out = (float*)d_out; p.ws = (unsigned char*)d_ws;
    void* args[] = {&p};
    hipError_t e = hipLaunchCooperativeKernel((const void*)fwd_megakernel, dim3(grid_blocks), dim3(512), args, LDS_BYTES, stream);
    if (e != hipSuccess) fprintf(stderr, "cooperative launch failed: %s (grid %d)\n", hipGetErrorString(e), grid_blocks);
}
```

```cpp
#include <hip/hip_runtime.h>
#include <hip/hip_cooperative_groups.h>
#include <cstdio>
#include <cstdint>
namespace cg = cooperative_groups;

#define LAS __attribute__((address_space(3)))
#define DI __device__ __forceinline__
typedef unsigned short bf16_t;
typedef short bf16x8 __attribute__((ext_vector_type(8)));
typedef float f32x4 __attribute__((ext_vector_type(4)));
typedef float f32x16 __attribute__((ext_vector_type(16)));
typedef unsigned u32x4 __attribute__((ext_vector_type(4)));
typedef unsigned u32x2 __attribute__((ext_vector_type(2)));

constexpr int DM = 1024, SEQ = 4096, MTOK = 16384, INC = 7424, DFF = 2816, UPC = 5632, RAWC = 1792;
constexpr int LDS_BYTES = 147456;
constexpr size_t MiB = 1048576;
constexpr size_t WS_WIN = 0, WS_WBR = WS_WIN + (size_t)INC * 1024 * 2, WS_WOUT = WS_WBR + 3u * 1024 * 512 * 2, WS_WUP = WS_WOUT + 1024u * 1024 * 2,
                 WS_WDN = WS_WUP + (size_t)UPC * 1024 * 2, WS_LWU = WS_WDN + (size_t)DFF * 1024 * 2, WS_LAU = WS_LWU + 65536, WS_LGU = WS_LAU + 65536;
constexpr size_t WS_H = 37 * MiB;
constexpr size_t WS_SMALL = 69 * MiB, WS_MOD = WS_SMALL, WS_ROPEC = WS_MOD + 262144, WS_ROPES = WS_ROPEC + 524288, WS_BONUS = WS_ROPES + 524288, WS_LSE = WS_BONUS + 524288;
constexpr size_t WS_BAR = WS_LSE + 524288;
constexpr size_t DB = 72 * MiB;
constexpr size_t WS_RAW = DB, WS_RZ = DB + 56 * MiB, WS_KP = DB + 72 * MiB, WS_KKN = DB + 88 * MiB, WS_B = DB + 104 * MiB, WS_W = DB + 120 * MiB, WS_VZ = DB + 152 * MiB, WS_G = DB + 168 * MiB;
constexpr size_t WS_YRAW = DB, WS_YSR = DB + 32 * MiB;
constexpr size_t WS_Q = DB + 56 * MiB, WS_K = DB + 72 * MiB, WS_V = DB + 88 * MiB, WS_UV = DB + 104 * MiB;
constexpr size_t WS_YSA = DB + 152 * MiB, WS_YSG = DB + 168 * MiB;
constexpr size_t WS_GATE = DB, WS_M32 = DB + 48 * MiB, WS_MB = DB + 112 * MiB;
constexpr size_t WS_UP = DB;
constexpr size_t WS_SIDEA = DB + 88 * MiB, WS_SIDEG = DB + 100 * MiB;
static_assert(WS_LGU + 131072 <= WS_H, "weights region overflow");
static_assert(WS_BAR + 64 * 26 * 4 <= DB, "small region overflow");

struct Params {
    const float* in[29];
    float* out;
    unsigned char* ws;
};

typedef const __attribute__((address_space(4))) Params* KP;
DI KP okp() { unsigned long long k = (unsigned long long)__builtin_amdgcn_kernarg_segment_ptr(); asm volatile("" : "+s"(k)); return (KP)k; }
typedef float f32x2_t __attribute__((ext_vector_type(2)));
typedef __bf16 bf16x2_t __attribute__((ext_vector_type(2)));
DI unsigned cvt_pk_bf16(float lo, float hi) { const f32x2_t v = {lo, hi}; const bf16x2_t r = __builtin_convertvector(v, bf16x2_t); return __builtin_bit_cast(unsigned, r); }
DI float bf_lo(unsigned w) { return __uint_as_float(w << 16); }
DI float bf_hi(unsigned w) { return __uint_as_float(w & 0xffff0000u); }
DI int otid(int wv) { int ln; asm volatile("v_mbcnt_lo_u32_b32 %0, -1, 0\n\tv_mbcnt_hi_u32_b32 %0, -1, %0" : "=v"(ln)); return wv * 64 + ln; }
DI unsigned char* ows(unsigned char* w) { asm volatile("" : "+s"(w)); return w; }
DI float row16_sum(float v) {
    v += __builtin_bit_cast(float, __builtin_amdgcn_update_dpp(0, __builtin_bit_cast(int, v), 0xB1, 0xF, 0xF, false));
    v += __builtin_bit_cast(float, __builtin_amdgcn_update_dpp(0, __builtin_bit_cast(int, v), 0x4E, 0xF, 0xF, false));
    v += __builtin_bit_cast(float, __builtin_amdgcn_update_dpp(0, __builtin_bit_cast(int, v), 0x141, 0xF, 0xF, false));
    v += __builtin_bit_cast(float, __builtin_amdgcn_update_dpp(0, __builtin_bit_cast(int, v), 0x140, 0xF, 0xF, false));
    return v;
}
DI float wave_sum(float v) { v = row16_sum(v); v += __shfl_xor(v, 16); v += __shfl_xor(v, 32); return v; }
#define XB_CNT(j)  (64 * (j))
#define XB_SUB(j)  (64 * (8 + (j)))
#define XB_GEN(j)  (64 * (16 + (j)))
#define XB_TOP     (64 * 24)
#define XB_TOPGEN  (64 * 25)
#define XB_WORDS   (64 * 26)
DI unsigned xb_ld(unsigned* p) { return __hip_atomic_load(p, __ATOMIC_RELAXED, __HIP_MEMORY_SCOPE_AGENT); }
DI unsigned xb_add(unsigned* p, unsigned v) { return __hip_atomic_fetch_add(p, v, __ATOMIC_RELAXED, __HIP_MEMORY_SCOPE_AGENT); }
DI unsigned xb_xcc_id() { return (unsigned)__builtin_amdgcn_s_getreg((3 << 11) | 20) & 0x7u; }
DI void gbar(unsigned* bar, volatile LAS unsigned* st, int wv) {
    asm volatile("s_waitcnt vmcnt(0) lgkmcnt(0)" ::: "memory");
    __syncthreads();
    if (otid(wv) == 0) {
        const unsigned nloc = st[0], nx = st[1], x = st[2];
        const unsigned old = xb_add(&bar[XB_SUB(x)], 1u);
        const unsigned gen = old / nloc;
        if (old + 1u == (gen + 1u) * nloc) {
            __builtin_amdgcn_fence(__ATOMIC_RELEASE, "agent");
            asm volatile("s_waitcnt vmcnt(0)" ::: "memory");
            const unsigned og = xb_add(&bar[XB_TOP], 1u);
            const unsigned tg = og / nx;
            if (og + 1u == (tg + 1u) * nx) xb_add(&bar[XB_TOPGEN], 1u);
            else { while (xb_ld(&bar[XB_TOPGEN]) == tg) __builtin_amdgcn_s_sleep(1); }
            __builtin_amdgcn_fence(__ATOMIC_ACQUIRE, "agent");
            xb_add(&bar[XB_GEN(x)], 1u);
            asm volatile("s_waitcnt vmcnt(0)" ::: "memory");
        } else {
            while (xb_ld(&bar[XB_GEN(x)]) == gen) __builtin_amdgcn_s_sleep(1);
            __builtin_amdgcn_fence(__ATOMIC_ACQUIRE, "agent");
            asm volatile("s_waitcnt vmcnt(0)" ::: "memory");
        }
    }
    asm volatile("" ::: "memory");
    __syncthreads();
}
DI float sigmoidf_(float x) { return __builtin_amdgcn_rcpf(1.0f + __expf(-x)); }
DI float gelu_tanh(float x) { const float u = 1.5957691216f * (x + 0.044715f * x * x * x); return x * __builtin_amdgcn_rcpf(1.0f + __expf(-u)); }
#define LDS_WAIT() asm volatile("s_waitcnt lgkmcnt(0)" ::: "memory")
#define MFMA32(a, b, c) __builtin_amdgcn_mfma_f32_32x32x16_bf16((a), (b), (c), 0, 0, 0)
DI int crow(int reg, int h) { return (reg & 3) + 8 * (reg >> 2) + 4 * h; }
DI bf16x8 pack8(float a0, float a1, float a2, float a3, float a4, float a5, float a6, float a7) {
    u32x4 p; p.x = cvt_pk_bf16(a0, a1); p.y = cvt_pk_bf16(a2, a3); p.z = cvt_pk_bf16(a4, a5); p.w = cvt_pk_bf16(a6, a7);
    return __builtin_bit_cast(bf16x8, p);
}

namespace pg8 {
constexpr int BM = 256, BK = 64, HALF = 128, HTB = HALF * BK * 2, STAGE_BYTES = 8 * HTB, NXCD = 8, WGM = 8;
DI int lds_byte(int r, int c) { const int st = (r >> 4) * 2 + (c >> 5), rr = r & 15, cc = c & 31, ob = rr * 64 + cc * 2; return st * 1024 + (ob ^ (((ob >> 9) & 1) << 5)); }
DI void stage_rc(int b, int& R, int& C) { const int st = b / 1024, sb = b % 1024, swz = sb ^ (((sb >> 9) & 1) << 5); R = (st >> 1) * 16 + swz / 64; C = (st & 1) * 32 + (swz % 64) / 2; }
DI int perm32(int rho) { const int n = rho >> 4, i = rho & 15; return 8 * (i >> 2) + 4 * n + (i & 3); }
struct Unit { int pm, pn, sub; };
struct Gemm { const bf16_t* A; const bf16_t* Bt; int lda, K; int merge; const unsigned char* ws; };
struct TileOrder {
    int nM, nN, nwg, G, c, split, off0, off1, nsub;
    DI void init(int nM_, int nN_, int G_, int c_, int split_, int off0_, int off1_, int nsub_ = 1) { nM = nM_; nN = nN_; nwg = nM * nN; G = G_; c = c_; split = split_; off0 = off0_; off1 = off1_; nsub = nsub_; }
    DI bool next(int i0, Unit& u) const {
        const int i = i0 / nsub; u.sub = i0 - i * nsub;
        const long L = (long)i * G + c; if (L >= nwg) return false;
        int wgid = (int)L; { const int q = nwg / NXCD, r = nwg % NXCD, xcd = wgid % NXCD, off = wgid / NXCD; wgid = (xcd < r ? xcd * (q + 1) : r * (q + 1) + (xcd - r) * q) + off; }
        const int nig = WGM * nN, gid = wgid / nig, fm = gid * WGM, gsz = (nM - fm) < WGM ? (nM - fm) : WGM;
        u.pm = fm + ((wgid % nig) % gsz); const int pnv = (wgid % nig) / gsz; u.pn = pnv < split ? pnv + off0 : pnv - split + off1; return true;
    }
};

enum { EM_INPROJ = 0, EM_GATE = 1, EM_BR_FIRST = 2, EM_BR_MID = 3, EM_BR_LAST = 4, EM_RESID = 5, EM_UP = 6, EM_MERGE = 7 };
struct Epi {
    int mode;
    bf16_t *o0, *o1, *o2, *o3, *o4;
    float* f3;
    float* f0; const float* f1; const float* f2;
    const float *ropec, *ropes;
    DI void up_conv(const f32x4 (&acc)[2][2][4][2], const Unit& u, int wr, int wc, int fr, int fq) const {
        const int f = u.pn * 128 + wc * 32 + 8 * fq;
        const int src1 = (fq << 4) | ((fr + 15) & 15), src2 = (fq << 4) | ((fr + 14) & 15);
        const f32x4 w0a = *(const f32x4*)(f1 + f), w0b = *(const f32x4*)(f1 + f + 4), w1a = *(const f32x4*)(f1 + DFF + f), w1b = *(const f32x4*)(f1 + DFF + f + 4);
        const f32x4 w2a = *(const f32x4*)(f1 + 2 * DFF + f), w2b = *(const f32x4*)(f1 + 2 * DFF + f + 4), cba = *(const f32x4*)(f2 + f), cbb = *(const f32x4*)(f2 + f + 4);
#pragma unroll
        for (int ai = 0; ai < 2; ++ai) {
            const int q = u.pm * 4 + ai * 2 + wr;
            f32x4 p1a_prev = {0.f, 0.f, 0.f, 0.f}, p1b_prev = p1a_prev, p2a_prev = p1a_prev, p2b_prev = p1a_prev;
#pragma unroll
            for (int m = 0; m < 4; ++m) {
                const f32x4 aa = acc[ai][0][m][0], ab = acc[ai][0][m][1], ga = acc[ai][1][m][0], gb = acc[ai][1][m][1];
                f32x4 p1a, p1b, p2a, p2b;
#pragma unroll
                for (int j = 0; j < 4; ++j) {
                    p1a[j] = __shfl(aa[j], src1); p1b[j] = __shfl(ab[j], src1); p2a[j] = __shfl(aa[j], src2); p2b[j] = __shfl(ab[j], src2);
                }
                const f32x4 t1a = fr >= 1 ? p1a : p1a_prev, t1b = fr >= 1 ? p1b : p1b_prev, t2a = fr >= 2 ? p2a : p2a_prev, t2b = fr >= 2 ? p2b : p2b_prev;
                const f32x4 ca = cba + w0a * t2a + w1a * t1a + w2a * aa, cb_ = cbb + w0b * t2b + w1b * t1b + w2b * ab;
                const int row = u.pm * BM + ai * HALF + wr * 64 + m * 16 + fr;
                u32x4 w;
                w.x = cvt_pk_bf16(gelu_tanh(ca[0]) * ga[0], gelu_tanh(ca[1]) * ga[1]); w.y = cvt_pk_bf16(gelu_tanh(ca[2]) * ga[2], gelu_tanh(ca[3]) * ga[3]);
                w.z = cvt_pk_bf16(gelu_tanh(cb_[0]) * gb[0], gelu_tanh(cb_[1]) * gb[1]); w.w = cvt_pk_bf16(gelu_tanh(cb_[2]) * gb[2], gelu_tanh(cb_[3]) * gb[3]);
                *(u32x4*)(o0 + (size_t)row * DFF + f) = w;
                if (m == 0 && fr < 2) {
                    float* sa = f0 + ((size_t)q * 4 + fr) * DFF + f; *(f32x4*)sa = aa; *(f32x4*)(sa + 4) = ab;
                    float* sg = f3 + ((size_t)q * 2 + fr) * DFF + f; *(f32x4*)sg = ga; *(f32x4*)(sg + 4) = gb;
                }
                if (m == 3 && fr >= 14) { float* sa = f0 + ((size_t)q * 4 + 2 + (fr - 14)) * DFF + f; *(f32x4*)sa = aa; *(f32x4*)(sa + 4) = ab; }
                p1a_prev = p1a; p1b_prev = p1b; p2a_prev = p2a; p2b_prev = p2b;
            }
        }
    }
    DI void operator()(const f32x4 (&acc)[2][2][4][2], const Unit& u, int wr, int wc, int fr, int fq) const {
        if (mode == EM_UP) { up_conv(acc, u, wr, wc, fr, fq); return; }
        const int mode = (this->mode == EM_MERGE) ? (((u.sub & 1) == 0) ? (int)EM_GATE : ((u.sub >> 1) == 0 ? (int)EM_BR_FIRST : ((u.sub >> 1) == 1 ? (int)EM_BR_MID : (int)EM_BR_LAST))) : this->mode;
        const int row0 = u.pm * BM + wr * 64 + fr, colb = u.pn * BM + wc * 32 + 8 * fq;
        if (mode == EM_RESID) {
            const float* gv = f2 + (size_t)(row0 >> 12) * 6144 + colb;
            const f32x4 g00 = *(const f32x4*)gv, g01 = *(const f32x4*)(gv + 4), g10 = *(const f32x4*)(gv + HALF), g11 = *(const f32x4*)(gv + HALF + 4);
#pragma unroll
            for (int ai = 0; ai < 2; ++ai) {
                f32x4 b0[4][2], b1[4][2];
#pragma unroll
                for (int m = 0; m < 4; ++m)
#pragma unroll
                    for (int bj = 0; bj < 2; ++bj) { const size_t off = (size_t)(row0 + ai * HALF + m * 16) * 1024 + colb + bj * HALF; b0[m][bj] = *(const f32x4*)(f1 + off); b1[m][bj] = *(const f32x4*)(f1 + off + 4); }
                asm volatile("" ::: "memory");
#pragma unroll
                for (int m = 0; m < 4; ++m)
#pragma unroll
                    for (int bj = 0; bj < 2; ++bj) { const size_t off = (size_t)(row0 + ai * HALF + m * 16) * 1024 + colb + bj * HALF;
                        *(f32x4*)(f0 + off) = b0[m][bj] + (bj ? g10 : g00) * acc[ai][bj][m][0]; *(f32x4*)(f0 + off + 4) = b1[m][bj] + (bj ? g11 : g01) * acc[ai][bj][m][1]; }
            }
            return;
        }
        if (mode == EM_BR_FIRST || mode == EM_BR_MID || mode == EM_BR_LAST) {
#pragma unroll
            for (int ai = 0; ai < 2; ++ai) {
                u32x4 gw[4][2], pm[4][2];
#pragma unroll
                for (int m = 0; m < 4; ++m)
#pragma unroll
                    for (int bj = 0; bj < 2; ++bj) { const size_t off = (size_t)(row0 + ai * HALF + m * 16) * 1024 + colb + bj * HALF; gw[m][bj] = *(const u32x4*)(o0 + off);
                        pm[m][bj] = (u32x4){0u, 0u, 0u, 0u}; if (mode != EM_BR_FIRST) pm[m][bj] = *(const u32x4*)(o1 + off); }
                asm volatile("" ::: "memory");
#pragma unroll
                for (int m = 0; m < 4; ++m)
#pragma unroll
                    for (int bj = 0; bj < 2; ++bj) { const size_t off = (size_t)(row0 + ai * HALF + m * 16) * 1024 + colb + bj * HALF;
                        const f32x4 v0 = acc[ai][bj][m][0], v1 = acc[ai][bj][m][1]; const u32x4 g_ = gw[m][bj], q_ = pm[m][bj];
                        u32x4 w;
                        w.x = cvt_pk_bf16(bf_lo(g_.x) * v0[0] + bf_lo(q_.x), bf_hi(g_.x) * v0[1] + bf_hi(q_.x)); w.y = cvt_pk_bf16(bf_lo(g_.y) * v0[2] + bf_lo(q_.y), bf_hi(g_.y) * v0[3] + bf_hi(q_.y));
                        w.z = cvt_pk_bf16(bf_lo(g_.z) * v1[0] + bf_lo(q_.z), bf_hi(g_.z) * v1[1] + bf_hi(q_.z)); w.w = cvt_pk_bf16(bf_lo(g_.w) * v1[2] + bf_lo(q_.w), bf_hi(g_.w) * v1[3] + bf_hi(q_.w));
                        *(u32x4*)(o1 + off) = w; }
            }
            return;
        }
#pragma unroll
        for (int ai = 0; ai < 2; ++ai) {
            f32x4 csn[4][2], snn[4][2];
            if (mode == EM_INPROJ && u.pn < 4) {
#pragma unroll
                for (int m = 0; m < 4; ++m)
#pragma unroll
                    for (int bj = 0; bj < 2; ++bj) { const int pos = (row0 + ai * HALF + m * 16) & (SEQ - 1), e0 = ((colb + bj * HALF) & 63) >> 1;
                        csn[m][bj] = *(const f32x4*)(ropec + pos * 32 + e0); snn[m][bj] = *(const f32x4*)(ropes + pos * 32 + e0); }
                asm volatile("" ::: "memory");
            }
#pragma unroll
            for (int m = 0; m < 4; ++m) {
                const int row = row0 + ai * HALF + m * 16;
#pragma unroll
                for (int bj = 0; bj < 2; ++bj) {
                    const int col0 = colb + bj * HALF;
                    f32x4 v0 = acc[ai][bj][m][0], v1 = acc[ai][bj][m][1];
                    if (mode == EM_INPROJ) {
                        bf16_t* dst;
                        if (u.pn < 4) {
                            const f32x4 cs = csn[m][bj], sn = snn[m][bj];
                            f32x4 a, b;
                            a[0] = v0[0] * cs[0] - v0[1] * sn[0]; a[1] = v0[1] * cs[0] + v0[0] * sn[0];
                            a[2] = v0[2] * cs[1] - v0[3] * sn[1]; a[3] = v0[3] * cs[1] + v0[2] * sn[1];
                            b[0] = v1[0] * cs[2] - v1[1] * sn[2]; b[1] = v1[1] * cs[2] + v1[0] * sn[2];
                            b[2] = v1[2] * cs[3] - v1[3] * sn[3]; b[3] = v1[3] * cs[3] + v1[2] * sn[3];
                            v0 = a; v1 = b;
                            dst = (u.pn < 2) ? o0 + (size_t)row * 512 + col0 : o1 + (size_t)row * 512 + (col0 - 512);
                        } else if (u.pn < 6) { dst = o2 + (size_t)row * 512 + (col0 - 1024); }
                        else if (u.pn < 13) { dst = o3 + (size_t)row * RAWC + (col0 - 1536); }
                        else {
#pragma unroll
                            for (int j = 0; j < 4; ++j) { v0[j] = gelu_tanh(v0[j]); v1[j] = gelu_tanh(v1[j]); }
                            dst = o4 + (size_t)row * 1024 + (col0 - 3328);
                        }
                        u32x4 w; w.x = cvt_pk_bf16(v0[0], v0[1]); w.y = cvt_pk_bf16(v0[2], v0[3]); w.z = cvt_pk_bf16(v1[0], v1[1]); w.w = cvt_pk_bf16(v1[2], v1[3]);
                        *(u32x4*)dst = w;
                    } else {
#pragma unroll
                        for (int j = 0; j < 4; ++j) { v0[j] = sigmoidf_(v0[j]); v1[j] = sigmoidf_(v1[j]); }
                        u32x4 w; w.x = cvt_pk_bf16(v0[0], v0[1]); w.y = cvt_pk_bf16(v0[2], v0[3]); w.z = cvt_pk_bf16(v1[0], v1[1]); w.w = cvt_pk_bf16(v1[2], v1[3]);
                        *(u32x4*)(o0 + (size_t)row * 1024 + col0) = w;
                    }
                }
            }
        }
    }
};

DI void unit_operands(const Gemm& g, int sub, const char*& A, const char*& Bt, int& lda, int& K) {
    if (!g.merge) { A = (const char*)g.A; Bt = (const char*)g.Bt; lda = g.lda; K = g.K; return; }
    const int br = sub >> 1;
    if ((sub & 1) == 0) { A = (const char*)(g.ws + WS_H); Bt = (const char*)(g.ws + WS_WIN) + (size_t)(4352 + 1024 * br) * 1024 * 2; lda = 1024; K = 1024; }
    else { A = (const char*)(g.ws + (br == 0 ? WS_YSA : (br == 1 ? WS_YSR : WS_YSG))); Bt = (const char*)(g.ws + WS_WBR) + (size_t)br * 1024 * 512 * 2; lda = 512; K = 512; }
}
DI void gemm_phase(LAS unsigned char* lds, const Gemm g, const TileOrder S, const Epi E, int wv) {
    const int tid = otid(wv), wid = __builtin_amdgcn_readfirstlane(tid >> 6), lane = tid & 63, wr = wid >> 2, wc = wid & 3, fr = lane & 15, fq = lane >> 4;
    int stR[2], stC[2], stRb[2];
#pragma unroll
    for (int i = 0; i < 2; ++i) { int R, C; stage_rc(tid * 16 + i * 8192, R, C); stR[i] = R; stC[i] = C; stRb[i] = (R & ~31) + perm32(R & 31); }
    const size_t kstep = (size_t)(BK * 2);
    const unsigned ldsw = (unsigned)wid * 1024u;
    const int aoff = lds_byte(wr * 64 + fr, fq * 8), boff = lds_byte(wc * 32 + fr, fq * 8);
#define PG8_SA(b, h) (((b) * 2 + (h)) * HTB)
#define PG8_SB(b, h) ((4 + (b) * 2 + (h)) * HTB)
#define PG8_STAGE(bufoff, gbase, voff) do { _Pragma("unroll") for (int _i = 0; _i < 2; ++_i) \
        __builtin_amdgcn_global_load_lds((const unsigned*)((const char*)(gbase) + (voff)[_i]), (LAS unsigned*)(lds + (bufoff) + ldsw + _i * 8192), 16, 0, 0); } while (0)
#define PG8_LDA(dst, b, h) do { _Pragma("unroll") for (int m = 0; m < 4; ++m) _Pragma("unroll") for (int k = 0; k < 2; ++k) dst[m][k] = *(const LAS bf16x8*)(lds + PG8_SA(b, h) + aoff + m * 2048 + k * 1024); } while (0)
#define PG8_LDB(dst, b, h) do { _Pragma("unroll") for (int n = 0; n < 2; ++n) _Pragma("unroll") for (int k = 0; k < 2; ++k) dst[n][k] = *(const LAS bf16x8*)(lds + PG8_SB(b, h) + boff + n * 2048 + k * 1024); } while (0)
#define PG8_MMA(ai, bj, At, Bt) do { __builtin_amdgcn_s_setprio(1); _Pragma("unroll") for (int m = 0; m < 4; ++m) _Pragma("unroll") for (int n = 0; n < 2; ++n) _Pragma("unroll") for (int k = 0; k < 2; ++k) \
        acc[ai][bj][m][n] = __builtin_amdgcn_mfma_f32_16x16x32_bf16(Bt[n][k], At[m][k], acc[ai][bj][m][n], 0, 0, 0); __builtin_amdgcn_s_setprio(0); } while (0)
#define PG8_WAIT_V(n) asm volatile("s_waitcnt vmcnt(" #n ")" ::: "memory")
#define PG8_WAIT_L(n) asm volatile("s_waitcnt lgkmcnt(" #n ")" ::: "memory")
#define PG8_BAR __builtin_amdgcn_s_barrier()
#define PG8_SCHED __builtin_amdgcn_sched_barrier(0)
#define PG8_SETUP(u, pA, pB, vA, vB, hA, hB, ntv) do { const char* _A; const char* _B; int _lda, _K; unit_operands(g, (u).sub, _A, _B, _lda, _K); \
        pA = _A + (size_t)(u).pm * 256 * _lda * 2; pB = _B + (size_t)(u).pn * 256 * _K * 2; hA = (size_t)HALF * _lda * 2; hB = (size_t)HALF * _K * 2; ntv = _K / BK; \
        _Pragma("unroll") for (int _i = 0; _i < 2; ++_i) { vA[_i] = (unsigned)(stR[_i] * _lda + stC[_i]) * 2u; vB[_i] = (unsigned)(stRb[_i] * _K + stC[_i]) * 2u; } } while (0)
    Unit cur, nxt; int ui = 0;
    if (!S.next(0, cur)) return;
    f32x4 acc[2][2][4][2];
#pragma unroll
    for (int a = 0; a < 2; ++a)
#pragma unroll
        for (int b = 0; b < 2; ++b)
#pragma unroll
            for (int m = 0; m < 4; ++m)
#pragma unroll
                for (int n = 0; n < 2; ++n) acc[a][b][m][n] = (f32x4){0.f, 0.f, 0.f, 0.f};
    bf16x8 At[4][2], B0[2][2], B1[2][2];
    const char *cA, *cB, *nA, *nB; unsigned vAc[2], vBc[2], vAn[2], vBn[2]; size_t hAc, hBc, hAn, hBn; int nt, ntn;
    PG8_SETUP(cur, cA, cB, vAc, vBc, hAc, hBc, nt);
    PG8_STAGE(PG8_SB(0, 0), cB, vBc); PG8_STAGE(PG8_SB(0, 1), cB + hBc, vBc); PG8_STAGE(PG8_SA(0, 0), cA, vAc); PG8_STAGE(PG8_SA(0, 1), cA + hAc, vAc);
    if (wr == 1) PG8_BAR;
    PG8_WAIT_V(2); PG8_BAR;
    PG8_STAGE(PG8_SB(1, 0), cB + kstep, vBc); PG8_STAGE(PG8_SA(1, 0), cA + kstep, vAc); PG8_STAGE(PG8_SB(1, 1), cB + hBc + kstep, vBc);
    PG8_WAIT_V(6); PG8_BAR;
    for (;;) {
        const bool has_next = S.next(ui + 1, nxt);
        if (has_next) { PG8_SETUP(nxt, nA, nB, vAn, vBn, hAn, hBn, ntn); }
        else { nA = cA; nB = cB; vAn[0] = vAc[0]; vAn[1] = vAc[1]; vBn[0] = vBc[0]; vBn[1] = vBc[1]; hAn = hAc; hBn = hBc; ntn = nt; }
        for (int t = 0; t < nt; t += 2) {
            const bool last = (t == nt - 2);
            const char* a1 = cA + (size_t)(t + 1) * kstep;
            const char* a2 = last ? nA : cA + (size_t)(t + 2) * kstep; const char* b2 = last ? nB : cB + (size_t)(t + 2) * kstep;
            const char* a3 = a2 + kstep; const char* b3 = b2 + kstep;
            unsigned vA2[2], vB2[2]; vA2[0] = last ? vAn[0] : vAc[0]; vA2[1] = last ? vAn[1] : vAc[1]; vB2[0] = last ? vBn[0] : vBc[0]; vB2[1] = last ? vBn[1] : vBc[1];
            const size_t hA2 = last ? hAn : hAc, hB2 = last ? hBn : hBc;
            PG8_LDB(B0, 0, 0); PG8_LDB(B1, 0, 1); PG8_SCHED; PG8_LDA(At, 0, 0); PG8_STAGE(PG8_SA(1, 1), a1 + hAc, vAc);
            PG8_WAIT_V(8); PG8_WAIT_L(0); PG8_BAR; PG8_MMA(0, 0, At, B0); PG8_MMA(0, 1, At, B1); PG8_BAR; PG8_SCHED;
            PG8_LDA(At, 0, 1); PG8_STAGE(PG8_SB(0, 0), b2, vB2); PG8_STAGE(PG8_SB(0, 1), b2 + hB2, vB2); PG8_STAGE(PG8_SA(0, 0), a2, vA2);
            PG8_WAIT_V(8); PG8_WAIT_L(0); PG8_BAR; PG8_MMA(1, 0, At, B0); PG8_MMA(1, 1, At, B1); PG8_BAR; PG8_SCHED;
            PG8_LDB(B0, 1, 0); PG8_LDB(B1, 1, 1); PG8_SCHED; PG8_LDA(At, 1, 0); PG8_STAGE(PG8_SA(0, 1), a2 + hA2, vA2);
            PG8_WAIT_V(8); PG8_WAIT_L(0); PG8_BAR; PG8_MMA(0, 0, At, B0); PG8_MMA(0, 1, At, B1); PG8_BAR; PG8_SCHED;
            PG8_LDA(At, 1, 1); PG8_STAGE(PG8_SB(1, 0), b3, vB2); PG8_STAGE(PG8_SB(1, 1), b3 + hB2, vB2); PG8_STAGE(PG8_SA(1, 0), a3, vA2);
            PG8_WAIT_V(8); PG8_WAIT_L(0); PG8_BAR; PG8_MMA(1, 0, At, B0); PG8_MMA(1, 1, At, B1); PG8_BAR; PG8_SCHED;
        }
        if (wr == 0) PG8_BAR;
        E(acc, cur, wr, wc, fr, fq);
        if (!has_next) break;
#pragma unroll
        for (int a = 0; a < 2; ++a)
#pragma unroll
            for (int b = 0; b < 2; ++b)
#pragma unroll
                for (int m = 0; m < 4; ++m)
#pragma unroll
                    for (int n = 0; n < 2; ++n) acc[a][b][m][n] = (f32x4){0.f, 0.f, 0.f, 0.f};
        cur = nxt; cA = nA; cB = nB; vAc[0] = vAn[0]; vAc[1] = vAn[1]; vBc[0] = vBn[0]; vBc[1] = vBn[1]; hAc = hAn; hBc = hBn; nt = ntn; ++ui;
        if (wr == 1) PG8_BAR;
    }
    PG8_WAIT_V(0);
    PG8_BAR;
#undef PG8_SA
#undef PG8_SB
#undef PG8_STAGE
#undef PG8_LDA
#undef PG8_LDB
#undef PG8_MMA
#undef PG8_WAIT_V
#undef PG8_WAIT_L
#undef PG8_BAR
#undef PG8_SCHED
#undef PG8_SETUP
}
}

template <int PERMK>
DI void transpose_item(const float* W, int K, int N, bf16_t* WT, LAS float* scr, int item, int lane) {
    const int nblk = N / 32, kb = item / nblk, nb = item % nblk, k0 = 64 * kb, n0 = 32 * nb;
    int sc = n0 + (lane & 31);
    if (PERMK == 1 && sc < 1024) { const int hd = sc >> 6, cp = sc & 63; sc = hd * 64 + 32 * (cp & 1) + (cp >> 1); }
    if (PERMK == 2) { const int tl = sc >> 8, w = sc & 255; sc = (w < 128) ? (128 * tl + w) : (DFF + 128 * tl + (w - 128)); }
#pragma unroll 8
    for (int i = 0; i < 32; ++i) { const int kk = 2 * i + (lane >> 5); scr[kk * 33 + (lane & 31)] = W[(size_t)(k0 + kk) * N + sc]; }
    LDS_WAIT();
    const int c = lane & 7;
#pragma unroll
    for (int j = 0; j < 4; ++j) { const int n = (lane >> 3) + 8 * j; const LAS float* s = scr + (8 * c) * 33 + n;
        u32x4 o; o.x = cvt_pk_bf16(s[0 * 33], s[1 * 33]); o.y = cvt_pk_bf16(s[2 * 33], s[3 * 33]); o.z = cvt_pk_bf16(s[4 * 33], s[5 * 33]); o.w = cvt_pk_bf16(s[6 * 33], s[7 * 33]);
        *(u32x4*)(WT + (size_t)(n0 + n) * K + k0 + 8 * c) = o; }
    LDS_WAIT();
}

DI void convert_weights(KP p, int l, LAS unsigned char* lds, int wv) {
    const int tid_ = otid(wv); const int wave = tid_ >> 6, lane = tid_ & 63;
    LAS float* scr = (LAS float*)(lds + wave * 8448);
    const int gw = blockIdx.x * 8 + wave, NGW = gridDim.x * 8;
    constexpr int I_IN = 16 * (INC / 32), I_BR = 8 * 32, I_OUT = 16 * 32, I_UP = 16 * (UPC / 32), I_DN = (DFF / 64) * 32, I_L64 = 16, I_L128 = 32;
    constexpr int NIT = I_IN + 3 * I_BR + I_OUT + I_UP + I_DN + 2 * I_L64 + I_L128;
    unsigned char* ws = ows(p->ws);
    for (int it = gw; it < NIT; it += NGW) {
        int r = it;
        if (r < I_IN) { transpose_item<1>(p->in[5] + (size_t)l * 1024 * INC, 1024, INC, (bf16_t*)(ws + WS_WIN), scr, r, lane); continue; } r -= I_IN;
        if (r < 3 * I_BR) { const int b = r / I_BR; transpose_item<0>(p->in[21] + ((size_t)l * 3 + b) * 512 * 1024, 512, 1024, (bf16_t*)(ws + WS_WBR) + (size_t)b * 1024 * 512, scr, r % I_BR, lane); continue; } r -= 3 * I_BR;
        if (r < I_OUT) { transpose_item<0>(p->in[22] + (size_t)l * 1024 * 1024, 1024, 1024, (bf16_t*)(ws + WS_WOUT), scr, r, lane); continue; } r -= I_OUT;
        if (r < I_UP) { transpose_item<2>(p->in[24] + (size_t)l * 1024 * UPC, 1024, UPC, (bf16_t*)(ws + WS_WUP), scr, r, lane); continue; } r -= I_UP;
        if (r < I_DN) { transpose_item<0>(p->in[27] + (size_t)l * DFF * 1024, DFF, 1024, (bf16_t*)(ws + WS_WDN), scr, r, lane); continue; } r -= I_DN;
        if (r < I_L64) { transpose_item<0>(p->in[8] + (size_t)l * 64 * 512, 64, 512, (bf16_t*)(ws + WS_LWU), scr, r, lane); continue; } r -= I_L64;
        if (r < I_L64) { transpose_item<0>(p->in[10] + (size_t)l * 64 * 512, 64, 512, (bf16_t*)(ws + WS_LAU), scr, r, lane); continue; } r -= I_L64;
        transpose_item<0>(p->in[11] + (size_t)l * 128 * 512, 128, 512, (bf16_t*)(ws + WS_LGU), scr, r, lane);
    }
}

DI void phase0(KP p, LAS unsigned char* lds, int wv) {
    const int tid = otid(wv);
    float* ropec = (float*)(p->ws + WS_ROPEC); float* ropes = (float*)(p->ws + WS_ROPES);
    for (int idx = blockIdx.x * 512 + tid; idx < SEQ * 32; idx += gridDim.x * 512) {
        const int pos = idx >> 5, e = idx & 31;
        const float inv = 1.0f / exp2f((float)e * (13.287712379549449f / 32.0f));
        const float ang = (float)pos * inv;
        double rev = (double)ang * 0.15915494309189535; rev -= rint(rev);
        const float rv = (float)rev;
        ropec[idx] = __builtin_amdgcn_cosf(rv); ropes[idx] = __builtin_amdgcn_sinf(rv);
    }
    {
        LAS float* ca = (LAS float*)lds;
        LAS float* red = (LAS float*)(lds + 16384);
        float* mod = (float*)(p->ws + WS_MOD);
        bool loaded = false;
        for (int item = blockIdx.x; item < 192; item += gridDim.x) {
            if (!loaded) { for (int i = tid; i < 4096; i += 512) { const float v = p->in[1][i]; ca[i] = v / (1.0f + __expf(-v)); } loaded = true; __syncthreads(); }
            const int l = item / 96, c0 = (item % 96) * 64, cc = tid & 63, kg = tid >> 6;
            const float* w = p->in[2] + (size_t)l * 1024 * 6144 + c0 + cc;
            float a0 = 0.f, a1 = 0.f, a2 = 0.f, a3 = 0.f;
#pragma unroll 8
            for (int k = kg * 128; k < kg * 128 + 128; ++k) { const float wv = w[(size_t)k * 6144]; a0 += ca[k] * wv; a1 += ca[1024 + k] * wv; a2 += ca[2048 + k] * wv; a3 += ca[3072 + k] * wv; }
            red[(kg * 4 + 0) * 64 + cc] = a0; red[(kg * 4 + 1) * 64 + cc] = a1; red[(kg * 4 + 2) * 64 + cc] = a2; red[(kg * 4 + 3) * 64 + cc] = a3;
            __syncthreads();
            if (tid < 256) { const int b = tid >> 6; float s = 0.f;
#pragma unroll
                for (int g = 0; g < 8; ++g) s += red[(g * 4 + b) * 64 + cc];
                mod[((size_t)l * 4 + b) * 6144 + c0 + cc] = s + p->in[3][(size_t)l * 6144 + c0 + cc]; }
            __syncthreads();
        }
        __syncthreads();
    }
    convert_weights(p, 0, lds, wv);
}

DI void norm_mod_phase(const float* x, const float* g, const float* sh, const float* sc, bf16_t* H, int wv) {
    const int tid_ = otid(wv); const int wave = tid_ >> 6, lane = tid_ & 63;
    for (int row0 = (blockIdx.x * 8 + wave) * 2; row0 < MTOK; row0 += gridDim.x * 16) {
        f32x4 v[2][4]; float s[2] = {0.f, 0.f};
#pragma unroll
        for (int q = 0; q < 2; ++q) { const f32x4* xr = (const f32x4*)(x + (size_t)(row0 + q) * DM) + lane;
#pragma unroll
            for (int j = 0; j < 4; ++j) v[q][j] = xr[64 * j]; }
#pragma unroll
        for (int q = 0; q < 2; ++q)
#pragma unroll
            for (int j = 0; j < 4; ++j) s[q] += (v[q][j][0] * v[q][j][0] + v[q][j][1] * v[q][j][1]) + (v[q][j][2] * v[q][j][2] + v[q][j][3] * v[q][j][3]);
        const float rs0 = rsqrtf(wave_sum(s[0]) * (1.0f / DM) + 1e-6f), rs1 = rsqrtf(wave_sum(s[1]) * (1.0f / DM) + 1e-6f);
        const int b = row0 >> 12;
#pragma unroll
        for (int j = 0; j < 4; ++j) {
            const int c = 4 * lane + 256 * j;
            const f32x4 gg = *(const f32x4*)(g + c), s1 = *(const f32x4*)(sc + (size_t)b * 6144 + c), s0 = *(const f32x4*)(sh + (size_t)b * 6144 + c);
#pragma unroll
            for (int q = 0; q < 2; ++q) {
                const f32x4 h = (v[q][j] * (q ? rs1 : rs0) * gg) * (s1 + 1.0f) + s0;
                u32x2 w; w.x = cvt_pk_bf16(h[0], h[1]); w.y = cvt_pk_bf16(h[2], h[3]);
                *((u32x2*)(H + (size_t)(row0 + q) * DM) + lane + 64 * j) = w;
            }
        }
    }
}
DI void final_norm_phase(float* x, const float* g, int wv) {
    const int tid_ = otid(wv); const int wave = tid_ >> 6, lane = tid_ & 63;
    for (int row = blockIdx.x * 8 + wave; row < MTOK; row += gridDim.x * 8) {
        f32x4* xr = (f32x4*)(x + (size_t)row * DM) + lane;
        f32x4 v[4]; float s = 0.f;
#pragma unroll
        for (int j = 0; j < 4; ++j) { v[j] = xr[64 * j]; s += (v[j][0] * v[j][0] + v[j][1] * v[j][1]) + (v[j][2] * v[j][2] + v[j][3] * v[j][3]); }
        const float rs = rsqrtf(wave_sum(s) * (1.0f / DM) + 1e-6f);
#pragma unroll
        for (int j = 0; j < 4; ++j) { const f32x4 gg = *(const f32x4*)(g + 4 * lane + 256 * j); xr[64 * j] = v[j] * rs * gg; }
    }
}

DI bf16x8 lerp_frag(const bf16_t* cur, const bf16_t* prv, bool hasprev, const float* mu, int act) {
    const u32x4 c = *(const u32x4*)cur; u32x4 q = {0u, 0u, 0u, 0u}; if (hasprev) q = *(const u32x4*)prv;
    const f32x4 m0 = *(const f32x4*)mu, m1 = *(const f32x4*)(mu + 4);
    float z[8];
    const unsigned cw[4] = {c.x, c.y, c.z, c.w}, qw[4] = {q.x, q.y, q.z, q.w};
#pragma unroll
    for (int j = 0; j < 4; ++j) {
        const float c0 = bf_lo(cw[j]), c1 = bf_hi(cw[j]), p0 = bf_lo(qw[j]), p1 = bf_hi(qw[j]);
        const float mA = (j < 2) ? m0[2 * j] : m1[2 * j - 4], mB = (j < 2) ? m0[2 * j + 1] : m1[2 * j - 3];
        z[2 * j] = c0 + (p0 - c0) * mA; z[2 * j + 1] = c1 + (p1 - c1) * mB;
    }
#pragma unroll
    for (int j = 0; j < 8; ++j) {
        if (act == 1) { const float e = __expf(2.0f * z[j]); z[j] = 1.0f - 2.0f / (1.0f + e); }
        else if (act == 2) z[j] = sigmoidf_(z[j]);
    }
    return pack8(z[0], z[1], z[2], z[3], z[4], z[5], z[6], z[7]);
}

DI void rwkv_derived_phase(KP p0, int l, LAS unsigned char* lds, int wv) {
    const int tid_ = otid(wv); const int wave = tid_ >> 6, lane = tid_ & 63, r = lane & 31, hh = lane >> 5;
    LAS float* lp = (LAS float*)(lds + wave * 2048);
    {
        const int ch = wave * 64 + lane;
        lp[0 * 64 + lane] = p0->in[6][(size_t)l * RAWC + ch]; lp[1 * 64 + lane] = p0->in[6][(size_t)l * RAWC + 512 + ch]; lp[2 * 64 + lane] = p0->in[6][(size_t)l * RAWC + 1024 + ch];
        lp[3 * 64 + lane] = p0->in[7][l * 512 + ch]; lp[4 * 64 + lane] = p0->in[9][l * 512 + ch]; lp[5 * 64 + lane] = p0->in[12][l * 512 + ch];
        lp[6 * 64 + lane] = p0->in[13][l * 512 + ch]; lp[7 * 64 + lane] = p0->in[14][l * 512 + ch];
        LDS_WAIT();
    }
    for (int job = blockIdx.x * 8 + wave; job < 512 * 8; job += gridDim.x * 8) {
        KP p = okp(); unsigned char* ws = ows(p->ws);
        const bf16_t* RAW = (const bf16_t*)(ws + WS_RAW);
        bf16_t *RZ = (bf16_t*)(ws + WS_RZ), *KP = (bf16_t*)(ws + WS_KP), *VZ = (bf16_t*)(ws + WS_VZ), *KKN = (bf16_t*)(ws + WS_KKN), *Bv = (bf16_t*)(ws + WS_B), *G = (bf16_t*)(ws + WS_G);
        float* W = (float*)(ws + WS_W);
        const bf16_t *LWU = (const bf16_t*)(ws + WS_LWU), *LAU = (const bf16_t*)(ws + WS_LAU), *LGU = (const bf16_t*)(ws + WS_LGU);
        const float* mu = p->in[6] + (size_t)l * RAWC; const float* w0 = p->in[7] + l * 512; const float* a0 = p->in[9] + l * 512;
        const float* k_k = p->in[12] + l * 512; const float* k_a = p->in[13] + l * 512; const float* r_k = p->in[14] + l * 512;
        const int hd = job & 7, tg = job >> 3, t = tg * 32 + r;
        const bool hp = (t & (SEQ - 1)) != 0;
        const bf16_t* cur = RAW + (size_t)t * RAWC; const bf16_t* prv = cur - RAWC;
        float ss = 0.f;
#pragma unroll
        for (int q = 0; q < 8; ++q) {
            const int c = hd * 64 + 8 * q + 4 * hh;
            const u32x2 kc = *(const u32x2*)(cur + 512 + c); u32x2 kq = {0u, 0u}; if (hp) kq = *(const u32x2*)(prv + 512 + c);
            const f32x4 mk = *(const LAS f32x4*)(lp + 1 * 64 + 8 * q + 4 * hh), kkw = *(const LAS f32x4*)(lp + 5 * 64 + 8 * q + 4 * hh);
            const float kcur[4] = {bf_lo(kc.x), bf_hi(kc.x), bf_lo(kc.y), bf_hi(kc.y)}, kprv[4] = {bf_lo(kq.x), bf_hi(kq.x), bf_lo(kq.y), bf_hi(kq.y)};
#pragma unroll
            for (int j = 0; j < 4; ++j) { const float kk = (kcur[j] + (kprv[j] - kcur[j]) * mk[j]) * kkw[j]; ss += kk * kk; }
        }
        ss += __shfl_xor(ss, 32);
        const float inv = 1.0f / fmaxf(sqrtf(ss), 1e-12f);
        float bonus = 0.f;
        {
            bf16x8 bw[4], ba[4];
#pragma unroll
            for (int s = 0; s < 4; ++s) { const int o = 16 * s + 8 * hh; bw[s] = lerp_frag(cur + 1536 + o, prv + 1536 + o, hp, mu + 1536 + o, 1); ba[s] = lerp_frag(cur + 1600 + o, prv + 1600 + o, hp, mu + 1600 + o, 0); }
#pragma unroll 1
            for (int mt = 0; mt < 2; ++mt) {
                const int chr = hd * 64 + 32 * mt + r;
                f32x16 aw, aa;
#pragma unroll
                for (int i = 0; i < 16; ++i) { aw[i] = 0.f; aa[i] = 0.f; }
                {
                    typedef const __attribute__((address_space(1))) bf16x8* GP8;
                    const GP8 pw = (GP8)(LWU + (size_t)chr * 64 + 8 * hh), pa = (GP8)(LAU + (size_t)chr * 64 + 8 * hh);
                    bf16x8 fw[4], fa[4];
#pragma unroll
                    for (int s = 0; s < 4; ++s) { fw[s] = pw[2 * s]; fa[s] = pa[2 * s]; }
                    asm volatile("" ::: "memory");
#pragma unroll
                    for (int s = 0; s < 4; ++s) { aw = MFMA32(fw[s], bw[s], aw); aa = MFMA32(fa[s], ba[s], aa); }
                }
                u32x2 rcA[4], kcA[4], vcA[4], rpA[4], kqA[4], vpA[4];
#pragma unroll
                for (int i4 = 0; i4 < 4; ++i4) {
                    const int c = hd * 64 + 32 * mt + 8 * i4 + 4 * hh;
                    rcA[i4] = *(const u32x2*)(cur + c); kcA[i4] = *(const u32x2*)(cur + 512 + c); vcA[i4] = *(const u32x2*)(cur + 1024 + c);
                    rpA[i4] = (u32x2){0u, 0u}; kqA[i4] = (u32x2){0u, 0u}; vpA[i4] = (u32x2){0u, 0u};
                    if (hp) { rpA[i4] = *(const u32x2*)(prv + c); kqA[i4] = *(const u32x2*)(prv + 512 + c); vpA[i4] = *(const u32x2*)(prv + 1024 + c); }
                }
                asm volatile("" ::: "memory");
#pragma unroll
                for (int i4 = 0; i4 < 4; ++i4) {
                    const int c = hd * 64 + 32 * mt + 8 * i4 + 4 * hh;
                    const u32x2 rc = rcA[i4], kc = kcA[i4], vc = vcA[i4], rp = rpA[i4], kq = kqA[i4], vp = vpA[i4];
                    const int cl = 32 * mt + 8 * i4 + 4 * hh;
                    const f32x4 mr = *(const LAS f32x4*)(lp + cl), mk = *(const LAS f32x4*)(lp + 64 + cl), mv = *(const LAS f32x4*)(lp + 128 + cl);
                    const f32x4 w0v = *(const LAS f32x4*)(lp + 192 + cl), a0v = *(const LAS f32x4*)(lp + 256 + cl), kkw = *(const LAS f32x4*)(lp + 320 + cl), kaw = *(const LAS f32x4*)(lp + 384 + cl), rkw = *(const LAS f32x4*)(lp + 448 + cl);
                    const float rcur[4] = {bf_lo(rc.x), bf_hi(rc.x), bf_lo(rc.y), bf_hi(rc.y)}, rprv[4] = {bf_lo(rp.x), bf_hi(rp.x), bf_lo(rp.y), bf_hi(rp.y)};
                    const float kcur[4] = {bf_lo(kc.x), bf_hi(kc.x), bf_lo(kc.y), bf_hi(kc.y)}, kprv[4] = {bf_lo(kq.x), bf_hi(kq.x), bf_lo(kq.y), bf_hi(kq.y)};
                    const float vcur[4] = {bf_lo(vc.x), bf_hi(vc.x), bf_lo(vc.y), bf_hi(vc.y)}, vprv[4] = {bf_lo(vp.x), bf_hi(vp.x), bf_lo(vp.y), bf_hi(vp.y)};
                    f32x4 dec; float rz[4], kp[4], vz[4], kn[4], bb[4];
#pragma unroll
                    for (int j = 0; j < 4; ++j) {
                        const int i = 4 * i4 + j;
                        const float zz = -(w0v[j] + aw[i]);
                        const float sp = (zz > 20.f) ? zz : __logf(1.0f + __expf(zz));
                        const float wv = -sp - 0.5f;
                        dec[j] = __expf(-__expf(wv));
                        const float av = sigmoidf_(a0v[j] + aa[i]);
                        rz[j] = rcur[j] + (rprv[j] - rcur[j]) * mr[j];
                        const float kz = kcur[j] + (kprv[j] - kcur[j]) * mk[j];
                        vz[j] = vcur[j] + (vprv[j] - vcur[j]) * mv[j];
                        kn[j] = kz * kkw[j] * inv; bb[j] = kn[j] * av;
                        kp[j] = kz * (1.0f + (av - 1.0f) * kaw[j]);
                        bonus += rz[j] * kp[j] * rkw[j];
                    }
                    const size_t o = (size_t)t * 512 + c;
                    *(f32x4*)(W + o) = dec;
                    u32x2 w2; w2.x = cvt_pk_bf16(rz[0], rz[1]); w2.y = cvt_pk_bf16(rz[2], rz[3]); *(u32x2*)(RZ + o) = w2;
                    w2.x = cvt_pk_bf16(kp[0], kp[1]); w2.y = cvt_pk_bf16(kp[2], kp[3]); *(u32x2*)(KP + o) = w2;
                    w2.x = cvt_pk_bf16(vz[0], vz[1]); w2.y = cvt_pk_bf16(vz[2], vz[3]); *(u32x2*)(VZ + o) = w2;
                    w2.x = cvt_pk_bf16(kn[0], kn[1]); w2.y = cvt_pk_bf16(kn[2], kn[3]); *(u32x2*)(KKN + o) = w2;
                    w2.x = cvt_pk_bf16(bb[0], bb[1]); w2.y = cvt_pk_bf16(bb[2], bb[3]); *(u32x2*)(Bv + o) = w2;
                }
            }
        }
        bonus += __shfl_xor(bonus, 32);
        int t2 = t; asm volatile("" : "+v"(t2));
        if (hh == 0) ((float*)(ows(ws) + WS_BONUS))[(size_t)t2 * 8 + hd] = bonus;
        {
            bf16x8 bg[8];
#pragma unroll
            for (int s = 0; s < 8; ++s) { const int o = 16 * s + 8 * hh; bg[s] = lerp_frag(cur + 1664 + o, prv + 1664 + o, hp, mu + 1664 + o, 2); }
#pragma unroll 1
            for (int mt = 0; mt < 2; ++mt) {
                const int chr = hd * 64 + 32 * mt + r;
                f32x16 ag;
#pragma unroll
                for (int i = 0; i < 16; ++i) ag[i] = 0.f;
                {
                    typedef const __attribute__((address_space(1))) bf16x8* GP8;
                    const GP8 pg = (GP8)(LGU + (size_t)chr * 128 + 8 * hh);
                    bf16x8 fg[8];
#pragma unroll
                    for (int s = 0; s < 8; ++s) fg[s] = pg[2 * s];
                    asm volatile("" ::: "memory");
#pragma unroll
                    for (int s = 0; s < 8; ++s) ag = MFMA32(fg[s], bg[s], ag);
                }
#pragma unroll
                for (int i4 = 0; i4 < 4; ++i4) {
                    const size_t o = (size_t)t2 * 512 + hd * 64 + 32 * mt + 8 * i4 + 4 * hh;
                    u32x2 w2; w2.x = cvt_pk_bf16(ag[4 * i4], ag[4 * i4 + 1]); w2.y = cvt_pk_bf16(ag[4 * i4 + 2], ag[4 * i4 + 3]); *(u32x2*)(G + o) = w2;
                }
            }
        }
    }
}

constexpr int SC_T = 32, SC_STEP = 1344, SC_BUF = SC_T * SC_STEP;
struct ScanRegs { f32x4 w0, w1; u32x4 kn, bb, kp, rz, vv; };
DI void scan_gload(KP p, ScanRegs& R, int b, int h, int rg, int ck, int pt) {
    const unsigned char* ws = ows(p->ws);
    const size_t tok0 = (size_t)b * SEQ + (size_t)ck * SC_T;
    { const int st = pt >> 4, sub = pt & 15; R.w0 = *(const f32x4*)((const float*)(ws + WS_W) + (tok0 + st) * 512 + h * 64 + 4 * sub); }
    { const int pp = pt + 256, st = pp >> 4, sub = pp & 15; R.w1 = *(const f32x4*)((const float*)(ws + WS_W) + (tok0 + st) * 512 + h * 64 + 4 * sub); }
    const int st = pt >> 3, sub = pt & 7; const size_t go = (tok0 + st) * 512 + h * 64 + 8 * sub;
    R.kn = *(const u32x4*)((const bf16_t*)(ws + WS_KKN) + go); R.bb = *(const u32x4*)((const bf16_t*)(ws + WS_B) + go);
    R.kp = *(const u32x4*)((const bf16_t*)(ws + WS_KP) + go); R.rz = *(const u32x4*)((const bf16_t*)(ws + WS_RZ) + go);
    R.vv = (u32x4){0u, 0u, 0u, 0u};
    if (pt < 64) { const int s2 = pt >> 1, hf = pt & 1; R.vv = *(const u32x4*)((const bf16_t*)(ws + WS_VZ) + (tok0 + s2) * 512 + h * 64 + rg * 16 + 8 * hf); }
}
DI void scan_write(const ScanRegs& R, LAS unsigned char* buf, int pt) {
    { const int st = pt >> 4, sub = pt & 15; *(LAS f32x4*)(buf + st * SC_STEP + sub * 16) = R.w0; }
    { const int pp = pt + 256, st = pp >> 4, sub = pp & 15; *(LAS f32x4*)(buf + st * SC_STEP + sub * 16) = R.w1; }
    const int st = pt >> 3, sub = pt & 7;
    const u32x4 kn = R.kn, bb = R.bb, kp = R.kp, rz = R.rz;
    LAS unsigned char* d = buf + st * SC_STEP + sub * 32;
    *(LAS f32x4*)(d + 256) = (f32x4){-bf_lo(kn.x), -bf_hi(kn.x), -bf_lo(kn.y), -bf_hi(kn.y)}; *(LAS f32x4*)(d + 256 + 16) = (f32x4){-bf_lo(kn.z), -bf_hi(kn.z), -bf_lo(kn.w), -bf_hi(kn.w)};
    *(LAS f32x4*)(d + 512) = (f32x4){bf_lo(bb.x), bf_hi(bb.x), bf_lo(bb.y), bf_hi(bb.y)}; *(LAS f32x4*)(d + 512 + 16) = (f32x4){bf_lo(bb.z), bf_hi(bb.z), bf_lo(bb.w), bf_hi(bb.w)};
    *(LAS f32x4*)(d + 768) = (f32x4){bf_lo(kp.x), bf_hi(kp.x), bf_lo(kp.y), bf_hi(kp.y)}; *(LAS f32x4*)(d + 768 + 16) = (f32x4){bf_lo(kp.z), bf_hi(kp.z), bf_lo(kp.w), bf_hi(kp.w)};
    *(LAS f32x4*)(d + 1024) = (f32x4){bf_lo(rz.x), bf_hi(rz.x), bf_lo(rz.y), bf_hi(rz.y)}; *(LAS f32x4*)(d + 1024 + 16) = (f32x4){bf_lo(rz.z), bf_hi(rz.z), bf_lo(rz.w), bf_hi(rz.w)};
    if (pt < 64) { const int s2 = pt >> 1, hf = pt & 1; const u32x4 vv = R.vv;
        LAS unsigned char* dv = buf + s2 * SC_STEP + 1280 + hf * 32;
        *(LAS f32x4*)dv = (f32x4){bf_lo(vv.x), bf_hi(vv.x), bf_lo(vv.y), bf_hi(vv.y)}; *(LAS f32x4*)(dv + 16) = (f32x4){bf_lo(vv.z), bf_hi(vv.z), bf_lo(vv.w), bf_hi(vv.w)}; }
}
DI void rwkv_scan_phase(KP p, LAS unsigned char* lds, int wv) {
    const int tid = otid(wv), wave = tid >> 6, lane = tid & 63;
    float* YRAW = (float*)(p->ws + WS_YRAW);
    for (int job = blockIdx.x; job < 128; job += gridDim.x) {
        const int jx = job & 7, jk = job >> 3;
        const int chain = jx + 8 * (jk >> 2), rg = jk & 3, b = chain >> 3, h = chain & 7;
        __syncthreads();
        ScanRegs R0, R1;
        if (wave >= 4) { scan_gload(p, R0, b, h, rg, 0, tid - 256); scan_write(R0, lds, tid - 256); scan_gload(p, R0, b, h, rg, 1, tid - 256); scan_gload(p, R1, b, h, rg, 2, tid - 256); }
        __syncthreads();
        f32x4 S = {0.f, 0.f, 0.f, 0.f};
        const int jl = lane & 15, rl = 4 * (wave & 3) + (lane >> 4);
        for (int ck2 = 0; ck2 < SEQ / SC_T; ck2 += 2) {
#pragma unroll
            for (int half = 0; half < 2; ++half) {
                const int ck = ck2 + half;
                LAS unsigned char* cb = lds + (ck & 1) * SC_BUF;
                if (wave >= 4) {
                    if (ck + 1 < SEQ / SC_T) {
                        if (half == 0) { scan_write(R0, lds + ((ck + 1) & 1) * SC_BUF, tid - 256); if (ck + 3 < SEQ / SC_T) scan_gload(p, R0, b, h, rg, ck + 3, tid - 256); }
                        else           { scan_write(R1, lds + ((ck + 1) & 1) * SC_BUF, tid - 256); if (ck + 3 < SEQ / SC_T) scan_gload(p, R1, b, h, rg, ck + 3, tid - 256); }
                    }
                } else {
                    float* yo = YRAW + ((size_t)b * SEQ + (size_t)ck * SC_T + jl) * 512 + h * 64 + rg * 16 + rl;
                    const LAS unsigned char* sb = cb + jl * 16; const LAS unsigned char* vb = cb + 1280 + rl * 4;
                    f32x4 w4 = *(const LAS f32x4*)sb, an = *(const LAS f32x4*)(sb + 256), b4 = *(const LAS f32x4*)(sb + 512), k4 = *(const LAS f32x4*)(sb + 768), r4 = *(const LAS f32x4*)(sb + 1024);
                    float vi = *(const LAS float*)vb;
                    f32x4 w4n = *(const LAS f32x4*)(sb + SC_STEP), ann = *(const LAS f32x4*)(sb + SC_STEP + 256), b4n = *(const LAS f32x4*)(sb + SC_STEP + 512), k4n = *(const LAS f32x4*)(sb + SC_STEP + 768), r4n = *(const LAS f32x4*)(sb + SC_STEP + 1024);
                    float vin = *(const LAS float*)(vb + SC_STEP);
                    float yp[16];
#pragma unroll
                    for (int s = 0; s < SC_T; ++s) {
                        f32x4 w4m = w4n, anm = ann, b4m = b4n, k4m = k4n, r4m = r4n; float vim = vin;
                        if (s + 2 < SC_T) {
                            const LAS unsigned char* sn = sb + (s + 2) * SC_STEP;
                            w4m = *(const LAS f32x4*)sn; anm = *(const LAS f32x4*)(sn + 256); b4m = *(const LAS f32x4*)(sn + 512); k4m = *(const LAS f32x4*)(sn + 768); r4m = *(const LAS f32x4*)(sn + 1024);
                            vim = *(const LAS float*)(vb + (s + 2) * SC_STEP);
                        }
                        float sa = fmaf(S[3], an[3], fmaf(S[2], an[2], fmaf(S[1], an[1], S[0] * an[0])));
                        sa = row16_sum(sa);
                        S = S * w4 + (b4 * sa + k4 * vi);
                        yp[s & 15] = fmaf(S[3], r4[3], fmaf(S[2], r4[2], fmaf(S[1], r4[1], S[0] * r4[0])));
                        if ((s & 15) == 15) {
                            const bool b0 = (jl & 1) != 0, b1 = (jl & 2) != 0, b2 = (jl & 4) != 0, b3 = (jl & 8) != 0;
                            float u8[8], w4_[4], x2[2];
#pragma unroll
                            for (int k = 0; k < 8; ++k) { const float keep = b0 ? yp[2 * k + 1] : yp[2 * k], send = b0 ? yp[2 * k] : yp[2 * k + 1];
                                u8[k] = keep + __builtin_bit_cast(float, __builtin_amdgcn_update_dpp(0, __builtin_bit_cast(int, send), 0xB1, 0xF, 0xF, false)); }
#pragma unroll
                            for (int k = 0; k < 4; ++k) { const float keep = b1 ? u8[2 * k + 1] : u8[2 * k], send = b1 ? u8[2 * k] : u8[2 * k + 1];
                                w4_[k] = keep + __builtin_bit_cast(float, __builtin_amdgcn_update_dpp(0, __builtin_bit_cast(int, send), 0x4E, 0xF, 0xF, false)); }
#pragma unroll
                            for (int k = 0; k < 2; ++k) { const float keep = b2 ? w4_[2 * k + 1] : w4_[2 * k], send = b2 ? w4_[2 * k] : w4_[2 * k + 1];
                                x2[k] = keep + __builtin_bit_cast(float, __builtin_amdgcn_ds_swizzle(__builtin_bit_cast(int, send), 0x101F)); }
                            const float keep = b3 ? x2[1] : x2[0], send = b3 ? x2[0] : x2[1];
                            const float ysum = keep + __builtin_bit_cast(float, __builtin_amdgcn_ds_swizzle(__builtin_bit_cast(int, send), 0x201F));
                            yo[(size_t)(s - 15) * 512] = ysum;
                        }
                        w4 = w4n; an = ann; b4 = b4n; k4 = k4n; r4 = r4n; vi = vin;
                        w4n = w4m; ann = anm; b4n = b4m; k4n = k4m; r4n = r4m; vin = vim;
                    }
                }
                __syncthreads();
            }
        }
    }
}

DI void rwkv_post_phase(KP p, int l, int wv) {
    const unsigned char* ws = ows(p->ws);
    const float* YRAW = (const float*)(ws + WS_YRAW); const bf16_t* VZ = (const bf16_t*)(ws + WS_VZ); const bf16_t* G = (const bf16_t*)(ws + WS_G);
    const float* BONUS = (const float*)(ws + WS_BONUS); bf16_t* YS = (bf16_t*)(p->ws + WS_YSR);
    const float* gnw = p->in[15] + l * 512; const float* gnb = p->in[16] + l * 512;
    const int tid_ = otid(wv); const int wave = tid_ >> 6, lane = tid_ & 63, c = 8 * lane;
    const f32x4 gw0 = *(const f32x4*)(gnw + c), gw1 = *(const f32x4*)(gnw + c + 4), gb0 = *(const f32x4*)(gnb + c), gb1 = *(const f32x4*)(gnb + c + 4);
    for (int t = blockIdx.x * 8 + wave; t < MTOK; t += gridDim.x * 8) {
        const size_t o = (size_t)t * 512 + c;
        const f32x4 y0 = *(const f32x4*)(YRAW + o), y1 = *(const f32x4*)(YRAW + o + 4);
        float s = (y0[0] + y0[1]) + (y0[2] + y0[3]) + (y1[0] + y1[1]) + (y1[2] + y1[3]);
        s += __shfl_xor(s, 1); s += __shfl_xor(s, 2); s += __shfl_xor(s, 4);
        const float mean = s * (1.0f / 64.0f);
        const f32x4 d0 = y0 - mean, d1 = y1 - mean;
        float q = (d0[0] * d0[0] + d0[1] * d0[1]) + (d0[2] * d0[2] + d0[3] * d0[3]) + (d1[0] * d1[0] + d1[1] * d1[1]) + (d1[2] * d1[2] + d1[3] * d1[3]);
        q += __shfl_xor(q, 1); q += __shfl_xor(q, 2); q += __shfl_xor(q, 4);
        const float rstd = rsqrtf(q * (1.0f / 64.0f) + 64e-5f);
        const float bon = BONUS[(size_t)t * 8 + (lane >> 3)];
        const u32x4 vv = *(const u32x4*)(VZ + o), gg = *(const u32x4*)(G + o);
        const f32x4 v0 = {bf_lo(vv.x), bf_hi(vv.x), bf_lo(vv.y), bf_hi(vv.y)}, v1 = {bf_lo(vv.z), bf_hi(vv.z), bf_lo(vv.w), bf_hi(vv.w)};
        const f32x4 g0 = {bf_lo(gg.x), bf_hi(gg.x), bf_lo(gg.y), bf_hi(gg.y)}, g1 = {bf_lo(gg.z), bf_hi(gg.z), bf_lo(gg.w), bf_hi(gg.w)};
        const f32x4 r0 = (d0 * rstd * gw0 + gb0 + v0 * bon) * g0, r1 = (d1 * rstd * gw1 + gb1 + v1 * bon) * g1;
        u32x4 w; w.x = cvt_pk_bf16(r0[0], r0[1]); w.y = cvt_pk_bf16(r0[2], r0[3]); w.z = cvt_pk_bf16(r1[0], r1[1]); w.w = cvt_pk_bf16(r1[2], r1[3]);
        *(u32x4*)(YS + o) = w;
    }
}

DI void attn_job(const bf16_t* Q, const bf16_t* K, const bf16_t* V, bf16_t* YS, float* LSE, LAS unsigned char* vl, int b, int h, int d, int rho, int J0, bool first, int lane) {
    asm volatile("" : "+v"(lane));
    const int r = lane & 31, hh = lane >> 5;
    const size_t tokq = (size_t)b * SEQ + (size_t)(J0 + r) * d + rho;
    typedef const __attribute__((address_space(1))) bf16x8* GP8;
    typedef const __attribute__((address_space(1))) u32x4* GP4;
    bf16x8 bq[4];
    { const GP8 qp = (GP8)(Q + tokq * 512 + h * 64 + 8 * hh);
#pragma unroll
      for (int s = 0; s < 4; ++s) bq[s] = qp[2 * s]; }
    bf16x8 ak[5][4];
#pragma unroll
    for (int kt = 0; kt < 5; ++kt) {
        const int Jk = J0 - 128 + 32 * kt + r;
        const size_t tokk = (size_t)b * SEQ + (size_t)(Jk >= 0 ? Jk : 0) * d + rho;
        const GP8 kp = (GP8)(K + tokk * 512 + h * 64 + 8 * hh);
#pragma unroll
        for (int s = 0; s < 4; ++s) ak[kt][s] = kp[2 * s];
    }
    asm volatile("" ::: "memory");
    f32x16 sc[5];
#pragma unroll
    for (int kt = 0; kt < 5; ++kt) {
        const bool valid = (J0 - 128 + 32 * kt + r) >= 0;
        f32x16 a;
#pragma unroll
        for (int i = 0; i < 16; ++i) a[i] = 0.f;
#pragma unroll
        for (int s = 0; s < 4; ++s) {
            bf16x8 kf = ak[kt][s];
            if (!valid) kf = (bf16x8){0, 0, 0, 0, 0, 0, 0, 0};
            a = MFMA32(kf, bq[s], a);
        }
        sc[kt] = a;
    }
    float m = -1e30f;
#pragma unroll
    for (int kt = 0; kt < 5; ++kt)
#pragma unroll
        for (int i = 0; i < 16; ++i) {
            const int kidx = 32 * kt + crow(i, hh); const int dist = 128 + r - kidx;
            const bool ok = (dist >= 0) && (dist <= 128) && (J0 - 128 + kidx >= 0);
            const float v = ok ? sc[kt][i] * 0.125f : -1e30f;
            sc[kt][i] = v; m = fmaxf(m, v);
        }
    m = fmaxf(m, __shfl_xor(m, 32));
    float lsum = 0.f;
#pragma unroll
    for (int kt = 0; kt < 5; ++kt)
#pragma unroll
        for (int i = 0; i < 16; ++i) { const float pv = __expf(sc[kt][i] - m); sc[kt][i] = pv; lsum += pv; }
    lsum += __shfl_xor(lsum, 32);
    const float lse = m + __logf(lsum);
    f32x16 o[2];
#pragma unroll
    for (int i = 0; i < 16; ++i) { o[0][i] = 0.f; o[1][i] = 0.f; }
    u32x4 vr[4];
    {
        const int key = lane >> 1, hf = lane & 1; const int Jk = J0 - 128 + key;
        const size_t tokv = (size_t)b * SEQ + (size_t)(Jk >= 0 ? Jk : 0) * d + rho;
        const GP4 src = (GP4)(V + tokv * 512 + h * 64 + 32 * hf);
        vr[0] = src[0]; vr[1] = src[1]; vr[2] = src[2]; vr[3] = src[3];
    }
#pragma unroll
    for (int kt = 0; kt < 5; ++kt) {
        {
            const int key = lane >> 1, hf = lane & 1;
            LAS u32x4* dst = (LAS u32x4*)(vl + key * 128 + hf * 64);
            dst[0] = vr[0]; dst[1] = vr[1]; dst[2] = vr[2]; dst[3] = vr[3];
            if (kt + 1 < 5) {
                const int Jk = J0 - 128 + 32 * (kt + 1) + key;
                const size_t tokv = (size_t)b * SEQ + (size_t)(Jk >= 0 ? Jk : 0) * d + rho;
                const GP4 src = (GP4)(V + tokv * 512 + h * 64 + 32 * hf);
                vr[0] = src[0]; vr[1] = src[1]; vr[2] = src[2]; vr[3] = src[3];
            }
        }
        LDS_WAIT();
#pragma unroll
        for (int s = 0; s < 2; ++s) {
            const bf16x8 xs = pack8(sc[kt][8 * s], sc[kt][8 * s + 1], sc[kt][8 * s + 2], sc[kt][8 * s + 3], sc[kt][8 * s + 4], sc[kt][8 * s + 5], sc[kt][8 * s + 6], sc[kt][8 * s + 7]);
#pragma unroll
            for (int mt = 0; mt < 2; ++mt) {
                bf16x8 pa;
#pragma unroll
                for (int j = 0; j < 8; ++j) { const int key = 16 * s + 8 * (j >> 2) + 4 * hh + (j & 3); pa[j] = (short)*(const LAS bf16_t*)(vl + key * 128 + (r + 32 * mt) * 2); }
                o[mt] = MFMA32(pa, xs, o[mt]);
            }
        }
        LDS_WAIT();
    }
    const float il = 1.0f / lsum;
    float wp = 0.f, wc = 1.0f, nl = lse;
    if (!first) { const float lp = LSE[tokq * 8 + h]; const float mx = fmaxf(lp, lse); const float ep = __expf(lp - mx), ec = __expf(lse - mx); nl = mx + __logf(ep + ec); wp = ep / (ep + ec); wc = ec / (ep + ec); }
#pragma unroll
    for (int mt = 0; mt < 2; ++mt)
#pragma unroll
        for (int g4 = 0; g4 < 4; ++g4) {
            bf16_t* dst = YS + tokq * 512 + h * 64 + 32 * mt + 8 * g4 + 4 * hh;
            float v[4];
#pragma unroll
            for (int j = 0; j < 4; ++j) v[j] = o[mt][4 * g4 + j] * il * wc;
            if (!first) { const u32x2 pw = *(const u32x2*)dst; v[0] += bf_lo(pw.x) * wp; v[1] += bf_hi(pw.x) * wp; v[2] += bf_lo(pw.y) * wp; v[3] += bf_hi(pw.y) * wp; }
            u32x2 w2; w2.x = cvt_pk_bf16(v[0], v[1]); w2.y = cvt_pk_bf16(v[2], v[3]); *(u32x2*)dst = w2;
        }
    if (hh == 0) LSE[tokq * 8 + h] = nl;
}

DI void attention_phase(KP p, LAS unsigned char* lds, int wv) {
    unsigned char* ws = ows(p->ws);
    const bf16_t *Q = (const bf16_t*)(ws + WS_Q), *K = (const bf16_t*)(ws + WS_K), *V = (const bf16_t*)(ws + WS_V);
    bf16_t* YS = (bf16_t*)(ws + WS_YSA); float* LSE = (float*)(ws + WS_LSE);
    const int tid_ = otid(wv); const int wave = tid_ >> 6, lane = tid_ & 63;
    LAS unsigned char* vl = lds + wave * 4096;
    for (int item0 = blockIdx.x; item0 < 256; item0 += gridDim.x) {
        const int item = (((item0 & 7) * 4 + (item0 >> 6)) << 3) | ((item0 >> 3) & 7);
        const int b = item >> 6, h = (item >> 3) & 7, qb = item & 7, P0 = qb * 512;
#pragma unroll 1
        for (int cfg = 0; cfg < 3; ++cfg) {
#pragma unroll 1
            for (int jj = wave; jj < 16; jj += 8) {
                int d, rho, J0;
                if (cfg == 0) { d = 1; rho = 0; J0 = P0 + 32 * jj; }
                else if (cfg == 1) { d = 4; rho = jj & 3; J0 = (P0 >> 2) + 32 * (jj >> 2); }
                else { d = 16; rho = jj; J0 = P0 >> 4; }
                attn_job(Q, K, V, YS, LSE, vl, b, h, d, rho, J0, cfg == 0, lane);
            }
            asm volatile("s_waitcnt vmcnt(0)" ::: "memory");
            __syncthreads();
        }
    }
}

DI void gmlp_phase(KP p, int l, LAS unsigned char* lds, int wv) {
    unsigned char* ws = ows(p->ws);
    const bf16_t* UV = (const bf16_t*)(ws + WS_UV); bf16_t* YS = (bf16_t*)(ws + WS_YSG);
    const float* lng = p->in[17] + l * 512; const float* lnb = p->in[18] + l * 512;
    const float* wsp = p->in[19] + (size_t)l * 8 * 128 * 128; const float* bsp = p->in[20] + (size_t)l * 8 * 128;
    const int tid_ = otid(wv); const int wave = tid_ >> 6, lane = tid_ & 63, r = lane & 31, hh = lane >> 5;
    LAS float* stats = (LAS float*)(lds + 8 * 17408);
    LAS bf16_t* VT = (LAS bf16_t*)(lds + wave * 17408);
    for (int item0 = blockIdx.x; item0 < 256; item0 += gridDim.x) {
        const int item = ((((item0 & 7) << 4) | (item0 >> 4)) << 1) | ((item0 >> 3) & 1);
        const size_t tok0 = (size_t)(item >> 1) * 128;
        __syncthreads();
        for (int tt = 0; tt < 16; ++tt) {
            const int tl = wave * 16 + tt;
            const u32x4 x = *(const u32x4*)(UV + (tok0 + tl) * 1024 + 512 + 8 * lane);
            const float f[8] = {bf_lo(x.x), bf_hi(x.x), bf_lo(x.y), bf_hi(x.y), bf_lo(x.z), bf_hi(x.z), bf_lo(x.w), bf_hi(x.w)};
            float s = 0.f;
#pragma unroll
            for (int j = 0; j < 8; ++j) s += f[j];
            const float mean = wave_sum(s) * (1.0f / 512.0f); float q = 0.f;
#pragma unroll
            for (int j = 0; j < 8; ++j) { const float dd = f[j] - mean; q += dd * dd; }
            const float rstd = rsqrtf(wave_sum(q) * (1.0f / 512.0f) + 1e-5f);
            if (lane == 0) { stats[2 * tl] = mean; stats[2 * tl + 1] = rstd; }
        }
        __syncthreads();
        const int g = (item & 1) * 4 + (wave & 3);
        if (wave < 4) {
        {
            const int d0 = 8 * (lane & 7);
            const f32x4 lg0 = *(const f32x4*)(lng + g * 64 + d0), lg1 = *(const f32x4*)(lng + g * 64 + d0 + 4), lb0 = *(const f32x4*)(lnb + g * 64 + d0), lb1 = *(const f32x4*)(lnb + g * 64 + d0 + 4);
            for (int it = 0; it < 16; ++it) {
                const int tl = it * 8 + (lane >> 3);
                const u32x4 x = *(const u32x4*)(UV + (tok0 + tl) * 1024 + 512 + g * 64 + d0);
                const float mean = stats[2 * tl], rstd = stats[2 * tl + 1];
                const float f[8] = {bf_lo(x.x), bf_hi(x.x), bf_lo(x.y), bf_hi(x.y), bf_lo(x.z), bf_hi(x.z), bf_lo(x.w), bf_hi(x.w)};
#pragma unroll
                for (int e = 0; e < 8; ++e) {
                    const float gg = e < 4 ? lg0[e & 3] : lg1[e & 3], bb = e < 4 ? lb0[e & 3] : lb1[e & 3];
                    const float y = (f[e] - mean) * rstd * gg + bb;
                    VT[(d0 + e) * 136 + tl] = (bf16_t)(cvt_pk_bf16(y, 0.f) & 0xffffu);
                }
            }
        }
        LDS_WAIT();
#pragma unroll 1
        for (int nt = 0; nt < 4; ++nt) {
            f32x16 acc[2];
#pragma unroll
            for (int i = 0; i < 16; ++i) { acc[0][i] = 0.f; acc[1][i] = 0.f; }
            const int irow = 32 * nt + r;
            for (int s = 0; s < 2 * (nt + 1); ++s) {
                const int j0 = 16 * s + 8 * hh;
                const float* wr_ = wsp + ((size_t)g * 128 + irow) * 128 + j0;
                const f32x4 wa = *(const f32x4*)wr_, wb = *(const f32x4*)(wr_ + 4);
                float wv[8] = {wa[0], wa[1], wa[2], wa[3], wb[0], wb[1], wb[2], wb[3]};
#pragma unroll
                for (int j = 0; j < 8; ++j) if (j0 + j > irow) wv[j] = 0.f;
                const bf16x8 bfr = pack8(wv[0], wv[1], wv[2], wv[3], wv[4], wv[5], wv[6], wv[7]);
#pragma unroll
                for (int mt = 0; mt < 2; ++mt) {
                    const bf16x8 afr = *(const LAS bf16x8*)(VT + (32 * mt + r) * 136 + j0);
                    acc[mt] = MFMA32(afr, bfr, acc[mt]);
                }
            }
            const size_t tok = tok0 + irow; const float bs = bsp[g * 128 + irow];
#pragma unroll
            for (int mt = 0; mt < 2; ++mt)
#pragma unroll
                for (int g4 = 0; g4 < 4; ++g4) {
                    const int c = g * 64 + 32 * mt + 8 * g4 + 4 * hh;
                    const u32x2 uu = *(const u32x2*)(UV + tok * 1024 + c);
                    const float o0 = bf_lo(uu.x) * (acc[mt][4 * g4] + bs), o1 = bf_hi(uu.x) * (acc[mt][4 * g4 + 1] + bs), o2 = bf_lo(uu.y) * (acc[mt][4 * g4 + 2] + bs), o3 = bf_hi(uu.y) * (acc[mt][4 * g4 + 3] + bs);
                    u32x2 w2; w2.x = cvt_pk_bf16(o0, o1); w2.y = cvt_pk_bf16(o2, o3); *(u32x2*)(YS + tok * 512 + c) = w2;
                }
        }
        }
    }
}

DI void ffn_fix_phase(KP p, int l, int wv) {
    unsigned char* ws = ows(p->ws);
    bf16_t* ACT = (bf16_t*)(ws + WS_UP); const float* SA = (const float*)(ws + WS_SIDEA); const float* SG = (const float*)(ws + WS_SIDEG);
    const float* cw = p->in[25] + (size_t)l * 3 * DFF; const float* cb = p->in[26] + (size_t)l * DFF;
    constexpr int NCG = DFF / 8;
    const int tid_ = otid(wv);
    for (int item = blockIdx.x * 512 + tid_; item < 256 * 2 * NCG; item += gridDim.x * 512) {
        const int cgi = item % NCG, qe = item / NCG, q = qe >> 1, e = qe & 1, f = 8 * cgi;
        const bool first = (q & 63) == 0;
        float o[8];
#pragma unroll
        for (int hf = 0; hf < 2; ++hf) {
            const int ff = f + 4 * hf;
            const f32x4 at = *(const f32x4*)(SA + ((size_t)q * 4 + e) * DFF + ff);
            f32x4 t1 = {0.f, 0.f, 0.f, 0.f}, t2 = {0.f, 0.f, 0.f, 0.f};
            if (e == 1) t1 = *(const f32x4*)(SA + ((size_t)q * 4 + 0) * DFF + ff);
            else if (!first) t1 = *(const f32x4*)(SA + ((size_t)(q - 1) * 4 + 3) * DFF + ff);
            if (!first) t2 = *(const f32x4*)(SA + ((size_t)(q - 1) * 4 + (e == 1 ? 3 : 2)) * DFF + ff);
            const f32x4 g = *(const f32x4*)(SG + ((size_t)q * 2 + e) * DFF + ff);
            const f32x4 w0 = *(const f32x4*)(cw + ff), w1 = *(const f32x4*)(cw + DFF + ff), w2 = *(const f32x4*)(cw + 2 * DFF + ff), bb = *(const f32x4*)(cb + ff);
            const f32x4 c = bb + w0 * t2 + w1 * t1 + w2 * at;
#pragma unroll
            for (int j = 0; j < 4; ++j) o[4 * hf + j] = gelu_tanh(c[j]) * g[j];
        }
        u32x4 w; w.x = cvt_pk_bf16(o[0], o[1]); w.y = cvt_pk_bf16(o[2], o[3]); w.z = cvt_pk_bf16(o[4], o[5]); w.w = cvt_pk_bf16(o[6], o[7]);
        *(u32x4*)(ACT + (size_t)(64 * q + e) * DFF + f) = w;
    }
}

__global__ void __launch_bounds__(512) fwd_megakernel(Params p_unused) {
    extern __shared__ __attribute__((aligned(16))) unsigned char lds_raw[];
    LAS unsigned char* lds = (LAS unsigned char*)lds_raw;
    cg::grid_group grid = cg::this_grid();
    KP p = okp();
    unsigned char* ws = p->ws;
    const int G = gridDim.x, c = blockIdx.x;
    const int wv = __builtin_amdgcn_readfirstlane((int)(threadIdx.x >> 6));
    pg8::Epi E; pg8::TileOrder S; pg8::Gemm g;

    unsigned* bar = (unsigned*)(ws + WS_BAR);
    volatile LAS unsigned* xst = (volatile LAS unsigned*)(lds + LDS_BYTES - 16);
    const unsigned myx = xb_xcc_id();
    if (otid(wv) == 0) { xb_add(&bar[XB_CNT(myx)], 1u); __builtin_amdgcn_fence(__ATOMIC_RELEASE, "agent"); }
    grid.sync();
    if (otid(wv) == 0) {
        unsigned mine = 0u, cnt = 0u;
#pragma unroll
        for (unsigned j = 0; j < 8; ++j) { const unsigned c = xb_ld(&bar[XB_CNT(j)]); cnt += (c > 0u) ? 1u : 0u; mine = (j == myx) ? c : mine; }
        xst[0] = mine > 0u ? mine : 1u; xst[1] = cnt > 0u ? cnt : 1u; xst[2] = myx;
    }
    __syncthreads();
    phase0(p, lds, wv);
    gbar(bar, xst, wv);
#pragma unroll 1
    for (int st = 0; st < 2 * 12; ++st) {
        const int l = st / 12, step = st % 12;
        p = okp(); ws = ows(p->ws);
        const float* mod = (const float*)(ws + WS_MOD); const bf16_t* H = (const bf16_t*)(ws + WS_H);
        const float* ml = mod + (size_t)l * 4 * 6144;
        const float* xin = (l == 0) ? p->in[0] : p->out;
        bool do_gemm = false;
        E = pg8::Epi{}; g.merge = 0; g.ws = ws;
        if (step == 0) {
            if (l > 0) convert_weights(p, l, lds, wv);
            norm_mod_phase(xin, p->in[4] + l * DM, ml + 0, ml + 1024, (bf16_t*)(ws + WS_H), wv);
        } else if (step == 1 || step == 4) {
            if (step == 4) rwkv_post_phase(p, l, wv);
            E.mode = pg8::EM_INPROJ; E.o0 = (bf16_t*)(ws + WS_Q); E.o1 = (bf16_t*)(ws + WS_K); E.o2 = (bf16_t*)(ws + WS_V); E.o3 = (bf16_t*)(ws + WS_RAW); E.o4 = (bf16_t*)(ws + WS_UV);
            E.ropec = (const float*)(ws + WS_ROPEC); E.ropes = (const float*)(ws + WS_ROPES);
            g.A = H; g.Bt = (const bf16_t*)(ws + WS_WIN); g.lda = 1024; g.K = 1024;
            if (step == 1) S.init(64, 7, G, c, 7, 6, 0); else S.init(64, 10, G, c, 6, 0, 13);
            do_gemm = true;
        } else if (step == 2) { rwkv_derived_phase(p, l, lds, wv); }
        else if (step == 3) { rwkv_scan_phase(p, lds, wv); }
        else if (step == 5) { attention_phase(p, lds, wv); gmlp_phase(p, l, lds, wv); }
        else if (step == 6) {
            E.mode = pg8::EM_MERGE; E.o0 = (bf16_t*)(ws + WS_GATE); E.o1 = (bf16_t*)(ws + WS_MB);
            g.merge = 1; g.A = H; g.Bt = (const bf16_t*)(ws + WS_WIN); g.lda = 1024; g.K = 1024;
            S.init(64, 4, G, c, 4, 0, 0, 6);
            do_gemm = true;
        } else if (step == 7) {
            E.mode = pg8::EM_RESID; E.f0 = p->out; E.f1 = xin; E.f2 = ml + 2048;
            g.A = (const bf16_t*)(ws + WS_MB); g.Bt = (const bf16_t*)(ws + WS_WOUT); g.lda = 1024; g.K = 1024;
            S.init(64, 4, G, c, 4, 0, 0); do_gemm = true;
        } else if (step == 8) { norm_mod_phase(p->out, p->in[23] + l * DM, ml + 3072, ml + 4096, (bf16_t*)(ws + WS_H), wv); }
        else if (step == 9) {
            E.mode = pg8::EM_UP; E.o0 = (bf16_t*)(ws + WS_UP); E.f0 = (float*)(ws + WS_SIDEA); E.f3 = (float*)(ws + WS_SIDEG); E.f1 = p->in[25] + (size_t)l * 3 * DFF; E.f2 = p->in[26] + (size_t)l * DFF;
            g.A = H; g.Bt = (const bf16_t*)(ws + WS_WUP); g.lda = 1024; g.K = 1024;
            S.init(64, 22, G, c, 22, 0, 0); do_gemm = true;
        } else if (step == 10) { ffn_fix_phase(p, l, wv); }
        else {
            E.mode = pg8::EM_RESID; E.f0 = p->out; E.f1 = p->out; E.f2 = ml + 5120;
            g.A = (const bf16_t*)(ws + WS_UP); g.Bt = (const bf16_t*)(ws + WS_WDN); g.lda = DFF; g.K = DFF;
            S.init(64, 4, G, c, 4, 0, 0); do_gemm = true;
        }
        if (do_gemm) pg8::gemm_phase(lds, g, S, E, wv);
        gbar((unsigned*)(ws + WS_BAR), xst, wv);
    }
    p = okp();
    final_norm_phase(p->out, p->in[28], wv);
}

extern "C" void kernel_launch(void* const* d_in, const int* in_sizes, int n_in, void* d_out, int out_size, void* d_ws, size_t ws_size, hipStream_t stream) {
    static int grid_blocks = 0;
    if (grid_blocks == 0) {
        int dev = 0, cus = 0, per_cu = 0;
        hipGetDevice(&dev);
        hipDeviceGetAttribute(&cus, hipDeviceAttributeMultiprocessorCount, dev);
        if (hipFuncSetAttribute((const void*)fwd_megakernel, hipFuncAttributeMaxDynamicSharedMemorySize, LDS_BYTES) != hipSuccess) { fprintf(stderr, "hipFuncSetAttribute failed\n"); }
        hipOccupancyMaxActiveBlocksPerMultiprocessor(&per_cu, (const void*)fwd_megakernel, 512, LDS_BYTES);
        if (per_cu < 1) { fprintf(stderr, "occupancy query returned %d\n", per_cu); per_cu = 1; }
        if (per_cu > 1) per_cu = 1;
        grid_blocks = cus * per_cu;
        (void)hipGetLastError();
    }
    if (n_in != 29 || ws_size < 256 * MiB) { fprintf(stderr, "unexpected inputs/workspace\n"); return; }
    (void)hipMemsetAsync((unsigned char*)d_ws + WS_BAR, 0, XB_WORDS * 4, stream);
    Params p{};
    for (int i = 0; i < 29; ++i) p.in[i] = (const float*)d_in[i];
    p.out = (float*)d_out; p.ws = (unsigned char*)d_ws;
    void* args[] = {&p};
    hipError_t e = hipLaunchCooperativeKernel((const void*)fwd_megakernel, dim3(grid_blocks), dim3(512), args, LDS_BYTES, stream);
    if (e != hipSuccess) fprintf(stderr, "cooperative launch failed: %s (grid %d)\n", hipGetErrorString(e), grid_blocks);
}
```

```cpp
#include <hip/hip_runtime.h>
#include <hip/hip_cooperative_groups.h>
#include <cstdio>
#include <cstdint>
namespace cg = cooperative_groups;

#define LAS __attribute__((address_space(3)))
#define DI __device__ __forceinline__
typedef unsigned short bf16_t;
typedef short bf16x8 __attribute__((ext_vector_type(8)));
typedef float f32x4 __attribute__((ext_vector_type(4)));
typedef float f32x16 __attribute__((ext_vector_type(16)));
typedef unsigned u32x4 __attribute__((ext_vector_type(4)));
typedef unsigned u32x2 __attribute__((ext_vector_type(2)));

constexpr int DM = 1024, SEQ = 4096, MTOK = 16384, INC = 7424, DFF = 2816, UPC = 5632, RAWC = 1792;
constexpr int LDS_BYTES = 147456;
constexpr size_t MiB = 1048576;
constexpr size_t WS_WIN = 0, WS_WBR = WS_WIN + (size_t)INC * 1024 * 2, WS_WOUT = WS_WBR + 3u * 1024 * 512 * 2, WS_WUP = WS_WOUT + 1024u * 1024 * 2,
                 WS_WDN = WS_WUP + (size_t)UPC * 1024 * 2, WS_LWU = WS_WDN + (size_t)DFF * 1024 * 2, WS_LAU = WS_LWU + 65536, WS_LGU = WS_LAU + 65536;
constexpr size_t WS_H = 37 * MiB;
constexpr size_t WS_SMALL = 69 * MiB, WS_MOD = WS_SMALL, WS_ROPEC = WS_MOD + 262144, WS_ROPES = WS_ROPEC + 524288, WS_BONUS = WS_ROPES + 524288, WS_LSE = WS_BONUS + 524288;
constexpr size_t WS_BAR = WS_LSE + 524288;
constexpr size_t DB = 72 * MiB;
constexpr size_t WS_RAW = DB, WS_RZ = DB + 56 * MiB, WS_KP = DB + 72 * MiB, WS_KKN = DB + 88 * MiB, WS_B = DB + 104 * MiB, WS_W = DB + 120 * MiB, WS_VZ = DB + 152 * MiB, WS_G = DB + 168 * MiB;
constexpr size_t WS_YRAW = DB, WS_YSR = DB + 32 * MiB;
constexpr size_t WS_Q = DB + 56 * MiB, WS_K = DB + 72 * MiB, WS_V = DB + 88 * MiB, WS_UV = DB + 104 * MiB;
constexpr size_t WS_YSA = DB + 152 * MiB, WS_YSG = DB + 168 * MiB;
constexpr size_t WS_GATE = DB, WS_M32 = DB + 48 * MiB, WS_MB = DB + 112 * MiB;
constexpr size_t WS_UP = DB;
constexpr size_t WS_SIDEA = DB + 88 * MiB, WS_SIDEG = DB + 100 * MiB;
static_assert(WS_LGU + 131072 <= WS_H, "weights region overflow");
static_assert(WS_BAR + 64 * 26 * 4 <= DB, "small region overflow");

struct Params {
    const float* in[29];
    float* out;
    unsigned char* ws;
};

typedef const __attribute__((address_space(4))) Params* KP;
DI KP okp() { unsigned long long k = (unsigned long long)__builtin_amdgcn_kernarg_segment_ptr(); asm volatile("" : "+s"(k)); return (KP)k; }
typedef float f32x2_t __attribute__((ext_vector_type(2)));
typedef __bf16 bf16x2_t __attribute__((ext_vector_type(2)));
DI unsigned cvt_pk_bf16(float lo, float hi) { const f32x2_t v = {lo, hi}; const bf16x2_t r = __builtin_convertvector(v, bf16x2_t); return __builtin_bit_cast(unsigned, r); }
DI float bf_lo(unsigned w) { return __uint_as_float(w << 16); }
DI float bf_hi(unsigned w) { return __uint_as_float(w & 0xffff0000u); }
DI int otid(int wv) { int ln; asm volatile("v_mbcnt_lo_u32_b32 %0, -1, 0\n\tv_mbcnt_hi_u32_b32 %0, -1, %0" : "=v"(ln)); return wv * 64 + ln; }
DI unsigned char* ows(unsigned char* w) { asm volatile("" : "+s"(w)); return w; }
DI float row16_sum(float v) {
    v += __builtin_bit_cast(float, __builtin_amdgcn_update_dpp(0, __builtin_bit_cast(int, v), 0xB1, 0xF, 0xF, false));
    v += __builtin_bit_cast(float, __builtin_amdgcn_update_dpp(0, __builtin_bit_cast(int, v), 0x4E, 0xF, 0xF, false));
    v += __builtin_bit_cast(float, __builtin_amdgcn_update_dpp(0, __builtin_bit_cast(int, v), 0x141, 0xF, 0xF, false));
    v += __builtin_bit_cast(float, __builtin_amdgcn_update_dpp(0, __builtin_bit_cast(int, v), 0x140, 0xF, 0xF, false));
    return v;
}
DI float wave_sum(float v) { v = row16_sum(v); v += __shfl_xor(v, 16); v += __shfl_xor(v, 32); return v; }
#define XB_CNT(j)  (64 * (j))
#define XB_SUB(j)  (64 * (8 + (j)))
#define XB_GEN(j)  (64 * (16 + (j)))
#define XB_TOP     (64 * 24)
#define XB_TOPGEN  (64 * 25)
#define XB_WORDS   (64 * 26)
DI unsigned xb_ld(unsigned* p) { return __hip_atomic_load(p, __ATOMIC_RELAXED, __HIP_MEMORY_SCOPE_AGENT); }
DI unsigned xb_add(unsigned* p, unsigned v) { return __hip_atomic_fetch_add(p, v, __ATOMIC_RELAXED, __HIP_MEMORY_SCOPE_AGENT); }
DI unsigned xb_xcc_id() { return (unsigned)__builtin_amdgcn_s_getreg((3 << 11) | 20) & 0x7u; }
DI void gbar(unsigned* bar, volatile LAS unsigned* st, int wv) {
    asm volatile("s_waitcnt vmcnt(0) lgkmcnt(0)" ::: "memory");
    __syncthreads();
    if (otid(wv) == 0) {
        const unsigned nloc = st[0], nx = st[1], x = st[2];
        const unsigned old = xb_add(&bar[XB_SUB(x)], 1u);
        const unsigned gen = old / nloc;
        if (old + 1u == (gen + 1u) * nloc) {
            __builtin_amdgcn_fence(__ATOMIC_RELEASE, "agent");
            asm volatile("s_waitcnt vmcnt(0)" ::: "memory");
            const unsigned og = xb_add(&bar[XB_TOP], 1u);
            const unsigned tg = og / nx;
            if (og + 1u == (tg + 1u) * nx) xb_add(&bar[XB_TOPGEN], 1u);
            else { while (xb_ld(&bar[XB_TOPGEN]) == tg) __builtin_amdgcn_s_sleep(1); }
            __builtin_amdgcn_fence(__ATOMIC_ACQUIRE, "agent");
            xb_add(&bar[XB_GEN(x)], 1u);
            asm volatile("s_waitcnt vmcnt(0)" ::: "memory");
        } else {
            while (xb_ld(&bar[XB_GEN(x)]) == gen) __builtin_amdgcn_s_sleep(1);
            __builtin_amdgcn_fence(__ATOMIC_ACQUIRE, "agent");
            asm volatile("s_waitcnt vmcnt(0)" ::: "memory");
        }
    }
    asm volatile("" ::: "memory");
    __syncthreads();
}
DI float sigmoidf_(float x) { return __builtin_amdgcn_rcpf(1.0f + __expf(-x)); }
DI float gelu_tanh(float x) { const float u = 1.5957691216f * (x + 0.044715f * x * x * x); return x * __builtin_amdgcn_rcpf(1.0f + __expf(-u)); }
#define LDS_WAIT() asm volatile("s_waitcnt lgkmcnt(0)" ::: "memory")
#define MFMA32(a, b, c) __builtin_amdgcn_mfma_f32_32x32x16_bf16((a), (b), (c), 0, 0, 0)
DI int crow(int reg, int h) { return (reg & 3) + 8 * (reg >> 2) + 4 * h; }
DI bf16x8 pack8(float a0, float a1, float a2, float a3, float a4, float a5, float a6, float a7) {
    u32x4 p; p.x = cvt_pk_bf16(a0, a1); p.y = cvt_pk_bf16(a2, a3); p.z = cvt_pk_bf16(a4, a5); p.w = cvt_pk_bf16(a6, a7);
    return __builtin_bit_cast(bf16x8, p);
}

namespace pg8 {
constexpr int BM = 256, BK = 64, HALF = 128, HTB = HALF * BK * 2, STAGE_BYTES = 8 * HTB, NXCD = 8, WGM = 8;
DI int lds_byte(int r, int c) { const int st = (r >> 4) * 2 + (c >> 5), rr = r & 15, cc = c & 31, ob = rr * 64 + cc * 2; return st * 1024 + (ob ^ (((ob >> 9) & 1) << 5)); }
DI void stage_rc(int b, int& R, int& C) { const int st = b / 1024, sb = b % 1024, swz = sb ^ (((sb >> 9) & 1) << 5); R = (st >> 1) * 16 + swz / 64; C = (st & 1) * 32 + (swz % 64) / 2; }
DI int perm32(int rho) { const int n = rho >> 4, i = rho & 15; return 8 * (i >> 2) + 4 * n + (i & 3); }
struct Unit { int pm, pn, sub; };
struct Gemm { const bf16_t* A; const bf16_t* Bt; int lda, K; int merge; const unsigned char* ws; };
struct TileOrder {
    int nM, nN, nwg, G, c, split, off0, off1, nsub;
    DI void init(int nM_, int nN_, int G_, int c_, int split_, int off0_, int off1_, int nsub_ = 1) { nM = nM_; nN = nN_; nwg = nM * nN; G = G_; c = c_; split = split_; off0 = off0_; off1 = off1_; nsub = nsub_; }
    DI bool next(int i0, Unit& u) const {
        const int i = i0 / nsub; u.sub = i0 - i * nsub;
        const long L = (long)i * G + c; if (L >= nwg) return false;
        int wgid = (int)L; { const int q = nwg / NXCD, r = nwg % NXCD, xcd = wgid % NXCD, off = wgid / NXCD; wgid = (xcd < r ? xcd * (q + 1) : r * (q + 1) + (xcd - r) * q) + off; }
        const int nig = WGM * nN, gid = wgid / nig, fm = gid * WGM, gsz = (nM - fm) < WGM ? (nM - fm) : WGM;
        u.pm = fm + ((wgid % nig) % gsz); const int pnv = (wgid % nig) / gsz; u.pn = pnv < split ? pnv + off0 : pnv - split + off1; return true;
    }
};

enum { EM_INPROJ = 0, EM_GATE = 1, EM_BR_FIRST = 2, EM_BR_MID = 3, EM_BR_LAST = 4, EM_RESID = 5, EM_UP = 6, EM_MERGE = 7 };
struct Epi {
    int mode;
    bf16_t *o0, *o1, *o2, *o3, *o4;
    float* f3;
    float* f0; const float* f1; const float* f2;
    const float *ropec, *ropes;
    DI void up_conv(const f32x4 (&acc)[2][2][4][2], const Unit& u, int wr, int wc, int fr, int fq) const {
        const int f = u.pn * 128 + wc * 32 + 8 * fq;
        const int src1 = (fq << 4) | ((fr + 15) & 15), src2 = (fq << 4) | ((fr + 14) & 15);
        const f32x4 w0a = *(const f32x4*)(f1 + f), w0b = *(const f32x4*)(f1 + f + 4), w1a = *(const f32x4*)(f1 + DFF + f), w1b = *(const f32x4*)(f1 + DFF + f + 4);
        const f32x4 w2a = *(const f32x4*)(f1 + 2 * DFF + f), w2b = *(const f32x4*)(f1 + 2 * DFF + f + 4), cba = *(const f32x4*)(f2 + f), cbb = *(const f32x4*)(f2 + f + 4);
#pragma unroll
        for (int ai = 0; ai < 2; ++ai) {
            const int q = u.pm * 4 + ai * 2 + wr;
            f32x4 p1a_prev = {0.f, 0.f, 0.f, 0.f}, p1b_prev = p1a_prev, p2a_prev = p1a_prev, p2b_prev = p1a_prev;
#pragma unroll
            for (int m = 0; m < 4; ++m) {
                const f32x4 aa = acc[ai][0][m][0], ab = acc[ai][0][m][1], ga = acc[ai][1][m][0], gb = acc[ai][1][m][1];
                f32x4 p1a, p1b, p2a, p2b;
#pragma unroll
                for (int j = 0; j < 4; ++j) {
                    p1a[j] = __shfl(aa[j], src1); p1b[j] = __shfl(ab[j], src1); p2a[j] = __shfl(aa[j], src2); p2b[j] = __shfl(ab[j], src2);
                }
                const f32x4 t1a = fr >= 1 ? p1a : p1a_prev, t1b = fr >= 1 ? p1b : p1b_prev, t2a = fr >= 2 ? p2a : p2a_prev, t2b = fr >= 2 ? p2b : p2b_prev;
                const f32x4 ca = cba + w0a * t2a + w1a * t1a + w2a * aa, cb_ = cbb + w0b * t2b + w1b * t1b + w2b * ab;
                const int row = u.pm * BM + ai * HALF + wr * 64 + m * 16 + fr;
                u32x4 w;
                w.x = cvt_pk_bf16(gelu_tanh(ca[0]) * ga[0], gelu_tanh(ca[1]) * ga[1]); w.y = cvt_pk_bf16(gelu_tanh(ca[2]) * ga[2], gelu_tanh(ca[3]) * ga[3]);
                w.z = cvt_pk_bf16(gelu_tanh(cb_[0]) * gb[0], gelu_tanh(cb_[1]) * gb[1]); w.w = cvt_pk_bf16(gelu_tanh(cb_[2]) * gb[2], gelu_tanh(cb_[3]) * gb[3]);
                *(u32x4*)(o0 + (size_t)row * DFF + f) = w;
                if (m == 0 && fr < 2) {
                    float* sa = f0 + ((size_t)q * 4 + fr) * DFF + f; *(f32x4*)sa = aa; *(f32x4*)(sa + 4) = ab;
                    float* sg = f3 + ((size_t)q * 2 + fr) * DFF + f; *(f32x4*)sg = ga; *(f32x4*)(sg + 4) = gb;
                }
                if (m == 3 && fr >= 14) { float* sa = f0 + ((size_t)q * 4 + 2 + (fr - 14)) * DFF + f; *(f32x4*)sa = aa; *(f32x4*)(sa + 4) = ab; }
                p1a_prev = p1a; p1b_prev = p1b; p2a_prev = p2a; p2b_prev = p2b;
            }
        }
    }
    DI void operator()(const f32x4 (&acc)[2][2][4][2], const Unit& u, int wr, int wc, int fr, int fq) const {
        if (mode == EM_UP) { up_conv(acc, u, wr, wc, fr, fq); return; }
        const int mode = (this->mode == EM_MERGE) ? (((u.sub & 1) == 0) ? (int)EM_GATE : ((u.sub >> 1) == 0 ? (int)EM_BR_FIRST : ((u.sub >> 1) == 1 ? (int)EM_BR_MID : (int)EM_BR_LAST))) : this->mode;
        const int row0 = u.pm * BM + wr * 64 + fr, colb = u.pn * BM + wc * 32 + 8 * fq;
        if (mode == EM_RESID) {
            const float* gv = f2 + (size_t)(row0 >> 12) * 6144 + colb;
            const f32x4 g00 = *(const f32x4*)gv, g01 = *(const f32x4*)(gv + 4), g10 = *(const f32x4*)(gv + HALF), g11 = *(const f32x4*)(gv + HALF + 4);
#pragma unroll
            for (int ai = 0; ai < 2; ++ai) {
                f32x4 b0[4][2], b1[4][2];
#pragma unroll
                for (int m = 0; m < 4; ++m)
#pragma unroll
                    for (int bj = 0; bj < 2; ++bj) { const size_t off = (size_t)(row0 + ai * HALF + m * 16) * 1024 + colb + bj * HALF; b0[m][bj] = *(const f32x4*)(f1 + off); b1[m][bj] = *(const f32x4*)(f1 + off + 4); }
                asm volatile("" ::: "memory");
#pragma unroll
                for (int m = 0; m < 4; ++m)
#pragma unroll
                    for (int bj = 0; bj < 2; ++bj) { const size_t off = (size_t)(row0 + ai * HALF + m * 16) * 1024 + colb + bj * HALF;
                        *(f32x4*)(f0 + off) = b0[m][bj] + (bj ? g10 : g00) * acc[ai][bj][m][0]; *(f32x4*)(f0 + off + 4) = b1[m][bj] + (bj ? g11 : g01) * acc[ai][bj][m][1]; }
            }
            return;
        }
        if (mode == EM_BR_FIRST || mode == EM_BR_MID || mode == EM_BR_LAST) {
#pragma unroll
            for (int ai = 0; ai < 2; ++ai) {
                u32x4 gw[4][2], pm[4][2];
#pragma unroll
                for (int m = 0; m < 4; ++m)
#pragma unroll
                    for (int bj = 0; bj < 2; ++bj) { const size_t off = (size_t)(row0 + ai * HALF + m * 16) * 1024 + colb + bj * HALF; gw[m][bj] = *(const u32x4*)(o0 + off);
                        pm[m][bj] = (u32x4){0u, 0u, 0u, 0u}; if (mode != EM_BR_FIRST) pm[m][bj] = *(const u32x4*)(o1 + off); }
                asm volatile("" ::: "memory");
#pragma unroll
                for (int m = 0; m < 4; ++m)
#pragma unroll
                    for (int bj = 0; bj < 2; ++bj) { const size_t off = (size_t)(row0 + ai * HALF + m * 16) * 1024 + colb + bj * HALF;
                        const f32x4 v0 = acc[ai][bj][m][0], v1 = acc[ai][bj][m][1]; const u32x4 g_ = gw[m][bj], q_ = pm[m][bj];
                        u32x4 w;
                        w.x = cvt_pk_bf16(bf_lo(g_.x) * v0[0] + bf_lo(q_.x), bf_hi(g_.x) * v0[1] + bf_hi(q_.x)); w.y = cvt_pk_bf16(bf_lo(g_.y) * v0[2] + bf_lo(q_.y), bf_hi(g_.y) * v0[3] + bf_hi(q_.y));
                        w.z = cvt_pk_bf16(bf_lo(g_.z) * v1[0] + bf_lo(q_.z), bf_hi(g_.z) * v1[1] + bf_hi(q_.z)); w.w = cvt_pk_bf16(bf_lo(g_.w) * v1[2] + bf_lo(q_.w), bf_hi(g_.w) * v1[3] + bf_hi(q_.w));
                        *(u32x4*)(o1 + off) = w; }
            }
            return;
        }
#pragma unroll
        for (int ai = 0; ai < 2; ++ai) {
            f32x4 csn[4][2], snn[4][2];
            if (mode == EM_INPROJ && u.pn < 4) {
#pragma unroll
                for (int m = 0; m < 4; ++m)
#pragma unroll
                    for (int bj = 0; bj < 2; ++bj) { const int pos = (row0 + ai * HALF + m * 16) & (SEQ - 1), e0 = ((colb + bj * HALF) & 63) >> 1;
                        csn[m][bj] = *(const f32x4*)(ropec + pos * 32 + e0); snn[m][bj] = *(const f32x4*)(ropes + pos * 32 + e0); }
                asm volatile("" ::: "memory");
            }
#pragma unroll
            for (int m = 0; m < 4; ++m) {
                const int row = row0 + ai * HALF + m * 16;
#pragma unroll
                for (int bj = 0; bj < 2; ++bj) {
                    const int col0 = colb + bj * HALF;
                    f32x4 v0 = acc[ai][bj][m][0], v1 = acc[ai][bj][m][1];
                    if (mode == EM_INPROJ) {
                        bf16_t* dst;
                        if (u.pn < 4) {
                            const f32x4 cs = csn[m][bj], sn = snn[m][bj];
                            f32x4 a, b;
                            a[0] = v0[0] * cs[0] - v0[1] * sn[0]; a[1] = v0[1] * cs[0] + v0[0] * sn[0];
                            a[2] = v0[2] * cs[1] - v0[3] * sn[1]; a[3] = v0[3] * cs[1] + v0[2] * sn[1];
                            b[0] = v1[0] * cs[2] - v1[1] * sn[2]; b[1] = v1[1] * cs[2] + v1[0] * sn[2];
                            b[2] = v1[2] * cs[3] - v1[3] * sn[3]; b[3] = v1[3] * cs[3] + v1[2] * sn[3];
                            v0 = a; v1 = b;
                            dst = (u.pn < 2) ? o0 + (size_t)row * 512 + col0 : o1 + (size_t)row * 512 + (col0 - 512);
                        } else if (u.pn < 6) { dst = o2 + (size_t)row * 512 + (col0 - 1024); }
                        else if (u.pn < 13) { dst = o3 + (size_t)row * RAWC + (col0 - 1536); }
                        else {
#pragma unroll
                            for (int j = 0; j < 4; ++j) { v0[j] = gelu_tanh(v0[j]); v1[j] = gelu_tanh(v1[j]); }
                            dst = o4 + (size_t)row * 1024 + (col0 - 3328);
                        }
                        u32x4 w; w.x = cvt_pk_bf16(v0[0], v0[1]); w.y = cvt_pk_bf16(v0[2], v0[3]); w.z = cvt_pk_bf16(v1[0], v1[1]); w.w = cvt_pk_bf16(v1[2], v1[3]);
                        *(u32x4*)dst = w;
                    } else {
#pragma unroll
                        for (int j = 0; j < 4; ++j) { v0[j] = sigmoidf_(v0[j]); v1[j] = sigmoidf_(v1[j]); }
                        u32x4 w; w.x = cvt_pk_bf16(v0[0], v0[1]); w.y = cvt_pk_bf16(v0[2], v0[3]); w.z = cvt_pk_bf16(v1[0], v1[1]); w.w = cvt_pk_bf16(v1[2], v1[3]);
                        *(u32x4*)(o0 + (size_t)row * 1024 + col0) = w;
                    }
                }
            }
        }
    }
};

DI void unit_operands(const Gemm& g, int sub, const char*& A, const char*& Bt, int& lda, int& K) {
    if (!g.merge) { A = (const char*)g.A; Bt = (const char*)g.Bt; lda = g.lda; K = g.K; return; }
    const int br = sub >> 1;
    if ((sub & 1) == 0) { A = (const char*)(g.ws + WS_H); Bt = (const char*)(g.ws + WS_WIN) + (size_t)(4352 + 1024 * br) * 1024 * 2; lda = 1024; K = 1024; }
    else { A = (const char*)(g.ws + (br == 0 ? WS_YSA : (br == 1 ? WS_YSR : WS_YSG))); Bt = (const char*)(g.ws + WS_WBR) + (size_t)br * 1024 * 512 * 2; lda = 512; K = 512; }
}
DI void gemm_phase(LAS unsigned char* lds, const Gemm g, const TileOrder S, const Epi E, int wv) {
    const int tid = otid(wv), wid = __builtin_amdgcn_readfirstlane(tid >> 6), lane = tid & 63, wr = wid >> 2, wc = wid & 3, fr = lane & 15, fq = lane >> 4;
    int stR[2], stC[2], stRb[2];
#pragma unroll
    for (int i = 0; i < 2; ++i) { int R, C; stage_rc(tid * 16 + i * 8192, R, C); stR[i] = R; stC[i] = C; stRb[i] = (R & ~31) + perm32(R & 31); }
    const size_t kstep = (size_t)(BK * 2);
    const unsigned ldsw = (unsigned)wid * 1024u;
    const int aoff = lds_byte(wr * 64 + fr, fq * 8), boff = lds_byte(wc * 32 + fr, fq * 8);
#define PG8_SA(b, h) (((b) * 2 + (h)) * HTB)
#define PG8_SB(b, h) ((4 + (b) * 2 + (h)) * HTB)
#define PG8_STAGE(bufoff, gbase, voff) do { _Pragma("unroll") for (int _i = 0; _i < 2; ++_i) \
        __builtin_amdgcn_global_load_lds((const unsigned*)((const char*)(gbase) + (voff)[_i]), (LAS unsigned*)(lds + (bufoff) + ldsw + _i * 8192), 16, 0, 0); } while (0)
#define PG8_LDA(dst, b, h) do { _Pragma("unroll") for (int m = 0; m < 4; ++m) _Pragma("unroll") for (int k = 0; k < 2; ++k) dst[m][k] = *(const LAS bf16x8*)(lds + PG8_SA(b, h) + aoff + m * 2048 + k * 1024); } while (0)
#define PG8_LDB(dst, b, h) do { _Pragma("unroll") for (int n = 0; n < 2; ++n) _Pragma("unroll") for (int k = 0; k < 2; ++k) dst[n][k] = *(const LAS bf16x8*)(lds + PG8_SB(b, h) + boff + n * 2048 + k * 1024); } while (0)
#define PG8_MMA(ai, bj, At, Bt) do { __builtin_amdgcn_s_setprio(1); _Pragma("unroll") for (int m = 0; m < 4; ++m) _Pragma("unroll") for (int n = 0; n < 2; ++n) _Pragma("unroll") for (int k = 0; k < 2; ++k) \
        acc[ai][bj][m][n] = __builtin_amdgcn_mfma_f32_16x16x32_bf16(Bt[n][k], At[m][k], acc[ai][bj][m][n], 0, 0, 0); __builtin_amdgcn_s_setprio(0); } while (0)
#define PG8_WAIT_V(n) asm volatile("s_waitcnt vmcnt(" #n ")" ::: "memory")
#define PG8_WAIT_L(n) asm volatile("s_waitcnt lgkmcnt(" #n ")" ::: "memory")
#define PG8_BAR __builtin_amdgcn_s_barrier()
#define PG8_SCHED __builtin_amdgcn_sched_barrier(0)
#define PG8_SETUP(u, pA, pB, vA, vB, hA, hB, ntv) do { const char* _A; const char* _B; int _lda, _K; unit_operands(g, (u).sub, _A, _B, _lda, _K); \
        pA = _A + (size_t)(u).pm * 256 * _lda * 2; pB = _B + (size_t)(u).pn * 256 * _K * 2; hA = (size_t)HALF * _lda * 2; hB = (size_t)HALF * _K * 2; ntv = _K / BK; \
        _Pragma("unroll") for (int _i = 0; _i < 2; ++_i) { vA[_i] = (unsigned)(stR[_i] * _lda + stC[_i]) * 2u; vB[_i] = (unsigned)(stRb[_i] * _K + stC[_i]) * 2u; } } while (0)
    Unit cur, nxt; int ui = 0;
    if (!S.next(0, cur)) return;
    f32x4 acc[2][2][4][2];
#pragma unroll
    for (int a = 0; a < 2; ++a)
#pragma unroll
        for (int b = 0; b < 2; ++b)
#pragma unroll
            for (int m = 0; m < 4; ++m)
#pragma unroll
                for (int n = 0; n < 2; ++n) acc[a][b][m][n] = (f32x4){0.f, 0.f, 0.f, 0.f};
    bf16x8 At[4][2], B0[2][2], B1[2][2];
    const char *cA, *cB, *nA, *nB; unsigned vAc[2], vBc[2], vAn[2], vBn[2]; size_t hAc, hBc, hAn, hBn; int nt, ntn;
    PG8_SETUP(cur, cA, cB, vAc, vBc, hAc, hBc, nt);
    PG8_STAGE(PG8_SB(0, 0), cB, vBc); PG8_STAGE(PG8_SB(0, 1), cB + hBc, vBc); PG8_STAGE(PG8_SA(0, 0), cA, vAc); PG8_STAGE(PG8_SA(0, 1), cA + hAc, vAc);
    if (wr == 1) PG8_BAR;
    PG8_WAIT_V(2); PG8_BAR;
    PG8_STAGE(PG8_SB(1, 0), cB + kstep, vBc); PG8_STAGE(PG8_SA(1, 0), cA + kstep, vAc); PG8_STAGE(PG8_SB(1, 1), cB + hBc + kstep, vBc);
    PG8_WAIT_V(6); PG8_BAR;
    for (;;) {
        const bool has_next = S.next(ui + 1, nxt);
        if (has_next) { PG8_SETUP(nxt, nA, nB, vAn, vBn, hAn, hBn, ntn); }
        else { nA = cA; nB = cB; vAn[0] = vAc[0]; vAn[1] = vAc[1]; vBn[0] = vBc[0]; vBn[1] = vBc[1]; hAn = hAc; hBn = hBc; ntn = nt; }
        for (int t = 0; t < nt; t += 2) {
            const bool last = (t == nt - 2);
            const char* a1 = cA + (size_t)(t + 1) * kstep;
            const char* a2 = last ? nA : cA + (size_t)(t + 2) * kstep; const char* b2 = last ? nB : cB + (size_t)(t + 2) * kstep;
            const char* a3 = a2 + kstep; const char* b3 = b2 + kstep;
            unsigned vA2[2], vB2[2]; vA2[0] = last ? vAn[0] : vAc[0]; vA2[1] = last ? vAn[1] : vAc[1]; vB2[0] = last ? vBn[0] : vBc[0]; vB2[1] = last ? vBn[1] : vBc[1];
            const size_t hA2 = last ? hAn : hAc, hB2 = last ? hBn : hBc;
            PG8_LDB(B0, 0, 0); PG8_LDB(B1, 0, 1); PG8_SCHED; PG8_LDA(At, 0, 0); PG8_STAGE(PG8_SA(1, 1), a1 + hAc, vAc);
            PG8_WAIT_V(8); PG8_WAIT_L(0); PG8_BAR; PG8_MMA(0, 0, At, B0); PG8_MMA(0, 1, At, B1); PG8_BAR; PG8_SCHED;
            PG8_LDA(At, 0, 1); PG8_STAGE(PG8_SB(0, 0), b2, vB2); PG8_STAGE(PG8_SB(0, 1), b2 + hB2, vB2); PG8_STAGE(PG8_SA(0, 0), a2, vA2);
            PG8_WAIT_V(8); PG8_WAIT_L(0); PG8_BAR; PG8_MMA(1, 0, At, B0); PG8_MMA(1, 1, At, B1); PG8_BAR; PG8_SCHED;
            PG8_LDB(B0, 1, 0); PG8_LDB(B1, 1, 1); PG8_SCHED; PG8_LDA(At, 1, 0); PG8_STAGE(PG8_SA(0, 1), a2 + hA2, vA2);
            PG8_WAIT_V(8); PG8_WAIT_L(0); PG8_BAR; PG8_MMA(0, 0, At, B0); PG8_MMA(0, 1, At, B1); PG8_BAR; PG8_SCHED;
            PG8_LDA(At, 1, 1); PG8_STAGE(PG8_SB(1, 0), b3, vB2); PG8_STAGE(PG8_SB(1, 1), b3 + hB2, vB2); PG8_STAGE(PG8_SA(1, 0), a3, vA2);
            PG8_WAIT_V(8); PG8_WAIT_L(0); PG8_BAR; PG8_MMA(1, 0, At, B0); PG8_MMA(1, 1, At, B1); PG8_BAR; PG8_SCHED;
        }
        if (wr == 0) PG8_BAR;
        E(acc, cur, wr, wc, fr, fq);
        if (!has_next) break;
#pragma unroll
        for (int a = 0; a < 2; ++a)
#pragma unroll
            for (int b = 0; b < 2; ++b)
#pragma unroll
                for (int m = 0; m < 4; ++m)
#pragma unroll
                    for (int n = 0; n < 2; ++n) acc[a][b][m][n] = (f32x4){0.f, 0.f, 0.f, 0.f};
        cur = nxt; cA = nA; cB = nB; vAc[0] = vAn[0]; vAc[1] = vAn[1]; vBc[0] = vBn[0]; vBc[1] = vBn[1]; hAc = hAn; hBc = hBn; nt = ntn; ++ui;
        if (wr == 1) PG8_BAR;
    }
    PG8_WAIT_V(0);
    PG8_BAR;
#undef PG8_SA
#undef PG8_SB
#undef PG8_STAGE
#undef PG8_LDA
#undef PG8_LDB
#undef PG8_MMA
#undef PG8_WAIT_V
#undef PG8_WAIT_L
#undef PG8_BAR
#undef PG8_SCHED
#undef PG8_SETUP
}
}

template <int PERMK>
DI void transpose_item(const float* W, int K, int N, bf16_t* WT, LAS float* scr, int item, int lane) {
    const int nblk = N / 32, kb = item / nblk, nb = item % nblk, k0 = 64 * kb, n0 = 32 * nb;
    int sc = n0 + (lane & 31);
    if (PERMK == 1 && sc < 1024) { const int hd = sc >> 6, cp = sc & 63; sc = hd * 64 + 32 * (cp & 1) + (cp >> 1); }
    if (PERMK == 2) { const int tl = sc >> 8, w = sc & 255; sc = (w < 128) ? (128 * tl + w) : (DFF + 128 * tl + (w - 128)); }
#pragma unroll 8
    for (int i = 0; i < 32; ++i) { const int kk = 2 * i + (lane >> 5); scr[kk * 33 + (lane & 31)] = W[(size_t)(k0 + kk) * N + sc]; }
    LDS_WAIT();
    const int c = lane & 7;
#pragma unroll
    for (int j = 0; j < 4; ++j) { const int n = (lane >> 3) + 8 * j; const LAS float* s = scr + (8 * c) * 33 + n;
        u32x4 o; o.x = cvt_pk_bf16(s[0 * 33], s[1 * 33]); o.y = cvt_pk_bf16(s[2 * 33], s[3 * 33]); o.z = cvt_pk_bf16(s[4 * 33], s[5 * 33]); o.w = cvt_pk_bf16(s[6 * 33], s[7 * 33]);
        *(u32x4*)(WT + (size_t)(n0 + n) * K + k0 + 8 * c) = o; }
    LDS_WAIT();
}

DI void convert_weights(KP p, int l, LAS unsigned char* lds, int wv) {
    const int tid_ = otid(wv); const int wave = tid_ >> 6, lane = tid_ & 63;
    LAS float* scr = (LAS float*)(lds + wave * 8448);
    const int gw = blockIdx.x * 8 + wave, NGW = gridDim.x * 8;
    constexpr int I_IN = 16 * (INC / 32), I_BR = 8 * 32, I_OUT = 16 * 32, I_UP = 16 * (UPC / 32), I_DN = (DFF / 64) * 32, I_L64 = 16, I_L128 = 32;
    constexpr int NIT = I_IN + 3 * I_BR + I_OUT + I_UP + I_DN + 2 * I_L64 + I_L128;
    unsigned char* ws = ows(p->ws);
    for (int it = gw; it < NIT; it += NGW) {
        int r = it;
        if (r < I_IN) { transpose_item<1>(p->in[5] + (size_t)l * 1024 * INC, 1024, INC, (bf16_t*)(ws + WS_WIN), scr, r, lane); continue; } r -= I_IN;
        if (r < 3 * I_BR) { const int b = r / I_BR; transpose_item<0>(p->in[21] + ((size_t)l * 3 + b) * 512 * 1024, 512, 1024, (bf16_t*)(ws + WS_WBR) + (size_t)b * 1024 * 512, scr, r % I_BR, lane); continue; } r -= 3 * I_BR;
        if (r < I_OUT) { transpose_item<0>(p->in[22] + (size_t)l * 1024 * 1024, 1024, 1024, (bf16_t*)(ws + WS_WOUT), scr, r, lane); continue; } r -= I_OUT;
        if (r < I_UP) { transpose_item<2>(p->in[24] + (size_t)l * 1024 * UPC, 1024, UPC, (bf16_t*)(ws + WS_WUP), scr, r, lane); continue; } r -= I_UP;
        if (r < I_DN) { transpose_item<0>(p->in[27] + (size_t)l * DFF * 1024, DFF, 1024, (bf16_t*)(ws + WS_WDN), scr, r, lane); continue; } r -= I_DN;
        if (r < I_L64) { transpose_item<0>(p->in[8] + (size_t)l * 64 * 512, 64, 512, (bf16_t*)(ws + WS_LWU), scr, r, lane); continue; } r -= I_L64;
        if (r < I_L64) { transpose_item<0>(p->in[10] + (size_t)l * 64 * 512, 64, 512, (bf16_t*)(ws + WS_LAU), scr, r, lane); continue; } r -= I_L64;
        transpose_item<0>(p->in[11] + (size_t)l * 128 * 512, 128, 512, (bf16_t*)(ws + WS_LGU), scr, r, lane);
    }
}

DI void phase0(KP p, LAS unsigned char* lds, int wv) {
    const int tid = otid(wv);
    float* ropec = (float*)(p->ws + WS_ROPEC); float* ropes = (float*)(p->ws + WS_ROPES);
    for (int idx = blockIdx.x * 512 + tid; idx < SEQ * 32; idx += gridDim.x * 512) {
        const int pos = idx >> 5, e = idx & 31;
        const float inv = 1.0f / exp2f((float)e * (13.287712379549449f / 32.0f));
        const float ang = (float)pos * inv;
        double rev = (double)ang * 0.15915494309189535; rev -= rint(rev);
        const float rv = (float)rev;
        ropec[idx] = __builtin_amdgcn_cosf(rv); ropes[idx] = __builtin_amdgcn_sinf(rv);
    }
    {
        LAS float* ca = (LAS float*)lds;
        LAS float* red = (LAS float*)(lds + 16384);
        float* mod = (float*)(p->ws + WS_MOD);
        bool loaded = false;
        for (int item = blockIdx.x; item < 192; item += gridDim.x) {
            if (!loaded) { for (int i = tid; i < 4096; i += 512) { const float v = p->in[1][i]; ca[i] = v / (1.0f + __expf(-v)); } loaded = true; __syncthreads(); }
            const int l = item / 96, c0 = (item % 96) * 64, cc = tid & 63, kg = tid >> 6;
            const float* w = p->in[2] + (size_t)l * 1024 * 6144 + c0 + cc;
            float a0 = 0.f, a1 = 0.f, a2 = 0.f, a3 = 0.f;
#pragma unroll 8
            for (int k = kg * 128; k < kg * 128 + 128; ++k) { const float wv = w[(size_t)k * 6144]; a0 += ca[k] * wv; a1 += ca[1024 + k] * wv; a2 += ca[2048 + k] * wv; a3 += ca[3072 + k] * wv; }
            red[(kg * 4 + 0) * 64 + cc] = a0; red[(kg * 4 + 1) * 64 + cc] = a1; red[(kg * 4 + 2) * 64 + cc] = a2; red[(kg * 4 + 3) * 64 + cc] = a3;
            __syncthreads();
            if (tid < 256) { const int b = tid >> 6; float s = 0.f;
#pragma unroll
                for (int g = 0; g < 8; ++g) s += red[(g * 4 + b) * 64 + cc];
                mod[((size_t)l * 4 + b) * 6144 + c0 + cc] = s + p->in[3][(size_t)l * 6144 + c0 + cc]; }
            __syncthreads();
        }
        __syncthreads();
    }
    convert_weights(p, 0, lds, wv);
}

DI void norm_mod_phase(const float* x, const float* g, const float* sh, const float* sc, bf16_t* H, int wv) {
    const int tid_ = otid(wv); const int wave = tid_ >> 6, lane = tid_ & 63;
    for (int row0 = (blockIdx.x * 8 + wave) * 2; row0 < MTOK; row0 += gridDim.x * 16) {
        f32x4 v[2][4]; float s[2] = {0.f, 0.f};
#pragma unroll
        for (int q = 0; q < 2; ++q) { const f32x4* xr = (const f32x4*)(x + (size_t)(row0 + q) * DM) + lane;
#pragma unroll
            for (int j = 0; j < 4; ++j) v[q][j] = xr[64 * j]; }
#pragma unroll
        for (int q = 0; q < 2; ++q)
#pragma unroll
            for (int j = 0; j < 4; ++j) s[q] += (v[q][j][0] * v[q][j][0] + v[q][j][1] * v[q][j][1]) + (v[q][j][2] * v[q][j][2] + v[q][j][3] * v[q][j][3]);
        const float rs0 = rsqrtf(wave_sum(s[0]) * (1.0f / DM) + 1e-6f), rs1 = rsqrtf(wave_sum(s[1]) * (1.0f / DM) + 1e-6f);
        const int b = row0 >> 12;
#pragma unroll
        for (int j = 0; j < 4; ++j) {
            const int c = 4 * lane + 256 * j;
            const f32x4 gg = *(const f32x4*)(g + c), s1 = *(const f32x4*)(sc + (size_t)b * 6144 + c), s0 = *(const f32x4*)(sh + (size_t)b * 6144 + c);
#pragma unroll
            for (int q = 0; q < 2; ++q) {
                const f32x4 h = (v[q][j] * (q ? rs1 : rs0) * gg) * (s1 + 1.0f) + s0;
                u32x2 w; w.x = cvt_pk_bf16(h[0], h[1]); w.y = cvt_pk_bf16(h[2], h[3]);
                *((u32x2*)(H + (size_t)(row0 + q) * DM) + lane + 64 * j) = w;
            }
        }
    }
}
DI void final_norm_phase(float* x, const float* g, int wv) {
    const int tid_ = otid(wv); const int wave = tid_ >> 6, lane = tid_ & 63;
    for (int row = blockIdx.x * 8 + wave; row < MTOK; row += gridDim.x * 8) {
        f32x4* xr = (f32x4*)(x + (size_t)row * DM) + lane;
        f32x4 v[4]; float s = 0.f;
#pragma unroll
        for (int j = 0; j < 4; ++j) { v[j] = xr[64 * j]; s += (v[j][0] * v[j][0] + v[j][1] * v[j][1]) + (v[j][2] * v[j][2] + v[j][3] * v[j][3]); }
        const float rs = rsqrtf(wave_sum(s) * (1.0f / DM) + 1e-6f);
#pragma unroll
        for (int j = 0; j < 4; ++j) { const f32x4 gg = *(const f32x4*)(g + 4 * lane + 256 * j); xr[64 * j] = v[j] * rs * gg; }
    }
}

DI bf16x8 lerp_frag(const bf16_t* cur, const bf16_t* prv, bool hasprev, const float* mu, int act) {
    const u32x4 c = *(const u32x4*)cur; u32x4 q = {0u, 0u, 0u, 0u}; if (hasprev) q = *(const u32x4*)prv;
    const f32x4 m0 = *(const f32x4*)mu, m1 = *(const f32x4*)(mu + 4);
    float z[8];
    const unsigned cw[4] = {c.x, c.y, c.z, c.w}, qw[4] = {q.x, q.y, q.z, q.w};
#pragma unroll
    for (int j = 0; j < 4; ++j) {
        const float c0 = bf_lo(cw[j]), c1 = bf_hi(cw[j]), p0 = bf_lo(qw[j]), p1 = bf_hi(qw[j]);
        const float mA = (j < 2) ? m0[2 * j] : m1[2 * j - 4], mB = (j < 2) ? m0[2 * j + 1] : m1[2 * j - 3];
        z[2 * j] = c0 + (p0 - c0) * mA; z[2 * j + 1] = c1 + (p1 - c1) * mB;
    }
#pragma unroll
    for (int j = 0; j < 8; ++j) {
        if (act == 1) { const float e = __expf(2.0f * z[j]); z[j] = 1.0f - 2.0f / (1.0f + e); }
        else if (act == 2) z[j] = sigmoidf_(z[j]);
    }
    return pack8(z[0], z[1], z[2], z[3], z[4], z[5], z[6], z[7]);
}

DI void rwkv_derived_phase(KP p0, int l, LAS unsigned char* lds, int wv) {
    const int tid_ = otid(wv); const int wave = tid_ >> 6, lane = tid_ & 63, r = lane & 31, hh = lane >> 5;
    LAS float* lp = (LAS float*)(lds + wave * 2048);
    {
        const int ch = wave * 64 + lane;
        lp[0 * 64 + lane] = p0->in[6][(size_t)l * RAWC + ch]; lp[1 * 64 + lane] = p0->in[6][(size_t)l * RAWC + 512 + ch]; lp[2 * 64 + lane] = p0->in[6][(size_t)l * RAWC + 1024 + ch];
        lp[3 * 64 + lane] = p0->in[7][l * 512 + ch]; lp[4 * 64 + lane] = p0->in[9][l * 512 + ch]; lp[5 * 64 + lane] = p0->in[12][l * 512 + ch];
        lp[6 * 64 + lane] = p0->in[13][l * 512 + ch]; lp[7 * 64 + lane] = p0->in[14][l * 512 + ch];
        LDS_WAIT();
    }
    for (int job = blockIdx.x * 8 + wave; job < 512 * 8; job += gridDim.x * 8) {
        KP p = okp(); unsigned char* ws = ows(p->ws);
        const bf16_t* RAW = (const bf16_t*)(ws + WS_RAW);
        bf16_t *RZ = (bf16_t*)(ws + WS_RZ), *KP = (bf16_t*)(ws + WS_KP), *VZ = (bf16_t*)(ws + WS_VZ), *KKN = (bf16_t*)(ws + WS_KKN), *Bv = (bf16_t*)(ws + WS_B), *G = (bf16_t*)(ws + WS_G);
        float* W = (float*)(ws + WS_W);
        const bf16_t *LWU = (const bf16_t*)(ws + WS_LWU), *LAU = (const bf16_t*)(ws + WS_LAU), *LGU = (const bf16_t*)(ws + WS_LGU);
        const float* mu = p->in[6] + (size_t)l * RAWC; const float* w0 = p->in[7] + l * 512; const float* a0 = p->in[9] + l * 512;
        const float* k_k = p->in[12] + l * 512; const float* k_a = p->in[13] + l * 512; const float* r_k = p->in[14] + l * 512;
        const int hd = job & 7, tg = job >> 3, t = tg * 32 + r;
        const bool hp = (t & (SEQ - 1)) != 0;
        const bf16_t* cur = RAW + (size_t)t * RAWC; const bf16_t* prv = cur - RAWC;
        float ss = 0.f;
#pragma unroll
        for (int q = 0; q < 8; ++q) {
            const int c = hd * 64 + 8 * q + 4 * hh;
            const u32x2 kc = *(const u32x2*)(cur + 512 + c); u32x2 kq = {0u, 0u}; if (hp) kq = *(const u32x2*)(prv + 512 + c);
            const f32x4 mk = *(const LAS f32x4*)(lp + 1 * 64 + 8 * q + 4 * hh), kkw = *(const LAS f32x4*)(lp + 5 * 64 + 8 * q + 4 * hh);
            const float kcur[4] = {bf_lo(kc.x), bf_hi(kc.x), bf_lo(kc.y), bf_hi(kc.y)}, kprv[4] = {bf_lo(kq.x), bf_hi(kq.x), bf_lo(kq.y), bf_hi(kq.y)};
#pragma unroll
            for (int j = 0; j < 4; ++j) { const float kk = (kcur[j] + (kprv[j] - kcur[j]) * mk[j]) * kkw[j]; ss += kk * kk; }
        }
        ss += __shfl_xor(ss, 32);
        const float inv = 1.0f / fmaxf(sqrtf(ss), 1e-12f);
        float bonus = 0.f;
        {
            bf16x8 bw[4], ba[4];
#pragma unroll
            for (int s = 0; s < 4; ++s) { const int o = 16 * s + 8 * hh; bw[s] = lerp_frag(cur + 1536 + o, prv + 1536 + o, hp, mu + 1536 + o, 1); ba[s] = lerp_frag(cur + 1600 + o, prv + 1600 + o, hp, mu + 1600 + o, 0); }
#pragma unroll 1
            for (int mt = 0; mt < 2; ++mt) {
                const int chr = hd * 64 + 32 * mt + r;
                f32x16 aw, aa;
#pragma unroll
                for (int i = 0; i < 16; ++i) { aw[i] = 0.f; aa[i] = 0.f; }
                {
                    typedef const __attribute__((address_space(1))) bf16x8* GP8;
                    const GP8 pw = (GP8)(LWU + (size_t)chr * 64 + 8 * hh), pa = (GP8)(LAU + (size_t)chr * 64 + 8 * hh);
                    bf16x8 fw[4], fa[4];
#pragma unroll
                    for (int s = 0; s < 4; ++s) { fw[s] = pw[2 * s]; fa[s] = pa[2 * s]; }
                    asm volatile("" ::: "memory");
#pragma unroll
                    for (int s = 0; s < 4; ++s) { aw = MFMA32(fw[s], bw[s], aw); aa = MFMA32(fa[s], ba[s], aa); }
                }
                u32x2 rcA[4], kcA[4], vcA[4], rpA[4], kqA[4], vpA[4];
#pragma unroll
                for (int i4 = 0; i4 < 4; ++i4) {
                    const int c = hd * 64 + 32 * mt + 8 * i4 + 4 * hh;
                    rcA[i4] = *(const u32x2*)(cur + c); kcA[i4] = *(const u32x2*)(cur + 512 + c); vcA[i4] = *(const u32x2*)(cur + 1024 + c);
                    rpA[i4] = (u32x2){0u, 0u}; kqA[i4] = (u32x2){0u, 0u}; vpA[i4] = (u32x2){0u, 0u};
                    if (hp) { rpA[i4] = *(const u32x2*)(prv + c); kqA[i4] = *(const u32x2*)(prv + 512 + c); vpA[i4] = *(const u32x2*)(prv + 1024 + c); }
                }
                asm volatile("" ::: "memory");
#pragma unroll
                for (int i4 = 0; i4 < 4; ++i4) {
                    const int c = hd * 64 + 32 * mt + 8 * i4 + 4 * hh;
                    const u32x2 rc = rcA[i4], kc = kcA[i4], vc = vcA[i4], rp = rpA[i4], kq = kqA[i4], vp = vpA[i4];
                    const int cl = 32 * mt + 8 * i4 + 4 * hh;
                    const f32x4 mr = *(const LAS f32x4*)(lp + cl), mk = *(const LAS f32x4*)(lp + 64 + cl), mv = *(const LAS f32x4*)(lp + 128 + cl);
                    const f32x4 w0v = *(const LAS f32x4*)(lp + 192 + cl), a0v = *(const LAS f32x4*)(lp + 256 + cl), kkw = *(const LAS f32x4*)(lp + 320 + cl), kaw = *(const LAS f32x4*)(lp + 384 + cl), rkw = *(const LAS f32x4*)(lp + 448 + cl);
                    const float rcur[4] = {bf_lo(rc.x), bf_hi(rc.x), bf_lo(rc.y), bf_hi(rc.y)}, rprv[4] = {bf_lo(rp.x), bf_hi(rp.x), bf_lo(rp.y), bf_hi(rp.y)};
                    const float kcur[4] = {bf_lo(kc.x), bf_hi(kc.x), bf_lo(kc.y), bf_hi(kc.y)}, kprv[4] = {bf_lo(kq.x), bf_hi(kq.x), bf_lo(kq.y), bf_hi(kq.y)};
                    const float vcur[4] = {bf_lo(vc.x), bf_hi(vc.x), bf_lo(vc.y), bf_hi(vc.y)}, vprv[4] = {bf_lo(vp.x), bf_hi(vp.x), bf_lo(vp.y), bf_hi(vp.y)};
                    f32x4 dec; float rz[4], kp[4], vz[4], kn[4], bb[4];
#pragma unroll
                    for (int j = 0; j < 4; ++j) {
                        const int i = 4 * i4 + j;
                        const float zz = -(w0v[j] + aw[i]);
                        const float sp = (zz > 20.f) ? zz : __logf(1.0f + __expf(zz));
                        const float wv = -sp - 0.5f;
                        dec[j] = __expf(-__expf(wv));
                        const float av = sigmoidf_(a0v[j] + aa[i]);
                        rz[j] = rcur[j] + (rprv[j] - rcur[j]) * mr[j];
                        const float kz = kcur[j] + (kprv[j] - kcur[j]) * mk[j];
                        vz[j] = vcur[j] + (vprv[j] - vcur[j]) * mv[j];
                        kn[j] = kz * kkw[j] * inv; bb[j] = kn[j] * av;
                        kp[j] = kz * (1.0f + (av - 1.0f) * kaw[j]);
                        bonus += rz[j] * kp[j] * rkw[j];
                    }
                    const size_t o = (size_t)t * 512 + c;
                    *(f32x4*)(W + o) = dec;
                    u32x2 w2; w2.x = cvt_pk_bf16(rz[0], rz[1]); w2.y = cvt_pk_bf16(rz[2], rz[3]); *(u32x2*)(RZ + o) = w2;
                    w2.x = cvt_pk_bf16(kp[0], kp[1]); w2.y = cvt_pk_bf16(kp[2], kp[3]); *(u32x2*)(KP + o) = w2;
                    w2.x = cvt_pk_bf16(vz[0], vz[1]); w2.y = cvt_pk_bf16(vz[2], vz[3]); *(u32x2*)(VZ + o) = w2;
                    w2.x = cvt_pk_bf16(-kn[0], -kn[1]); w2.y = cvt_pk_bf16(-kn[2], -kn[3]); *(u32x2*)(KKN + o) = w2;
                    w2.x = cvt_pk_bf16(bb[0], bb[1]); w2.y = cvt_pk_bf16(bb[2], bb[3]); *(u32x2*)(Bv + o) = w2;
                }
            }
        }
        bonus += __shfl_xor(bonus, 32);
        int t2 = t; asm volatile("" : "+v"(t2));
        if (hh == 0) ((float*)(ows(ws) + WS_BONUS))[(size_t)t2 * 8 + hd] = bonus;
        {
            bf16x8 bg[8];
#pragma unroll
            for (int s = 0; s < 8; ++s) { const int o = 16 * s + 8 * hh; bg[s] = lerp_frag(cur + 1664 + o, prv + 1664 + o, hp, mu + 1664 + o, 2); }
#pragma unroll 1
            for (int mt = 0; mt < 2; ++mt) {
                const int chr = hd * 64 + 32 * mt + r;
                f32x16 ag;
#pragma unroll
                for (int i = 0; i < 16; ++i) ag[i] = 0.f;
                {
                    typedef const __attribute__((address_space(1))) bf16x8* GP8;
                    const GP8 pg = (GP8)(LGU + (size_t)chr * 128 + 8 * hh);
                    bf16x8 fg[8];
#pragma unroll
                    for (int s = 0; s < 8; ++s) fg[s] = pg[2 * s];
                    asm volatile("" ::: "memory");
#pragma unroll
                    for (int s = 0; s < 8; ++s) ag = MFMA32(fg[s], bg[s], ag);
                }
#pragma unroll
                for (int i4 = 0; i4 < 4; ++i4) {
                    const size_t o = (size_t)t2 * 512 + hd * 64 + 32 * mt + 8 * i4 + 4 * hh;
                    u32x2 w2; w2.x = cvt_pk_bf16(ag[4 * i4], ag[4 * i4 + 1]); w2.y = cvt_pk_bf16(ag[4 * i4 + 2], ag[4 * i4 + 3]); *(u32x2*)(G + o) = w2;
                }
            }
        }
    }
}

constexpr int SC_T = 32, SC_STEP = 1344, SC_VOFF = SC_T * SC_STEP, SC_BUF = SC_VOFF + 16 * SC_T * 4;
struct ScanRegs { f32x4 w0, w1; u32x4 kn, bb, kp, rz, vv; };
DI void scan_gload(KP p, ScanRegs& R, int b, int h, int rg, int ck, int pt) {
    const unsigned char* ws = ows(p->ws);
    const size_t tok0 = (size_t)b * SEQ + (size_t)ck * SC_T;
    { const int st = pt >> 4, sub = pt & 15; R.w0 = *(const f32x4*)((const float*)(ws + WS_W) + (tok0 + st) * 512 + h * 64 + 4 * sub); }
    { const int pp = pt + 256, st = pp >> 4, sub = pp & 15; R.w1 = *(const f32x4*)((const float*)(ws + WS_W) + (tok0 + st) * 512 + h * 64 + 4 * sub); }
    const int st = pt >> 3, sub = pt & 7; const size_t go = (tok0 + st) * 512 + h * 64 + 8 * sub;
    R.kn = *(const u32x4*)((const bf16_t*)(ws + WS_KKN) + go); R.bb = *(const u32x4*)((const bf16_t*)(ws + WS_B) + go);
    R.kp = *(const u32x4*)((const bf16_t*)(ws + WS_KP) + go); R.rz = *(const u32x4*)((const bf16_t*)(ws + WS_RZ) + go);
    R.vv = (u32x4){0u, 0u, 0u, 0u};
    if (pt < 64) { const int s2 = pt >> 1, hf = pt & 1; R.vv = *(const u32x4*)((const bf16_t*)(ws + WS_VZ) + (tok0 + s2) * 512 + h * 64 + rg * 16 + 8 * hf); }
}
DI void scan_write(const ScanRegs& R, LAS unsigned char* buf, int pt) {
    { const int st = pt >> 4, sub = pt & 15; *(LAS f32x4*)(buf + st * SC_STEP + sub * 16) = R.w0; }
    { const int pp = pt + 256, st = pp >> 4, sub = pp & 15; *(LAS f32x4*)(buf + st * SC_STEP + sub * 16) = R.w1; }
    const int st = pt >> 3, sub = pt & 7;
    const u32x4 kn = R.kn, bb = R.bb, kp = R.kp, rz = R.rz;
    LAS unsigned char* d = buf + st * SC_STEP + sub * 32;
    *(LAS f32x4*)(d + 256) = (f32x4){bf_lo(kn.x), bf_hi(kn.x), bf_lo(kn.y), bf_hi(kn.y)}; *(LAS f32x4*)(d + 256 + 16) = (f32x4){bf_lo(kn.z), bf_hi(kn.z), bf_lo(kn.w), bf_hi(kn.w)};
    *(LAS f32x4*)(d + 512) = (f32x4){bf_lo(bb.x), bf_hi(bb.x), bf_lo(bb.y), bf_hi(bb.y)}; *(LAS f32x4*)(d + 512 + 16) = (f32x4){bf_lo(bb.z), bf_hi(bb.z), bf_lo(bb.w), bf_hi(bb.w)};
    *(LAS f32x4*)(d + 768) = (f32x4){bf_lo(kp.x), bf_hi(kp.x), bf_lo(kp.y), bf_hi(kp.y)}; *(LAS f32x4*)(d + 768 + 16) = (f32x4){bf_lo(kp.z), bf_hi(kp.z), bf_lo(kp.w), bf_hi(kp.w)};
    *(LAS f32x4*)(d + 1024) = (f32x4){bf_lo(rz.x), bf_hi(rz.x), bf_lo(rz.y), bf_hi(rz.y)}; *(LAS f32x4*)(d + 1024 + 16) = (f32x4){bf_lo(rz.z), bf_hi(rz.z), bf_lo(rz.w), bf_hi(rz.w)};
    if (pt < 64) { const int s2 = pt >> 1, hf = pt & 1; const u32x4 vv = R.vv;
        LAS float* dv = (LAS float*)(buf + SC_VOFF) + (8 * hf) * SC_T + s2;
        dv[0 * SC_T] = bf_lo(vv.x); dv[1 * SC_T] = bf_hi(vv.x); dv[2 * SC_T] = bf_lo(vv.y); dv[3 * SC_T] = bf_hi(vv.y);
        dv[4 * SC_T] = bf_lo(vv.z); dv[5 * SC_T] = bf_hi(vv.z); dv[6 * SC_T] = bf_lo(vv.w); dv[7 * SC_T] = bf_hi(vv.w); }
}
DI void rwkv_scan_phase(KP p, LAS unsigned char* lds, int wv) {
    const int tid = otid(wv), wave = tid >> 6, lane = tid & 63;
    float* YRAW = (float*)(p->ws + WS_YRAW);
    for (int job = blockIdx.x; job < 128; job += gridDim.x) {
        const int jx = job & 7, jk = job >> 3;
        const int chain = jx + 8 * (jk >> 2), rg = jk & 3, b = chain >> 3, h = chain & 7;
        __syncthreads();
        ScanRegs R0, R1;
        if (wave >= 4) { scan_gload(p, R0, b, h, rg, 0, tid - 256); scan_write(R0, lds, tid - 256); scan_gload(p, R0, b, h, rg, 1, tid - 256); scan_gload(p, R1, b, h, rg, 2, tid - 256); }
        __syncthreads();
        f32x4 S = {0.f, 0.f, 0.f, 0.f};
        const int jl = lane & 15, rl = 4 * (wave & 3) + (lane >> 4);
        for (int ck2 = 0; ck2 < SEQ / SC_T; ck2 += 2) {
#pragma unroll
            for (int half = 0; half < 2; ++half) {
                const int ck = ck2 + half;
                LAS unsigned char* cb = lds + (ck & 1) * SC_BUF;
                if (wave >= 4) {
                    if (ck + 1 < SEQ / SC_T) {
                        if (half == 0) { scan_write(R0, lds + ((ck + 1) & 1) * SC_BUF, tid - 256); if (ck + 3 < SEQ / SC_T) scan_gload(p, R0, b, h, rg, ck + 3, tid - 256); }
                        else           { scan_write(R1, lds + ((ck + 1) & 1) * SC_BUF, tid - 256); if (ck + 3 < SEQ / SC_T) scan_gload(p, R1, b, h, rg, ck + 3, tid - 256); }
                    }
                } else {
                    float* yo = YRAW + ((size_t)b * SEQ + (size_t)ck * SC_T + jl) * 512 + h * 64 + rg * 16 + rl;
                    const LAS unsigned char* sb = cb + jl * 16; const LAS unsigned char* vb = cb + SC_VOFF + rl * (SC_T * 4);
                    f32x4 w4 = *(const LAS f32x4*)sb, an = *(const LAS f32x4*)(sb + 256), b4 = *(const LAS f32x4*)(sb + 512), k4 = *(const LAS f32x4*)(sb + 768), r4 = *(const LAS f32x4*)(sb + 1024);
                    f32x4 vq = *(const LAS f32x4*)vb, vqn = *(const LAS f32x4*)(vb + 16);
                    f32x4 w4n = *(const LAS f32x4*)(sb + SC_STEP), ann = *(const LAS f32x4*)(sb + SC_STEP + 256), b4n = *(const LAS f32x4*)(sb + SC_STEP + 512), k4n = *(const LAS f32x4*)(sb + SC_STEP + 768), r4n = *(const LAS f32x4*)(sb + SC_STEP + 1024);
                    float yp[16];
#pragma unroll
                    for (int s = 0; s < SC_T; ++s) {
                        f32x4 w4m = w4n, anm = ann, b4m = b4n, k4m = k4n, r4m = r4n;
                        const float vi = vq[s & 3];
                        if (s + 2 < SC_T) {
                            const LAS unsigned char* sn = sb + (s + 2) * SC_STEP;
                            w4m = *(const LAS f32x4*)sn; anm = *(const LAS f32x4*)(sn + 256); b4m = *(const LAS f32x4*)(sn + 512); k4m = *(const LAS f32x4*)(sn + 768); r4m = *(const LAS f32x4*)(sn + 1024);
                        }
                        float sa = fmaf(S[3], an[3], fmaf(S[2], an[2], fmaf(S[1], an[1], S[0] * an[0])));
                        sa = row16_sum(sa);
                        S = S * w4 + (b4 * sa + k4 * vi);
                        yp[s & 15] = fmaf(S[3], r4[3], fmaf(S[2], r4[2], fmaf(S[1], r4[1], S[0] * r4[0])));
                        if ((s & 15) == 15) {
                            const bool b0 = (jl & 1) != 0, b1 = (jl & 2) != 0, b2 = (jl & 4) != 0, b3 = (jl & 8) != 0;
                            float u8[8], w4_[4], x2[2];
#pragma unroll
                            for (int k = 0; k < 8; ++k) { const float keep = b0 ? yp[2 * k + 1] : yp[2 * k], send = b0 ? yp[2 * k] : yp[2 * k + 1];
                                u8[k] = keep + __builtin_bit_cast(float, __builtin_amdgcn_update_dpp(0, __builtin_bit_cast(int, send), 0xB1, 0xF, 0xF, false)); }
#pragma unroll
                            for (int k = 0; k < 4; ++k) { const float keep = b1 ? u8[2 * k + 1] : u8[2 * k], send = b1 ? u8[2 * k] : u8[2 * k + 1];
                                w4_[k] = keep + __builtin_bit_cast(float, __builtin_amdgcn_update_dpp(0, __builtin_bit_cast(int, send), 0x4E, 0xF, 0xF, false)); }
#pragma unroll
                            for (int k = 0; k < 2; ++k) { const float keep = b2 ? w4_[2 * k + 1] : w4_[2 * k], send = b2 ? w4_[2 * k] : w4_[2 * k + 1];
                                x2[k] = keep + __builtin_bit_cast(float, __builtin_amdgcn_ds_swizzle(__builtin_bit_cast(int, send), 0x101F)); }
                            const float keep = b3 ? x2[1] : x2[0], send = b3 ? x2[0] : x2[1];
                            const float ysum = keep + __builtin_bit_cast(float, __builtin_amdgcn_ds_swizzle(__builtin_bit_cast(int, send), 0x201F));
                            yo[(size_t)(s - 15) * 512] = ysum;
                        }
                        w4 = w4n; an = ann; b4 = b4n; k4 = k4n; r4 = r4n;
                        w4n = w4m; ann = anm; b4n = b4m; k4n = k4m; r4n = r4m;
                        if ((s & 3) == 3) { vq = vqn; if (s + 5 < SC_T) vqn = *(const LAS f32x4*)(vb + (s + 5) * 4); }
                    }
                }
                __syncthreads();
            }
        }
    }
}

DI void rwkv_post_phase(KP p, int l, int wv) {
    const unsigned char* ws = ows(p->ws);
    const float* YRAW = (const float*)(ws + WS_YRAW); const bf16_t* VZ = (const bf16_t*)(ws + WS_VZ); const bf16_t* G = (const bf16_t*)(ws + WS_G);
    const float* BONUS = (const float*)(ws + WS_BONUS); bf16_t* YS = (bf16_t*)(p->ws + WS_YSR);
    const float* gnw = p->in[15] + l * 512; const float* gnb = p->in[16] + l * 512;
    const int tid_ = otid(wv); const int wave = tid_ >> 6, lane = tid_ & 63, c = 8 * lane;
    const f32x4 gw0 = *(const f32x4*)(gnw + c), gw1 = *(const f32x4*)(gnw + c + 4), gb0 = *(const f32x4*)(gnb + c), gb1 = *(const f32x4*)(gnb + c + 4);
    for (int t = blockIdx.x * 8 + wave; t < MTOK; t += gridDim.x * 8) {
        const size_t o = (size_t)t * 512 + c;
        const f32x4 y0 = *(const f32x4*)(YRAW + o), y1 = *(const f32x4*)(YRAW + o + 4);
        float s = (y0[0] + y0[1]) + (y0[2] + y0[3]) + (y1[0] + y1[1]) + (y1[2] + y1[3]);
        s += __shfl_xor(s, 1); s += __shfl_xor(s, 2); s += __shfl_xor(s, 4);
        const float mean = s * (1.0f / 64.0f);
        const f32x4 d0 = y0 - mean, d1 = y1 - mean;
        float q = (d0[0] * d0[0] + d0[1] * d0[1]) + (d0[2] * d0[2] + d0[3] * d0[3]) + (d1[0] * d1[0] + d1[1] * d1[1]) + (d1[2] * d1[2] + d1[3] * d1[3]);
        q += __shfl_xor(q, 1); q += __shfl_xor(q, 2); q += __shfl_xor(q, 4);
        const float rstd = rsqrtf(q * (1.0f / 64.0f) + 64e-5f);
        const float bon = BONUS[(size_t)t * 8 + (lane >> 3)];
        const u32x4 vv = *(const u32x4*)(VZ + o), gg = *(const u32x4*)(G + o);
        const f32x4 v0 = {bf_lo(vv.x), bf_hi(vv.x), bf_lo(vv.y), bf_hi(vv.y)}, v1 = {bf_lo(vv.z), bf_hi(vv.z), bf_lo(vv.w), bf_hi(vv.w)};
        const f32x4 g0 = {bf_lo(gg.x), bf_hi(gg.x), bf_lo(gg.y), bf_hi(gg.y)}, g1 = {bf_lo(gg.z), bf_hi(gg.z), bf_lo(gg.w), bf_hi(gg.w)};
        const f32x4 r0 = (d0 * rstd * gw0 + gb0 + v0 * bon) * g0, r1 = (d1 * rstd * gw1 + gb1 + v1 * bon) * g1;
        u32x4 w; w.x = cvt_pk_bf16(r0[0], r0[1]); w.y = cvt_pk_bf16(r0[2], r0[3]); w.z = cvt_pk_bf16(r1[0], r1[1]); w.w = cvt_pk_bf16(r1[2], r1[3]);
        *(u32x4*)(YS + o) = w;
    }
}

DI void attn_job(const bf16_t* Q, const bf16_t* K, const bf16_t* V, bf16_t* YS, float* LSE, LAS unsigned char* vl, int b, int h, int d, int rho, int J0, bool first, int lane) {
    asm volatile("" : "+v"(lane));
    const int r = lane & 31, hh = lane >> 5;
    const size_t tokq = (size_t)b * SEQ + (size_t)(J0 + r) * d + rho;
    typedef const __attribute__((address_space(1))) bf16x8* GP8;
    typedef const __attribute__((address_space(1))) u32x4* GP4;
    bf16x8 bq[4];
    { const GP8 qp = (GP8)(Q + tokq * 512 + h * 64 + 8 * hh);
#pragma unroll
      for (int s = 0; s < 4; ++s) bq[s] = qp[2 * s]; }
    bf16x8 ak[5][4];
#pragma unroll
    for (int kt = 0; kt < 5; ++kt) {
        const int Jk = J0 - 128 + 32 * kt + r;
        const size_t tokk = (size_t)b * SEQ + (size_t)(Jk >= 0 ? Jk : 0) * d + rho;
        const GP8 kp = (GP8)(K + tokk * 512 + h * 64 + 8 * hh);
#pragma unroll
        for (int s = 0; s < 4; ++s) ak[kt][s] = kp[2 * s];
    }
    asm volatile("" ::: "memory");
    f32x16 sc[5];
#pragma unroll
    for (int kt = 0; kt < 5; ++kt) {
        const bool valid = (J0 - 128 + 32 * kt + r) >= 0;
        f32x16 a;
#pragma unroll
        for (int i = 0; i < 16; ++i) a[i] = 0.f;
#pragma unroll
        for (int s = 0; s < 4; ++s) {
            bf16x8 kf = ak[kt][s];
            if (!valid) kf = (bf16x8){0, 0, 0, 0, 0, 0, 0, 0};
            a = MFMA32(kf, bq[s], a);
        }
        sc[kt] = a;
    }
    float m = -1e30f;
#pragma unroll
    for (int kt = 0; kt < 5; ++kt)
#pragma unroll
        for (int i = 0; i < 16; ++i) {
            const int kidx = 32 * kt + crow(i, hh); const int dist = 128 + r - kidx;
            const bool ok = (dist >= 0) && (dist <= 128) && (J0 - 128 + kidx >= 0);
            const float v = ok ? sc[kt][i] * 0.125f : -1e30f;
            sc[kt][i] = v; m = fmaxf(m, v);
        }
    m = fmaxf(m, __shfl_xor(m, 32));
    float lsum = 0.f;
#pragma unroll
    for (int kt = 0; kt < 5; ++kt)
#pragma unroll
        for (int i = 0; i < 16; ++i) { const float pv = __expf(sc[kt][i] - m); sc[kt][i] = pv; lsum += pv; }
    lsum += __shfl_xor(lsum, 32);
    const float lse = m + __logf(lsum);
    f32x16 o[2];
#pragma unroll
    for (int i = 0; i < 16; ++i) { o[0][i] = 0.f; o[1][i] = 0.f; }
    u32x4 vr[4];
    {
        const int key = lane >> 1, hf = lane & 1; const int Jk = J0 - 128 + key;
        const size_t tokv = (size_t)b * SEQ + (size_t)(Jk >= 0 ? Jk : 0) * d + rho;
        const GP4 src = (GP4)(V + tokv * 512 + h * 64 + 32 * hf);
        vr[0] = src[0]; vr[1] = src[1]; vr[2] = src[2]; vr[3] = src[3];
    }
#pragma unroll
    for (int kt = 0; kt < 5; ++kt) {
        {
            const int key = lane >> 1, hf = lane & 1;
            LAS u32x4* dst = (LAS u32x4*)(vl + key * 128 + hf * 64);
            dst[0] = vr[0]; dst[1] = vr[1]; dst[2] = vr[2]; dst[3] = vr[3];
            if (kt + 1 < 5) {
                const int Jk = J0 - 128 + 32 * (kt + 1) + key;
                const size_t tokv = (size_t)b * SEQ + (size_t)(Jk >= 0 ? Jk : 0) * d + rho;
                const GP4 src = (GP4)(V + tokv * 512 + h * 64 + 32 * hf);
                vr[0] = src[0]; vr[1] = src[1]; vr[2] = src[2]; vr[3] = src[3];
            }
        }
        LDS_WAIT();
#pragma unroll
        for (int s = 0; s < 2; ++s) {
            const bf16x8 xs = pack8(sc[kt][8 * s], sc[kt][8 * s + 1], sc[kt][8 * s + 2], sc[kt][8 * s + 3], sc[kt][8 * s + 4], sc[kt][8 * s + 5], sc[kt][8 * s + 6], sc[kt][8 * s + 7]);
#pragma unroll
            for (int mt = 0; mt < 2; ++mt) {
                bf16x8 pa;
#pragma unroll
                for (int j = 0; j < 8; ++j) { const int key = 16 * s + 8 * (j >> 2) + 4 * hh + (j & 3); pa[j] = (short)*(const LAS bf16_t*)(vl + key * 128 + (r + 32 * mt) * 2); }
                o[mt] = MFMA32(pa, xs, o[mt]);
            }
        }
        LDS_WAIT();
    }
    const float il = 1.0f / lsum;
    float wp = 0.f, wc = 1.0f, nl = lse;
    if (!first) { const float lp = LSE[tokq * 8 + h]; const float mx = fmaxf(lp, lse); const float ep = __expf(lp - mx), ec = __expf(lse - mx); nl = mx + __logf(ep + ec); wp = ep / (ep + ec); wc = ec / (ep + ec); }
#pragma unroll
    for (int mt = 0; mt < 2; ++mt)
#pragma unroll
        for (int g4 = 0; g4 < 4; ++g4) {
            bf16_t* dst = YS + tokq * 512 + h * 64 + 32 * mt + 8 * g4 + 4 * hh;
            float v[4];
#pragma unroll
            for (int j = 0; j < 4; ++j) v[j] = o[mt][4 * g4 + j] * il * wc;
            if (!first) { const u32x2 pw = *(const u32x2*)dst; v[0] += bf_lo(pw.x) * wp; v[1] += bf_hi(pw.x) * wp; v[2] += bf_lo(pw.y) * wp; v[3] += bf_hi(pw.y) * wp; }
            u32x2 w2; w2.x = cvt_pk_bf16(v[0], v[1]); w2.y = cvt_pk_bf16(v[2], v[3]); *(u32x2*)dst = w2;
        }
    if (hh == 0) LSE[tokq * 8 + h] = nl;
}

DI void attention_phase(KP p, LAS unsigned char* lds, int wv) {
    unsigned char* ws = ows(p->ws);
    const bf16_t *Q = (const bf16_t*)(ws + WS_Q), *K = (const bf16_t*)(ws + WS_K), *V = (const bf16_t*)(ws + WS_V);
    bf16_t* YS = (bf16_t*)(ws + WS_YSA); float* LSE = (float*)(ws + WS_LSE);
    const int tid_ = otid(wv); const int wave = tid_ >> 6, lane = tid_ & 63;
    LAS unsigned char* vl = lds + wave * 4096;
    for (int item0 = blockIdx.x; item0 < 256; item0 += gridDim.x) {
        const int item = (((item0 & 7) * 4 + (item0 >> 6)) << 3) | ((item0 >> 3) & 7);
        const int b = item >> 6, h = (item >> 3) & 7, qb = item & 7, P0 = qb * 512;
#pragma unroll 1
        for (int cfg = 0; cfg < 3; ++cfg) {
#pragma unroll 1
            for (int jj = wave; jj < 16; jj += 8) {
                int d, rho, J0;
                if (cfg == 0) { d = 1; rho = 0; J0 = P0 + 32 * jj; }
                else if (cfg == 1) { d = 4; rho = jj & 3; J0 = (P0 >> 2) + 32 * (jj >> 2); }
                else { d = 16; rho = jj; J0 = P0 >> 4; }
                attn_job(Q, K, V, YS, LSE, vl, b, h, d, rho, J0, cfg == 0, lane);
            }
            asm volatile("s_waitcnt vmcnt(0)" ::: "memory");
            __syncthreads();
        }
    }
}

DI void gmlp_phase(KP p, int l, LAS unsigned char* lds, int wv) {
    unsigned char* ws = ows(p->ws);
    const bf16_t* UV = (const bf16_t*)(ws + WS_UV); bf16_t* YS = (bf16_t*)(ws + WS_YSG);
    const float* lng = p->in[17] + l * 512; const float* lnb = p->in[18] + l * 512;
    const float* wsp = p->in[19] + (size_t)l * 8 * 128 * 128; const float* bsp = p->in[20] + (size_t)l * 8 * 128;
    const int tid_ = otid(wv); const int wave = tid_ >> 6, lane = tid_ & 63, r = lane & 31, hh = lane >> 5;
    LAS float* stats = (LAS float*)(lds + 8 * 17408);
    LAS bf16_t* VT = (LAS bf16_t*)(lds + wave * 17408);
    for (int item0 = blockIdx.x; item0 < 256; item0 += gridDim.x) {
        const int item = ((((item0 & 7) << 4) | (item0 >> 4)) << 1) | ((item0 >> 3) & 1);
        const size_t tok0 = (size_t)(item >> 1) * 128;
        __syncthreads();
        for (int tt = 0; tt < 16; ++tt) {
            const int tl = wave * 16 + tt;
            const u32x4 x = *(const u32x4*)(UV + (tok0 + tl) * 1024 + 512 + 8 * lane);
            const float f[8] = {bf_lo(x.x), bf_hi(x.x), bf_lo(x.y), bf_hi(x.y), bf_lo(x.z), bf_hi(x.z), bf_lo(x.w), bf_hi(x.w)};
            float s = 0.f;
#pragma unroll
            for (int j = 0; j < 8; ++j) s += f[j];
            const float mean = wave_sum(s) * (1.0f / 512.0f); float q = 0.f;
#pragma unroll
            for (int j = 0; j < 8; ++j) { const float dd = f[j] - mean; q += dd * dd; }
            const float rstd = rsqrtf(wave_sum(q) * (1.0f / 512.0f) + 1e-5f);
            if (lane == 0) { stats[2 * tl] = mean; stats[2 * tl + 1] = rstd; }
        }
        __syncthreads();
        const int g = (item & 1) * 4 + (wave & 3);
        if (wave < 4) {
        {
            const int d0 = 8 * (lane & 7);
            const f32x4 lg0 = *(const f32x4*)(lng + g * 64 + d0), lg1 = *(const f32x4*)(lng + g * 64 + d0 + 4), lb0 = *(const f32x4*)(lnb + g * 64 + d0), lb1 = *(const f32x4*)(lnb + g * 64 + d0 + 4);
            for (int it = 0; it < 16; ++it) {
                const int tl = it * 8 + (lane >> 3);
                const u32x4 x = *(const u32x4*)(UV + (tok0 + tl) * 1024 + 512 + g * 64 + d0);
                const float mean = stats[2 * tl], rstd = stats[2 * tl + 1];
                const float f[8] = {bf_lo(x.x), bf_hi(x.x), bf_lo(x.y), bf_hi(x.y), bf_lo(x.z), bf_hi(x.z), bf_lo(x.w), bf_hi(x.w)};
#pragma unroll
                for (int e = 0; e < 8; ++e) {
                    const float gg = e < 4 ? lg0[e & 3] : lg1[e & 3], bb = e < 4 ? lb0[e & 3] : lb1[e & 3];
                    const float y = (f[e] - mean) * rstd * gg + bb;
                    VT[(d0 + e) * 136 + tl] = (bf16_t)(cvt_pk_bf16(y, 0.f) & 0xffffu);
                }
            }
        }
        LDS_WAIT();
#pragma unroll 1
        for (int nt = 0; nt < 4; ++nt) {
            f32x16 acc[2];
#pragma unroll
            for (int i = 0; i < 16; ++i) { acc[0][i] = 0.f; acc[1][i] = 0.f; }
            const int irow = 32 * nt + r;
            for (int s = 0; s < 2 * (nt + 1); ++s) {
                const int j0 = 16 * s + 8 * hh;
                const float* wr_ = wsp + ((size_t)g * 128 + irow) * 128 + j0;
                const f32x4 wa = *(const f32x4*)wr_, wb = *(const f32x4*)(wr_ + 4);
                float wv[8] = {wa[0], wa[1], wa[2], wa[3], wb[0], wb[1], wb[2], wb[3]};
#pragma unroll
                for (int j = 0; j < 8; ++j) if (j0 + j > irow) wv[j] = 0.f;
                const bf16x8 bfr = pack8(wv[0], wv[1], wv[2], wv[3], wv[4], wv[5], wv[6], wv[7]);
#pragma unroll
                for (int mt = 0; mt < 2; ++mt) {
                    const bf16x8 afr = *(const LAS bf16x8*)(VT + (32 * mt + r) * 136 + j0);
                    acc[mt] = MFMA32(afr, bfr, acc[mt]);
                }
            }
            const size_t tok = tok0 + irow; const float bs = bsp[g * 128 + irow];
#pragma unroll
            for (int mt = 0; mt < 2; ++mt)
#pragma unroll
                for (int g4 = 0; g4 < 4; ++g4) {
                    const int c = g * 64 + 32 * mt + 8 * g4 + 4 * hh;
                    const u32x2 uu = *(const u32x2*)(UV + tok * 1024 + c);
                    const float o0 = bf_lo(uu.x) * (acc[mt][4 * g4] + bs), o1 = bf_hi(uu.x) * (acc[mt][4 * g4 + 1] + bs), o2 = bf_lo(uu.y) * (acc[mt][4 * g4 + 2] + bs), o3 = bf_hi(uu.y) * (acc[mt][4 * g4 + 3] + bs);
                    u32x2 w2; w2.x = cvt_pk_bf16(o0, o1); w2.y = cvt_pk_bf16(o2, o3); *(u32x2*)(YS + tok * 512 + c) = w2;
                }
        }
        }
    }
}

DI void ffn_fix_phase(KP p, int l, int wv) {
    unsigned char* ws = ows(p->ws);
    bf16_t* ACT = (bf16_t*)(ws + WS_UP); const float* SA = (const float*)(ws + WS_SIDEA); const float* SG = (const float*)(ws + WS_SIDEG);
    const float* cw = p->in[25] + (size_t)l * 3 * DFF; const float* cb = p->in[26] + (size_t)l * DFF;
    constexpr int NCG = DFF / 8;
    const int tid_ = otid(wv);
    for (int item = blockIdx.x * 512 + tid_; item < 256 * 2 * NCG; item += gridDim.x * 512) {
        const int cgi = item % NCG, qe = item / NCG, q = qe >> 1, e = qe & 1, f = 8 * cgi;
        const bool first = (q & 63) == 0;
        float o[8];
#pragma unroll
        for (int hf = 0; hf < 2; ++hf) {
            const int ff = f + 4 * hf;
            const f32x4 at = *(const f32x4*)(SA + ((size_t)q * 4 + e) * DFF + ff);
            f32x4 t1 = {0.f, 0.f, 0.f, 0.f}, t2 = {0.f, 0.f, 0.f, 0.f};
            if (e == 1) t1 = *(const f32x4*)(SA + ((size_t)q * 4 + 0) * DFF + ff);
            else if (!first) t1 = *(const f32x4*)(SA + ((size_t)(q - 1) * 4 + 3) * DFF + ff);
            if (!first) t2 = *(const f32x4*)(SA + ((size_t)(q - 1) * 4 + (e == 1 ? 3 : 2)) * DFF + ff);
            const f32x4 g = *(const f32x4*)(SG + ((size_t)q * 2 + e) * DFF + ff);
            const f32x4 w0 = *(const f32x4*)(cw + ff), w1 = *(const f32x4*)(cw + DFF + ff), w2 = *(const f32x4*)(cw + 2 * DFF + ff), bb = *(const f32x4*)(cb + ff);
            const f32x4 c = bb + w0 * t2 + w1 * t1 + w2 * at;
#pragma unroll
            for (int j = 0; j < 4; ++j) o[4 * hf + j] = gelu_tanh(c[j]) * g[j];
        }
        u32x4 w; w.x = cvt_pk_bf16(o[0], o[1]); w.y = cvt_pk_bf16(o[2], o[3]); w.z = cvt_pk_bf16(o[4], o[5]); w.w = cvt_pk_bf16(o[6], o[7]);
        *(u32x4*)(ACT + (size_t)(64 * q + e) * DFF + f) = w;
    }
}

__global__ void __launch_bounds__(512) fwd_megakernel(Params p_unused) {
    extern __shared__ __attribute__((aligned(16))) unsigned char lds_raw[];
    LAS unsigned char* lds = (LAS unsigned char*)lds_raw;
    cg::grid_group grid = cg::this_grid();
    KP p = okp();
    unsigned char* ws = p->ws;
    const int G = gridDim.x, c = blockIdx.x;
    const int wv = __builtin_amdgcn_readfirstlane((int)(threadIdx.x >> 6));
    pg8::Epi E; pg8::TileOrder S; pg8::Gemm g;

    unsigned* bar = (unsigned*)(ws + WS_BAR);
    volatile LAS unsigned* xst = (volatile LAS unsigned*)(lds + LDS_BYTES - 16);
    const unsigned myx = xb_xcc_id();
    if (otid(wv) == 0) { xb_add(&bar[XB_CNT(myx)], 1u); __builtin_amdgcn_fence(__ATOMIC_RELEASE, "agent"); }
    grid.sync();
    if (otid(wv) == 0) {
        unsigned mine = 0u, cnt = 0u;
#pragma unroll
        for (unsigned j = 0; j < 8; ++j) { const unsigned c = xb_ld(&bar[XB_CNT(j)]); cnt += (c > 0u) ? 1u : 0u; mine = (j == myx) ? c : mine; }
        xst[0] = mine > 0u ? mine : 1u; xst[1] = cnt > 0u ? cnt : 1u; xst[2] = myx;
    }
    __syncthreads();
    phase0(p, lds, wv);
    gbar(bar, xst, wv);
#pragma unroll 1
    for (int st = 0; st < 2 * 12; ++st) {
        const int l = st / 12, step = st % 12;
        p = okp(); ws = ows(p->ws);
        const float* mod = (const float*)(ws + WS_MOD); const bf16_t* H = (const bf16_t*)(ws + WS_H);
        const float* ml = mod + (size_t)l * 4 * 6144;
        const float* xin = (l == 0) ? p->in[0] : p->out;
        bool do_gemm = false;
        E = pg8::Epi{}; g.merge = 0; g.ws = ws;
        if (step == 0) {
            if (l > 0) convert_weights(p, l, lds, wv);
            norm_mod_phase(xin, p->in[4] + l * DM, ml + 0, ml + 1024, (bf16_t*)(ws + WS_H), wv);
        } else if (step == 1 || step == 4) {
            if (step == 4) rwkv_post_phase(p, l, wv);
            E.mode = pg8::EM_INPROJ; E.o0 = (bf16_t*)(ws + WS_Q); E.o1 = (bf16_t*)(ws + WS_K); E.o2 = (bf16_t*)(ws + WS_V); E.o3 = (bf16_t*)(ws + WS_RAW); E.o4 = (bf16_t*)(ws + WS_UV);
            E.ropec = (const float*)(ws + WS_ROPEC); E.ropes = (const float*)(ws + WS_ROPES);
            g.A = H; g.Bt = (const bf16_t*)(ws + WS_WIN); g.lda = 1024; g.K = 1024;
            if (step == 1) S.init(64, 7, G, c, 7, 6, 0); else S.init(64, 10, G, c, 6, 0, 13);
            do_gemm = true;
        } else if (step == 2) { rwkv_derived_phase(p, l, lds, wv); }
        else if (step == 3) { rwkv_scan_phase(p, lds, wv); }
        else if (step == 5) { attention_phase(p, lds, wv); gmlp_phase(p, l, lds, wv); }
        else if (step == 6) {
            E.mode = pg8::EM_MERGE; E.o0 = (bf16_t*)(ws + WS_GATE); E.o1 = (bf16_t*)(ws + WS_MB);
            g.merge = 1; g.A = H; g.Bt = (const bf16_t*)(ws + WS_WIN); g.lda = 1024; g.K = 1024;
            S.init(64, 4, G, c, 4, 0, 0, 6);
            do_gemm = true;
        } else if (step == 7) {
            E.mode = pg8::EM_RESID; E.f0 = p->out; E.f1 = xin; E.f2 = ml + 2048;
            g.A = (const bf16_t*)(ws + WS_MB); g.Bt = (const bf16_t*)(ws + WS_WOUT); g.lda = 1024; g.K = 1024;
            S.init(64, 4, G, c, 4, 0, 0); do_gemm = true;
        } else if (step == 8) { norm_mod_phase(p->out, p->in[23] + l * DM, ml + 3072, ml + 4096, (bf16_t*)(ws + WS_H), wv); }
        else if (step == 9) {
            E.mode = pg8::EM_UP; E.o0 = (bf16_t*)(ws + WS_UP); E.f0 = (float*)(ws + WS_SIDEA); E.f3 = (float*)(ws + WS_SIDEG); E.f1 = p->in[25] + (size_t)l * 3 * DFF; E.f2 = p->in[26] + (size_t)l * DFF;
            g.A = H; g.Bt = (const bf16_t*)(ws + WS_WUP); g.lda = 1024; g.K = 1024;
            S.init(64, 22, G, c, 22, 0, 0); do_gemm = true;
        } else if (step == 10) { ffn_fix_phase(p, l, wv); }
        else {
            E.mode = pg8::EM_RESID; E.f0 = p->out; E.f1 = p->out; E.f2 = ml + 5120;
            g.A = (const bf16_t*)(ws + WS_UP); g.Bt = (const bf16_t*)(ws + WS_WDN); g.lda = DFF; g.K = DFF;
            S.init(64, 4, G, c, 4, 0, 0); do_gemm = true;
        }
        if (do_gemm) pg8::gemm_phase(lds, g, S, E, wv);
        gbar((unsigned*)(ws + WS_BAR), xst, wv);
    }
    p = okp();
    final_norm_phase(p->out, p->in[28], wv);
}

extern "C" void kernel_launch(void* const* d_in, const int* in_sizes, int n_in, void* d_out, int out_size, void* d_ws, size_t ws_size, hipStream_t stream) {
    static int grid_blocks = 0;
    if (grid_blocks == 0) {
        int dev = 0, cus = 0, per_cu = 0;
        hipGetDevice(&dev);
        hipDeviceGetAttribute(&cus, hipDeviceAttributeMultiprocessorCount, dev);
        if (hipFuncSetAttribute((const void*)fwd_megakernel, hipFuncAttributeMaxDynamicSharedMemorySize, LDS_BYTES) != hipSuccess) { fprintf(stderr, "hipFuncSetAttribute failed\n"); }
        hipOccupancyMaxActiveBlocksPerMultiprocessor(&per_cu, (const void*)fwd_megakernel, 512, LDS_BYTES);
        if (per_cu < 1) { fprintf(stderr, "occupancy query returned %d\n", per_cu); per_cu = 1; }
        if (per_cu > 1) per_cu = 1;
        grid_blocks = cus * per_cu;
        (void)hipGetLastError();
    }
    if (n_in != 29 || ws_size < 256 * MiB) { fprintf(stderr, "unexpected inputs/workspace\n"); return; }
    (void)hipMemsetAsync((unsigned char*)d_ws + WS_BAR, 0, XB_WORDS * 4, stream);
    Params p{};
    for (int i = 0; i < 29; ++i) p.in[i] = (const float*)d_in[i];
    p.out = (float*)d_out; p.ws = (unsigned char*)d_ws;
    void* args[] = {&p};
    hipError_t e = hipLaunchCooperativeKernel((const void*)fwd_megakernel, dim3(grid_blocks), dim3(512), args, LDS_BYTES, stream);
    if (e != hipSuccess) fprintf(stderr, "cooperative launch failed: %s (grid %d)\n", hipGetErrorString(e), grid_blocks);
}
```
